# Optimizing an MI355X kernel written in HIP

```python
import math
import jax, jax.numpy as jnp
from jax import lax
import numpy as np

D_MODEL = 1024
BATCH = 1
SEQ = 16384
DEPTH = 1

CHUNK = 64
Q_BLOCK = 128
EPS = 1e-6
FOX_HEADS = 8
FOX_HD = 64
FOX_W = FOX_HEADS * FOX_HD
MLA_HEADS = 8
MLA_NOPE = 64
MLA_ROPE = 32
MLA_V = 64
Q_LORA = 256
KV_LORA = 128
ROPE_THETA = 10000.0
MLA_W = MLA_HEADS * MLA_V
MIX_W = FOX_W + MLA_W
IN_SIZES = (FOX_W, FOX_W, FOX_W, FOX_HEADS, Q_LORA, KV_LORA, MLA_ROPE)
IN_COLS = int(sum(IN_SIZES))
IN_SPLITS = [int(s) for s in np.cumsum(IN_SIZES)[:-1]]
D_FF = 4 * D_MODEL

kernel_name = "hymba_fox_mla_sqrelu_block"


def _rmsnorm(x, g):
    xf = x.astype(jnp.float32)
    y = xf * lax.rsqrt(jnp.mean(xf * xf, axis=-1, keepdims=True) + EPS)
    return (y * g.astype(jnp.float32)).astype(x.dtype)


def _rope(x, pos):
    half = x.shape[-1] // 2
    inv = ROPE_THETA ** (-jnp.arange(half, dtype=jnp.float32) / half)
    ang = pos.astype(jnp.float32)[:, None] * inv[None, :]
    cos = jnp.cos(ang).astype(x.dtype)
    sin = jnp.sin(ang).astype(x.dtype)
    x1, x2 = x[..., :half], x[..., half:]
    return jnp.concatenate([x1 * cos - x2 * sin, x2 * cos + x1 * sin], axis=-1)


def _block_sweep(q, k, v, block_bias, scale):
    b, h, s, dk = q.shape
    nb = s // Q_BLOCK
    qb = q.reshape(b, h, nb, Q_BLOCK, dk).transpose(2, 0, 1, 3, 4)

    def one(args):
        i, qi = args
        logits = jnp.einsum('bhqd,bhkd->bhqk', qi, k).astype(jnp.float32) * scale
        probs = jax.nn.softmax(logits + block_bias(i), axis=-1)
        return jnp.einsum('bhqk,bhkd->bhqd', probs.astype(v.dtype), v)

    out = lax.map(one, (jnp.arange(nb), qb))
    return out.transpose(1, 2, 0, 3, 4).reshape(b, h, s, v.shape[-1])


def _hybrid_mixer(h, pos, w_in, b_f, g_q, w_q_up, g_kv, w_kv_up, w_o):
    b, s, _ = h.shape
    p = jnp.einsum('bsd,dc->bsc', h, w_in)
    fq, fk, fv, f_logit, q_lat, kv_lat, k_rope_raw = jnp.split(p, IN_SPLITS, axis=-1)
    kpos = jnp.arange(s)

    def heads(t, nh):
        return t.reshape(b, s, nh, -1).transpose(0, 2, 1, 3)
    fq, fk, fv = heads(fq, FOX_HEADS), heads(fk, FOX_HEADS), heads(fv, FOX_HEADS)
    log_f = jax.nn.log_sigmoid((f_logit + b_f).astype(jnp.float32))
    logcum = jnp.cumsum(log_f, axis=1).transpose(0, 2, 1)

    def fox_bias(i):
        start = i * Q_BLOCK
        cq = lax.dynamic_slice_in_dim(logcum, start, Q_BLOCK, axis=2)
        qpos = start + jnp.arange(Q_BLOCK)
        mask = kpos[None, :] <= qpos[:, None]
        return jnp.where(mask, cq[..., None] - logcum[:, :, None, :], -jnp.inf)

    o_fox = _block_sweep(fq, fk, fv, fox_bias, 1.0 / math.sqrt(FOX_HD))

    cq = jnp.einsum('bsr,rc->bsc', _rmsnorm(q_lat, g_q), w_q_up)
    cq = heads(cq, MLA_HEADS)
    q_mla = jnp.concatenate([cq[..., :MLA_NOPE], _rope(cq[..., MLA_NOPE:], pos)], axis=-1)
    ckv = jnp.einsum('bsr,rc->bsc', _rmsnorm(kv_lat, g_kv), w_kv_up)
    ckv = heads(ckv, MLA_HEADS)
    k_nope, v_mla = ckv[..., :MLA_NOPE], ckv[..., MLA_NOPE:]
    k_rope = _rope(k_rope_raw, pos)[:, None]
    k_mla = jnp.concatenate(
        [k_nope, jnp.broadcast_to(k_rope, (b, MLA_HEADS, s, MLA_ROPE))], axis=-1)

    def chunk_bias(i):
        qpos = i * Q_BLOCK + jnp.arange(Q_BLOCK)
        mask = (kpos // CHUNK)[None, :] <= (qpos // CHUNK)[:, None]
        return jnp.where(mask, jnp.float32(0.0), jnp.float32(-jnp.inf))[None, None]

    o_mla = _block_sweep(q_mla, k_mla, v_mla, chunk_bias,
                         1.0 / math.sqrt(MLA_NOPE + MLA_ROPE))

    o = jnp.concatenate([o_fox, o_mla], axis=1)
    o = o.transpose(0, 2, 1, 3).reshape(b, s, MIX_W)
    return jnp.einsum('bsc,cd->bsd', o, w_o)


def setup_inputs(seed: int = 0) -> dict:
    key = jax.random.key(seed)
    ks = jax.random.split(key, 16)
    L = DEPTH

    def w(k, shape, fan_in):
        return jax.random.normal(k, shape, jnp.float32) * fan_in ** -0.5

    def gain(k, shape):
        return 1.0 + 0.05 * jax.random.normal(k, shape, jnp.float32)

    return {
        "x": jax.random.normal(ks[0], (BATCH, SEQ, D_MODEL), jnp.float32),
        "g_mix": gain(ks[1], (L, D_MODEL)),
        "w_in": w(ks[2], (L, D_MODEL, IN_COLS), D_MODEL),
        "b_f": 3.0 + 0.5 * jax.random.normal(ks[3], (L, FOX_HEADS), jnp.float32),
        "g_q": gain(ks[4], (L, Q_LORA)),
        "w_q_up": w(ks[5], (L, Q_LORA, MLA_HEADS * (MLA_NOPE + MLA_ROPE)), Q_LORA),
        "g_kv": gain(ks[6], (L, KV_LORA)),
        "w_kv_up": w(ks[7], (L, KV_LORA, MLA_HEADS * (MLA_NOPE + MLA_V)), KV_LORA),
        "w_o": w(ks[8], (L, MIX_W, D_MODEL), MIX_W),
        "g_mlp": gain(ks[9], (L, D_MODEL)),
        "w_ff1": w(ks[10], (L, D_MODEL, D_FF), D_MODEL),
        "w_ff2": w(ks[11], (L, D_FF, D_MODEL), D_FF),
        "g_final": gain(ks[12], (D_MODEL,)),
    }


def reference(x, g_mix, w_in, b_f, g_q, w_q_up, g_kv, w_kv_up, w_o,
              g_mlp, w_ff1, w_ff2, g_final):
    pos = jnp.arange(x.shape[1])
    for l in range(DEPTH):
        h = _rmsnorm(x, g_mix[l])
        x = x + _hybrid_mixer(h, pos, w_in[l], b_f[l], g_q[l], w_q_up[l],
                              g_kv[l], w_kv_up[l], w_o[l])
        h2 = _rmsnorm(x, g_mlp[l])
        u = jnp.einsum('bsd,df->bsf', h2, w_ff1[l])
        x = x + jnp.einsum('bsf,fd->bsd', jnp.square(jax.nn.relu(u)), w_ff2[l])
    return _rmsnorm(x, g_final)
```

```cpp
#include <hip/hip_runtime.h>
#include <hip/hip_cooperative_groups.h>
#include <hip/hip_bf16.h>
#include <cstdio>
#include <cstdint>
#include <cmath>
namespace pg8 {
#define PG8_LAS __attribute__((address_space(3)))
typedef unsigned short bf16_t;
typedef short bf16x8 __attribute__((ext_vector_type(8)));
typedef float f32x4 __attribute__((ext_vector_type(4)));
typedef unsigned u32x4 __attribute__((ext_vector_type(4)));
constexpr int BM = 256, BK = 64, HALF = 128, HTB = HALF * BK * 2  , STAGE_BYTES = 8 * HTB, NXCD = 8, WGM = 8;

__host__ __device__ __forceinline__ int lds_byte(int r, int c) { const int st = (r >> 4) * 2 + (c >> 5), rr = r & 15, cc = c & 31, ob = rr * 64 + cc * 2; return st * 1024 + (ob ^ (((ob >> 9) & 1) << 5)); }
__host__ __device__ __forceinline__ void stage_rc(int b, int& R, int& C) { const int st = b / 1024, sb = b % 1024, swz = sb ^ (((sb >> 9) & 1) << 5); R = (st >> 1) * 16 + swz / 64; C = (st & 1) * 32 + (swz % 64) / 2; }
__host__ __device__ __forceinline__ int perm32(int rho) { const int n = rho >> 4, i = rho & 15; return 8 * (i >> 2) + 4 * n + (i & 3); }

struct Unit { int pm, pn; };
struct Gemm { const bf16_t* A; const bf16_t* Bt; int M, N, K; int lda; };

struct StaticOrder {
    int nM, nN, nwg, G, c;
    __host__ __device__ void init(int M, int N, int G_, int c_) { nM = M / BM; nN = N / BM; nwg = nM * nN; G = G_; c = c_; }
    __host__ __device__ bool next(int i, Unit& u) const {
        const long L = (long)i * G + c; if (L >= nwg) return false;
        int wgid = (int)L; { const int q = nwg / NXCD, r = nwg % NXCD, xcd = wgid % NXCD, off = wgid / NXCD; wgid = (xcd < r ? xcd * (q + 1) : r * (q + 1) + (xcd - r) * q) + off; }
        const int nig = WGM * nN, gid = wgid / nig, fm = gid * WGM, gsz = (nM - fm) < WGM ? (nM - fm) : WGM;
        u.pm = fm + ((wgid % nig) % gsz); u.pn = (wgid % nig) / gsz; return true;
    }
    __device__ __forceinline__ void a_ready(const Unit&) const {}
    __device__ __forceinline__ void done(const Unit&) const {}
};

__device__ __forceinline__ unsigned cvt_pk_bf16(float lo, float hi) { unsigned r; asm volatile("v_cvt_pk_bf16_f32 %0, %1, %2" : "=v"(r) : "v"(lo), "v"(hi)); return r; }
typedef float f32x2 __attribute__((ext_vector_type(2)));
__device__ __forceinline__ f32x2 gelu_pk(f32x2 v) {
    const f32x2 av = __builtin_elementwise_abs(v), d = av * 0.2316418882f + 1.0f;
    f32x2 t; t.x = __builtin_amdgcn_rcpf(d.x); t.y = __builtin_amdgcn_rcpf(d.y);
    f32x2 q = t * 0.5307027145f + (-0.7265760135f); q = q * t + 0.7107068705f; q = q * t + (-0.142248368f); q = q * t + 0.127414796f; q = q * t;
    const f32x2 s = (v * v) * (-0.72134752044f);
    f32x2 e; e.x = __builtin_amdgcn_exp2f(s.x); e.y = __builtin_amdgcn_exp2f(s.y);
    const f32x2 m = v * (q * e), r = v - m;
    f32x2 o; o.x = v.x < 0.f ? m.x : r.x; o.y = v.y < 0.f ? m.y : r.y; return o;
}

template <int ACT  > struct EpiBf16 {
    static constexpr bool PERM = true, AFTER_DRAIN = false; static_assert(ACT == 0 || ACT == 1, "EpiBf16: ACT is 0 (none) or 1 (gelu_pk)");
    bf16_t* O; int ldc; const float* bias; int split_cols; size_t split_stride; float scale0;
    __device__ __forceinline__ void operator()(const f32x4 (&acc)[2][2][4][2], const Unit& u, int wr, int wc, int fr, int fq) const {
        const int row0 = u.pm * BM + wr * 64 + fr; int colt = u.pn * BM; bf16_t* base = O;
        float sc = 1.f; if (split_cols) { const int t = colt / split_cols; base += (size_t)t * split_stride; colt -= t * split_cols; if (t == 0) sc = scale0; }
        const int col0 = colt + wc * 32 + 8 * fq, bcol0 = u.pn * BM + wc * 32 + 8 * fq;
        f32x4 bv[2][2];
#pragma unroll
        for (int bj = 0; bj < 2; ++bj)
#pragma unroll
            for (int n = 0; n < 2; ++n) bv[bj][n] = bias ? *(const f32x4*)(bias + bcol0 + bj * HALF + 4 * n) : (f32x4){0.f, 0.f, 0.f, 0.f};
#pragma unroll
        for (int ai = 0; ai < 2; ++ai)
#pragma unroll
            for (int m = 0; m < 4; ++m) { bf16_t* rowp = base + (size_t)(row0 + ai * HALF + m * 16) * ldc + col0;
#pragma unroll
                for (int bj = 0; bj < 2; ++bj) { f32x4 v0 = acc[ai][bj][m][0] + bv[bj][0], v1 = acc[ai][bj][m][1] + bv[bj][1];
                    if (ACT == 1) { f32x2 a = gelu_pk((f32x2){v0[0], v0[1]}), b = gelu_pk((f32x2){v0[2], v0[3]}), c = gelu_pk((f32x2){v1[0], v1[1]}), d = gelu_pk((f32x2){v1[2], v1[3]});
                        v0 = (f32x4){a.x, a.y, b.x, b.y}; v1 = (f32x4){c.x, c.y, d.x, d.y}; }
                    v0 = v0 * sc; v1 = v1 * sc; u32x4 w; w.x = cvt_pk_bf16(v0[0], v0[1]); w.y = cvt_pk_bf16(v0[2], v0[3]); w.z = cvt_pk_bf16(v1[0], v1[1]); w.w = cvt_pk_bf16(v1[2], v1[3]);
                    *(u32x4*)(rowp + bj * HALF) = w; } }
    }
};

struct EpiQm {
    static constexpr bool PERM = true, AFTER_DRAIN = false;
    bf16_t* O; int ldc; const float* rt; float scale; const float* ssq; float eps;
    __device__ __forceinline__ void operator()(const f32x4 (&acc)[2][2][4][2], const Unit& u, int wr, int wc, int fr, int fq) const {
        const int row0 = u.pm * BM + wr * 64 + fr, col0 = u.pn * BM + wc * 32 + 8 * fq;
#pragma unroll
        for (int ai = 0; ai < 2; ++ai)
#pragma unroll
            for (int m = 0; m < 4; ++m) { const int row = row0 + ai * HALF + m * 16;
                const f32x4 sq = *(const f32x4*)(ssq + (size_t)row * 4); const float rs = scale / sqrtf(((sq[0] + sq[1]) + (sq[2] + sq[3])) * (1.0f / 256.0f) + eps);
#pragma unroll
                for (int bj = 0; bj < 2; ++bj) { const int c = col0 + bj * HALF, d = c % 96;
                    f32x4 v0 = acc[ai][bj][m][0], v1 = acc[ai][bj][m][1];
                    if (d >= 64) { const f32x4* t = (const f32x4*)(rt + (size_t)row * 32 + (d - 64)); const f32x4 t0 = t[0], t1 = t[1];
                        f32x4 w0, w1;
                        w0[0] = v0[0] * t0[0] - v0[1] * t0[1]; w0[1] = v0[1] * t0[0] + v0[0] * t0[1];
                        w0[2] = v0[2] * t0[2] - v0[3] * t0[3]; w0[3] = v0[3] * t0[2] + v0[2] * t0[3];
                        w1[0] = v1[0] * t1[0] - v1[1] * t1[1]; w1[1] = v1[1] * t1[0] + v1[0] * t1[1];
                        w1[2] = v1[2] * t1[2] - v1[3] * t1[3]; w1[3] = v1[3] * t1[2] + v1[2] * t1[3];
                        v0 = w0; v1 = w1; }
                    v0 = v0 * rs; v1 = v1 * rs; u32x4 w; w.x = cvt_pk_bf16(v0[0], v0[1]); w.y = cvt_pk_bf16(v0[2], v0[3]); w.z = cvt_pk_bf16(v1[0], v1[1]); w.w = cvt_pk_bf16(v1[2], v1[3]);
                    *(u32x4*)(O + (size_t)row * ldc + c) = w; }
                asm volatile("" ::: "memory"); }
    }
};

struct EpiKv {
    static constexpr bool PERM = true, AFTER_DRAIN = false;
    bf16_t* O; int ldc; const float* ssq; float eps;
    __device__ __forceinline__ void operator()(const f32x4 (&acc)[2][2][4][2], const Unit& u, int wr, int wc, int fr, int fq) const {
        const int row0 = u.pm * BM + wr * 64 + fr, col0 = u.pn * BM + wc * 32 + 8 * fq;
#pragma unroll
        for (int ai = 0; ai < 2; ++ai)
#pragma unroll
            for (int m = 0; m < 4; ++m) { const int row = row0 + ai * HALF + m * 16;
                const f32x4 sq = *(const f32x4*)(ssq + (size_t)row * 4); const float rs = 1.0f / sqrtf(((sq[0] + sq[1]) + (sq[2] + sq[3])) * (1.0f / 128.0f) + eps);
#pragma unroll
                for (int bj = 0; bj < 2; ++bj) { const f32x4 v0 = acc[ai][bj][m][0] * rs, v1 = acc[ai][bj][m][1] * rs;
                    u32x4 w; w.x = cvt_pk_bf16(v0[0], v0[1]); w.y = cvt_pk_bf16(v0[2], v0[3]); w.z = cvt_pk_bf16(v1[0], v1[1]); w.w = cvt_pk_bf16(v1[2], v1[3]);
                    *(u32x4*)(O + (size_t)row * ldc + col0 + bj * HALF) = w; }
                asm volatile("" ::: "memory"); }
    }
};
struct EpiIn {
    static constexpr bool PERM = true, AFTER_DRAIN = false;
    bf16_t* O; int ldc; float scale0; float* ssq; float* sskv; const float* rt; const float* bf; float* lf; int nrows;
    __device__ __forceinline__ void operator()(const f32x4 (&acc)[2][2][4][2], const Unit& u, int wr, int wc, int fr, int fq) const {
        const int row0 = u.pm * BM + wr * 64 + fr, col0 = u.pn * BM + wc * 32 + 8 * fq; const int pn = u.pn;
        const float sc = pn < 2 ? scale0 : 1.f;
#pragma unroll
        for (int ai = 0; ai < 2; ++ai)
#pragma unroll
            for (int m = 0; m < 4; ++m) { const int row = row0 + ai * HALF + m * 16; bf16_t* rowp = O + (size_t)row * ldc + col0; float s0 = 0.f, s1 = 0.f;
#pragma unroll
                for (int bj = 0; bj < 2; ++bj) { f32x4 v0 = acc[ai][bj][m][0] * sc, v1 = acc[ai][bj][m][1] * sc;
                    const float sq = ((v0[0] * v0[0] + v0[1] * v0[1]) + (v0[2] * v0[2] + v0[3] * v0[3])) + ((v1[0] * v1[0] + v1[1] * v1[1]) + (v1[2] * v1[2] + v1[3] * v1[3]));
                    if (bj == 0) s0 = sq; else s1 = sq;
                    bool store = true;
                    if (pn == 7 && bj == 1) { store = (wc == 0);
                        if (wc == 0) { const f32x4* t = (const f32x4*)(rt + (size_t)row * 32 + 8 * fq); const f32x4 t0 = t[0], t1 = t[1]; f32x4 w0, w1;
                            w0[0] = v0[0] * t0[0] - v0[1] * t0[1]; w0[1] = v0[1] * t0[0] + v0[0] * t0[1];
                            w0[2] = v0[2] * t0[2] - v0[3] * t0[3]; w0[3] = v0[3] * t0[2] + v0[2] * t0[3];
                            w1[0] = v1[0] * t1[0] - v1[1] * t1[1]; w1[1] = v1[1] * t1[0] + v1[0] * t1[1];
                            w1[2] = v1[2] * t1[2] - v1[3] * t1[3]; w1[3] = v1[3] * t1[2] + v1[2] * t1[3];
                            v0 = w0; v1 = w1; }
                        else if (wc == 1 && fq == 0) {
#pragma unroll
                            for (int e = 0; e < 8; ++e) { const float z = (e < 4 ? v0[e & 3] : v1[e & 3]) + bf[e]; lf[(size_t)e * nrows + row] = fminf(z, 0.f) - log1pf(expf(-fabsf(z))); } } }
                    if (store) { u32x4 w; w.x = cvt_pk_bf16(v0[0], v0[1]); w.y = cvt_pk_bf16(v0[2], v0[3]); w.z = cvt_pk_bf16(v1[0], v1[1]); w.w = cvt_pk_bf16(v1[2], v1[3]);
                        *(u32x4*)(rowp + bj * HALF) = w; } }
                if (pn == 6) { float s = s0 + s1; s += __shfl_xor(s, 16); s += __shfl_xor(s, 32); if (fq == 0) ssq[(size_t)row * 4 + wc] = s; }
                if (pn == 7) { float s = s0; s += __shfl_xor(s, 16); s += __shfl_xor(s, 32); if (fq == 0) sskv[(size_t)row * 4 + wc] = s; }
                asm volatile("" ::: "memory"); }
    }
};
struct EpiRes {
    static constexpr bool PERM = false, AFTER_DRAIN = false;
    const float* base; float* out; int ldc; bf16_t* ob; float* ss;
    __device__ __forceinline__ void operator()(const f32x4 (&acc)[2][2][4][2], const Unit& u, int wr, int wc, int fr, int fq) const {
        typedef unsigned u32x2v __attribute__((ext_vector_type(2)));
        const int row0 = u.pm * BM + wr * 64 + fr, col0 = u.pn * BM + wc * 32 + 4 * fq;
#pragma unroll
        for (int ai = 0; ai < 2; ++ai)
#pragma unroll
            for (int m = 0; m < 4; ++m) { const int row = row0 + ai * HALF + m * 16; const size_t off = (size_t)row * ldc + col0; float s = 0.f;
#pragma unroll
                for (int bj = 0; bj < 2; ++bj)
#pragma unroll
                    for (int n = 0; n < 2; ++n) { const f32x4 v = *(const f32x4*)(base + off + bj * HALF + n * 16) + acc[ai][bj][m][n];
                        *(f32x4*)(out + off + bj * HALF + n * 16) = v; s += (v[0] * v[0] + v[1] * v[1]) + (v[2] * v[2] + v[3] * v[3]);
                        if (ob) { u32x2v w; w.x = cvt_pk_bf16(v[0], v[1]); w.y = cvt_pk_bf16(v[2], v[3]); *(u32x2v*)(ob + off + bj * HALF + n * 16) = w; } }
                if (ss) { s += __shfl_xor(s, 16); s += __shfl_xor(s, 32); if (fq == 0) ss[(size_t)row * 16 + u.pn * 4 + wc] = s; }
                asm volatile("" ::: "memory");
            }
    }
};

struct EpiResNorm {
    static constexpr bool PERM = false, AFTER_DRAIN = true;
    const float* base; float* out; int ldc; const float* g; float* xs; unsigned* cnt; float eps; float inv_n;
    __device__ __forceinline__ void fused(f32x4 (&acc)[2][2][4][2], const Unit& u, int wr, int wc, int fr, int fq, PG8_LAS unsigned char* lds, int wid, int lane) const {
        PG8_LAS float* Pm = (PG8_LAS float*)lds;
        PG8_LAS float* S = (PG8_LAS float*)(lds + 4096);
        const int row0 = u.pm * BM + wr * 64 + fr, col0 = u.pn * BM + wc * 32 + 4 * fq;
#pragma unroll
        for (int ai = 0; ai < 2; ++ai)
#pragma unroll
            for (int m = 0; m < 4; ++m) { const size_t off = (size_t)(row0 + ai * HALF + m * 16) * ldc + col0; float s = 0.f;
#pragma unroll
                for (int bj = 0; bj < 2; ++bj)
#pragma unroll
                    for (int n = 0; n < 2; ++n) { const f32x4 v = *(const f32x4*)(base + off + bj * HALF + n * 16) + acc[ai][bj][m][n]; acc[ai][bj][m][n] = v;
                        s += (v[0] * v[0] + v[1] * v[1]) + (v[2] * v[2] + v[3] * v[3]); }
                s += __shfl_xor(s, 16); s += __shfl_xor(s, 32);
                if (fq == 0) Pm[(ai * HALF + wr * 64 + m * 16 + fr) * 4 + wc] = s;
                if (m & 1) asm volatile("" ::: "memory"); }
        asm volatile("s_waitcnt lgkmcnt(0)" ::: "memory"); __builtin_amdgcn_s_barrier(); asm volatile("" ::: "memory");
        const int tid = wid * 64 + lane;
        if (tid < 256) { const f32x4 p4 = *(const PG8_LAS f32x4*)(Pm + tid * 4);
            __hip_atomic_store(xs + (size_t)(u.pm * BM + tid) * 4 + u.pn, (p4[0] + p4[1]) + (p4[2] + p4[3]), __ATOMIC_RELAXED, __HIP_MEMORY_SCOPE_AGENT);
            asm volatile("s_waitcnt vmcnt(0)" ::: "memory");
            if (lane == 0) __hip_atomic_fetch_add(cnt + 64 * u.pm, 1u, __ATOMIC_RELAXED, __HIP_MEMORY_SCOPE_AGENT); }
        if (wid == 0) { unsigned sp = 0;
            while ((unsigned)__builtin_amdgcn_readfirstlane(__hip_atomic_load(cnt + 64 * u.pm, __ATOMIC_RELAXED, __HIP_MEMORY_SCOPE_AGENT)) < 16u) { __builtin_amdgcn_s_sleep(2); if (++sp > (1u << 22)) break; }
            __builtin_amdgcn_fence(__ATOMIC_ACQUIRE, "agent"); }
        asm volatile("s_waitcnt vmcnt(0) lgkmcnt(0)" ::: "memory"); __builtin_amdgcn_s_barrier(); asm volatile("" ::: "memory");
        if (tid < 256) { const float* xp = xs + (size_t)(u.pm * BM + tid) * 4;
            const float t0 = __hip_atomic_load(xp + 0, __ATOMIC_RELAXED, __HIP_MEMORY_SCOPE_AGENT), t1 = __hip_atomic_load(xp + 1, __ATOMIC_RELAXED, __HIP_MEMORY_SCOPE_AGENT);
            const float t2 = __hip_atomic_load(xp + 2, __ATOMIC_RELAXED, __HIP_MEMORY_SCOPE_AGENT), t3 = __hip_atomic_load(xp + 3, __ATOMIC_RELAXED, __HIP_MEMORY_SCOPE_AGENT);
            S[tid] = 1.0f / sqrtf(((t0 + t1) + (t2 + t3)) * inv_n + eps); }
        asm volatile("s_waitcnt vmcnt(0) lgkmcnt(0)" ::: "memory"); __builtin_amdgcn_s_barrier(); asm volatile("" ::: "memory");
        f32x4 gv[2][2];
#pragma unroll
        for (int bj = 0; bj < 2; ++bj)
#pragma unroll
            for (int n = 0; n < 2; ++n) gv[bj][n] = *(const f32x4*)(g + col0 + bj * HALF + n * 16);
#pragma unroll
        for (int ai = 0; ai < 2; ++ai)
#pragma unroll
            for (int m = 0; m < 4; ++m) { const int r = ai * HALF + wr * 64 + m * 16 + fr; const float rs = S[r]; const size_t off = (size_t)(u.pm * BM + r) * ldc + col0;
#pragma unroll
                for (int bj = 0; bj < 2; ++bj)
#pragma unroll
                    for (int n = 0; n < 2; ++n) *(f32x4*)(out + off + bj * HALF + n * 16) = acc[ai][bj][m][n] * rs * gv[bj][n]; }
    }
};
struct EpiSqRelu {
    static constexpr bool PERM = true, AFTER_DRAIN = false;
    bf16_t* O; int ldc; const float* ss; float eps; float inv_n;
    __device__ __forceinline__ void operator()(const f32x4 (&acc)[2][2][4][2], const Unit& u, int wr, int wc, int fr, int fq) const {
        const int row0 = u.pm * BM + wr * 64 + fr, col0 = u.pn * BM + wc * 32 + 8 * fq;
#pragma unroll
        for (int ai = 0; ai < 2; ++ai)
#pragma unroll
            for (int m = 0; m < 4; ++m) { const int row = row0 + ai * HALF + m * 16;
                const f32x4* sp = (const f32x4*)(ss + (size_t)row * 16); const f32x4 a = sp[0], b = sp[1], c = sp[2], d = sp[3];
                const float tot = ((a[0] + a[1]) + (a[2] + a[3])) + ((b[0] + b[1]) + (b[2] + b[3])) + ((c[0] + c[1]) + (c[2] + c[3])) + ((d[0] + d[1]) + (d[2] + d[3]));
                const float rstd = 1.0f / sqrtf(tot * inv_n + eps);
#pragma unroll
                for (int bj = 0; bj < 2; ++bj) { f32x4 v0 = acc[ai][bj][m][0] * rstd, v1 = acc[ai][bj][m][1] * rstd;
#pragma unroll
                    for (int e = 0; e < 4; ++e) { const float x0 = fmaxf(v0[e], 0.f), x1 = fmaxf(v1[e], 0.f); v0[e] = x0 * x0; v1[e] = x1 * x1; }
                    u32x4 w; w.x = cvt_pk_bf16(v0[0], v0[1]); w.y = cvt_pk_bf16(v0[2], v0[3]); w.z = cvt_pk_bf16(v1[0], v1[1]); w.w = cvt_pk_bf16(v1[2], v1[3]);
                    *(u32x4*)(O + (size_t)row * ldc + col0 + bj * HALF) = w; }
                asm volatile("" ::: "memory"); }
    }
};


template <class Epi, class Sched, bool ALIGN_EPI = false, bool SP2 = false>
__device__ __forceinline__ void gemm_phase(PG8_LAS unsigned char* lds, const Gemm g, const Sched& S, const Epi& E) {
    const int tid = threadIdx.x, wid = __builtin_amdgcn_readfirstlane(tid >> 6), lane = tid & 63, wr = wid >> 2, wc = wid & 3, fr = lane & 15, fq = lane >> 4;
    const int K = g.K, nt = K / BK, lda = g.lda ? g.lda : g.K;
    unsigned voffA[2], voffB[2];
#pragma unroll
    for (int i = 0; i < 2; ++i) { int R, C; stage_rc(tid * 16 + i * 8192, R, C); const int Rb = Epi::PERM ? ((R & ~31) + perm32(R & 31)) : R;
        voffA[i] = (unsigned)(R * lda + C) * 2u; voffB[i] = (unsigned)(Rb * K + C) * 2u; }
    const size_t kstep = (size_t)(BK * 2);
    const size_t hstep = (size_t)HALF * K * 2;
    const size_t tstep = 2 * hstep;
    const size_t hstepA = (size_t)HALF * lda * 2, tstepA = 2 * hstepA;
    const unsigned ldsw = (unsigned)wid * 1024u;
    const int aoff = lds_byte(wr * 64 + fr, fq * 8), boff = lds_byte(wc * 32 + fr, fq * 8);
#define PG8_SA(b, h) (((b) * 2 + (h)) * HTB)
#define PG8_SB(b, h) ((4 + (b) * 2 + (h)) * HTB)
#define PG8_STAGE(bufoff, gbase, voff) do { _Pragma("unroll") for (int _i = 0; _i < 2; ++_i) \
        __builtin_amdgcn_global_load_lds((const unsigned*)((const char*)(gbase) + (voff)[_i]), (PG8_LAS unsigned*)(lds + (bufoff) + ldsw + _i * 8192), 16, 0, 0); } while (0)
#define PG8_LDA(dst, b, h) do { _Pragma("unroll") for (int m = 0; m < 4; ++m) _Pragma("unroll") for (int k = 0; k < 2; ++k) dst[m][k] = *(const PG8_LAS bf16x8*)(lds + PG8_SA(b, h) + aoff + m * 2048 + k * 1024); } while (0)
#define PG8_LDB(dst, b, h) do { _Pragma("unroll") for (int n = 0; n < 2; ++n) _Pragma("unroll") for (int k = 0; k < 2; ++k) dst[n][k] = *(const PG8_LAS bf16x8*)(lds + PG8_SB(b, h) + boff + n * 2048 + k * 1024); } while (0)
#define PG8_MMA(ai, bj, At, Bt) do { __builtin_amdgcn_s_setprio(1); _Pragma("unroll") for (int m = 0; m < 4; ++m) _Pragma("unroll") for (int n = 0; n < 2; ++n) _Pragma("unroll") for (int k = 0; k < 2; ++k) \
        acc[ai][bj][m][n] = __builtin_amdgcn_mfma_f32_16x16x32_bf16(Bt[n][k], At[m][k], acc[ai][bj][m][n], 0, 0, 0); __builtin_amdgcn_s_setprio(0); } while (0)
#define PG8_WAIT_V(n) asm volatile("s_waitcnt vmcnt(" #n ")" ::: "memory")
#define PG8_WAIT_L(n) asm volatile("s_waitcnt lgkmcnt(" #n ")" ::: "memory")
#define PG8_BAR __builtin_amdgcn_s_barrier()
#define PG8_SCHED __builtin_amdgcn_sched_barrier(0)
    Unit cur, nxt; int ui = 0;
    if (!S.next(0, cur)) return;
    f32x4 acc[2][2][4][2];
#pragma unroll
    for (int a = 0; a < 2; ++a)
#pragma unroll
        for (int b = 0; b < 2; ++b)
#pragma unroll
            for (int m = 0; m < 4; ++m)
#pragma unroll
                for (int n = 0; n < 2; ++n) acc[a][b][m][n] = (f32x4){0.f, 0.f, 0.f, 0.f};
    bf16x8 At[4][2], B0[2][2], B1[2][2];
    const char* cA = (const char*)g.A + (size_t)cur.pm * tstepA; const char* cB = (const char*)g.Bt + (size_t)cur.pn * tstep;
    S.a_ready(cur);
    if constexpr (SP2) {
        PG8_STAGE(PG8_SB(0, 0), cB, voffB); PG8_STAGE(PG8_SB(0, 1), cB + hstep, voffB); PG8_STAGE(PG8_SA(0, 0), cA, voffA); PG8_STAGE(PG8_SA(0, 1), cA + hstepA, voffA);
        if (wr == 1) PG8_BAR;
        PG8_WAIT_V(2); PG8_BAR;
        PG8_STAGE(PG8_SB(1, 0), cB + kstep, voffB); PG8_STAGE(PG8_SA(1, 0), cA + kstep, voffA); PG8_STAGE(PG8_SB(1, 1), cB + hstep + kstep, voffB);
        PG8_WAIT_V(6); PG8_BAR;
    } else {
        PG8_STAGE(PG8_SB(0, 0), cB, voffB); PG8_STAGE(PG8_SA(0, 0), cA, voffA); PG8_STAGE(PG8_SB(0, 1), cB + hstep, voffB); PG8_STAGE(PG8_SA(0, 1), cA + hstepA, voffA);
        if (wr == 1) PG8_BAR;
        PG8_WAIT_V(4); PG8_BAR;
        PG8_STAGE(PG8_SB(1, 0), cB + kstep, voffB); PG8_STAGE(PG8_SA(1, 0), cA + kstep, voffA); PG8_STAGE(PG8_SB(1, 1), cB + hstep + kstep, voffB);
        PG8_WAIT_V(6); PG8_BAR;
    }
    for (;;) {
        const bool has_next = S.next(ui + 1, nxt);
        const char* nA = has_next ? (const char*)g.A + (size_t)nxt.pm * tstepA : cA; const char* nB = has_next ? (const char*)g.Bt + (size_t)nxt.pn * tstep : cB;
        for (int t = 0; t < nt; t += 2) {
            const bool last = (t == nt - 2);
            const char* a1 = cA + (size_t)(t + 1) * kstep;
            const char* a2 = last ? nA : cA + (size_t)(t + 2) * kstep; const char* b2 = last ? nB : cB + (size_t)(t + 2) * kstep;
            const char* a3 = a2 + kstep; const char* b3 = b2 + kstep;
            if (last && has_next) S.a_ready(nxt);
            if constexpr (SP2) {
            PG8_LDB(B0, 0, 0); PG8_LDB(B1, 0, 1); PG8_SCHED; PG8_LDA(At, 0, 0); PG8_STAGE(PG8_SA(1, 1), a1 + hstepA, voffA);
            PG8_WAIT_V(8); PG8_WAIT_L(0); PG8_BAR; PG8_MMA(0, 0, At, B0); PG8_MMA(0, 1, At, B1); PG8_BAR; PG8_SCHED;
            PG8_LDA(At, 0, 1); PG8_STAGE(PG8_SB(0, 0), b2, voffB); PG8_STAGE(PG8_SB(0, 1), b2 + hstep, voffB); PG8_STAGE(PG8_SA(0, 0), a2, voffA);
            PG8_WAIT_V(8); PG8_WAIT_L(0); PG8_BAR; PG8_MMA(1, 0, At, B0); PG8_MMA(1, 1, At, B1); PG8_BAR; PG8_SCHED;
            PG8_LDB(B0, 1, 0); PG8_LDB(B1, 1, 1); PG8_SCHED; PG8_LDA(At, 1, 0); PG8_STAGE(PG8_SA(0, 1), a2 + hstepA, voffA);
            PG8_WAIT_V(8); PG8_WAIT_L(0); PG8_BAR; PG8_MMA(0, 0, At, B0); PG8_MMA(0, 1, At, B1); PG8_BAR; PG8_SCHED;
            PG8_LDA(At, 1, 1); PG8_STAGE(PG8_SB(1, 0), b3, voffB); PG8_STAGE(PG8_SB(1, 1), b3 + hstep, voffB); PG8_STAGE(PG8_SA(1, 0), a3, voffA);
            PG8_WAIT_V(8); PG8_WAIT_L(0); PG8_BAR; PG8_MMA(1, 0, At, B0); PG8_MMA(1, 1, At, B1); PG8_BAR; PG8_SCHED;
            } else {
            PG8_LDB(B0, 0, 0); PG8_SCHED; PG8_LDA(At, 0, 0); PG8_STAGE(PG8_SA(1, 1), a1 + hstepA, voffA);
            PG8_WAIT_L(8); PG8_BAR; PG8_WAIT_L(0); PG8_MMA(0, 0, At, B0); PG8_BAR; PG8_SCHED;
            PG8_LDB(B1, 0, 1); PG8_STAGE(PG8_SB(0, 0), b2, voffB);
            PG8_BAR; PG8_WAIT_L(0); PG8_MMA(0, 1, At, B1); PG8_BAR;
            PG8_LDA(At, 0, 1); PG8_STAGE(PG8_SA(0, 0), a2, voffA);
            PG8_BAR; PG8_WAIT_L(0); PG8_MMA(1, 0, At, B0); PG8_BAR; PG8_SCHED;
            PG8_STAGE(PG8_SB(0, 1), b2 + hstep, voffB);
            PG8_WAIT_V(6); PG8_BAR; PG8_MMA(1, 1, At, B1); PG8_BAR;
            PG8_LDB(B0, 1, 0); PG8_SCHED; PG8_LDA(At, 1, 0); PG8_STAGE(PG8_SA(0, 1), a2 + hstepA, voffA);
            PG8_WAIT_L(8); PG8_BAR; PG8_WAIT_L(0); PG8_MMA(0, 0, At, B0); PG8_BAR; PG8_SCHED;
            PG8_LDB(B1, 1, 1); PG8_STAGE(PG8_SB(1, 0), b3, voffB);
            PG8_BAR; PG8_WAIT_L(0); PG8_MMA(0, 1, At, B1); PG8_BAR;
            PG8_LDA(At, 1, 1); PG8_STAGE(PG8_SA(1, 0), a3, voffA);
            PG8_BAR; PG8_WAIT_L(0); PG8_MMA(1, 0, At, B0); PG8_BAR; PG8_SCHED;
            PG8_STAGE(PG8_SB(1, 1), b3 + hstep, voffB);
            PG8_WAIT_V(6); PG8_BAR; PG8_MMA(1, 1, At, B1); PG8_BAR;
            }
        }
        if constexpr (ALIGN_EPI) { if (wr == 0) PG8_BAR; }
        if constexpr (!Epi::AFTER_DRAIN) { E(acc, cur, wr, wc, fr, fq); S.done(cur); }
        if (!has_next) break;
#pragma unroll
        for (int a = 0; a < 2; ++a)
#pragma unroll
            for (int b = 0; b < 2; ++b)
#pragma unroll
                for (int m = 0; m < 4; ++m)
#pragma unroll
                    for (int n = 0; n < 2; ++n) acc[a][b][m][n] = (f32x4){0.f, 0.f, 0.f, 0.f};
        cur = nxt; cA = nA; cB = nB; ++ui;
        if constexpr (ALIGN_EPI) { if (wr == 1) PG8_BAR; }
    }
    PG8_WAIT_V(0);
    if constexpr (!ALIGN_EPI) { if (wr == 0) PG8_BAR; }
    PG8_BAR;
    if constexpr (Epi::AFTER_DRAIN) { E.fused(acc, cur, wr, wc, fr, fq, lds, wid, lane); S.done(cur); }
#undef PG8_SA
#undef PG8_SB
#undef PG8_STAGE
#undef PG8_LDA
#undef PG8_LDB
#undef PG8_MMA
#undef PG8_WAIT_V
#undef PG8_WAIT_L
#undef PG8_BAR
#undef PG8_SCHED
}
}

#ifndef PG8_SP2
#define PG8_SP2 true
#endif
#ifndef PG8_ALIGN
#define PG8_ALIGN true
#endif
namespace att {
#define LAS3 __attribute__((address_space(3)))
using bf16x8 = __attribute__((ext_vector_type(8))) short;
using s16x4 = __attribute__((ext_vector_type(4))) short;
using f32x16 = __attribute__((ext_vector_type(16))) float;
using f32x4 = __attribute__((ext_vector_type(4))) float;
using u32x4 = __attribute__((ext_vector_type(4))) unsigned;
typedef unsigned short u16;
typedef LAS3 const unsigned char* lds_cptr;
typedef short v4i16_t __attribute__((ext_vector_type(4)));
constexpr int SEQ = 16384, NW = 8, QBLK = 32, QB = 256, KVBLK = 64;
constexpr int KSLOT = 12288, VSLOT = 8192, NKS = 4, NVS = 4;
constexpr int LDS_K = 0, LDS_V = NKS * KSLOT, LDS_WS = LDS_V + NVS * VSLOT, LDS_OST = LDS_WS + NW * 256, LDS_QX = LDS_OST + NW * 4096, LDS_BYTES = LDS_QX + NW * 2048;
__device__ __forceinline__ int crow(int r, int hi) { return (r & 3) + 8 * (r >> 2) + 4 * hi; }
__device__ __forceinline__ void glds16(const void* gsrc, unsigned lds_dst) { unsigned keep;
    asm volatile("s_mov_b32 %0, m0\n\ts_mov_b32 m0, %2\n\ts_nop 0\n\tglobal_load_lds_dwordx4 %1, off\n\ts_mov_b32 m0, %0" : "=&s"(keep) : "v"(gsrc), "s"(lds_dst) : "memory"); }
typedef float f32x2_t __attribute__((ext_vector_type(2))); typedef __bf16 bf16x2_t __attribute__((ext_vector_type(2)));
__device__ __forceinline__ unsigned cvtpk_s(float lo, float hi) { f32x2_t v = {lo, hi}; bf16x2_t b = __builtin_convertvector(v, bf16x2_t); return __builtin_bit_cast(unsigned, b); }
__device__ __forceinline__ s16x4 vtr(lds_cptr p) { return __builtin_bit_cast(s16x4, __builtin_amdgcn_ds_read_tr16_b64_v4i16((LAS3 v4i16_t*)p)); }
#define ATT_SBAR() __builtin_amdgcn_sched_barrier(0)
#define ATT_WAIT_BAR(N) asm volatile("s_waitcnt vmcnt(" #N ") lgkmcnt(0)\n\ts_barrier" ::: "memory")
struct Src {
    const u16* q; int qp;
    const u16* k; int kp;
    const u16* k2; int k2p;
    const u16* v; int vp;
    u16* o; int op;
};
template <int NDK, int NQR, bool ZC, int XHS>
__device__ __forceinline__ void phase_a(f32x16& C0, f32x16& C1, const lds_cptr* kb_, int ksl_, const bf16x8* qr, lds_cptr qx_, const f32x16& negm) {
    bf16x8 kf[2 * NDK]; bf16x8 qx[NDK > NQR ? NDK - NQR : 1];
    constexpr int KPF = 4;
#define ATT_KRD(j) kf[j] = *(const LAS3 bf16x8*)(kb_[(j) >> 1] + ksl_ + ((j) & 1) * (((j) >> 1) < 4 ? 4096 : XHS))
    ATT_KRD(0); ATT_KRD(1); ATT_KRD(2); ATT_KRD(3);
#pragma unroll
    for (int j = 0; j < 2 * NDK; ++j) {
        if (j + KPF < 2 * NDK) ATT_KRD(j + KPF);
        if (NDK > NQR && (j & 1) == 0 && (j >> 1) + 2 >= NQR && (j >> 1) + 2 < NDK) qx[(j >> 1) + 2 - NQR] = *(const LAS3 bf16x8*)(qx_ + ((j >> 1) + 2 - NQR) * 1024);
        ATT_SBAR();
        const f32x16 z = f32x16{}; const bf16x8 qf = ((j >> 1) < NQR) ? qr[(j >> 1) < NQR ? (j >> 1) : 0] : qx[(j >> 1) >= NQR ? (j >> 1) - NQR : 0];
        if (j & 1) C1 = __builtin_amdgcn_mfma_f32_32x32x16_bf16(kf[j], qf, (j < 2) ? (ZC ? z : negm) : C1, 0, 0, 0);
        else       C0 = __builtin_amdgcn_mfma_f32_32x32x16_bf16(kf[j], qf, (j < 2) ? (ZC ? z : negm) : C0, 0, 0, 0);
        ATT_SBAR();
    }
#undef ATT_KRD
}
template <bool QK, bool FIN>
__device__ __forceinline__ void phase_b(f32x16& C0, f32x16& C1, f32x16* o, lds_cptr vp_, u32x4* pw, float& l_reg) {
    s16x4 vlo[8], vhi[8]; f32x2_t sacc = {0.f, 0.f};
#define ATT_VRD(i) do { const int vi_ = ((i) >> 1) + 4 * ((i) & 1); vlo[i] = vtr(vp_ + ((vi_ >> 2) * 4096 + (vi_ & 3) * 1024)); vhi[i] = vtr(vp_ + ((vi_ >> 2) * 4096 + (vi_ & 3) * 1024 + 512)); } while (0)
    if (FIN) { ATT_VRD(0); ATT_VRD(1); }
#pragma unroll
    for (int i = 0; i < 8; ++i) {
        if (FIN && i + 2 < 8) ATT_VRD(i + 2);
        ATT_SBAR();
        if (FIN) { const bf16x8 vf = (bf16x8){vlo[i][0], vlo[i][1], vlo[i][2], vlo[i][3], vhi[i][0], vhi[i][1], vhi[i][2], vhi[i][3]};
            o[i & 1] = __builtin_amdgcn_mfma_f32_32x32x16_bf16(__builtin_bit_cast(bf16x8, pw[i >> 1]), vf, o[i & 1], 0, 0, 0); }
        if (QK) { f32x16& X = (i < 4) ? C0 : C1; const int b = 4 * (i & 3);
            X[b] = __builtin_amdgcn_exp2f(X[b]); X[b + 1] = __builtin_amdgcn_exp2f(X[b + 1]); X[b + 2] = __builtin_amdgcn_exp2f(X[b + 2]); X[b + 3] = __builtin_amdgcn_exp2f(X[b + 3]);
            sacc += (f32x2_t){X[b], X[b + 1]}; sacc += (f32x2_t){X[b + 2], X[b + 3]}; asm volatile("" : "+v"(sacc));
            if (i & 1) { const int k = i >> 1, c = 8 * (k & 1);
                pw[k] = (u32x4){cvtpk_s(X[c], X[c + 1]), cvtpk_s(X[c + 2], X[c + 3]), cvtpk_s(X[c + 4], X[c + 5]), cvtpk_s(X[c + 6], X[c + 7])}; asm volatile("" : "+v"(pw[k])); } }
        ATT_SBAR();
    }
#undef ATT_VRD
    if (QK) l_reg += sacc[0] + sacc[1];
}
template <bool MLA> __device__ __forceinline__ void attn_unit(int qb, const Src& s, LAS3 unsigned char* shm, const float* bias_h, float kmax2) {
    constexpr int NDK = MLA ? 6 : 5, NX = MLA ? 4 : 1, NQR = MLA ? 4 : 5;
    constexpr float THRL = MLA ? 8.0f : 16.0f;
    const int tid = threadIdx.x, lane = tid & 63, r32 = lane & 31, hi = lane >> 5; const int wid = __builtin_amdgcn_readfirstlane(tid >> 6);
    const int q0 = qb * QB;
    const unsigned lds0 = (unsigned)(uintptr_t)shm;
    LAS3 float* wsf = (LAS3 float*)(shm + LDS_WS) + wid * 64;
    const int NT = (q0 + QB) / KVBLK;
    const int wvis = NT - 4 + (wid >> 1);
    const bool xw = wid < NX;
    const int krow = 8 * wid + (lane >> 3);
    const u16* ksrc = s.k + (size_t)krow * s.kp + (((lane & 7) ^ ((krow >> 1) & 7)) * 8);
    const int k2row = 16 * (wid & 3) + (lane >> 2);
    const u16* k2src = MLA ? s.k2 + (size_t)k2row * s.k2p + (((lane & 3) ^ ((k2row >> 2) & 3)) * 8) : s.k2 + (size_t)lane * s.k2p;
    const u16* vsrc = s.v + (size_t)(16 * (wid & 3) + (lane >> 2)) * s.vp + (wid >> 2) * 32 + (lane & 3) * 8;
    const unsigned kdst = lds0 + LDS_K + wid * 1024, k2dst = lds0 + LDS_K + (8 + (wid & 3)) * 1024, vdst = lds0 + LDS_V + wid * 1024;
#define ATT_DMA_K(t) do { const int sl_ = (t) & 3; glds16(ksrc + (size_t)(t) * KVBLK * s.kp, (unsigned)__builtin_amdgcn_readfirstlane(kdst + sl_ * KSLOT)); \
        if (xw) glds16(k2src + (size_t)(t) * KVBLK * s.k2p, (unsigned)__builtin_amdgcn_readfirstlane(k2dst + sl_ * KSLOT)); } while (0)
#define ATT_DMA_V(t, vsl) glds16(vsrc + (size_t)(t) * KVBLK * s.vp, (unsigned)__builtin_amdgcn_readfirstlane(vdst + (vsl)))
    if (!MLA) {
        if (tid < 256) { const int sl = tid >> 6; *(LAS3 f32x4*)(shm + LDS_K + sl * KSLOT + 9 * 1024 + (tid & 63) * 16) = (f32x4){0.f, 0.f, 0.f, 0.f}; } }
    const u16* Qw = s.q + (size_t)(q0 + wid * QBLK + r32) * s.qp + hi * 8;
    bf16x8 qr[NQR];
#pragma unroll
    for (int d0 = 0; d0 < 4; ++d0) qr[d0] = *reinterpret_cast<const bf16x8*>(Qw + d0 * 16);
    const lds_cptr qx0 = (lds_cptr)shm + LDS_QX + wid * 2048 + lane * 16;
    if (MLA) { const bf16x8 q4 = *reinterpret_cast<const bf16x8*>(Qw + 64), q5 = *reinterpret_cast<const bf16x8*>(Qw + 80);
        *(LAS3 bf16x8*)(shm + LDS_QX + wid * 2048 + lane * 16) = q4; *(LAS3 bf16x8*)(shm + LDS_QX + wid * 2048 + 1024 + lane * 16) = q5; }
    const short one = hi ? (short)0 : (short)0x3F80;
    if (!MLA) qr[NQR - 1] = (bf16x8){one, one, one, 0, 0, 0, 0, 0};
    int t0 = 0;
    if (!MLA) {
        float nq = 0.f;
#pragma unroll
        for (int d0 = 0; d0 < 4; ++d0)
#pragma unroll
            for (int e = 0; e < 8; ++e) { const float v = __uint_as_float((unsigned)(unsigned short)qr[d0][e] << 16); nq += v * v; }
        nq += __shfl_xor(nq, 32);
#pragma unroll
        for (int o_ = 16; o_ >= 1; o_ >>= 1) nq = fmaxf(nq, __shfl_xor(nq, o_));
        if (lane == 0) wsf[0] = nq;
        asm volatile("s_waitcnt lgkmcnt(0)\n\ts_barrier" ::: "memory");
        float qm = 0.f;
#pragma unroll
        for (int w = 0; w < NW; ++w) qm = fmaxf(qm, ((const LAS3 float*)(shm + LDS_WS))[w * 64]);
        const float thr = bias_h[q0] - 170.f - 2.f * sqrtf(qm * kmax2);
        int best = 0;
        for (int tt = 1 + lane; tt <= NT - 4; tt += 64) { if (bias_h[64 * tt - 1] < thr) best = tt; }
#pragma unroll
        for (int o_ = 32; o_ >= 1; o_ >>= 1) best = max(best, __shfl_xor(best, o_));
        t0 = __builtin_amdgcn_readfirstlane(best);
        asm volatile("s_waitcnt lgkmcnt(0)\n\ts_barrier" ::: "memory");
    }
    ATT_DMA_K(t0); ATT_DMA_V(t0, (t0 & 3) * VSLOT); ATT_DMA_K(t0 + 1); ATT_DMA_K(t0 + 2);
    float mhat = 0.f, l_reg = 0.f; f32x16 o[2]; o[0] = f32x16{}; o[1] = f32x16{}; f32x16 negm = f32x16{};
    const int qrel = wid * QBLK + r32;
    lds_cptr kb[NDK];
#pragma unroll
    for (int d0 = 0; d0 < 4; ++d0) kb[d0] = (lds_cptr)shm + LDS_K + r32 * 128 + ((((2 * d0 + hi) ^ ((r32 >> 1) & 7))) << 4);
    if (MLA) {
#pragma unroll
        for (int d0 = 4; d0 < NDK; ++d0) kb[d0] = (lds_cptr)shm + LDS_K + 8192 + r32 * 64 + ((((2 * (d0 - 4) + hi) ^ ((r32 >> 2) & 3))) << 4);
    } else kb[NDK - 1] = (lds_cptr)shm + LDS_K + 8192 + hi * 1024 + r32 * 16;
    constexpr int XHS = MLA ? 2048 : 512;
    const lds_cptr vp0 = (lds_cptr)shm + LDS_V + ((lane >> 4) & 1) * 32 + (lane & 3) * 8 + (4 * hi + ((lane & 15) >> 2)) * 64;
    f32x16 C0, C1; u32x4 pw[4]; bool resc = false;
#define ATT_TOP(t) do { if ((t) == t0 || (t) + 2 >= NT) { ATT_WAIT_BAR(0); } else if (xw) { ATT_WAIT_BAR(3); } else { ATT_WAIT_BAR(2); } \
        if ((t) + 3 < NT) ATT_DMA_K((t) + 3); if ((t) + 1 < NT) ATT_DMA_V((t) + 1, (((t) + 1) & 3) * VSLOT); } while (0)
#define ATT_MASK(C0, C1, t) do { const int kbq_ = 64 * ((t) - (NT - 4)) + 4 * hi; \
        _Pragma("unroll") for (int r = 0; r < 16; ++r) { const int kv_ = kbq_ + (r & 3) + 8 * (r >> 2); if (kv_ > qrel) C0[r] = -INFINITY; if (kv_ + 32 > qrel) C1[r] = -INFINITY; } } while (0)
#define ATT_DECIDE(C0, C1, FIRST) do { \
        float a_ = fmaxf(fmaxf(C0[0], C0[1]), C1[0]), b_ = fmaxf(fmaxf(C0[2], C0[3]), C1[1]); a_ = fmaxf(fmaxf(a_, C1[2]), C1[3]); \
        _Pragma("unroll") for (int r = 4; r < 16; r += 4) { a_ = fmaxf(fmaxf(a_, C0[r]), C0[r + 1]); b_ = fmaxf(fmaxf(b_, C0[r + 2]), C0[r + 3]); a_ = fmaxf(fmaxf(a_, C1[r]), C1[r + 1]); b_ = fmaxf(fmaxf(b_, C1[r + 2]), C1[r + 3]); } \
        float rm_ = fmaxf(a_, b_); { auto rr_ = __builtin_amdgcn_permlane32_swap(__float_as_uint(rm_), __float_as_uint(rm_), false, false); rm_ = fmaxf(__uint_as_float(rr_[0]), __uint_as_float(rr_[1])); } \
        resc = false; \
        if ((FIRST) || __any(rm_ > THRL)) { float dl_ = (FIRST) ? rm_ : fmaxf(rm_, 0.f); \
            if (!MLA) { const float nm_ = -(mhat + dl_); const unsigned h_ = cvtpk_s(nm_, 0.f) & 0xffffu; const float r1_ = nm_ - __uint_as_float(h_ << 16); const unsigned m_ = cvtpk_s(r1_, 0.f) & 0xffffu; \
                const float r2_ = r1_ - __uint_as_float(m_ << 16); const unsigned l_ = cvtpk_s(r2_, 0.f) & 0xffffu; \
                const float mn_ = -((__uint_as_float(h_ << 16) + __uint_as_float(m_ << 16)) + __uint_as_float(l_ << 16)); dl_ = mn_ - mhat; mhat = mn_; \
                if (hi == 0) qr[NQR - 1] = (bf16x8){one, one, one, (short)h_, (short)m_, (short)l_, 0, 0}; } \
            else { mhat += dl_; _Pragma("unroll") for (int r = 0; r < 16; ++r) negm[r] = -mhat; } \
            _Pragma("unroll") for (int r = 0; r < 16; ++r) { C0[r] -= dl_; C1[r] -= dl_; } \
            if (!(FIRST)) { const float f_ = __builtin_amdgcn_exp2f(-dl_); l_reg *= f_; if (hi == 0) wsf[r32] = f_; resc = true; } } } while (0)
#define ATT_RESC() do { if (resc) { \
        _Pragma("unroll") for (int i = 0; i < 4; ++i) { const f32x4 fv_ = *(const LAS3 f32x4*)(wsf + 8 * i + 4 * hi); \
            _Pragma("unroll") for (int d = 0; d < 2; ++d) { o[d][4 * i] *= fv_[0]; o[d][4 * i + 1] *= fv_[1]; o[d][4 * i + 2] *= fv_[2]; o[d][4 * i + 3] *= fv_[3]; } } } } while (0)
#define ATT_VS(tt) (vp0 + (((tt)) & 3) * VSLOT)
#define ATT_KS(tt) kb, ((((tt)) & 3) * KSLOT)
#ifndef ATT_STAGGER
#define ATT_STAGGER 0
#endif
    if (!ATT_STAGGER || wid < 4) {
#define ATT_STEP(t, MASKED) do { ATT_TOP(t); \
        phase_a<NDK, NQR, !MLA, XHS>(C0, C1, ATT_KS(t), qr, qx0, negm); \
        if (!MLA && (MASKED)) ATT_MASK(C0, C1, t); \
        ATT_DECIDE(C0, C1, false); ATT_SBAR(); \
        phase_b<true, true>(C0, C1, o, ATT_VS((t) - 1), pw, l_reg); \
        ATT_RESC(); } while (0)
        ATT_TOP(t0);
        phase_a<NDK, NQR, !MLA, XHS>(C0, C1, ATT_KS(t0), qr, qx0, negm);
        if (!MLA && wvis == t0) ATT_MASK(C0, C1, t0);
        ATT_DECIDE(C0, C1, true); ATT_SBAR();
        phase_b<true, false>(C0, C1, o, vp0, pw, l_reg);
        int t = t0 + 1;
        for (; t < wvis; ++t) ATT_STEP(t, false);
        if (t == wvis) { ATT_STEP(t, true); ++t; }
        { ATT_TOP(t); phase_b<false, true>(C0, C1, o, ATT_VS(t - 1), pw, l_reg); ++t; }
        for (; t <= NT + ATT_STAGGER; ++t) { ATT_TOP(t); }
#undef ATT_STEP
    } else {
        ATT_TOP(t0);
        phase_a<NDK, NQR, !MLA, XHS>(C0, C1, ATT_KS(t0), qr, qx0, negm);
        ATT_DECIDE(C0, C1, true); ATT_SBAR();
        ATT_TOP(t0 + 1);
        phase_b<true, false>(C0, C1, o, vp0, pw, l_reg); ATT_SBAR();
        phase_a<NDK, NQR, !MLA, XHS>(C0, C1, ATT_KS(t0 + 1), qr, qx0, negm);
        ATT_DECIDE(C0, C1, false); ATT_SBAR();
        int t = t0 + 2;
#define ATT_STEP2(t, MASKED) do { ATT_TOP(t); \
        phase_b<true, true>(C0, C1, o, ATT_VS((t) - 2), pw, l_reg); \
        ATT_RESC(); ATT_SBAR(); \
        phase_a<NDK, NQR, !MLA, XHS>(C0, C1, ATT_KS(t), qr, qx0, negm); \
        if (!MLA && (MASKED)) ATT_MASK(C0, C1, t); \
        ATT_DECIDE(C0, C1, false); ATT_SBAR(); } while (0)
        for (; t < wvis; ++t) ATT_STEP2(t, false);
        ATT_STEP2(t, true); ++t;
        { ATT_TOP(t); phase_b<true, true>(C0, C1, o, ATT_VS(t - 2), pw, l_reg); ATT_RESC(); ++t; }
        { ATT_TOP(t); phase_b<false, true>(C0, C1, o, ATT_VS(t - 2), pw, l_reg); ++t; }
        for (; t <= NT + ATT_STAGGER; ++t) { ATT_TOP(t); }
#undef ATT_STEP2
    }
    { auto rr = __builtin_amdgcn_permlane32_swap(__float_as_uint(l_reg), __float_as_uint(l_reg), false, false); l_reg = __uint_as_float(rr[0]) + __uint_as_float(rr[1]); }
    if (hi == 0) wsf[32 + r32] = 1.0f / l_reg;
    float rli[16];
#pragma unroll
    for (int i = 0; i < 4; ++i) { const f32x4 fv = *(const LAS3 f32x4*)(wsf + 32 + 8 * i + 4 * hi); rli[4 * i] = fv[0]; rli[4 * i + 1] = fv[1]; rli[4 * i + 2] = fv[2]; rli[4 * i + 3] = fv[3]; }
    u16* Ow = s.o + (size_t)(q0 + wid * QBLK) * s.op;
    { LAS3 u16* stg = (LAS3 u16*)(shm + LDS_OST) + wid * 2048;
#pragma unroll
        for (int r = 0; r < 16; ++r) { const int orow = crow(r, hi);
#pragma unroll
            for (int d0 = 0; d0 < 2; ++d0) stg[orow * 64 + d0 * 32 + r32] = (u16)(cvtpk_s(o[d0][r] * rli[r], 0.f) & 0xffffu); }
        asm volatile("s_waitcnt lgkmcnt(0)" ::: "memory");
#pragma unroll
        for (int i = 0; i < 4; ++i) { const int row = i * 8 + (lane >> 3), ch = lane & 7; const u32x4 v = *(const LAS3 u32x4*)(stg + row * 64 + ch * 8); *(u32x4*)(Ow + (size_t)row * s.op + ch * 8) = v; } }
    asm volatile("s_waitcnt lgkmcnt(0)\n\ts_barrier" ::: "memory");
#undef ATT_DMA_K
#undef ATT_DMA_V
#undef ATT_TOP
#undef ATT_MASK
#undef ATT_DECIDE
#undef ATT_RESC
#undef ATT_STEP
}
}

namespace cg = cooperative_groups;
#define LAS __attribute__((address_space(3)))
typedef unsigned short bf16;
typedef unsigned v4u __attribute__((ext_vector_type(4)));
typedef unsigned v2u __attribute__((ext_vector_type(2)));
typedef float f32x4 __attribute__((ext_vector_type(4)));
constexpr int NWAVES = 8;
constexpr int M = 16384, D = 1024, FF = 4096, NIN = 1960, NINP = 2048, QL = 256, KVL = 128, NQU = 768, NKVU = 1024;
constexpr float EPS = 1e-6f;
constexpr float LOG2E = 1.4426950408889634f;
constexpr float C2_FOX = 0.125f * LOG2E, C2_MLA = 0.10206207261596575f * LOG2E;
constexpr size_t MiB = 1u << 20;
constexpr size_t WS_WIN = 1 * MiB, WS_WQ = 5 * MiB, WS_WKV = 5 * MiB + 512 * 1024, WS_WO = 6 * MiB, WS_W1 = 8 * MiB, WS_W2 = 16 * MiB;
constexpr size_t WS_RT = 24 * MiB, WS_LF = 26 * MiB, WS_LC = 26 * MiB + 512 * 1024, WS_SS = 27 * MiB, WS_KR = 28 * MiB, WS_KB = 29 * MiB, WS_SSQ = 31 * MiB, WS_SSKV = 31 * MiB + 512 * 1024, WS_BIASF = 28 * MiB;
constexpr size_t WS_XN = 32 * MiB, WS_H = 64 * MiB, WS_P = 64 * MiB, WS_QM = 128 * MiB, WS_KVM = 152 * MiB, WS_QN = 184 * MiB, WS_O = 192 * MiB, WS_KVN = 224 * MiB, WS_END = 228 * MiB;
constexpr int RING_BYTES = 131072, LDS_BYTES = 147456;
static_assert(att::LDS_BYTES <= LDS_BYTES, "attention scratch fits the LDS allocation");

__device__ __forceinline__ unsigned f2bf(float f) { unsigned u = __builtin_bit_cast(unsigned, f); return (u + 0x7fffu + ((u >> 16) & 1u)) >> 16; }
__device__ __forceinline__ unsigned pk2(float lo, float hi) { return f2bf(lo) | (f2bf(hi) << 16); }
__device__ __forceinline__ float bf2f(unsigned short h) { return __builtin_bit_cast(float, (unsigned)h << 16); }
__device__ __forceinline__ float wave_sum(float v) {
#pragma unroll
    for (int o = 1; o < 64; o <<= 1) v += __shfl_xor(v, o);
    return v;
}
__device__ __forceinline__ int map_row(int mode, int n) {
    if (mode == 1) { const int h = n / 96, d = n % 96; if (d < 64) return n; const int i = d - 64; return h * 96 + (i < 16 ? 64 + 2 * i : 64 + 2 * (i - 16) + 1); }
    if (mode == 2) { const int h = n >> 7, j = n & 127; return j < 64 ? h * 64 + j : 512 + h * 64 + (j - 64); }
    if (mode == 3) { if (n < 1536 || n >= 1960) return n; if (n < 1544) return 1952 + (n - 1536); if (n < 1800) return 1536 + (n - 1544); if (n < 1928) return 1792 + (n - 1800);
        const int i = n - 1928; return 1920 + (i < 16 ? 2 * i : 2 * (i - 16) + 1); }
    return n;
}
__device__ __forceinline__ void p0_transpose_item(const float* W, int K, int N, int nblk, bf16* WT, int mode, const float* gk, LAS float* scr, int item, int lane) {
    const int kb = item / nblk, nb = item % nblk, k0 = 64 * kb, n0 = 32 * nb;
    const int nn = n0 + (lane & 31);
#pragma unroll 8
    for (int i = 0; i < 32; ++i) { const int kk = 2 * i + (lane >> 5); float v = (nn < N) ? W[(size_t)(k0 + kk) * N + nn] : 0.f; if (gk) v *= gk[k0 + kk]; scr[kk * 33 + (lane & 31)] = v; }
    asm volatile("s_waitcnt lgkmcnt(0)" ::: "memory");
    const int c = lane & 7;
#pragma unroll
    for (int j = 0; j < 4; ++j) { const int n = (lane >> 3) + 8 * j; const LAS float* sp = scr + (8 * c) * 33 + n;
        v4u o; o.x = pk2(sp[0 * 33], sp[1 * 33]); o.y = pk2(sp[2 * 33], sp[3 * 33]); o.z = pk2(sp[4 * 33], sp[5 * 33]); o.w = pk2(sp[6 * 33], sp[7 * 33]);
        *(v4u*)(WT + (size_t)map_row(mode, n0 + n) * K + k0 + 8 * c) = o; }
    asm volatile("s_waitcnt lgkmcnt(0)" ::: "memory");
}
__device__ __forceinline__ void sincos_d(double x, float& sn, float& cs) {
    const double k = rint(x * 0.63661977236758134308);
    double r = fma(-k, 1.57079632679489655800e+00, x); r = fma(-k, 6.12323399573676603587e-17, r);
    const double r2 = r * r;
    double s = -1.0 / 6227020800.0; s = s * r2 + 1.0 / 39916800.0; s = s * r2 - 1.0 / 362880.0; s = s * r2 + 1.0 / 5040.0; s = s * r2 - 1.0 / 120.0; s = s * r2 + 1.0 / 6.0; s = r - r * r2 * s;
    double c = 1.0 / 479001600.0; c = c * r2 - 1.0 / 3628800.0; c = c * r2 + 1.0 / 40320.0; c = c * r2 - 1.0 / 720.0; c = c * r2 + 1.0 / 24.0; c = c * r2 - 0.5; c = 1.0 + r2 * c;
    const int q = ((int)k) & 3;
    const double ss = (q == 0) ? s : (q == 1) ? c : (q == 2) ? -s : -c;
    const double cc = (q == 0) ? c : (q == 1) ? -s : (q == 2) ? -c : s;
    sn = (float)ss; cs = (float)cc;
}

#define RLX_AGENT __ATOMIC_RELAXED, __HIP_MEMORY_SCOPE_AGENT
#define XB_TMO      128
#define XB_XCNT(j)  (256  + 64 * (j))
#define XB_XSUB(j)  (1280 + 64 * (j))
#define XB_XGEN(j)  (2304 + 64 * (j))
#define XB_TOP      3328
#define XB_TOPGEN   3392
#define XCD_BAR_WORDS 3456
#define XB_SPIN_CAP (1u << 18)

__device__ __forceinline__ unsigned xb_ld(unsigned* p)              { return __hip_atomic_load(p, __ATOMIC_RELAXED, __HIP_MEMORY_SCOPE_AGENT); }
__device__ __forceinline__ unsigned xb_add(unsigned* p, unsigned v) { return __hip_atomic_fetch_add(p, v, __ATOMIC_RELAXED, __HIP_MEMORY_SCOPE_AGENT); }
__device__ __forceinline__ unsigned xb_xcc_id() { return (unsigned)__builtin_amdgcn_s_getreg((3 << 11) | 20) & 0xFu; }
#define XB_SPIN(cond, bar) do { unsigned _sp = 0; while (cond) { __builtin_amdgcn_s_sleep(1); \
    if ((++_sp & 255u) == 0u) { if (xb_ld(&(bar)[XB_TMO])) break; if (_sp > XB_SPIN_CAP) { atomicAdd(&(bar)[XB_TMO], 1u); break; } } } } while (0)

struct XcdBarrier {
    unsigned* bar; unsigned x;
    volatile LAS unsigned* st;
};

__device__ __forceinline__ XcdBarrier xcd_barrier_post(unsigned* bar, volatile LAS unsigned* st) {
    XcdBarrier b; b.bar = bar; b.x = xb_xcc_id(); b.st = st;
    if (threadIdx.x == 0) (void)xb_add(&bar[XB_XCNT(b.x)], 1u);
    return b;
}
__device__ __forceinline__ void xcd_barrier_complete(unsigned* bar, unsigned x, unsigned& nloc, unsigned& nx) {
    const unsigned G = gridDim.x * gridDim.y * gridDim.z;
    unsigned sum, cnt, mine, sp = 0u;
    for (;;) {
        sum = 0u; cnt = 0u; mine = 0u;
#pragma unroll
        for (unsigned j = 0; j < 16; ++j) { const unsigned c = xb_ld(&bar[XB_XCNT(j)]); sum += c; cnt += (c > 0u) ? 1u : 0u; mine = (j == x) ? c : mine; }
        if (sum == G) break;
        __builtin_amdgcn_s_sleep(1);
        if ((++sp & 255u) == 0u) { if (xb_ld(&bar[XB_TMO])) break; if (sp > XB_SPIN_CAP) { atomicAdd(&bar[XB_TMO], 1u); break; } }
    }
    nloc = mine > 0u ? mine : 1u; nx = cnt > 0u ? cnt : 1u;
}

__device__ __forceinline__ void xcd_barrier(const XcdBarrier& b) {
    asm volatile("s_waitcnt vmcnt(0)" ::: "memory");
    __syncthreads();
    if (threadIdx.x == 0) {
        unsigned* bar = b.bar;
        __builtin_amdgcn_s_waitcnt(0);
        unsigned nloc = b.st[0], nx = b.st[1];
        if (nloc == 0u) { xcd_barrier_complete(bar, b.x, nloc, nx); b.st[0] = nloc; b.st[1] = nx; }
        const unsigned old = xb_add(&bar[XB_XSUB(b.x)], 1u);
        const unsigned gen = old / nloc;
        if (old + 1u == (gen + 1u) * nloc) {
            __builtin_amdgcn_fence(__ATOMIC_RELEASE, "agent");
            asm volatile("s_waitcnt vmcnt(0)" ::: "memory");
            const unsigned og = xb_add(&bar[XB_TOP], 1u);
            const unsigned tg = og / nx;
            if (og + 1u == (tg + 1u) * nx) xb_add(&bar[XB_TOPGEN], 1u);
            else XB_SPIN(xb_ld(&bar[XB_TOPGEN]) == tg, bar);
            __builtin_amdgcn_fence(__ATOMIC_ACQUIRE, "agent");
            xb_add(&bar[XB_XGEN(b.x)], 1u);
            asm volatile("s_waitcnt vmcnt(0)" ::: "memory");
        } else {
            XB_SPIN(xb_ld(&bar[XB_XGEN(b.x)]) == gen, bar);
            __builtin_amdgcn_fence(__ATOMIC_ACQUIRE, "agent");
            asm volatile("s_waitcnt vmcnt(0)" ::: "memory");
        }
    }
    __syncthreads();
}

constexpr int MISC_OFF = LDS_BYTES - 128;
constexpr size_t WS_CTL = 0, CTL_ZERO_BYTES = 64 * 1024;
constexpr int CW_KMAX = 8192, CW_QF = 8192 + 512, CW_QM = 8192 + 1024, CW_PCNT = 8192 + 1536;
static_assert(att::LDS_BYTES <= MISC_OFF, "LDS map");
struct Args { const float* in[13]; float* out; unsigned char* ws; int ph_lo, ph_hi, dup, pad; };
constexpr int NPHASE = 8;

__global__ void __launch_bounds__(NWAVES * 64, 2) mk_fwd(Args args) {
    extern __shared__ __attribute__((aligned(16))) unsigned char lds_raw[];
    LAS unsigned char* lds = (LAS unsigned char*)lds_raw;
    const int G = gridDim.x, bx = blockIdx.x;
#define MK_IDS int tid = threadIdx.x; asm volatile("" : "+v"(tid)); const int lane = tid & 63, wave = __builtin_amdgcn_readfirstlane(tid >> 6); const int gw = vcu * NWAVES + wave; (void)gw; (void)lane;
    const int vcu = (G % 8 == 0) ? (bx % 8) * (G / 8) + bx / 8 : bx;
    const int NGW = G * NWAVES;
    unsigned char* ws = args.ws;
#define MKP_x ((const float*)args.in[0])
#define MKP_g_mix ((const float*)args.in[1])
#define MKP_w_in ((const float*)args.in[2])
#define MKP_b_f ((const float*)args.in[3])
#define MKP_g_q ((const float*)args.in[4])
#define MKP_w_q_up ((const float*)args.in[5])
#define MKP_g_kv ((const float*)args.in[6])
#define MKP_w_kv_up ((const float*)args.in[7])
#define MKP_w_o ((const float*)args.in[8])
#define MKP_g_mlp ((const float*)args.in[9])
#define MKP_w_ff1 ((const float*)args.in[10])
#define MKP_w_ff2 ((const float*)args.in[11])
#define MKP_g_final ((const float*)args.in[12])
#define MKP_out (args.out)
#define MKP_Win_t ((bf16*)(args.ws + WS_WIN))
#define MKP_Wq_t ((bf16*)(args.ws + WS_WQ))
#define MKP_Wkv_t ((bf16*)(args.ws + WS_WKV))
#define MKP_Wo_t ((bf16*)(args.ws + WS_WO))
#define MKP_W1_t ((bf16*)(args.ws + WS_W1))
#define MKP_W2_t ((bf16*)(args.ws + WS_W2))
#define MKP_RT ((float*)(args.ws + WS_RT))
#define MKP_LF ((float*)(args.ws + WS_LF))
#define MKP_SS ((float*)(args.ws + WS_SS))
#define MKP_SSQ ((float*)(args.ws + WS_SSQ))
#define MKP_BIASF ((float*)(args.ws + WS_BIASF))
#define MKP_SSKV ((float*)(args.ws + WS_SSKV))
#define MKP_KB ((bf16*)(args.ws + WS_KB))
#define MKP_KR ((bf16*)(args.ws + WS_KR))
#define MKP_XN ((bf16*)(args.ws + WS_XN))
#define MKP_HB ((bf16*)(args.ws + WS_H))
#define MKP_P ((bf16*)(args.ws + WS_P))
#define MKP_QM ((bf16*)(args.ws + WS_QM))
#define MKP_KVM ((bf16*)(args.ws + WS_KVM))
#define MKP_QN ((bf16*)(args.ws + WS_QN))
#define MKP_OB ((bf16*)(args.ws + WS_O))
#define MKP_KVN ((bf16*)(args.ws + WS_KVN))
    const int lo = args.ph_lo, hi = args.ph_hi;
#ifndef MK_MASK
#define MK_MASK 0x1ff
#endif
#define IN(k) (((MK_MASK >> (k)) & 1) && lo <= (k) && (k) < hi)
#define REP(k) for (int rep_ = 0; rep_ < ((args.dup == (k)) ? 2 : 1); ++rep_)
    { volatile LAS unsigned* misc = (volatile LAS unsigned*)(lds + MISC_OFF); if (threadIdx.x < 32) misc[threadIdx.x] = 0u; }
    __syncthreads();
    (void)xcd_barrier_post((unsigned*)(ws + WS_CTL), (volatile LAS unsigned*)(lds + MISC_OFF) + 8);
    if (args.ph_lo < 0) cg::this_grid().sync();
#define SEAM(k) do { if (IN(k) && IN((k) + 1)) { XcdBarrier b_; b_.bar = (unsigned*)(args.ws + WS_CTL); b_.x = xb_xcc_id(); b_.st = (volatile LAS unsigned*)(lds + MISC_OFF) + 8; xcd_barrier(b_); } } while (0)

    if (IN(0)) { MK_IDS
        LAS float* scr = (LAS float*)(lds + wave * 16384);
        constexpr int I_IN = (D / 64) * (NINP / 32), I_Q = (QL / 64) * (NQU / 32), I_KV = (KVL / 64) * (NKVU / 32), I_O = (D / 64) * (D / 32), I_1 = (D / 64) * (FF / 32), I_2 = (FF / 64) * (D / 32);
        constexpr int NITEMS = I_IN + I_Q + I_KV + I_O + I_1 + I_2;
        for (int it = gw; it < NITEMS; it += NGW) {
            int r = it;
            if (r < I_IN) { p0_transpose_item(MKP_w_in, D, NIN, NINP / 32, MKP_Win_t, 3, nullptr, scr, r, lane); continue; } r -= I_IN;
            if (r < I_Q) { p0_transpose_item(MKP_w_q_up, QL, NQU, NQU / 32, MKP_Wq_t, 1, MKP_g_q, scr, r, lane); continue; } r -= I_Q;
            if (r < I_KV) { p0_transpose_item(MKP_w_kv_up, KVL, NKVU, NKVU / 32, MKP_Wkv_t, 2, MKP_g_kv, scr, r, lane); continue; } r -= I_KV;
            if (r < I_O) { p0_transpose_item(MKP_w_o, D, D, D / 32, MKP_Wo_t, 0, nullptr, scr, r, lane); continue; } r -= I_O;
            if (r < I_1) { p0_transpose_item(MKP_w_ff1, D, FF, FF / 32, MKP_W1_t, 0, MKP_g_mlp, scr, r, lane); continue; } r -= I_1;
            p0_transpose_item(MKP_w_ff2, FF, D, D / 32, MKP_W2_t, 0, nullptr, scr, r, lane);
        }
        for (int m0 = gw; m0 < M; m0 += 4 * NGW) {
            const f32x4* gr = (const f32x4*)MKP_g_mix + lane; f32x4 v[4][4]; float s2[4];
#pragma unroll
            for (int r = 0; r < 4; ++r) { const int m = m0 + r * NGW; const f32x4* xr = (const f32x4*)(MKP_x + (size_t)(m < M ? m : 0) * D) + lane;
#pragma unroll
                for (int j = 0; j < 4; ++j) v[r][j] = xr[64 * j]; }
#pragma unroll
            for (int r = 0; r < 4; ++r) { s2[r] = 0.f;
#pragma unroll
                for (int j = 0; j < 4; ++j) s2[r] += (v[r][j].x * v[r][j].x + v[r][j].y * v[r][j].y) + (v[r][j].z * v[r][j].z + v[r][j].w * v[r][j].w);
                s2[r] = 1.f / sqrtf(wave_sum(s2[r]) * (1.f / D) + EPS); }
#pragma unroll
            for (int r = 0; r < 4; ++r) { const int m = m0 + r * NGW; if (m < M) { unsigned long long* o8 = (unsigned long long*)(MKP_XN + (size_t)m * D) + lane; const float rstd = s2[r];
#pragma unroll
                for (int j = 0; j < 4; ++j) { const f32x4 g = gr[64 * j]; o8[64 * j] = (unsigned long long)pk2(v[r][j].x * rstd * g.x, v[r][j].y * rstd * g.y) | ((unsigned long long)pk2(v[r][j].z * rstd * g.z, v[r][j].w * rstd * g.w) << 32); } } }
        }
        for (int e = (vcu * NWAVES * 64 + tid); e < M * 16; e += G * NWAVES * 64) {
            const int m = e >> 4, i = e & 15; double inv = 1.0; for (int j = 0; j < i; ++j) inv *= 0.56234132519034908039;
            float sn, cs; sincos_d((double)m * inv, sn, cs); MKP_RT[2 * e] = cs; MKP_RT[2 * e + 1] = sn;
        }
    }
    SEAM(0);
    if (IN(1)) {
        pg8::Gemm g{MKP_XN, MKP_Win_t, M, NINP, D}; pg8::StaticOrder S; S.init(M, NINP, G, bx);
        pg8::EpiIn E{MKP_P, NINP, C2_FOX, MKP_SSQ, MKP_SSKV, MKP_RT, MKP_b_f, MKP_LF, M};
        pg8::gemm_phase<pg8::EpiIn, pg8::StaticOrder, PG8_ALIGN, PG8_SP2>(lds, g, S, E);
    }
    SEAM(1);
    if (IN(3)) { MK_IDS
        if (wave < 2) { const int job = bx + 256 * wave;
            if (job < 512 && bx < 256) { const int h = job >> 6, ti = job & 63; const f32x4* lf4 = (const f32x4*)(MKP_LF + (size_t)h * M);
                float pre = 0.f; { int j = 0; float pa[8] = {0.f, 0.f, 0.f, 0.f, 0.f, 0.f, 0.f, 0.f};
                    for (; j + 8 <= ti; j += 8) { f32x4 w[8];
#pragma unroll
                        for (int u = 0; u < 8; ++u) w[u] = lf4[(j + u) * 64 + lane];
#pragma unroll
                        for (int u = 0; u < 8; ++u) pa[u] += (w[u].x + w[u].y) + (w[u].z + w[u].w); }
                    for (; j < ti; ++j) { const f32x4 w = lf4[j * 64 + lane]; pa[0] += (w.x + w.y) + (w.z + w.w); }
                    pre = ((pa[0] + pa[1]) + (pa[2] + pa[3])) + ((pa[4] + pa[5]) + (pa[6] + pa[7])); }
                pre = wave_sum(pre);
                const f32x4 v = lf4[ti * 64 + lane];
                const float s1 = v.x, s2 = s1 + v.y, s3 = s2 + v.z, s4 = s3 + v.w; float inc = s4;
#pragma unroll
                for (int o = 1; o < 64; o <<= 1) { const float n = __shfl_up(inc, o); if (lane >= o) inc += n; }
                const float ex = pre + (inc - s4); const float cs[4] = {ex + s1, ex + s2, ex + s3, ex + s4};
                *(f32x4*)(MKP_BIASF + (size_t)h * M + ti * 256 + 4 * lane) = (f32x4){-cs[0] * LOG2E, -cs[1] * LOG2E, -cs[2] * LOG2E, -cs[3] * LOG2E};
                { float km = 0.f;
                  for (int e = 0; e < 4; ++e) { const v4u* kr = (const v4u*)(MKP_P + (size_t)(ti * 256 + 4 * lane + e) * NINP + 512 + h * 64); float a2 = 0.f;
#pragma unroll
                      for (int c8 = 0; c8 < 8; ++c8) { const v4u w = kr[c8]; const unsigned ww[4] = {w.x, w.y, w.z, w.w};
#pragma unroll
                          for (int q4 = 0; q4 < 4; ++q4) { const float lo_ = __builtin_bit_cast(float, ww[q4] << 16), hi_ = __builtin_bit_cast(float, ww[q4] & 0xffff0000u); a2 += lo_ * lo_ + hi_ * hi_; } }
                      km = fmaxf(km, a2); }
#pragma unroll
                  for (int o = 32; o >= 1; o >>= 1) km = fmaxf(km, __shfl_xor(km, o));
                  if (lane == 0) atomicMax((unsigned*)(args.ws + WS_CTL) + CW_KMAX + 64 * h, __builtin_bit_cast(unsigned, km)); }
#pragma unroll
                for (int e = 0; e < 4; ++e) { const float b = -cs[e] * LOG2E; const unsigned bh = f2bf(b); const float r1 = b - __builtin_bit_cast(float, bh << 16); const unsigned bm = f2bf(r1);
                    const float r2 = r1 - __builtin_bit_cast(float, bm << 16); const unsigned bl = f2bf(r2);
                    *(v4u*)(MKP_KB + ((size_t)h * M + ti * 256 + 4 * lane + e) * 8) = (v4u){bh | (bm << 16), bl | 0x3F800000u, 0x3F803F80u, 0u}; } } }
        { int kq = QL; asm volatile("" : "+s"(kq)); pg8::Gemm g{MKP_P + 1536, MKP_Wq_t, M, NQU, kq, NINP}; pg8::StaticOrder S; S.init(M, NQU, G, bx);
          pg8::EpiQm E{MKP_QM, NQU, MKP_RT, C2_MLA, MKP_SSQ, EPS};
          pg8::gemm_phase<pg8::EpiQm, pg8::StaticOrder, PG8_ALIGN, PG8_SP2>(lds, g, S, E); }
        { int kkv = KVL; asm volatile("" : "+s"(kkv)); pg8::Gemm g{MKP_P + 1792, MKP_Wkv_t, M, NKVU, kkv, NINP}; pg8::StaticOrder S; S.init(M, NKVU, G, bx);
          pg8::EpiKv E{MKP_KVM, NKVU, MKP_SSKV, EPS};
          pg8::gemm_phase<pg8::EpiKv, pg8::StaticOrder, PG8_ALIGN, PG8_SP2>(lds, g, S, E); }
    }
    SEAM(3);
    if (IN(4)) {
        const int v = (G == 256) ? vcu : bx; const int h0 = (v >> 5) & 7;
        volatile LAS unsigned* misc = (volatile LAS unsigned*)(lds + MISC_OFF);
        unsigned* ctlw = (unsigned*)(args.ws + WS_CTL);
        for (int k = 0; k < 8; ++k) { const int h = (h0 + k) & 7;
            const float kmax2 = __builtin_bit_cast(float, __hip_atomic_load(ctlw + CW_KMAX + 64 * h, __ATOMIC_RELAXED, __HIP_MEMORY_SCOPE_AGENT));
            att::Src s{MKP_P + h * 64, NINP, MKP_P + 512 + h * 64, NINP, MKP_KB + (size_t)h * M * 8, 8, MKP_P + 1024 + h * 64, NINP, MKP_OB + h * 64, D};
            for (;;) {
                if (threadIdx.x == 0) misc[0] = __hip_atomic_fetch_add(ctlw + CW_QF + 64 * h, 1u, __ATOMIC_RELAXED, __HIP_MEMORY_SCOPE_AGENT);
                __syncthreads(); const unsigned i = misc[0]; __syncthreads();
                if (i >= 64u) break;
                att::attn_unit<false>(63 - (int)i, s, lds, MKP_BIASF + (size_t)h * M, kmax2);
            } }
        asm volatile("" ::: "memory");
        for (int k = 0; k < 8; ++k) { const int h = (h0 + k) & 7;
            att::Src s{MKP_QM + h * 96, NQU, MKP_KVM + h * 64, NKVU, MKP_P + 1920, NINP, MKP_KVM + 512 + h * 64, NKVU, MKP_OB + 512 + h * 64, D};
            for (;;) {
                if (threadIdx.x == 0) misc[0] = __hip_atomic_fetch_add(ctlw + CW_QM + 64 * h, 1u, __ATOMIC_RELAXED, __HIP_MEMORY_SCOPE_AGENT);
                __syncthreads(); const unsigned i = misc[0]; __syncthreads();
                if (i >= 64u) break;
                att::attn_unit<true>(63 - (int)i, s, lds, nullptr, 0.f);
            } }
    }
    SEAM(4);
    if (IN(5)) {
        pg8::Gemm g{MKP_OB, MKP_Wo_t, M, D, D}; pg8::StaticOrder S; S.init(M, D, G, bx);
        pg8::EpiRes E{MKP_x, MKP_out, D, MKP_XN, MKP_SS};
        pg8::gemm_phase<pg8::EpiRes, pg8::StaticOrder, PG8_ALIGN, PG8_SP2>(lds, g, S, E);
    }
    SEAM(5);
    if (IN(6)) {
        pg8::Gemm g{MKP_XN, MKP_W1_t, M, FF, D}; pg8::StaticOrder S; S.init(M, FF, G, bx);
        pg8::EpiSqRelu E{MKP_HB, FF, MKP_SS, EPS, 1.f / D};
        pg8::gemm_phase<pg8::EpiSqRelu, pg8::StaticOrder, PG8_ALIGN, PG8_SP2>(lds, g, S, E);
    }
    SEAM(6);
    if (IN(7)) {
        pg8::Gemm g{MKP_HB, MKP_W2_t, M, D, FF}; pg8::StaticOrder S; S.init(M, D, G, bx);
        pg8::EpiResNorm E{MKP_out, MKP_out, D, MKP_g_final, MKP_SSQ, (unsigned*)(args.ws + WS_CTL) + CW_PCNT, EPS, 1.f / D};
        pg8::gemm_phase<pg8::EpiResNorm, pg8::StaticOrder, false, PG8_SP2>(lds, g, S, E);
    }
#undef IN
#undef SEAM
#undef MKP_x
#undef MKP_g_mix
#undef MKP_w_in
#undef MKP_b_f
#undef MKP_g_q
#undef MKP_w_q_up
#undef MKP_g_kv
#undef MKP_w_kv_up
#undef MKP_w_o
#undef MKP_g_mlp
#undef MKP_w_ff1
#undef MKP_w_ff2
#undef MKP_g_final
#undef MKP_out
#undef MKP_Win_t
#undef MKP_Wq_t
#undef MKP_Wkv_t
#undef MKP_Wo_t
#undef MKP_W1_t
#undef MKP_W2_t
#undef MKP_RT
#undef MKP_LF
#undef MKP_SS
#undef MKP_SSQ
#undef MKP_BIASF
#undef MKP_SSKV
#undef MKP_KB
#undef MKP_KR
#undef MKP_XN
#undef MKP_HB
#undef MKP_P
#undef MKP_QM
#undef MKP_KVM
#undef MKP_QN
#undef MKP_OB
#undef MKP_KVN
}

#ifndef MK_ONE_LAUNCH
#define MK_ONE_LAUNCH 1
#endif
extern "C" void kernel_launch(void* const* d_in, const int* in_sizes, int n_in, void* d_out, int out_size, void* d_ws, size_t ws_size, hipStream_t stream) {
    static int ready = 0;
    if (ready == 0) {
        if (n_in != 13 || in_sizes[0] != M * D || out_size != M * D || ws_size < WS_END) { fprintf(stderr, "kernel_launch: unexpected shapes (n_in %d, in0 %d, out %d, ws %zu)\n", n_in, n_in > 0 ? in_sizes[0] : -1, out_size, ws_size); ready = -1; return; }
        if (hipFuncSetAttribute((const void*)mk_fwd, hipFuncAttributeMaxDynamicSharedMemorySize, LDS_BYTES) != hipSuccess) { fprintf(stderr, "kernel_launch: hipFuncSetAttribute failed\n"); ready = -1; return; }
        ready = 1;
    }
    if (ready < 0) return;
    if (hipMemsetAsync((char*)d_ws + WS_CTL, 0, CTL_ZERO_BYTES, stream) != hipSuccess) { fprintf(stderr, "kernel_launch: hipMemsetAsync failed\n"); return; }
    Args a{};
    for (int i = 0; i < 13; ++i) a.in[i] = (const float*)d_in[i];
    a.out = (float*)d_out; a.ws = (unsigned char*)d_ws;
#ifndef MK_DUP
#define MK_DUP -1
#endif
    a.dup = MK_DUP;
    const int grid = 256;
#if MK_ONE_LAUNCH
    a.ph_lo = 0; a.ph_hi = NPHASE;
    void* kargs[] = {&a};
    hipError_t e = hipLaunchCooperativeKernel((const void*)mk_fwd, dim3(grid), dim3(NWAVES * 64), kargs, LDS_BYTES, stream);
    if (e != hipSuccess) fprintf(stderr, "kernel_launch: cooperative launch failed: %s\n", hipGetErrorString(e));
#else
    for (int p = 0; p < NPHASE; ++p) { a.ph_lo = p; a.ph_hi = p + 1; hipLaunchKernelGGL(mk_fwd, dim3(grid), dim3(NWAVES * 64), LDS_BYTES, stream, a); }
#endif
}
```

```cpp
#include <hip/hip_runtime.h>
#include <hip/hip_cooperative_groups.h>
#include <hip/hip_bf16.h>
#include <cstdio>
#include <cstdint>
#include <cmath>
namespace pg8 {
#define PG8_LAS __attribute__((address_space(3)))
typedef unsigned short bf16_t;
typedef short bf16x8 __attribute__((ext_vector_type(8)));
typedef float f32x4 __attribute__((ext_vector_type(4)));
typedef unsigned u32x4 __attribute__((ext_vector_type(4)));
constexpr int BM = 256, BK = 64, HALF = 128, HTB = HALF * BK * 2  , STAGE_BYTES = 8 * HTB, NXCD = 8, WGM = 8;

__host__ __device__ __forceinline__ int lds_byte(int r, int c) { const int st = (r >> 4) * 2 + (c >> 5), rr = r & 15, cc = c & 31, ob = rr * 64 + cc * 2; return st * 1024 + (ob ^ (((ob >> 9) & 1) << 5)); }
__host__ __device__ __forceinline__ void stage_rc(int b, int& R, int& C) { const int st = b / 1024, sb = b % 1024, swz = sb ^ (((sb >> 9) & 1) << 5); R = (st >> 1) * 16 + swz / 64; C = (st & 1) * 32 + (swz % 64) / 2; }
__host__ __device__ __forceinline__ int perm32(int rho) { const int n = rho >> 4, i = rho & 15; return 8 * (i >> 2) + 4 * n + (i & 3); }

struct Unit { int pm, pn; };
struct Gemm { const bf16_t* A; const bf16_t* Bt; int M, N, K; int lda; };

struct StaticOrder {
    int nM, nN, nwg, G, c;
    __host__ __device__ void init(int M, int N, int G_, int c_) { nM = M / BM; nN = N / BM; nwg = nM * nN; G = G_; c = c_; }
    __host__ __device__ bool next(int i, Unit& u) const {
        const long L = (long)i * G + c; if (L >= nwg) return false;
        int wgid = (int)L; { const int q = nwg / NXCD, r = nwg % NXCD, xcd = wgid % NXCD, off = wgid / NXCD; wgid = (xcd < r ? xcd * (q + 1) : r * (q + 1) + (xcd - r) * q) + off; }
        const int nig = WGM * nN, gid = wgid / nig, fm = gid * WGM, gsz = (nM - fm) < WGM ? (nM - fm) : WGM;
        u.pm = fm + ((wgid % nig) % gsz); u.pn = (wgid % nig) / gsz; return true;
    }
    __device__ __forceinline__ void a_ready(const Unit&) const {}
    __device__ __forceinline__ void done(const Unit&) const {}
};

__device__ __forceinline__ unsigned cvt_pk_bf16(float lo, float hi) { unsigned r; asm volatile("v_cvt_pk_bf16_f32 %0, %1, %2" : "=v"(r) : "v"(lo), "v"(hi)); return r; }
typedef float f32x2 __attribute__((ext_vector_type(2)));
__device__ __forceinline__ f32x2 gelu_pk(f32x2 v) {
    const f32x2 av = __builtin_elementwise_abs(v), d = av * 0.2316418882f + 1.0f;
    f32x2 t; t.x = __builtin_amdgcn_rcpf(d.x); t.y = __builtin_amdgcn_rcpf(d.y);
    f32x2 q = t * 0.5307027145f + (-0.7265760135f); q = q * t + 0.7107068705f; q = q * t + (-0.142248368f); q = q * t + 0.127414796f; q = q * t;
    const f32x2 s = (v * v) * (-0.72134752044f);
    f32x2 e; e.x = __builtin_amdgcn_exp2f(s.x); e.y = __builtin_amdgcn_exp2f(s.y);
    const f32x2 m = v * (q * e), r = v - m;
    f32x2 o; o.x = v.x < 0.f ? m.x : r.x; o.y = v.y < 0.f ? m.y : r.y; return o;
}

template <int ACT  > struct EpiBf16 {
    static constexpr bool PERM = true, AFTER_DRAIN = false; static_assert(ACT == 0 || ACT == 1, "EpiBf16: ACT is 0 (none) or 1 (gelu_pk)");
    bf16_t* O; int ldc; const float* bias; int split_cols; size_t split_stride; float scale0;
    __device__ __forceinline__ void operator()(const f32x4 (&acc)[2][2][4][2], const Unit& u, int wr, int wc, int fr, int fq) const {
        const int row0 = u.pm * BM + wr * 64 + fr; int colt = u.pn * BM; bf16_t* base = O;
        float sc = 1.f; if (split_cols) { const int t = colt / split_cols; base += (size_t)t * split_stride; colt -= t * split_cols; if (t == 0) sc = scale0; }
        const int col0 = colt + wc * 32 + 8 * fq, bcol0 = u.pn * BM + wc * 32 + 8 * fq;
        f32x4 bv[2][2];
#pragma unroll
        for (int bj = 0; bj < 2; ++bj)
#pragma unroll
            for (int n = 0; n < 2; ++n) bv[bj][n] = bias ? *(const f32x4*)(bias + bcol0 + bj * HALF + 4 * n) : (f32x4){0.f, 0.f, 0.f, 0.f};
#pragma unroll
        for (int ai = 0; ai < 2; ++ai)
#pragma unroll
            for (int m = 0; m < 4; ++m) { bf16_t* rowp = base + (size_t)(row0 + ai * HALF + m * 16) * ldc + col0;
#pragma unroll
                for (int bj = 0; bj < 2; ++bj) { f32x4 v0 = acc[ai][bj][m][0] + bv[bj][0], v1 = acc[ai][bj][m][1] + bv[bj][1];
                    if (ACT == 1) { f32x2 a = gelu_pk((f32x2){v0[0], v0[1]}), b = gelu_pk((f32x2){v0[2], v0[3]}), c = gelu_pk((f32x2){v1[0], v1[1]}), d = gelu_pk((f32x2){v1[2], v1[3]});
                        v0 = (f32x4){a.x, a.y, b.x, b.y}; v1 = (f32x4){c.x, c.y, d.x, d.y}; }
                    v0 = v0 * sc; v1 = v1 * sc; u32x4 w; w.x = cvt_pk_bf16(v0[0], v0[1]); w.y = cvt_pk_bf16(v0[2], v0[3]); w.z = cvt_pk_bf16(v1[0], v1[1]); w.w = cvt_pk_bf16(v1[2], v1[3]);
                    *(u32x4*)(rowp + bj * HALF) = w; } }
    }
};

struct EpiQm {
    static constexpr bool PERM = true, AFTER_DRAIN = false;
    bf16_t* O; int ldc; const float* rt; float scale; const float* ssq; float eps;
    __device__ __forceinline__ void operator()(const f32x4 (&acc)[2][2][4][2], const Unit& u, int wr, int wc, int fr, int fq) const {
        const int row0 = u.pm * BM + wr * 64 + fr, col0 = u.pn * BM + wc * 32 + 8 * fq;
#pragma unroll
        for (int ai = 0; ai < 2; ++ai)
#pragma unroll
            for (int m = 0; m < 4; ++m) { const int row = row0 + ai * HALF + m * 16;
                const f32x4 sq = *(const f32x4*)(ssq + (size_t)row * 4); const float rs = scale / sqrtf(((sq[0] + sq[1]) + (sq[2] + sq[3])) * (1.0f / 256.0f) + eps);
#pragma unroll
                for (int bj = 0; bj < 2; ++bj) { const int c = col0 + bj * HALF, d = c % 96;
                    f32x4 v0 = acc[ai][bj][m][0], v1 = acc[ai][bj][m][1];
                    if (d >= 64) { const f32x4* t = (const f32x4*)(rt + (size_t)row * 32 + (d - 64)); const f32x4 t0 = t[0], t1 = t[1];
                        f32x4 w0, w1;
                        w0[0] = v0[0] * t0[0] - v0[1] * t0[1]; w0[1] = v0[1] * t0[0] + v0[0] * t0[1];
                        w0[2] = v0[2] * t0[2] - v0[3] * t0[3]; w0[3] = v0[3] * t0[2] + v0[2] * t0[3];
                        w1[0] = v1[0] * t1[0] - v1[1] * t1[1]; w1[1] = v1[1] * t1[0] + v1[0] * t1[1];
                        w1[2] = v1[2] * t1[2] - v1[3] * t1[3]; w1[3] = v1[3] * t1[2] + v1[2] * t1[3];
                        v0 = w0; v1 = w1; }
                    v0 = v0 * rs; v1 = v1 * rs; u32x4 w; w.x = cvt_pk_bf16(v0[0], v0[1]); w.y = cvt_pk_bf16(v0[2], v0[3]); w.z = cvt_pk_bf16(v1[0], v1[1]); w.w = cvt_pk_bf16(v1[2], v1[3]);
                    *(u32x4*)(O + (size_t)row * ldc + c) = w; }
                asm volatile("" ::: "memory"); }
    }
};

struct EpiKv {
    static constexpr bool PERM = true, AFTER_DRAIN = false;
    bf16_t* O; int ldc; const float* ssq; float eps;
    __device__ __forceinline__ void operator()(const f32x4 (&acc)[2][2][4][2], const Unit& u, int wr, int wc, int fr, int fq) const {
        const int row0 = u.pm * BM + wr * 64 + fr, col0 = u.pn * BM + wc * 32 + 8 * fq;
#pragma unroll
        for (int ai = 0; ai < 2; ++ai)
#pragma unroll
            for (int m = 0; m < 4; ++m) { const int row = row0 + ai * HALF + m * 16;
                const f32x4 sq = *(const f32x4*)(ssq + (size_t)row * 4); const float rs = 1.0f / sqrtf(((sq[0] + sq[1]) + (sq[2] + sq[3])) * (1.0f / 128.0f) + eps);
#pragma unroll
                for (int bj = 0; bj < 2; ++bj) { const f32x4 v0 = acc[ai][bj][m][0] * rs, v1 = acc[ai][bj][m][1] * rs;
                    u32x4 w; w.x = cvt_pk_bf16(v0[0], v0[1]); w.y = cvt_pk_bf16(v0[2], v0[3]); w.z = cvt_pk_bf16(v1[0], v1[1]); w.w = cvt_pk_bf16(v1[2], v1[3]);
                    *(u32x4*)(O + (size_t)row * ldc + col0 + bj * HALF) = w; }
                asm volatile("" ::: "memory"); }
    }
};
struct EpiIn {
    static constexpr bool PERM = true, AFTER_DRAIN = false;
    bf16_t* O; int ldc; float scale0; float* ssq; float* sskv; const float* rt; const float* bf; float* lf; int nrows;
    __device__ __forceinline__ void operator()(const f32x4 (&acc)[2][2][4][2], const Unit& u, int wr, int wc, int fr, int fq) const {
        const int row0 = u.pm * BM + wr * 64 + fr, col0 = u.pn * BM + wc * 32 + 8 * fq; const int pn = u.pn;
        const float sc = pn < 2 ? scale0 : 1.f;
#pragma unroll
        for (int ai = 0; ai < 2; ++ai)
#pragma unroll
            for (int m = 0; m < 4; ++m) { const int row = row0 + ai * HALF + m * 16; bf16_t* rowp = O + (size_t)row * ldc + col0; float s0 = 0.f, s1 = 0.f;
#pragma unroll
                for (int bj = 0; bj < 2; ++bj) { f32x4 v0 = acc[ai][bj][m][0] * sc, v1 = acc[ai][bj][m][1] * sc;
                    const float sq = ((v0[0] * v0[0] + v0[1] * v0[1]) + (v0[2] * v0[2] + v0[3] * v0[3])) + ((v1[0] * v1[0] + v1[1] * v1[1]) + (v1[2] * v1[2] + v1[3] * v1[3]));
                    if (bj == 0) s0 = sq; else s1 = sq;
                    bool store = true;
                    if (pn == 7 && bj == 1) { store = (wc == 0);
                        if (wc == 0) { const f32x4* t = (const f32x4*)(rt + (size_t)row * 32 + 8 * fq); const f32x4 t0 = t[0], t1 = t[1]; f32x4 w0, w1;
                            w0[0] = v0[0] * t0[0] - v0[1] * t0[1]; w0[1] = v0[1] * t0[0] + v0[0] * t0[1];
                            w0[2] = v0[2] * t0[2] - v0[3] * t0[3]; w0[3] = v0[3] * t0[2] + v0[2] * t0[3];
                            w1[0] = v1[0] * t1[0] - v1[1] * t1[1]; w1[1] = v1[1] * t1[0] + v1[0] * t1[1];
                            w1[2] = v1[2] * t1[2] - v1[3] * t1[3]; w1[3] = v1[3] * t1[2] + v1[2] * t1[3];
                            v0 = w0; v1 = w1; }
                        else if (wc == 1 && fq == 0) {
#pragma unroll
                            for (int e = 0; e < 8; ++e) { const float z = (e < 4 ? v0[e & 3] : v1[e & 3]) + bf[e]; lf[(size_t)e * nrows + row] = fminf(z, 0.f) - 0.6931471805599453f * __builtin_amdgcn_logf(1.0f + __builtin_amdgcn_exp2f(-1.4426950408889634f * fabsf(z))); } } }
                    if (store) { u32x4 w; w.x = cvt_pk_bf16(v0[0], v0[1]); w.y = cvt_pk_bf16(v0[2], v0[3]); w.z = cvt_pk_bf16(v1[0], v1[1]); w.w = cvt_pk_bf16(v1[2], v1[3]);
                        *(u32x4*)(rowp + bj * HALF) = w; } }
                if (pn == 6) { float s = s0 + s1; s += __shfl_xor(s, 16); s += __shfl_xor(s, 32); if (fq == 0) ssq[(size_t)row * 4 + wc] = s; }
                if (pn == 7) { float s = s0; s += __shfl_xor(s, 16); s += __shfl_xor(s, 32); if (fq == 0) sskv[(size_t)row * 4 + wc] = s; }
                asm volatile("" ::: "memory"); }
    }
};
struct EpiRes {
    static constexpr bool PERM = false, AFTER_DRAIN = false;
    const float* base; float* out; int ldc; bf16_t* ob; float* ss;
    __device__ __forceinline__ void operator()(const f32x4 (&acc)[2][2][4][2], const Unit& u, int wr, int wc, int fr, int fq) const {
        typedef unsigned u32x2v __attribute__((ext_vector_type(2)));
        const int row0 = u.pm * BM + wr * 64 + fr, col0 = u.pn * BM + wc * 32 + 4 * fq;
#pragma unroll
        for (int ai = 0; ai < 2; ++ai)
#pragma unroll
            for (int m = 0; m < 4; ++m) { const int row = row0 + ai * HALF + m * 16; const size_t off = (size_t)row * ldc + col0; float s = 0.f;
#pragma unroll
                for (int bj = 0; bj < 2; ++bj)
#pragma unroll
                    for (int n = 0; n < 2; ++n) { const f32x4 v = *(const f32x4*)(base + off + bj * HALF + n * 16) + acc[ai][bj][m][n];
                        *(f32x4*)(out + off + bj * HALF + n * 16) = v; s += (v[0] * v[0] + v[1] * v[1]) + (v[2] * v[2] + v[3] * v[3]);
                        if (ob) { u32x2v w; w.x = cvt_pk_bf16(v[0], v[1]); w.y = cvt_pk_bf16(v[2], v[3]); *(u32x2v*)(ob + off + bj * HALF + n * 16) = w; } }
                if (ss) { s += __shfl_xor(s, 16); s += __shfl_xor(s, 32); if (fq == 0) ss[(size_t)row * 16 + u.pn * 4 + wc] = s; }
                asm volatile("" ::: "memory");
            }
    }
};

struct EpiResNorm {
    static constexpr bool PERM = false, AFTER_DRAIN = true;
    const float* base; float* out; int ldc; const float* g; float* xs; unsigned* cnt; float eps; float inv_n;
    __device__ __forceinline__ void fused(f32x4 (&acc)[2][2][4][2], const Unit& u, int wr, int wc, int fr, int fq, PG8_LAS unsigned char* lds, int wid, int lane) const {
        PG8_LAS float* Pm = (PG8_LAS float*)lds;
        PG8_LAS float* S = (PG8_LAS float*)(lds + 4096);
        const int row0 = u.pm * BM + wr * 64 + fr, col0 = u.pn * BM + wc * 32 + 4 * fq;
#pragma unroll
        for (int ai = 0; ai < 2; ++ai)
#pragma unroll
            for (int m = 0; m < 4; ++m) { const size_t off = (size_t)(row0 + ai * HALF + m * 16) * ldc + col0; float s = 0.f;
#pragma unroll
                for (int bj = 0; bj < 2; ++bj)
#pragma unroll
                    for (int n = 0; n < 2; ++n) { const f32x4 v = *(const f32x4*)(base + off + bj * HALF + n * 16) + acc[ai][bj][m][n]; acc[ai][bj][m][n] = v;
                        s += (v[0] * v[0] + v[1] * v[1]) + (v[2] * v[2] + v[3] * v[3]); }
                s += __shfl_xor(s, 16); s += __shfl_xor(s, 32);
                if (fq == 0) Pm[(ai * HALF + wr * 64 + m * 16 + fr) * 4 + wc] = s;
                if (m & 1) asm volatile("" ::: "memory"); }
        asm volatile("s_waitcnt lgkmcnt(0)" ::: "memory"); __builtin_amdgcn_s_barrier(); asm volatile("" ::: "memory");
        const int tid = wid * 64 + lane;
        if (tid < 256) { const f32x4 p4 = *(const PG8_LAS f32x4*)(Pm + tid * 4);
            __hip_atomic_store(xs + (size_t)(u.pm * BM + tid) * 4 + u.pn, (p4[0] + p4[1]) + (p4[2] + p4[3]), __ATOMIC_RELAXED, __HIP_MEMORY_SCOPE_AGENT);
            asm volatile("s_waitcnt vmcnt(0)" ::: "memory");
            if (lane == 0) __hip_atomic_fetch_add(cnt + 64 * u.pm, 1u, __ATOMIC_RELAXED, __HIP_MEMORY_SCOPE_AGENT); }
        if (wid == 0) { unsigned sp = 0;
            while ((unsigned)__builtin_amdgcn_readfirstlane(__hip_atomic_load(cnt + 64 * u.pm, __ATOMIC_RELAXED, __HIP_MEMORY_SCOPE_AGENT)) < 16u) { __builtin_amdgcn_s_sleep(2); if (++sp > (1u << 22)) break; }
            __builtin_amdgcn_fence(__ATOMIC_ACQUIRE, "agent"); }
        asm volatile("s_waitcnt vmcnt(0) lgkmcnt(0)" ::: "memory"); __builtin_amdgcn_s_barrier(); asm volatile("" ::: "memory");
        if (tid < 256) { const float* xp = xs + (size_t)(u.pm * BM + tid) * 4;
            const float t0 = __hip_atomic_load(xp + 0, __ATOMIC_RELAXED, __HIP_MEMORY_SCOPE_AGENT), t1 = __hip_atomic_load(xp + 1, __ATOMIC_RELAXED, __HIP_MEMORY_SCOPE_AGENT);
            const float t2 = __hip_atomic_load(xp + 2, __ATOMIC_RELAXED, __HIP_MEMORY_SCOPE_AGENT), t3 = __hip_atomic_load(xp + 3, __ATOMIC_RELAXED, __HIP_MEMORY_SCOPE_AGENT);
            S[tid] = 1.0f / sqrtf(((t0 + t1) + (t2 + t3)) * inv_n + eps); }
        asm volatile("s_waitcnt vmcnt(0) lgkmcnt(0)" ::: "memory"); __builtin_amdgcn_s_barrier(); asm volatile("" ::: "memory");
        f32x4 gv[2][2];
#pragma unroll
        for (int bj = 0; bj < 2; ++bj)
#pragma unroll
            for (int n = 0; n < 2; ++n) gv[bj][n] = *(const f32x4*)(g + col0 + bj * HALF + n * 16);
#pragma unroll
        for (int ai = 0; ai < 2; ++ai)
#pragma unroll
            for (int m = 0; m < 4; ++m) { const int r = ai * HALF + wr * 64 + m * 16 + fr; const float rs = S[r]; const size_t off = (size_t)(u.pm * BM + r) * ldc + col0;
#pragma unroll
                for (int bj = 0; bj < 2; ++bj)
#pragma unroll
                    for (int n = 0; n < 2; ++n) *(f32x4*)(out + off + bj * HALF + n * 16) = acc[ai][bj][m][n] * rs * gv[bj][n]; }
    }
};
struct EpiSqRelu {
    static constexpr bool PERM = true, AFTER_DRAIN = false;
    bf16_t* O; int ldc; const float* ss; float eps; float inv_n;
    __device__ __forceinline__ void operator()(const f32x4 (&acc)[2][2][4][2], const Unit& u, int wr, int wc, int fr, int fq) const {
        const int row0 = u.pm * BM + wr * 64 + fr, col0 = u.pn * BM + wc * 32 + 8 * fq;
#pragma unroll
        for (int ai = 0; ai < 2; ++ai)
#pragma unroll
            for (int m = 0; m < 4; ++m) { const int row = row0 + ai * HALF + m * 16;
                const f32x4* sp = (const f32x4*)(ss + (size_t)row * 16); const f32x4 a = sp[0], b = sp[1], c = sp[2], d = sp[3];
                const float tot = ((a[0] + a[1]) + (a[2] + a[3])) + ((b[0] + b[1]) + (b[2] + b[3])) + ((c[0] + c[1]) + (c[2] + c[3])) + ((d[0] + d[1]) + (d[2] + d[3]));
                const float rstd = 1.0f / sqrtf(tot * inv_n + eps);
#pragma unroll
                for (int bj = 0; bj < 2; ++bj) { f32x4 v0 = acc[ai][bj][m][0] * rstd, v1 = acc[ai][bj][m][1] * rstd;
#pragma unroll
                    for (int e = 0; e < 4; ++e) { const float x0 = fmaxf(v0[e], 0.f), x1 = fmaxf(v1[e], 0.f); v0[e] = x0 * x0; v1[e] = x1 * x1; }
                    u32x4 w; w.x = cvt_pk_bf16(v0[0], v0[1]); w.y = cvt_pk_bf16(v0[2], v0[3]); w.z = cvt_pk_bf16(v1[0], v1[1]); w.w = cvt_pk_bf16(v1[2], v1[3]);
                    *(u32x4*)(O + (size_t)row * ldc + col0 + bj * HALF) = w; }
                asm volatile("" ::: "memory"); }
    }
};


template <class Epi, class Sched, bool ALIGN_EPI = false, bool SP2 = false>
__device__ __forceinline__ void gemm_phase(PG8_LAS unsigned char* lds, const Gemm g, const Sched& S, const Epi& E) {
    const int tid = threadIdx.x, wid = __builtin_amdgcn_readfirstlane(tid >> 6), lane = tid & 63, wr = wid >> 2, wc = wid & 3, fr = lane & 15, fq = lane >> 4;
    const int K = g.K, nt = K / BK, lda = g.lda ? g.lda : g.K;
    unsigned voffA[2], voffB[2];
#pragma unroll
    for (int i = 0; i < 2; ++i) { int R, C; stage_rc(tid * 16 + i * 8192, R, C); const int Rb = Epi::PERM ? ((R & ~31) + perm32(R & 31)) : R;
        voffA[i] = (unsigned)(R * lda + C) * 2u; voffB[i] = (unsigned)(Rb * K + C) * 2u; }
    const size_t kstep = (size_t)(BK * 2);
    const size_t hstep = (size_t)HALF * K * 2;
    const size_t tstep = 2 * hstep;
    const size_t hstepA = (size_t)HALF * lda * 2, tstepA = 2 * hstepA;
    const unsigned ldsw = (unsigned)wid * 1024u;
    const int aoff = lds_byte(wr * 64 + fr, fq * 8), boff = lds_byte(wc * 32 + fr, fq * 8);
#define PG8_SA(b, h) (((b) * 2 + (h)) * HTB)
#define PG8_SB(b, h) ((4 + (b) * 2 + (h)) * HTB)
#define PG8_STAGE(bufoff, gbase, voff) do { _Pragma("unroll") for (int _i = 0; _i < 2; ++_i) \
        __builtin_amdgcn_global_load_lds((const unsigned*)((const char*)(gbase) + (voff)[_i]), (PG8_LAS unsigned*)(lds + (bufoff) + ldsw + _i * 8192), 16, 0, 0); } while (0)
#define PG8_LDA(dst, b, h) do { _Pragma("unroll") for (int m = 0; m < 4; ++m) _Pragma("unroll") for (int k = 0; k < 2; ++k) dst[m][k] = *(const PG8_LAS bf16x8*)(lds + PG8_SA(b, h) + aoff + m * 2048 + k * 1024); } while (0)
#define PG8_LDB(dst, b, h) do { _Pragma("unroll") for (int n = 0; n < 2; ++n) _Pragma("unroll") for (int k = 0; k < 2; ++k) dst[n][k] = *(const PG8_LAS bf16x8*)(lds + PG8_SB(b, h) + boff + n * 2048 + k * 1024); } while (0)
#define PG8_MMA(ai, bj, At, Bt) do { __builtin_amdgcn_s_setprio(1); _Pragma("unroll") for (int m = 0; m < 4; ++m) _Pragma("unroll") for (int n = 0; n < 2; ++n) _Pragma("unroll") for (int k = 0; k < 2; ++k) \
        acc[ai][bj][m][n] = __builtin_amdgcn_mfma_f32_16x16x32_bf16(Bt[n][k], At[m][k], acc[ai][bj][m][n], 0, 0, 0); __builtin_amdgcn_s_setprio(0); } while (0)
#define PG8_WAIT_V(n) asm volatile("s_waitcnt vmcnt(" #n ")" ::: "memory")
#define PG8_WAIT_L(n) asm volatile("s_waitcnt lgkmcnt(" #n ")" ::: "memory")
#define PG8_BAR __builtin_amdgcn_s_barrier()
#define PG8_SCHED __builtin_amdgcn_sched_barrier(0)
    Unit cur, nxt; int ui = 0;
    if (!S.next(0, cur)) return;
    f32x4 acc[2][2][4][2];
#pragma unroll
    for (int a = 0; a < 2; ++a)
#pragma unroll
        for (int b = 0; b < 2; ++b)
#pragma unroll
            for (int m = 0; m < 4; ++m)
#pragma unroll
                for (int n = 0; n < 2; ++n) acc[a][b][m][n] = (f32x4){0.f, 0.f, 0.f, 0.f};
    bf16x8 At[4][2], B0[2][2], B1[2][2];
    const char* cA = (const char*)g.A + (size_t)cur.pm * tstepA; const char* cB = (const char*)g.Bt + (size_t)cur.pn * tstep;
    S.a_ready(cur);
    if constexpr (SP2) {
        PG8_STAGE(PG8_SB(0, 0), cB, voffB); PG8_STAGE(PG8_SB(0, 1), cB + hstep, voffB); PG8_STAGE(PG8_SA(0, 0), cA, voffA); PG8_STAGE(PG8_SA(0, 1), cA + hstepA, voffA);
        if (wr == 1) PG8_BAR;
        PG8_WAIT_V(2); PG8_BAR;
        PG8_STAGE(PG8_SB(1, 0), cB + kstep, voffB); PG8_STAGE(PG8_SA(1, 0), cA + kstep, voffA); PG8_STAGE(PG8_SB(1, 1), cB + hstep + kstep, voffB);
        PG8_WAIT_V(6); PG8_BAR;
    } else {
        PG8_STAGE(PG8_SB(0, 0), cB, voffB); PG8_STAGE(PG8_SA(0, 0), cA, voffA); PG8_STAGE(PG8_SB(0, 1), cB + hstep, voffB); PG8_STAGE(PG8_SA(0, 1), cA + hstepA, voffA);
        if (wr == 1) PG8_BAR;
        PG8_WAIT_V(4); PG8_BAR;
        PG8_STAGE(PG8_SB(1, 0), cB + kstep, voffB); PG8_STAGE(PG8_SA(1, 0), cA + kstep, voffA); PG8_STAGE(PG8_SB(1, 1), cB + hstep + kstep, voffB);
        PG8_WAIT_V(6); PG8_BAR;
    }
    for (;;) {
        const bool has_next = S.next(ui + 1, nxt);
        const char* nA = has_next ? (const char*)g.A + (size_t)nxt.pm * tstepA : cA; const char* nB = has_next ? (const char*)g.Bt + (size_t)nxt.pn * tstep : cB;
        for (int t = 0; t < nt; t += 2) {
            const bool last = (t == nt - 2);
            const char* a1 = cA + (size_t)(t + 1) * kstep;
            const char* a2 = last ? nA : cA + (size_t)(t + 2) * kstep; const char* b2 = last ? nB : cB + (size_t)(t + 2) * kstep;
            const char* a3 = a2 + kstep; const char* b3 = b2 + kstep;
            if (last && has_next) S.a_ready(nxt);
            if constexpr (SP2) {
            PG8_LDB(B0, 0, 0); PG8_LDB(B1, 0, 1); PG8_SCHED; PG8_LDA(At, 0, 0); PG8_STAGE(PG8_SA(1, 1), a1 + hstepA, voffA);
            PG8_WAIT_V(8); PG8_WAIT_L(0); PG8_BAR; PG8_MMA(0, 0, At, B0); PG8_MMA(0, 1, At, B1); PG8_BAR; PG8_SCHED;
            PG8_LDA(At, 0, 1); PG8_STAGE(PG8_SB(0, 0), b2, voffB); PG8_STAGE(PG8_SB(0, 1), b2 + hstep, voffB); PG8_STAGE(PG8_SA(0, 0), a2, voffA);
            PG8_WAIT_V(8); PG8_WAIT_L(0); PG8_BAR; PG8_MMA(1, 0, At, B0); PG8_MMA(1, 1, At, B1); PG8_BAR; PG8_SCHED;
            PG8_LDB(B0, 1, 0); PG8_LDB(B1, 1, 1); PG8_SCHED; PG8_LDA(At, 1, 0); PG8_STAGE(PG8_SA(0, 1), a2 + hstepA, voffA);
            PG8_WAIT_V(8); PG8_WAIT_L(0); PG8_BAR; PG8_MMA(0, 0, At, B0); PG8_MMA(0, 1, At, B1); PG8_BAR; PG8_SCHED;
            PG8_LDA(At, 1, 1); PG8_STAGE(PG8_SB(1, 0), b3, voffB); PG8_STAGE(PG8_SB(1, 1), b3 + hstep, voffB); PG8_STAGE(PG8_SA(1, 0), a3, voffA);
            PG8_WAIT_V(8); PG8_WAIT_L(0); PG8_BAR; PG8_MMA(1, 0, At, B0); PG8_MMA(1, 1, At, B1); PG8_BAR; PG8_SCHED;
            } else {
            PG8_LDB(B0, 0, 0); PG8_SCHED; PG8_LDA(At, 0, 0); PG8_STAGE(PG8_SA(1, 1), a1 + hstepA, voffA);
            PG8_WAIT_L(8); PG8_BAR; PG8_WAIT_L(0); PG8_MMA(0, 0, At, B0); PG8_BAR; PG8_SCHED;
            PG8_LDB(B1, 0, 1); PG8_STAGE(PG8_SB(0, 0), b2, voffB);
            PG8_BAR; PG8_WAIT_L(0); PG8_MMA(0, 1, At, B1); PG8_BAR;
            PG8_LDA(At, 0, 1); PG8_STAGE(PG8_SA(0, 0), a2, voffA);
            PG8_BAR; PG8_WAIT_L(0); PG8_MMA(1, 0, At, B0); PG8_BAR; PG8_SCHED;
            PG8_STAGE(PG8_SB(0, 1), b2 + hstep, voffB);
            PG8_WAIT_V(6); PG8_BAR; PG8_MMA(1, 1, At, B1); PG8_BAR;
            PG8_LDB(B0, 1, 0); PG8_SCHED; PG8_LDA(At, 1, 0); PG8_STAGE(PG8_SA(0, 1), a2 + hstepA, voffA);
            PG8_WAIT_L(8); PG8_BAR; PG8_WAIT_L(0); PG8_MMA(0, 0, At, B0); PG8_BAR; PG8_SCHED;
            PG8_LDB(B1, 1, 1); PG8_STAGE(PG8_SB(1, 0), b3, voffB);
            PG8_BAR; PG8_WAIT_L(0); PG8_MMA(0, 1, At, B1); PG8_BAR;
            PG8_LDA(At, 1, 1); PG8_STAGE(PG8_SA(1, 0), a3, voffA);
            PG8_BAR; PG8_WAIT_L(0); PG8_MMA(1, 0, At, B0); PG8_BAR; PG8_SCHED;
            PG8_STAGE(PG8_SB(1, 1), b3 + hstep, voffB);
            PG8_WAIT_V(6); PG8_BAR; PG8_MMA(1, 1, At, B1); PG8_BAR;
            }
        }
        if constexpr (ALIGN_EPI) { if (wr == 0) PG8_BAR; }
        if constexpr (!Epi::AFTER_DRAIN) { E(acc, cur, wr, wc, fr, fq); S.done(cur); }
        if (!has_next) break;
#pragma unroll
        for (int a = 0; a < 2; ++a)
#pragma unroll
            for (int b = 0; b < 2; ++b)
#pragma unroll
                for (int m = 0; m < 4; ++m)
#pragma unroll
                    for (int n = 0; n < 2; ++n) acc[a][b][m][n] = (f32x4){0.f, 0.f, 0.f, 0.f};
        cur = nxt; cA = nA; cB = nB; ++ui;
        if constexpr (ALIGN_EPI) { if (wr == 1) PG8_BAR; }
    }
    PG8_WAIT_V(0);
    if constexpr (!ALIGN_EPI) { if (wr == 0) PG8_BAR; }
    PG8_BAR;
    if constexpr (Epi::AFTER_DRAIN) { E.fused(acc, cur, wr, wc, fr, fq, lds, wid, lane); S.done(cur); }
#undef PG8_SA
#undef PG8_SB
#undef PG8_STAGE
#undef PG8_LDA
#undef PG8_LDB
#undef PG8_MMA
#undef PG8_WAIT_V
#undef PG8_WAIT_L
#undef PG8_BAR
#undef PG8_SCHED
}
}

#ifndef PG8_SP2
#define PG8_SP2 true
#endif
#ifndef PG8_ALIGN
#define PG8_ALIGN true
#endif
namespace att {
#define LAS3 __attribute__((address_space(3)))
using bf16x8 = __attribute__((ext_vector_type(8))) short;
using s16x4 = __attribute__((ext_vector_type(4))) short;
using f32x16 = __attribute__((ext_vector_type(16))) float;
using f32x4 = __attribute__((ext_vector_type(4))) float;
using u32x4 = __attribute__((ext_vector_type(4))) unsigned;
typedef unsigned short u16;
typedef LAS3 const unsigned char* lds_cptr;
typedef short v4i16_t __attribute__((ext_vector_type(4)));
constexpr int SEQ = 16384, NW = 8, QBLK = 32, QB = 256, KVBLK = 64;
constexpr int KSLOT = 12288, VSLOT = 8192, NKS = 4, NVS = 4;
constexpr int LDS_K = 0, LDS_V = NKS * KSLOT, LDS_WS = LDS_V + NVS * VSLOT, LDS_OST = LDS_WS + NW * 256, LDS_QX = LDS_OST + NW * 4096, LDS_BYTES = LDS_QX + NW * 2048;
__device__ __forceinline__ int crow(int r, int hi) { return (r & 3) + 8 * (r >> 2) + 4 * hi; }
__device__ __forceinline__ void glds16(const void* gsrc, unsigned lds_dst) { unsigned keep;
    asm volatile("s_mov_b32 %0, m0\n\ts_mov_b32 m0, %2\n\ts_nop 0\n\tglobal_load_lds_dwordx4 %1, off\n\ts_mov_b32 m0, %0" : "=&s"(keep) : "v"(gsrc), "s"(lds_dst) : "memory"); }
typedef float f32x2_t __attribute__((ext_vector_type(2))); typedef __bf16 bf16x2_t __attribute__((ext_vector_type(2)));
__device__ __forceinline__ unsigned cvtpk_s(float lo, float hi) { f32x2_t v = {lo, hi}; bf16x2_t b = __builtin_convertvector(v, bf16x2_t); return __builtin_bit_cast(unsigned, b); }
__device__ __forceinline__ s16x4 vtr(lds_cptr p) { return __builtin_bit_cast(s16x4, __builtin_amdgcn_ds_read_tr16_b64_v4i16((LAS3 v4i16_t*)p)); }
#define ATT_SBAR() __builtin_amdgcn_sched_barrier(0)
#define ATT_WAIT_BAR(N) asm volatile("s_waitcnt vmcnt(" #N ") lgkmcnt(0)\n\ts_barrier" ::: "memory")
struct Src {
    const u16* q; int qp;
    const u16* k; int kp;
    const u16* k2; int k2p;
    const u16* v; int vp;
    u16* o; int op;
};
template <int NDK, int NQR, bool ZC, int XHS, int JLO, int JHI>
__device__ __forceinline__ void phase_a(f32x16& C0, f32x16& C1, const lds_cptr* kb_, int ksl_, const bf16x8* qr, lds_cptr qx_, const f32x16& negm, bf16x8* kf, bf16x8* qx) {
    constexpr int KPF = 4;
#define ATT_KRD(j) kf[j] = *(const LAS3 bf16x8*)(kb_[(j) >> 1] + ksl_ + ((j) & 1) * (((j) >> 1) < 4 ? 4096 : XHS))
    if (JLO == 0) { ATT_KRD(0); ATT_KRD(1); ATT_KRD(2); ATT_KRD(3); }
#pragma unroll
    for (int j = JLO; j < JHI; ++j) {
        if (j + KPF < 2 * NDK) ATT_KRD(j + KPF);
        if (NDK > NQR && (j & 1) == 0 && (j >> 1) + 2 >= NQR && (j >> 1) + 2 < NDK) qx[(j >> 1) + 2 - NQR] = *(const LAS3 bf16x8*)(qx_ + ((j >> 1) + 2 - NQR) * 1024);
        ATT_SBAR();
        const f32x16 z = f32x16{}; const bf16x8 qf = ((j >> 1) < NQR) ? qr[(j >> 1) < NQR ? (j >> 1) : 0] : qx[(j >> 1) >= NQR ? (j >> 1) - NQR : 0];
        if (j & 1) C1 = __builtin_amdgcn_mfma_f32_32x32x16_bf16(kf[j], qf, (j < 2) ? (ZC ? z : negm) : C1, 0, 0, 0);
        else       C0 = __builtin_amdgcn_mfma_f32_32x32x16_bf16(kf[j], qf, (j < 2) ? (ZC ? z : negm) : C0, 0, 0, 0);
        ATT_SBAR();
    }
#undef ATT_KRD
}
template <bool QK, bool FIN>
__device__ __forceinline__ void phase_b(f32x16& C0, f32x16& C1, f32x16* o, lds_cptr vp_, u32x4* pw, float& l_reg) {
    s16x4 vlo[8], vhi[8]; f32x2_t sacc = {0.f, 0.f};
#define ATT_VRD(i) do { const int vi_ = ((i) >> 1) + 4 * ((i) & 1); vlo[i] = vtr(vp_ + ((vi_ >> 2) * 4096 + (vi_ & 3) * 1024)); vhi[i] = vtr(vp_ + ((vi_ >> 2) * 4096 + (vi_ & 3) * 1024 + 512)); } while (0)
    if (FIN) { ATT_VRD(0); ATT_VRD(1); }
#pragma unroll
    for (int i = 0; i < 8; ++i) {
        if (FIN && i + 2 < 8) ATT_VRD(i + 2);
        ATT_SBAR();
        if (FIN) { const bf16x8 vf = (bf16x8){vlo[i][0], vlo[i][1], vlo[i][2], vlo[i][3], vhi[i][0], vhi[i][1], vhi[i][2], vhi[i][3]};
            o[i & 1] = __builtin_amdgcn_mfma_f32_32x32x16_bf16(__builtin_bit_cast(bf16x8, pw[i >> 1]), vf, o[i & 1], 0, 0, 0); }
        if (QK) { f32x16& X = (i < 4) ? C0 : C1; const int b = 4 * (i & 3);
            X[b] = __builtin_amdgcn_exp2f(X[b]); X[b + 1] = __builtin_amdgcn_exp2f(X[b + 1]); X[b + 2] = __builtin_amdgcn_exp2f(X[b + 2]); X[b + 3] = __builtin_amdgcn_exp2f(X[b + 3]);
            sacc += (f32x2_t){X[b], X[b + 1]}; sacc += (f32x2_t){X[b + 2], X[b + 3]}; asm volatile("" : "+v"(sacc));
            if (i & 1) { const int k = i >> 1, c = 8 * (k & 1);
                pw[k] = (u32x4){cvtpk_s(X[c], X[c + 1]), cvtpk_s(X[c + 2], X[c + 3]), cvtpk_s(X[c + 4], X[c + 5]), cvtpk_s(X[c + 6], X[c + 7])}; asm volatile("" : "+v"(pw[k])); } }
        ATT_SBAR();
    }
#undef ATT_VRD
    if (QK) l_reg += sacc[0] + sacc[1];
}
template <bool MLA> __device__ __forceinline__ void attn_unit(int qb, const Src& s, LAS3 unsigned char* shm, const float* bias_h, float kmax2) {
    constexpr int NDK = MLA ? 6 : 5, NX = MLA ? 4 : 1, NQR = MLA ? 4 : 5;
    constexpr float THRL = MLA ? 8.0f : 16.0f;
    const int tid = threadIdx.x, lane = tid & 63, r32 = lane & 31, hi = lane >> 5; const int wid = __builtin_amdgcn_readfirstlane(tid >> 6);
    const int q0 = qb * QB;
    const unsigned lds0 = (unsigned)(uintptr_t)shm;
    LAS3 float* wsf = (LAS3 float*)(shm + LDS_WS) + wid * 64;
    const int NT = (q0 + QB) / KVBLK;
    const int wvis = NT - 4 + (wid >> 1);
    const bool xw = wid < NX;
    const int krow = 8 * wid + (lane >> 3);
    const u16* ksrc = s.k + (size_t)krow * s.kp + (((lane & 7) ^ ((krow >> 1) & 7)) * 8);
    const int k2row = 16 * (wid & 3) + (lane >> 2);
    const u16* k2src = MLA ? s.k2 + (size_t)k2row * s.k2p + (((lane & 3) ^ ((k2row >> 2) & 3)) * 8) : s.k2 + (size_t)lane * s.k2p;
    const u16* vsrc = s.v + (size_t)(16 * (wid & 3) + (lane >> 2)) * s.vp + (wid >> 2) * 32 + (lane & 3) * 8;
    const unsigned kdst = lds0 + LDS_K + wid * 1024, k2dst = lds0 + LDS_K + (8 + (wid & 3)) * 1024, vdst = lds0 + LDS_V + wid * 1024;
#define ATT_DMA_K(t) do { const int sl_ = (t) & 3; glds16(ksrc + (size_t)(t) * KVBLK * s.kp, (unsigned)__builtin_amdgcn_readfirstlane(kdst + sl_ * KSLOT)); \
        if (xw) glds16(k2src + (size_t)(t) * KVBLK * s.k2p, (unsigned)__builtin_amdgcn_readfirstlane(k2dst + sl_ * KSLOT)); } while (0)
#define ATT_DMA_V(t, vsl) glds16(vsrc + (size_t)(t) * KVBLK * s.vp, (unsigned)__builtin_amdgcn_readfirstlane(vdst + (vsl)))
    if (!MLA) {
        if (tid < 256) { const int sl = tid >> 6; *(LAS3 f32x4*)(shm + LDS_K + sl * KSLOT + 9 * 1024 + (tid & 63) * 16) = (f32x4){0.f, 0.f, 0.f, 0.f}; } }
    const u16* Qw = s.q + (size_t)(q0 + wid * QBLK + r32) * s.qp + hi * 8;
    bf16x8 qr[NQR];
#pragma unroll
    for (int d0 = 0; d0 < 4; ++d0) qr[d0] = *reinterpret_cast<const bf16x8*>(Qw + d0 * 16);
    const lds_cptr qx0 = (lds_cptr)shm + LDS_QX + wid * 2048 + lane * 16;
    if (MLA) { const bf16x8 q4 = *reinterpret_cast<const bf16x8*>(Qw + 64), q5 = *reinterpret_cast<const bf16x8*>(Qw + 80);
        *(LAS3 bf16x8*)(shm + LDS_QX + wid * 2048 + lane * 16) = q4; *(LAS3 bf16x8*)(shm + LDS_QX + wid * 2048 + 1024 + lane * 16) = q5; }
    const short one = hi ? (short)0 : (short)0x3F80;
    if (!MLA) qr[NQR - 1] = (bf16x8){one, one, one, 0, 0, 0, 0, 0};
    int t0 = 0;
    if (!MLA) {
        float nq = 0.f;
#pragma unroll
        for (int d0 = 0; d0 < 4; ++d0)
#pragma unroll
            for (int e = 0; e < 8; ++e) { const float v = __uint_as_float((unsigned)(unsigned short)qr[d0][e] << 16); nq += v * v; }
        nq += __shfl_xor(nq, 32);
#pragma unroll
        for (int o_ = 16; o_ >= 1; o_ >>= 1) nq = fmaxf(nq, __shfl_xor(nq, o_));
        if (lane == 0) wsf[0] = nq;
        asm volatile("s_waitcnt lgkmcnt(0)\n\ts_barrier" ::: "memory");
        float qm = 0.f;
#pragma unroll
        for (int w = 0; w < NW; ++w) qm = fmaxf(qm, ((const LAS3 float*)(shm + LDS_WS))[w * 64]);
        const float thr = bias_h[q0] - 170.f - 2.f * sqrtf(qm * kmax2);
        int best = 0;
        for (int tt = 1 + lane; tt <= NT - 4; tt += 64) { if (bias_h[64 * tt - 1] < thr) best = tt; }
#pragma unroll
        for (int o_ = 32; o_ >= 1; o_ >>= 1) best = max(best, __shfl_xor(best, o_));
        t0 = __builtin_amdgcn_readfirstlane(best);
        asm volatile("s_waitcnt lgkmcnt(0)\n\ts_barrier" ::: "memory");
    }
    ATT_DMA_K(t0); ATT_DMA_V(t0, (t0 & 3) * VSLOT); ATT_DMA_K(t0 + 1); ATT_DMA_K(t0 + 2);
    float mhat = 0.f, l_reg = 0.f; f32x16 o[2]; o[0] = f32x16{}; o[1] = f32x16{}; f32x16 negm = f32x16{};
    const int qrel = wid * QBLK + r32;
    lds_cptr kb[NDK];
#pragma unroll
    for (int d0 = 0; d0 < 4; ++d0) kb[d0] = (lds_cptr)shm + LDS_K + r32 * 128 + ((((2 * d0 + hi) ^ ((r32 >> 1) & 7))) << 4);
    if (MLA) {
#pragma unroll
        for (int d0 = 4; d0 < NDK; ++d0) kb[d0] = (lds_cptr)shm + LDS_K + 8192 + r32 * 64 + ((((2 * (d0 - 4) + hi) ^ ((r32 >> 2) & 3))) << 4);
    } else kb[NDK - 1] = (lds_cptr)shm + LDS_K + 8192 + hi * 1024 + r32 * 16;
    constexpr int XHS = MLA ? 2048 : 512;
    const lds_cptr vp0 = (lds_cptr)shm + LDS_V + ((lane >> 4) & 1) * 32 + (lane & 3) * 8 + (4 * hi + ((lane & 15) >> 2)) * 64;
    f32x16 C0, C1; u32x4 pw[4]; bool resc = false;
#define ATT_TOP(t) do { if ((t) == t0 || (t) + 2 >= NT) { ATT_WAIT_BAR(0); } else if (xw) { ATT_WAIT_BAR(3); } else { ATT_WAIT_BAR(2); } \
        } while (0)
#define ATT_ISSUE(t) do { if ((t) + 3 < NT) ATT_DMA_K((t) + 3); if ((t) + 1 < NT) ATT_DMA_V((t) + 1, (((t) + 1) & 3) * VSLOT); } while (0)
#define ATT_QK(t) do { bf16x8 kf_[2 * NDK]; bf16x8 qx_[NDK > NQR ? NDK - NQR : 1]; \
        phase_a<NDK, NQR, !MLA, XHS, 0, 4>(C0, C1, ATT_KS(t), qr, qx0, negm, kf_, qx_); ATT_ISSUE(t); ATT_SBAR(); \
        phase_a<NDK, NQR, !MLA, XHS, 4, 2 * NDK>(C0, C1, ATT_KS(t), qr, qx0, negm, kf_, qx_); } while (0)
#define ATT_MASK(C0, C1, t) do { const int kbq_ = 64 * ((t) - (NT - 4)) + 4 * hi; \
        _Pragma("unroll") for (int r = 0; r < 16; ++r) { const int kv_ = kbq_ + (r & 3) + 8 * (r >> 2); if (kv_ > qrel) C0[r] = -INFINITY; if (kv_ + 32 > qrel) C1[r] = -INFINITY; } } while (0)
#define ATT_DECIDE(C0, C1, FIRST) do { \
        float a_ = fmaxf(fmaxf(C0[0], C0[1]), C1[0]), b_ = fmaxf(fmaxf(C0[2], C0[3]), C1[1]); a_ = fmaxf(fmaxf(a_, C1[2]), C1[3]); \
        _Pragma("unroll") for (int r = 4; r < 16; r += 4) { a_ = fmaxf(fmaxf(a_, C0[r]), C0[r + 1]); b_ = fmaxf(fmaxf(b_, C0[r + 2]), C0[r + 3]); a_ = fmaxf(fmaxf(a_, C1[r]), C1[r + 1]); b_ = fmaxf(fmaxf(b_, C1[r + 2]), C1[r + 3]); } \
        float rm_ = fmaxf(a_, b_); { auto rr_ = __builtin_amdgcn_permlane32_swap(__float_as_uint(rm_), __float_as_uint(rm_), false, false); rm_ = fmaxf(__uint_as_float(rr_[0]), __uint_as_float(rr_[1])); } \
        resc = false; \
        if ((FIRST) || __any(rm_ > THRL)) { float dl_ = (FIRST) ? rm_ : fmaxf(rm_, 0.f); \
            if (!MLA) { const float nm_ = -(mhat + dl_); const unsigned h_ = cvtpk_s(nm_, 0.f) & 0xffffu; const float r1_ = nm_ - __uint_as_float(h_ << 16); const unsigned m_ = cvtpk_s(r1_, 0.f) & 0xffffu; \
                const float r2_ = r1_ - __uint_as_float(m_ << 16); const unsigned l_ = cvtpk_s(r2_, 0.f) & 0xffffu; \
                const float mn_ = -((__uint_as_float(h_ << 16) + __uint_as_float(m_ << 16)) + __uint_as_float(l_ << 16)); dl_ = mn_ - mhat; mhat = mn_; \
                if (hi == 0) qr[NQR - 1] = (bf16x8){one, one, one, (short)h_, (short)m_, (short)l_, 0, 0}; } \
            else { mhat += dl_; _Pragma("unroll") for (int r = 0; r < 16; ++r) negm[r] = -mhat; } \
            _Pragma("unroll") for (int r = 0; r < 16; ++r) { C0[r] -= dl_; C1[r] -= dl_; } \
            if (!(FIRST)) { const float f_ = __builtin_amdgcn_exp2f(-dl_); l_reg *= f_; if (hi == 0) wsf[r32] = f_; resc = true; } } } while (0)
#define ATT_RESC() do { if (resc) { \
        _Pragma("unroll") for (int i = 0; i < 4; ++i) { const f32x4 fv_ = *(const LAS3 f32x4*)(wsf + 8 * i + 4 * hi); \
            _Pragma("unroll") for (int d = 0; d < 2; ++d) { o[d][4 * i] *= fv_[0]; o[d][4 * i + 1] *= fv_[1]; o[d][4 * i + 2] *= fv_[2]; o[d][4 * i + 3] *= fv_[3]; } } } } while (0)
#define ATT_VS(tt) (vp0 + (((tt)) & 3) * VSLOT)
#define ATT_KS(tt) kb, ((((tt)) & 3) * KSLOT)
#ifndef ATT_STAGGER
#define ATT_STAGGER 0
#endif
    if (!ATT_STAGGER || wid < 4) {
#define ATT_STEP(t, MASKED) do { ATT_TOP(t); \
        ATT_QK(t); \
        if (!MLA && (MASKED)) ATT_MASK(C0, C1, t); \
        ATT_DECIDE(C0, C1, false); ATT_SBAR(); \
        phase_b<true, true>(C0, C1, o, ATT_VS((t) - 1), pw, l_reg); \
        ATT_RESC(); } while (0)
        ATT_TOP(t0);
        ATT_QK(t0);
        if (!MLA && wvis == t0) ATT_MASK(C0, C1, t0);
        ATT_DECIDE(C0, C1, true); ATT_SBAR();
        phase_b<true, false>(C0, C1, o, vp0, pw, l_reg);
        int t = t0 + 1;
        for (; t < wvis; ++t) ATT_STEP(t, false);
        if (t == wvis) { ATT_STEP(t, true); ++t; }
        { ATT_TOP(t); ATT_ISSUE(t); phase_b<false, true>(C0, C1, o, ATT_VS(t - 1), pw, l_reg); ++t; }
        for (; t <= NT + ATT_STAGGER; ++t) { ATT_TOP(t); ATT_ISSUE(t); }
#undef ATT_STEP
    } else {
        ATT_TOP(t0);
        ATT_QK(t0);
        ATT_DECIDE(C0, C1, true); ATT_SBAR();
        ATT_TOP(t0 + 1);
        phase_b<true, false>(C0, C1, o, vp0, pw, l_reg); ATT_SBAR();
        ATT_QK(t0 + 1);
        ATT_DECIDE(C0, C1, false); ATT_SBAR();
        int t = t0 + 2;
#define ATT_STEP2(t, MASKED) do { ATT_TOP(t); \
        phase_b<true, true>(C0, C1, o, ATT_VS((t) - 2), pw, l_reg); \
        ATT_RESC(); ATT_SBAR(); \
        ATT_QK(t); \
        if (!MLA && (MASKED)) ATT_MASK(C0, C1, t); \
        ATT_DECIDE(C0, C1, false); ATT_SBAR(); } while (0)
        for (; t < wvis; ++t) ATT_STEP2(t, false);
        ATT_STEP2(t, true); ++t;
        { ATT_TOP(t); ATT_ISSUE(t); phase_b<true, true>(C0, C1, o, ATT_VS(t - 2), pw, l_reg); ATT_RESC(); ++t; }
        { ATT_TOP(t); ATT_ISSUE(t); phase_b<false, true>(C0, C1, o, ATT_VS(t - 2), pw, l_reg); ++t; }
        for (; t <= NT + ATT_STAGGER; ++t) { ATT_TOP(t); ATT_ISSUE(t); }
#undef ATT_STEP2
    }
    { auto rr = __builtin_amdgcn_permlane32_swap(__float_as_uint(l_reg), __float_as_uint(l_reg), false, false); l_reg = __uint_as_float(rr[0]) + __uint_as_float(rr[1]); }
    if (hi == 0) wsf[32 + r32] = 1.0f / l_reg;
    float rli[16];
#pragma unroll
    for (int i = 0; i < 4; ++i) { const f32x4 fv = *(const LAS3 f32x4*)(wsf + 32 + 8 * i + 4 * hi); rli[4 * i] = fv[0]; rli[4 * i + 1] = fv[1]; rli[4 * i + 2] = fv[2]; rli[4 * i + 3] = fv[3]; }
    u16* Ow = s.o + (size_t)(q0 + wid * QBLK) * s.op;
    { LAS3 u16* stg = (LAS3 u16*)(shm + LDS_OST) + wid * 2048;
#pragma unroll
        for (int r = 0; r < 16; ++r) { const int orow = crow(r, hi);
#pragma unroll
            for (int d0 = 0; d0 < 2; ++d0) stg[orow * 64 + d0 * 32 + r32] = (u16)(cvtpk_s(o[d0][r] * rli[r], 0.f) & 0xffffu); }
        asm volatile("s_waitcnt lgkmcnt(0)" ::: "memory");
#pragma unroll
        for (int i = 0; i < 4; ++i) { const int row = i * 8 + (lane >> 3), ch = lane & 7; const u32x4 v = *(const LAS3 u32x4*)(stg + row * 64 + ch * 8); *(u32x4*)(Ow + (size_t)row * s.op + ch * 8) = v; } }
    asm volatile("s_waitcnt lgkmcnt(0)\n\ts_barrier" ::: "memory");
#undef ATT_DMA_K
#undef ATT_DMA_V
#undef ATT_TOP
#undef ATT_ISSUE
#undef ATT_QK
#undef ATT_MASK
#undef ATT_DECIDE
#undef ATT_RESC
#undef ATT_STEP
}
}

namespace cg = cooperative_groups;
#define LAS __attribute__((address_space(3)))
typedef unsigned short bf16;
typedef unsigned v4u __attribute__((ext_vector_type(4)));
typedef unsigned v2u __attribute__((ext_vector_type(2)));
typedef float f32x4 __attribute__((ext_vector_type(4)));
constexpr int NWAVES = 8;
constexpr int M = 16384, D = 1024, FF = 4096, NIN = 1960, NINP = 2048, QL = 256, KVL = 128, NQU = 768, NKVU = 1024;
constexpr float EPS = 1e-6f;
constexpr float LOG2E = 1.4426950408889634f;
constexpr float C2_FOX = 0.125f * LOG2E, C2_MLA = 0.10206207261596575f * LOG2E;
constexpr size_t MiB = 1u << 20;
constexpr size_t WS_WIN = 1 * MiB, WS_WQ = 5 * MiB, WS_WKV = 5 * MiB + 512 * 1024, WS_WO = 6 * MiB, WS_W1 = 8 * MiB, WS_W2 = 16 * MiB;
constexpr size_t WS_RT = 24 * MiB, WS_LF = 26 * MiB, WS_LC = 26 * MiB + 512 * 1024, WS_SS = 27 * MiB, WS_KR = 28 * MiB, WS_KB = 29 * MiB, WS_SSQ = 31 * MiB, WS_SSKV = 31 * MiB + 512 * 1024, WS_BIASF = 28 * MiB;
constexpr size_t WS_XN = 32 * MiB, WS_H = 64 * MiB, WS_P = 64 * MiB, WS_QM = 128 * MiB, WS_KVM = 152 * MiB, WS_QN = 184 * MiB, WS_O = 192 * MiB, WS_KVN = 224 * MiB, WS_END = 228 * MiB;
constexpr int RING_BYTES = 131072, LDS_BYTES = 147456;
static_assert(att::LDS_BYTES <= LDS_BYTES, "attention scratch fits the LDS allocation");

__device__ __forceinline__ unsigned f2bf(float f) { unsigned u = __builtin_bit_cast(unsigned, f); return (u + 0x7fffu + ((u >> 16) & 1u)) >> 16; }
__device__ __forceinline__ unsigned pk2(float lo, float hi) { return f2bf(lo) | (f2bf(hi) << 16); }
__device__ __forceinline__ float bf2f(unsigned short h) { return __builtin_bit_cast(float, (unsigned)h << 16); }
__device__ __forceinline__ float wave_sum(float v) {
#pragma unroll
    for (int o = 1; o < 64; o <<= 1) v += __shfl_xor(v, o);
    return v;
}
__device__ __forceinline__ int map_row(int mode, int n) {
    if (mode == 1) { const int h = n / 96, d = n % 96; if (d < 64) return n; const int i = d - 64; return h * 96 + (i < 16 ? 64 + 2 * i : 64 + 2 * (i - 16) + 1); }
    if (mode == 2) { const int h = n >> 7, j = n & 127; return j < 64 ? h * 64 + j : 512 + h * 64 + (j - 64); }
    if (mode == 3) { if (n < 1536 || n >= 1960) return n; if (n < 1544) return 1952 + (n - 1536); if (n < 1800) return 1536 + (n - 1544); if (n < 1928) return 1792 + (n - 1800);
        const int i = n - 1928; return 1920 + (i < 16 ? 2 * i : 2 * (i - 16) + 1); }
    return n;
}
__device__ __forceinline__ void p0_transpose_item(const float* W, int K, int N, int nblk, bf16* WT, int mode, const float* gk, LAS float* scr, int item, int lane) {
    const int kb = item / nblk, nb = item % nblk, k0 = 64 * kb, n0 = 32 * nb;
    const int nn = n0 + (lane & 31);
    float wv[32];
#pragma unroll
    for (int i = 0; i < 32; ++i) { const int kk = 2 * i + (lane >> 5); wv[i] = (nn < N) ? W[(size_t)(k0 + kk) * N + nn] : 0.f; }
    if (gk) {
#pragma unroll
        for (int i = 0; i < 32; ++i) wv[i] *= gk[k0 + 2 * i + (lane >> 5)]; }
#pragma unroll
    for (int i = 0; i < 32; ++i) { const int kk = 2 * i + (lane >> 5); scr[kk * 33 + (lane & 31)] = wv[i]; }
    asm volatile("s_waitcnt lgkmcnt(0)" ::: "memory");
    const int c = lane & 7;
#pragma unroll
    for (int j = 0; j < 4; ++j) { const int n = (lane >> 3) + 8 * j; const LAS float* sp = scr + (8 * c) * 33 + n;
        v4u o; o.x = pk2(sp[0 * 33], sp[1 * 33]); o.y = pk2(sp[2 * 33], sp[3 * 33]); o.z = pk2(sp[4 * 33], sp[5 * 33]); o.w = pk2(sp[6 * 33], sp[7 * 33]);
        *(v4u*)(WT + (size_t)map_row(mode, n0 + n) * K + k0 + 8 * c) = o; }
    asm volatile("s_waitcnt lgkmcnt(0)" ::: "memory");
}
__device__ __forceinline__ void sincos_d(double x, float& sn, float& cs) {
    const double k = rint(x * 0.63661977236758134308);
    double r = fma(-k, 1.57079632679489655800e+00, x); r = fma(-k, 6.12323399573676603587e-17, r);
    const double r2 = r * r;
    double s = -1.0 / 6227020800.0; s = s * r2 + 1.0 / 39916800.0; s = s * r2 - 1.0 / 362880.0; s = s * r2 + 1.0 / 5040.0; s = s * r2 - 1.0 / 120.0; s = s * r2 + 1.0 / 6.0; s = r - r * r2 * s;
    double c = 1.0 / 479001600.0; c = c * r2 - 1.0 / 3628800.0; c = c * r2 + 1.0 / 40320.0; c = c * r2 - 1.0 / 720.0; c = c * r2 + 1.0 / 24.0; c = c * r2 - 0.5; c = 1.0 + r2 * c;
    const int q = ((int)k) & 3;
    const double ss = (q == 0) ? s : (q == 1) ? c : (q == 2) ? -s : -c;
    const double cc = (q == 0) ? c : (q == 1) ? -s : (q == 2) ? -c : s;
    sn = (float)ss; cs = (float)cc;
}

#define RLX_AGENT __ATOMIC_RELAXED, __HIP_MEMORY_SCOPE_AGENT
#define XB_TMO      128
#define XB_XCNT(j)  (256  + 64 * (j))
#define XB_XSUB(j)  (1280 + 64 * (j))
#define XB_XGEN(j)  (2304 + 64 * (j))
#define XB_TOP      3328
#define XB_TOPGEN   3392
#define XCD_BAR_WORDS 3456
#define XB_SPIN_CAP (1u << 18)

__device__ __forceinline__ unsigned xb_ld(unsigned* p)              { return __hip_atomic_load(p, __ATOMIC_RELAXED, __HIP_MEMORY_SCOPE_AGENT); }
__device__ __forceinline__ unsigned xb_add(unsigned* p, unsigned v) { return __hip_atomic_fetch_add(p, v, __ATOMIC_RELAXED, __HIP_MEMORY_SCOPE_AGENT); }
__device__ __forceinline__ unsigned xb_xcc_id() { return (unsigned)__builtin_amdgcn_s_getreg((3 << 11) | 20) & 0xFu; }
#define XB_SPIN(cond, bar) do { unsigned _sp = 0; while (cond) { __builtin_amdgcn_s_sleep(1); \
    if ((++_sp & 255u) == 0u) { if (xb_ld(&(bar)[XB_TMO])) break; if (_sp > XB_SPIN_CAP) { atomicAdd(&(bar)[XB_TMO], 1u); break; } } } } while (0)

struct XcdBarrier {
    unsigned* bar; unsigned x;
    volatile LAS unsigned* st;
};

__device__ __forceinline__ XcdBarrier xcd_barrier_post(unsigned* bar, volatile LAS unsigned* st) {
    XcdBarrier b; b.bar = bar; b.x = xb_xcc_id(); b.st = st;
    if (threadIdx.x == 0) (void)xb_add(&bar[XB_XCNT(b.x)], 1u);
    return b;
}
__device__ __forceinline__ void xcd_barrier_complete(unsigned* bar, unsigned x, unsigned& nloc, unsigned& nx) {
    const unsigned G = gridDim.x * gridDim.y * gridDim.z;
    unsigned sum, cnt, mine, sp = 0u;
    for (;;) {
        sum = 0u; cnt = 0u; mine = 0u;
#pragma unroll
        for (unsigned j = 0; j < 16; ++j) { const unsigned c = xb_ld(&bar[XB_XCNT(j)]); sum += c; cnt += (c > 0u) ? 1u : 0u; mine = (j == x) ? c : mine; }
        if (sum == G) break;
        __builtin_amdgcn_s_sleep(1);
        if ((++sp & 255u) == 0u) { if (xb_ld(&bar[XB_TMO])) break; if (sp > XB_SPIN_CAP) { atomicAdd(&bar[XB_TMO], 1u); break; } }
    }
    nloc = mine > 0u ? mine : 1u; nx = cnt > 0u ? cnt : 1u;
}

__device__ __forceinline__ void xcd_barrier(const XcdBarrier& b) {
    asm volatile("s_waitcnt vmcnt(0)" ::: "memory");
    __syncthreads();
    if (threadIdx.x == 0) {
        unsigned* bar = b.bar;
        __builtin_amdgcn_s_waitcnt(0);
        unsigned nloc = b.st[0], nx = b.st[1];
        if (nloc == 0u) { xcd_barrier_complete(bar, b.x, nloc, nx); b.st[0] = nloc; b.st[1] = nx; }
        const unsigned old = xb_add(&bar[XB_XSUB(b.x)], 1u);
        const unsigned gen = old / nloc;
        if (old + 1u == (gen + 1u) * nloc) {
            __builtin_amdgcn_fence(__ATOMIC_RELEASE, "agent");
            asm volatile("s_waitcnt vmcnt(0)" ::: "memory");
            const unsigned og = xb_add(&bar[XB_TOP], 1u);
            const unsigned tg = og / nx;
            if (og + 1u == (tg + 1u) * nx) xb_add(&bar[XB_TOPGEN], 1u);
            else XB_SPIN(xb_ld(&bar[XB_TOPGEN]) == tg, bar);
            __builtin_amdgcn_fence(__ATOMIC_ACQUIRE, "agent");
            xb_add(&bar[XB_XGEN(b.x)], 1u);
            asm volatile("s_waitcnt vmcnt(0)" ::: "memory");
        } else {
            XB_SPIN(xb_ld(&bar[XB_XGEN(b.x)]) == gen, bar);
            __builtin_amdgcn_fence(__ATOMIC_ACQUIRE, "agent");
            asm volatile("s_waitcnt vmcnt(0)" ::: "memory");
        }
    }
    __syncthreads();
}

constexpr int MISC_OFF = LDS_BYTES - 128;
constexpr size_t WS_CTL = 0, CTL_ZERO_BYTES = 64 * 1024;
constexpr int CW_KMAX = 8192, CW_QF = 8192 + 512, CW_QM = 8192 + 1024, CW_PCNT = 8192 + 1536;
static_assert(att::LDS_BYTES <= MISC_OFF, "LDS map");
struct Args { const float* in[13]; float* out; unsigned char* ws; int ph_lo, ph_hi, dup, pad; };
constexpr int NPHASE = 8;

__global__ void __launch_bounds__(NWAVES * 64, 2) mk_fwd(Args args) {
    extern __shared__ __attribute__((aligned(16))) unsigned char lds_raw[];
    LAS unsigned char* lds = (LAS unsigned char*)lds_raw;
    const int G = gridDim.x, bx = blockIdx.x;
#define MK_IDS int tid = threadIdx.x; asm volatile("" : "+v"(tid)); const int lane = tid & 63, wave = __builtin_amdgcn_readfirstlane(tid >> 6); const int gw = vcu * NWAVES + wave; (void)gw; (void)lane;
    const int vcu = (G % 8 == 0) ? (bx % 8) * (G / 8) + bx / 8 : bx;
    const int NGW = G * NWAVES;
    unsigned char* ws = args.ws;
#define MKP_x ((const float*)args.in[0])
#define MKP_g_mix ((const float*)args.in[1])
#define MKP_w_in ((const float*)args.in[2])
#define MKP_b_f ((const float*)args.in[3])
#define MKP_g_q ((const float*)args.in[4])
#define MKP_w_q_up ((const float*)args.in[5])
#define MKP_g_kv ((const float*)args.in[6])
#define MKP_w_kv_up ((const float*)args.in[7])
#define MKP_w_o ((const float*)args.in[8])
#define MKP_g_mlp ((const float*)args.in[9])
#define MKP_w_ff1 ((const float*)args.in[10])
#define MKP_w_ff2 ((const float*)args.in[11])
#define MKP_g_final ((const float*)args.in[12])
#define MKP_out (args.out)
#define MKP_Win_t ((bf16*)(args.ws + WS_WIN))
#define MKP_Wq_t ((bf16*)(args.ws + WS_WQ))
#define MKP_Wkv_t ((bf16*)(args.ws + WS_WKV))
#define MKP_Wo_t ((bf16*)(args.ws + WS_WO))
#define MKP_W1_t ((bf16*)(args.ws + WS_W1))
#define MKP_W2_t ((bf16*)(args.ws + WS_W2))
#define MKP_RT ((float*)(args.ws + WS_RT))
#define MKP_LF ((float*)(args.ws + WS_LF))
#define MKP_SS ((float*)(args.ws + WS_SS))
#define MKP_SSQ ((float*)(args.ws + WS_SSQ))
#define MKP_BIASF ((float*)(args.ws + WS_BIASF))
#define MKP_SSKV ((float*)(args.ws + WS_SSKV))
#define MKP_KB ((bf16*)(args.ws + WS_KB))
#define MKP_KR ((bf16*)(args.ws + WS_KR))
#define MKP_XN ((bf16*)(args.ws + WS_XN))
#define MKP_HB ((bf16*)(args.ws + WS_H))
#define MKP_P ((bf16*)(args.ws + WS_P))
#define MKP_QM ((bf16*)(args.ws + WS_QM))
#define MKP_KVM ((bf16*)(args.ws + WS_KVM))
#define MKP_QN ((bf16*)(args.ws + WS_QN))
#define MKP_OB ((bf16*)(args.ws + WS_O))
#define MKP_KVN ((bf16*)(args.ws + WS_KVN))
    const int lo = args.ph_lo, hi = args.ph_hi;
#ifndef MK_MASK
#define MK_MASK 0x1ff
#endif
#define IN(k) (((MK_MASK >> (k)) & 1) && lo <= (k) && (k) < hi)
#define REP(k) for (int rep_ = 0; rep_ < ((args.dup == (k)) ? 2 : 1); ++rep_)
    { volatile LAS unsigned* misc = (volatile LAS unsigned*)(lds + MISC_OFF); if (threadIdx.x < 32) misc[threadIdx.x] = 0u; }
    __syncthreads();
    (void)xcd_barrier_post((unsigned*)(ws + WS_CTL), (volatile LAS unsigned*)(lds + MISC_OFF) + 8);
    if (args.ph_lo < 0) cg::this_grid().sync();
#ifdef TS_PHASE
    unsigned long long ts_a_ = 0, ts_b_ = 0;
#define TS_BEGIN(k) do { if ((k) == TS_PHASE) ts_a_ = __builtin_amdgcn_s_memrealtime(); } while (0)
#define TS_END(k) do { if ((k) == TS_PHASE) ts_b_ = __builtin_amdgcn_s_memrealtime(); } while (0)
#else
#define TS_BEGIN(k)
#define TS_END(k)
#endif
#define SEAM(k) do { if (IN(k) && IN((k) + 1)) { XcdBarrier b_; b_.bar = (unsigned*)(args.ws + WS_CTL); b_.x = xb_xcc_id(); b_.st = (volatile LAS unsigned*)(lds + MISC_OFF) + 8; xcd_barrier(b_); } } while (0)

    TS_BEGIN(0);
    if (IN(0)) { MK_IDS
        LAS float* scr = (LAS float*)(lds + wave * 16384);
        constexpr int I_IN = (D / 64) * (NINP / 32), I_Q = (QL / 64) * (NQU / 32), I_KV = (KVL / 64) * (NKVU / 32), I_O = (D / 64) * (D / 32), I_1 = (D / 64) * (FF / 32), I_2 = (FF / 64) * (D / 32);
        constexpr int NITEMS = I_IN + I_Q + I_KV + I_O + I_1 + I_2;
        for (int it = gw; it < NITEMS; it += NGW) {
            int r = it;
            if (r < I_IN) { p0_transpose_item(MKP_w_in, D, NIN, NINP / 32, MKP_Win_t, 3, nullptr, scr, r, lane); continue; } r -= I_IN;
            if (r < I_Q) { p0_transpose_item(MKP_w_q_up, QL, NQU, NQU / 32, MKP_Wq_t, 1, MKP_g_q, scr, r, lane); continue; } r -= I_Q;
            if (r < I_KV) { p0_transpose_item(MKP_w_kv_up, KVL, NKVU, NKVU / 32, MKP_Wkv_t, 2, MKP_g_kv, scr, r, lane); continue; } r -= I_KV;
            if (r < I_O) { p0_transpose_item(MKP_w_o, D, D, D / 32, MKP_Wo_t, 0, nullptr, scr, r, lane); continue; } r -= I_O;
            if (r < I_1) { p0_transpose_item(MKP_w_ff1, D, FF, FF / 32, MKP_W1_t, 0, MKP_g_mlp, scr, r, lane); continue; } r -= I_1;
            p0_transpose_item(MKP_w_ff2, FF, D, D / 32, MKP_W2_t, 0, nullptr, scr, r, lane);
        }
        for (int m0 = gw; m0 < M; m0 += 4 * NGW) {
            const f32x4* gr = (const f32x4*)MKP_g_mix + lane; f32x4 v[4][4]; float s2[4];
#pragma unroll
            for (int r = 0; r < 4; ++r) { const int m = m0 + r * NGW; const f32x4* xr = (const f32x4*)(MKP_x + (size_t)(m < M ? m : 0) * D) + lane;
#pragma unroll
                for (int j = 0; j < 4; ++j) v[r][j] = xr[64 * j]; }
#pragma unroll
            for (int r = 0; r < 4; ++r) { s2[r] = 0.f;
#pragma unroll
                for (int j = 0; j < 4; ++j) s2[r] += (v[r][j].x * v[r][j].x + v[r][j].y * v[r][j].y) + (v[r][j].z * v[r][j].z + v[r][j].w * v[r][j].w);
                s2[r] = 1.f / sqrtf(wave_sum(s2[r]) * (1.f / D) + EPS); }
#pragma unroll
            for (int r = 0; r < 4; ++r) { const int m = m0 + r * NGW; if (m < M) { unsigned long long* o8 = (unsigned long long*)(MKP_XN + (size_t)m * D) + lane; const float rstd = s2[r];
#pragma unroll
                for (int j = 0; j < 4; ++j) { const f32x4 g = gr[64 * j]; o8[64 * j] = (unsigned long long)pk2(v[r][j].x * rstd * g.x, v[r][j].y * rstd * g.y) | ((unsigned long long)pk2(v[r][j].z * rstd * g.z, v[r][j].w * rstd * g.w) << 32); } } }
        }
        for (int e = (vcu * NWAVES * 64 + tid); e < M * 16; e += G * NWAVES * 64) {
            const int m = e >> 4, i = e & 15; double inv = 1.0; for (int j = 0; j < i; ++j) inv *= 0.56234132519034908039;
            float sn, cs; sincos_d((double)m * inv, sn, cs); MKP_RT[2 * e] = cs; MKP_RT[2 * e + 1] = sn;
        }
    }
    SEAM(0);
    TS_END(0);
    TS_BEGIN(1);
    if (IN(1)) {
        pg8::Gemm g{MKP_XN, MKP_Win_t, M, NINP, D}; pg8::StaticOrder S; S.init(M, NINP, G, bx);
        pg8::EpiIn E{MKP_P, NINP, C2_FOX, MKP_SSQ, MKP_SSKV, MKP_RT, MKP_b_f, MKP_LF, M};
        pg8::gemm_phase<pg8::EpiIn, pg8::StaticOrder, PG8_ALIGN, PG8_SP2>(lds, g, S, E);
    }
    SEAM(1);
    TS_END(1);
    TS_BEGIN(3);
    if (IN(3)) { MK_IDS
        if (wave < 2) { const int job = bx + 256 * wave;
            if (job < 512 && bx < 256) { const int h = job >> 6, ti = job & 63; const f32x4* lf4 = (const f32x4*)(MKP_LF + (size_t)h * M);
                float pre = 0.f; { int j = 0; float pa[8] = {0.f, 0.f, 0.f, 0.f, 0.f, 0.f, 0.f, 0.f};
                    for (; j + 8 <= ti; j += 8) { f32x4 w[8];
#pragma unroll
                        for (int u = 0; u < 8; ++u) w[u] = lf4[(j + u) * 64 + lane];
#pragma unroll
                        for (int u = 0; u < 8; ++u) pa[u] += (w[u].x + w[u].y) + (w[u].z + w[u].w); }
                    for (; j < ti; ++j) { const f32x4 w = lf4[j * 64 + lane]; pa[0] += (w.x + w.y) + (w.z + w.w); }
                    pre = ((pa[0] + pa[1]) + (pa[2] + pa[3])) + ((pa[4] + pa[5]) + (pa[6] + pa[7])); }
                pre = wave_sum(pre);
                const f32x4 v = lf4[ti * 64 + lane];
                const float s1 = v.x, s2 = s1 + v.y, s3 = s2 + v.z, s4 = s3 + v.w; float inc = s4;
#pragma unroll
                for (int o = 1; o < 64; o <<= 1) { const float n = __shfl_up(inc, o); if (lane >= o) inc += n; }
                const float ex = pre + (inc - s4); const float cs[4] = {ex + s1, ex + s2, ex + s3, ex + s4};
                *(f32x4*)(MKP_BIASF + (size_t)h * M + ti * 256 + 4 * lane) = (f32x4){-cs[0] * LOG2E, -cs[1] * LOG2E, -cs[2] * LOG2E, -cs[3] * LOG2E};
                { float km = 0.f;
                  for (int e = 0; e < 4; ++e) { const v4u* kr = (const v4u*)(MKP_P + (size_t)(ti * 256 + 4 * lane + e) * NINP + 512 + h * 64); float a2 = 0.f;
#pragma unroll
                      for (int c8 = 0; c8 < 8; ++c8) { const v4u w = kr[c8]; const unsigned ww[4] = {w.x, w.y, w.z, w.w};
#pragma unroll
                          for (int q4 = 0; q4 < 4; ++q4) { const float lo_ = __builtin_bit_cast(float, ww[q4] << 16), hi_ = __builtin_bit_cast(float, ww[q4] & 0xffff0000u); a2 += lo_ * lo_ + hi_ * hi_; } }
                      km = fmaxf(km, a2); }
#pragma unroll
                  for (int o = 32; o >= 1; o >>= 1) km = fmaxf(km, __shfl_xor(km, o));
                  if (lane == 0) atomicMax((unsigned*)(args.ws + WS_CTL) + CW_KMAX + 64 * h, __builtin_bit_cast(unsigned, km)); }
#pragma unroll
                for (int e = 0; e < 4; ++e) { const float b = -cs[e] * LOG2E; const unsigned bh = f2bf(b); const float r1 = b - __builtin_bit_cast(float, bh << 16); const unsigned bm = f2bf(r1);
                    const float r2 = r1 - __builtin_bit_cast(float, bm << 16); const unsigned bl = f2bf(r2);
                    *(v4u*)(MKP_KB + ((size_t)h * M + ti * 256 + 4 * lane + e) * 8) = (v4u){bh | (bm << 16), bl | 0x3F800000u, 0x3F803F80u, 0u}; } } }
        { int kq = QL; asm volatile("" : "+s"(kq)); pg8::Gemm g{MKP_P + 1536, MKP_Wq_t, M, NQU, kq, NINP}; pg8::StaticOrder S; S.init(M, NQU, G, bx);
          pg8::EpiQm E{MKP_QM, NQU, MKP_RT, C2_MLA, MKP_SSQ, EPS};
          pg8::gemm_phase<pg8::EpiQm, pg8::StaticOrder, PG8_ALIGN, PG8_SP2>(lds, g, S, E); }
        { int kkv = KVL; asm volatile("" : "+s"(kkv)); pg8::Gemm g{MKP_P + 1792, MKP_Wkv_t, M, NKVU, kkv, NINP}; pg8::StaticOrder S; S.init(M, NKVU, G, bx);
          pg8::EpiKv E{MKP_KVM, NKVU, MKP_SSKV, EPS};
          pg8::gemm_phase<pg8::EpiKv, pg8::StaticOrder, PG8_ALIGN, PG8_SP2>(lds, g, S, E); }
    }
    SEAM(3);
    TS_END(3);
    TS_BEGIN(4);
    if (IN(4)) {
        const int v = (G == 256) ? vcu : bx; const int h0 = (v >> 5) & 7;
#ifdef ATT_PRIO
        if ((threadIdx.x >> 6) >= 4) __builtin_amdgcn_s_setprio(1);
#endif
        volatile LAS unsigned* misc = (volatile LAS unsigned*)(lds + MISC_OFF);
        unsigned* ctlw = (unsigned*)(args.ws + WS_CTL);
#ifndef PROBE_FOX
#define PROBE_FOX 1
#endif
#ifndef PROBE_MLA
#define PROBE_MLA 1
#endif
        for (int rep = 0; rep < PROBE_FOX; ++rep)
        for (int k = 0; k < 8; ++k) { const int h = (h0 + k) & 7;
            const float kmax2 = __builtin_bit_cast(float, __hip_atomic_load(ctlw + CW_KMAX + 64 * h, __ATOMIC_RELAXED, __HIP_MEMORY_SCOPE_AGENT));
            att::Src s{MKP_P + h * 64, NINP, MKP_P + 512 + h * 64, NINP, MKP_KB + (size_t)h * M * 8, 8, MKP_P + 1024 + h * 64, NINP, MKP_OB + h * 64, D};
            for (;;) {
                if (threadIdx.x == 0) misc[0] = __hip_atomic_fetch_add(ctlw + CW_QF + 64 * h + 16 * rep, 1u, __ATOMIC_RELAXED, __HIP_MEMORY_SCOPE_AGENT);
                __syncthreads(); const unsigned i = misc[0]; __syncthreads();
                if (i >= 64u) break;
                att::attn_unit<false>(63 - (int)i, s, lds, MKP_BIASF + (size_t)h * M, kmax2);
            } }
        asm volatile("" ::: "memory");
        for (int rep = 0; rep < PROBE_MLA; ++rep)
        for (int k = 0; k < 8; ++k) { const int h = (h0 + k) & 7;
            att::Src s{MKP_QM + h * 96, NQU, MKP_KVM + h * 64, NKVU, MKP_P + 1920, NINP, MKP_KVM + 512 + h * 64, NKVU, MKP_OB + 512 + h * 64, D};
            for (;;) {
                if (threadIdx.x == 0) misc[0] = __hip_atomic_fetch_add(ctlw + CW_QM + 64 * h + 16 * rep, 1u, __ATOMIC_RELAXED, __HIP_MEMORY_SCOPE_AGENT);
                __syncthreads(); const unsigned i = misc[0]; __syncthreads();
                if (i >= 64u) break;
                att::attn_unit<true>(63 - (int)i, s, lds, nullptr, 0.f);
            } }
    }
#ifdef ATT_PRIO
    __builtin_amdgcn_s_setprio(0);
#endif
    SEAM(4);
    TS_END(4);
    TS_BEGIN(5);
    if (IN(5)) {
        pg8::Gemm g{MKP_OB, MKP_Wo_t, M, D, D}; pg8::StaticOrder S; S.init(M, D, G, bx);
        pg8::EpiRes E{MKP_x, MKP_out, D, MKP_XN, MKP_SS};
        pg8::gemm_phase<pg8::EpiRes, pg8::StaticOrder, PG8_ALIGN, PG8_SP2>(lds, g, S, E);
    }
    SEAM(5);
    TS_END(5);
    TS_BEGIN(6);
    if (IN(6)) {
        pg8::Gemm g{MKP_XN, MKP_W1_t, M, FF, D}; pg8::StaticOrder S; S.init(M, FF, G, bx);
        pg8::EpiSqRelu E{MKP_HB, FF, MKP_SS, EPS, 1.f / D};
        pg8::gemm_phase<pg8::EpiSqRelu, pg8::StaticOrder, PG8_ALIGN, PG8_SP2>(lds, g, S, E);
    }
    SEAM(6);
    TS_END(6);
    TS_BEGIN(7);
    if (IN(7)) {
        pg8::Gemm g{MKP_HB, MKP_W2_t, M, D, FF}; pg8::StaticOrder S; S.init(M, D, G, bx);
        pg8::EpiResNorm E{MKP_out, MKP_out, D, MKP_g_final, MKP_SSQ, (unsigned*)(args.ws + WS_CTL) + CW_PCNT, EPS, 1.f / D};
        pg8::gemm_phase<pg8::EpiResNorm, pg8::StaticOrder, false, PG8_SP2>(lds, g, S, E);
    }
#ifdef TS_PHASE
    { XcdBarrier b_; b_.bar = (unsigned*)(args.ws + WS_CTL); b_.x = xb_xcc_id(); b_.st = (volatile LAS unsigned*)(lds + MISC_OFF) + 8; xcd_barrier(b_); }
    TS_END(7);
    if (blockIdx.x == 0 && threadIdx.x == 0) MKP_out[0] = (float)(((ts_b_ - ts_a_) / TS_Q) * (TS_Q / 100ull));
#endif
#undef IN
#undef SEAM
#undef MKP_x
#undef MKP_g_mix
#undef MKP_w_in
#undef MKP_b_f
#undef MKP_g_q
#undef MKP_w_q_up
#undef MKP_g_kv
#undef MKP_w_kv_up
#undef MKP_w_o
#undef MKP_g_mlp
#undef MKP_w_ff1
#undef MKP_w_ff2
#undef MKP_g_final
#undef MKP_out
#undef MKP_Win_t
#undef MKP_Wq_t
#undef MKP_Wkv_t
#undef MKP_Wo_t
#undef MKP_W1_t
#undef MKP_W2_t
#undef MKP_RT
#undef MKP_LF
#undef MKP_SS
#undef MKP_SSQ
#undef MKP_BIASF
#undef MKP_SSKV
#undef MKP_KB
#undef MKP_KR
#undef MKP_XN
#undef MKP_HB
#undef MKP_P
#undef MKP_QM
#undef MKP_KVM
#undef MKP_QN
#undef MKP_OB
#undef MKP_KVN
}

#ifndef MK_ONE_LAUNCH
#define MK_ONE_LAUNCH 1
#endif
extern "C" void kernel_launch(void* const* d_in, const int* in_sizes, int n_in, void* d_out, int out_size, void* d_ws, size_t ws_size, hipStream_t stream) {
    static int ready = 0;
    if (ready == 0) {
        if (n_in != 13 || in_sizes[0] != M * D || out_size != M * D || ws_size < WS_END) { fprintf(stderr, "kernel_launch: unexpected shapes (n_in %d, in0 %d, out %d, ws %zu)\n", n_in, n_in > 0 ? in_sizes[0] : -1, out_size, ws_size); ready = -1; return; }
        if (hipFuncSetAttribute((const void*)mk_fwd, hipFuncAttributeMaxDynamicSharedMemorySize, LDS_BYTES) != hipSuccess) { fprintf(stderr, "kernel_launch: hipFuncSetAttribute failed\n"); ready = -1; return; }
        ready = 1;
    }
    if (ready < 0) return;
    if (hipMemsetAsync((char*)d_ws + WS_CTL, 0, CTL_ZERO_BYTES, stream) != hipSuccess) { fprintf(stderr, "kernel_launch: hipMemsetAsync failed\n"); return; }
    Args a{};
    for (int i = 0; i < 13; ++i) a.in[i] = (const float*)d_in[i];
    a.out = (float*)d_out; a.ws = (unsigned char*)d_ws;
#ifndef MK_DUP
#define MK_DUP -1
#endif
    a.dup = MK_DUP;
    const int grid = 256;
#if MK_ONE_LAUNCH
    a.ph_lo = 0; a.ph_hi = NPHASE;
    void* kargs[] = {&a};
    hipError_t e = hipLaunchCooperativeKernel((const void*)mk_fwd, dim3(grid), dim3(NWAVES * 64), kargs, LDS_BYTES, stream);
    if (e != hipSuccess) fprintf(stderr, "kernel_launch: cooperative launch failed: %s\n", hipGetErrorString(e));
#else
    for (int p = 0; p < NPHASE; ++p) { a.ph_lo = p; a.ph_hi = p + 1; hipLaunchKernelGGL(mk_fwd, dim3(grid), dim3(NWAVES * 64), LDS_BYTES, stream, a); }
#endif
}
```

```cpp
#include <hip/hip_runtime.h>
#include <hip/hip_cooperative_groups.h>
#include <hip/hip_bf16.h>
#include <cstdio>
#include <cstdint>
#include <cmath>
namespace pg8 {
#define PG8_LAS __attribute__((address_space(3)))
typedef unsigned short bf16_t;
typedef short bf16x8 __attribute__((ext_vector_type(8)));
typedef float f32x4 __attribute__((ext_vector_type(4)));
typedef unsigned u32x4 __attribute__((ext_vector_type(4)));
constexpr int BM = 256, BK = 64, HALF = 128, HTB = HALF * BK * 2  , STAGE_BYTES = 8 * HTB, NXCD = 8, WGM = 8;

__host__ __device__ __forceinline__ int lds_byte(int r, int c) { const int st = (r >> 4) * 2 + (c >> 5), rr = r & 15, cc = c & 31, ob = rr * 64 + cc * 2; return st * 1024 + (ob ^ (((ob >> 9) & 1) << 5)); }
__host__ __device__ __forceinline__ void stage_rc(int b, int& R, int& C) { const int st = b / 1024, sb = b % 1024, swz = sb ^ (((sb >> 9) & 1) << 5); R = (st >> 1) * 16 + swz / 64; C = (st & 1) * 32 + (swz % 64) / 2; }
__host__ __device__ __forceinline__ int perm32(int rho) { const int n = rho >> 4, i = rho & 15; return 8 * (i >> 2) + 4 * n + (i & 3); }

struct Unit { int pm, pn; };
struct Gemm { const bf16_t* A; const bf16_t* Bt; int M, N, K; int lda; };

struct StaticOrder {
    int nM, nN, nwg, G, c;
    __host__ __device__ void init(int M, int N, int G_, int c_) { nM = M / BM; nN = N / BM; nwg = nM * nN; G = G_; c = c_; }
    __host__ __device__ bool next(int i, Unit& u) const {
        const long L = (long)i * G + c; if (L >= nwg) return false;
        int wgid = (int)L; { const int q = nwg / NXCD, r = nwg % NXCD, xcd = wgid % NXCD, off = wgid / NXCD; wgid = (xcd < r ? xcd * (q + 1) : r * (q + 1) + (xcd - r) * q) + off; }
        const int nig = WGM * nN, gid = wgid / nig, fm = gid * WGM, gsz = (nM - fm) < WGM ? (nM - fm) : WGM;
        u.pm = fm + ((wgid % nig) % gsz); u.pn = (wgid % nig) / gsz; return true;
    }
    __device__ __forceinline__ void a_ready(const Unit&) const {}
    __device__ __forceinline__ void done(const Unit&) const {}
};

__device__ __forceinline__ unsigned cvt_pk_bf16(float lo, float hi) { unsigned r; asm volatile("v_cvt_pk_bf16_f32 %0, %1, %2" : "=v"(r) : "v"(lo), "v"(hi)); return r; }
typedef float f32x2 __attribute__((ext_vector_type(2)));
__device__ __forceinline__ f32x2 gelu_pk(f32x2 v) {
    const f32x2 av = __builtin_elementwise_abs(v), d = av * 0.2316418882f + 1.0f;
    f32x2 t; t.x = __builtin_amdgcn_rcpf(d.x); t.y = __builtin_amdgcn_rcpf(d.y);
    f32x2 q = t * 0.5307027145f + (-0.7265760135f); q = q * t + 0.7107068705f; q = q * t + (-0.142248368f); q = q * t + 0.127414796f; q = q * t;
    const f32x2 s = (v * v) * (-0.72134752044f);
    f32x2 e; e.x = __builtin_amdgcn_exp2f(s.x); e.y = __builtin_amdgcn_exp2f(s.y);
    const f32x2 m = v * (q * e), r = v - m;
    f32x2 o; o.x = v.x < 0.f ? m.x : r.x; o.y = v.y < 0.f ? m.y : r.y; return o;
}

template <int ACT  > struct EpiBf16 {
    static constexpr bool PERM = true, AFTER_DRAIN = false; static_assert(ACT == 0 || ACT == 1, "EpiBf16: ACT is 0 (none) or 1 (gelu_pk)");
    bf16_t* O; int ldc; const float* bias; int split_cols; size_t split_stride; float scale0;
    __device__ __forceinline__ void operator()(const f32x4 (&acc)[2][2][4][2], const Unit& u, int wr, int wc, int fr, int fq) const {
        const int row0 = u.pm * BM + wr * 64 + fr; int colt = u.pn * BM; bf16_t* base = O;
        float sc = 1.f; if (split_cols) { const int t = colt / split_cols; base += (size_t)t * split_stride; colt -= t * split_cols; if (t == 0) sc = scale0; }
        const int col0 = colt + wc * 32 + 8 * fq, bcol0 = u.pn * BM + wc * 32 + 8 * fq;
        f32x4 bv[2][2];
#pragma unroll
        for (int bj = 0; bj < 2; ++bj)
#pragma unroll
            for (int n = 0; n < 2; ++n) bv[bj][n] = bias ? *(const f32x4*)(bias + bcol0 + bj * HALF + 4 * n) : (f32x4){0.f, 0.f, 0.f, 0.f};
#pragma unroll
        for (int ai = 0; ai < 2; ++ai)
#pragma unroll
            for (int m = 0; m < 4; ++m) { bf16_t* rowp = base + (size_t)(row0 + ai * HALF + m * 16) * ldc + col0;
#pragma unroll
                for (int bj = 0; bj < 2; ++bj) { f32x4 v0 = acc[ai][bj][m][0] + bv[bj][0], v1 = acc[ai][bj][m][1] + bv[bj][1];
                    if (ACT == 1) { f32x2 a = gelu_pk((f32x2){v0[0], v0[1]}), b = gelu_pk((f32x2){v0[2], v0[3]}), c = gelu_pk((f32x2){v1[0], v1[1]}), d = gelu_pk((f32x2){v1[2], v1[3]});
                        v0 = (f32x4){a.x, a.y, b.x, b.y}; v1 = (f32x4){c.x, c.y, d.x, d.y}; }
                    v0 = v0 * sc; v1 = v1 * sc; u32x4 w; w.x = cvt_pk_bf16(v0[0], v0[1]); w.y = cvt_pk_bf16(v0[2], v0[3]); w.z = cvt_pk_bf16(v1[0], v1[1]); w.w = cvt_pk_bf16(v1[2], v1[3]);
                    *(u32x4*)(rowp + bj * HALF) = w; } }
    }
};

struct EpiQm {
    static constexpr bool PERM = true, AFTER_DRAIN = false;
    bf16_t* O; int ldc; const float* rt; float scale; const float* ssq; float eps;
    __device__ __forceinline__ void operator()(const f32x4 (&acc)[2][2][4][2], const Unit& u, int wr, int wc, int fr, int fq) const {
        const int row0 = u.pm * BM + wr * 64 + fr, col0 = u.pn * BM + wc * 32 + 8 * fq;
#pragma unroll
        for (int ai = 0; ai < 2; ++ai)
#pragma unroll
            for (int m = 0; m < 4; ++m) { const int row = row0 + ai * HALF + m * 16;
                const f32x4 sq = *(const f32x4*)(ssq + (size_t)row * 4); const float rs = scale / sqrtf(((sq[0] + sq[1]) + (sq[2] + sq[3])) * (1.0f / 256.0f) + eps);
#pragma unroll
                for (int bj = 0; bj < 2; ++bj) { const int c = col0 + bj * HALF, d = c % 96;
                    f32x4 v0 = acc[ai][bj][m][0], v1 = acc[ai][bj][m][1];
                    if (d >= 64) { const f32x4* t = (const f32x4*)(rt + (size_t)row * 32 + (d - 64)); const f32x4 t0 = t[0], t1 = t[1];
                        f32x4 w0, w1;
                        w0[0] = v0[0] * t0[0] - v0[1] * t0[1]; w0[1] = v0[1] * t0[0] + v0[0] * t0[1];
                        w0[2] = v0[2] * t0[2] - v0[3] * t0[3]; w0[3] = v0[3] * t0[2] + v0[2] * t0[3];
                        w1[0] = v1[0] * t1[0] - v1[1] * t1[1]; w1[1] = v1[1] * t1[0] + v1[0] * t1[1];
                        w1[2] = v1[2] * t1[2] - v1[3] * t1[3]; w1[3] = v1[3] * t1[2] + v1[2] * t1[3];
                        v0 = w0; v1 = w1; }
                    v0 = v0 * rs; v1 = v1 * rs; u32x4 w; w.x = cvt_pk_bf16(v0[0], v0[1]); w.y = cvt_pk_bf16(v0[2], v0[3]); w.z = cvt_pk_bf16(v1[0], v1[1]); w.w = cvt_pk_bf16(v1[2], v1[3]);
                    *(u32x4*)(O + (size_t)row * ldc + c) = w; }
                asm volatile("" ::: "memory"); }
    }
};

struct EpiKv {
    static constexpr bool PERM = true, AFTER_DRAIN = false;
    bf16_t* O; int ldc; const float* ssq; float eps;
    __device__ __forceinline__ void operator()(const f32x4 (&acc)[2][2][4][2], const Unit& u, int wr, int wc, int fr, int fq) const {
        const int row0 = u.pm * BM + wr * 64 + fr, col0 = u.pn * BM + wc * 32 + 8 * fq;
#pragma unroll
        for (int ai = 0; ai < 2; ++ai)
#pragma unroll
            for (int m = 0; m < 4; ++m) { const int row = row0 + ai * HALF + m * 16;
                const f32x4 sq = *(const f32x4*)(ssq + (size_t)row * 4); const float rs = 1.0f / sqrtf(((sq[0] + sq[1]) + (sq[2] + sq[3])) * (1.0f / 128.0f) + eps);
#pragma unroll
                for (int bj = 0; bj < 2; ++bj) { const f32x4 v0 = acc[ai][bj][m][0] * rs, v1 = acc[ai][bj][m][1] * rs;
                    u32x4 w; w.x = cvt_pk_bf16(v0[0], v0[1]); w.y = cvt_pk_bf16(v0[2], v0[3]); w.z = cvt_pk_bf16(v1[0], v1[1]); w.w = cvt_pk_bf16(v1[2], v1[3]);
                    *(u32x4*)(O + (size_t)row * ldc + col0 + bj * HALF) = w; }
                asm volatile("" ::: "memory"); }
    }
};
struct EpiIn {
    static constexpr bool PERM = true, AFTER_DRAIN = false;
    bf16_t* O; int ldc; float scale0; float* ssq; float* sskv; const float* rt; const float* bf; float* lf; int nrows;
    __device__ __forceinline__ void operator()(const f32x4 (&acc)[2][2][4][2], const Unit& u, int wr, int wc, int fr, int fq) const {
        const int row0 = u.pm * BM + wr * 64 + fr, col0 = u.pn * BM + wc * 32 + 8 * fq; const int pn = u.pn;
        const float sc = pn < 2 ? scale0 : 1.f;
#pragma unroll
        for (int ai = 0; ai < 2; ++ai)
#pragma unroll
            for (int m = 0; m < 4; ++m) { const int row = row0 + ai * HALF + m * 16; bf16_t* rowp = O + (size_t)row * ldc + col0; float s0 = 0.f, s1 = 0.f;
#pragma unroll
                for (int bj = 0; bj < 2; ++bj) { f32x4 v0 = acc[ai][bj][m][0] * sc, v1 = acc[ai][bj][m][1] * sc;
                    const float sq = ((v0[0] * v0[0] + v0[1] * v0[1]) + (v0[2] * v0[2] + v0[3] * v0[3])) + ((v1[0] * v1[0] + v1[1] * v1[1]) + (v1[2] * v1[2] + v1[3] * v1[3]));
                    if (bj == 0) s0 = sq; else s1 = sq;
                    bool store = true;
                    if (pn == 7 && bj == 1) { store = (wc == 0);
                        if (wc == 0) { const f32x4* t = (const f32x4*)(rt + (size_t)row * 32 + 8 * fq); const f32x4 t0 = t[0], t1 = t[1]; f32x4 w0, w1;
                            w0[0] = v0[0] * t0[0] - v0[1] * t0[1]; w0[1] = v0[1] * t0[0] + v0[0] * t0[1];
                            w0[2] = v0[2] * t0[2] - v0[3] * t0[3]; w0[3] = v0[3] * t0[2] + v0[2] * t0[3];
                            w1[0] = v1[0] * t1[0] - v1[1] * t1[1]; w1[1] = v1[1] * t1[0] + v1[0] * t1[1];
                            w1[2] = v1[2] * t1[2] - v1[3] * t1[3]; w1[3] = v1[3] * t1[2] + v1[2] * t1[3];
                            v0 = w0; v1 = w1; }
                        else if (wc == 1 && fq == 0) {
#pragma unroll
                            for (int e = 0; e < 8; ++e) { const float z = (e < 4 ? v0[e & 3] : v1[e & 3]) + bf[e]; lf[(size_t)e * nrows + row] = fminf(z, 0.f) - 0.6931471805599453f * __builtin_amdgcn_logf(1.0f + __builtin_amdgcn_exp2f(-1.4426950408889634f * fabsf(z))); } } }
                    if (store) { u32x4 w; w.x = cvt_pk_bf16(v0[0], v0[1]); w.y = cvt_pk_bf16(v0[2], v0[3]); w.z = cvt_pk_bf16(v1[0], v1[1]); w.w = cvt_pk_bf16(v1[2], v1[3]);
                        *(u32x4*)(rowp + bj * HALF) = w; } }
                if (pn == 6) { float s = s0 + s1; s += __shfl_xor(s, 16); s += __shfl_xor(s, 32); if (fq == 0) ssq[(size_t)row * 4 + wc] = s; }
                if (pn == 7) { float s = s0; s += __shfl_xor(s, 16); s += __shfl_xor(s, 32); if (fq == 0) sskv[(size_t)row * 4 + wc] = s; }
                asm volatile("" ::: "memory"); }
    }
};
struct EpiRes {
    static constexpr bool PERM = false, AFTER_DRAIN = false;
    const float* base; float* out; int ldc; bf16_t* ob; float* ss;
    __device__ __forceinline__ void operator()(const f32x4 (&acc)[2][2][4][2], const Unit& u, int wr, int wc, int fr, int fq) const {
        typedef unsigned u32x2v __attribute__((ext_vector_type(2)));
        const int row0 = u.pm * BM + wr * 64 + fr, col0 = u.pn * BM + wc * 32 + 4 * fq;
#pragma unroll
        for (int ai = 0; ai < 2; ++ai)
#pragma unroll
            for (int m = 0; m < 4; ++m) { const int row = row0 + ai * HALF + m * 16; const size_t off = (size_t)row * ldc + col0; float s = 0.f;
#pragma unroll
                for (int bj = 0; bj < 2; ++bj)
#pragma unroll
                    for (int n = 0; n < 2; ++n) { const f32x4 v = *(const f32x4*)(base + off + bj * HALF + n * 16) + acc[ai][bj][m][n];
                        *(f32x4*)(out + off + bj * HALF + n * 16) = v; s += (v[0] * v[0] + v[1] * v[1]) + (v[2] * v[2] + v[3] * v[3]);
                        if (ob) { u32x2v w; w.x = cvt_pk_bf16(v[0], v[1]); w.y = cvt_pk_bf16(v[2], v[3]); *(u32x2v*)(ob + off + bj * HALF + n * 16) = w; } }
                if (ss) { s += __shfl_xor(s, 16); s += __shfl_xor(s, 32); if (fq == 0) ss[(size_t)row * 16 + u.pn * 4 + wc] = s; }
                asm volatile("" ::: "memory");
            }
    }
};

struct EpiResNorm {
    static constexpr bool PERM = false, AFTER_DRAIN = true;
    const float* base; float* out; int ldc; const float* g; float* xs; unsigned* cnt; float eps; float inv_n;
    __device__ __forceinline__ void fused(f32x4 (&acc)[2][2][4][2], const Unit& u, int wr, int wc, int fr, int fq, PG8_LAS unsigned char* lds, int wid, int lane) const {
        PG8_LAS float* Pm = (PG8_LAS float*)lds;
        PG8_LAS float* S = (PG8_LAS float*)(lds + 4096);
        const int row0 = u.pm * BM + wr * 64 + fr, col0 = u.pn * BM + wc * 32 + 4 * fq;
#pragma unroll
        for (int ai = 0; ai < 2; ++ai)
#pragma unroll
            for (int m = 0; m < 4; ++m) { const size_t off = (size_t)(row0 + ai * HALF + m * 16) * ldc + col0; float s = 0.f;
#pragma unroll
                for (int bj = 0; bj < 2; ++bj)
#pragma unroll
                    for (int n = 0; n < 2; ++n) { const f32x4 v = *(const f32x4*)(base + off + bj * HALF + n * 16) + acc[ai][bj][m][n]; acc[ai][bj][m][n] = v;
                        s += (v[0] * v[0] + v[1] * v[1]) + (v[2] * v[2] + v[3] * v[3]); }
                s += __shfl_xor(s, 16); s += __shfl_xor(s, 32);
                if (fq == 0) Pm[(ai * HALF + wr * 64 + m * 16 + fr) * 4 + wc] = s;
                if (m & 1) asm volatile("" ::: "memory"); }
        asm volatile("s_waitcnt lgkmcnt(0)" ::: "memory"); __builtin_amdgcn_s_barrier(); asm volatile("" ::: "memory");
        const int tid = wid * 64 + lane;
        if (tid < 256) { const f32x4 p4 = *(const PG8_LAS f32x4*)(Pm + tid * 4);
            __hip_atomic_store(xs + (size_t)(u.pm * BM + tid) * 4 + u.pn, (p4[0] + p4[1]) + (p4[2] + p4[3]), __ATOMIC_RELAXED, __HIP_MEMORY_SCOPE_AGENT);
            asm volatile("s_waitcnt vmcnt(0)" ::: "memory");
            if (lane == 0) __hip_atomic_fetch_add(cnt + 64 * u.pm, 1u, __ATOMIC_RELAXED, __HIP_MEMORY_SCOPE_AGENT); }
        if (wid == 0) { unsigned sp = 0;
            while ((unsigned)__builtin_amdgcn_readfirstlane(__hip_atomic_load(cnt + 64 * u.pm, __ATOMIC_RELAXED, __HIP_MEMORY_SCOPE_AGENT)) < 16u) { __builtin_amdgcn_s_sleep(2); if (++sp > (1u << 22)) break; }
            __builtin_amdgcn_fence(__ATOMIC_ACQUIRE, "agent"); }
        asm volatile("s_waitcnt vmcnt(0) lgkmcnt(0)" ::: "memory"); __builtin_amdgcn_s_barrier(); asm volatile("" ::: "memory");
        if (tid < 256) { const float* xp = xs + (size_t)(u.pm * BM + tid) * 4;
            const float t0 = __hip_atomic_load(xp + 0, __ATOMIC_RELAXED, __HIP_MEMORY_SCOPE_AGENT), t1 = __hip_atomic_load(xp + 1, __ATOMIC_RELAXED, __HIP_MEMORY_SCOPE_AGENT);
            const float t2 = __hip_atomic_load(xp + 2, __ATOMIC_RELAXED, __HIP_MEMORY_SCOPE_AGENT), t3 = __hip_atomic_load(xp + 3, __ATOMIC_RELAXED, __HIP_MEMORY_SCOPE_AGENT);
            S[tid] = 1.0f / sqrtf(((t0 + t1) + (t2 + t3)) * inv_n + eps); }
        asm volatile("s_waitcnt vmcnt(0) lgkmcnt(0)" ::: "memory"); __builtin_amdgcn_s_barrier(); asm volatile("" ::: "memory");
        f32x4 gv[2][2];
#pragma unroll
        for (int bj = 0; bj < 2; ++bj)
#pragma unroll
            for (int n = 0; n < 2; ++n) gv[bj][n] = *(const f32x4*)(g + col0 + bj * HALF + n * 16);
#pragma unroll
        for (int ai = 0; ai < 2; ++ai)
#pragma unroll
            for (int m = 0; m < 4; ++m) { const int r = ai * HALF + wr * 64 + m * 16 + fr; const float rs = S[r]; const size_t off = (size_t)(u.pm * BM + r) * ldc + col0;
#pragma unroll
                for (int bj = 0; bj < 2; ++bj)
#pragma unroll
                    for (int n = 0; n < 2; ++n) *(f32x4*)(out + off + bj * HALF + n * 16) = acc[ai][bj][m][n] * rs * gv[bj][n]; }
    }
};
struct EpiSqRelu {
    static constexpr bool PERM = true, AFTER_DRAIN = false;
    bf16_t* O; int ldc; const float* ss; float eps; float inv_n;
    __device__ __forceinline__ void operator()(const f32x4 (&acc)[2][2][4][2], const Unit& u, int wr, int wc, int fr, int fq) const {
        const int row0 = u.pm * BM + wr * 64 + fr, col0 = u.pn * BM + wc * 32 + 8 * fq;
#pragma unroll
        for (int ai = 0; ai < 2; ++ai)
#pragma unroll
            for (int m = 0; m < 4; ++m) { const int row = row0 + ai * HALF + m * 16;
                const f32x4* sp = (const f32x4*)(ss + (size_t)row * 16); const f32x4 a = sp[0], b = sp[1], c = sp[2], d = sp[3];
                const float tot = ((a[0] + a[1]) + (a[2] + a[3])) + ((b[0] + b[1]) + (b[2] + b[3])) + ((c[0] + c[1]) + (c[2] + c[3])) + ((d[0] + d[1]) + (d[2] + d[3]));
                const float rstd = 1.0f / sqrtf(tot * inv_n + eps);
#pragma unroll
                for (int bj = 0; bj < 2; ++bj) { f32x4 v0 = acc[ai][bj][m][0] * rstd, v1 = acc[ai][bj][m][1] * rstd;
#pragma unroll
                    for (int e = 0; e < 4; ++e) { const float x0 = fmaxf(v0[e], 0.f), x1 = fmaxf(v1[e], 0.f); v0[e] = x0 * x0; v1[e] = x1 * x1; }
                    u32x4 w; w.x = cvt_pk_bf16(v0[0], v0[1]); w.y = cvt_pk_bf16(v0[2], v0[3]); w.z = cvt_pk_bf16(v1[0], v1[1]); w.w = cvt_pk_bf16(v1[2], v1[3]);
                    *(u32x4*)(O + (size_t)row * ldc + col0 + bj * HALF) = w; }
                asm volatile("" ::: "memory"); }
    }
};


template <class Epi, class Sched, bool ALIGN_EPI = false, bool SP2 = false>
__device__ __forceinline__ void gemm_phase(PG8_LAS unsigned char* lds, const Gemm g, const Sched& S, const Epi& E) {
    const int tid = threadIdx.x, wid = __builtin_amdgcn_readfirstlane(tid >> 6), lane = tid & 63, wr = wid >> 2, wc = wid & 3, fr = lane & 15, fq = lane >> 4;
    const int K = g.K, nt = K / BK, lda = g.lda ? g.lda : g.K;
    unsigned voffA[2], voffB[2];
#pragma unroll
    for (int i = 0; i < 2; ++i) { int R, C; stage_rc(tid * 16 + i * 8192, R, C); const int Rb = Epi::PERM ? ((R & ~31) + perm32(R & 31)) : R;
        voffA[i] = (unsigned)(R * lda + C) * 2u; voffB[i] = (unsigned)(Rb * K + C) * 2u; }
    const size_t kstep = (size_t)(BK * 2);
    const size_t hstep = (size_t)HALF * K * 2;
    const size_t tstep = 2 * hstep;
    const size_t hstepA = (size_t)HALF * lda * 2, tstepA = 2 * hstepA;
    const unsigned ldsw = (unsigned)wid * 1024u;
    const int aoff = lds_byte(wr * 64 + fr, fq * 8), boff = lds_byte(wc * 32 + fr, fq * 8);
#define PG8_SA(b, h) (((b) * 2 + (h)) * HTB)
#define PG8_SB(b, h) ((4 + (b) * 2 + (h)) * HTB)
#define PG8_STAGE(bufoff, gbase, voff) do { _Pragma("unroll") for (int _i = 0; _i < 2; ++_i) \
        __builtin_amdgcn_global_load_lds((const unsigned*)((const char*)(gbase) + (voff)[_i]), (PG8_LAS unsigned*)(lds + (bufoff) + ldsw + _i * 8192), 16, 0, 0); } while (0)
#define PG8_LDA(dst, b, h) do { _Pragma("unroll") for (int m = 0; m < 4; ++m) _Pragma("unroll") for (int k = 0; k < 2; ++k) dst[m][k] = *(const PG8_LAS bf16x8*)(lds + PG8_SA(b, h) + aoff + m * 2048 + k * 1024); } while (0)
#define PG8_LDB(dst, b, h) do { _Pragma("unroll") for (int n = 0; n < 2; ++n) _Pragma("unroll") for (int k = 0; k < 2; ++k) dst[n][k] = *(const PG8_LAS bf16x8*)(lds + PG8_SB(b, h) + boff + n * 2048 + k * 1024); } while (0)
#define PG8_MMA(ai, bj, At, Bt) do { __builtin_amdgcn_s_setprio(1); _Pragma("unroll") for (int m = 0; m < 4; ++m) _Pragma("unroll") for (int n = 0; n < 2; ++n) _Pragma("unroll") for (int k = 0; k < 2; ++k) \
        acc[ai][bj][m][n] = __builtin_amdgcn_mfma_f32_16x16x32_bf16(Bt[n][k], At[m][k], acc[ai][bj][m][n], 0, 0, 0); __builtin_amdgcn_s_setprio(0); } while (0)
#define PG8_WAIT_V(n) asm volatile("s_waitcnt vmcnt(" #n ")" ::: "memory")
#define PG8_WAIT_L(n) asm volatile("s_waitcnt lgkmcnt(" #n ")" ::: "memory")
#define PG8_BAR __builtin_amdgcn_s_barrier()
#define PG8_SCHED __builtin_amdgcn_sched_barrier(0)
    Unit cur, nxt; int ui = 0;
    if (!S.next(0, cur)) return;
    f32x4 acc[2][2][4][2];
#pragma unroll
    for (int a = 0; a < 2; ++a)
#pragma unroll
        for (int b = 0; b < 2; ++b)
#pragma unroll
            for (int m = 0; m < 4; ++m)
#pragma unroll
                for (int n = 0; n < 2; ++n) acc[a][b][m][n] = (f32x4){0.f, 0.f, 0.f, 0.f};
    bf16x8 At[4][2], B0[2][2], B1[2][2];
    const char* cA = (const char*)g.A + (size_t)cur.pm * tstepA; const char* cB = (const char*)g.Bt + (size_t)cur.pn * tstep;
    S.a_ready(cur);
    if constexpr (SP2) {
        PG8_STAGE(PG8_SB(0, 0), cB, voffB); PG8_STAGE(PG8_SB(0, 1), cB + hstep, voffB); PG8_STAGE(PG8_SA(0, 0), cA, voffA); PG8_STAGE(PG8_SA(0, 1), cA + hstepA, voffA);
        if (wr == 1) PG8_BAR;
        PG8_WAIT_V(2); PG8_BAR;
        PG8_STAGE(PG8_SB(1, 0), cB + kstep, voffB); PG8_STAGE(PG8_SA(1, 0), cA + kstep, voffA); PG8_STAGE(PG8_SB(1, 1), cB + hstep + kstep, voffB);
        PG8_WAIT_V(6); PG8_BAR;
    } else {
        PG8_STAGE(PG8_SB(0, 0), cB, voffB); PG8_STAGE(PG8_SA(0, 0), cA, voffA); PG8_STAGE(PG8_SB(0, 1), cB + hstep, voffB); PG8_STAGE(PG8_SA(0, 1), cA + hstepA, voffA);
        if (wr == 1) PG8_BAR;
        PG8_WAIT_V(4); PG8_BAR;
        PG8_STAGE(PG8_SB(1, 0), cB + kstep, voffB); PG8_STAGE(PG8_SA(1, 0), cA + kstep, voffA); PG8_STAGE(PG8_SB(1, 1), cB + hstep + kstep, voffB);
        PG8_WAIT_V(6); PG8_BAR;
    }
    for (;;) {
        const bool has_next = S.next(ui + 1, nxt);
        const char* nA = has_next ? (const char*)g.A + (size_t)nxt.pm * tstepA : cA; const char* nB = has_next ? (const char*)g.Bt + (size_t)nxt.pn * tstep : cB;
        for (int t = 0; t < nt; t += 2) {
            const bool last = (t == nt - 2);
            const char* a1 = cA + (size_t)(t + 1) * kstep;
            const char* a2 = last ? nA : cA + (size_t)(t + 2) * kstep; const char* b2 = last ? nB : cB + (size_t)(t + 2) * kstep;
            const char* a3 = a2 + kstep; const char* b3 = b2 + kstep;
            if (last && has_next) S.a_ready(nxt);
            if constexpr (SP2) {
            PG8_LDB(B0, 0, 0); PG8_LDB(B1, 0, 1); PG8_SCHED; PG8_LDA(At, 0, 0); PG8_STAGE(PG8_SA(1, 1), a1 + hstepA, voffA);
            PG8_WAIT_V(8); PG8_WAIT_L(0); PG8_BAR; PG8_MMA(0, 0, At, B0); PG8_MMA(0, 1, At, B1); PG8_BAR; PG8_SCHED;
            PG8_LDA(At, 0, 1); PG8_STAGE(PG8_SB(0, 0), b2, voffB); PG8_STAGE(PG8_SB(0, 1), b2 + hstep, voffB); PG8_STAGE(PG8_SA(0, 0), a2, voffA);
            PG8_WAIT_V(8); PG8_WAIT_L(0); PG8_BAR; PG8_MMA(1, 0, At, B0); PG8_MMA(1, 1, At, B1); PG8_BAR; PG8_SCHED;
            PG8_LDB(B0, 1, 0); PG8_LDB(B1, 1, 1); PG8_SCHED; PG8_LDA(At, 1, 0); PG8_STAGE(PG8_SA(0, 1), a2 + hstepA, voffA);
            PG8_WAIT_V(8); PG8_WAIT_L(0); PG8_BAR; PG8_MMA(0, 0, At, B0); PG8_MMA(0, 1, At, B1); PG8_BAR; PG8_SCHED;
            PG8_LDA(At, 1, 1); PG8_STAGE(PG8_SB(1, 0), b3, voffB); PG8_STAGE(PG8_SB(1, 1), b3 + hstep, voffB); PG8_STAGE(PG8_SA(1, 0), a3, voffA);
            PG8_WAIT_V(8); PG8_WAIT_L(0); PG8_BAR; PG8_MMA(1, 0, At, B0); PG8_MMA(1, 1, At, B1); PG8_BAR; PG8_SCHED;
            } else {
            PG8_LDB(B0, 0, 0); PG8_SCHED; PG8_LDA(At, 0, 0); PG8_STAGE(PG8_SA(1, 1), a1 + hstepA, voffA);
            PG8_WAIT_L(8); PG8_BAR; PG8_WAIT_L(0); PG8_MMA(0, 0, At, B0); PG8_BAR; PG8_SCHED;
            PG8_LDB(B1, 0, 1); PG8_STAGE(PG8_SB(0, 0), b2, voffB);
            PG8_BAR; PG8_WAIT_L(0); PG8_MMA(0, 1, At, B1); PG8_BAR;
            PG8_LDA(At, 0, 1); PG8_STAGE(PG8_SA(0, 0), a2, voffA);
            PG8_BAR; PG8_WAIT_L(0); PG8_MMA(1, 0, At, B0); PG8_BAR; PG8_SCHED;
            PG8_STAGE(PG8_SB(0, 1), b2 + hstep, voffB);
            PG8_WAIT_V(6); PG8_BAR; PG8_MMA(1, 1, At, B1); PG8_BAR;
            PG8_LDB(B0, 1, 0); PG8_SCHED; PG8_LDA(At, 1, 0); PG8_STAGE(PG8_SA(0, 1), a2 + hstepA, voffA);
            PG8_WAIT_L(8); PG8_BAR; PG8_WAIT_L(0); PG8_MMA(0, 0, At, B0); PG8_BAR; PG8_SCHED;
            PG8_LDB(B1, 1, 1); PG8_STAGE(PG8_SB(1, 0), b3, voffB);
            PG8_BAR; PG8_WAIT_L(0); PG8_MMA(0, 1, At, B1); PG8_BAR;
            PG8_LDA(At, 1, 1); PG8_STAGE(PG8_SA(1, 0), a3, voffA);
            PG8_BAR; PG8_WAIT_L(0); PG8_MMA(1, 0, At, B0); PG8_BAR; PG8_SCHED;
            PG8_STAGE(PG8_SB(1, 1), b3 + hstep, voffB);
            PG8_WAIT_V(6); PG8_BAR; PG8_MMA(1, 1, At, B1); PG8_BAR;
            }
        }
        if constexpr (ALIGN_EPI) { if (wr == 0) PG8_BAR; }
        if constexpr (!Epi::AFTER_DRAIN) { E(acc, cur, wr, wc, fr, fq); S.done(cur); }
        if (!has_next) break;
#pragma unroll
        for (int a = 0; a < 2; ++a)
#pragma unroll
            for (int b = 0; b < 2; ++b)
#pragma unroll
                for (int m = 0; m < 4; ++m)
#pragma unroll
                    for (int n = 0; n < 2; ++n) acc[a][b][m][n] = (f32x4){0.f, 0.f, 0.f, 0.f};
        cur = nxt; cA = nA; cB = nB; ++ui;
        if constexpr (ALIGN_EPI) { if (wr == 1) PG8_BAR; }
    }
    PG8_WAIT_V(0);
    if constexpr (!ALIGN_EPI) { if (wr == 0) PG8_BAR; }
    PG8_BAR;
    if constexpr (Epi::AFTER_DRAIN) { E.fused(acc, cur, wr, wc, fr, fq, lds, wid, lane); S.done(cur); }
#undef PG8_SA
#undef PG8_SB
#undef PG8_STAGE
#undef PG8_LDA
#undef PG8_LDB
#undef PG8_MMA
#undef PG8_WAIT_V
#undef PG8_WAIT_L
#undef PG8_BAR
#undef PG8_SCHED
}
}

#ifndef PG8_SP2
#define PG8_SP2 true
#endif
#ifndef PG8_ALIGN
#define PG8_ALIGN true
#endif
namespace att {
#define LAS3 __attribute__((address_space(3)))
using bf16x8 = __attribute__((ext_vector_type(8))) short;
using s16x4 = __attribute__((ext_vector_type(4))) short;
using f32x16 = __attribute__((ext_vector_type(16))) float;
using f32x4 = __attribute__((ext_vector_type(4))) float;
using u32x4 = __attribute__((ext_vector_type(4))) unsigned;
typedef unsigned short u16;
typedef LAS3 const unsigned char* lds_cptr;
typedef short v4i16_t __attribute__((ext_vector_type(4)));
constexpr int SEQ = 16384, NW = 8, QBLK = 32, QB = 256, KVBLK = 64;
constexpr int KSLOT = 12288, VSLOT = 8192, NKS = 4, NVS = 4;
constexpr int LDS_K = 0, LDS_V = NKS * KSLOT, LDS_WS = LDS_V + NVS * VSLOT, LDS_OST = LDS_WS + NW * 256, LDS_QX = LDS_OST + NW * 4096, LDS_BYTES = LDS_QX + NW * 2048;
__device__ __forceinline__ int crow(int r, int hi) { return (r & 3) + 8 * (r >> 2) + 4 * hi; }
__device__ __forceinline__ void glds16(const void* gsrc, unsigned lds_dst) { unsigned keep;
    asm volatile("s_mov_b32 %0, m0\n\ts_mov_b32 m0, %2\n\ts_nop 0\n\tglobal_load_lds_dwordx4 %1, off\n\ts_mov_b32 m0, %0" : "=&s"(keep) : "v"(gsrc), "s"(lds_dst) : "memory"); }
typedef float f32x2_t __attribute__((ext_vector_type(2))); typedef __bf16 bf16x2_t __attribute__((ext_vector_type(2)));
__device__ __forceinline__ unsigned cvtpk_s(float lo, float hi) { f32x2_t v = {lo, hi}; bf16x2_t b = __builtin_convertvector(v, bf16x2_t); return __builtin_bit_cast(unsigned, b); }
__device__ __forceinline__ s16x4 vtr(lds_cptr p) { return __builtin_bit_cast(s16x4, __builtin_amdgcn_ds_read_tr16_b64_v4i16((LAS3 v4i16_t*)p)); }
#define ATT_SBAR() __builtin_amdgcn_sched_barrier(0)
#define ATT_WAIT_BAR(N) asm volatile("s_waitcnt vmcnt(" #N ") lgkmcnt(0)\n\ts_barrier" ::: "memory")
struct Src {
    const u16* q; int qp;
    const u16* k; int kp;
    const u16* k2; int k2p;
    const u16* v; int vp;
    u16* o; int op;
};
template <int NDK, int NQR, bool ZC, int XHS, int JLO, int JHI>
__device__ __forceinline__ void phase_a(f32x16& C0, f32x16& C1, const lds_cptr* kb_, int ksl_, const bf16x8* qr, lds_cptr qx_, const f32x16& negm, bf16x8* kf, bf16x8* qx) {
#ifndef ATT_KPF
#define ATT_KPF 4
#endif
    constexpr int KPF = ATT_KPF;
#define ATT_KRD(j) kf[j] = *(const LAS3 bf16x8*)(kb_[(j) >> 1] + ksl_ + ((j) & 1) * (((j) >> 1) < 4 ? 4096 : XHS))
    if (JLO == 0) {
#pragma unroll
        for (int j = 0; j < KPF; ++j) ATT_KRD(j); }
#pragma unroll
    for (int j = JLO; j < JHI; ++j) {
        if (j + KPF < 2 * NDK) ATT_KRD(j + KPF);
        if (NDK > NQR && (j & 1) == 0 && (j >> 1) + 2 >= NQR && (j >> 1) + 2 < NDK) qx[(j >> 1) + 2 - NQR] = *(const LAS3 bf16x8*)(qx_ + ((j >> 1) + 2 - NQR) * 1024);
        ATT_SBAR();
        const f32x16 z = f32x16{}; const bf16x8 qf = ((j >> 1) < NQR) ? qr[(j >> 1) < NQR ? (j >> 1) : 0] : qx[(j >> 1) >= NQR ? (j >> 1) - NQR : 0];
        if (j & 1) C1 = __builtin_amdgcn_mfma_f32_32x32x16_bf16(kf[j], qf, (j < 2) ? (ZC ? z : negm) : C1, 0, 0, 0);
        else       C0 = __builtin_amdgcn_mfma_f32_32x32x16_bf16(kf[j], qf, (j < 2) ? (ZC ? z : negm) : C0, 0, 0, 0);
        ATT_SBAR();
    }
#undef ATT_KRD
}
template <bool QK, bool FIN>
__device__ __forceinline__ void phase_b(f32x16& C0, f32x16& C1, f32x16* o, lds_cptr vp_, u32x4* pw, float& l_reg) {
    s16x4 vlo[8], vhi[8]; f32x2_t sacc = {0.f, 0.f};
#define ATT_VRD(i) do { const int vi_ = ((i) >> 1) + 4 * ((i) & 1); vlo[i] = vtr(vp_ + ((vi_ >> 2) * 4096 + (vi_ & 3) * 1024)); vhi[i] = vtr(vp_ + ((vi_ >> 2) * 4096 + (vi_ & 3) * 1024 + 512)); } while (0)
    if (FIN) { ATT_VRD(0); ATT_VRD(1); }
#pragma unroll
    for (int i = 0; i < 8; ++i) {
        if (FIN && i + 2 < 8) ATT_VRD(i + 2);
        ATT_SBAR();
        if (FIN) { const bf16x8 vf = (bf16x8){vlo[i][0], vlo[i][1], vlo[i][2], vlo[i][3], vhi[i][0], vhi[i][1], vhi[i][2], vhi[i][3]};
            o[i & 1] = __builtin_amdgcn_mfma_f32_32x32x16_bf16(__builtin_bit_cast(bf16x8, pw[i >> 1]), vf, o[i & 1], 0, 0, 0); }
        if (QK) { f32x16& X = (i < 4) ? C0 : C1; const int b = 4 * (i & 3);
            X[b] = __builtin_amdgcn_exp2f(X[b]); X[b + 1] = __builtin_amdgcn_exp2f(X[b + 1]); X[b + 2] = __builtin_amdgcn_exp2f(X[b + 2]); X[b + 3] = __builtin_amdgcn_exp2f(X[b + 3]);
            sacc += (f32x2_t){X[b], X[b + 1]}; sacc += (f32x2_t){X[b + 2], X[b + 3]}; asm volatile("" : "+v"(sacc));
            if (i & 1) { const int k = i >> 1, c = 8 * (k & 1);
                pw[k] = (u32x4){cvtpk_s(X[c], X[c + 1]), cvtpk_s(X[c + 2], X[c + 3]), cvtpk_s(X[c + 4], X[c + 5]), cvtpk_s(X[c + 6], X[c + 7])}; asm volatile("" : "+v"(pw[k])); } }
        ATT_SBAR();
    }
#undef ATT_VRD
    if (QK) l_reg += sacc[0] + sacc[1];
}
template <bool MLA> __device__ __forceinline__ void attn_unit(int qb, const Src& s, LAS3 unsigned char* shm, const float* bias_h, float kmax2, const float* qmax_h) {
    constexpr int NDK = MLA ? 6 : 5, NX = MLA ? 4 : 1, NQR = MLA ? 4 : 5;
    constexpr float THRL = MLA ? 8.0f : 16.0f;
    const int tid = threadIdx.x, lane = tid & 63, r32 = lane & 31, hi = lane >> 5; const int wid = __builtin_amdgcn_readfirstlane(tid >> 6);
    const int q0 = qb * QB;
    const unsigned lds0 = (unsigned)(uintptr_t)shm;
    LAS3 float* wsf = (LAS3 float*)(shm + LDS_WS) + wid * 64;
    const int NT = (q0 + QB) / KVBLK;
    const int wvis = NT - 4 + (wid >> 1);
    const bool xw = wid < NX;
    const int krow = 8 * wid + (lane >> 3);
    const u16* ksrc = s.k + (size_t)krow * s.kp + (((lane & 7) ^ ((krow >> 1) & 7)) * 8);
    const int k2row = 16 * (wid & 3) + (lane >> 2);
    const u16* k2src = MLA ? s.k2 + (size_t)k2row * s.k2p + (((lane & 3) ^ ((k2row >> 2) & 3)) * 8) : s.k2 + (size_t)lane * s.k2p;
    const u16* vsrc = s.v + (size_t)(16 * (wid & 3) + (lane >> 2)) * s.vp + (wid >> 2) * 32 + (lane & 3) * 8;
    const unsigned kdst = lds0 + LDS_K + wid * 1024, k2dst = lds0 + LDS_K + (8 + (wid & 3)) * 1024, vdst = lds0 + LDS_V + wid * 1024;
#define ATT_DMA_K(t) do { const int sl_ = (t) & 3; glds16(ksrc + (size_t)(t) * KVBLK * s.kp, (unsigned)__builtin_amdgcn_readfirstlane(kdst + sl_ * KSLOT)); \
        if (xw) glds16(k2src + (size_t)(t) * KVBLK * s.k2p, (unsigned)__builtin_amdgcn_readfirstlane(k2dst + sl_ * KSLOT)); } while (0)
#define ATT_DMA_V(t, vsl) glds16(vsrc + (size_t)(t) * KVBLK * s.vp, (unsigned)__builtin_amdgcn_readfirstlane(vdst + (vsl)))
    if (!MLA) {
        if (tid < 256) { const int sl = tid >> 6; *(LAS3 f32x4*)(shm + LDS_K + sl * KSLOT + 9 * 1024 + (tid & 63) * 16) = (f32x4){0.f, 0.f, 0.f, 0.f}; } }
    if (MLA) { ATT_DMA_K(0); ATT_DMA_V(0, 0); ATT_DMA_K(1); ATT_DMA_K(2); }
    const u16* Qw = s.q + (size_t)(q0 + wid * QBLK + r32) * s.qp + hi * 8;
    bf16x8 qr[NQR];
#pragma unroll
    for (int d0 = 0; d0 < 4; ++d0) qr[d0] = *reinterpret_cast<const bf16x8*>(Qw + d0 * 16);
    const lds_cptr qx0 = (lds_cptr)shm + LDS_QX + wid * 2048 + lane * 16;
    if (MLA) { const bf16x8 q4 = *reinterpret_cast<const bf16x8*>(Qw + 64), q5 = *reinterpret_cast<const bf16x8*>(Qw + 80);
        *(LAS3 bf16x8*)(shm + LDS_QX + wid * 2048 + lane * 16) = q4; *(LAS3 bf16x8*)(shm + LDS_QX + wid * 2048 + 1024 + lane * 16) = q5; }
    const short one = hi ? (short)0 : (short)0x3F80;
    if (!MLA) qr[NQR - 1] = (bf16x8){one, one, one, 0, 0, 0, 0, 0};
    int t0 = 0;
    if (!MLA) {
        const float qm = qmax_h[qb];
        const float thr = bias_h[q0] - 170.f - 2.f * sqrtf(qm * kmax2);
        int best = 0;
        for (int tt = 1 + lane; tt <= NT - 4; tt += 64) { if (bias_h[64 * tt - 1] < thr) best = tt; }
#pragma unroll
        for (int o_ = 32; o_ >= 1; o_ >>= 1) best = max(best, __shfl_xor(best, o_));
        t0 = __builtin_amdgcn_readfirstlane(best);
    }
    if (!MLA) { ATT_DMA_K(t0); ATT_DMA_V(t0, (t0 & 3) * VSLOT); ATT_DMA_K(t0 + 1); ATT_DMA_K(t0 + 2); }
    float mhat = 0.f, l_reg = 0.f; f32x16 o[2]; o[0] = f32x16{}; o[1] = f32x16{}; f32x16 negm = f32x16{};
    const int qrel = wid * QBLK + r32;
    lds_cptr kb[NDK];
#pragma unroll
    for (int d0 = 0; d0 < 4; ++d0) kb[d0] = (lds_cptr)shm + LDS_K + r32 * 128 + ((((2 * d0 + hi) ^ ((r32 >> 1) & 7))) << 4);
    if (MLA) {
#pragma unroll
        for (int d0 = 4; d0 < NDK; ++d0) kb[d0] = (lds_cptr)shm + LDS_K + 8192 + r32 * 64 + ((((2 * (d0 - 4) + hi) ^ ((r32 >> 2) & 3))) << 4);
    } else kb[NDK - 1] = (lds_cptr)shm + LDS_K + 8192 + hi * 1024 + r32 * 16;
    constexpr int XHS = MLA ? 2048 : 512;
    const lds_cptr vp0 = (lds_cptr)shm + LDS_V + ((lane >> 4) & 1) * 32 + (lane & 3) * 8 + (4 * hi + ((lane & 15) >> 2)) * 64;
    f32x16 C0, C1; u32x4 pw[4]; bool resc = false;
#define ATT_TOP(t) do { if ((t) == t0 || (t) + 2 >= NT) { ATT_WAIT_BAR(0); } else if (xw) { ATT_WAIT_BAR(3); } else { ATT_WAIT_BAR(2); } \
        } while (0)
#define ATT_ISSUE(t) do { if ((t) + 3 < NT) ATT_DMA_K((t) + 3); if ((t) + 1 < NT) ATT_DMA_V((t) + 1, (((t) + 1) & 3) * VSLOT); } while (0)
#define ATT_QK(t) do { bf16x8 kf_[2 * NDK]; bf16x8 qx_[NDK > NQR ? NDK - NQR : 1]; \
        phase_a<NDK, NQR, !MLA, XHS, 0, 4>(C0, C1, ATT_KS(t), qr, qx0, negm, kf_, qx_); ATT_ISSUE(t); ATT_SBAR(); \
        phase_a<NDK, NQR, !MLA, XHS, 4, 2 * NDK>(C0, C1, ATT_KS(t), qr, qx0, negm, kf_, qx_); } while (0)
#define ATT_MASK(C0, C1, t) do { const int kbq_ = 64 * ((t) - (NT - 4)) + 4 * hi; \
        _Pragma("unroll") for (int r = 0; r < 16; ++r) { const int kv_ = kbq_ + (r & 3) + 8 * (r >> 2); if (kv_ > qrel) C0[r] = -INFINITY; if (kv_ + 32 > qrel) C1[r] = -INFINITY; } } while (0)
#define ATT_DECIDE(C0, C1, FIRST) do { \
        float a_ = fmaxf(fmaxf(C0[0], C0[1]), C1[0]), b_ = fmaxf(fmaxf(C0[2], C0[3]), C1[1]); a_ = fmaxf(fmaxf(a_, C1[2]), C1[3]); \
        _Pragma("unroll") for (int r = 4; r < 16; r += 4) { a_ = fmaxf(fmaxf(a_, C0[r]), C0[r + 1]); b_ = fmaxf(fmaxf(b_, C0[r + 2]), C0[r + 3]); a_ = fmaxf(fmaxf(a_, C1[r]), C1[r + 1]); b_ = fmaxf(fmaxf(b_, C1[r + 2]), C1[r + 3]); } \
        float rm_ = fmaxf(a_, b_); { auto rr_ = __builtin_amdgcn_permlane32_swap(__float_as_uint(rm_), __float_as_uint(rm_), false, false); rm_ = fmaxf(__uint_as_float(rr_[0]), __uint_as_float(rr_[1])); } \
        resc = false; \
        if ((FIRST) || __any(rm_ > THRL)) { float dl_ = (FIRST) ? rm_ : fmaxf(rm_, 0.f); \
            if (!MLA) { const float nm_ = -(mhat + dl_); const unsigned h_ = cvtpk_s(nm_, 0.f) & 0xffffu; const float r1_ = nm_ - __uint_as_float(h_ << 16); const unsigned m_ = cvtpk_s(r1_, 0.f) & 0xffffu; \
                const float r2_ = r1_ - __uint_as_float(m_ << 16); const unsigned l_ = cvtpk_s(r2_, 0.f) & 0xffffu; \
                const float mn_ = -((__uint_as_float(h_ << 16) + __uint_as_float(m_ << 16)) + __uint_as_float(l_ << 16)); dl_ = mn_ - mhat; mhat = mn_; \
                if (hi == 0) qr[NQR - 1] = (bf16x8){one, one, one, (short)h_, (short)m_, (short)l_, 0, 0}; } \
            else { mhat += dl_; _Pragma("unroll") for (int r = 0; r < 16; ++r) negm[r] = -mhat; } \
            _Pragma("unroll") for (int r = 0; r < 16; ++r) { C0[r] -= dl_; C1[r] -= dl_; } \
            if (!(FIRST)) { const float f_ = __builtin_amdgcn_exp2f(-dl_); l_reg *= f_; if (hi == 0) wsf[r32] = f_; resc = true; } } } while (0)
#define ATT_RESC() do { if (resc) { \
        _Pragma("unroll") for (int i = 0; i < 4; ++i) { const f32x4 fv_ = *(const LAS3 f32x4*)(wsf + 8 * i + 4 * hi); \
            _Pragma("unroll") for (int d = 0; d < 2; ++d) { o[d][4 * i] *= fv_[0]; o[d][4 * i + 1] *= fv_[1]; o[d][4 * i + 2] *= fv_[2]; o[d][4 * i + 3] *= fv_[3]; } } } } while (0)
#define ATT_VS(tt) (vp0 + (((tt)) & 3) * VSLOT)
#define ATT_KS(tt) kb, ((((tt)) & 3) * KSLOT)
#ifndef ATT_STAGGER
#define ATT_STAGGER 0
#endif
    if (!ATT_STAGGER || wid < 4) {
#define ATT_STEP(t, MASKED) do { ATT_TOP(t); \
        ATT_QK(t); \
        if (!MLA && (MASKED)) ATT_MASK(C0, C1, t); \
        ATT_DECIDE(C0, C1, false); ATT_SBAR(); \
        phase_b<true, true>(C0, C1, o, ATT_VS((t) - 1), pw, l_reg); \
        ATT_RESC(); } while (0)
        ATT_TOP(t0);
        ATT_QK(t0);
        if (!MLA && wvis == t0) ATT_MASK(C0, C1, t0);
        ATT_DECIDE(C0, C1, true); ATT_SBAR();
        phase_b<true, false>(C0, C1, o, vp0, pw, l_reg);
        int t = t0 + 1;
        for (; t < wvis; ++t) ATT_STEP(t, false);
        if (t == wvis) { ATT_STEP(t, true); ++t; }
        { ATT_TOP(t); ATT_ISSUE(t); phase_b<false, true>(C0, C1, o, ATT_VS(t - 1), pw, l_reg); ++t; }
        for (; t <= NT + ATT_STAGGER; ++t) { ATT_TOP(t); ATT_ISSUE(t); }
#undef ATT_STEP
    } else {
        ATT_TOP(t0);
        ATT_QK(t0);
        ATT_DECIDE(C0, C1, true); ATT_SBAR();
        ATT_TOP(t0 + 1);
        phase_b<true, false>(C0, C1, o, vp0, pw, l_reg); ATT_SBAR();
        ATT_QK(t0 + 1);
        ATT_DECIDE(C0, C1, false); ATT_SBAR();
        int t = t0 + 2;
#define ATT_STEP2(t, MASKED) do { ATT_TOP(t); \
        phase_b<true, true>(C0, C1, o, ATT_VS((t) - 2), pw, l_reg); \
        ATT_RESC(); ATT_SBAR(); \
        ATT_QK(t); \
        if (!MLA && (MASKED)) ATT_MASK(C0, C1, t); \
        ATT_DECIDE(C0, C1, false); ATT_SBAR(); } while (0)
        for (; t < wvis; ++t) ATT_STEP2(t, false);
        ATT_STEP2(t, true); ++t;
        { ATT_TOP(t); ATT_ISSUE(t); phase_b<true, true>(C0, C1, o, ATT_VS(t - 2), pw, l_reg); ATT_RESC(); ++t; }
        { ATT_TOP(t); ATT_ISSUE(t); phase_b<false, true>(C0, C1, o, ATT_VS(t - 2), pw, l_reg); ++t; }
        for (; t <= NT + ATT_STAGGER; ++t) { ATT_TOP(t); ATT_ISSUE(t); }
#undef ATT_STEP2
    }
    { auto rr = __builtin_amdgcn_permlane32_swap(__float_as_uint(l_reg), __float_as_uint(l_reg), false, false); l_reg = __uint_as_float(rr[0]) + __uint_as_float(rr[1]); }
    if (hi == 0) wsf[32 + r32] = 1.0f / l_reg;
    float rli[16];
#pragma unroll
    for (int i = 0; i < 4; ++i) { const f32x4 fv = *(const LAS3 f32x4*)(wsf + 32 + 8 * i + 4 * hi); rli[4 * i] = fv[0]; rli[4 * i + 1] = fv[1]; rli[4 * i + 2] = fv[2]; rli[4 * i + 3] = fv[3]; }
    u16* Ow = s.o + (size_t)(q0 + wid * QBLK) * s.op;
    { LAS3 u16* stg = (LAS3 u16*)(shm + LDS_OST) + wid * 2048;
#pragma unroll
        for (int r = 0; r < 16; ++r) { const int orow = crow(r, hi);
#pragma unroll
            for (int d0 = 0; d0 < 2; ++d0) stg[orow * 64 + d0 * 32 + r32] = (u16)(cvtpk_s(o[d0][r] * rli[r], 0.f) & 0xffffu); }
        asm volatile("s_waitcnt lgkmcnt(0)" ::: "memory");
#pragma unroll
        for (int i = 0; i < 4; ++i) { const int row = i * 8 + (lane >> 3), ch = lane & 7; const u32x4 v = *(const LAS3 u32x4*)(stg + row * 64 + ch * 8); *(u32x4*)(Ow + (size_t)row * s.op + ch * 8) = v; } }
    asm volatile("s_waitcnt lgkmcnt(0)\n\ts_barrier" ::: "memory");
#undef ATT_DMA_K
#undef ATT_DMA_V
#undef ATT_TOP
#undef ATT_ISSUE
#undef ATT_QK
#undef ATT_MASK
#undef ATT_DECIDE
#undef ATT_RESC
#undef ATT_STEP
}
}

namespace cg = cooperative_groups;
#define LAS __attribute__((address_space(3)))
typedef unsigned short bf16;
typedef unsigned v4u __attribute__((ext_vector_type(4)));
typedef unsigned v2u __attribute__((ext_vector_type(2)));
typedef float f32x4 __attribute__((ext_vector_type(4)));
constexpr int NWAVES = 8;
constexpr int M = 16384, D = 1024, FF = 4096, NIN = 1960, NINP = 2048, QL = 256, KVL = 128, NQU = 768, NKVU = 1024;
constexpr float EPS = 1e-6f;
constexpr float LOG2E = 1.4426950408889634f;
constexpr float C2_FOX = 0.125f * LOG2E, C2_MLA = 0.10206207261596575f * LOG2E;
constexpr size_t MiB = 1u << 20;
constexpr size_t WS_WIN = 1 * MiB, WS_WQ = 5 * MiB, WS_WKV = 5 * MiB + 512 * 1024, WS_WO = 6 * MiB, WS_W1 = 8 * MiB, WS_W2 = 16 * MiB;
constexpr size_t WS_RT = 24 * MiB, WS_LF = 26 * MiB, WS_LC = 26 * MiB + 512 * 1024, WS_SS = 27 * MiB, WS_KR = 28 * MiB, WS_KB = 29 * MiB, WS_SSQ = 31 * MiB, WS_SSKV = 31 * MiB + 512 * 1024, WS_BIASF = 28 * MiB;
constexpr size_t WS_XN = 32 * MiB, WS_H = 64 * MiB, WS_P = 64 * MiB, WS_QM = 128 * MiB, WS_KVM = 152 * MiB, WS_QN = 184 * MiB, WS_O = 192 * MiB, WS_KVN = 224 * MiB, WS_END = 228 * MiB;
constexpr int RING_BYTES = 131072, LDS_BYTES = 147456;
static_assert(att::LDS_BYTES <= LDS_BYTES, "attention scratch fits the LDS allocation");

__device__ __forceinline__ unsigned f2bf(float f) { unsigned u = __builtin_bit_cast(unsigned, f); return (u + 0x7fffu + ((u >> 16) & 1u)) >> 16; }
__device__ __forceinline__ unsigned pk2(float lo, float hi) { return f2bf(lo) | (f2bf(hi) << 16); }
__device__ __forceinline__ float bf2f(unsigned short h) { return __builtin_bit_cast(float, (unsigned)h << 16); }
__device__ __forceinline__ float wave_sum(float v) {
#pragma unroll
    for (int o = 1; o < 64; o <<= 1) v += __shfl_xor(v, o);
    return v;
}
__device__ __forceinline__ int map_row(int mode, int n) {
    if (mode == 1) { const int h = n / 96, d = n % 96; if (d < 64) return n; const int i = d - 64; return h * 96 + (i < 16 ? 64 + 2 * i : 64 + 2 * (i - 16) + 1); }
    if (mode == 2) { const int h = n >> 7, j = n & 127; return j < 64 ? h * 64 + j : 512 + h * 64 + (j - 64); }
    if (mode == 3) { if (n < 1536 || n >= 1960) return n; if (n < 1544) return 1952 + (n - 1536); if (n < 1800) return 1536 + (n - 1544); if (n < 1928) return 1792 + (n - 1800);
        const int i = n - 1928; return 1920 + (i < 16 ? 2 * i : 2 * (i - 16) + 1); }
    return n;
}
__device__ __forceinline__ void p0_transpose_item(const float* W, int K, int N, int nblk, bf16* WT, int mode, const float* gk, LAS float* scr, int item, int lane) {
    const int kb = item / nblk, nb = item % nblk, k0 = 64 * kb, n0 = 32 * nb;
    const int nn = n0 + (lane & 31);
    float wv[32];
#pragma unroll
    for (int i = 0; i < 32; ++i) { const int kk = 2 * i + (lane >> 5); wv[i] = (nn < N) ? W[(size_t)(k0 + kk) * N + nn] : 0.f; }
    if (gk) {
#pragma unroll
        for (int i = 0; i < 32; ++i) wv[i] *= gk[k0 + 2 * i + (lane >> 5)]; }
#pragma unroll
    for (int i = 0; i < 32; ++i) { const int kk = 2 * i + (lane >> 5); scr[kk * 33 + (lane & 31)] = wv[i]; }
    asm volatile("s_waitcnt lgkmcnt(0)" ::: "memory");
    const int c = lane & 7;
#pragma unroll
    for (int j = 0; j < 4; ++j) { const int n = (lane >> 3) + 8 * j; const LAS float* sp = scr + (8 * c) * 33 + n;
        v4u o; o.x = pk2(sp[0 * 33], sp[1 * 33]); o.y = pk2(sp[2 * 33], sp[3 * 33]); o.z = pk2(sp[4 * 33], sp[5 * 33]); o.w = pk2(sp[6 * 33], sp[7 * 33]);
        *(v4u*)(WT + (size_t)map_row(mode, n0 + n) * K + k0 + 8 * c) = o; }
    asm volatile("s_waitcnt lgkmcnt(0)" ::: "memory");
}
__device__ __forceinline__ void sincos_d(double x, float& sn, float& cs) {
    const double k = rint(x * 0.63661977236758134308);
    double r = fma(-k, 1.57079632679489655800e+00, x); r = fma(-k, 6.12323399573676603587e-17, r);
    const double r2 = r * r;
    double s = -1.0 / 6227020800.0; s = s * r2 + 1.0 / 39916800.0; s = s * r2 - 1.0 / 362880.0; s = s * r2 + 1.0 / 5040.0; s = s * r2 - 1.0 / 120.0; s = s * r2 + 1.0 / 6.0; s = r - r * r2 * s;
    double c = 1.0 / 479001600.0; c = c * r2 - 1.0 / 3628800.0; c = c * r2 + 1.0 / 40320.0; c = c * r2 - 1.0 / 720.0; c = c * r2 + 1.0 / 24.0; c = c * r2 - 0.5; c = 1.0 + r2 * c;
    const int q = ((int)k) & 3;
    const double ss = (q == 0) ? s : (q == 1) ? c : (q == 2) ? -s : -c;
    const double cc = (q == 0) ? c : (q == 1) ? -s : (q == 2) ? -c : s;
    sn = (float)ss; cs = (float)cc;
}

#define RLX_AGENT __ATOMIC_RELAXED, __HIP_MEMORY_SCOPE_AGENT
#define XB_TMO      128
#define XB_XCNT(j)  (256  + 64 * (j))
#define XB_XSUB(j)  (1280 + 64 * (j))
#define XB_XGEN(j)  (2304 + 64 * (j))
#define XB_TOP      3328
#define XB_TOPGEN   3392
#define XCD_BAR_WORDS 3456
#define XB_SPIN_CAP (1u << 18)

__device__ __forceinline__ unsigned xb_ld(unsigned* p)              { return __hip_atomic_load(p, __ATOMIC_RELAXED, __HIP_MEMORY_SCOPE_AGENT); }
__device__ __forceinline__ unsigned xb_add(unsigned* p, unsigned v) { return __hip_atomic_fetch_add(p, v, __ATOMIC_RELAXED, __HIP_MEMORY_SCOPE_AGENT); }
__device__ __forceinline__ unsigned xb_xcc_id() { return (unsigned)__builtin_amdgcn_s_getreg((3 << 11) | 20) & 0xFu; }
#define XB_SPIN(cond, bar) do { unsigned _sp = 0; while (cond) { __builtin_amdgcn_s_sleep(1); \
    if ((++_sp & 255u) == 0u) { if (xb_ld(&(bar)[XB_TMO])) break; if (_sp > XB_SPIN_CAP) { atomicAdd(&(bar)[XB_TMO], 1u); break; } } } } while (0)

struct XcdBarrier {
    unsigned* bar; unsigned x;
    volatile LAS unsigned* st;
};

__device__ __forceinline__ XcdBarrier xcd_barrier_post(unsigned* bar, volatile LAS unsigned* st) {
    XcdBarrier b; b.bar = bar; b.x = xb_xcc_id(); b.st = st;
    if (threadIdx.x == 0) (void)xb_add(&bar[XB_XCNT(b.x)], 1u);
    return b;
}
__device__ __forceinline__ void xcd_barrier_complete(unsigned* bar, unsigned x, unsigned& nloc, unsigned& nx) {
    const unsigned G = gridDim.x * gridDim.y * gridDim.z;
    unsigned sum, cnt, mine, sp = 0u;
    for (;;) {
        sum = 0u; cnt = 0u; mine = 0u;
#pragma unroll
        for (unsigned j = 0; j < 16; ++j) { const unsigned c = xb_ld(&bar[XB_XCNT(j)]); sum += c; cnt += (c > 0u) ? 1u : 0u; mine = (j == x) ? c : mine; }
        if (sum == G) break;
        __builtin_amdgcn_s_sleep(1);
        if ((++sp & 255u) == 0u) { if (xb_ld(&bar[XB_TMO])) break; if (sp > XB_SPIN_CAP) { atomicAdd(&bar[XB_TMO], 1u); break; } }
    }
    nloc = mine > 0u ? mine : 1u; nx = cnt > 0u ? cnt : 1u;
}

__device__ __forceinline__ void xcd_barrier(const XcdBarrier& b) {
    asm volatile("s_waitcnt vmcnt(0)" ::: "memory");
    __syncthreads();
    if (threadIdx.x == 0) {
        unsigned* bar = b.bar;
        __builtin_amdgcn_s_waitcnt(0);
        unsigned nloc = b.st[0], nx = b.st[1];
        if (nloc == 0u) { xcd_barrier_complete(bar, b.x, nloc, nx); b.st[0] = nloc; b.st[1] = nx; }
        const unsigned old = xb_add(&bar[XB_XSUB(b.x)], 1u);
        const unsigned gen = old / nloc;
        if (old + 1u == (gen + 1u) * nloc) {
            __builtin_amdgcn_fence(__ATOMIC_RELEASE, "agent");
            asm volatile("s_waitcnt vmcnt(0)" ::: "memory");
            const unsigned og = xb_add(&bar[XB_TOP], 1u);
            const unsigned tg = og / nx;
            if (og + 1u == (tg + 1u) * nx) xb_add(&bar[XB_TOPGEN], 1u);
            else XB_SPIN(xb_ld(&bar[XB_TOPGEN]) == tg, bar);
            __builtin_amdgcn_fence(__ATOMIC_ACQUIRE, "agent");
            xb_add(&bar[XB_XGEN(b.x)], 1u);
            asm volatile("s_waitcnt vmcnt(0)" ::: "memory");
        } else {
            XB_SPIN(xb_ld(&bar[XB_XGEN(b.x)]) == gen, bar);
            __builtin_amdgcn_fence(__ATOMIC_ACQUIRE, "agent");
            asm volatile("s_waitcnt vmcnt(0)" ::: "memory");
        }
    }
    __syncthreads();
}

constexpr int MISC_OFF = LDS_BYTES - 128;
constexpr size_t WS_CTL = 0, CTL_ZERO_BYTES = 64 * 1024;
constexpr int CW_KMAX = 8192, CW_QF = 8192 + 512, CW_QM = 8192 + 1024, CW_PCNT = 8192 + 1536;
static_assert(att::LDS_BYTES <= MISC_OFF, "LDS map");
struct Args { const float* in[13]; float* out; unsigned char* ws; int ph_lo, ph_hi, dup, pad; };
constexpr int NPHASE = 8;

__global__ void __launch_bounds__(NWAVES * 64, 2) mk_fwd(Args args) {
    extern __shared__ __attribute__((aligned(16))) unsigned char lds_raw[];
    LAS unsigned char* lds = (LAS unsigned char*)lds_raw;
    const int G = gridDim.x, bx = blockIdx.x;
#define MK_IDS int tid = threadIdx.x; asm volatile("" : "+v"(tid)); const int lane = tid & 63, wave = __builtin_amdgcn_readfirstlane(tid >> 6); const int gw = vcu * NWAVES + wave; (void)gw; (void)lane;
    const int vcu = (G % 8 == 0) ? (bx % 8) * (G / 8) + bx / 8 : bx;
    const int NGW = G * NWAVES;
    unsigned char* ws = args.ws;
#define MKP_x ((const float*)args.in[0])
#define MKP_g_mix ((const float*)args.in[1])
#define MKP_w_in ((const float*)args.in[2])
#define MKP_b_f ((const float*)args.in[3])
#define MKP_g_q ((const float*)args.in[4])
#define MKP_w_q_up ((const float*)args.in[5])
#define MKP_g_kv ((const float*)args.in[6])
#define MKP_w_kv_up ((const float*)args.in[7])
#define MKP_w_o ((const float*)args.in[8])
#define MKP_g_mlp ((const float*)args.in[9])
#define MKP_w_ff1 ((const float*)args.in[10])
#define MKP_w_ff2 ((const float*)args.in[11])
#define MKP_g_final ((const float*)args.in[12])
#define MKP_out (args.out)
#define MKP_Win_t ((bf16*)(args.ws + WS_WIN))
#define MKP_Wq_t ((bf16*)(args.ws + WS_WQ))
#define MKP_Wkv_t ((bf16*)(args.ws + WS_WKV))
#define MKP_Wo_t ((bf16*)(args.ws + WS_WO))
#define MKP_W1_t ((bf16*)(args.ws + WS_W1))
#define MKP_W2_t ((bf16*)(args.ws + WS_W2))
#define MKP_RT ((float*)(args.ws + WS_RT))
#define MKP_LF ((float*)(args.ws + WS_LF))
#define MKP_SS ((float*)(args.ws + WS_SS))
#define MKP_SSQ ((float*)(args.ws + WS_SSQ))
#define MKP_BIASF ((float*)(args.ws + WS_BIASF))
#define MKP_QMAX ((float*)(args.ws + WS_LC))
#define MKP_SSKV ((float*)(args.ws + WS_SSKV))
#define MKP_KB ((bf16*)(args.ws + WS_KB))
#define MKP_KR ((bf16*)(args.ws + WS_KR))
#define MKP_XN ((bf16*)(args.ws + WS_XN))
#define MKP_HB ((bf16*)(args.ws + WS_H))
#define MKP_P ((bf16*)(args.ws + WS_P))
#define MKP_QM ((bf16*)(args.ws + WS_QM))
#define MKP_KVM ((bf16*)(args.ws + WS_KVM))
#define MKP_QN ((bf16*)(args.ws + WS_QN))
#define MKP_OB ((bf16*)(args.ws + WS_O))
#define MKP_KVN ((bf16*)(args.ws + WS_KVN))
    const int lo = args.ph_lo, hi = args.ph_hi;
#ifndef MK_MASK
#define MK_MASK 0x1ff
#endif
#define IN(k) (((MK_MASK >> (k)) & 1) && lo <= (k) && (k) < hi)
#define REP(k) for (int rep_ = 0; rep_ < ((args.dup == (k)) ? 2 : 1); ++rep_)
    { volatile LAS unsigned* misc = (volatile LAS unsigned*)(lds + MISC_OFF); if (threadIdx.x < 32) misc[threadIdx.x] = 0u; }
    __syncthreads();
    (void)xcd_barrier_post((unsigned*)(ws + WS_CTL), (volatile LAS unsigned*)(lds + MISC_OFF) + 8);
    if (args.ph_lo < 0) cg::this_grid().sync();
#ifdef TS_PHASE
    unsigned long long ts_a_ = 0, ts_b_ = 0;
#define TS_BEGIN(k) do { if ((k) == TS_PHASE) ts_a_ = __builtin_amdgcn_s_memrealtime(); } while (0)
#define TS_END(k) do { if ((k) == TS_PHASE) ts_b_ = __builtin_amdgcn_s_memrealtime(); } while (0)
#else
#define TS_BEGIN(k)
#define TS_END(k)
#endif
#define SEAM(k) do { if (IN(k) && IN((k) + 1)) { XcdBarrier b_; b_.bar = (unsigned*)(args.ws + WS_CTL); b_.x = xb_xcc_id(); b_.st = (volatile LAS unsigned*)(lds + MISC_OFF) + 8; xcd_barrier(b_); } } while (0)

    TS_BEGIN(0);
    if (IN(0)) { MK_IDS
        LAS float* scr = (LAS float*)(lds + wave * 16384);
        constexpr int I_IN = (D / 64) * (NINP / 32), I_Q = (QL / 64) * (NQU / 32), I_KV = (KVL / 64) * (NKVU / 32), I_O = (D / 64) * (D / 32), I_1 = (D / 64) * (FF / 32), I_2 = (FF / 64) * (D / 32);
        constexpr int NITEMS = I_IN + I_Q + I_KV;
        (void)I_O; (void)I_1; (void)I_2;
        for (int it = gw; it < NITEMS; it += NGW) {
            int r = it;
            if (r < I_IN) { p0_transpose_item(MKP_w_in, D, NIN, NINP / 32, MKP_Win_t, 3, nullptr, scr, r, lane); continue; } r -= I_IN;
            if (r < I_Q) { p0_transpose_item(MKP_w_q_up, QL, NQU, NQU / 32, MKP_Wq_t, 1, MKP_g_q, scr, r, lane); continue; } r -= I_Q;
            p0_transpose_item(MKP_w_kv_up, KVL, NKVU, NKVU / 32, MKP_Wkv_t, 2, MKP_g_kv, scr, r, lane);
        }
        for (int m0 = gw; m0 < M; m0 += 4 * NGW) {
            const f32x4* gr = (const f32x4*)MKP_g_mix + lane; f32x4 v[4][4]; float s2[4];
#pragma unroll
            for (int r = 0; r < 4; ++r) { const int m = m0 + r * NGW; const f32x4* xr = (const f32x4*)(MKP_x + (size_t)(m < M ? m : 0) * D) + lane;
#pragma unroll
                for (int j = 0; j < 4; ++j) v[r][j] = xr[64 * j]; }
#pragma unroll
            for (int r = 0; r < 4; ++r) { s2[r] = 0.f;
#pragma unroll
                for (int j = 0; j < 4; ++j) s2[r] += (v[r][j].x * v[r][j].x + v[r][j].y * v[r][j].y) + (v[r][j].z * v[r][j].z + v[r][j].w * v[r][j].w);
                s2[r] = 1.f / sqrtf(wave_sum(s2[r]) * (1.f / D) + EPS); }
#pragma unroll
            for (int r = 0; r < 4; ++r) { const int m = m0 + r * NGW; if (m < M) { unsigned long long* o8 = (unsigned long long*)(MKP_XN + (size_t)m * D) + lane; const float rstd = s2[r];
#pragma unroll
                for (int j = 0; j < 4; ++j) { const f32x4 g = gr[64 * j]; o8[64 * j] = (unsigned long long)pk2(v[r][j].x * rstd * g.x, v[r][j].y * rstd * g.y) | ((unsigned long long)pk2(v[r][j].z * rstd * g.z, v[r][j].w * rstd * g.w) << 32); } } }
        }
        for (int e = (vcu * NWAVES * 64 + tid); e < M * 16; e += G * NWAVES * 64) {
            const int m = e >> 4, i = e & 15; double inv = 1.0; for (int j = 0; j < i; ++j) inv *= 0.56234132519034908039;
            float sn, cs; sincos_d((double)m * inv, sn, cs); MKP_RT[2 * e] = cs; MKP_RT[2 * e + 1] = sn;
        }
    }
    SEAM(0);
    TS_END(0);
    TS_BEGIN(1);
    if (IN(1)) {
        pg8::Gemm g{MKP_XN, MKP_Win_t, M, NINP, D}; pg8::StaticOrder S; S.init(M, NINP, G, bx);
        pg8::EpiIn E{MKP_P, NINP, C2_FOX, MKP_SSQ, MKP_SSKV, MKP_RT, MKP_b_f, MKP_LF, M};
        pg8::gemm_phase<pg8::EpiIn, pg8::StaticOrder, PG8_ALIGN, PG8_SP2>(lds, g, S, E);
    }
    SEAM(1);
    TS_END(1);
    TS_BEGIN(3);
    if (IN(3)) { MK_IDS
        if (wave >= 2) {
            LAS float* scr = (LAS float*)(lds + wave * 16384);
            constexpr int J_O = (D / 64) * (D / 32), J_1 = (D / 64) * (FF / 32), J_2 = (FF / 64) * (D / 32);
            for (int it = vcu * 6 + (wave - 2); it < J_O + J_1 + J_2; it += G * 6) {
                int r = it;
                if (r < J_O) { p0_transpose_item(MKP_w_o, D, D, D / 32, MKP_Wo_t, 0, nullptr, scr, r, lane); continue; } r -= J_O;
                if (r < J_1) { p0_transpose_item(MKP_w_ff1, D, FF, FF / 32, MKP_W1_t, 0, MKP_g_mlp, scr, r, lane); continue; } r -= J_1;
                p0_transpose_item(MKP_w_ff2, FF, D, D / 32, MKP_W2_t, 0, nullptr, scr, r, lane);
            }
        }
        if (wave < 2) { const int job = bx + 256 * wave;
            if (job < 512 && bx < 256) { const int h = job >> 6, ti = job & 63; const f32x4* lf4 = (const f32x4*)(MKP_LF + (size_t)h * M);
                float pre = 0.f; { int j = 0; float pa[8] = {0.f, 0.f, 0.f, 0.f, 0.f, 0.f, 0.f, 0.f};
                    for (; j + 8 <= ti; j += 8) { f32x4 w[8];
#pragma unroll
                        for (int u = 0; u < 8; ++u) w[u] = lf4[(j + u) * 64 + lane];
#pragma unroll
                        for (int u = 0; u < 8; ++u) pa[u] += (w[u].x + w[u].y) + (w[u].z + w[u].w); }
                    for (; j < ti; ++j) { const f32x4 w = lf4[j * 64 + lane]; pa[0] += (w.x + w.y) + (w.z + w.w); }
                    pre = ((pa[0] + pa[1]) + (pa[2] + pa[3])) + ((pa[4] + pa[5]) + (pa[6] + pa[7])); }
                pre = wave_sum(pre);
                const f32x4 v = lf4[ti * 64 + lane];
                const float s1 = v.x, s2 = s1 + v.y, s3 = s2 + v.z, s4 = s3 + v.w; float inc = s4;
#pragma unroll
                for (int o = 1; o < 64; o <<= 1) { const float n = __shfl_up(inc, o); if (lane >= o) inc += n; }
                const float ex = pre + (inc - s4); const float cs[4] = {ex + s1, ex + s2, ex + s3, ex + s4};
                *(f32x4*)(MKP_BIASF + (size_t)h * M + ti * 256 + 4 * lane) = (f32x4){-cs[0] * LOG2E, -cs[1] * LOG2E, -cs[2] * LOG2E, -cs[3] * LOG2E};
                { float km = 0.f;
                  float qmx = 0.f;
                  for (int e = 0; e < 4; ++e) { const v4u* kr = (const v4u*)(MKP_P + (size_t)(ti * 256 + 4 * lane + e) * NINP + 512 + h * 64); float a2 = 0.f; const v4u* qrw = kr - 64; float q2 = 0.f;
#pragma unroll
                      for (int c8 = 0; c8 < 8; ++c8) { const v4u w = qrw[c8]; const unsigned ww[4] = {w.x, w.y, w.z, w.w};
#pragma unroll
                          for (int q4 = 0; q4 < 4; ++q4) { const float lo_ = __builtin_bit_cast(float, ww[q4] << 16), hi_ = __builtin_bit_cast(float, ww[q4] & 0xffff0000u); q2 += lo_ * lo_ + hi_ * hi_; } }
                      qmx = fmaxf(qmx, q2);
#pragma unroll
                      for (int c8 = 0; c8 < 8; ++c8) { const v4u w = kr[c8]; const unsigned ww[4] = {w.x, w.y, w.z, w.w};
#pragma unroll
                          for (int q4 = 0; q4 < 4; ++q4) { const float lo_ = __builtin_bit_cast(float, ww[q4] << 16), hi_ = __builtin_bit_cast(float, ww[q4] & 0xffff0000u); a2 += lo_ * lo_ + hi_ * hi_; } }
                      km = fmaxf(km, a2); }
#pragma unroll
                  for (int o = 32; o >= 1; o >>= 1) km = fmaxf(km, __shfl_xor(km, o));
#pragma unroll
                  for (int o = 32; o >= 1; o >>= 1) qmx = fmaxf(qmx, __shfl_xor(qmx, o));
                  if (lane == 0) { atomicMax((unsigned*)(args.ws + WS_CTL) + CW_KMAX + 64 * h, __builtin_bit_cast(unsigned, km)); MKP_QMAX[h * 64 + ti] = qmx; } }
#pragma unroll
                for (int e = 0; e < 4; ++e) { const float b = -cs[e] * LOG2E; const unsigned bh = f2bf(b); const float r1 = b - __builtin_bit_cast(float, bh << 16); const unsigned bm = f2bf(r1);
                    const float r2 = r1 - __builtin_bit_cast(float, bm << 16); const unsigned bl = f2bf(r2);
                    *(v4u*)(MKP_KB + ((size_t)h * M + ti * 256 + 4 * lane + e) * 8) = (v4u){bh | (bm << 16), bl | 0x3F800000u, 0x3F803F80u, 0u}; } } }
        __syncthreads();
        { int kq = QL; asm volatile("" : "+s"(kq)); pg8::Gemm g{MKP_P + 1536, MKP_Wq_t, M, NQU, kq, NINP}; pg8::StaticOrder S; S.init(M, NQU, G, bx);
          pg8::EpiQm E{MKP_QM, NQU, MKP_RT, C2_MLA, MKP_SSQ, EPS};
          pg8::gemm_phase<pg8::EpiQm, pg8::StaticOrder, PG8_ALIGN, PG8_SP2>(lds, g, S, E); }
        { int kkv = KVL; asm volatile("" : "+s"(kkv)); pg8::Gemm g{MKP_P + 1792, MKP_Wkv_t, M, NKVU, kkv, NINP}; pg8::StaticOrder S; S.init(M, NKVU, G, bx);
          pg8::EpiKv E{MKP_KVM, NKVU, MKP_SSKV, EPS};
          pg8::gemm_phase<pg8::EpiKv, pg8::StaticOrder, PG8_ALIGN, PG8_SP2>(lds, g, S, E); }
    }
    SEAM(3);
    TS_END(3);
    TS_BEGIN(4);
    if (IN(4)) {
        const int v = (G == 256) ? vcu : bx; const int h0 = (v >> 5) & 7;
#ifdef ATT_PRIO
        if ((threadIdx.x >> 6) >= 4) __builtin_amdgcn_s_setprio(1);
#endif
        volatile LAS unsigned* misc = (volatile LAS unsigned*)(lds + MISC_OFF);
        unsigned* ctlw = (unsigned*)(args.ws + WS_CTL);
#ifndef PROBE_FOX
#define PROBE_FOX 1
#endif
#ifndef PROBE_MLA
#define PROBE_MLA 1
#endif
        for (int rep = 0; rep < PROBE_FOX; ++rep)
        for (int k = 0; k < 8; ++k) { const int h = (h0 + k) & 7;
            const float kmax2 = __builtin_bit_cast(float, __hip_atomic_load(ctlw + CW_KMAX + 64 * h, __ATOMIC_RELAXED, __HIP_MEMORY_SCOPE_AGENT));
            att::Src s{MKP_P + h * 64, NINP, MKP_P + 512 + h * 64, NINP, MKP_KB + (size_t)h * M * 8, 8, MKP_P + 1024 + h * 64, NINP, MKP_OB + h * 64, D};
            for (;;) {
                if (threadIdx.x == 0) misc[0] = __hip_atomic_fetch_add(ctlw + CW_QF + 64 * h + 16 * rep, 1u, __ATOMIC_RELAXED, __HIP_MEMORY_SCOPE_AGENT);
                __syncthreads(); const unsigned i = misc[0]; __syncthreads();
                if (i >= 64u) break;
                att::attn_unit<false>(63 - (int)i, s, lds, MKP_BIASF + (size_t)h * M, kmax2, MKP_QMAX + h * 64);
            } }
        asm volatile("" ::: "memory");
        for (int rep = 0; rep < PROBE_MLA; ++rep)
        for (int k = 0; k < 8; ++k) { const int h = (h0 + k) & 7;
            att::Src s{MKP_QM + h * 96, NQU, MKP_KVM + h * 64, NKVU, MKP_P + 1920, NINP, MKP_KVM + 512 + h * 64, NKVU, MKP_OB + 512 + h * 64, D};
            for (;;) {
                if (threadIdx.x == 0) misc[0] = __hip_atomic_fetch_add(ctlw + CW_QM + 64 * h + 16 * rep, 1u, __ATOMIC_RELAXED, __HIP_MEMORY_SCOPE_AGENT);
                __syncthreads(); const unsigned i = misc[0]; __syncthreads();
                if (i >= 64u) break;
                att::attn_unit<true>(63 - (int)i, s, lds, nullptr, 0.f, nullptr);
            } }
    }
#ifdef ATT_PRIO
    __builtin_amdgcn_s_setprio(0);
#endif
    SEAM(4);
    TS_END(4);
    TS_BEGIN(5);
    if (IN(5)) {
        pg8::Gemm g{MKP_OB, MKP_Wo_t, M, D, D}; pg8::StaticOrder S; S.init(M, D, G, bx);
        pg8::EpiRes E{MKP_x, MKP_out, D, MKP_XN, MKP_SS};
        pg8::gemm_phase<pg8::EpiRes, pg8::StaticOrder, PG8_ALIGN, PG8_SP2>(lds, g, S, E);
    }
    SEAM(5);
    TS_END(5);
    TS_BEGIN(6);
    if (IN(6)) {
        pg8::Gemm g{MKP_XN, MKP_W1_t, M, FF, D}; pg8::StaticOrder S; S.init(M, FF, G, bx);
        pg8::EpiSqRelu E{MKP_HB, FF, MKP_SS, EPS, 1.f / D};
        pg8::gemm_phase<pg8::EpiSqRelu, pg8::StaticOrder, PG8_ALIGN, PG8_SP2>(lds, g, S, E);
    }
    SEAM(6);
    TS_END(6);
    TS_BEGIN(7);
    if (IN(7)) {
        pg8::Gemm g{MKP_HB, MKP_W2_t, M, D, FF}; pg8::StaticOrder S; S.init(M, D, G, bx);
        pg8::EpiResNorm E{MKP_out, MKP_out, D, MKP_g_final, MKP_SSQ, (unsigned*)(args.ws + WS_CTL) + CW_PCNT, EPS, 1.f / D};
        pg8::gemm_phase<pg8::EpiResNorm, pg8::StaticOrder, false, PG8_SP2>(lds, g, S, E);
    }
#ifdef TS_PHASE
    { XcdBarrier b_; b_.bar = (unsigned*)(args.ws + WS_CTL); b_.x = xb_xcc_id(); b_.st = (volatile LAS unsigned*)(lds + MISC_OFF) + 8; xcd_barrier(b_); }
    TS_END(7);
    if (blockIdx.x == 0 && threadIdx.x == 0) MKP_out[0] = (float)(((ts_b_ - ts_a_) / TS_Q) * (TS_Q / 100ull));
#endif
#undef IN
#undef SEAM
#undef MKP_x
#undef MKP_g_mix
#undef MKP_w_in
#undef MKP_b_f
#undef MKP_g_q
#undef MKP_w_q_up
#undef MKP_g_kv
#undef MKP_w_kv_up
#undef MKP_w_o
#undef MKP_g_mlp
#undef MKP_w_ff1
#undef MKP_w_ff2
#undef MKP_g_final
#undef MKP_out
#undef MKP_Win_t
#undef MKP_Wq_t
#undef MKP_Wkv_t
#undef MKP_Wo_t
#undef MKP_W1_t
#undef MKP_W2_t
#undef MKP_RT
#undef MKP_LF
#undef MKP_SS
#undef MKP_SSQ
#undef MKP_BIASF
#undef MKP_QMAX
#undef MKP_SSKV
#undef MKP_KB
#undef MKP_KR
#undef MKP_XN
#undef MKP_HB
#undef MKP_P
#undef MKP_QM
#undef MKP_KVM
#undef MKP_QN
#undef MKP_OB
#undef MKP_KVN
}

#ifndef MK_ONE_LAUNCH
#define MK_ONE_LAUNCH 1
#endif
extern "C" void kernel_launch(void* const* d_in, const int* in_sizes, int n_in, void* d_out, int out_size, void* d_ws, size_t ws_size, hipStream_t stream) {
    static int ready = 0;
    if (ready == 0) {
        if (n_in != 13 || in_sizes[0] != M * D || out_size != M * D || ws_size < WS_END) { fprintf(stderr, "kernel_launch: unexpected shapes (n_in %d, in0 %d, out %d, ws %zu)\n", n_in, n_in > 0 ? in_sizes[0] : -1, out_size, ws_size); ready = -1; return; }
        if (hipFuncSetAttribute((const void*)mk_fwd, hipFuncAttributeMaxDynamicSharedMemorySize, LDS_BYTES) != hipSuccess) { fprintf(stderr, "kernel_launch: hipFuncSetAttribute failed\n"); ready = -1; return; }
        ready = 1;
    }
    if (ready < 0) return;
    if (hipMemsetAsync((char*)d_ws + WS_CTL, 0, CTL_ZERO_BYTES, stream) != hipSuccess) { fprintf(stderr, "kernel_launch: hipMemsetAsync failed\n"); return; }
    Args a{};
    for (int i = 0; i < 13; ++i) a.in[i] = (const float*)d_in[i];
    a.out = (float*)d_out; a.ws = (unsigned char*)d_ws;
#ifndef MK_DUP
#define MK_DUP -1
#endif
    a.dup = MK_DUP;
    const int grid = 256;
#if MK_ONE_LAUNCH
    a.ph_lo = 0; a.ph_hi = NPHASE;
    void* kargs[] = {&a};
    hipError_t e = hipLaunchCooperativeKernel((const void*)mk_fwd, dim3(grid), dim3(NWAVES * 64), kargs, LDS_BYTES, stream);
    if (e != hipSuccess) fprintf(stderr, "kernel_launch: cooperative launch failed: %s\n", hipGetErrorString(e));
#else
    for (int p = 0; p < NPHASE; ++p) { a.ph_lo = p; a.ph_hi = p + 1; hipLaunchKernelGGL(mk_fwd, dim3(grid), dim3(NWAVES * 64), LDS_BYTES, stream, a); }
#endif
}
```

```cpp
#include <hip/hip_runtime.h>
#include <hip/hip_cooperative_groups.h>
#include <hip/hip_bf16.h>
#include <cstdio>
#include <cstdint>
#include <cmath>
namespace pg8 {
#define PG8_LAS __attribute__((address_space(3)))
typedef unsigned short bf16_t;
typedef short bf16x8 __attribute__((ext_vector_type(8)));
typedef float f32x4 __attribute__((ext_vector_type(4)));
typedef unsigned u32x4 __attribute__((ext_vector_type(4)));
constexpr int BM = 256, BK = 64, HALF = 128, HTB = HALF * BK * 2  , STAGE_BYTES = 8 * HTB, NXCD = 8, WGM = 8;

__host__ __device__ __forceinline__ int lds_byte(int r, int c) { const int st = (r >> 4) * 2 + (c >> 5), rr = r & 15, cc = c & 31, ob = rr * 64 + cc * 2; return st * 1024 + (ob ^ (((ob >> 9) & 1) << 5)); }
__host__ __device__ __forceinline__ void stage_rc(int b, int& R, int& C) { const int st = b / 1024, sb = b % 1024, swz = sb ^ (((sb >> 9) & 1) << 5); R = (st >> 1) * 16 + swz / 64; C = (st & 1) * 32 + (swz % 64) / 2; }
__host__ __device__ __forceinline__ int perm32(int rho) { const int n = rho >> 4, i = rho & 15; return 8 * (i >> 2) + 4 * n + (i & 3); }

struct Unit { int pm, pn; };
struct Gemm { const bf16_t* A; const bf16_t* Bt; int M, N, K; int lda; };

struct StaticOrder {
    int nM, nN, nwg, G, c;
    __host__ __device__ void init(int M, int N, int G_, int c_) { nM = M / BM; nN = N / BM; nwg = nM * nN; G = G_; c = c_; }
    __host__ __device__ bool next(int i, Unit& u) const {
        const long L = (long)i * G + c; if (L >= nwg) return false;
        int wgid = (int)L; { const int q = nwg / NXCD, r = nwg % NXCD, xcd = wgid % NXCD, off = wgid / NXCD; wgid = (xcd < r ? xcd * (q + 1) : r * (q + 1) + (xcd - r) * q) + off; }
        const int nig = WGM * nN, gid = wgid / nig, fm = gid * WGM, gsz = (nM - fm) < WGM ? (nM - fm) : WGM;
        u.pm = fm + ((wgid % nig) % gsz); u.pn = (wgid % nig) / gsz; return true;
    }
    __device__ __forceinline__ void a_ready(const Unit&) const {}
    __device__ __forceinline__ void done(const Unit&) const {}
};

__device__ __forceinline__ unsigned cvt_pk_bf16(float lo, float hi) { unsigned r; asm volatile("v_cvt_pk_bf16_f32 %0, %1, %2" : "=v"(r) : "v"(lo), "v"(hi)); return r; }
typedef float f32x2 __attribute__((ext_vector_type(2)));
__device__ __forceinline__ f32x2 gelu_pk(f32x2 v) {
    const f32x2 av = __builtin_elementwise_abs(v), d = av * 0.2316418882f + 1.0f;
    f32x2 t; t.x = __builtin_amdgcn_rcpf(d.x); t.y = __builtin_amdgcn_rcpf(d.y);
    f32x2 q = t * 0.5307027145f + (-0.7265760135f); q = q * t + 0.7107068705f; q = q * t + (-0.142248368f); q = q * t + 0.127414796f; q = q * t;
    const f32x2 s = (v * v) * (-0.72134752044f);
    f32x2 e; e.x = __builtin_amdgcn_exp2f(s.x); e.y = __builtin_amdgcn_exp2f(s.y);
    const f32x2 m = v * (q * e), r = v - m;
    f32x2 o; o.x = v.x < 0.f ? m.x : r.x; o.y = v.y < 0.f ? m.y : r.y; return o;
}

template <int ACT  > struct EpiBf16 {
    static constexpr bool PERM = true, AFTER_DRAIN = false; static_assert(ACT == 0 || ACT == 1, "EpiBf16: ACT is 0 (none) or 1 (gelu_pk)");
    bf16_t* O; int ldc; const float* bias; int split_cols; size_t split_stride; float scale0;
    __device__ __forceinline__ void operator()(const f32x4 (&acc)[2][2][4][2], const Unit& u, int wr, int wc, int fr, int fq) const {
        const int row0 = u.pm * BM + wr * 64 + fr; int colt = u.pn * BM; bf16_t* base = O;
        float sc = 1.f; if (split_cols) { const int t = colt / split_cols; base += (size_t)t * split_stride; colt -= t * split_cols; if (t == 0) sc = scale0; }
        const int col0 = colt + wc * 32 + 8 * fq, bcol0 = u.pn * BM + wc * 32 + 8 * fq;
        f32x4 bv[2][2];
#pragma unroll
        for (int bj = 0; bj < 2; ++bj)
#pragma unroll
            for (int n = 0; n < 2; ++n) bv[bj][n] = bias ? *(const f32x4*)(bias + bcol0 + bj * HALF + 4 * n) : (f32x4){0.f, 0.f, 0.f, 0.f};
#pragma unroll
        for (int ai = 0; ai < 2; ++ai)
#pragma unroll
            for (int m = 0; m < 4; ++m) { bf16_t* rowp = base + (size_t)(row0 + ai * HALF + m * 16) * ldc + col0;
#pragma unroll
                for (int bj = 0; bj < 2; ++bj) { f32x4 v0 = acc[ai][bj][m][0] + bv[bj][0], v1 = acc[ai][bj][m][1] + bv[bj][1];
                    if (ACT == 1) { f32x2 a = gelu_pk((f32x2){v0[0], v0[1]}), b = gelu_pk((f32x2){v0[2], v0[3]}), c = gelu_pk((f32x2){v1[0], v1[1]}), d = gelu_pk((f32x2){v1[2], v1[3]});
                        v0 = (f32x4){a.x, a.y, b.x, b.y}; v1 = (f32x4){c.x, c.y, d.x, d.y}; }
                    v0 = v0 * sc; v1 = v1 * sc; u32x4 w; w.x = cvt_pk_bf16(v0[0], v0[1]); w.y = cvt_pk_bf16(v0[2], v0[3]); w.z = cvt_pk_bf16(v1[0], v1[1]); w.w = cvt_pk_bf16(v1[2], v1[3]);
                    *(u32x4*)(rowp + bj * HALF) = w; } }
    }
};

struct EpiQm {
    static constexpr bool PERM = true, AFTER_DRAIN = false;
    bf16_t* O; int ldc; const float* rt; float scale; const float* ssq; float eps;
    __device__ __forceinline__ void operator()(const f32x4 (&acc)[2][2][4][2], const Unit& u, int wr, int wc, int fr, int fq) const {
        const int row0 = u.pm * BM + wr * 64 + fr, col0 = u.pn * BM + wc * 32 + 8 * fq;
#pragma unroll
        for (int ai = 0; ai < 2; ++ai)
#pragma unroll
            for (int m = 0; m < 4; ++m) { const int row = row0 + ai * HALF + m * 16;
                const f32x4 sq = *(const f32x4*)(ssq + (size_t)row * 4); const float rs = scale / sqrtf(((sq[0] + sq[1]) + (sq[2] + sq[3])) * (1.0f / 256.0f) + eps);
#pragma unroll
                for (int bj = 0; bj < 2; ++bj) { const int c = col0 + bj * HALF, d = c % 96;
                    f32x4 v0 = acc[ai][bj][m][0], v1 = acc[ai][bj][m][1];
                    if (d >= 64) { const f32x4* t = (const f32x4*)(rt + (size_t)row * 32 + (d - 64)); const f32x4 t0 = t[0], t1 = t[1];
                        f32x4 w0, w1;
                        w0[0] = v0[0] * t0[0] - v0[1] * t0[1]; w0[1] = v0[1] * t0[0] + v0[0] * t0[1];
                        w0[2] = v0[2] * t0[2] - v0[3] * t0[3]; w0[3] = v0[3] * t0[2] + v0[2] * t0[3];
                        w1[0] = v1[0] * t1[0] - v1[1] * t1[1]; w1[1] = v1[1] * t1[0] + v1[0] * t1[1];
                        w1[2] = v1[2] * t1[2] - v1[3] * t1[3]; w1[3] = v1[3] * t1[2] + v1[2] * t1[3];
                        v0 = w0; v1 = w1; }
                    v0 = v0 * rs; v1 = v1 * rs; u32x4 w; w.x = cvt_pk_bf16(v0[0], v0[1]); w.y = cvt_pk_bf16(v0[2], v0[3]); w.z = cvt_pk_bf16(v1[0], v1[1]); w.w = cvt_pk_bf16(v1[2], v1[3]);
                    *(u32x4*)(O + (size_t)row * ldc + c) = w; }
                asm volatile("" ::: "memory"); }
    }
};

struct EpiKv {
    static constexpr bool PERM = true, AFTER_DRAIN = false;
    bf16_t* O; int ldc; const float* ssq; float eps;
    __device__ __forceinline__ void operator()(const f32x4 (&acc)[2][2][4][2], const Unit& u, int wr, int wc, int fr, int fq) const {
        const int row0 = u.pm * BM + wr * 64 + fr, col0 = u.pn * BM + wc * 32 + 8 * fq;
#pragma unroll
        for (int ai = 0; ai < 2; ++ai)
#pragma unroll
            for (int m = 0; m < 4; ++m) { const int row = row0 + ai * HALF + m * 16;
                const f32x4 sq = *(const f32x4*)(ssq + (size_t)row * 4); const float rs = 1.0f / sqrtf(((sq[0] + sq[1]) + (sq[2] + sq[3])) * (1.0f / 128.0f) + eps);
#pragma unroll
                for (int bj = 0; bj < 2; ++bj) { const f32x4 v0 = acc[ai][bj][m][0] * rs, v1 = acc[ai][bj][m][1] * rs;
                    u32x4 w; w.x = cvt_pk_bf16(v0[0], v0[1]); w.y = cvt_pk_bf16(v0[2], v0[3]); w.z = cvt_pk_bf16(v1[0], v1[1]); w.w = cvt_pk_bf16(v1[2], v1[3]);
                    *(u32x4*)(O + (size_t)row * ldc + col0 + bj * HALF) = w; }
                asm volatile("" ::: "memory"); }
    }
};
struct EpiIn {
    static constexpr bool PERM = true, AFTER_DRAIN = false;
    bf16_t* O; int ldc; float scale0; float* ssq; float* sskv; const float* rt; const float* bf; float* lf; int nrows;
    __device__ __forceinline__ void operator()(const f32x4 (&acc)[2][2][4][2], const Unit& u, int wr, int wc, int fr, int fq) const {
        const int row0 = u.pm * BM + wr * 64 + fr, col0 = u.pn * BM + wc * 32 + 8 * fq; const int pn = u.pn;
        const float sc = pn < 2 ? scale0 : 1.f;
#pragma unroll
        for (int ai = 0; ai < 2; ++ai)
#pragma unroll
            for (int m = 0; m < 4; ++m) { const int row = row0 + ai * HALF + m * 16; bf16_t* rowp = O + (size_t)row * ldc + col0; float s0 = 0.f, s1 = 0.f;
#pragma unroll
                for (int bj = 0; bj < 2; ++bj) { f32x4 v0 = acc[ai][bj][m][0] * sc, v1 = acc[ai][bj][m][1] * sc;
                    const float sq = ((v0[0] * v0[0] + v0[1] * v0[1]) + (v0[2] * v0[2] + v0[3] * v0[3])) + ((v1[0] * v1[0] + v1[1] * v1[1]) + (v1[2] * v1[2] + v1[3] * v1[3]));
                    if (bj == 0) s0 = sq; else s1 = sq;
                    bool store = true;
                    if (pn == 7 && bj == 1) { store = (wc == 0);
                        if (wc == 0) { const f32x4* t = (const f32x4*)(rt + (size_t)row * 32 + 8 * fq); const f32x4 t0 = t[0], t1 = t[1]; f32x4 w0, w1;
                            w0[0] = v0[0] * t0[0] - v0[1] * t0[1]; w0[1] = v0[1] * t0[0] + v0[0] * t0[1];
                            w0[2] = v0[2] * t0[2] - v0[3] * t0[3]; w0[3] = v0[3] * t0[2] + v0[2] * t0[3];
                            w1[0] = v1[0] * t1[0] - v1[1] * t1[1]; w1[1] = v1[1] * t1[0] + v1[0] * t1[1];
                            w1[2] = v1[2] * t1[2] - v1[3] * t1[3]; w1[3] = v1[3] * t1[2] + v1[2] * t1[3];
                            v0 = w0; v1 = w1; }
                        else if (wc == 1 && fq == 0) {
#pragma unroll
                            for (int e = 0; e < 8; ++e) { const float z = (e < 4 ? v0[e & 3] : v1[e & 3]) + bf[e]; lf[(size_t)e * nrows + row] = fminf(z, 0.f) - 0.6931471805599453f * __builtin_amdgcn_logf(1.0f + __builtin_amdgcn_exp2f(-1.4426950408889634f * fabsf(z))); } } }
                    if (store) { u32x4 w; w.x = cvt_pk_bf16(v0[0], v0[1]); w.y = cvt_pk_bf16(v0[2], v0[3]); w.z = cvt_pk_bf16(v1[0], v1[1]); w.w = cvt_pk_bf16(v1[2], v1[3]);
                        *(u32x4*)(rowp + bj * HALF) = w; } }
                if (pn == 6) { float s = s0 + s1; s += __shfl_xor(s, 16); s += __shfl_xor(s, 32); if (fq == 0) ssq[(size_t)row * 4 + wc] = s; }
                if (pn == 7) { float s = s0; s += __shfl_xor(s, 16); s += __shfl_xor(s, 32); if (fq == 0) sskv[(size_t)row * 4 + wc] = s; }
                asm volatile("" ::: "memory"); }
    }
};
struct EpiRes {
    static constexpr bool PERM = false, AFTER_DRAIN = false;
    const float* base; float* out; int ldc; bf16_t* ob; float* ss;
    __device__ __forceinline__ void operator()(const f32x4 (&acc)[2][2][4][2], const Unit& u, int wr, int wc, int fr, int fq) const {
        typedef unsigned u32x2v __attribute__((ext_vector_type(2)));
        const int row0 = u.pm * BM + wr * 64 + fr, col0 = u.pn * BM + wc * 32 + 4 * fq;
#pragma unroll
        for (int ai = 0; ai < 2; ++ai)
#pragma unroll
            for (int m = 0; m < 4; ++m) { const int row = row0 + ai * HALF + m * 16; const size_t off = (size_t)row * ldc + col0; float s = 0.f;
#pragma unroll
                for (int bj = 0; bj < 2; ++bj)
#pragma unroll
                    for (int n = 0; n < 2; ++n) { const f32x4 v = *(const f32x4*)(base + off + bj * HALF + n * 16) + acc[ai][bj][m][n];
                        *(f32x4*)(out + off + bj * HALF + n * 16) = v; s += (v[0] * v[0] + v[1] * v[1]) + (v[2] * v[2] + v[3] * v[3]);
                        if (ob) { u32x2v w; w.x = cvt_pk_bf16(v[0], v[1]); w.y = cvt_pk_bf16(v[2], v[3]); *(u32x2v*)(ob + off + bj * HALF + n * 16) = w; } }
                if (ss) { s += __shfl_xor(s, 16); s += __shfl_xor(s, 32); if (fq == 0) ss[(size_t)row * 16 + u.pn * 4 + wc] = s; }
                asm volatile("" ::: "memory");
            }
    }
};

struct EpiResNorm {
    static constexpr bool PERM = false, AFTER_DRAIN = true;
    const float* base; float* out; int ldc; const float* g; float* xs; unsigned* cnt; float eps; float inv_n;
    __device__ __forceinline__ void fused(f32x4 (&acc)[2][2][4][2], const Unit& u, int wr, int wc, int fr, int fq, PG8_LAS unsigned char* lds, int wid, int lane) const {
        PG8_LAS float* Pm = (PG8_LAS float*)lds;
        PG8_LAS float* S = (PG8_LAS float*)(lds + 4096);
        const int row0 = u.pm * BM + wr * 64 + fr, col0 = u.pn * BM + wc * 32 + 4 * fq;
#pragma unroll
        for (int ai = 0; ai < 2; ++ai)
#pragma unroll
            for (int m = 0; m < 4; ++m) { const size_t off = (size_t)(row0 + ai * HALF + m * 16) * ldc + col0; float s = 0.f;
#pragma unroll
                for (int bj = 0; bj < 2; ++bj)
#pragma unroll
                    for (int n = 0; n < 2; ++n) { const f32x4 v = *(const f32x4*)(base + off + bj * HALF + n * 16) + acc[ai][bj][m][n]; acc[ai][bj][m][n] = v;
                        s += (v[0] * v[0] + v[1] * v[1]) + (v[2] * v[2] + v[3] * v[3]); }
                s += __shfl_xor(s, 16); s += __shfl_xor(s, 32);
                if (fq == 0) Pm[(ai * HALF + wr * 64 + m * 16 + fr) * 4 + wc] = s;
                if (m & 1) asm volatile("" ::: "memory"); }
        asm volatile("s_waitcnt lgkmcnt(0)" ::: "memory"); __builtin_amdgcn_s_barrier(); asm volatile("" ::: "memory");
        const int tid = wid * 64 + lane;
        if (tid < 256) { const f32x4 p4 = *(const PG8_LAS f32x4*)(Pm + tid * 4);
            __hip_atomic_store(xs + (size_t)(u.pm * BM + tid) * 4 + u.pn, (p4[0] + p4[1]) + (p4[2] + p4[3]), __ATOMIC_RELAXED, __HIP_MEMORY_SCOPE_AGENT);
            asm volatile("s_waitcnt vmcnt(0)" ::: "memory");
            if (lane == 0) __hip_atomic_fetch_add(cnt + 64 * u.pm, 1u, __ATOMIC_RELAXED, __HIP_MEMORY_SCOPE_AGENT); }
        if (wid == 0) { unsigned sp = 0;
            while ((unsigned)__builtin_amdgcn_readfirstlane(__hip_atomic_load(cnt + 64 * u.pm, __ATOMIC_RELAXED, __HIP_MEMORY_SCOPE_AGENT)) < 16u) { __builtin_amdgcn_s_sleep(2); if (++sp > (1u << 22)) break; }
            __builtin_amdgcn_fence(__ATOMIC_ACQUIRE, "agent"); }
        asm volatile("s_waitcnt vmcnt(0) lgkmcnt(0)" ::: "memory"); __builtin_amdgcn_s_barrier(); asm volatile("" ::: "memory");
        if (tid < 256) { const float* xp = xs + (size_t)(u.pm * BM + tid) * 4;
            const float t0 = __hip_atomic_load(xp + 0, __ATOMIC_RELAXED, __HIP_MEMORY_SCOPE_AGENT), t1 = __hip_atomic_load(xp + 1, __ATOMIC_RELAXED, __HIP_MEMORY_SCOPE_AGENT);
            const float t2 = __hip_atomic_load(xp + 2, __ATOMIC_RELAXED, __HIP_MEMORY_SCOPE_AGENT), t3 = __hip_atomic_load(xp + 3, __ATOMIC_RELAXED, __HIP_MEMORY_SCOPE_AGENT);
            S[tid] = 1.0f / sqrtf(((t0 + t1) + (t2 + t3)) * inv_n + eps); }
        asm volatile("s_waitcnt vmcnt(0) lgkmcnt(0)" ::: "memory"); __builtin_amdgcn_s_barrier(); asm volatile("" ::: "memory");
        f32x4 gv[2][2];
#pragma unroll
        for (int bj = 0; bj < 2; ++bj)
#pragma unroll
            for (int n = 0; n < 2; ++n) gv[bj][n] = *(const f32x4*)(g + col0 + bj * HALF + n * 16);
#pragma unroll
        for (int ai = 0; ai < 2; ++ai)
#pragma unroll
            for (int m = 0; m < 4; ++m) { const int r = ai * HALF + wr * 64 + m * 16 + fr; const float rs = S[r]; const size_t off = (size_t)(u.pm * BM + r) * ldc + col0;
#pragma unroll
                for (int bj = 0; bj < 2; ++bj)
#pragma unroll
                    for (int n = 0; n < 2; ++n) *(f32x4*)(out + off + bj * HALF + n * 16) = acc[ai][bj][m][n] * rs * gv[bj][n]; }
    }
};
struct EpiSqRelu {
    static constexpr bool PERM = true, AFTER_DRAIN = false;
    bf16_t* O; int ldc; const float* ss; float eps; float inv_n;
    __device__ __forceinline__ void operator()(const f32x4 (&acc)[2][2][4][2], const Unit& u, int wr, int wc, int fr, int fq) const {
        const int row0 = u.pm * BM + wr * 64 + fr, col0 = u.pn * BM + wc * 32 + 8 * fq;
#pragma unroll
        for (int ai = 0; ai < 2; ++ai)
#pragma unroll
            for (int m = 0; m < 4; ++m) { const int row = row0 + ai * HALF + m * 16;
                const f32x4* sp = (const f32x4*)(ss + (size_t)row * 16); const f32x4 a = sp[0], b = sp[1], c = sp[2], d = sp[3];
                const float tot = ((a[0] + a[1]) + (a[2] + a[3])) + ((b[0] + b[1]) + (b[2] + b[3])) + ((c[0] + c[1]) + (c[2] + c[3])) + ((d[0] + d[1]) + (d[2] + d[3]));
                const float rstd = 1.0f / sqrtf(tot * inv_n + eps);
#pragma unroll
                for (int bj = 0; bj < 2; ++bj) { f32x4 v0 = acc[ai][bj][m][0] * rstd, v1 = acc[ai][bj][m][1] * rstd;
#pragma unroll
                    for (int e = 0; e < 4; ++e) { const float x0 = fmaxf(v0[e], 0.f), x1 = fmaxf(v1[e], 0.f); v0[e] = x0 * x0; v1[e] = x1 * x1; }
                    u32x4 w; w.x = cvt_pk_bf16(v0[0], v0[1]); w.y = cvt_pk_bf16(v0[2], v0[3]); w.z = cvt_pk_bf16(v1[0], v1[1]); w.w = cvt_pk_bf16(v1[2], v1[3]);
                    *(u32x4*)(O + (size_t)row * ldc + col0 + bj * HALF) = w; }
                asm volatile("" ::: "memory"); }
    }
};


template <class Epi, class Sched, bool ALIGN_EPI = false, bool SP2 = false>
__device__ __forceinline__ void gemm_phase(PG8_LAS unsigned char* lds, const Gemm g, const Sched& S, const Epi& E) {
    const int tid = threadIdx.x, wid = __builtin_amdgcn_readfirstlane(tid >> 6), lane = tid & 63, wr = wid >> 2, wc = wid & 3, fr = lane & 15, fq = lane >> 4;
    const int K = g.K, nt = K / BK, lda = g.lda ? g.lda : g.K;
    unsigned voffA[2], voffB[2];
#pragma unroll
    for (int i = 0; i < 2; ++i) { int R, C; stage_rc(tid * 16 + i * 8192, R, C); const int Rb = Epi::PERM ? ((R & ~31) + perm32(R & 31)) : R;
        voffA[i] = (unsigned)(R * lda + C) * 2u; voffB[i] = (unsigned)(Rb * K + C) * 2u; }
    const size_t kstep = (size_t)(BK * 2);
    const size_t hstep = (size_t)HALF * K * 2;
    const size_t tstep = 2 * hstep;
    const size_t hstepA = (size_t)HALF * lda * 2, tstepA = 2 * hstepA;
    const unsigned ldsw = (unsigned)wid * 1024u;
    const int aoff = lds_byte(wr * 64 + fr, fq * 8), boff = lds_byte(wc * 32 + fr, fq * 8);
#define PG8_SA(b, h) (((b) * 2 + (h)) * HTB)
#define PG8_SB(b, h) ((4 + (b) * 2 + (h)) * HTB)
#define PG8_STAGE(bufoff, gbase, voff) do { _Pragma("unroll") for (int _i = 0; _i < 2; ++_i) \
        __builtin_amdgcn_global_load_lds((const unsigned*)((const char*)(gbase) + (voff)[_i]), (PG8_LAS unsigned*)(lds + (bufoff) + ldsw + _i * 8192), 16, 0, 0); } while (0)
#define PG8_LDA(dst, b, h) do { _Pragma("unroll") for (int m = 0; m < 4; ++m) _Pragma("unroll") for (int k = 0; k < 2; ++k) dst[m][k] = *(const PG8_LAS bf16x8*)(lds + PG8_SA(b, h) + aoff + m * 2048 + k * 1024); } while (0)
#define PG8_LDB(dst, b, h) do { _Pragma("unroll") for (int n = 0; n < 2; ++n) _Pragma("unroll") for (int k = 0; k < 2; ++k) dst[n][k] = *(const PG8_LAS bf16x8*)(lds + PG8_SB(b, h) + boff + n * 2048 + k * 1024); } while (0)
#define PG8_MMA(ai, bj, At, Bt) do { __builtin_amdgcn_s_setprio(1); _Pragma("unroll") for (int m = 0; m < 4; ++m) _Pragma("unroll") for (int n = 0; n < 2; ++n) _Pragma("unroll") for (int k = 0; k < 2; ++k) \
        acc[ai][bj][m][n] = __builtin_amdgcn_mfma_f32_16x16x32_bf16(Bt[n][k], At[m][k], acc[ai][bj][m][n], 0, 0, 0); __builtin_amdgcn_s_setprio(0); } while (0)
#define PG8_WAIT_V(n) asm volatile("s_waitcnt vmcnt(" #n ")" ::: "memory")
#define PG8_WAIT_L(n) asm volatile("s_waitcnt lgkmcnt(" #n ")" ::: "memory")
#define PG8_BAR __builtin_amdgcn_s_barrier()
#define PG8_SCHED __builtin_amdgcn_sched_barrier(0)
    Unit cur, nxt; int ui = 0;
    if (!S.next(0, cur)) return;
    f32x4 acc[2][2][4][2];
#pragma unroll
    for (int a = 0; a < 2; ++a)
#pragma unroll
        for (int b = 0; b < 2; ++b)
#pragma unroll
            for (int m = 0; m < 4; ++m)
#pragma unroll
                for (int n = 0; n < 2; ++n) acc[a][b][m][n] = (f32x4){0.f, 0.f, 0.f, 0.f};
    bf16x8 At[4][2], B0[2][2], B1[2][2];
    const char* cA = (const char*)g.A + (size_t)cur.pm * tstepA; const char* cB = (const char*)g.Bt + (size_t)cur.pn * tstep;
    S.a_ready(cur);
    if constexpr (SP2) {
        PG8_STAGE(PG8_SB(0, 0), cB, voffB); PG8_STAGE(PG8_SB(0, 1), cB + hstep, voffB); PG8_STAGE(PG8_SA(0, 0), cA, voffA); PG8_STAGE(PG8_SA(0, 1), cA + hstepA, voffA);
        if (wr == 1) PG8_BAR;
        PG8_WAIT_V(2); PG8_BAR;
        PG8_STAGE(PG8_SB(1, 0), cB + kstep, voffB); PG8_STAGE(PG8_SA(1, 0), cA + kstep, voffA); PG8_STAGE(PG8_SB(1, 1), cB + hstep + kstep, voffB);
        PG8_WAIT_V(6); PG8_BAR;
    } else {
        PG8_STAGE(PG8_SB(0, 0), cB, voffB); PG8_STAGE(PG8_SA(0, 0), cA, voffA); PG8_STAGE(PG8_SB(0, 1), cB + hstep, voffB); PG8_STAGE(PG8_SA(0, 1), cA + hstepA, voffA);
        if (wr == 1) PG8_BAR;
        PG8_WAIT_V(4); PG8_BAR;
        PG8_STAGE(PG8_SB(1, 0), cB + kstep, voffB); PG8_STAGE(PG8_SA(1, 0), cA + kstep, voffA); PG8_STAGE(PG8_SB(1, 1), cB + hstep + kstep, voffB);
        PG8_WAIT_V(6); PG8_BAR;
    }
    for (;;) {
        const bool has_next = S.next(ui + 1, nxt);
        const char* nA = has_next ? (const char*)g.A + (size_t)nxt.pm * tstepA : cA; const char* nB = has_next ? (const char*)g.Bt + (size_t)nxt.pn * tstep : cB;
        for (int t = 0; t < nt; t += 2) {
            const bool last = (t == nt - 2);
            const char* a1 = cA + (size_t)(t + 1) * kstep;
            const char* a2 = last ? nA : cA + (size_t)(t + 2) * kstep; const char* b2 = last ? nB : cB + (size_t)(t + 2) * kstep;
            const char* a3 = a2 + kstep; const char* b3 = b2 + kstep;
            if (last && has_next) S.a_ready(nxt);
            if constexpr (SP2) {
            PG8_LDB(B0, 0, 0); PG8_LDB(B1, 0, 1); PG8_SCHED; PG8_LDA(At, 0, 0); PG8_STAGE(PG8_SA(1, 1), a1 + hstepA, voffA);
            PG8_WAIT_V(8); PG8_WAIT_L(0); PG8_BAR; PG8_MMA(0, 0, At, B0); PG8_MMA(0, 1, At, B1); PG8_BAR; PG8_SCHED;
            PG8_LDA(At, 0, 1); PG8_STAGE(PG8_SB(0, 0), b2, voffB); PG8_STAGE(PG8_SB(0, 1), b2 + hstep, voffB); PG8_STAGE(PG8_SA(0, 0), a2, voffA);
            PG8_WAIT_V(8); PG8_WAIT_L(0); PG8_BAR; PG8_MMA(1, 0, At, B0); PG8_MMA(1, 1, At, B1); PG8_BAR; PG8_SCHED;
            PG8_LDB(B0, 1, 0); PG8_LDB(B1, 1, 1); PG8_SCHED; PG8_LDA(At, 1, 0); PG8_STAGE(PG8_SA(0, 1), a2 + hstepA, voffA);
            PG8_WAIT_V(8); PG8_WAIT_L(0); PG8_BAR; PG8_MMA(0, 0, At, B0); PG8_MMA(0, 1, At, B1); PG8_BAR; PG8_SCHED;
            PG8_LDA(At, 1, 1); PG8_STAGE(PG8_SB(1, 0), b3, voffB); PG8_STAGE(PG8_SB(1, 1), b3 + hstep, voffB); PG8_STAGE(PG8_SA(1, 0), a3, voffA);
            PG8_WAIT_V(8); PG8_WAIT_L(0); PG8_BAR; PG8_MMA(1, 0, At, B0); PG8_MMA(1, 1, At, B1); PG8_BAR; PG8_SCHED;
            } else {
            PG8_LDB(B0, 0, 0); PG8_SCHED; PG8_LDA(At, 0, 0); PG8_STAGE(PG8_SA(1, 1), a1 + hstepA, voffA);
            PG8_WAIT_L(8); PG8_BAR; PG8_WAIT_L(0); PG8_MMA(0, 0, At, B0); PG8_BAR; PG8_SCHED;
            PG8_LDB(B1, 0, 1); PG8_STAGE(PG8_SB(0, 0), b2, voffB);
            PG8_BAR; PG8_WAIT_L(0); PG8_MMA(0, 1, At, B1); PG8_BAR;
            PG8_LDA(At, 0, 1); PG8_STAGE(PG8_SA(0, 0), a2, voffA);
            PG8_BAR; PG8_WAIT_L(0); PG8_MMA(1, 0, At, B0); PG8_BAR; PG8_SCHED;
            PG8_STAGE(PG8_SB(0, 1), b2 + hstep, voffB);
            PG8_WAIT_V(6); PG8_BAR; PG8_MMA(1, 1, At, B1); PG8_BAR;
            PG8_LDB(B0, 1, 0); PG8_SCHED; PG8_LDA(At, 1, 0); PG8_STAGE(PG8_SA(0, 1), a2 + hstepA, voffA);
            PG8_WAIT_L(8); PG8_BAR; PG8_WAIT_L(0); PG8_MMA(0, 0, At, B0); PG8_BAR; PG8_SCHED;
            PG8_LDB(B1, 1, 1); PG8_STAGE(PG8_SB(1, 0), b3, voffB);
            PG8_BAR; PG8_WAIT_L(0); PG8_MMA(0, 1, At, B1); PG8_BAR;
            PG8_LDA(At, 1, 1); PG8_STAGE(PG8_SA(1, 0), a3, voffA);
            PG8_BAR; PG8_WAIT_L(0); PG8_MMA(1, 0, At, B0); PG8_BAR; PG8_SCHED;
            PG8_STAGE(PG8_SB(1, 1), b3 + hstep, voffB);
            PG8_WAIT_V(6); PG8_BAR; PG8_MMA(1, 1, At, B1); PG8_BAR;
            }
        }
        if constexpr (ALIGN_EPI) { if (wr == 0) PG8_BAR; }
        if constexpr (!Epi::AFTER_DRAIN) { E(acc, cur, wr, wc, fr, fq); S.done(cur); }
        if (!has_next) break;
#pragma unroll
        for (int a = 0; a < 2; ++a)
#pragma unroll
            for (int b = 0; b < 2; ++b)
#pragma unroll
                for (int m = 0; m < 4; ++m)
#pragma unroll
                    for (int n = 0; n < 2; ++n) acc[a][b][m][n] = (f32x4){0.f, 0.f, 0.f, 0.f};
        cur = nxt; cA = nA; cB = nB; ++ui;
        if constexpr (ALIGN_EPI) { if (wr == 1) PG8_BAR; }
    }
    PG8_WAIT_V(0);
    if constexpr (!ALIGN_EPI) { if (wr == 0) PG8_BAR; }
    PG8_BAR;
    if constexpr (Epi::AFTER_DRAIN) { E.fused(acc, cur, wr, wc, fr, fq, lds, wid, lane); S.done(cur); }
#undef PG8_SA
#undef PG8_SB
#undef PG8_STAGE
#undef PG8_LDA
#undef PG8_LDB
#undef PG8_MMA
#undef PG8_WAIT_V
#undef PG8_WAIT_L
#undef PG8_BAR
#undef PG8_SCHED
}
}

#ifndef PG8_SP2
#define PG8_SP2 true
#endif
#ifndef PG8_ALIGN
#define PG8_ALIGN true
#endif
namespace att {
#define LAS3 __attribute__((address_space(3)))
using bf16x8 = __attribute__((ext_vector_type(8))) short;
using s16x4 = __attribute__((ext_vector_type(4))) short;
using f32x16 = __attribute__((ext_vector_type(16))) float;
using f32x4 = __attribute__((ext_vector_type(4))) float;
using u32x4 = __attribute__((ext_vector_type(4))) unsigned;
typedef unsigned short u16;
typedef LAS3 const unsigned char* lds_cptr;
typedef short v4i16_t __attribute__((ext_vector_type(4)));
constexpr int SEQ = 16384, NW = 8, QBLK = 32, QB = 256, KVBLK = 64;
constexpr int KSLOT = 12288, VSLOT = 8192, NKS = 4, NVS = 4;
constexpr int LDS_K = 0, LDS_V = NKS * KSLOT, LDS_WS = LDS_V + NVS * VSLOT, LDS_OST = LDS_WS + NW * 256, LDS_QX = LDS_OST + NW * 4096, LDS_BYTES = LDS_QX + NW * 2048;
__device__ __forceinline__ int crow(int r, int hi) { return (r & 3) + 8 * (r >> 2) + 4 * hi; }
__device__ __forceinline__ void glds16(const void* gsrc, unsigned lds_dst) { unsigned keep;
    asm volatile("s_mov_b32 %0, m0\n\ts_mov_b32 m0, %2\n\ts_nop 0\n\tglobal_load_lds_dwordx4 %1, off\n\ts_mov_b32 m0, %0" : "=&s"(keep) : "v"(gsrc), "s"(lds_dst) : "memory"); }
typedef float f32x2_t __attribute__((ext_vector_type(2))); typedef __bf16 bf16x2_t __attribute__((ext_vector_type(2)));
__device__ __forceinline__ unsigned cvtpk_s(float lo, float hi) { f32x2_t v = {lo, hi}; bf16x2_t b = __builtin_convertvector(v, bf16x2_t); return __builtin_bit_cast(unsigned, b); }
__device__ __forceinline__ s16x4 vtr(lds_cptr p) { return __builtin_bit_cast(s16x4, __builtin_amdgcn_ds_read_tr16_b64_v4i16((LAS3 v4i16_t*)p)); }
#define ATT_SBAR() __builtin_amdgcn_sched_barrier(0)
#define ATT_WAIT_BAR(N) asm volatile("s_waitcnt vmcnt(" #N ") lgkmcnt(0)\n\ts_barrier" ::: "memory")
struct Src {
    const u16* q; int qp;
    const u16* k; int kp;
    const u16* k2; int k2p;
    const u16* v; int vp;
    u16* o; int op;
};
template <int NDK, int NQR, bool ZC, int XHS, int JLO, int JHI>
__device__ __forceinline__ void phase_a(f32x16& C0, f32x16& C1, const lds_cptr* kb_, int ksl_, const bf16x8* qr, lds_cptr qx_, const f32x16& negm, bf16x8* kf, bf16x8* qx) {
#ifndef ATT_KPF
#define ATT_KPF 4
#endif
    constexpr int KPF = ATT_KPF;
#define ATT_KRD(j) kf[j] = *(const LAS3 bf16x8*)(kb_[(j) >> 1] + ksl_ + ((j) & 1) * (((j) >> 1) < 4 ? 4096 : XHS))
    if (JLO == 0) {
#pragma unroll
        for (int j = 0; j < KPF; ++j) ATT_KRD(j); }
#pragma unroll
    for (int j = JLO; j < JHI; ++j) {
        if (j + KPF < 2 * NDK) ATT_KRD(j + KPF);
        if (NDK > NQR && (j & 1) == 0 && (j >> 1) + 2 >= NQR && (j >> 1) + 2 < NDK) qx[(j >> 1) + 2 - NQR] = *(const LAS3 bf16x8*)(qx_ + ((j >> 1) + 2 - NQR) * 1024);
        ATT_SBAR();
        const f32x16 z = f32x16{}; const bf16x8 qf = ((j >> 1) < NQR) ? qr[(j >> 1) < NQR ? (j >> 1) : 0] : qx[(j >> 1) >= NQR ? (j >> 1) - NQR : 0];
        if (j & 1) C1 = __builtin_amdgcn_mfma_f32_32x32x16_bf16(kf[j], qf, (j < 2) ? (ZC ? z : negm) : C1, 0, 0, 0);
        else       C0 = __builtin_amdgcn_mfma_f32_32x32x16_bf16(kf[j], qf, (j < 2) ? (ZC ? z : negm) : C0, 0, 0, 0);
        ATT_SBAR();
    }
#undef ATT_KRD
}
template <bool QK, bool FIN>
__device__ __forceinline__ void phase_b(f32x16& C0, f32x16& C1, f32x16* o, lds_cptr vp_, u32x4* pw, float& l_reg) {
    s16x4 vlo[8], vhi[8]; float sacc = 0.f, sacd = 0.f;
#define ATT_VRD(i) do { const int vi_ = ((i) >> 1) + 4 * ((i) & 1); vlo[i] = vtr(vp_ + ((vi_ >> 2) * 4096 + (vi_ & 3) * 1024)); vhi[i] = vtr(vp_ + ((vi_ >> 2) * 4096 + (vi_ & 3) * 1024 + 512)); } while (0)
    if (FIN) { ATT_VRD(0); ATT_VRD(1); }
#pragma unroll
    for (int i = 0; i < 8; ++i) {
        if (FIN && i + 2 < 8) ATT_VRD(i + 2);
        ATT_SBAR();
        if (FIN) { const bf16x8 vf = (bf16x8){vlo[i][0], vlo[i][1], vlo[i][2], vlo[i][3], vhi[i][0], vhi[i][1], vhi[i][2], vhi[i][3]};
            o[i & 1] = __builtin_amdgcn_mfma_f32_32x32x16_bf16(__builtin_bit_cast(bf16x8, pw[i >> 1]), vf, o[i & 1], 0, 0, 0); }
        if (QK) { f32x16& X = (i < 4) ? C0 : C1; const int b = 4 * (i & 3);
            X[b] = __builtin_amdgcn_exp2f(X[b]); X[b + 1] = __builtin_amdgcn_exp2f(X[b + 1]); X[b + 2] = __builtin_amdgcn_exp2f(X[b + 2]); X[b + 3] = __builtin_amdgcn_exp2f(X[b + 3]);
            sacc += X[b]; sacd += X[b + 1]; sacc += X[b + 2]; sacd += X[b + 3]; asm volatile("" : "+v"(sacc), "+v"(sacd));
            if (i & 1) { const int k = i >> 1, c = 8 * (k & 1);
                pw[k] = (u32x4){cvtpk_s(X[c], X[c + 1]), cvtpk_s(X[c + 2], X[c + 3]), cvtpk_s(X[c + 4], X[c + 5]), cvtpk_s(X[c + 6], X[c + 7])}; asm volatile("" : "+v"(pw[k])); } }
        ATT_SBAR();
    }
#undef ATT_VRD
    if (QK) l_reg += sacc + sacd;
}
template <bool MLA> __device__ __forceinline__ void attn_unit(int qb, const Src& s, LAS3 unsigned char* shm, const float* bias_h, float kmax2, const float* qmax_h) {
    constexpr int NDK = MLA ? 6 : 5, NX = MLA ? 4 : 1, NQR = MLA ? 4 : 5;
    constexpr float THRL = MLA ? 8.0f : 16.0f;
    const int tid = threadIdx.x, lane = tid & 63, r32 = lane & 31, hi = lane >> 5; const int wid = __builtin_amdgcn_readfirstlane(tid >> 6);
    const int q0 = qb * QB;
    const unsigned lds0 = (unsigned)(uintptr_t)shm;
    LAS3 float* wsf = (LAS3 float*)(shm + LDS_WS) + wid * 64;
    const int NT = (q0 + QB) / KVBLK;
    const int wvis = NT - 4 + (wid >> 1);
    const bool xw = wid < NX;
    const int krow = 8 * wid + (lane >> 3);
    const u16* ksrc = s.k + (size_t)krow * s.kp + (((lane & 7) ^ ((krow >> 1) & 7)) * 8);
    const int k2row = 16 * (wid & 3) + (lane >> 2);
    const u16* k2src = MLA ? s.k2 + (size_t)k2row * s.k2p + (((lane & 3) ^ ((k2row >> 2) & 3)) * 8) : s.k2 + (size_t)lane * s.k2p;
    const u16* vsrc = s.v + (size_t)(16 * (wid & 3) + (lane >> 2)) * s.vp + (wid >> 2) * 32 + (lane & 3) * 8;
    const unsigned kdst = lds0 + LDS_K + wid * 1024, k2dst = lds0 + LDS_K + (8 + (wid & 3)) * 1024, vdst = lds0 + LDS_V + wid * 1024;
#define ATT_DMA_K(t) do { const int sl_ = (t) & 3; glds16(ksrc + (size_t)(t) * KVBLK * s.kp, (unsigned)__builtin_amdgcn_readfirstlane(kdst + sl_ * KSLOT)); \
        if (xw) glds16(k2src + (size_t)(t) * KVBLK * s.k2p, (unsigned)__builtin_amdgcn_readfirstlane(k2dst + sl_ * KSLOT)); } while (0)
#define ATT_DMA_V(t, vsl) glds16(vsrc + (size_t)(t) * KVBLK * s.vp, (unsigned)__builtin_amdgcn_readfirstlane(vdst + (vsl)))
    if (!MLA) {
        if (tid < 256) { const int sl = tid >> 6; *(LAS3 f32x4*)(shm + LDS_K + sl * KSLOT + 9 * 1024 + (tid & 63) * 16) = (f32x4){0.f, 0.f, 0.f, 0.f}; } }
    if (MLA) { ATT_DMA_K(0); ATT_DMA_V(0, 0); ATT_DMA_K(1); ATT_DMA_K(2); }
    const u16* Qw = s.q + (size_t)(q0 + wid * QBLK + r32) * s.qp + hi * 8;
    bf16x8 qr[NQR];
#pragma unroll
    for (int d0 = 0; d0 < 4; ++d0) qr[d0] = *reinterpret_cast<const bf16x8*>(Qw + d0 * 16);
    const lds_cptr qx0 = (lds_cptr)shm + LDS_QX + wid * 2048 + lane * 16;
    if (MLA) { const bf16x8 q4 = *reinterpret_cast<const bf16x8*>(Qw + 64), q5 = *reinterpret_cast<const bf16x8*>(Qw + 80);
        *(LAS3 bf16x8*)(shm + LDS_QX + wid * 2048 + lane * 16) = q4; *(LAS3 bf16x8*)(shm + LDS_QX + wid * 2048 + 1024 + lane * 16) = q5; }
    const short one = hi ? (short)0 : (short)0x3F80;
    if (!MLA) qr[NQR - 1] = (bf16x8){one, one, one, 0, 0, 0, 0, 0};
    int t0 = 0;
    if (!MLA) {
        const float qm = qmax_h[qb];
        const float thr = bias_h[q0] - 170.f - 2.f * sqrtf(qm * kmax2);
        int best = 0;
        for (int tt = 1 + lane; tt <= NT - 4; tt += 64) { if (bias_h[64 * tt - 1] < thr) best = tt; }
#pragma unroll
        for (int o_ = 32; o_ >= 1; o_ >>= 1) best = max(best, __shfl_xor(best, o_));
        t0 = __builtin_amdgcn_readfirstlane(best);
    }
    if (!MLA) { ATT_DMA_K(t0); ATT_DMA_V(t0, (t0 & 3) * VSLOT); ATT_DMA_K(t0 + 1); ATT_DMA_K(t0 + 2); }
    float mhat = 0.f, l_reg = 0.f; f32x16 o[2]; o[0] = f32x16{}; o[1] = f32x16{}; f32x16 negm = f32x16{};
    const int qrel = wid * QBLK + r32;
    lds_cptr kb[NDK];
#pragma unroll
    for (int d0 = 0; d0 < 4; ++d0) kb[d0] = (lds_cptr)shm + LDS_K + r32 * 128 + ((((2 * d0 + hi) ^ ((r32 >> 1) & 7))) << 4);
    if (MLA) {
#pragma unroll
        for (int d0 = 4; d0 < NDK; ++d0) kb[d0] = (lds_cptr)shm + LDS_K + 8192 + r32 * 64 + ((((2 * (d0 - 4) + hi) ^ ((r32 >> 2) & 3))) << 4);
    } else kb[NDK - 1] = (lds_cptr)shm + LDS_K + 8192 + hi * 1024 + r32 * 16;
    constexpr int XHS = MLA ? 2048 : 512;
    const lds_cptr vp0 = (lds_cptr)shm + LDS_V + ((lane >> 4) & 1) * 32 + (lane & 3) * 8 + (4 * hi + ((lane & 15) >> 2)) * 64;
    f32x16 C0, C1; u32x4 pw[4]; bool resc = false;
#define ATT_TOP(t) do { if ((t) == t0 || (t) + 2 >= NT) { ATT_WAIT_BAR(0); } else if (xw) { ATT_WAIT_BAR(3); } else { ATT_WAIT_BAR(2); } \
        } while (0)
#define ATT_ISSUE(t) do { if ((t) + 3 < NT) ATT_DMA_K((t) + 3); if ((t) + 1 < NT) ATT_DMA_V((t) + 1, (((t) + 1) & 3) * VSLOT); } while (0)
#define ATT_QK(t) do { bf16x8 kf_[2 * NDK]; bf16x8 qx_[NDK > NQR ? NDK - NQR : 1]; \
        phase_a<NDK, NQR, !MLA, XHS, 0, 4>(C0, C1, ATT_KS(t), qr, qx0, negm, kf_, qx_); ATT_ISSUE(t); ATT_SBAR(); \
        phase_a<NDK, NQR, !MLA, XHS, 4, 2 * NDK>(C0, C1, ATT_KS(t), qr, qx0, negm, kf_, qx_); } while (0)
#define ATT_MASK(C0, C1, t) do { const int kbq_ = 64 * ((t) - (NT - 4)) + 4 * hi; \
        _Pragma("unroll") for (int r = 0; r < 16; ++r) { const int kv_ = kbq_ + (r & 3) + 8 * (r >> 2); if (kv_ > qrel) C0[r] = -INFINITY; if (kv_ + 32 > qrel) C1[r] = -INFINITY; } } while (0)
#define ATT_DECIDE(C0, C1, FIRST) do { \
        float a_ = fmaxf(fmaxf(C0[0], C0[1]), C1[0]), b_ = fmaxf(fmaxf(C0[2], C0[3]), C1[1]); a_ = fmaxf(fmaxf(a_, C1[2]), C1[3]); \
        _Pragma("unroll") for (int r = 4; r < 16; r += 4) { a_ = fmaxf(fmaxf(a_, C0[r]), C0[r + 1]); b_ = fmaxf(fmaxf(b_, C0[r + 2]), C0[r + 3]); a_ = fmaxf(fmaxf(a_, C1[r]), C1[r + 1]); b_ = fmaxf(fmaxf(b_, C1[r + 2]), C1[r + 3]); } \
        float rm_ = fmaxf(a_, b_); { auto rr_ = __builtin_amdgcn_permlane32_swap(__float_as_uint(rm_), __float_as_uint(rm_), false, false); rm_ = fmaxf(__uint_as_float(rr_[0]), __uint_as_float(rr_[1])); } \
        resc = false; \
        if ((FIRST) || __any(rm_ > THRL)) { float dl_ = (FIRST) ? rm_ : fmaxf(rm_, 0.f); \
            if (!MLA) { const float nm_ = -(mhat + dl_); const unsigned h_ = cvtpk_s(nm_, 0.f) & 0xffffu; const float r1_ = nm_ - __uint_as_float(h_ << 16); const unsigned m_ = cvtpk_s(r1_, 0.f) & 0xffffu; \
                const float r2_ = r1_ - __uint_as_float(m_ << 16); const unsigned l_ = cvtpk_s(r2_, 0.f) & 0xffffu; \
                const float mn_ = -((__uint_as_float(h_ << 16) + __uint_as_float(m_ << 16)) + __uint_as_float(l_ << 16)); dl_ = mn_ - mhat; mhat = mn_; \
                if (hi == 0) qr[NQR - 1] = (bf16x8){one, one, one, (short)h_, (short)m_, (short)l_, 0, 0}; } \
            else { mhat += dl_; _Pragma("unroll") for (int r = 0; r < 16; ++r) negm[r] = -mhat; } \
            _Pragma("unroll") for (int r = 0; r < 16; ++r) { C0[r] -= dl_; C1[r] -= dl_; } \
            if (!(FIRST)) { const float f_ = __builtin_amdgcn_exp2f(-dl_); l_reg *= f_; if (hi == 0) wsf[r32] = f_; resc = true; } } } while (0)
#define ATT_RESC() do { if (resc) { \
        _Pragma("unroll") for (int i = 0; i < 4; ++i) { const f32x4 fv_ = *(const LAS3 f32x4*)(wsf + 8 * i + 4 * hi); \
            _Pragma("unroll") for (int d = 0; d < 2; ++d) { o[d][4 * i] *= fv_[0]; o[d][4 * i + 1] *= fv_[1]; o[d][4 * i + 2] *= fv_[2]; o[d][4 * i + 3] *= fv_[3]; } } } } while (0)
#define ATT_VS(tt) (vp0 + (((tt)) & 3) * VSLOT)
#define ATT_KS(tt) kb, ((((tt)) & 3) * KSLOT)
#ifndef ATT_STAGGER
#define ATT_STAGGER 0
#endif
    if (!ATT_STAGGER || wid < 4) {
#define ATT_STEP(t, MASKED) do { ATT_TOP(t); \
        ATT_QK(t); \
        if (!MLA && (MASKED)) ATT_MASK(C0, C1, t); \
        ATT_DECIDE(C0, C1, false); ATT_SBAR(); \
        phase_b<true, true>(C0, C1, o, ATT_VS((t) - 1), pw, l_reg); \
        ATT_RESC(); } while (0)
        ATT_TOP(t0);
        ATT_QK(t0);
        if (!MLA && wvis == t0) ATT_MASK(C0, C1, t0);
        ATT_DECIDE(C0, C1, true); ATT_SBAR();
        phase_b<true, false>(C0, C1, o, vp0, pw, l_reg);
        int t = t0 + 1;
        for (; t < wvis; ++t) ATT_STEP(t, false);
        if (t == wvis) { ATT_STEP(t, true); ++t; }
        { ATT_TOP(t); ATT_ISSUE(t); phase_b<false, true>(C0, C1, o, ATT_VS(t - 1), pw, l_reg); ++t; }
        for (; t <= NT + ATT_STAGGER; ++t) { ATT_TOP(t); ATT_ISSUE(t); }
#undef ATT_STEP
    } else {
        ATT_TOP(t0);
        ATT_QK(t0);
        ATT_DECIDE(C0, C1, true); ATT_SBAR();
        ATT_TOP(t0 + 1);
        phase_b<true, false>(C0, C1, o, vp0, pw, l_reg); ATT_SBAR();
        ATT_QK(t0 + 1);
        ATT_DECIDE(C0, C1, false); ATT_SBAR();
        int t = t0 + 2;
#define ATT_STEP2(t, MASKED) do { ATT_TOP(t); \
        phase_b<true, true>(C0, C1, o, ATT_VS((t) - 2), pw, l_reg); \
        ATT_RESC(); ATT_SBAR(); \
        ATT_QK(t); \
        if (!MLA && (MASKED)) ATT_MASK(C0, C1, t); \
        ATT_DECIDE(C0, C1, false); ATT_SBAR(); } while (0)
        for (; t < wvis; ++t) ATT_STEP2(t, false);
        ATT_STEP2(t, true); ++t;
        { ATT_TOP(t); ATT_ISSUE(t); phase_b<true, true>(C0, C1, o, ATT_VS(t - 2), pw, l_reg); ATT_RESC(); ++t; }
        { ATT_TOP(t); ATT_ISSUE(t); phase_b<false, true>(C0, C1, o, ATT_VS(t - 2), pw, l_reg); ++t; }
        for (; t <= NT + ATT_STAGGER; ++t) { ATT_TOP(t); ATT_ISSUE(t); }
#undef ATT_STEP2
    }
    { auto rr = __builtin_amdgcn_permlane32_swap(__float_as_uint(l_reg), __float_as_uint(l_reg), false, false); l_reg = __uint_as_float(rr[0]) + __uint_as_float(rr[1]); }
    if (hi == 0) wsf[32 + r32] = 1.0f / l_reg;
    float rli[16];
#pragma unroll
    for (int i = 0; i < 4; ++i) { const f32x4 fv = *(const LAS3 f32x4*)(wsf + 32 + 8 * i + 4 * hi); rli[4 * i] = fv[0]; rli[4 * i + 1] = fv[1]; rli[4 * i + 2] = fv[2]; rli[4 * i + 3] = fv[3]; }
    u16* Ow = s.o + (size_t)(q0 + wid * QBLK) * s.op;
    { LAS3 u16* stg = (LAS3 u16*)(shm + LDS_OST) + wid * 2048;
#pragma unroll
        for (int r = 0; r < 16; ++r) { const int orow = crow(r, hi);
#pragma unroll
            for (int d0 = 0; d0 < 2; ++d0) stg[orow * 64 + d0 * 32 + r32] = (u16)(cvtpk_s(o[d0][r] * rli[r], 0.f) & 0xffffu); }
        asm volatile("s_waitcnt lgkmcnt(0)" ::: "memory");
#pragma unroll
        for (int i = 0; i < 4; ++i) { const int row = i * 8 + (lane >> 3), ch = lane & 7; const u32x4 v = *(const LAS3 u32x4*)(stg + row * 64 + ch * 8); *(u32x4*)(Ow + (size_t)row * s.op + ch * 8) = v; } }
    asm volatile("s_waitcnt lgkmcnt(0)\n\ts_barrier" ::: "memory");
#undef ATT_DMA_K
#undef ATT_DMA_V
#undef ATT_TOP
#undef ATT_ISSUE
#undef ATT_QK
#undef ATT_MASK
#undef ATT_DECIDE
#undef ATT_RESC
#undef ATT_STEP
}
}

namespace cg = cooperative_groups;
#define LAS __attribute__((address_space(3)))
typedef unsigned short bf16;
typedef unsigned v4u __attribute__((ext_vector_type(4)));
typedef unsigned v2u __attribute__((ext_vector_type(2)));
typedef float f32x4 __attribute__((ext_vector_type(4)));
constexpr int NWAVES = 8;
constexpr int M = 16384, D = 1024, FF = 4096, NIN = 1960, NINP = 2048, QL = 256, KVL = 128, NQU = 768, NKVU = 1024;
constexpr float EPS = 1e-6f;
constexpr float LOG2E = 1.4426950408889634f;
constexpr float C2_FOX = 0.125f * LOG2E, C2_MLA = 0.10206207261596575f * LOG2E;
constexpr size_t MiB = 1u << 20;
constexpr size_t WS_WIN = 1 * MiB, WS_WQ = 5 * MiB, WS_WKV = 5 * MiB + 512 * 1024, WS_WO = 6 * MiB, WS_W1 = 8 * MiB, WS_W2 = 16 * MiB;
constexpr size_t WS_RT = 24 * MiB, WS_LF = 26 * MiB, WS_LC = 26 * MiB + 512 * 1024, WS_SS = 27 * MiB, WS_KR = 28 * MiB, WS_KB = 29 * MiB, WS_SSQ = 31 * MiB, WS_SSKV = 31 * MiB + 512 * 1024, WS_BIASF = 28 * MiB;
constexpr size_t WS_XN = 32 * MiB, WS_H = 64 * MiB, WS_P = 64 * MiB, WS_QM = 128 * MiB, WS_KVM = 152 * MiB, WS_QN = 184 * MiB, WS_O = 192 * MiB, WS_KVN = 224 * MiB, WS_END = 228 * MiB;
constexpr int RING_BYTES = 131072, LDS_BYTES = 147456;
static_assert(att::LDS_BYTES <= LDS_BYTES, "attention scratch fits the LDS allocation");

__device__ __forceinline__ unsigned f2bf(float f) { unsigned u = __builtin_bit_cast(unsigned, f); return (u + 0x7fffu + ((u >> 16) & 1u)) >> 16; }
__device__ __forceinline__ unsigned pk2(float lo, float hi) { return f2bf(lo) | (f2bf(hi) << 16); }
__device__ __forceinline__ float bf2f(unsigned short h) { return __builtin_bit_cast(float, (unsigned)h << 16); }
__device__ __forceinline__ float wave_sum(float v) {
#pragma unroll
    for (int o = 1; o < 64; o <<= 1) v += __shfl_xor(v, o);
    return v;
}
__device__ __forceinline__ int map_row(int mode, int n) {
    if (mode == 1) { const int h = n / 96, d = n % 96; if (d < 64) return n; const int i = d - 64; return h * 96 + (i < 16 ? 64 + 2 * i : 64 + 2 * (i - 16) + 1); }
    if (mode == 2) { const int h = n >> 7, j = n & 127; return j < 64 ? h * 64 + j : 512 + h * 64 + (j - 64); }
    if (mode == 3) { if (n < 1536 || n >= 1960) return n; if (n < 1544) return 1952 + (n - 1536); if (n < 1800) return 1536 + (n - 1544); if (n < 1928) return 1792 + (n - 1800);
        const int i = n - 1928; return 1920 + (i < 16 ? 2 * i : 2 * (i - 16) + 1); }
    return n;
}
__device__ __forceinline__ void p0_transpose_item(const float* W, int K, int N, int nblk, bf16* WT, int mode, const float* gk, LAS float* scr, int item, int lane) {
    const int kb = item / nblk, nb = item % nblk, k0 = 64 * kb, n0 = 32 * nb;
    const int nn = n0 + (lane & 31);
    float wv[32];
#pragma unroll
    for (int i = 0; i < 32; ++i) { const int kk = 2 * i + (lane >> 5); wv[i] = (nn < N) ? W[(size_t)(k0 + kk) * N + nn] : 0.f; }
    if (gk) {
#pragma unroll
        for (int i = 0; i < 32; ++i) wv[i] *= gk[k0 + 2 * i + (lane >> 5)]; }
#pragma unroll
    for (int i = 0; i < 32; ++i) { const int kk = 2 * i + (lane >> 5); scr[kk * 33 + (lane & 31)] = wv[i]; }
    asm volatile("s_waitcnt lgkmcnt(0)" ::: "memory");
    const int c = lane & 7;
#pragma unroll
    for (int j = 0; j < 4; ++j) { const int n = (lane >> 3) + 8 * j; const LAS float* sp = scr + (8 * c) * 33 + n;
        v4u o; o.x = pk2(sp[0 * 33], sp[1 * 33]); o.y = pk2(sp[2 * 33], sp[3 * 33]); o.z = pk2(sp[4 * 33], sp[5 * 33]); o.w = pk2(sp[6 * 33], sp[7 * 33]);
        *(v4u*)(WT + (size_t)map_row(mode, n0 + n) * K + k0 + 8 * c) = o; }
    asm volatile("s_waitcnt lgkmcnt(0)" ::: "memory");
}
__device__ __forceinline__ void sincos_d(double x, float& sn, float& cs) {
    const double k = rint(x * 0.63661977236758134308);
    double r = fma(-k, 1.57079632679489655800e+00, x); r = fma(-k, 6.12323399573676603587e-17, r);
    const double r2 = r * r;
    double s = -1.0 / 6227020800.0; s = s * r2 + 1.0 / 39916800.0; s = s * r2 - 1.0 / 362880.0; s = s * r2 + 1.0 / 5040.0; s = s * r2 - 1.0 / 120.0; s = s * r2 + 1.0 / 6.0; s = r - r * r2 * s;
    double c = 1.0 / 479001600.0; c = c * r2 - 1.0 / 3628800.0; c = c * r2 + 1.0 / 40320.0; c = c * r2 - 1.0 / 720.0; c = c * r2 + 1.0 / 24.0; c = c * r2 - 0.5; c = 1.0 + r2 * c;
    const int q = ((int)k) & 3;
    const double ss = (q == 0) ? s : (q == 1) ? c : (q == 2) ? -s : -c;
    const double cc = (q == 0) ? c : (q == 1) ? -s : (q == 2) ? -c : s;
    sn = (float)ss; cs = (float)cc;
}

#define RLX_AGENT __ATOMIC_RELAXED, __HIP_MEMORY_SCOPE_AGENT
#define XB_TMO      128
#define XB_XCNT(j)  (256  + 64 * (j))
#define XB_XSUB(j)  (1280 + 64 * (j))
#define XB_XGEN(j)  (2304 + 64 * (j))
#define XB_TOP      3328
#define XB_TOPGEN   3392
#define XCD_BAR_WORDS 3456
#define XB_SPIN_CAP (1u << 18)

__device__ __forceinline__ unsigned xb_ld(unsigned* p)              { return __hip_atomic_load(p, __ATOMIC_RELAXED, __HIP_MEMORY_SCOPE_AGENT); }
__device__ __forceinline__ unsigned xb_add(unsigned* p, unsigned v) { return __hip_atomic_fetch_add(p, v, __ATOMIC_RELAXED, __HIP_MEMORY_SCOPE_AGENT); }
__device__ __forceinline__ unsigned xb_xcc_id() { return (unsigned)__builtin_amdgcn_s_getreg((3 << 11) | 20) & 0xFu; }
#define XB_SPIN(cond, bar) do { unsigned _sp = 0; while (cond) { __builtin_amdgcn_s_sleep(1); \
    if ((++_sp & 255u) == 0u) { if (xb_ld(&(bar)[XB_TMO])) break; if (_sp > XB_SPIN_CAP) { atomicAdd(&(bar)[XB_TMO], 1u); break; } } } } while (0)

struct XcdBarrier {
    unsigned* bar; unsigned x;
    volatile LAS unsigned* st;
};

__device__ __forceinline__ XcdBarrier xcd_barrier_post(unsigned* bar, volatile LAS unsigned* st) {
    XcdBarrier b; b.bar = bar; b.x = xb_xcc_id(); b.st = st;
    if (threadIdx.x == 0) (void)xb_add(&bar[XB_XCNT(b.x)], 1u);
    return b;
}
__device__ __forceinline__ void xcd_barrier_complete(unsigned* bar, unsigned x, unsigned& nloc, unsigned& nx) {
    const unsigned G = gridDim.x * gridDim.y * gridDim.z;
    unsigned sum, cnt, mine, sp = 0u;
    for (;;) {
        sum = 0u; cnt = 0u; mine = 0u;
#pragma unroll
        for (unsigned j = 0; j < 16; ++j) { const unsigned c = xb_ld(&bar[XB_XCNT(j)]); sum += c; cnt += (c > 0u) ? 1u : 0u; mine = (j == x) ? c : mine; }
        if (sum == G) break;
        __builtin_amdgcn_s_sleep(1);
        if ((++sp & 255u) == 0u) { if (xb_ld(&bar[XB_TMO])) break; if (sp > XB_SPIN_CAP) { atomicAdd(&bar[XB_TMO], 1u); break; } }
    }
    nloc = mine > 0u ? mine : 1u; nx = cnt > 0u ? cnt : 1u;
}

__device__ __forceinline__ void xcd_barrier(const XcdBarrier& b) {
    asm volatile("s_waitcnt vmcnt(0)" ::: "memory");
    __syncthreads();
    if (threadIdx.x == 0) {
        unsigned* bar = b.bar;
        __builtin_amdgcn_s_waitcnt(0);
        unsigned nloc = b.st[0], nx = b.st[1];
        if (nloc == 0u) { xcd_barrier_complete(bar, b.x, nloc, nx); b.st[0] = nloc; b.st[1] = nx; }
        const unsigned old = xb_add(&bar[XB_XSUB(b.x)], 1u);
        const unsigned gen = old / nloc;
        if (old + 1u == (gen + 1u) * nloc) {
            __builtin_amdgcn_fence(__ATOMIC_RELEASE, "agent");
            asm volatile("s_waitcnt vmcnt(0)" ::: "memory");
            const unsigned og = xb_add(&bar[XB_TOP], 1u);
            const unsigned tg = og / nx;
            if (og + 1u == (tg + 1u) * nx) xb_add(&bar[XB_TOPGEN], 1u);
            else XB_SPIN(xb_ld(&bar[XB_TOPGEN]) == tg, bar);
            __builtin_amdgcn_fence(__ATOMIC_ACQUIRE, "agent");
            xb_add(&bar[XB_XGEN(b.x)], 1u);
            asm volatile("s_waitcnt vmcnt(0)" ::: "memory");
        } else {
            XB_SPIN(xb_ld(&bar[XB_XGEN(b.x)]) == gen, bar);
            __builtin_amdgcn_fence(__ATOMIC_ACQUIRE, "agent");
            asm volatile("s_waitcnt vmcnt(0)" ::: "memory");
        }
    }
    __syncthreads();
}

constexpr int MISC_OFF = LDS_BYTES - 128;
constexpr size_t WS_CTL = 0, CTL_ZERO_BYTES = 64 * 1024;
constexpr int CW_KMAX = 8192, CW_QF = 8192 + 512, CW_QM = 8192 + 1024, CW_PCNT = 8192 + 1536;
static_assert(att::LDS_BYTES <= MISC_OFF, "LDS map");
struct Args { const float* in[13]; float* out; unsigned char* ws; int ph_lo, ph_hi, dup, pad; };
constexpr int NPHASE = 8;

__global__ void __launch_bounds__(NWAVES * 64, 2) mk_fwd(Args args) {
    extern __shared__ __attribute__((aligned(16))) unsigned char lds_raw[];
    LAS unsigned char* lds = (LAS unsigned char*)lds_raw;
    const int G = gridDim.x, bx = blockIdx.x;
#define MK_IDS int tid = threadIdx.x; asm volatile("" : "+v"(tid)); const int lane = tid & 63, wave = __builtin_amdgcn_readfirstlane(tid >> 6); const int gw = vcu * NWAVES + wave; (void)gw; (void)lane;
    const int vcu = (G % 8 == 0) ? (bx % 8) * (G / 8) + bx / 8 : bx;
    const int NGW = G * NWAVES;
    unsigned char* ws = args.ws;
#define MKP_x ((const float*)args.in[0])
#define MKP_g_mix ((const float*)args.in[1])
#define MKP_w_in ((const float*)args.in[2])
#define MKP_b_f ((const float*)args.in[3])
#define MKP_g_q ((const float*)args.in[4])
#define MKP_w_q_up ((const float*)args.in[5])
#define MKP_g_kv ((const float*)args.in[6])
#define MKP_w_kv_up ((const float*)args.in[7])
#define MKP_w_o ((const float*)args.in[8])
#define MKP_g_mlp ((const float*)args.in[9])
#define MKP_w_ff1 ((const float*)args.in[10])
#define MKP_w_ff2 ((const float*)args.in[11])
#define MKP_g_final ((const float*)args.in[12])
#define MKP_out (args.out)
#define MKP_Win_t ((bf16*)(args.ws + WS_WIN))
#define MKP_Wq_t ((bf16*)(args.ws + WS_WQ))
#define MKP_Wkv_t ((bf16*)(args.ws + WS_WKV))
#define MKP_Wo_t ((bf16*)(args.ws + WS_WO))
#define MKP_W1_t ((bf16*)(args.ws + WS_W1))
#define MKP_W2_t ((bf16*)(args.ws + WS_W2))
#define MKP_RT ((float*)(args.ws + WS_RT))
#define MKP_LF ((float*)(args.ws + WS_LF))
#define MKP_SS ((float*)(args.ws + WS_SS))
#define MKP_SSQ ((float*)(args.ws + WS_SSQ))
#define MKP_BIASF ((float*)(args.ws + WS_BIASF))
#define MKP_QMAX ((float*)(args.ws + WS_LC))
#define MKP_SSKV ((float*)(args.ws + WS_SSKV))
#define MKP_KB ((bf16*)(args.ws + WS_KB))
#define MKP_KR ((bf16*)(args.ws + WS_KR))
#define MKP_XN ((bf16*)(args.ws + WS_XN))
#define MKP_HB ((bf16*)(args.ws + WS_H))
#define MKP_P ((bf16*)(args.ws + WS_P))
#define MKP_QM ((bf16*)(args.ws + WS_QM))
#define MKP_KVM ((bf16*)(args.ws + WS_KVM))
#define MKP_QN ((bf16*)(args.ws + WS_QN))
#define MKP_OB ((bf16*)(args.ws + WS_O))
#define MKP_KVN ((bf16*)(args.ws + WS_KVN))
    const int lo = args.ph_lo, hi = args.ph_hi;
#ifndef MK_MASK
#define MK_MASK 0x1ff
#endif
#define IN(k) (((MK_MASK >> (k)) & 1) && lo <= (k) && (k) < hi)
#define REP(k) for (int rep_ = 0; rep_ < ((args.dup == (k)) ? 2 : 1); ++rep_)
    { volatile LAS unsigned* misc = (volatile LAS unsigned*)(lds + MISC_OFF); if (threadIdx.x < 32) misc[threadIdx.x] = 0u; }
    __syncthreads();
    (void)xcd_barrier_post((unsigned*)(ws + WS_CTL), (volatile LAS unsigned*)(lds + MISC_OFF) + 8);
    if (args.ph_lo < 0) cg::this_grid().sync();
#ifdef TS_PHASE
    unsigned long long ts_a_ = 0, ts_b_ = 0;
#define TS_BEGIN(k) do { if ((k) == TS_PHASE || (TS_PHASE == 99 && (k) == 0)) ts_a_ = __builtin_amdgcn_s_memrealtime(); } while (0)
#define TS_END(k) do { if ((k) == TS_PHASE || (TS_PHASE == 99 && (k) == 7)) ts_b_ = __builtin_amdgcn_s_memrealtime(); } while (0)
#else
#define TS_BEGIN(k)
#define TS_END(k)
#endif
#define SEAM(k) do { if (IN(k) && IN((k) + 1)) { XcdBarrier b_; b_.bar = (unsigned*)(args.ws + WS_CTL); b_.x = xb_xcc_id(); b_.st = (volatile LAS unsigned*)(lds + MISC_OFF) + 8; xcd_barrier(b_); } } while (0)

    TS_BEGIN(0);
    if (IN(0)) { MK_IDS
        LAS float* scr = (LAS float*)(lds + wave * 16384);
        constexpr int I_IN = (D / 64) * (NINP / 32), I_Q = (QL / 64) * (NQU / 32), I_KV = (KVL / 64) * (NKVU / 32), I_O = (D / 64) * (D / 32), I_1 = (D / 64) * (FF / 32), I_2 = (FF / 64) * (D / 32);
        constexpr int NITEMS = I_IN + I_Q + I_KV;
        (void)I_O; (void)I_1; (void)I_2;
        for (int it = gw; it < NITEMS; it += NGW) {
            int r = it;
            if (r < I_IN) { p0_transpose_item(MKP_w_in, D, NIN, NINP / 32, MKP_Win_t, 3, nullptr, scr, r, lane); continue; } r -= I_IN;
            if (r < I_Q) { p0_transpose_item(MKP_w_q_up, QL, NQU, NQU / 32, MKP_Wq_t, 1, MKP_g_q, scr, r, lane); continue; } r -= I_Q;
            p0_transpose_item(MKP_w_kv_up, KVL, NKVU, NKVU / 32, MKP_Wkv_t, 2, MKP_g_kv, scr, r, lane);
        }
        for (int m0 = gw; m0 < M; m0 += 4 * NGW) {
            const f32x4* gr = (const f32x4*)MKP_g_mix + lane; f32x4 v[4][4]; float s2[4];
#pragma unroll
            for (int r = 0; r < 4; ++r) { const int m = m0 + r * NGW; const f32x4* xr = (const f32x4*)(MKP_x + (size_t)(m < M ? m : 0) * D) + lane;
#pragma unroll
                for (int j = 0; j < 4; ++j) v[r][j] = xr[64 * j]; }
#pragma unroll
            for (int r = 0; r < 4; ++r) { s2[r] = 0.f;
#pragma unroll
                for (int j = 0; j < 4; ++j) s2[r] += (v[r][j].x * v[r][j].x + v[r][j].y * v[r][j].y) + (v[r][j].z * v[r][j].z + v[r][j].w * v[r][j].w);
                s2[r] = 1.f / sqrtf(wave_sum(s2[r]) * (1.f / D) + EPS); }
#pragma unroll
            for (int r = 0; r < 4; ++r) { const int m = m0 + r * NGW; if (m < M) { unsigned long long* o8 = (unsigned long long*)(MKP_XN + (size_t)m * D) + lane; const float rstd = s2[r];
#pragma unroll
                for (int j = 0; j < 4; ++j) { const f32x4 g = gr[64 * j]; o8[64 * j] = (unsigned long long)pk2(v[r][j].x * rstd * g.x, v[r][j].y * rstd * g.y) | ((unsigned long long)pk2(v[r][j].z * rstd * g.z, v[r][j].w * rstd * g.w) << 32); } } }
        }
        for (int e = (vcu * NWAVES * 64 + tid); e < M * 16; e += G * NWAVES * 64) {
            const int m = e >> 4, i = e & 15; double inv = 1.0; for (int j = 0; j < i; ++j) inv *= 0.56234132519034908039;
            float sn, cs; sincos_d((double)m * inv, sn, cs); MKP_RT[2 * e] = cs; MKP_RT[2 * e + 1] = sn;
        }
    }
    SEAM(0);
    TS_END(0);
    TS_BEGIN(1);
    if (IN(1)) {
        pg8::Gemm g{MKP_XN, MKP_Win_t, M, NINP, D}; pg8::StaticOrder S; S.init(M, NINP, G, bx);
        pg8::EpiIn E{MKP_P, NINP, C2_FOX, MKP_SSQ, MKP_SSKV, MKP_RT, MKP_b_f, MKP_LF, M};
        pg8::gemm_phase<pg8::EpiIn, pg8::StaticOrder, PG8_ALIGN, PG8_SP2>(lds, g, S, E);
    }
    SEAM(1);
    TS_END(1);
    TS_BEGIN(3);
    if (IN(3)) { MK_IDS
        if (wave >= 2) {
            LAS float* scr = (LAS float*)(lds + wave * 16384);
            constexpr int J_O = (D / 64) * (D / 32), J_1 = (D / 64) * (FF / 32), J_2 = (FF / 64) * (D / 32);
            for (int it = vcu * 6 + (wave - 2); it < J_O + J_1 + J_2; it += G * 6) {
                int r = it;
                if (r < J_O) { p0_transpose_item(MKP_w_o, D, D, D / 32, MKP_Wo_t, 0, nullptr, scr, r, lane); continue; } r -= J_O;
                if (r < J_1) { p0_transpose_item(MKP_w_ff1, D, FF, FF / 32, MKP_W1_t, 0, MKP_g_mlp, scr, r, lane); continue; } r -= J_1;
                p0_transpose_item(MKP_w_ff2, FF, D, D / 32, MKP_W2_t, 0, nullptr, scr, r, lane);
            }
        }
        if (wave < 2) { const int job = bx + 256 * wave;
            if (job < 512 && bx < 256) { const int h = job >> 6, ti = job & 63; const f32x4* lf4 = (const f32x4*)(MKP_LF + (size_t)h * M);
                float pre = 0.f; { int j = 0; float pa[8] = {0.f, 0.f, 0.f, 0.f, 0.f, 0.f, 0.f, 0.f};
                    for (; j + 8 <= ti; j += 8) { f32x4 w[8];
#pragma unroll
                        for (int u = 0; u < 8; ++u) w[u] = lf4[(j + u) * 64 + lane];
#pragma unroll
                        for (int u = 0; u < 8; ++u) pa[u] += (w[u].x + w[u].y) + (w[u].z + w[u].w); }
                    for (; j < ti; ++j) { const f32x4 w = lf4[j * 64 + lane]; pa[0] += (w.x + w.y) + (w.z + w.w); }
                    pre = ((pa[0] + pa[1]) + (pa[2] + pa[3])) + ((pa[4] + pa[5]) + (pa[6] + pa[7])); }
                pre = wave_sum(pre);
                const f32x4 v = lf4[ti * 64 + lane];
                const float s1 = v.x, s2 = s1 + v.y, s3 = s2 + v.z, s4 = s3 + v.w; float inc = s4;
#pragma unroll
                for (int o = 1; o < 64; o <<= 1) { const float n = __shfl_up(inc, o); if (lane >= o) inc += n; }
                const float ex = pre + (inc - s4); const float cs[4] = {ex + s1, ex + s2, ex + s3, ex + s4};
                *(f32x4*)(MKP_BIASF + (size_t)h * M + ti * 256 + 4 * lane) = (f32x4){-cs[0] * LOG2E, -cs[1] * LOG2E, -cs[2] * LOG2E, -cs[3] * LOG2E};
                { float km = 0.f;
                  float qmx = 0.f;
                  for (int e = 0; e < 4; ++e) { const v4u* kr = (const v4u*)(MKP_P + (size_t)(ti * 256 + 4 * lane + e) * NINP + 512 + h * 64); float a2 = 0.f; const v4u* qrw = kr - 64; float q2 = 0.f;
#pragma unroll
                      for (int c8 = 0; c8 < 8; ++c8) { const v4u w = qrw[c8]; const unsigned ww[4] = {w.x, w.y, w.z, w.w};
#pragma unroll
                          for (int q4 = 0; q4 < 4; ++q4) { const float lo_ = __builtin_bit_cast(float, ww[q4] << 16), hi_ = __builtin_bit_cast(float, ww[q4] & 0xffff0000u); q2 += lo_ * lo_ + hi_ * hi_; } }
                      qmx = fmaxf(qmx, q2);
#pragma unroll
                      for (int c8 = 0; c8 < 8; ++c8) { const v4u w = kr[c8]; const unsigned ww[4] = {w.x, w.y, w.z, w.w};
#pragma unroll
                          for (int q4 = 0; q4 < 4; ++q4) { const float lo_ = __builtin_bit_cast(float, ww[q4] << 16), hi_ = __builtin_bit_cast(float, ww[q4] & 0xffff0000u); a2 += lo_ * lo_ + hi_ * hi_; } }
                      km = fmaxf(km, a2); }
#pragma unroll
                  for (int o = 32; o >= 1; o >>= 1) km = fmaxf(km, __shfl_xor(km, o));
#pragma unroll
                  for (int o = 32; o >= 1; o >>= 1) qmx = fmaxf(qmx, __shfl_xor(qmx, o));
                  if (lane == 0) { atomicMax((unsigned*)(args.ws + WS_CTL) + CW_KMAX + 64 * h, __builtin_bit_cast(unsigned, km)); MKP_QMAX[h * 64 + ti] = qmx; } }
#pragma unroll
                for (int e = 0; e < 4; ++e) { const float b = -cs[e] * LOG2E; const unsigned bh = f2bf(b); const float r1 = b - __builtin_bit_cast(float, bh << 16); const unsigned bm = f2bf(r1);
                    const float r2 = r1 - __builtin_bit_cast(float, bm << 16); const unsigned bl = f2bf(r2);
                    *(v4u*)(MKP_KB + ((size_t)h * M + ti * 256 + 4 * lane + e) * 8) = (v4u){bh | (bm << 16), bl | 0x3F800000u, 0x3F803F80u, 0u}; } } }
        __syncthreads();
        { int kq = QL; asm volatile("" : "+s"(kq)); pg8::Gemm g{MKP_P + 1536, MKP_Wq_t, M, NQU, kq, NINP}; pg8::StaticOrder S; S.init(M, NQU, G, bx);
          pg8::EpiQm E{MKP_QM, NQU, MKP_RT, C2_MLA, MKP_SSQ, EPS};
          pg8::gemm_phase<pg8::EpiQm, pg8::StaticOrder, PG8_ALIGN, PG8_SP2>(lds, g, S, E); }
        { int kkv = KVL; asm volatile("" : "+s"(kkv)); pg8::Gemm g{MKP_P + 1792, MKP_Wkv_t, M, NKVU, kkv, NINP}; pg8::StaticOrder S; S.init(M, NKVU, G, bx);
          pg8::EpiKv E{MKP_KVM, NKVU, MKP_SSKV, EPS};
          pg8::gemm_phase<pg8::EpiKv, pg8::StaticOrder, PG8_ALIGN, PG8_SP2>(lds, g, S, E); }
    }
    SEAM(3);
    TS_END(3);
    TS_BEGIN(4);
    if (IN(4)) {
        const int v = (G == 256) ? vcu : bx; const int h0 = (v >> 5) & 7;
#ifdef ATT_PRIO
        if ((threadIdx.x >> 6) >= 4) __builtin_amdgcn_s_setprio(1);
#endif
        volatile LAS unsigned* misc = (volatile LAS unsigned*)(lds + MISC_OFF);
        unsigned* ctlw = (unsigned*)(args.ws + WS_CTL);
#ifndef PROBE_FOX
#define PROBE_FOX 1
#endif
#ifndef PROBE_MLA
#define PROBE_MLA 1
#endif
        for (int rep = 0; rep < PROBE_FOX; ++rep)
        for (int k = 0; k < 8; ++k) { const int h = (h0 + k) & 7;
            const float kmax2 = __builtin_bit_cast(float, __hip_atomic_load(ctlw + CW_KMAX + 64 * h, __ATOMIC_RELAXED, __HIP_MEMORY_SCOPE_AGENT));
            att::Src s{MKP_P + h * 64, NINP, MKP_P + 512 + h * 64, NINP, MKP_KB + (size_t)h * M * 8, 8, MKP_P + 1024 + h * 64, NINP, MKP_OB + h * 64, D};
            for (;;) {
                if (threadIdx.x == 0) misc[0] = __hip_atomic_fetch_add(ctlw + CW_QF + 64 * h + 16 * rep, 1u, __ATOMIC_RELAXED, __HIP_MEMORY_SCOPE_AGENT);
                __syncthreads(); const unsigned i = misc[0]; __syncthreads();
                if (i >= 64u) break;
                att::attn_unit<false>(63 - (int)i, s, lds, MKP_BIASF + (size_t)h * M, kmax2, MKP_QMAX + h * 64);
            } }
        asm volatile("" ::: "memory");
        for (int rep = 0; rep < PROBE_MLA; ++rep)
        for (int k = 0; k < 8; ++k) { const int h = (h0 + k) & 7;
            att::Src s{MKP_QM + h * 96, NQU, MKP_KVM + h * 64, NKVU, MKP_P + 1920, NINP, MKP_KVM + 512 + h * 64, NKVU, MKP_OB + 512 + h * 64, D};
            for (;;) {
                if (threadIdx.x == 0) misc[0] = __hip_atomic_fetch_add(ctlw + CW_QM + 64 * h + 16 * rep, 1u, __ATOMIC_RELAXED, __HIP_MEMORY_SCOPE_AGENT);
                __syncthreads(); const unsigned i = misc[0]; __syncthreads();
                if (i >= 64u) break;
                att::attn_unit<true>(63 - (int)i, s, lds, nullptr, 0.f, nullptr);
            } }
    }
#ifdef ATT_PRIO
    __builtin_amdgcn_s_setprio(0);
#endif
    SEAM(4);
    TS_END(4);
    TS_BEGIN(5);
    if (IN(5)) {
        pg8::Gemm g{MKP_OB, MKP_Wo_t, M, D, D}; pg8::StaticOrder S; S.init(M, D, G, bx);
        pg8::EpiRes E{MKP_x, MKP_out, D, MKP_XN, MKP_SS};
        pg8::gemm_phase<pg8::EpiRes, pg8::StaticOrder, PG8_ALIGN, PG8_SP2>(lds, g, S, E);
    }
    SEAM(5);
    TS_END(5);
    TS_BEGIN(6);
    if (IN(6)) {
        pg8::Gemm g{MKP_XN, MKP_W1_t, M, FF, D}; pg8::StaticOrder S; S.init(M, FF, G, bx);
        pg8::EpiSqRelu E{MKP_HB, FF, MKP_SS, EPS, 1.f / D};
        pg8::gemm_phase<pg8::EpiSqRelu, pg8::StaticOrder, PG8_ALIGN, PG8_SP2>(lds, g, S, E);
    }
    SEAM(6);
    TS_END(6);
    TS_BEGIN(7);
    if (IN(7)) {
        pg8::Gemm g{MKP_HB, MKP_W2_t, M, D, FF}; pg8::StaticOrder S; S.init(M, D, G, bx);
        pg8::EpiResNorm E{MKP_out, MKP_out, D, MKP_g_final, MKP_SSQ, (unsigned*)(args.ws + WS_CTL) + CW_PCNT, EPS, 1.f / D};
        pg8::gemm_phase<pg8::EpiResNorm, pg8::StaticOrder, false, PG8_SP2>(lds, g, S, E);
    }
#ifdef TS_PHASE
    { XcdBarrier b_; b_.bar = (unsigned*)(args.ws + WS_CTL); b_.x = xb_xcc_id(); b_.st = (volatile LAS unsigned*)(lds + MISC_OFF) + 8; xcd_barrier(b_); }
    TS_END(7);
    if (blockIdx.x == 0 && threadIdx.x == 0) MKP_out[0] = (float)(((ts_b_ - ts_a_) / TS_Q) * (TS_Q / 100ull));
#endif
#undef IN
#undef SEAM
#undef MKP_x
#undef MKP_g_mix
#undef MKP_w_in
#undef MKP_b_f
#undef MKP_g_q
#undef MKP_w_q_up
#undef MKP_g_kv
#undef MKP_w_kv_up
#undef MKP_w_o
#undef MKP_g_mlp
#undef MKP_w_ff1
#undef MKP_w_ff2
#undef MKP_g_final
#undef MKP_out
#undef MKP_Win_t
#undef MKP_Wq_t
#undef MKP_Wkv_t
#undef MKP_Wo_t
#undef MKP_W1_t
#undef MKP_W2_t
#undef MKP_RT
#undef MKP_LF
#undef MKP_SS
#undef MKP_SSQ
#undef MKP_BIASF
#undef MKP_QMAX
#undef MKP_SSKV
#undef MKP_KB
#undef MKP_KR
#undef MKP_XN
#undef MKP_HB
#undef MKP_P
#undef MKP_QM
#undef MKP_KVM
#undef MKP_QN
#undef MKP_OB
#undef MKP_KVN
}

#ifndef MK_ONE_LAUNCH
#define MK_ONE_LAUNCH 1
#endif
extern "C" void kernel_launch(void* const* d_in, const int* in_sizes, int n_in, void* d_out, int out_size, void* d_ws, size_t ws_size, hipStream_t stream) {
    static int ready = 0;
    if (ready == 0) {
        if (n_in != 13 || in_sizes[0] != M * D || out_size != M * D || ws_size < WS_END) { fprintf(stderr, "kernel_launch: unexpected shapes (n_in %d, in0 %d, out %d, ws %zu)\n", n_in, n_in > 0 ? in_sizes[0] : -1, out_size, ws_size); ready = -1; return; }
        if (hipFuncSetAttribute((const void*)mk_fwd, hipFuncAttributeMaxDynamicSharedMemorySize, LDS_BYTES) != hipSuccess) { fprintf(stderr, "kernel_launch: hipFuncSetAttribute failed\n"); ready = -1; return; }
        ready = 1;
    }
    if (ready < 0) return;
    if (hipMemsetAsync((char*)d_ws + WS_CTL, 0, CTL_ZERO_BYTES, stream) != hipSuccess) { fprintf(stderr, "kernel_launch: hipMemsetAsync failed\n"); return; }
    Args a{};
    for (int i = 0; i < 13; ++i) a.in[i] = (const float*)d_in[i];
    a.out = (float*)d_out; a.ws = (unsigned char*)d_ws;
#ifndef MK_DUP
#define MK_DUP -1
#endif
    a.dup = MK_DUP;
    const int grid = 256;
#if MK_ONE_LAUNCH
    a.ph_lo = 0; a.ph_hi = NPHASE;
    void* kargs[] = {&a};
    hipError_t e = hipLaunchCooperativeKernel((const void*)mk_fwd, dim3(grid), dim3(NWAVES * 64), kargs, LDS_BYTES, stream);
    if (e != hipSuccess) fprintf(stderr, "kernel_launch: cooperative launch failed: %s\n", hipGetErrorString(e));
#else
    for (int p = 0; p < NPHASE; ++p) { a.ph_lo = p; a.ph_hi = p + 1; hipLaunchKernelGGL(mk_fwd, dim3(grid), dim3(NWAVES * 64), LDS_BYTES, stream, a); }
#endif
}
```

```cpp
#include <hip/hip_runtime.h>
#include <hip/hip_cooperative_groups.h>
#include <hip/hip_bf16.h>
#include <cstdio>
#include <cstdint>
#include <cmath>
namespace pg8 {
#define PG8_LAS __attribute__((address_space(3)))
typedef unsigned short bf16_t;
typedef short bf16x8 __attribute__((ext_vector_type(8)));
typedef float f32x4 __attribute__((ext_vector_type(4)));
typedef unsigned u32x4 __attribute__((ext_vector_type(4)));
constexpr int BM = 256, BK = 64, HALF = 128, HTB = HALF * BK * 2  , STAGE_BYTES = 8 * HTB, NXCD = 8, WGM = 8;

__host__ __device__ __forceinline__ int lds_byte(int r, int c) { const int st = (r >> 4) * 2 + (c >> 5), rr = r & 15, cc = c & 31, ob = rr * 64 + cc * 2; return st * 1024 + (ob ^ (((ob >> 9) & 1) << 5)); }
__host__ __device__ __forceinline__ void stage_rc(int b, int& R, int& C) { const int st = b / 1024, sb = b % 1024, swz = sb ^ (((sb >> 9) & 1) << 5); R = (st >> 1) * 16 + swz / 64; C = (st & 1) * 32 + (swz % 64) / 2; }
__host__ __device__ __forceinline__ int perm32(int rho) { const int n = rho >> 4, i = rho & 15; return 8 * (i >> 2) + 4 * n + (i & 3); }

struct Unit { int pm, pn; };
struct Gemm { const bf16_t* A; const bf16_t* Bt; int M, N, K; int lda; };

struct StaticOrder {
    int nM, nN, nwg, G, c;
    __host__ __device__ void init(int M, int N, int G_, int c_) { nM = M / BM; nN = N / BM; nwg = nM * nN; G = G_; c = c_; }
    __host__ __device__ bool next(int i, Unit& u) const {
        const long L = (long)i * G + c; if (L >= nwg) return false;
        int wgid = (int)L; { const int q = nwg / NXCD, r = nwg % NXCD, xcd = wgid % NXCD, off = wgid / NXCD; wgid = (xcd < r ? xcd * (q + 1) : r * (q + 1) + (xcd - r) * q) + off; }
        const int nig = WGM * nN, gid = wgid / nig, fm = gid * WGM, gsz = (nM - fm) < WGM ? (nM - fm) : WGM;
        u.pm = fm + ((wgid % nig) % gsz); u.pn = (wgid % nig) / gsz; return true;
    }
    __device__ __forceinline__ void a_ready(const Unit&) const {}
    __device__ __forceinline__ void done(const Unit&) const {}
};

__device__ __forceinline__ unsigned cvt_pk_bf16(float lo, float hi) { unsigned r; asm volatile("v_cvt_pk_bf16_f32 %0, %1, %2" : "=v"(r) : "v"(lo), "v"(hi)); return r; }
typedef float f32x2 __attribute__((ext_vector_type(2)));
__device__ __forceinline__ f32x2 gelu_pk(f32x2 v) {
    const f32x2 av = __builtin_elementwise_abs(v), d = av * 0.2316418882f + 1.0f;
    f32x2 t; t.x = __builtin_amdgcn_rcpf(d.x); t.y = __builtin_amdgcn_rcpf(d.y);
    f32x2 q = t * 0.5307027145f + (-0.7265760135f); q = q * t + 0.7107068705f; q = q * t + (-0.142248368f); q = q * t + 0.127414796f; q = q * t;
    const f32x2 s = (v * v) * (-0.72134752044f);
    f32x2 e; e.x = __builtin_amdgcn_exp2f(s.x); e.y = __builtin_amdgcn_exp2f(s.y);
    const f32x2 m = v * (q * e), r = v - m;
    f32x2 o; o.x = v.x < 0.f ? m.x : r.x; o.y = v.y < 0.f ? m.y : r.y; return o;
}

template <int ACT  > struct EpiBf16 {
    static constexpr bool PERM = true, AFTER_DRAIN = false; static_assert(ACT == 0 || ACT == 1, "EpiBf16: ACT is 0 (none) or 1 (gelu_pk)");
    bf16_t* O; int ldc; const float* bias; int split_cols; size_t split_stride; float scale0;
    __device__ __forceinline__ void operator()(const f32x4 (&acc)[2][2][4][2], const Unit& u, int wr, int wc, int fr, int fq) const {
        const int row0 = u.pm * BM + wr * 64 + fr; int colt = u.pn * BM; bf16_t* base = O;
        float sc = 1.f; if (split_cols) { const int t = colt / split_cols; base += (size_t)t * split_stride; colt -= t * split_cols; if (t == 0) sc = scale0; }
        const int col0 = colt + wc * 32 + 8 * fq, bcol0 = u.pn * BM + wc * 32 + 8 * fq;
        f32x4 bv[2][2];
#pragma unroll
        for (int bj = 0; bj < 2; ++bj)
#pragma unroll
            for (int n = 0; n < 2; ++n) bv[bj][n] = bias ? *(const f32x4*)(bias + bcol0 + bj * HALF + 4 * n) : (f32x4){0.f, 0.f, 0.f, 0.f};
#pragma unroll
        for (int ai = 0; ai < 2; ++ai)
#pragma unroll
            for (int m = 0; m < 4; ++m) { bf16_t* rowp = base + (size_t)(row0 + ai * HALF + m * 16) * ldc + col0;
#pragma unroll
                for (int bj = 0; bj < 2; ++bj) { f32x4 v0 = acc[ai][bj][m][0] + bv[bj][0], v1 = acc[ai][bj][m][1] + bv[bj][1];
                    if (ACT == 1) { f32x2 a = gelu_pk((f32x2){v0[0], v0[1]}), b = gelu_pk((f32x2){v0[2], v0[3]}), c = gelu_pk((f32x2){v1[0], v1[1]}), d = gelu_pk((f32x2){v1[2], v1[3]});
                        v0 = (f32x4){a.x, a.y, b.x, b.y}; v1 = (f32x4){c.x, c.y, d.x, d.y}; }
                    v0 = v0 * sc; v1 = v1 * sc; u32x4 w; w.x = cvt_pk_bf16(v0[0], v0[1]); w.y = cvt_pk_bf16(v0[2], v0[3]); w.z = cvt_pk_bf16(v1[0], v1[1]); w.w = cvt_pk_bf16(v1[2], v1[3]);
                    *(u32x4*)(rowp + bj * HALF) = w; } }
    }
};

struct EpiQm {
    static constexpr bool PERM = true, AFTER_DRAIN = false;
    bf16_t* O; int ldc; const float* rt; float scale; const float* ssq; float eps;
    __device__ __forceinline__ void operator()(const f32x4 (&acc)[2][2][4][2], const Unit& u, int wr, int wc, int fr, int fq) const {
        const int row0 = u.pm * BM + wr * 64 + fr, col0 = u.pn * BM + wc * 32 + 8 * fq;
#pragma unroll
        for (int ai = 0; ai < 2; ++ai)
#pragma unroll
            for (int m = 0; m < 4; ++m) { const int row = row0 + ai * HALF + m * 16;
                const f32x4 sq = *(const f32x4*)(ssq + (size_t)row * 4); const float rs = scale / sqrtf(((sq[0] + sq[1]) + (sq[2] + sq[3])) * (1.0f / 256.0f) + eps);
#pragma unroll
                for (int bj = 0; bj < 2; ++bj) { const int c = col0 + bj * HALF, d = c % 96;
                    f32x4 v0 = acc[ai][bj][m][0], v1 = acc[ai][bj][m][1];
                    if (d >= 64) { const f32x4* t = (const f32x4*)(rt + (size_t)row * 32 + (d - 64)); const f32x4 t0 = t[0], t1 = t[1];
                        f32x4 w0, w1;
                        w0[0] = v0[0] * t0[0] - v0[1] * t0[1]; w0[1] = v0[1] * t0[0] + v0[0] * t0[1];
                        w0[2] = v0[2] * t0[2] - v0[3] * t0[3]; w0[3] = v0[3] * t0[2] + v0[2] * t0[3];
                        w1[0] = v1[0] * t1[0] - v1[1] * t1[1]; w1[1] = v1[1] * t1[0] + v1[0] * t1[1];
                        w1[2] = v1[2] * t1[2] - v1[3] * t1[3]; w1[3] = v1[3] * t1[2] + v1[2] * t1[3];
                        v0 = w0; v1 = w1; }
                    v0 = v0 * rs; v1 = v1 * rs; u32x4 w; w.x = cvt_pk_bf16(v0[0], v0[1]); w.y = cvt_pk_bf16(v0[2], v0[3]); w.z = cvt_pk_bf16(v1[0], v1[1]); w.w = cvt_pk_bf16(v1[2], v1[3]);
                    *(u32x4*)(O + (size_t)row * ldc + c) = w; }
                asm volatile("" ::: "memory"); }
    }
};

struct EpiKv {
    static constexpr bool PERM = true, AFTER_DRAIN = false;
    bf16_t* O; int ldc; const float* ssq; float eps;
    __device__ __forceinline__ void operator()(const f32x4 (&acc)[2][2][4][2], const Unit& u, int wr, int wc, int fr, int fq) const {
        const int row0 = u.pm * BM + wr * 64 + fr, col0 = u.pn * BM + wc * 32 + 8 * fq;
#pragma unroll
        for (int ai = 0; ai < 2; ++ai)
#pragma unroll
            for (int m = 0; m < 4; ++m) { const int row = row0 + ai * HALF + m * 16;
                const f32x4 sq = *(const f32x4*)(ssq + (size_t)row * 4); const float rs = 1.0f / sqrtf(((sq[0] + sq[1]) + (sq[2] + sq[3])) * (1.0f / 128.0f) + eps);
#pragma unroll
                for (int bj = 0; bj < 2; ++bj) { const f32x4 v0 = acc[ai][bj][m][0] * rs, v1 = acc[ai][bj][m][1] * rs;
                    u32x4 w; w.x = cvt_pk_bf16(v0[0], v0[1]); w.y = cvt_pk_bf16(v0[2], v0[3]); w.z = cvt_pk_bf16(v1[0], v1[1]); w.w = cvt_pk_bf16(v1[2], v1[3]);
                    *(u32x4*)(O + (size_t)row * ldc + col0 + bj * HALF) = w; }
                asm volatile("" ::: "memory"); }
    }
};
struct EpiIn {
    static constexpr bool PERM = true, AFTER_DRAIN = false;
    bf16_t* O; int ldc; float scale0; float* ssq; float* sskv; const float* rt; const float* bf; float* lf; int nrows;
    __device__ __forceinline__ void operator()(const f32x4 (&acc)[2][2][4][2], const Unit& u, int wr, int wc, int fr, int fq) const {
        const int row0 = u.pm * BM + wr * 64 + fr, col0 = u.pn * BM + wc * 32 + 8 * fq; const int pn = u.pn;
        const float sc = pn < 2 ? scale0 : 1.f;
#pragma unroll
        for (int ai = 0; ai < 2; ++ai)
#pragma unroll
            for (int m = 0; m < 4; ++m) { const int row = row0 + ai * HALF + m * 16; bf16_t* rowp = O + (size_t)row * ldc + col0; float s0 = 0.f, s1 = 0.f;
#pragma unroll
                for (int bj = 0; bj < 2; ++bj) { f32x4 v0 = acc[ai][bj][m][0] * sc, v1 = acc[ai][bj][m][1] * sc;
                    const float sq = ((v0[0] * v0[0] + v0[1] * v0[1]) + (v0[2] * v0[2] + v0[3] * v0[3])) + ((v1[0] * v1[0] + v1[1] * v1[1]) + (v1[2] * v1[2] + v1[3] * v1[3]));
                    if (bj == 0) s0 = sq; else s1 = sq;
                    bool store = true;
                    if (pn == 7 && bj == 1) { store = (wc == 0);
                        if (wc == 0) { const f32x4* t = (const f32x4*)(rt + (size_t)row * 32 + 8 * fq); const f32x4 t0 = t[0], t1 = t[1]; f32x4 w0, w1;
                            w0[0] = v0[0] * t0[0] - v0[1] * t0[1]; w0[1] = v0[1] * t0[0] + v0[0] * t0[1];
                            w0[2] = v0[2] * t0[2] - v0[3] * t0[3]; w0[3] = v0[3] * t0[2] + v0[2] * t0[3];
                            w1[0] = v1[0] * t1[0] - v1[1] * t1[1]; w1[1] = v1[1] * t1[0] + v1[0] * t1[1];
                            w1[2] = v1[2] * t1[2] - v1[3] * t1[3]; w1[3] = v1[3] * t1[2] + v1[2] * t1[3];
                            v0 = w0; v1 = w1; }
                        else if (wc == 1 && fq == 0) {
#pragma unroll
                            for (int e = 0; e < 8; ++e) { const float z = (e < 4 ? v0[e & 3] : v1[e & 3]) + bf[e]; lf[(size_t)e * nrows + row] = fminf(z, 0.f) - 0.6931471805599453f * __builtin_amdgcn_logf(1.0f + __builtin_amdgcn_exp2f(-1.4426950408889634f * fabsf(z))); } } }
                    if (store) { u32x4 w; w.x = cvt_pk_bf16(v0[0], v0[1]); w.y = cvt_pk_bf16(v0[2], v0[3]); w.z = cvt_pk_bf16(v1[0], v1[1]); w.w = cvt_pk_bf16(v1[2], v1[3]);
                        *(u32x4*)(rowp + bj * HALF) = w; } }
                if (pn == 6) { float s = s0 + s1; s += __shfl_xor(s, 16); s += __shfl_xor(s, 32); if (fq == 0) ssq[(size_t)row * 4 + wc] = s; }
                if (pn == 7) { float s = s0; s += __shfl_xor(s, 16); s += __shfl_xor(s, 32); if (fq == 0) sskv[(size_t)row * 4 + wc] = s; }
                asm volatile("" ::: "memory"); }
    }
};
struct EpiRes {
    static constexpr bool PERM = false, AFTER_DRAIN = false;
    const float* base; float* out; int ldc; bf16_t* ob; float* ss;
    __device__ __forceinline__ void operator()(const f32x4 (&acc)[2][2][4][2], const Unit& u, int wr, int wc, int fr, int fq) const {
        typedef unsigned u32x2v __attribute__((ext_vector_type(2)));
        const int row0 = u.pm * BM + wr * 64 + fr, col0 = u.pn * BM + wc * 32 + 4 * fq;
#pragma unroll
        for (int ai = 0; ai < 2; ++ai)
#pragma unroll
            for (int m = 0; m < 4; ++m) { const int row = row0 + ai * HALF + m * 16; const size_t off = (size_t)row * ldc + col0; float s = 0.f;
#pragma unroll
                for (int bj = 0; bj < 2; ++bj)
#pragma unroll
                    for (int n = 0; n < 2; ++n) { const f32x4 v = *(const f32x4*)(base + off + bj * HALF + n * 16) + acc[ai][bj][m][n];
                        *(f32x4*)(out + off + bj * HALF + n * 16) = v; s += (v[0] * v[0] + v[1] * v[1]) + (v[2] * v[2] + v[3] * v[3]);
                        if (ob) { u32x2v w; w.x = cvt_pk_bf16(v[0], v[1]); w.y = cvt_pk_bf16(v[2], v[3]); *(u32x2v*)(ob + off + bj * HALF + n * 16) = w; } }
                if (ss) { s += __shfl_xor(s, 16); s += __shfl_xor(s, 32); if (fq == 0) ss[(size_t)row * 16 + u.pn * 4 + wc] = s; }
                asm volatile("" ::: "memory");
            }
    }
};

struct EpiResNorm {
    static constexpr bool PERM = false, AFTER_DRAIN = true;
    const float* base; float* out; int ldc; const float* g; float* xs; unsigned* cnt; float eps; float inv_n;
    __device__ __forceinline__ void fused(f32x4 (&acc)[2][2][4][2], const Unit& u, int wr, int wc, int fr, int fq, PG8_LAS unsigned char* lds, int wid, int lane) const {
        PG8_LAS float* Pm = (PG8_LAS float*)lds;
        PG8_LAS float* S = (PG8_LAS float*)(lds + 4096);
        const int row0 = u.pm * BM + wr * 64 + fr, col0 = u.pn * BM + wc * 32 + 4 * fq;
#pragma unroll
        for (int ai = 0; ai < 2; ++ai)
#pragma unroll
            for (int m = 0; m < 4; ++m) { const size_t off = (size_t)(row0 + ai * HALF + m * 16) * ldc + col0; float s = 0.f;
#pragma unroll
                for (int bj = 0; bj < 2; ++bj)
#pragma unroll
                    for (int n = 0; n < 2; ++n) { const f32x4 v = *(const f32x4*)(base + off + bj * HALF + n * 16) + acc[ai][bj][m][n]; acc[ai][bj][m][n] = v;
                        s += (v[0] * v[0] + v[1] * v[1]) + (v[2] * v[2] + v[3] * v[3]); }
                s += __shfl_xor(s, 16); s += __shfl_xor(s, 32);
                if (fq == 0) Pm[(ai * HALF + wr * 64 + m * 16 + fr) * 4 + wc] = s;
                if (m & 1) asm volatile("" ::: "memory"); }
        asm volatile("s_waitcnt lgkmcnt(0)" ::: "memory"); __builtin_amdgcn_s_barrier(); asm volatile("" ::: "memory");
        const int tid = wid * 64 + lane;
        if (tid < 256) { const f32x4 p4 = *(const PG8_LAS f32x4*)(Pm + tid * 4);
            __hip_atomic_store(xs + (size_t)(u.pm * BM + tid) * 4 + u.pn, (p4[0] + p4[1]) + (p4[2] + p4[3]), __ATOMIC_RELAXED, __HIP_MEMORY_SCOPE_AGENT);
            asm volatile("s_waitcnt vmcnt(0)" ::: "memory");
            if (lane == 0) __hip_atomic_fetch_add(cnt + 64 * u.pm, 1u, __ATOMIC_RELAXED, __HIP_MEMORY_SCOPE_AGENT); }
        if (wid == 0) { unsigned sp = 0;
            while ((unsigned)__builtin_amdgcn_readfirstlane(__hip_atomic_load(cnt + 64 * u.pm, __ATOMIC_RELAXED, __HIP_MEMORY_SCOPE_AGENT)) < 16u) { __builtin_amdgcn_s_sleep(2); if (++sp > (1u << 22)) break; }
            __builtin_amdgcn_fence(__ATOMIC_ACQUIRE, "agent"); }
        asm volatile("s_waitcnt vmcnt(0) lgkmcnt(0)" ::: "memory"); __builtin_amdgcn_s_barrier(); asm volatile("" ::: "memory");
        if (tid < 256) { const float* xp = xs + (size_t)(u.pm * BM + tid) * 4;
            const float t0 = __hip_atomic_load(xp + 0, __ATOMIC_RELAXED, __HIP_MEMORY_SCOPE_AGENT), t1 = __hip_atomic_load(xp + 1, __ATOMIC_RELAXED, __HIP_MEMORY_SCOPE_AGENT);
            const float t2 = __hip_atomic_load(xp + 2, __ATOMIC_RELAXED, __HIP_MEMORY_SCOPE_AGENT), t3 = __hip_atomic_load(xp + 3, __ATOMIC_RELAXED, __HIP_MEMORY_SCOPE_AGENT);
            S[tid] = 1.0f / sqrtf(((t0 + t1) + (t2 + t3)) * inv_n + eps); }
        asm volatile("s_waitcnt vmcnt(0) lgkmcnt(0)" ::: "memory"); __builtin_amdgcn_s_barrier(); asm volatile("" ::: "memory");
        f32x4 gv[2][2];
#pragma unroll
        for (int bj = 0; bj < 2; ++bj)
#pragma unroll
            for (int n = 0; n < 2; ++n) gv[bj][n] = *(const f32x4*)(g + col0 + bj * HALF + n * 16);
#pragma unroll
        for (int ai = 0; ai < 2; ++ai)
#pragma unroll
            for (int m = 0; m < 4; ++m) { const int r = ai * HALF + wr * 64 + m * 16 + fr; const float rs = S[r]; const size_t off = (size_t)(u.pm * BM + r) * ldc + col0;
#pragma unroll
                for (int bj = 0; bj < 2; ++bj)
#pragma unroll
                    for (int n = 0; n < 2; ++n) *(f32x4*)(out + off + bj * HALF + n * 16) = acc[ai][bj][m][n] * rs * gv[bj][n]; }
    }
};
struct EpiSqRelu {
    static constexpr bool PERM = true, AFTER_DRAIN = false;
    bf16_t* O; int ldc; const float* ss; float eps; float inv_n;
    __device__ __forceinline__ void operator()(const f32x4 (&acc)[2][2][4][2], const Unit& u, int wr, int wc, int fr, int fq) const {
        const int row0 = u.pm * BM + wr * 64 + fr, col0 = u.pn * BM + wc * 32 + 8 * fq;
#pragma unroll
        for (int ai = 0; ai < 2; ++ai)
#pragma unroll
            for (int m = 0; m < 4; ++m) { const int row = row0 + ai * HALF + m * 16;
                const f32x4* sp = (const f32x4*)(ss + (size_t)row * 16); const f32x4 a = sp[0], b = sp[1], c = sp[2], d = sp[3];
                const float tot = ((a[0] + a[1]) + (a[2] + a[3])) + ((b[0] + b[1]) + (b[2] + b[3])) + ((c[0] + c[1]) + (c[2] + c[3])) + ((d[0] + d[1]) + (d[2] + d[3]));
                const float rstd = 1.0f / sqrtf(tot * inv_n + eps);
#pragma unroll
                for (int bj = 0; bj < 2; ++bj) { f32x4 v0 = acc[ai][bj][m][0] * rstd, v1 = acc[ai][bj][m][1] * rstd;
#pragma unroll
                    for (int e = 0; e < 4; ++e) { const float x0 = fmaxf(v0[e], 0.f), x1 = fmaxf(v1[e], 0.f); v0[e] = x0 * x0; v1[e] = x1 * x1; }
                    u32x4 w; w.x = cvt_pk_bf16(v0[0], v0[1]); w.y = cvt_pk_bf16(v0[2], v0[3]); w.z = cvt_pk_bf16(v1[0], v1[1]); w.w = cvt_pk_bf16(v1[2], v1[3]);
                    *(u32x4*)(O + (size_t)row * ldc + col0 + bj * HALF) = w; }
                asm volatile("" ::: "memory"); }
    }
};


template <class Epi, class Sched, bool ALIGN_EPI = false, bool SP2 = false>
__device__ __forceinline__ void gemm_phase(PG8_LAS unsigned char* lds, const Gemm g, const Sched& S, const Epi& E) {
    const int tid = threadIdx.x, wid = __builtin_amdgcn_readfirstlane(tid >> 6), lane = tid & 63, wr = wid >> 2, wc = wid & 3, fr = lane & 15, fq = lane >> 4;
    const int K = g.K, nt = K / BK, lda = g.lda ? g.lda : g.K;
    unsigned voffA[2], voffB[2];
#pragma unroll
    for (int i = 0; i < 2; ++i) { int R, C; stage_rc(tid * 16 + i * 8192, R, C); const int Rb = Epi::PERM ? ((R & ~31) + perm32(R & 31)) : R;
        voffA[i] = (unsigned)(R * lda + C) * 2u; voffB[i] = (unsigned)(Rb * K + C) * 2u; }
    const size_t kstep = (size_t)(BK * 2);
    const size_t hstep = (size_t)HALF * K * 2;
    const size_t tstep = 2 * hstep;
    const size_t hstepA = (size_t)HALF * lda * 2, tstepA = 2 * hstepA;
    const unsigned ldsw = (unsigned)wid * 1024u;
    const int aoff = lds_byte(wr * 64 + fr, fq * 8), boff = lds_byte(wc * 32 + fr, fq * 8);
#define PG8_SA(b, h) (((b) * 2 + (h)) * HTB)
#define PG8_SB(b, h) ((4 + (b) * 2 + (h)) * HTB)
#define PG8_STAGE(bufoff, gbase, voff) do { _Pragma("unroll") for (int _i = 0; _i < 2; ++_i) \
        __builtin_amdgcn_global_load_lds((const unsigned*)((const char*)(gbase) + (voff)[_i]), (PG8_LAS unsigned*)(lds + (bufoff) + ldsw + _i * 8192), 16, 0, 0); } while (0)
#define PG8_LDA(dst, b, h) do { _Pragma("unroll") for (int m = 0; m < 4; ++m) _Pragma("unroll") for (int k = 0; k < 2; ++k) dst[m][k] = *(const PG8_LAS bf16x8*)(lds + PG8_SA(b, h) + aoff + m * 2048 + k * 1024); } while (0)
#define PG8_LDB(dst, b, h) do { _Pragma("unroll") for (int n = 0; n < 2; ++n) _Pragma("unroll") for (int k = 0; k < 2; ++k) dst[n][k] = *(const PG8_LAS bf16x8*)(lds + PG8_SB(b, h) + boff + n * 2048 + k * 1024); } while (0)
#define PG8_MMA(ai, bj, At, Bt) do { __builtin_amdgcn_s_setprio(1); _Pragma("unroll") for (int m = 0; m < 4; ++m) _Pragma("unroll") for (int n = 0; n < 2; ++n) _Pragma("unroll") for (int k = 0; k < 2; ++k) \
        acc[ai][bj][m][n] = __builtin_amdgcn_mfma_f32_16x16x32_bf16(Bt[n][k], At[m][k], acc[ai][bj][m][n], 0, 0, 0); __builtin_amdgcn_s_setprio(0); } while (0)
#define PG8_WAIT_V(n) asm volatile("s_waitcnt vmcnt(" #n ")" ::: "memory")
#define PG8_WAIT_L(n) asm volatile("s_waitcnt lgkmcnt(" #n ")" ::: "memory")
#define PG8_BAR __builtin_amdgcn_s_barrier()
#define PG8_SCHED __builtin_amdgcn_sched_barrier(0)
    Unit cur, nxt; int ui = 0;
    if (!S.next(0, cur)) return;
    f32x4 acc[2][2][4][2];
#pragma unroll
    for (int a = 0; a < 2; ++a)
#pragma unroll
        for (int b = 0; b < 2; ++b)
#pragma unroll
            for (int m = 0; m < 4; ++m)
#pragma unroll
                for (int n = 0; n < 2; ++n) acc[a][b][m][n] = (f32x4){0.f, 0.f, 0.f, 0.f};
    bf16x8 At[4][2], B0[2][2], B1[2][2];
    const char* cA = (const char*)g.A + (size_t)cur.pm * tstepA; const char* cB = (const char*)g.Bt + (size_t)cur.pn * tstep;
    S.a_ready(cur);
    if constexpr (SP2) {
        PG8_STAGE(PG8_SB(0, 0), cB, voffB); PG8_STAGE(PG8_SB(0, 1), cB + hstep, voffB); PG8_STAGE(PG8_SA(0, 0), cA, voffA); PG8_STAGE(PG8_SA(0, 1), cA + hstepA, voffA);
        if (wr == 1) PG8_BAR;
        PG8_WAIT_V(2); PG8_BAR;
        PG8_STAGE(PG8_SB(1, 0), cB + kstep, voffB); PG8_STAGE(PG8_SA(1, 0), cA + kstep, voffA); PG8_STAGE(PG8_SB(1, 1), cB + hstep + kstep, voffB);
        PG8_WAIT_V(6); PG8_BAR;
    } else {
        PG8_STAGE(PG8_SB(0, 0), cB, voffB); PG8_STAGE(PG8_SA(0, 0), cA, voffA); PG8_STAGE(PG8_SB(0, 1), cB + hstep, voffB); PG8_STAGE(PG8_SA(0, 1), cA + hstepA, voffA);
        if (wr == 1) PG8_BAR;
        PG8_WAIT_V(4); PG8_BAR;
        PG8_STAGE(PG8_SB(1, 0), cB + kstep, voffB); PG8_STAGE(PG8_SA(1, 0), cA + kstep, voffA); PG8_STAGE(PG8_SB(1, 1), cB + hstep + kstep, voffB);
        PG8_WAIT_V(6); PG8_BAR;
    }
    for (;;) {
        const bool has_next = S.next(ui + 1, nxt);
        const char* nA = has_next ? (const char*)g.A + (size_t)nxt.pm * tstepA : cA; const char* nB = has_next ? (const char*)g.Bt + (size_t)nxt.pn * tstep : cB;
        for (int t = 0; t < nt; t += 2) {
            const bool last = (t == nt - 2);
            const char* a1 = cA + (size_t)(t + 1) * kstep;
            const char* a2 = last ? nA : cA + (size_t)(t + 2) * kstep; const char* b2 = last ? nB : cB + (size_t)(t + 2) * kstep;
            const char* a3 = a2 + kstep; const char* b3 = b2 + kstep;
            if (last && has_next) S.a_ready(nxt);
            if constexpr (SP2) {
            PG8_LDB(B0, 0, 0); PG8_LDB(B1, 0, 1); PG8_SCHED; PG8_LDA(At, 0, 0); PG8_STAGE(PG8_SA(1, 1), a1 + hstepA, voffA);
            PG8_WAIT_V(8); PG8_WAIT_L(0); PG8_BAR; PG8_MMA(0, 0, At, B0); PG8_MMA(0, 1, At, B1); PG8_BAR; PG8_SCHED;
            PG8_LDA(At, 0, 1); PG8_STAGE(PG8_SB(0, 0), b2, voffB); PG8_STAGE(PG8_SB(0, 1), b2 + hstep, voffB); PG8_STAGE(PG8_SA(0, 0), a2, voffA);
            PG8_WAIT_V(8); PG8_WAIT_L(0); PG8_BAR; PG8_MMA(1, 0, At, B0); PG8_MMA(1, 1, At, B1); PG8_BAR; PG8_SCHED;
            PG8_LDB(B0, 1, 0); PG8_LDB(B1, 1, 1); PG8_SCHED; PG8_LDA(At, 1, 0); PG8_STAGE(PG8_SA(0, 1), a2 + hstepA, voffA);
            PG8_WAIT_V(8); PG8_WAIT_L(0); PG8_BAR; PG8_MMA(0, 0, At, B0); PG8_MMA(0, 1, At, B1); PG8_BAR; PG8_SCHED;
            PG8_LDA(At, 1, 1); PG8_STAGE(PG8_SB(1, 0), b3, voffB); PG8_STAGE(PG8_SB(1, 1), b3 + hstep, voffB); PG8_STAGE(PG8_SA(1, 0), a3, voffA);
            PG8_WAIT_V(8); PG8_WAIT_L(0); PG8_BAR; PG8_MMA(1, 0, At, B0); PG8_MMA(1, 1, At, B1); PG8_BAR; PG8_SCHED;
            } else {
            PG8_LDB(B0, 0, 0); PG8_SCHED; PG8_LDA(At, 0, 0); PG8_STAGE(PG8_SA(1, 1), a1 + hstepA, voffA);
            PG8_WAIT_L(8); PG8_BAR; PG8_WAIT_L(0); PG8_MMA(0, 0, At, B0); PG8_BAR; PG8_SCHED;
            PG8_LDB(B1, 0, 1); PG8_STAGE(PG8_SB(0, 0), b2, voffB);
            PG8_BAR; PG8_WAIT_L(0); PG8_MMA(0, 1, At, B1); PG8_BAR;
            PG8_LDA(At, 0, 1); PG8_STAGE(PG8_SA(0, 0), a2, voffA);
            PG8_BAR; PG8_WAIT_L(0); PG8_MMA(1, 0, At, B0); PG8_BAR; PG8_SCHED;
            PG8_STAGE(PG8_SB(0, 1), b2 + hstep, voffB);
            PG8_WAIT_V(6); PG8_BAR; PG8_MMA(1, 1, At, B1); PG8_BAR;
            PG8_LDB(B0, 1, 0); PG8_SCHED; PG8_LDA(At, 1, 0); PG8_STAGE(PG8_SA(0, 1), a2 + hstepA, voffA);
            PG8_WAIT_L(8); PG8_BAR; PG8_WAIT_L(0); PG8_MMA(0, 0, At, B0); PG8_BAR; PG8_SCHED;
            PG8_LDB(B1, 1, 1); PG8_STAGE(PG8_SB(1, 0), b3, voffB);
            PG8_BAR; PG8_WAIT_L(0); PG8_MMA(0, 1, At, B1); PG8_BAR;
            PG8_LDA(At, 1, 1); PG8_STAGE(PG8_SA(1, 0), a3, voffA);
            PG8_BAR; PG8_WAIT_L(0); PG8_MMA(1, 0, At, B0); PG8_BAR; PG8_SCHED;
            PG8_STAGE(PG8_SB(1, 1), b3 + hstep, voffB);
            PG8_WAIT_V(6); PG8_BAR; PG8_MMA(1, 1, At, B1); PG8_BAR;
            }
        }
        if constexpr (ALIGN_EPI) { if (wr == 0) PG8_BAR; }
        if constexpr (!Epi::AFTER_DRAIN) { E(acc, cur, wr, wc, fr, fq); S.done(cur); }
        if (!has_next) break;
#pragma unroll
        for (int a = 0; a < 2; ++a)
#pragma unroll
            for (int b = 0; b < 2; ++b)
#pragma unroll
                for (int m = 0; m < 4; ++m)
#pragma unroll
                    for (int n = 0; n < 2; ++n) acc[a][b][m][n] = (f32x4){0.f, 0.f, 0.f, 0.f};
        cur = nxt; cA = nA; cB = nB; ++ui;
        if constexpr (ALIGN_EPI) { if (wr == 1) PG8_BAR; }
    }
    PG8_WAIT_V(0);
    if constexpr (!ALIGN_EPI) { if (wr == 0) PG8_BAR; }
    PG8_BAR;
    if constexpr (Epi::AFTER_DRAIN) { E.fused(acc, cur, wr, wc, fr, fq, lds, wid, lane); S.done(cur); }
#undef PG8_SA
#undef PG8_SB
#undef PG8_STAGE
#undef PG8_LDA
#undef PG8_LDB
#undef PG8_MMA
#undef PG8_WAIT_V
#undef PG8_WAIT_L
#undef PG8_BAR
#undef PG8_SCHED
}
}

#ifndef PG8_SP2
#define PG8_SP2 true
#endif
#ifndef PG8_ALIGN
#define PG8_ALIGN true
#endif
namespace att {
#define LAS3 __attribute__((address_space(3)))
using bf16x8 = __attribute__((ext_vector_type(8))) short;
using s16x4 = __attribute__((ext_vector_type(4))) short;
using f32x16 = __attribute__((ext_vector_type(16))) float;
using f32x4 = __attribute__((ext_vector_type(4))) float;
using u32x4 = __attribute__((ext_vector_type(4))) unsigned;
typedef unsigned short u16;
typedef LAS3 const unsigned char* lds_cptr;
typedef short v4i16_t __attribute__((ext_vector_type(4)));
constexpr int SEQ = 16384, NW = 8, QBLK = 32, QB = 256, KVBLK = 64;
constexpr int KSLOT = 12288, VSLOT = 8192, NKS = 4, NVS = 4;
constexpr int LDS_K = 0, LDS_V = NKS * KSLOT, LDS_WS = LDS_V + NVS * VSLOT, LDS_OST = LDS_WS + NW * 256, LDS_QX = LDS_OST + NW * 4096, LDS_BYTES = LDS_QX + NW * 2048;
__device__ __forceinline__ int crow(int r, int hi) { return (r & 3) + 8 * (r >> 2) + 4 * hi; }
__device__ __forceinline__ void glds16(const void* gsrc, unsigned lds_dst) { unsigned keep;
    asm volatile("s_mov_b32 %0, m0\n\ts_mov_b32 m0, %2\n\ts_nop 0\n\tglobal_load_lds_dwordx4 %1, off\n\ts_mov_b32 m0, %0" : "=&s"(keep) : "v"(gsrc), "s"(lds_dst) : "memory"); }
typedef float f32x2_t __attribute__((ext_vector_type(2))); typedef __bf16 bf16x2_t __attribute__((ext_vector_type(2)));
__device__ __forceinline__ unsigned cvtpk_s(float lo, float hi) { f32x2_t v = {lo, hi}; bf16x2_t b = __builtin_convertvector(v, bf16x2_t); return __builtin_bit_cast(unsigned, b); }
__device__ __forceinline__ s16x4 vtr(lds_cptr p) { return __builtin_bit_cast(s16x4, __builtin_amdgcn_ds_read_tr16_b64_v4i16((LAS3 v4i16_t*)p)); }
#define ATT_SBAR() __builtin_amdgcn_sched_barrier(0)
#define ATT_WAIT_BAR(N) asm volatile("s_waitcnt vmcnt(" #N ") lgkmcnt(0)\n\ts_barrier" ::: "memory")
struct Src {
    const u16* q; int qp;
    const u16* k; int kp;
    const u16* k2; int k2p;
    const u16* v; int vp;
    u16* o; int op;
};
template <int NDK, int NQR, bool ZC, int XHS, int JLO, int JHI>
__device__ __forceinline__ void phase_a(f32x16& C0, f32x16& C1, const lds_cptr* kb_, int ksl_, const bf16x8* qr, lds_cptr qx_, const f32x16& negm, bf16x8* kf, bf16x8* qx) {
#ifndef ATT_KPF
#define ATT_KPF 4
#endif
    constexpr int KPF = ATT_KPF;
#define ATT_KRD(j) kf[j] = *(const LAS3 bf16x8*)(kb_[(j) >> 1] + ksl_ + ((j) & 1) * (((j) >> 1) < 4 ? 4096 : XHS))
    if (JLO == 0) {
#pragma unroll
        for (int j = 0; j < KPF; ++j) ATT_KRD(j); }
#pragma unroll
    for (int j = JLO; j < JHI; ++j) {
        if (j + KPF < 2 * NDK) ATT_KRD(j + KPF);
        if (NDK > NQR && (j & 1) == 0 && (j >> 1) + 2 >= NQR && (j >> 1) + 2 < NDK) qx[(j >> 1) + 2 - NQR] = *(const LAS3 bf16x8*)(qx_ + ((j >> 1) + 2 - NQR) * 1024);
        ATT_SBAR();
        const f32x16 z = f32x16{}; const bf16x8 qf = ((j >> 1) < NQR) ? qr[(j >> 1) < NQR ? (j >> 1) : 0] : qx[(j >> 1) >= NQR ? (j >> 1) - NQR : 0];
        if (j & 1) C1 = __builtin_amdgcn_mfma_f32_32x32x16_bf16(kf[j], qf, (j < 2) ? (ZC ? z : negm) : C1, 0, 0, 0);
        else       C0 = __builtin_amdgcn_mfma_f32_32x32x16_bf16(kf[j], qf, (j < 2) ? (ZC ? z : negm) : C0, 0, 0, 0);
        ATT_SBAR();
    }
#undef ATT_KRD
}
template <bool QK, bool FIN>
__device__ __forceinline__ void phase_b(f32x16& C0, f32x16& C1, f32x16* o, lds_cptr vp_, u32x4* pw, float& l_reg) {
    s16x4 vlo[8], vhi[8]; float sacc = 0.f, sacd = 0.f;
#define ATT_VRD(i) do { const int vi_ = ((i) >> 1) + 4 * ((i) & 1); vlo[i] = vtr(vp_ + ((vi_ >> 2) * 4096 + (vi_ & 3) * 1024)); vhi[i] = vtr(vp_ + ((vi_ >> 2) * 4096 + (vi_ & 3) * 1024 + 512)); } while (0)
    if (FIN) { ATT_VRD(0); ATT_VRD(1); }
#pragma unroll
    for (int i = 0; i < 8; ++i) {
        if (FIN && i + 2 < 8) ATT_VRD(i + 2);
        ATT_SBAR();
        if (FIN) { const bf16x8 vf = (bf16x8){vlo[i][0], vlo[i][1], vlo[i][2], vlo[i][3], vhi[i][0], vhi[i][1], vhi[i][2], vhi[i][3]};
            o[i & 1] = __builtin_amdgcn_mfma_f32_32x32x16_bf16(__builtin_bit_cast(bf16x8, pw[i >> 1]), vf, o[i & 1], 0, 0, 0); }
        if (QK) { f32x16& X = (i < 4) ? C0 : C1; const int b = 4 * (i & 3);
            X[b] = __builtin_amdgcn_exp2f(X[b]); X[b + 1] = __builtin_amdgcn_exp2f(X[b + 1]); X[b + 2] = __builtin_amdgcn_exp2f(X[b + 2]); X[b + 3] = __builtin_amdgcn_exp2f(X[b + 3]);
            sacc += X[b]; sacd += X[b + 1]; sacc += X[b + 2]; sacd += X[b + 3]; asm volatile("" : "+v"(sacc), "+v"(sacd));
            if (i & 1) { const int k = i >> 1, c = 8 * (k & 1);
                pw[k] = (u32x4){cvtpk_s(X[c], X[c + 1]), cvtpk_s(X[c + 2], X[c + 3]), cvtpk_s(X[c + 4], X[c + 5]), cvtpk_s(X[c + 6], X[c + 7])}; asm volatile("" : "+v"(pw[k])); } }
        ATT_SBAR();
    }
#undef ATT_VRD
    if (QK) l_reg += sacc + sacd;
}
template <bool MLA, bool FIX> __device__ __forceinline__ void attn_unit(int qb, const Src& s, LAS3 unsigned char* shm, const float* bias_h, float kmax2, const float* qmax_h) {
    constexpr int NDK = MLA ? 6 : 5, NX = MLA ? 4 : 1, NQR = MLA ? 4 : 5;
    constexpr float THRL = MLA ? 8.0f : 16.0f;
    const int tid = threadIdx.x, lane = tid & 63, r32 = lane & 31, hi = lane >> 5; const int wid = __builtin_amdgcn_readfirstlane(tid >> 6);
    const int q0 = qb * QB;
    const unsigned lds0 = (unsigned)(uintptr_t)shm;
    LAS3 float* wsf = (LAS3 float*)(shm + LDS_WS) + wid * 64;
    const int NT = (q0 + QB) / KVBLK;
    const int wvis = NT - 4 + (wid >> 1);
    const bool xw = wid < NX;
    const int krow = 8 * wid + (lane >> 3);
    const u16* ksrc = s.k + (size_t)krow * s.kp + (((lane & 7) ^ ((krow >> 1) & 7)) * 8);
    const int k2row = 16 * (wid & 3) + (lane >> 2);
    const u16* k2src = MLA ? s.k2 + (size_t)k2row * s.k2p + (((lane & 3) ^ ((k2row >> 2) & 3)) * 8) : s.k2 + (size_t)lane * s.k2p;
    const u16* vsrc = s.v + (size_t)(16 * (wid & 3) + (lane >> 2)) * s.vp + (wid >> 2) * 32 + (lane & 3) * 8;
    const unsigned kdst = lds0 + LDS_K + wid * 1024, k2dst = lds0 + LDS_K + (8 + (wid & 3)) * 1024, vdst = lds0 + LDS_V + wid * 1024;
#define ATT_DMA_K(t) do { const int sl_ = (t) & 3; glds16(ksrc + (size_t)(t) * KVBLK * s.kp, (unsigned)__builtin_amdgcn_readfirstlane(kdst + sl_ * KSLOT)); \
        if (xw) glds16(k2src + (size_t)(t) * KVBLK * s.k2p, (unsigned)__builtin_amdgcn_readfirstlane(k2dst + sl_ * KSLOT)); } while (0)
#define ATT_DMA_V(t, vsl) glds16(vsrc + (size_t)(t) * KVBLK * s.vp, (unsigned)__builtin_amdgcn_readfirstlane(vdst + (vsl)))
    if (!MLA) {
        if (tid < 256) { const int sl = tid >> 6; *(LAS3 f32x4*)(shm + LDS_K + sl * KSLOT + 9 * 1024 + (tid & 63) * 16) = (f32x4){0.f, 0.f, 0.f, 0.f}; } }
    if (MLA) { ATT_DMA_K(0); ATT_DMA_V(0, 0); ATT_DMA_K(1); ATT_DMA_K(2); }
    const u16* Qw = s.q + (size_t)(q0 + wid * QBLK + r32) * s.qp + hi * 8;
    bf16x8 qr[NQR];
#pragma unroll
    for (int d0 = 0; d0 < 4; ++d0) qr[d0] = *reinterpret_cast<const bf16x8*>(Qw + d0 * 16);
    const lds_cptr qx0 = (lds_cptr)shm + LDS_QX + wid * 2048 + lane * 16;
    float mla_ref = 0.f;
    if (MLA) { const bf16x8 q4 = *reinterpret_cast<const bf16x8*>(Qw + 64), q5 = *reinterpret_cast<const bf16x8*>(Qw + 80);
        *(LAS3 bf16x8*)(shm + LDS_QX + wid * 2048 + lane * 16) = q4; *(LAS3 bf16x8*)(shm + LDS_QX + wid * 2048 + 1024 + lane * 16) = q5;
        if (FIX) { float nq = 0.f;
#pragma unroll
            for (int e = 0; e < 8; ++e) { const float a = __uint_as_float((unsigned)(unsigned short)q4[e] << 16), b = __uint_as_float((unsigned)(unsigned short)q5[e] << 16); nq += a * a + b * b; }
#pragma unroll
            for (int d0 = 0; d0 < 4; ++d0)
#pragma unroll
                for (int e = 0; e < 8; ++e) { const float a = __uint_as_float((unsigned)(unsigned short)qr[d0][e] << 16); nq += a * a; }
            nq += __shfl_xor(nq, 32); mla_ref = sqrtf(nq * kmax2); } }
    const short one = hi ? (short)0 : (short)0x3F80;
    if (!MLA) qr[NQR - 1] = (bf16x8){one, one, one, 0, 0, 0, 0, 0};
    int t0 = 0;
    if (!MLA) {
        const float qm = qmax_h[qb];
        const float bunit = sqrtf(qm * kmax2);
        const float thr = FIX ? bias_h[q0] - 152.f : bias_h[q0] - 170.f - 2.f * bunit;
        if (FIX) { const float nm_ = -(bias_h[q0 + wid * QBLK + r32] + bunit); const unsigned h_ = cvtpk_s(nm_, 0.f) & 0xffffu; const float r1_ = nm_ - __uint_as_float(h_ << 16); const unsigned m_ = cvtpk_s(r1_, 0.f) & 0xffffu;
            const float r2_ = r1_ - __uint_as_float(m_ << 16); const unsigned l_ = cvtpk_s(r2_, 0.f) & 0xffffu;
            if (hi == 0) qr[NQR - 1] = (bf16x8){one, one, one, (short)h_, (short)m_, (short)l_, 0, 0}; }
        int best = 0;
        for (int tt = 1 + lane; tt <= NT - 4; tt += 64) { if (bias_h[64 * tt - 1] < thr) best = tt; }
#pragma unroll
        for (int o_ = 32; o_ >= 1; o_ >>= 1) best = max(best, __shfl_xor(best, o_));
        t0 = __builtin_amdgcn_readfirstlane(best);
    }
    if (!MLA) { ATT_DMA_K(t0); ATT_DMA_V(t0, (t0 & 3) * VSLOT); ATT_DMA_K(t0 + 1); ATT_DMA_K(t0 + 2); }
    float mhat = 0.f, l_reg = 0.f; f32x16 o[2]; o[0] = f32x16{}; o[1] = f32x16{}; f32x16 negm = f32x16{};
    if (MLA && FIX) {
#pragma unroll
        for (int r = 0; r < 16; ++r) negm[r] = -mla_ref; }
    const int qrel = wid * QBLK + r32;
    lds_cptr kb[NDK];
#pragma unroll
    for (int d0 = 0; d0 < 4; ++d0) kb[d0] = (lds_cptr)shm + LDS_K + r32 * 128 + ((((2 * d0 + hi) ^ ((r32 >> 1) & 7))) << 4);
    if (MLA) {
#pragma unroll
        for (int d0 = 4; d0 < NDK; ++d0) kb[d0] = (lds_cptr)shm + LDS_K + 8192 + r32 * 64 + ((((2 * (d0 - 4) + hi) ^ ((r32 >> 2) & 3))) << 4);
    } else kb[NDK - 1] = (lds_cptr)shm + LDS_K + 8192 + hi * 1024 + r32 * 16;
    constexpr int XHS = MLA ? 2048 : 512;
    const lds_cptr vp0 = (lds_cptr)shm + LDS_V + ((lane >> 4) & 1) * 32 + (lane & 3) * 8 + (4 * hi + ((lane & 15) >> 2)) * 64;
    f32x16 C0, C1; u32x4 pw[4]; bool resc = false;
#define ATT_TOP(t) do { if ((t) == t0 || (t) + 2 >= NT) { ATT_WAIT_BAR(0); } else if (xw) { ATT_WAIT_BAR(3); } else { ATT_WAIT_BAR(2); } \
        } while (0)
#define ATT_ISSUE(t) do { if ((t) + 3 < NT) ATT_DMA_K((t) + 3); if ((t) + 1 < NT) ATT_DMA_V((t) + 1, (((t) + 1) & 3) * VSLOT); } while (0)
#ifdef ATT_QKPRIO
#define ATT_PRIO_ON() __builtin_amdgcn_s_setprio(1)
#define ATT_PRIO_OFF() __builtin_amdgcn_s_setprio(0)
#else
#define ATT_PRIO_ON()
#define ATT_PRIO_OFF()
#endif
#define ATT_QK(t) do { bf16x8 kf_[2 * NDK]; bf16x8 qx_[NDK > NQR ? NDK - NQR : 1]; \
        phase_a<NDK, NQR, !MLA, XHS, 0, 4>(C0, C1, ATT_KS(t), qr, qx0, negm, kf_, qx_); ATT_ISSUE(t); ATT_SBAR(); ATT_PRIO_ON(); \
        phase_a<NDK, NQR, !MLA, XHS, 4, 2 * NDK>(C0, C1, ATT_KS(t), qr, qx0, negm, kf_, qx_); ATT_PRIO_OFF(); } while (0)
#define ATT_MASK(C0, C1, t) do { const int kbq_ = 64 * ((t) - (NT - 4)) + 4 * hi; \
        _Pragma("unroll") for (int r = 0; r < 16; ++r) { const int kv_ = kbq_ + (r & 3) + 8 * (r >> 2); if (kv_ > qrel) C0[r] = -INFINITY; if (kv_ + 32 > qrel) C1[r] = -INFINITY; } } while (0)
#define ATT_DECIDE(C0, C1, FIRST) do { if (!FIX) { \
        float a_ = fmaxf(fmaxf(C0[0], C0[1]), C1[0]), b_ = fmaxf(fmaxf(C0[2], C0[3]), C1[1]); a_ = fmaxf(fmaxf(a_, C1[2]), C1[3]); \
        _Pragma("unroll") for (int r = 4; r < 16; r += 4) { a_ = fmaxf(fmaxf(a_, C0[r]), C0[r + 1]); b_ = fmaxf(fmaxf(b_, C0[r + 2]), C0[r + 3]); a_ = fmaxf(fmaxf(a_, C1[r]), C1[r + 1]); b_ = fmaxf(fmaxf(b_, C1[r + 2]), C1[r + 3]); } \
        float rm_ = fmaxf(a_, b_); { auto rr_ = __builtin_amdgcn_permlane32_swap(__float_as_uint(rm_), __float_as_uint(rm_), false, false); rm_ = fmaxf(__uint_as_float(rr_[0]), __uint_as_float(rr_[1])); } \
        resc = false; \
        if ((FIRST) || __any(rm_ > THRL)) { float dl_ = (FIRST) ? rm_ : fmaxf(rm_, 0.f); \
            if (!MLA) { const float nm_ = -(mhat + dl_); const unsigned h_ = cvtpk_s(nm_, 0.f) & 0xffffu; const float r1_ = nm_ - __uint_as_float(h_ << 16); const unsigned m_ = cvtpk_s(r1_, 0.f) & 0xffffu; \
                const float r2_ = r1_ - __uint_as_float(m_ << 16); const unsigned l_ = cvtpk_s(r2_, 0.f) & 0xffffu; \
                const float mn_ = -((__uint_as_float(h_ << 16) + __uint_as_float(m_ << 16)) + __uint_as_float(l_ << 16)); dl_ = mn_ - mhat; mhat = mn_; \
                if (hi == 0) qr[NQR - 1] = (bf16x8){one, one, one, (short)h_, (short)m_, (short)l_, 0, 0}; } \
            else { mhat += dl_; _Pragma("unroll") for (int r = 0; r < 16; ++r) negm[r] = -mhat; } \
            _Pragma("unroll") for (int r = 0; r < 16; ++r) { C0[r] -= dl_; C1[r] -= dl_; } \
            if (!(FIRST)) { const float f_ = __builtin_amdgcn_exp2f(-dl_); l_reg *= f_; if (hi == 0) wsf[r32] = f_; resc = true; } } } } while (0)
#define ATT_RESC() do { if (!FIX && resc) { \
        _Pragma("unroll") for (int i = 0; i < 4; ++i) { const f32x4 fv_ = *(const LAS3 f32x4*)(wsf + 8 * i + 4 * hi); \
            _Pragma("unroll") for (int d = 0; d < 2; ++d) { o[d][4 * i] *= fv_[0]; o[d][4 * i + 1] *= fv_[1]; o[d][4 * i + 2] *= fv_[2]; o[d][4 * i + 3] *= fv_[3]; } } } } while (0)
#define ATT_VS(tt) (vp0 + (((tt)) & 3) * VSLOT)
#define ATT_KS(tt) kb, ((((tt)) & 3) * KSLOT)
#ifndef ATT_STAGGER
#define ATT_STAGGER 0
#endif
    if (!ATT_STAGGER || wid < 4) {
#define ATT_STEP(t, MASKED) do { ATT_TOP(t); \
        ATT_QK(t); \
        if (!MLA && (MASKED)) ATT_MASK(C0, C1, t); \
        ATT_DECIDE(C0, C1, false); ATT_SBAR(); \
        phase_b<true, true>(C0, C1, o, ATT_VS((t) - 1), pw, l_reg); \
        ATT_RESC(); } while (0)
        ATT_TOP(t0);
        ATT_QK(t0);
        if (!MLA && wvis == t0) ATT_MASK(C0, C1, t0);
        ATT_DECIDE(C0, C1, true); ATT_SBAR();
        phase_b<true, false>(C0, C1, o, vp0, pw, l_reg);
        int t = t0 + 1;
        for (; t < wvis; ++t) ATT_STEP(t, false);
        if (t == wvis) { ATT_STEP(t, true); ++t; }
        { ATT_TOP(t); ATT_ISSUE(t); phase_b<false, true>(C0, C1, o, ATT_VS(t - 1), pw, l_reg); ++t; }
        for (; t <= NT + ATT_STAGGER; ++t) { ATT_TOP(t); ATT_ISSUE(t); }
#undef ATT_STEP
    } else {
        ATT_TOP(t0);
        ATT_QK(t0);
        ATT_DECIDE(C0, C1, true); ATT_SBAR();
        ATT_TOP(t0 + 1);
        phase_b<true, false>(C0, C1, o, vp0, pw, l_reg); ATT_SBAR();
        ATT_QK(t0 + 1);
        ATT_DECIDE(C0, C1, false); ATT_SBAR();
        int t = t0 + 2;
#define ATT_STEP2(t, MASKED) do { ATT_TOP(t); \
        phase_b<true, true>(C0, C1, o, ATT_VS((t) - 2), pw, l_reg); \
        ATT_RESC(); ATT_SBAR(); \
        ATT_QK(t); \
        if (!MLA && (MASKED)) ATT_MASK(C0, C1, t); \
        ATT_DECIDE(C0, C1, false); ATT_SBAR(); } while (0)
        for (; t < wvis; ++t) ATT_STEP2(t, false);
        ATT_STEP2(t, true); ++t;
        { ATT_TOP(t); ATT_ISSUE(t); phase_b<true, true>(C0, C1, o, ATT_VS(t - 2), pw, l_reg); ATT_RESC(); ++t; }
        { ATT_TOP(t); ATT_ISSUE(t); phase_b<false, true>(C0, C1, o, ATT_VS(t - 2), pw, l_reg); ++t; }
        for (; t <= NT + ATT_STAGGER; ++t) { ATT_TOP(t); ATT_ISSUE(t); }
#undef ATT_STEP2
    }
    { auto rr = __builtin_amdgcn_permlane32_swap(__float_as_uint(l_reg), __float_as_uint(l_reg), false, false); l_reg = __uint_as_float(rr[0]) + __uint_as_float(rr[1]); }
    if (hi == 0) wsf[32 + r32] = 1.0f / l_reg;
    float rli[16];
#pragma unroll
    for (int i = 0; i < 4; ++i) { const f32x4 fv = *(const LAS3 f32x4*)(wsf + 32 + 8 * i + 4 * hi); rli[4 * i] = fv[0]; rli[4 * i + 1] = fv[1]; rli[4 * i + 2] = fv[2]; rli[4 * i + 3] = fv[3]; }
    u16* Ow = s.o + (size_t)(q0 + wid * QBLK) * s.op;
    { LAS3 u16* stg = (LAS3 u16*)(shm + LDS_OST) + wid * 2048;
#pragma unroll
        for (int r = 0; r < 16; ++r) { const int orow = crow(r, hi);
#pragma unroll
            for (int d0 = 0; d0 < 2; ++d0) stg[orow * 64 + d0 * 32 + r32] = (u16)(cvtpk_s(o[d0][r] * rli[r], 0.f) & 0xffffu); }
        asm volatile("s_waitcnt lgkmcnt(0)" ::: "memory");
#pragma unroll
        for (int i = 0; i < 4; ++i) { const int row = i * 8 + (lane >> 3), ch = lane & 7; const u32x4 v = *(const LAS3 u32x4*)(stg + row * 64 + ch * 8); *(u32x4*)(Ow + (size_t)row * s.op + ch * 8) = v; } }
    asm volatile("s_waitcnt lgkmcnt(0)\n\ts_barrier" ::: "memory");
#undef ATT_DMA_K
#undef ATT_DMA_V
#undef ATT_TOP
#undef ATT_ISSUE
#undef ATT_QK
#undef ATT_MASK
#undef ATT_DECIDE
#undef ATT_RESC
#undef ATT_STEP
}
}

namespace cg = cooperative_groups;
#define LAS __attribute__((address_space(3)))
typedef unsigned short bf16;
typedef unsigned v4u __attribute__((ext_vector_type(4)));
typedef unsigned v2u __attribute__((ext_vector_type(2)));
typedef float f32x4 __attribute__((ext_vector_type(4)));
constexpr int NWAVES = 8;
constexpr int M = 16384, D = 1024, FF = 4096, NIN = 1960, NINP = 2048, QL = 256, KVL = 128, NQU = 768, NKVU = 1024;
constexpr float EPS = 1e-6f;
constexpr float LOG2E = 1.4426950408889634f;
constexpr float C2_FOX = 0.125f * LOG2E, C2_MLA = 0.10206207261596575f * LOG2E;
constexpr size_t MiB = 1u << 20;
constexpr size_t WS_WIN = 1 * MiB, WS_WQ = 5 * MiB, WS_WKV = 5 * MiB + 512 * 1024, WS_WO = 6 * MiB, WS_W1 = 8 * MiB, WS_W2 = 16 * MiB;
constexpr size_t WS_RT = 24 * MiB, WS_LF = 26 * MiB, WS_LC = 26 * MiB + 512 * 1024, WS_SS = 27 * MiB, WS_KR = 28 * MiB, WS_KB = 29 * MiB, WS_SSQ = 31 * MiB, WS_SSKV = 31 * MiB + 512 * 1024, WS_BIASF = 28 * MiB;
constexpr size_t WS_XN = 32 * MiB, WS_H = 64 * MiB, WS_P = 64 * MiB, WS_QM = 128 * MiB, WS_KVM = 152 * MiB, WS_QN = 184 * MiB, WS_O = 192 * MiB, WS_KVN = 224 * MiB, WS_END = 228 * MiB;
constexpr int RING_BYTES = 131072, LDS_BYTES = 147456;
static_assert(att::LDS_BYTES <= LDS_BYTES, "attention scratch fits the LDS allocation");

__device__ __forceinline__ unsigned f2bf(float f) { unsigned u = __builtin_bit_cast(unsigned, f); return (u + 0x7fffu + ((u >> 16) & 1u)) >> 16; }
__device__ __forceinline__ unsigned pk2(float lo, float hi) { return f2bf(lo) | (f2bf(hi) << 16); }
__device__ __forceinline__ float bf2f(unsigned short h) { return __builtin_bit_cast(float, (unsigned)h << 16); }
__device__ __forceinline__ float wave_sum(float v) {
#pragma unroll
    for (int o = 1; o < 64; o <<= 1) v += __shfl_xor(v, o);
    return v;
}
__device__ __forceinline__ int map_row(int mode, int n) {
    if (mode == 1) { const int h = n / 96, d = n % 96; if (d < 64) return n; const int i = d - 64; return h * 96 + (i < 16 ? 64 + 2 * i : 64 + 2 * (i - 16) + 1); }
    if (mode == 2) { const int h = n >> 7, j = n & 127; return j < 64 ? h * 64 + j : 512 + h * 64 + (j - 64); }
    if (mode == 3) { if (n < 1536 || n >= 1960) return n; if (n < 1544) return 1952 + (n - 1536); if (n < 1800) return 1536 + (n - 1544); if (n < 1928) return 1792 + (n - 1800);
        const int i = n - 1928; return 1920 + (i < 16 ? 2 * i : 2 * (i - 16) + 1); }
    return n;
}
__device__ __forceinline__ void p0_transpose_item(const float* W, int K, int N, int nblk, bf16* WT, int mode, const float* gk, LAS float* scr, int item, int lane) {
    const int kb = item / nblk, nb = item % nblk, k0 = 64 * kb, n0 = 32 * nb;
    const int nn = n0 + (lane & 31);
    float wv[32];
#pragma unroll
    for (int i = 0; i < 32; ++i) { const int kk = 2 * i + (lane >> 5); wv[i] = (nn < N) ? W[(size_t)(k0 + kk) * N + nn] : 0.f; }
    if (gk) {
#pragma unroll
        for (int i = 0; i < 32; ++i) wv[i] *= gk[k0 + 2 * i + (lane >> 5)]; }
#pragma unroll
    for (int i = 0; i < 32; ++i) { const int kk = 2 * i + (lane >> 5); scr[kk * 33 + (lane & 31)] = wv[i]; }
    asm volatile("s_waitcnt lgkmcnt(0)" ::: "memory");
    const int c = lane & 7;
#pragma unroll
    for (int j = 0; j < 4; ++j) { const int n = (lane >> 3) + 8 * j; const LAS float* sp = scr + (8 * c) * 33 + n;
        v4u o; o.x = pk2(sp[0 * 33], sp[1 * 33]); o.y = pk2(sp[2 * 33], sp[3 * 33]); o.z = pk2(sp[4 * 33], sp[5 * 33]); o.w = pk2(sp[6 * 33], sp[7 * 33]);
        *(v4u*)(WT + (size_t)map_row(mode, n0 + n) * K + k0 + 8 * c) = o; }
    asm volatile("s_waitcnt lgkmcnt(0)" ::: "memory");
}
__device__ __forceinline__ void sincos_d(double x, float& sn, float& cs) {
    const double k = rint(x * 0.63661977236758134308);
    double r = fma(-k, 1.57079632679489655800e+00, x); r = fma(-k, 6.12323399573676603587e-17, r);
    const double r2 = r * r;
    double s = -1.0 / 6227020800.0; s = s * r2 + 1.0 / 39916800.0; s = s * r2 - 1.0 / 362880.0; s = s * r2 + 1.0 / 5040.0; s = s * r2 - 1.0 / 120.0; s = s * r2 + 1.0 / 6.0; s = r - r * r2 * s;
    double c = 1.0 / 479001600.0; c = c * r2 - 1.0 / 3628800.0; c = c * r2 + 1.0 / 40320.0; c = c * r2 - 1.0 / 720.0; c = c * r2 + 1.0 / 24.0; c = c * r2 - 0.5; c = 1.0 + r2 * c;
    const int q = ((int)k) & 3;
    const double ss = (q == 0) ? s : (q == 1) ? c : (q == 2) ? -s : -c;
    const double cc = (q == 0) ? c : (q == 1) ? -s : (q == 2) ? -c : s;
    sn = (float)ss; cs = (float)cc;
}

#define RLX_AGENT __ATOMIC_RELAXED, __HIP_MEMORY_SCOPE_AGENT
#define XB_TMO      128
#define XB_XCNT(j)  (256  + 64 * (j))
#define XB_XSUB(j)  (1280 + 64 * (j))
#define XB_XGEN(j)  (2304 + 64 * (j))
#define XB_TOP      3328
#define XB_TOPGEN   3392
#define XCD_BAR_WORDS 3456
#define XB_SPIN_CAP (1u << 18)

__device__ __forceinline__ unsigned xb_ld(unsigned* p)              { return __hip_atomic_load(p, __ATOMIC_RELAXED, __HIP_MEMORY_SCOPE_AGENT); }
__device__ __forceinline__ unsigned xb_add(unsigned* p, unsigned v) { return __hip_atomic_fetch_add(p, v, __ATOMIC_RELAXED, __HIP_MEMORY_SCOPE_AGENT); }
__device__ __forceinline__ unsigned xb_xcc_id() { return (unsigned)__builtin_amdgcn_s_getreg((3 << 11) | 20) & 0xFu; }
#define XB_SPIN(cond, bar) do { unsigned _sp = 0; while (cond) { __builtin_amdgcn_s_sleep(1); \
    if ((++_sp & 255u) == 0u) { if (xb_ld(&(bar)[XB_TMO])) break; if (_sp > XB_SPIN_CAP) { atomicAdd(&(bar)[XB_TMO], 1u); break; } } } } while (0)

struct XcdBarrier {
    unsigned* bar; unsigned x;
    volatile LAS unsigned* st;
};

__device__ __forceinline__ XcdBarrier xcd_barrier_post(unsigned* bar, volatile LAS unsigned* st) {
    XcdBarrier b; b.bar = bar; b.x = xb_xcc_id(); b.st = st;
    if (threadIdx.x == 0) (void)xb_add(&bar[XB_XCNT(b.x)], 1u);
    return b;
}
__device__ __forceinline__ void xcd_barrier_complete(unsigned* bar, unsigned x, unsigned& nloc, unsigned& nx) {
    const unsigned G = gridDim.x * gridDim.y * gridDim.z;
    unsigned sum, cnt, mine, sp = 0u;
    for (;;) {
        sum = 0u; cnt = 0u; mine = 0u;
#pragma unroll
        for (unsigned j = 0; j < 16; ++j) { const unsigned c = xb_ld(&bar[XB_XCNT(j)]); sum += c; cnt += (c > 0u) ? 1u : 0u; mine = (j == x) ? c : mine; }
        if (sum == G) break;
        __builtin_amdgcn_s_sleep(1);
        if ((++sp & 255u) == 0u) { if (xb_ld(&bar[XB_TMO])) break; if (sp > XB_SPIN_CAP) { atomicAdd(&bar[XB_TMO], 1u); break; } }
    }
    nloc = mine > 0u ? mine : 1u; nx = cnt > 0u ? cnt : 1u;
}

__device__ __forceinline__ void xcd_barrier(const XcdBarrier& b) {
    asm volatile("s_waitcnt vmcnt(0)" ::: "memory");
    __syncthreads();
    if (threadIdx.x == 0) {
        unsigned* bar = b.bar;
        __builtin_amdgcn_s_waitcnt(0);
        unsigned nloc = b.st[0], nx = b.st[1];
        if (nloc == 0u) { xcd_barrier_complete(bar, b.x, nloc, nx); b.st[0] = nloc; b.st[1] = nx; }
        const unsigned old = xb_add(&bar[XB_XSUB(b.x)], 1u);
        const unsigned gen = old / nloc;
        if (old + 1u == (gen + 1u) * nloc) {
            __builtin_amdgcn_fence(__ATOMIC_RELEASE, "agent");
            asm volatile("s_waitcnt vmcnt(0)" ::: "memory");
            const unsigned og = xb_add(&bar[XB_TOP], 1u);
            const unsigned tg = og / nx;
            if (og + 1u == (tg + 1u) * nx) xb_add(&bar[XB_TOPGEN], 1u);
            else XB_SPIN(xb_ld(&bar[XB_TOPGEN]) == tg, bar);
            __builtin_amdgcn_fence(__ATOMIC_ACQUIRE, "agent");
            xb_add(&bar[XB_XGEN(b.x)], 1u);
            asm volatile("s_waitcnt vmcnt(0)" ::: "memory");
        } else {
            XB_SPIN(xb_ld(&bar[XB_XGEN(b.x)]) == gen, bar);
            __builtin_amdgcn_fence(__ATOMIC_ACQUIRE, "agent");
            asm volatile("s_waitcnt vmcnt(0)" ::: "memory");
        }
    }
    __syncthreads();
}

constexpr int MISC_OFF = LDS_BYTES - 128;
constexpr size_t WS_CTL = 0, CTL_ZERO_BYTES = 64 * 1024;
constexpr int CW_KMAX = 8192, CW_QF = 8192 + 512, CW_QM = 8192 + 1024, CW_PCNT = 8192 + 1536, CW_KMAXM = 13824, CW_QMAXM = 14400, CW_DONE = 14464;
static_assert(att::LDS_BYTES <= MISC_OFF, "LDS map");
struct Args { const float* in[13]; float* out; unsigned char* ws; int ph_lo, ph_hi, dup, pad; };
constexpr int NPHASE = 8;

__global__ void __launch_bounds__(NWAVES * 64, 2) mk_fwd(Args args) {
    extern __shared__ __attribute__((aligned(16))) unsigned char lds_raw[];
    LAS unsigned char* lds = (LAS unsigned char*)lds_raw;
    const int G = gridDim.x, bx = blockIdx.x;
#define MK_IDS int tid = threadIdx.x; asm volatile("" : "+v"(tid)); const int lane = tid & 63, wave = __builtin_amdgcn_readfirstlane(tid >> 6); const int gw = vcu * NWAVES + wave; (void)gw; (void)lane;
    const int vcu = (G % 8 == 0) ? (bx % 8) * (G / 8) + bx / 8 : bx;
    const int NGW = G * NWAVES;
    unsigned char* ws = args.ws;
#define MKP_x ((const float*)args.in[0])
#define MKP_g_mix ((const float*)args.in[1])
#define MKP_w_in ((const float*)args.in[2])
#define MKP_b_f ((const float*)args.in[3])
#define MKP_g_q ((const float*)args.in[4])
#define MKP_w_q_up ((const float*)args.in[5])
#define MKP_g_kv ((const float*)args.in[6])
#define MKP_w_kv_up ((const float*)args.in[7])
#define MKP_w_o ((const float*)args.in[8])
#define MKP_g_mlp ((const float*)args.in[9])
#define MKP_w_ff1 ((const float*)args.in[10])
#define MKP_w_ff2 ((const float*)args.in[11])
#define MKP_g_final ((const float*)args.in[12])
#define MKP_out (args.out)
#define MKP_Win_t ((bf16*)(args.ws + WS_WIN))
#define MKP_Wq_t ((bf16*)(args.ws + WS_WQ))
#define MKP_Wkv_t ((bf16*)(args.ws + WS_WKV))
#define MKP_Wo_t ((bf16*)(args.ws + WS_WO))
#define MKP_W1_t ((bf16*)(args.ws + WS_W1))
#define MKP_W2_t ((bf16*)(args.ws + WS_W2))
#define MKP_RT ((float*)(args.ws + WS_RT))
#define MKP_LF ((float*)(args.ws + WS_LF))
#define MKP_SS ((float*)(args.ws + WS_SS))
#define MKP_SSQ ((float*)(args.ws + WS_SSQ))
#define MKP_BIASF ((float*)(args.ws + WS_BIASF))
#define MKP_QMAX ((float*)(args.ws + WS_LC))
#define MKP_SSKV ((float*)(args.ws + WS_SSKV))
#define MKP_KB ((bf16*)(args.ws + WS_KB))
#define MKP_KR ((bf16*)(args.ws + WS_KR))
#define MKP_XN ((bf16*)(args.ws + WS_XN))
#define MKP_HB ((bf16*)(args.ws + WS_H))
#define MKP_P ((bf16*)(args.ws + WS_P))
#define MKP_QM ((bf16*)(args.ws + WS_QM))
#define MKP_KVM ((bf16*)(args.ws + WS_KVM))
#define MKP_QN ((bf16*)(args.ws + WS_QN))
#define MKP_OB ((bf16*)(args.ws + WS_O))
#define MKP_KVN ((bf16*)(args.ws + WS_KVN))
    const int lo = args.ph_lo, hi = args.ph_hi;
#ifndef MK_MASK
#define MK_MASK 0x1ff
#endif
#define IN(k) (((MK_MASK >> (k)) & 1) && lo <= (k) && (k) < hi)
#define REP(k) for (int rep_ = 0; rep_ < ((args.dup == (k)) ? 2 : 1); ++rep_)
    { volatile LAS unsigned* misc = (volatile LAS unsigned*)(lds + MISC_OFF); if (threadIdx.x < 32) misc[threadIdx.x] = 0u; }
    __syncthreads();
    (void)xcd_barrier_post((unsigned*)(ws + WS_CTL), (volatile LAS unsigned*)(lds + MISC_OFF) + 8);
    if (args.ph_lo < 0) cg::this_grid().sync();
#ifdef TS_PHASE
    unsigned long long ts_a_ = 0, ts_b_ = 0;
#define TS_BEGIN(k) do { if ((k) == TS_PHASE || (TS_PHASE == 99 && (k) == 0)) ts_a_ = __builtin_amdgcn_s_memrealtime(); } while (0)
#define TS_END(k) do { if ((k) == TS_PHASE || (TS_PHASE == 99 && (k) == 7)) ts_b_ = __builtin_amdgcn_s_memrealtime(); } while (0)
#else
#define TS_BEGIN(k)
#define TS_END(k)
#endif
#define SEAM(k) do { if (IN(k) && IN((k) + 1)) { XcdBarrier b_; b_.bar = (unsigned*)(args.ws + WS_CTL); b_.x = xb_xcc_id(); b_.st = (volatile LAS unsigned*)(lds + MISC_OFF) + 8; xcd_barrier(b_); } } while (0)

    TS_BEGIN(0);
    if (IN(0)) { MK_IDS
        LAS float* scr = (LAS float*)(lds + wave * 16384);
        constexpr int I_IN = (D / 64) * (NINP / 32), I_Q = (QL / 64) * (NQU / 32), I_KV = (KVL / 64) * (NKVU / 32), I_O = (D / 64) * (D / 32), I_1 = (D / 64) * (FF / 32), I_2 = (FF / 64) * (D / 32);
        constexpr int NITEMS = I_IN + I_Q + I_KV;
        (void)I_O; (void)I_1; (void)I_2;
        for (int it = gw; it < NITEMS; it += NGW) {
            int r = it;
            if (r < I_IN) { p0_transpose_item(MKP_w_in, D, NIN, NINP / 32, MKP_Win_t, 3, nullptr, scr, r, lane); continue; } r -= I_IN;
            if (r < I_Q) { p0_transpose_item(MKP_w_q_up, QL, NQU, NQU / 32, MKP_Wq_t, 1, MKP_g_q, scr, r, lane); continue; } r -= I_Q;
            p0_transpose_item(MKP_w_kv_up, KVL, NKVU, NKVU / 32, MKP_Wkv_t, 2, MKP_g_kv, scr, r, lane);
        }
        for (int m0 = gw; m0 < M; m0 += 4 * NGW) {
            const f32x4* gr = (const f32x4*)MKP_g_mix + lane; f32x4 v[4][4]; float s2[4];
#pragma unroll
            for (int r = 0; r < 4; ++r) { const int m = m0 + r * NGW; const f32x4* xr = (const f32x4*)(MKP_x + (size_t)(m < M ? m : 0) * D) + lane;
#pragma unroll
                for (int j = 0; j < 4; ++j) v[r][j] = xr[64 * j]; }
#pragma unroll
            for (int r = 0; r < 4; ++r) { s2[r] = 0.f;
#pragma unroll
                for (int j = 0; j < 4; ++j) s2[r] += (v[r][j].x * v[r][j].x + v[r][j].y * v[r][j].y) + (v[r][j].z * v[r][j].z + v[r][j].w * v[r][j].w);
                s2[r] = 1.f / sqrtf(wave_sum(s2[r]) * (1.f / D) + EPS); }
#pragma unroll
            for (int r = 0; r < 4; ++r) { const int m = m0 + r * NGW; if (m < M) { unsigned long long* o8 = (unsigned long long*)(MKP_XN + (size_t)m * D) + lane; const float rstd = s2[r];
#pragma unroll
                for (int j = 0; j < 4; ++j) { const f32x4 g = gr[64 * j]; o8[64 * j] = (unsigned long long)pk2(v[r][j].x * rstd * g.x, v[r][j].y * rstd * g.y) | ((unsigned long long)pk2(v[r][j].z * rstd * g.z, v[r][j].w * rstd * g.w) << 32); } } }
        }
        for (int e = (vcu * NWAVES * 64 + tid); e < M * 16; e += G * NWAVES * 64) {
            const int m = e >> 4, i = e & 15; double inv = 1.0; for (int j = 0; j < i; ++j) inv *= 0.56234132519034908039;
            float sn, cs; sincos_d((double)m * inv, sn, cs); MKP_RT[2 * e] = cs; MKP_RT[2 * e + 1] = sn;
        }
    }
    SEAM(0);
    TS_END(0);
    TS_BEGIN(1);
    if (IN(1)) {
        pg8::Gemm g{MKP_XN, MKP_Win_t, M, NINP, D}; pg8::StaticOrder S; S.init(M, NINP, G, bx);
        pg8::EpiIn E{MKP_P, NINP, C2_FOX, MKP_SSQ, MKP_SSKV, MKP_RT, MKP_b_f, MKP_LF, M};
        pg8::gemm_phase<pg8::EpiIn, pg8::StaticOrder, PG8_ALIGN, PG8_SP2>(lds, g, S, E);
    }
    SEAM(1);
    TS_END(1);
    TS_BEGIN(3);
    if (IN(3)) { MK_IDS
        if (wave >= 2) {
            LAS float* scr = (LAS float*)(lds + wave * 16384);
            constexpr int J_O = (D / 64) * (D / 32), J_1 = (D / 64) * (FF / 32), J_2 = (FF / 64) * (D / 32);
            for (int it = vcu * 6 + (wave - 2); it < J_O + J_1 + J_2; it += G * 6) {
                int r = it;
                if (r < J_O) { p0_transpose_item(MKP_w_o, D, D, D / 32, MKP_Wo_t, 0, nullptr, scr, r, lane); continue; } r -= J_O;
                if (r < J_1) { p0_transpose_item(MKP_w_ff1, D, FF, FF / 32, MKP_W1_t, 0, MKP_g_mlp, scr, r, lane); continue; } r -= J_1;
                p0_transpose_item(MKP_w_ff2, FF, D, D / 32, MKP_W2_t, 0, nullptr, scr, r, lane);
            }
        }
        if (wave < 2) { const int job = bx + 256 * wave;
            if (job < 512 && bx < 256) { const int h = job >> 6, ti = job & 63; const f32x4* lf4 = (const f32x4*)(MKP_LF + (size_t)h * M);
                float pre = 0.f; { int j = 0; float pa[8] = {0.f, 0.f, 0.f, 0.f, 0.f, 0.f, 0.f, 0.f};
                    for (; j + 8 <= ti; j += 8) { f32x4 w[8];
#pragma unroll
                        for (int u = 0; u < 8; ++u) w[u] = lf4[(j + u) * 64 + lane];
#pragma unroll
                        for (int u = 0; u < 8; ++u) pa[u] += (w[u].x + w[u].y) + (w[u].z + w[u].w); }
                    for (; j < ti; ++j) { const f32x4 w = lf4[j * 64 + lane]; pa[0] += (w.x + w.y) + (w.z + w.w); }
                    pre = ((pa[0] + pa[1]) + (pa[2] + pa[3])) + ((pa[4] + pa[5]) + (pa[6] + pa[7])); }
                pre = wave_sum(pre);
                const f32x4 v = lf4[ti * 64 + lane];
                const float s1 = v.x, s2 = s1 + v.y, s3 = s2 + v.z, s4 = s3 + v.w; float inc = s4;
#pragma unroll
                for (int o = 1; o < 64; o <<= 1) { const float n = __shfl_up(inc, o); if (lane >= o) inc += n; }
                const float ex = pre + (inc - s4); const float cs[4] = {ex + s1, ex + s2, ex + s3, ex + s4};
                *(f32x4*)(MKP_BIASF + (size_t)h * M + ti * 256 + 4 * lane) = (f32x4){-cs[0] * LOG2E, -cs[1] * LOG2E, -cs[2] * LOG2E, -cs[3] * LOG2E};
                { float km = 0.f;
                  float qmx = 0.f;
                  for (int e = 0; e < 4; ++e) { const v4u* kr = (const v4u*)(MKP_P + (size_t)(ti * 256 + 4 * lane + e) * NINP + 512 + h * 64); float a2 = 0.f; const v4u* qrw = kr - 64; float q2 = 0.f;
#pragma unroll
                      for (int c8 = 0; c8 < 8; ++c8) { const v4u w = qrw[c8]; const unsigned ww[4] = {w.x, w.y, w.z, w.w};
#pragma unroll
                          for (int q4 = 0; q4 < 4; ++q4) { const float lo_ = __builtin_bit_cast(float, ww[q4] << 16), hi_ = __builtin_bit_cast(float, ww[q4] & 0xffff0000u); q2 += lo_ * lo_ + hi_ * hi_; } }
                      qmx = fmaxf(qmx, q2);
#pragma unroll
                      for (int c8 = 0; c8 < 8; ++c8) { const v4u w = kr[c8]; const unsigned ww[4] = {w.x, w.y, w.z, w.w};
#pragma unroll
                          for (int q4 = 0; q4 < 4; ++q4) { const float lo_ = __builtin_bit_cast(float, ww[q4] << 16), hi_ = __builtin_bit_cast(float, ww[q4] & 0xffff0000u); a2 += lo_ * lo_ + hi_ * hi_; } }
                      km = fmaxf(km, a2); }
#pragma unroll
                  for (int o = 32; o >= 1; o >>= 1) km = fmaxf(km, __shfl_xor(km, o));
#pragma unroll
                  for (int o = 32; o >= 1; o >>= 1) qmx = fmaxf(qmx, __shfl_xor(qmx, o));
                  if (lane == 0) { atomicMax((unsigned*)(args.ws + WS_CTL) + CW_KMAX + 64 * h, __builtin_bit_cast(unsigned, km)); MKP_QMAX[h * 64 + ti] = qmx; } }
#pragma unroll
                for (int e = 0; e < 4; ++e) { const float b = -cs[e] * LOG2E; const unsigned bh = f2bf(b); const float r1 = b - __builtin_bit_cast(float, bh << 16); const unsigned bm = f2bf(r1);
                    const float r2 = r1 - __builtin_bit_cast(float, bm << 16); const unsigned bl = f2bf(r2);
                    *(v4u*)(MKP_KB + ((size_t)h * M + ti * 256 + 4 * lane + e) * 8) = (v4u){bh | (bm << 16), bl | 0x3F800000u, 0x3F803F80u, 0u}; } } }
        __syncthreads();
        { int kq = QL; asm volatile("" : "+s"(kq)); pg8::Gemm g{MKP_P + 1536, MKP_Wq_t, M, NQU, kq, NINP}; pg8::StaticOrder S; S.init(M, NQU, G, bx);
          pg8::EpiQm E{MKP_QM, NQU, MKP_RT, C2_MLA, MKP_SSQ, EPS};
          pg8::gemm_phase<pg8::EpiQm, pg8::StaticOrder, PG8_ALIGN, PG8_SP2>(lds, g, S, E); }
        { int kkv = KVL; asm volatile("" : "+s"(kkv)); pg8::Gemm g{MKP_P + 1792, MKP_Wkv_t, M, NKVU, kkv, NINP}; pg8::StaticOrder S; S.init(M, NKVU, G, bx);
          pg8::EpiKv E{MKP_KVM, NKVU, MKP_SSKV, EPS};
          pg8::gemm_phase<pg8::EpiKv, pg8::StaticOrder, PG8_ALIGN, PG8_SP2>(lds, g, S, E); }
    }
    SEAM(3);
    TS_END(3);
    TS_BEGIN(4);
    if (IN(4)) {
        const int v = (G == 256) ? vcu : bx; const int h0 = (v >> 5) & 7;
        volatile LAS unsigned* misc = (volatile LAS unsigned*)(lds + MISC_OFF);
        unsigned* ctlw = (unsigned*)(args.ws + WS_CTL);
        { const int tid_ = threadIdx.x, lane_ = tid_ & 63, tok = bx * 64 + (tid_ >> 3), hh = tid_ & 7; float k2 = 0.f, q2 = 0.f;
          if (bx < 256) {
            const v4u* kp = (const v4u*)(MKP_KVM + (size_t)tok * NKVU + hh * 64); const v4u* rp = (const v4u*)(MKP_P + (size_t)tok * NINP + 1920); const v4u* qp = (const v4u*)(MKP_QM + (size_t)tok * NQU + hh * 96);
#define MK_SQ(w_, acc_) do { const unsigned ww_[4] = {w_.x, w_.y, w_.z, w_.w}; _Pragma("unroll") for (int q4_ = 0; q4_ < 4; ++q4_) { const float lo_ = __builtin_bit_cast(float, ww_[q4_] << 16), hi_ = __builtin_bit_cast(float, ww_[q4_] & 0xffff0000u); acc_ += lo_ * lo_ + hi_ * hi_; } } while (0)
#pragma unroll
            for (int c8 = 0; c8 < 8; ++c8) { const v4u w = kp[c8]; MK_SQ(w, k2); }
#pragma unroll
            for (int c8 = 0; c8 < 4; ++c8) { const v4u w = rp[c8]; MK_SQ(w, k2); }
#pragma unroll
            for (int c8 = 0; c8 < 12; ++c8) { const v4u w = qp[c8]; MK_SQ(w, q2); }
#undef MK_SQ
          }
#pragma unroll
          for (int o = 8; o <= 32; o <<= 1) { k2 = fmaxf(k2, __shfl_xor(k2, o)); q2 = fmaxf(q2, __shfl_xor(q2, o)); }
          if (lane_ < 8) { atomicMax(ctlw + CW_KMAXM + 64 * lane_, __builtin_bit_cast(unsigned, k2)); atomicMax(ctlw + CW_QMAXM, __builtin_bit_cast(unsigned, q2)); }
          asm volatile("s_waitcnt vmcnt(0)" ::: "memory"); __syncthreads();
          if (tid_ == 0) { __hip_atomic_fetch_add(ctlw + CW_DONE, 1u, __ATOMIC_RELAXED, __HIP_MEMORY_SCOPE_AGENT); unsigned sp = 0;
              while (__hip_atomic_load(ctlw + CW_DONE, __ATOMIC_RELAXED, __HIP_MEMORY_SCOPE_AGENT) < (unsigned)G) { __builtin_amdgcn_s_sleep(2); if (++sp > (1u << 22)) break; } }
          __syncthreads(); }
        bool okfix = true;
        { const float qmM = __builtin_bit_cast(float, __hip_atomic_load(ctlw + CW_QMAXM, __ATOMIC_RELAXED, __HIP_MEMORY_SCOPE_AGENT)); const int lane_ = threadIdx.x & 63;
          for (int h = 0; h < 8; ++h) { const float kF = __builtin_bit_cast(float, __hip_atomic_load(ctlw + CW_KMAX + 64 * h, __ATOMIC_RELAXED, __HIP_MEMORY_SCOPE_AGENT));
              const float kM = __builtin_bit_cast(float, __hip_atomic_load(ctlw + CW_KMAXM + 64 * h, __ATOMIC_RELAXED, __HIP_MEMORY_SCOPE_AGENT));
              float qF = MKP_QMAX[h * 64 + lane_];
#pragma unroll
              for (int o = 32; o >= 1; o >>= 1) qF = fmaxf(qF, __shfl_xor(qF, o));
              okfix = okfix && (qF * kF < 2025.f) && (qmM * kM < 2025.f); }
          okfix = __builtin_amdgcn_readfirstlane(okfix ? 1 : 0) != 0; }
#define MK_ATT_LOOPS(FIXV) do { \
        for (int rep = 0; rep < PROBE_FOX; ++rep) \
        for (int k = 0; k < 8; ++k) { const int h = (h0 + k) & 7; \
            const float kmax2 = __builtin_bit_cast(float, __hip_atomic_load(ctlw + CW_KMAX + 64 * h, __ATOMIC_RELAXED, __HIP_MEMORY_SCOPE_AGENT)); \
            att::Src s{MKP_P + h * 64, NINP, MKP_P + 512 + h * 64, NINP, MKP_KB + (size_t)h * M * 8, 8, MKP_P + 1024 + h * 64, NINP, MKP_OB + h * 64, D}; \
            for (;;) { \
                if (threadIdx.x == 0) misc[0] = __hip_atomic_fetch_add(ctlw + CW_QF + 64 * h + 16 * rep, 1u, __ATOMIC_RELAXED, __HIP_MEMORY_SCOPE_AGENT); \
                __syncthreads(); const unsigned i = misc[0]; __syncthreads(); \
                if (i >= 64u) break; \
                att::attn_unit<false, FIXV>(63 - (int)i, s, lds, MKP_BIASF + (size_t)h * M, kmax2, MKP_QMAX + h * 64); \
            } } \
        asm volatile("" ::: "memory"); \
        for (int rep = 0; rep < PROBE_MLA; ++rep) \
        for (int k = 0; k < 8; ++k) { const int h = (h0 + k) & 7; \
            const float kmaxm = __builtin_bit_cast(float, __hip_atomic_load(ctlw + CW_KMAXM + 64 * h, __ATOMIC_RELAXED, __HIP_MEMORY_SCOPE_AGENT)); \
            att::Src s{MKP_QM + h * 96, NQU, MKP_KVM + h * 64, NKVU, MKP_P + 1920, NINP, MKP_KVM + 512 + h * 64, NKVU, MKP_OB + 512 + h * 64, D}; \
            for (;;) { \
                if (threadIdx.x == 0) misc[0] = __hip_atomic_fetch_add(ctlw + CW_QM + 64 * h + 16 * rep, 1u, __ATOMIC_RELAXED, __HIP_MEMORY_SCOPE_AGENT); \
                __syncthreads(); const unsigned i = misc[0]; __syncthreads(); \
                if (i >= 64u) break; \
                att::attn_unit<true, FIXV>(63 - (int)i, s, lds, nullptr, kmaxm, nullptr); \
            } } } while (0)
#ifndef PROBE_FOX
#define PROBE_FOX 1
#endif
#ifndef PROBE_MLA
#define PROBE_MLA 1
#endif
        if (okfix) MK_ATT_LOOPS(true); else MK_ATT_LOOPS(false);
#undef MK_ATT_LOOPS
    }
#ifdef ATT_PRIO
    __builtin_amdgcn_s_setprio(0);
#endif
    SEAM(4);
    TS_END(4);
    TS_BEGIN(5);
    if (IN(5)) {
        pg8::Gemm g{MKP_OB, MKP_Wo_t, M, D, D}; pg8::StaticOrder S; S.init(M, D, G, bx);
        pg8::EpiRes E{MKP_x, MKP_out, D, MKP_XN, MKP_SS};
        pg8::gemm_phase<pg8::EpiRes, pg8::StaticOrder, PG8_ALIGN, PG8_SP2>(lds, g, S, E);
    }
    SEAM(5);
    TS_END(5);
    TS_BEGIN(6);
    if (IN(6)) {
        pg8::Gemm g{MKP_XN, MKP_W1_t, M, FF, D}; pg8::StaticOrder S; S.init(M, FF, G, bx);
        pg8::EpiSqRelu E{MKP_HB, FF, MKP_SS, EPS, 1.f / D};
        pg8::gemm_phase<pg8::EpiSqRelu, pg8::StaticOrder, PG8_ALIGN, PG8_SP2>(lds, g, S, E);
    }
    SEAM(6);
    TS_END(6);
    TS_BEGIN(7);
    if (IN(7)) {
        pg8::Gemm g{MKP_HB, MKP_W2_t, M, D, FF}; pg8::StaticOrder S; S.init(M, D, G, bx);
        pg8::EpiResNorm E{MKP_out, MKP_out, D, MKP_g_final, MKP_SSQ, (unsigned*)(args.ws + WS_CTL) + CW_PCNT, EPS, 1.f / D};
        pg8::gemm_phase<pg8::EpiResNorm, pg8::StaticOrder, false, PG8_SP2>(lds, g, S, E);
    }
#ifdef TS_PHASE
    { XcdBarrier b_; b_.bar = (unsigned*)(args.ws + WS_CTL); b_.x = xb_xcc_id(); b_.st = (volatile LAS unsigned*)(lds + MISC_OFF) + 8; xcd_barrier(b_); }
    TS_END(7);
    if (blockIdx.x == 0 && threadIdx.x == 0) MKP_out[0] = (float)(((ts_b_ - ts_a_) / TS_Q) * (TS_Q / 100ull));
#endif
#undef IN
#undef SEAM
#undef MKP_x
#undef MKP_g_mix
#undef MKP_w_in
#undef MKP_b_f
#undef MKP_g_q
#undef MKP_w_q_up
#undef MKP_g_kv
#undef MKP_w_kv_up
#undef MKP_w_o
#undef MKP_g_mlp
#undef MKP_w_ff1
#undef MKP_w_ff2
#undef MKP_g_final
#undef MKP_out
#undef MKP_Win_t
#undef MKP_Wq_t
#undef MKP_Wkv_t
#undef MKP_Wo_t
#undef MKP_W1_t
#undef MKP_W2_t
#undef MKP_RT
#undef MKP_LF
#undef MKP_SS
#undef MKP_SSQ
#undef MKP_BIASF
#undef MKP_QMAX
#undef MKP_SSKV
#undef MKP_KB
#undef MKP_KR
#undef MKP_XN
#undef MKP_HB
#undef MKP_P
#undef MKP_QM
#undef MKP_KVM
#undef MKP_QN
#undef MKP_OB
#undef MKP_KVN
}

#ifndef MK_ONE_LAUNCH
#define MK_ONE_LAUNCH 1
#endif
extern "C" void kernel_launch(void* const* d_in, const int* in_sizes, int n_in, void* d_out, int out_size, void* d_ws, size_t ws_size, hipStream_t stream) {
    static int ready = 0;
    if (ready == 0) {
        if (n_in != 13 || in_sizes[0] != M * D || out_size != M * D || ws_size < WS_END) { fprintf(stderr, "kernel_launch: unexpected shapes (n_in %d, in0 %d, out %d, ws %zu)\n", n_in, n_in > 0 ? in_sizes[0] : -1, out_size, ws_size); ready = -1; return; }
        if (hipFuncSetAttribute((const void*)mk_fwd, hipFuncAttributeMaxDynamicSharedMemorySize, LDS_BYTES) != hipSuccess) { fprintf(stderr, "kernel_launch: hipFuncSetAttribute failed\n"); ready = -1; return; }
        ready = 1;
    }
    if (ready < 0) return;
    if (hipMemsetAsync((char*)d_ws + WS_CTL, 0, CTL_ZERO_BYTES, stream) != hipSuccess) { fprintf(stderr, "kernel_launch: hipMemsetAsync failed\n"); return; }
    Args a{};
    for (int i = 0; i < 13; ++i) a.in[i] = (const float*)d_in[i];
    a.out = (float*)d_out; a.ws = (unsigned char*)d_ws;
#ifndef MK_DUP
#define MK_DUP -1
#endif
    a.dup = MK_DUP;
    const int grid = 256;
#if MK_ONE_LAUNCH
    a.ph_lo = 0; a.ph_hi = NPHASE;
    void* kargs[] = {&a};
    hipError_t e = hipLaunchCooperativeKernel((const void*)mk_fwd, dim3(grid), dim3(NWAVES * 64), kargs, LDS_BYTES, stream);
    if (e != hipSuccess) fprintf(stderr, "kernel_launch: cooperative launch failed: %s\n", hipGetErrorString(e));
#else
    for (int p = 0; p < NPHASE; ++p) { a.ph_lo = p; a.ph_hi = p + 1; hipLaunchKernelGGL(mk_fwd, dim3(grid), dim3(NWAVES * 64), LDS_BYTES, stream, a); }
#endif
}
```

```cpp
#include <hip/hip_runtime.h>
#include <hip/hip_cooperative_groups.h>
#define ATT_STAGGER 1
#include <hip/hip_bf16.h>
#include <cstdio>
#include <cstdint>
#include <cmath>
namespace pg8 {
#define PG8_LAS __attribute__((address_space(3)))
typedef unsigned short bf16_t;
typedef short bf16x8 __attribute__((ext_vector_type(8)));
typedef float f32x4 __attribute__((ext_vector_type(4)));
typedef unsigned u32x4 __attribute__((ext_vector_type(4)));
constexpr int BM = 256, BK = 64, HALF = 128, HTB = HALF * BK * 2  , STAGE_BYTES = 8 * HTB, NXCD = 8, WGM = 8;

__host__ __device__ __forceinline__ int lds_byte(int r, int c) { const int st = (r >> 4) * 2 + (c >> 5), rr = r & 15, cc = c & 31, ob = rr * 64 + cc * 2; return st * 1024 + (ob ^ (((ob >> 9) & 1) << 5)); }
__host__ __device__ __forceinline__ void stage_rc(int b, int& R, int& C) { const int st = b / 1024, sb = b % 1024, swz = sb ^ (((sb >> 9) & 1) << 5); R = (st >> 1) * 16 + swz / 64; C = (st & 1) * 32 + (swz % 64) / 2; }
__host__ __device__ __forceinline__ int perm32(int rho) { const int n = rho >> 4, i = rho & 15; return 8 * (i >> 2) + 4 * n + (i & 3); }

struct Unit { int pm, pn; };
struct Gemm { const bf16_t* A; const bf16_t* Bt; int M, N, K; int lda; };

struct StaticOrder {
    int nM, nN, nwg, G, c;
    __host__ __device__ void init(int M, int N, int G_, int c_) { nM = M / BM; nN = N / BM; nwg = nM * nN; G = G_; c = c_; }
    __host__ __device__ bool next(int i, Unit& u) const {
        const long L = (long)i * G + c; if (L >= nwg) return false;
        int wgid = (int)L; { const int q = nwg / NXCD, r = nwg % NXCD, xcd = wgid % NXCD, off = wgid / NXCD; wgid = (xcd < r ? xcd * (q + 1) : r * (q + 1) + (xcd - r) * q) + off; }
        const int nig = WGM * nN, gid = wgid / nig, fm = gid * WGM, gsz = (nM - fm) < WGM ? (nM - fm) : WGM;
        u.pm = fm + ((wgid % nig) % gsz); u.pn = (wgid % nig) / gsz; return true;
    }
    __device__ __forceinline__ void a_ready(const Unit&) const {}
    __device__ __forceinline__ void done(const Unit&) const {}
};

__device__ __forceinline__ unsigned cvt_pk_bf16(float lo, float hi) { unsigned r; asm volatile("v_cvt_pk_bf16_f32 %0, %1, %2" : "=v"(r) : "v"(lo), "v"(hi)); return r; }
typedef float f32x2 __attribute__((ext_vector_type(2)));
__device__ __forceinline__ f32x2 gelu_pk(f32x2 v) {
    const f32x2 av = __builtin_elementwise_abs(v), d = av * 0.2316418882f + 1.0f;
    f32x2 t; t.x = __builtin_amdgcn_rcpf(d.x); t.y = __builtin_amdgcn_rcpf(d.y);
    f32x2 q = t * 0.5307027145f + (-0.7265760135f); q = q * t + 0.7107068705f; q = q * t + (-0.142248368f); q = q * t + 0.127414796f; q = q * t;
    const f32x2 s = (v * v) * (-0.72134752044f);
    f32x2 e; e.x = __builtin_amdgcn_exp2f(s.x); e.y = __builtin_amdgcn_exp2f(s.y);
    const f32x2 m = v * (q * e), r = v - m;
    f32x2 o; o.x = v.x < 0.f ? m.x : r.x; o.y = v.y < 0.f ? m.y : r.y; return o;
}

template <int ACT  > struct EpiBf16 {
    static constexpr bool PERM = true, AFTER_DRAIN = false; static_assert(ACT == 0 || ACT == 1, "EpiBf16: ACT is 0 (none) or 1 (gelu_pk)");
    bf16_t* O; int ldc; const float* bias; int split_cols; size_t split_stride; float scale0;
    __device__ __forceinline__ void operator()(const f32x4 (&acc)[2][2][4][2], const Unit& u, int wr, int wc, int fr, int fq) const {
        const int row0 = u.pm * BM + wr * 64 + fr; int colt = u.pn * BM; bf16_t* base = O;
        float sc = 1.f; if (split_cols) { const int t = colt / split_cols; base += (size_t)t * split_stride; colt -= t * split_cols; if (t == 0) sc = scale0; }
        const int col0 = colt + wc * 32 + 8 * fq, bcol0 = u.pn * BM + wc * 32 + 8 * fq;
        f32x4 bv[2][2];
#pragma unroll
        for (int bj = 0; bj < 2; ++bj)
#pragma unroll
            for (int n = 0; n < 2; ++n) bv[bj][n] = bias ? *(const f32x4*)(bias + bcol0 + bj * HALF + 4 * n) : (f32x4){0.f, 0.f, 0.f, 0.f};
#pragma unroll
        for (int ai = 0; ai < 2; ++ai)
#pragma unroll
            for (int m = 0; m < 4; ++m) { bf16_t* rowp = base + (size_t)(row0 + ai * HALF + m * 16) * ldc + col0;
#pragma unroll
                for (int bj = 0; bj < 2; ++bj) { f32x4 v0 = acc[ai][bj][m][0] + bv[bj][0], v1 = acc[ai][bj][m][1] + bv[bj][1];
                    if (ACT == 1) { f32x2 a = gelu_pk((f32x2){v0[0], v0[1]}), b = gelu_pk((f32x2){v0[2], v0[3]}), c = gelu_pk((f32x2){v1[0], v1[1]}), d = gelu_pk((f32x2){v1[2], v1[3]});
                        v0 = (f32x4){a.x, a.y, b.x, b.y}; v1 = (f32x4){c.x, c.y, d.x, d.y}; }
                    v0 = v0 * sc; v1 = v1 * sc; u32x4 w; w.x = cvt_pk_bf16(v0[0], v0[1]); w.y = cvt_pk_bf16(v0[2], v0[3]); w.z = cvt_pk_bf16(v1[0], v1[1]); w.w = cvt_pk_bf16(v1[2], v1[3]);
                    *(u32x4*)(rowp + bj * HALF) = w; } }
    }
};

struct EpiQm {
    static constexpr bool PERM = true, AFTER_DRAIN = false;
    bf16_t* O; int ldc; const float* rt; float scale; const float* ssq; float eps;
    __device__ __forceinline__ void operator()(const f32x4 (&acc)[2][2][4][2], const Unit& u, int wr, int wc, int fr, int fq) const {
        const int row0 = u.pm * BM + wr * 64 + fr, col0 = u.pn * BM + wc * 32 + 8 * fq;
#pragma unroll
        for (int ai = 0; ai < 2; ++ai)
#pragma unroll
            for (int m = 0; m < 4; ++m) { const int row = row0 + ai * HALF + m * 16;
                const f32x4 sq = *(const f32x4*)(ssq + (size_t)row * 4); const float rs = scale / sqrtf(((sq[0] + sq[1]) + (sq[2] + sq[3])) * (1.0f / 256.0f) + eps);
#pragma unroll
                for (int bj = 0; bj < 2; ++bj) { const int c = col0 + bj * HALF, d = c % 96;
                    f32x4 v0 = acc[ai][bj][m][0], v1 = acc[ai][bj][m][1];
                    if (d >= 64) { const f32x4* t = (const f32x4*)(rt + (size_t)row * 32 + (d - 64)); const f32x4 t0 = t[0], t1 = t[1];
                        f32x4 w0, w1;
                        w0[0] = v0[0] * t0[0] - v0[1] * t0[1]; w0[1] = v0[1] * t0[0] + v0[0] * t0[1];
                        w0[2] = v0[2] * t0[2] - v0[3] * t0[3]; w0[3] = v0[3] * t0[2] + v0[2] * t0[3];
                        w1[0] = v1[0] * t1[0] - v1[1] * t1[1]; w1[1] = v1[1] * t1[0] + v1[0] * t1[1];
                        w1[2] = v1[2] * t1[2] - v1[3] * t1[3]; w1[3] = v1[3] * t1[2] + v1[2] * t1[3];
                        v0 = w0; v1 = w1; }
                    v0 = v0 * rs; v1 = v1 * rs; u32x4 w; w.x = cvt_pk_bf16(v0[0], v0[1]); w.y = cvt_pk_bf16(v0[2], v0[3]); w.z = cvt_pk_bf16(v1[0], v1[1]); w.w = cvt_pk_bf16(v1[2], v1[3]);
                    *(u32x4*)(O + (size_t)row * ldc + c) = w; }
                asm volatile("" ::: "memory"); }
    }
};

struct EpiKv {
    static constexpr bool PERM = true, AFTER_DRAIN = false;
    bf16_t* O; int ldc; const float* ssq; float eps;
    __device__ __forceinline__ void operator()(const f32x4 (&acc)[2][2][4][2], const Unit& u, int wr, int wc, int fr, int fq) const {
        const int row0 = u.pm * BM + wr * 64 + fr, col0 = u.pn * BM + wc * 32 + 8 * fq;
#pragma unroll
        for (int ai = 0; ai < 2; ++ai)
#pragma unroll
            for (int m = 0; m < 4; ++m) { const int row = row0 + ai * HALF + m * 16;
                const f32x4 sq = *(const f32x4*)(ssq + (size_t)row * 4); const float rs = 1.0f / sqrtf(((sq[0] + sq[1]) + (sq[2] + sq[3])) * (1.0f / 128.0f) + eps);
#pragma unroll
                for (int bj = 0; bj < 2; ++bj) { const f32x4 v0 = acc[ai][bj][m][0] * rs, v1 = acc[ai][bj][m][1] * rs;
                    u32x4 w; w.x = cvt_pk_bf16(v0[0], v0[1]); w.y = cvt_pk_bf16(v0[2], v0[3]); w.z = cvt_pk_bf16(v1[0], v1[1]); w.w = cvt_pk_bf16(v1[2], v1[3]);
                    *(u32x4*)(O + (size_t)row * ldc + col0 + bj * HALF) = w; }
                asm volatile("" ::: "memory"); }
    }
};
struct EpiIn {
    static constexpr bool PERM = true, AFTER_DRAIN = false;
    bf16_t* O; int ldc; float scale0; float* ssq; float* sskv; const float* rt; const float* bf; float* lf; int nrows;
    __device__ __forceinline__ void operator()(const f32x4 (&acc)[2][2][4][2], const Unit& u, int wr, int wc, int fr, int fq) const {
        const int row0 = u.pm * BM + wr * 64 + fr, col0 = u.pn * BM + wc * 32 + 8 * fq; const int pn = u.pn;
        const float sc = pn < 2 ? scale0 : 1.f;
#pragma unroll
        for (int ai = 0; ai < 2; ++ai)
#pragma unroll
            for (int m = 0; m < 4; ++m) { const int row = row0 + ai * HALF + m * 16; bf16_t* rowp = O + (size_t)row * ldc + col0; float s0 = 0.f, s1 = 0.f;
#pragma unroll
                for (int bj = 0; bj < 2; ++bj) { f32x4 v0 = acc[ai][bj][m][0] * sc, v1 = acc[ai][bj][m][1] * sc;
                    const float sq = ((v0[0] * v0[0] + v0[1] * v0[1]) + (v0[2] * v0[2] + v0[3] * v0[3])) + ((v1[0] * v1[0] + v1[1] * v1[1]) + (v1[2] * v1[2] + v1[3] * v1[3]));
                    if (bj == 0) s0 = sq; else s1 = sq;
                    bool store = true;
                    if (pn == 7 && bj == 1) { store = (wc == 0);
                        if (wc == 0) { const f32x4* t = (const f32x4*)(rt + (size_t)row * 32 + 8 * fq); const f32x4 t0 = t[0], t1 = t[1]; f32x4 w0, w1;
                            w0[0] = v0[0] * t0[0] - v0[1] * t0[1]; w0[1] = v0[1] * t0[0] + v0[0] * t0[1];
                            w0[2] = v0[2] * t0[2] - v0[3] * t0[3]; w0[3] = v0[3] * t0[2] + v0[2] * t0[3];
                            w1[0] = v1[0] * t1[0] - v1[1] * t1[1]; w1[1] = v1[1] * t1[0] + v1[0] * t1[1];
                            w1[2] = v1[2] * t1[2] - v1[3] * t1[3]; w1[3] = v1[3] * t1[2] + v1[2] * t1[3];
                            v0 = w0; v1 = w1; }
                        else if (wc == 1 && fq == 0) {
#pragma unroll
                            for (int e = 0; e < 8; ++e) { const float z = (e < 4 ? v0[e & 3] : v1[e & 3]) + bf[e]; lf[(size_t)e * nrows + row] = fminf(z, 0.f) - 0.6931471805599453f * __builtin_amdgcn_logf(1.0f + __builtin_amdgcn_exp2f(-1.4426950408889634f * fabsf(z))); } } }
                    if (store) { u32x4 w; w.x = cvt_pk_bf16(v0[0], v0[1]); w.y = cvt_pk_bf16(v0[2], v0[3]); w.z = cvt_pk_bf16(v1[0], v1[1]); w.w = cvt_pk_bf16(v1[2], v1[3]);
                        *(u32x4*)(rowp + bj * HALF) = w; } }
                if (pn == 6) { float s = s0 + s1; s += __shfl_xor(s, 16); s += __shfl_xor(s, 32); if (fq == 0) ssq[(size_t)row * 4 + wc] = s; }
                if (pn == 7) { float s = s0; s += __shfl_xor(s, 16); s += __shfl_xor(s, 32); if (fq == 0) sskv[(size_t)row * 4 + wc] = s; }
                asm volatile("" ::: "memory"); }
    }
};
struct EpiRes {
    static constexpr bool PERM = false, AFTER_DRAIN = false;
    const float* base; float* out; int ldc; bf16_t* ob; float* ss;
    __device__ __forceinline__ void operator()(const f32x4 (&acc)[2][2][4][2], const Unit& u, int wr, int wc, int fr, int fq) const {
        typedef unsigned u32x2v __attribute__((ext_vector_type(2)));
        const int row0 = u.pm * BM + wr * 64 + fr, col0 = u.pn * BM + wc * 32 + 4 * fq;
#pragma unroll
        for (int ai = 0; ai < 2; ++ai)
#pragma unroll
            for (int m = 0; m < 4; ++m) { const int row = row0 + ai * HALF + m * 16; const size_t off = (size_t)row * ldc + col0; float s = 0.f;
#pragma unroll
                for (int bj = 0; bj < 2; ++bj)
#pragma unroll
                    for (int n = 0; n < 2; ++n) { const f32x4 v = *(const f32x4*)(base + off + bj * HALF + n * 16) + acc[ai][bj][m][n];
                        *(f32x4*)(out + off + bj * HALF + n * 16) = v; s += (v[0] * v[0] + v[1] * v[1]) + (v[2] * v[2] + v[3] * v[3]);
                        if (ob) { u32x2v w; w.x = cvt_pk_bf16(v[0], v[1]); w.y = cvt_pk_bf16(v[2], v[3]); *(u32x2v*)(ob + off + bj * HALF + n * 16) = w; } }
                if (ss) { s += __shfl_xor(s, 16); s += __shfl_xor(s, 32); if (fq == 0) ss[(size_t)row * 16 + u.pn * 4 + wc] = s; }
                asm volatile("" ::: "memory");
            }
    }
};

struct EpiResNorm {
    static constexpr bool PERM = false, AFTER_DRAIN = true;
    const float* base; float* out; int ldc; const float* g; float* xs; unsigned* cnt; float eps; float inv_n;
    __device__ __forceinline__ void fused(f32x4 (&acc)[2][2][4][2], const Unit& u, int wr, int wc, int fr, int fq, PG8_LAS unsigned char* lds, int wid, int lane) const {
        PG8_LAS float* Pm = (PG8_LAS float*)lds;
        PG8_LAS float* S = (PG8_LAS float*)(lds + 4096);
        const int row0 = u.pm * BM + wr * 64 + fr, col0 = u.pn * BM + wc * 32 + 4 * fq;
#pragma unroll
        for (int ai = 0; ai < 2; ++ai)
#pragma unroll
            for (int m = 0; m < 4; ++m) { const size_t off = (size_t)(row0 + ai * HALF + m * 16) * ldc + col0; float s = 0.f;
#pragma unroll
                for (int bj = 0; bj < 2; ++bj)
#pragma unroll
                    for (int n = 0; n < 2; ++n) { const f32x4 v = *(const f32x4*)(base + off + bj * HALF + n * 16) + acc[ai][bj][m][n]; acc[ai][bj][m][n] = v;
                        s += (v[0] * v[0] + v[1] * v[1]) + (v[2] * v[2] + v[3] * v[3]); }
                s += __shfl_xor(s, 16); s += __shfl_xor(s, 32);
                if (fq == 0) Pm[(ai * HALF + wr * 64 + m * 16 + fr) * 4 + wc] = s;
                if (m & 1) asm volatile("" ::: "memory"); }
        asm volatile("s_waitcnt lgkmcnt(0)" ::: "memory"); __builtin_amdgcn_s_barrier(); asm volatile("" ::: "memory");
        const int tid = wid * 64 + lane;
        if (tid < 256) { const f32x4 p4 = *(const PG8_LAS f32x4*)(Pm + tid * 4);
            __hip_atomic_store(xs + (size_t)(u.pm * BM + tid) * 4 + u.pn, (p4[0] + p4[1]) + (p4[2] + p4[3]), __ATOMIC_RELAXED, __HIP_MEMORY_SCOPE_AGENT);
            asm volatile("s_waitcnt vmcnt(0)" ::: "memory");
            if (lane == 0) __hip_atomic_fetch_add(cnt + 64 * u.pm, 1u, __ATOMIC_RELAXED, __HIP_MEMORY_SCOPE_AGENT); }
        if (wid == 0) { unsigned sp = 0;
            while ((unsigned)__builtin_amdgcn_readfirstlane(__hip_atomic_load(cnt + 64 * u.pm, __ATOMIC_RELAXED, __HIP_MEMORY_SCOPE_AGENT)) < 16u) { __builtin_amdgcn_s_sleep(2); if (++sp > (1u << 22)) break; }
            __builtin_amdgcn_fence(__ATOMIC_ACQUIRE, "agent"); }
        asm volatile("s_waitcnt vmcnt(0) lgkmcnt(0)" ::: "memory"); __builtin_amdgcn_s_barrier(); asm volatile("" ::: "memory");
        if (tid < 256) { const float* xp = xs + (size_t)(u.pm * BM + tid) * 4;
            const float t0 = __hip_atomic_load(xp + 0, __ATOMIC_RELAXED, __HIP_MEMORY_SCOPE_AGENT), t1 = __hip_atomic_load(xp + 1, __ATOMIC_RELAXED, __HIP_MEMORY_SCOPE_AGENT);
            const float t2 = __hip_atomic_load(xp + 2, __ATOMIC_RELAXED, __HIP_MEMORY_SCOPE_AGENT), t3 = __hip_atomic_load(xp + 3, __ATOMIC_RELAXED, __HIP_MEMORY_SCOPE_AGENT);
            S[tid] = 1.0f / sqrtf(((t0 + t1) + (t2 + t3)) * inv_n + eps); }
        asm volatile("s_waitcnt vmcnt(0) lgkmcnt(0)" ::: "memory"); __builtin_amdgcn_s_barrier(); asm volatile("" ::: "memory");
        f32x4 gv[2][2];
#pragma unroll
        for (int bj = 0; bj < 2; ++bj)
#pragma unroll
            for (int n = 0; n < 2; ++n) gv[bj][n] = *(const f32x4*)(g + col0 + bj * HALF + n * 16);
#pragma unroll
        for (int ai = 0; ai < 2; ++ai)
#pragma unroll
            for (int m = 0; m < 4; ++m) { const int r = ai * HALF + wr * 64 + m * 16 + fr; const float rs = S[r]; const size_t off = (size_t)(u.pm * BM + r) * ldc + col0;
#pragma unroll
                for (int bj = 0; bj < 2; ++bj)
#pragma unroll
                    for (int n = 0; n < 2; ++n) *(f32x4*)(out + off + bj * HALF + n * 16) = acc[ai][bj][m][n] * rs * gv[bj][n]; }
    }
};
struct EpiSqRelu {
    static constexpr bool PERM = true, AFTER_DRAIN = false;
    bf16_t* O; int ldc; const float* ss; float eps; float inv_n;
    __device__ __forceinline__ void operator()(const f32x4 (&acc)[2][2][4][2], const Unit& u, int wr, int wc, int fr, int fq) const {
        const int row0 = u.pm * BM + wr * 64 + fr, col0 = u.pn * BM + wc * 32 + 8 * fq;
#pragma unroll
        for (int ai = 0; ai < 2; ++ai)
#pragma unroll
            for (int m = 0; m < 4; ++m) { const int row = row0 + ai * HALF + m * 16;
                const f32x4* sp = (const f32x4*)(ss + (size_t)row * 16); const f32x4 a = sp[0], b = sp[1], c = sp[2], d = sp[3];
                const float tot = ((a[0] + a[1]) + (a[2] + a[3])) + ((b[0] + b[1]) + (b[2] + b[3])) + ((c[0] + c[1]) + (c[2] + c[3])) + ((d[0] + d[1]) + (d[2] + d[3]));
                const float rstd = 1.0f / sqrtf(tot * inv_n + eps);
#pragma unroll
                for (int bj = 0; bj < 2; ++bj) { f32x4 v0 = acc[ai][bj][m][0] * rstd, v1 = acc[ai][bj][m][1] * rstd;
#pragma unroll
                    for (int e = 0; e < 4; ++e) { const float x0 = fmaxf(v0[e], 0.f), x1 = fmaxf(v1[e], 0.f); v0[e] = x0 * x0; v1[e] = x1 * x1; }
                    u32x4 w; w.x = cvt_pk_bf16(v0[0], v0[1]); w.y = cvt_pk_bf16(v0[2], v0[3]); w.z = cvt_pk_bf16(v1[0], v1[1]); w.w = cvt_pk_bf16(v1[2], v1[3]);
                    *(u32x4*)(O + (size_t)row * ldc + col0 + bj * HALF) = w; }
                asm volatile("" ::: "memory"); }
    }
};


template <class Epi, class Sched, bool ALIGN_EPI = false, bool SP2 = false>
__device__ __forceinline__ void gemm_phase(PG8_LAS unsigned char* lds, const Gemm g, const Sched& S, const Epi& E) {
    const int tid = threadIdx.x, wid = __builtin_amdgcn_readfirstlane(tid >> 6), lane = tid & 63, wr = wid >> 2, wc = wid & 3, fr = lane & 15, fq = lane >> 4;
    const int K = g.K, nt = K / BK, lda = g.lda ? g.lda : g.K;
    unsigned voffA[2], voffB[2];
#pragma unroll
    for (int i = 0; i < 2; ++i) { int R, C; stage_rc(tid * 16 + i * 8192, R, C); const int Rb = Epi::PERM ? ((R & ~31) + perm32(R & 31)) : R;
        voffA[i] = (unsigned)(R * lda + C) * 2u; voffB[i] = (unsigned)(Rb * K + C) * 2u; }
    const size_t kstep = (size_t)(BK * 2);
    const size_t hstep = (size_t)HALF * K * 2;
    const size_t tstep = 2 * hstep;
    const size_t hstepA = (size_t)HALF * lda * 2, tstepA = 2 * hstepA;
    const unsigned ldsw = (unsigned)wid * 1024u;
    const int aoff = lds_byte(wr * 64 + fr, fq * 8), boff = lds_byte(wc * 32 + fr, fq * 8);
#define PG8_SA(b, h) (((b) * 2 + (h)) * HTB)
#define PG8_SB(b, h) ((4 + (b) * 2 + (h)) * HTB)
#define PG8_STAGE(bufoff, gbase, voff) do { _Pragma("unroll") for (int _i = 0; _i < 2; ++_i) \
        __builtin_amdgcn_global_load_lds((const unsigned*)((const char*)(gbase) + (voff)[_i]), (PG8_LAS unsigned*)(lds + (bufoff) + ldsw + _i * 8192), 16, 0, 0); } while (0)
#define PG8_LDA(dst, b, h) do { _Pragma("unroll") for (int m = 0; m < 4; ++m) _Pragma("unroll") for (int k = 0; k < 2; ++k) dst[m][k] = *(const PG8_LAS bf16x8*)(lds + PG8_SA(b, h) + aoff + m * 2048 + k * 1024); } while (0)
#define PG8_LDB(dst, b, h) do { _Pragma("unroll") for (int n = 0; n < 2; ++n) _Pragma("unroll") for (int k = 0; k < 2; ++k) dst[n][k] = *(const PG8_LAS bf16x8*)(lds + PG8_SB(b, h) + boff + n * 2048 + k * 1024); } while (0)
#define PG8_MMA(ai, bj, At, Bt) do { __builtin_amdgcn_s_setprio(1); _Pragma("unroll") for (int m = 0; m < 4; ++m) _Pragma("unroll") for (int n = 0; n < 2; ++n) _Pragma("unroll") for (int k = 0; k < 2; ++k) \
        acc[ai][bj][m][n] = __builtin_amdgcn_mfma_f32_16x16x32_bf16(Bt[n][k], At[m][k], acc[ai][bj][m][n], 0, 0, 0); __builtin_amdgcn_s_setprio(0); } while (0)
#define PG8_WAIT_V(n) asm volatile("s_waitcnt vmcnt(" #n ")" ::: "memory")
#define PG8_WAIT_L(n) asm volatile("s_waitcnt lgkmcnt(" #n ")" ::: "memory")
#define PG8_BAR __builtin_amdgcn_s_barrier()
#define PG8_SCHED __builtin_amdgcn_sched_barrier(0)
    Unit cur, nxt; int ui = 0;
    if (!S.next(0, cur)) return;
    f32x4 acc[2][2][4][2];
#pragma unroll
    for (int a = 0; a < 2; ++a)
#pragma unroll
        for (int b = 0; b < 2; ++b)
#pragma unroll
            for (int m = 0; m < 4; ++m)
#pragma unroll
                for (int n = 0; n < 2; ++n) acc[a][b][m][n] = (f32x4){0.f, 0.f, 0.f, 0.f};
    bf16x8 At[4][2], B0[2][2], B1[2][2];
    const char* cA = (const char*)g.A + (size_t)cur.pm * tstepA; const char* cB = (const char*)g.Bt + (size_t)cur.pn * tstep;
    S.a_ready(cur);
    if constexpr (SP2) {
        PG8_STAGE(PG8_SB(0, 0), cB, voffB); PG8_STAGE(PG8_SB(0, 1), cB + hstep, voffB); PG8_STAGE(PG8_SA(0, 0), cA, voffA); PG8_STAGE(PG8_SA(0, 1), cA + hstepA, voffA);
        if (wr == 1) PG8_BAR;
        PG8_WAIT_V(2); PG8_BAR;
        PG8_STAGE(PG8_SB(1, 0), cB + kstep, voffB); PG8_STAGE(PG8_SA(1, 0), cA + kstep, voffA); PG8_STAGE(PG8_SB(1, 1), cB + hstep + kstep, voffB);
        PG8_WAIT_V(6); PG8_BAR;
    } else {
        PG8_STAGE(PG8_SB(0, 0), cB, voffB); PG8_STAGE(PG8_SA(0, 0), cA, voffA); PG8_STAGE(PG8_SB(0, 1), cB + hstep, voffB); PG8_STAGE(PG8_SA(0, 1), cA + hstepA, voffA);
        if (wr == 1) PG8_BAR;
        PG8_WAIT_V(4); PG8_BAR;
        PG8_STAGE(PG8_SB(1, 0), cB + kstep, voffB); PG8_STAGE(PG8_SA(1, 0), cA + kstep, voffA); PG8_STAGE(PG8_SB(1, 1), cB + hstep + kstep, voffB);
        PG8_WAIT_V(6); PG8_BAR;
    }
    for (;;) {
        const bool has_next = S.next(ui + 1, nxt);
        const char* nA = has_next ? (const char*)g.A + (size_t)nxt.pm * tstepA : cA; const char* nB = has_next ? (const char*)g.Bt + (size_t)nxt.pn * tstep : cB;
        for (int t = 0; t < nt; t += 2) {
            const bool last = (t == nt - 2);
            const char* a1 = cA + (size_t)(t + 1) * kstep;
            const char* a2 = last ? nA : cA + (size_t)(t + 2) * kstep; const char* b2 = last ? nB : cB + (size_t)(t + 2) * kstep;
            const char* a3 = a2 + kstep; const char* b3 = b2 + kstep;
            if (last && has_next) S.a_ready(nxt);
            if constexpr (SP2) {
            PG8_LDB(B0, 0, 0); PG8_LDB(B1, 0, 1); PG8_SCHED; PG8_LDA(At, 0, 0); PG8_STAGE(PG8_SA(1, 1), a1 + hstepA, voffA);
            PG8_WAIT_V(8); PG8_WAIT_L(0); PG8_BAR; PG8_MMA(0, 0, At, B0); PG8_MMA(0, 1, At, B1); PG8_BAR; PG8_SCHED;
            PG8_LDA(At, 0, 1); PG8_STAGE(PG8_SB(0, 0), b2, voffB); PG8_STAGE(PG8_SB(0, 1), b2 + hstep, voffB); PG8_STAGE(PG8_SA(0, 0), a2, voffA);
            PG8_WAIT_V(8); PG8_WAIT_L(0); PG8_BAR; PG8_MMA(1, 0, At, B0); PG8_MMA(1, 1, At, B1); PG8_BAR; PG8_SCHED;
            PG8_LDB(B0, 1, 0); PG8_LDB(B1, 1, 1); PG8_SCHED; PG8_LDA(At, 1, 0); PG8_STAGE(PG8_SA(0, 1), a2 + hstepA, voffA);
            PG8_WAIT_V(8); PG8_WAIT_L(0); PG8_BAR; PG8_MMA(0, 0, At, B0); PG8_MMA(0, 1, At, B1); PG8_BAR; PG8_SCHED;
            PG8_LDA(At, 1, 1); PG8_STAGE(PG8_SB(1, 0), b3, voffB); PG8_STAGE(PG8_SB(1, 1), b3 + hstep, voffB); PG8_STAGE(PG8_SA(1, 0), a3, voffA);
            PG8_WAIT_V(8); PG8_WAIT_L(0); PG8_BAR; PG8_MMA(1, 0, At, B0); PG8_MMA(1, 1, At, B1); PG8_BAR; PG8_SCHED;
            } else {
            PG8_LDB(B0, 0, 0); PG8_SCHED; PG8_LDA(At, 0, 0); PG8_STAGE(PG8_SA(1, 1), a1 + hstepA, voffA);
            PG8_WAIT_L(8); PG8_BAR; PG8_WAIT_L(0); PG8_MMA(0, 0, At, B0); PG8_BAR; PG8_SCHED;
            PG8_LDB(B1, 0, 1); PG8_STAGE(PG8_SB(0, 0), b2, voffB);
            PG8_BAR; PG8_WAIT_L(0); PG8_MMA(0, 1, At, B1); PG8_BAR;
            PG8_LDA(At, 0, 1); PG8_STAGE(PG8_SA(0, 0), a2, voffA);
            PG8_BAR; PG8_WAIT_L(0); PG8_MMA(1, 0, At, B0); PG8_BAR; PG8_SCHED;
            PG8_STAGE(PG8_SB(0, 1), b2 + hstep, voffB);
            PG8_WAIT_V(6); PG8_BAR; PG8_MMA(1, 1, At, B1); PG8_BAR;
            PG8_LDB(B0, 1, 0); PG8_SCHED; PG8_LDA(At, 1, 0); PG8_STAGE(PG8_SA(0, 1), a2 + hstepA, voffA);
            PG8_WAIT_L(8); PG8_BAR; PG8_WAIT_L(0); PG8_MMA(0, 0, At, B0); PG8_BAR; PG8_SCHED;
            PG8_LDB(B1, 1, 1); PG8_STAGE(PG8_SB(1, 0), b3, voffB);
            PG8_BAR; PG8_WAIT_L(0); PG8_MMA(0, 1, At, B1); PG8_BAR;
            PG8_LDA(At, 1, 1); PG8_STAGE(PG8_SA(1, 0), a3, voffA);
            PG8_BAR; PG8_WAIT_L(0); PG8_MMA(1, 0, At, B0); PG8_BAR; PG8_SCHED;
            PG8_STAGE(PG8_SB(1, 1), b3 + hstep, voffB);
            PG8_WAIT_V(6); PG8_BAR; PG8_MMA(1, 1, At, B1); PG8_BAR;
            }
        }
        if constexpr (ALIGN_EPI) { if (wr == 0) PG8_BAR; }
        if constexpr (!Epi::AFTER_DRAIN) { E(acc, cur, wr, wc, fr, fq); S.done(cur); }
        if (!has_next) break;
#pragma unroll
        for (int a = 0; a < 2; ++a)
#pragma unroll
            for (int b = 0; b < 2; ++b)
#pragma unroll
                for (int m = 0; m < 4; ++m)
#pragma unroll
                    for (int n = 0; n < 2; ++n) acc[a][b][m][n] = (f32x4){0.f, 0.f, 0.f, 0.f};
        cur = nxt; cA = nA; cB = nB; ++ui;
        if constexpr (ALIGN_EPI) { if (wr == 1) PG8_BAR; }
    }
    PG8_WAIT_V(0);
    if constexpr (!ALIGN_EPI) { if (wr == 0) PG8_BAR; }
    PG8_BAR;
    if constexpr (Epi::AFTER_DRAIN) { E.fused(acc, cur, wr, wc, fr, fq, lds, wid, lane); S.done(cur); }
#undef PG8_SA
#undef PG8_SB
#undef PG8_STAGE
#undef PG8_LDA
#undef PG8_LDB
#undef PG8_MMA
#undef PG8_WAIT_V
#undef PG8_WAIT_L
#undef PG8_BAR
#undef PG8_SCHED
}
}

#ifndef PG8_SP2
#define PG8_SP2 true
#endif
#ifndef PG8_ALIGN
#define PG8_ALIGN true
#endif
namespace att {
#define LAS3 __attribute__((address_space(3)))
using bf16x8 = __attribute__((ext_vector_type(8))) short;
using s16x4 = __attribute__((ext_vector_type(4))) short;
using f32x16 = __attribute__((ext_vector_type(16))) float;
using f32x4 = __attribute__((ext_vector_type(4))) float;
using u32x4 = __attribute__((ext_vector_type(4))) unsigned;
typedef unsigned short u16;
typedef LAS3 const unsigned char* lds_cptr;
typedef short v4i16_t __attribute__((ext_vector_type(4)));
constexpr int SEQ = 16384, NW = 8, QBLK = 32, QB = 256, KVBLK = 64;
constexpr int KSLOT = 12288, VSLOT = 8192, NKS = 4, NVS = 4;
constexpr int LDS_K = 0, LDS_V = NKS * KSLOT, LDS_WS = LDS_V + NVS * VSLOT, LDS_OST = LDS_WS + NW * 256, LDS_QX = LDS_OST + NW * 4096, LDS_BYTES = LDS_QX + NW * 2048;
__device__ __forceinline__ int crow(int r, int hi) { return (r & 3) + 8 * (r >> 2) + 4 * hi; }
__device__ __forceinline__ void glds16(const void* gsrc, unsigned lds_dst) { unsigned keep;
    asm volatile("s_mov_b32 %0, m0\n\ts_mov_b32 m0, %2\n\ts_nop 0\n\tglobal_load_lds_dwordx4 %1, off\n\ts_mov_b32 m0, %0" : "=&s"(keep) : "v"(gsrc), "s"(lds_dst) : "memory"); }
typedef float f32x2_t __attribute__((ext_vector_type(2))); typedef __bf16 bf16x2_t __attribute__((ext_vector_type(2)));
__device__ __forceinline__ unsigned cvtpk_s(float lo, float hi) { f32x2_t v = {lo, hi}; bf16x2_t b = __builtin_convertvector(v, bf16x2_t); return __builtin_bit_cast(unsigned, b); }
__device__ __forceinline__ s16x4 vtr(lds_cptr p) { return __builtin_bit_cast(s16x4, __builtin_amdgcn_ds_read_tr16_b64_v4i16((LAS3 v4i16_t*)p)); }
#define ATT_SBAR() __builtin_amdgcn_sched_barrier(0)
#define ATT_WAIT_BAR(N) asm volatile("s_waitcnt vmcnt(" #N ") lgkmcnt(0)\n\ts_barrier" ::: "memory")
struct Src {
    const u16* q; int qp;
    const u16* k; int kp;
    const u16* k2; int k2p;
    const u16* v; int vp;
    u16* o; int op;
};
template <int NDK, int NQR, bool ZC, int XHS, int JLO, int JHI>
__device__ __forceinline__ void phase_a(f32x16& C0, f32x16& C1, const lds_cptr* kb_, int ksl_, const bf16x8* qr, lds_cptr qx_, const f32x16& negm, bf16x8* kf, bf16x8* qx) {
#ifndef ATT_KPF
#define ATT_KPF 4
#endif
    constexpr int KPF = ATT_KPF;
#define ATT_KRD(j) kf[j] = *(const LAS3 bf16x8*)(kb_[(j) >> 1] + ksl_ + ((j) & 1) * (((j) >> 1) < 4 ? 4096 : XHS))
    if (JLO == 0) {
#pragma unroll
        for (int j = 0; j < KPF; ++j) ATT_KRD(j); }
#pragma unroll
    for (int j = JLO; j < JHI; ++j) {
        if (j + KPF < 2 * NDK) ATT_KRD(j + KPF);
        if (NDK > NQR && (j & 1) == 0 && (j >> 1) + 2 >= NQR && (j >> 1) + 2 < NDK) qx[(j >> 1) + 2 - NQR] = *(const LAS3 bf16x8*)(qx_ + ((j >> 1) + 2 - NQR) * 1024);
        ATT_SBAR();
        const f32x16 z = f32x16{}; const bf16x8 qf = ((j >> 1) < NQR) ? qr[(j >> 1) < NQR ? (j >> 1) : 0] : qx[(j >> 1) >= NQR ? (j >> 1) - NQR : 0];
        if (j & 1) C1 = __builtin_amdgcn_mfma_f32_32x32x16_bf16(kf[j], qf, (j < 2) ? (ZC ? z : negm) : C1, 0, 0, 0);
        else       C0 = __builtin_amdgcn_mfma_f32_32x32x16_bf16(kf[j], qf, (j < 2) ? (ZC ? z : negm) : C0, 0, 0, 0);
        ATT_SBAR();
    }
#undef ATT_KRD
}
template <bool QK, bool FIN>
__device__ __forceinline__ void phase_b(f32x16& C0, f32x16& C1, f32x16* o, lds_cptr vp_, u32x4* pw, float& l_reg) {
    s16x4 vlo[8], vhi[8]; float sacc = 0.f, sacd = 0.f;
#define ATT_VRD(i) do { const int vi_ = ((i) >> 1) + 4 * ((i) & 1); vlo[i] = vtr(vp_ + ((vi_ >> 2) * 4096 + (vi_ & 3) * 1024)); vhi[i] = vtr(vp_ + ((vi_ >> 2) * 4096 + (vi_ & 3) * 1024 + 512)); } while (0)
    if (FIN) { ATT_VRD(0); ATT_VRD(1); }
#pragma unroll
    for (int i = 0; i < 8; ++i) {
        if (FIN && i + 2 < 8) ATT_VRD(i + 2);
        ATT_SBAR();
        if (FIN) { const bf16x8 vf = (bf16x8){vlo[i][0], vlo[i][1], vlo[i][2], vlo[i][3], vhi[i][0], vhi[i][1], vhi[i][2], vhi[i][3]};
            o[i & 1] = __builtin_amdgcn_mfma_f32_32x32x16_bf16(__builtin_bit_cast(bf16x8, pw[i >> 1]), vf, o[i & 1], 0, 0, 0); }
        if (QK) { f32x16& X = (i < 4) ? C0 : C1; const int b = 4 * (i & 3);
            X[b] = __builtin_amdgcn_exp2f(X[b]); X[b + 1] = __builtin_amdgcn_exp2f(X[b + 1]); X[b + 2] = __builtin_amdgcn_exp2f(X[b + 2]); X[b + 3] = __builtin_amdgcn_exp2f(X[b + 3]);
            sacc += X[b]; sacd += X[b + 1]; sacc += X[b + 2]; sacd += X[b + 3]; asm volatile("" : "+v"(sacc), "+v"(sacd));
            if (i & 1) { const int k = i >> 1, c = 8 * (k & 1);
                pw[k] = (u32x4){cvtpk_s(X[c], X[c + 1]), cvtpk_s(X[c + 2], X[c + 3]), cvtpk_s(X[c + 4], X[c + 5]), cvtpk_s(X[c + 6], X[c + 7])}; asm volatile("" : "+v"(pw[k])); } }
        ATT_SBAR();
    }
#undef ATT_VRD
    if (QK) l_reg += sacc + sacd;
}
template <bool MLA, bool FIX> __device__ __forceinline__ void attn_unit(int qb, const Src& s, LAS3 unsigned char* shm, const float* bias_h, float kmax2, const float* qmax_h) {
    constexpr int NDK = MLA ? 6 : 5, NX = MLA ? 4 : 1, NQR = MLA ? 4 : 5;
    constexpr float THRL = MLA ? 8.0f : 16.0f;
    const int tid = threadIdx.x, lane = tid & 63, r32 = lane & 31, hi = lane >> 5; const int wid = __builtin_amdgcn_readfirstlane(tid >> 6);
    const int q0 = qb * QB;
    const unsigned lds0 = (unsigned)(uintptr_t)shm;
    LAS3 float* wsf = (LAS3 float*)(shm + LDS_WS) + wid * 64;
    const int NT = (q0 + QB) / KVBLK;
    const int wvis = NT - 4 + (wid >> 1);
    const bool xw = wid < NX;
    const int krow = 8 * wid + (lane >> 3);
    const u16* ksrc = s.k + (size_t)krow * s.kp + (((lane & 7) ^ ((krow >> 1) & 7)) * 8);
    const int k2row = 16 * (wid & 3) + (lane >> 2);
    const u16* k2src = MLA ? s.k2 + (size_t)k2row * s.k2p + (((lane & 3) ^ ((k2row >> 2) & 3)) * 8) : s.k2 + (size_t)lane * s.k2p;
    const u16* vsrc = s.v + (size_t)(16 * (wid & 3) + (lane >> 2)) * s.vp + (wid >> 2) * 32 + (lane & 3) * 8;
    const unsigned kdst = lds0 + LDS_K + wid * 1024, k2dst = lds0 + LDS_K + (8 + (wid & 3)) * 1024, vdst = lds0 + LDS_V + wid * 1024;
#define ATT_DMA_K(t) do { const int sl_ = (t) & 3; glds16(ksrc + (size_t)(t) * KVBLK * s.kp, (unsigned)__builtin_amdgcn_readfirstlane(kdst + sl_ * KSLOT)); \
        if (xw) glds16(k2src + (size_t)(t) * KVBLK * s.k2p, (unsigned)__builtin_amdgcn_readfirstlane(k2dst + sl_ * KSLOT)); } while (0)
#define ATT_DMA_V(t, vsl) glds16(vsrc + (size_t)(t) * KVBLK * s.vp, (unsigned)__builtin_amdgcn_readfirstlane(vdst + (vsl)))
    if (!MLA) {
        if (tid < 256) { const int sl = tid >> 6; *(LAS3 f32x4*)(shm + LDS_K + sl * KSLOT + 9 * 1024 + (tid & 63) * 16) = (f32x4){0.f, 0.f, 0.f, 0.f}; } }
    if (MLA) { ATT_DMA_K(0); ATT_DMA_V(0, 0); ATT_DMA_K(1); ATT_DMA_K(2); }
    const u16* Qw = s.q + (size_t)(q0 + wid * QBLK + r32) * s.qp + hi * 8;
    bf16x8 qr[NQR];
#pragma unroll
    for (int d0 = 0; d0 < 4; ++d0) qr[d0] = *reinterpret_cast<const bf16x8*>(Qw + d0 * 16);
    const lds_cptr qx0 = (lds_cptr)shm + LDS_QX + wid * 2048 + lane * 16;
    float mla_ref = 0.f;
    if (MLA) { const bf16x8 q4 = *reinterpret_cast<const bf16x8*>(Qw + 64), q5 = *reinterpret_cast<const bf16x8*>(Qw + 80);
        *(LAS3 bf16x8*)(shm + LDS_QX + wid * 2048 + lane * 16) = q4; *(LAS3 bf16x8*)(shm + LDS_QX + wid * 2048 + 1024 + lane * 16) = q5;
        if (FIX) { float nq = 0.f;
#pragma unroll
            for (int e = 0; e < 8; ++e) { const float a = __uint_as_float((unsigned)(unsigned short)q4[e] << 16), b = __uint_as_float((unsigned)(unsigned short)q5[e] << 16); nq += a * a + b * b; }
#pragma unroll
            for (int d0 = 0; d0 < 4; ++d0)
#pragma unroll
                for (int e = 0; e < 8; ++e) { const float a = __uint_as_float((unsigned)(unsigned short)qr[d0][e] << 16); nq += a * a; }
            nq += __shfl_xor(nq, 32); mla_ref = sqrtf(nq * kmax2); } }
    const short one = hi ? (short)0 : (short)0x3F80;
    if (!MLA) qr[NQR - 1] = (bf16x8){one, one, one, 0, 0, 0, 0, 0};
    int t0 = 0;
    if (!MLA) {
        const float qm = qmax_h[qb];
        const float bunit = sqrtf(qm * kmax2);
        const float thr = FIX ? bias_h[q0] - 152.f : bias_h[q0] - 170.f - 2.f * bunit;
        if (FIX) { const float nm_ = -(bias_h[q0 + wid * QBLK + r32] + bunit); const unsigned h_ = cvtpk_s(nm_, 0.f) & 0xffffu; const float r1_ = nm_ - __uint_as_float(h_ << 16); const unsigned m_ = cvtpk_s(r1_, 0.f) & 0xffffu;
            const float r2_ = r1_ - __uint_as_float(m_ << 16); const unsigned l_ = cvtpk_s(r2_, 0.f) & 0xffffu;
            if (hi == 0) qr[NQR - 1] = (bf16x8){one, one, one, (short)h_, (short)m_, (short)l_, 0, 0}; }
        int best = 0;
        for (int tt = 1 + lane; tt <= NT - 4; tt += 64) { if (bias_h[64 * tt - 1] < thr) best = tt; }
#pragma unroll
        for (int o_ = 32; o_ >= 1; o_ >>= 1) best = max(best, __shfl_xor(best, o_));
        t0 = __builtin_amdgcn_readfirstlane(best);
    }
    if (!MLA) { ATT_DMA_K(t0); ATT_DMA_V(t0, (t0 & 3) * VSLOT); ATT_DMA_K(t0 + 1); ATT_DMA_K(t0 + 2); }
    float mhat = 0.f, l_reg = 0.f; f32x16 o[2]; o[0] = f32x16{}; o[1] = f32x16{}; f32x16 negm = f32x16{};
    if (MLA && FIX) {
#pragma unroll
        for (int r = 0; r < 16; ++r) negm[r] = -mla_ref; }
    const int qrel = wid * QBLK + r32;
    lds_cptr kb[NDK];
#pragma unroll
    for (int d0 = 0; d0 < 4; ++d0) kb[d0] = (lds_cptr)shm + LDS_K + r32 * 128 + ((((2 * d0 + hi) ^ ((r32 >> 1) & 7))) << 4);
    if (MLA) {
#pragma unroll
        for (int d0 = 4; d0 < NDK; ++d0) kb[d0] = (lds_cptr)shm + LDS_K + 8192 + r32 * 64 + ((((2 * (d0 - 4) + hi) ^ ((r32 >> 2) & 3))) << 4);
    } else kb[NDK - 1] = (lds_cptr)shm + LDS_K + 8192 + hi * 1024 + r32 * 16;
    constexpr int XHS = MLA ? 2048 : 512;
    const lds_cptr vp0 = (lds_cptr)shm + LDS_V + ((lane >> 4) & 1) * 32 + (lane & 3) * 8 + (4 * hi + ((lane & 15) >> 2)) * 64;
    f32x16 C0, C1; u32x4 pw[4]; bool resc = false;
#define ATT_TOP(t) do { if ((t) == t0 || (t) + 2 >= NT) { ATT_WAIT_BAR(0); } else if (xw) { ATT_WAIT_BAR(3); } else { ATT_WAIT_BAR(2); } \
        } while (0)
#define ATT_ISSUE(t) do { if ((t) + 3 < NT) ATT_DMA_K((t) + 3); if ((t) + 1 < NT) ATT_DMA_V((t) + 1, (((t) + 1) & 3) * VSLOT); } while (0)
#ifdef ATT_QKPRIO
#define ATT_PRIO_ON() __builtin_amdgcn_s_setprio(1)
#define ATT_PRIO_OFF() __builtin_amdgcn_s_setprio(0)
#else
#define ATT_PRIO_ON()
#define ATT_PRIO_OFF()
#endif
#define ATT_QK(t) do { bf16x8 kf_[2 * NDK]; bf16x8 qx_[NDK > NQR ? NDK - NQR : 1]; \
        phase_a<NDK, NQR, !MLA, XHS, 0, 4>(C0, C1, ATT_KS(t), qr, qx0, negm, kf_, qx_); ATT_ISSUE(t); ATT_SBAR(); ATT_PRIO_ON(); \
        phase_a<NDK, NQR, !MLA, XHS, 4, 2 * NDK>(C0, C1, ATT_KS(t), qr, qx0, negm, kf_, qx_); ATT_PRIO_OFF(); } while (0)
#define ATT_MASK(C0, C1, t) do { const int kbq_ = 64 * ((t) - (NT - 4)) + 4 * hi; \
        _Pragma("unroll") for (int r = 0; r < 16; ++r) { const int kv_ = kbq_ + (r & 3) + 8 * (r >> 2); if (kv_ > qrel) C0[r] = -INFINITY; if (kv_ + 32 > qrel) C1[r] = -INFINITY; } } while (0)
#define ATT_DECIDE(C0, C1, FIRST) do { if (!FIX) { \
        float a_ = fmaxf(fmaxf(C0[0], C0[1]), C1[0]), b_ = fmaxf(fmaxf(C0[2], C0[3]), C1[1]); a_ = fmaxf(fmaxf(a_, C1[2]), C1[3]); \
        _Pragma("unroll") for (int r = 4; r < 16; r += 4) { a_ = fmaxf(fmaxf(a_, C0[r]), C0[r + 1]); b_ = fmaxf(fmaxf(b_, C0[r + 2]), C0[r + 3]); a_ = fmaxf(fmaxf(a_, C1[r]), C1[r + 1]); b_ = fmaxf(fmaxf(b_, C1[r + 2]), C1[r + 3]); } \
        float rm_ = fmaxf(a_, b_); { auto rr_ = __builtin_amdgcn_permlane32_swap(__float_as_uint(rm_), __float_as_uint(rm_), false, false); rm_ = fmaxf(__uint_as_float(rr_[0]), __uint_as_float(rr_[1])); } \
        resc = false; \
        if ((FIRST) || __any(rm_ > THRL)) { float dl_ = (FIRST) ? rm_ : fmaxf(rm_, 0.f); \
            if (!MLA) { const float nm_ = -(mhat + dl_); const unsigned h_ = cvtpk_s(nm_, 0.f) & 0xffffu; const float r1_ = nm_ - __uint_as_float(h_ << 16); const unsigned m_ = cvtpk_s(r1_, 0.f) & 0xffffu; \
                const float r2_ = r1_ - __uint_as_float(m_ << 16); const unsigned l_ = cvtpk_s(r2_, 0.f) & 0xffffu; \
                const float mn_ = -((__uint_as_float(h_ << 16) + __uint_as_float(m_ << 16)) + __uint_as_float(l_ << 16)); dl_ = mn_ - mhat; mhat = mn_; \
                if (hi == 0) qr[NQR - 1] = (bf16x8){one, one, one, (short)h_, (short)m_, (short)l_, 0, 0}; } \
            else { mhat += dl_; _Pragma("unroll") for (int r = 0; r < 16; ++r) negm[r] = -mhat; } \
            _Pragma("unroll") for (int r = 0; r < 16; ++r) { C0[r] -= dl_; C1[r] -= dl_; } \
            if (!(FIRST)) { const float f_ = __builtin_amdgcn_exp2f(-dl_); l_reg *= f_; if (hi == 0) wsf[r32] = f_; resc = true; } } } } while (0)
#define ATT_RESC() do { if (!FIX && resc) { \
        _Pragma("unroll") for (int i = 0; i < 4; ++i) { const f32x4 fv_ = *(const LAS3 f32x4*)(wsf + 8 * i + 4 * hi); \
            _Pragma("unroll") for (int d = 0; d < 2; ++d) { o[d][4 * i] *= fv_[0]; o[d][4 * i + 1] *= fv_[1]; o[d][4 * i + 2] *= fv_[2]; o[d][4 * i + 3] *= fv_[3]; } } } } while (0)
#define ATT_VS(tt) (vp0 + (((tt)) & 3) * VSLOT)
#define ATT_KS(tt) kb, ((((tt)) & 3) * KSLOT)
#ifndef ATT_STAGGER
#define ATT_STAGGER 0
#endif
    if (!ATT_STAGGER || wid < 4) {
#define ATT_STEP(t, MASKED) do { ATT_TOP(t); \
        ATT_QK(t); \
        if (!MLA && (MASKED)) ATT_MASK(C0, C1, t); \
        ATT_DECIDE(C0, C1, false); ATT_SBAR(); \
        phase_b<true, true>(C0, C1, o, ATT_VS((t) - 1), pw, l_reg); \
        ATT_RESC(); } while (0)
        ATT_TOP(t0);
        ATT_QK(t0);
        if (!MLA && wvis == t0) ATT_MASK(C0, C1, t0);
        ATT_DECIDE(C0, C1, true); ATT_SBAR();
        phase_b<true, false>(C0, C1, o, vp0, pw, l_reg);
        int t = t0 + 1;
        for (; t < wvis; ++t) ATT_STEP(t, false);
        if (t == wvis) { ATT_STEP(t, true); ++t; }
        { ATT_TOP(t); ATT_ISSUE(t); phase_b<false, true>(C0, C1, o, ATT_VS(t - 1), pw, l_reg); ++t; }
        for (; t <= NT + ATT_STAGGER; ++t) { ATT_TOP(t); ATT_ISSUE(t); }
#undef ATT_STEP
    } else {
        ATT_TOP(t0);
        ATT_QK(t0);
        ATT_DECIDE(C0, C1, true); ATT_SBAR();
        ATT_TOP(t0 + 1);
        phase_b<true, false>(C0, C1, o, vp0, pw, l_reg); ATT_SBAR();
        ATT_QK(t0 + 1);
        ATT_DECIDE(C0, C1, false); ATT_SBAR();
        int t = t0 + 2;
#define ATT_STEP2(t, MASKED) do { ATT_TOP(t); \
        phase_b<true, true>(C0, C1, o, ATT_VS((t) - 2), pw, l_reg); \
        ATT_RESC(); ATT_SBAR(); \
        ATT_QK(t); \
        if (!MLA && (MASKED)) ATT_MASK(C0, C1, t); \
        ATT_DECIDE(C0, C1, false); ATT_SBAR(); } while (0)
        for (; t < wvis; ++t) ATT_STEP2(t, false);
        ATT_STEP2(t, true); ++t;
        { ATT_TOP(t); ATT_ISSUE(t); phase_b<true, true>(C0, C1, o, ATT_VS(t - 2), pw, l_reg); ATT_RESC(); ++t; }
        { ATT_TOP(t); ATT_ISSUE(t); phase_b<false, true>(C0, C1, o, ATT_VS(t - 2), pw, l_reg); ++t; }
        for (; t <= NT + ATT_STAGGER; ++t) { ATT_TOP(t); ATT_ISSUE(t); }
#undef ATT_STEP2
    }
    { auto rr = __builtin_amdgcn_permlane32_swap(__float_as_uint(l_reg), __float_as_uint(l_reg), false, false); l_reg = __uint_as_float(rr[0]) + __uint_as_float(rr[1]); }
    if (hi == 0) wsf[32 + r32] = 1.0f / l_reg;
    float rli[16];
#pragma unroll
    for (int i = 0; i < 4; ++i) { const f32x4 fv = *(const LAS3 f32x4*)(wsf + 32 + 8 * i + 4 * hi); rli[4 * i] = fv[0]; rli[4 * i + 1] = fv[1]; rli[4 * i + 2] = fv[2]; rli[4 * i + 3] = fv[3]; }
    u16* Ow = s.o + (size_t)(q0 + wid * QBLK) * s.op;
    { LAS3 u16* stg = (LAS3 u16*)(shm + LDS_OST) + wid * 2048;
#pragma unroll
        for (int r = 0; r < 16; ++r) { const int orow = crow(r, hi);
#pragma unroll
            for (int d0 = 0; d0 < 2; ++d0) stg[orow * 64 + d0 * 32 + r32] = (u16)(cvtpk_s(o[d0][r] * rli[r], 0.f) & 0xffffu); }
        asm volatile("s_waitcnt lgkmcnt(0)" ::: "memory");
#pragma unroll
        for (int i = 0; i < 4; ++i) { const int row = i * 8 + (lane >> 3), ch = lane & 7; const u32x4 v = *(const LAS3 u32x4*)(stg + row * 64 + ch * 8); *(u32x4*)(Ow + (size_t)row * s.op + ch * 8) = v; } }
    asm volatile("s_waitcnt lgkmcnt(0)\n\ts_barrier" ::: "memory");
#undef ATT_DMA_K
#undef ATT_DMA_V
#undef ATT_TOP
#undef ATT_ISSUE
#undef ATT_QK
#undef ATT_MASK
#undef ATT_DECIDE
#undef ATT_RESC
#undef ATT_STEP
}
}

namespace cg = cooperative_groups;
#define LAS __attribute__((address_space(3)))
typedef unsigned short bf16;
typedef unsigned v4u __attribute__((ext_vector_type(4)));
typedef unsigned v2u __attribute__((ext_vector_type(2)));
typedef float f32x4 __attribute__((ext_vector_type(4)));
constexpr int NWAVES = 8;
constexpr int M = 16384, D = 1024, FF = 4096, NIN = 1960, NINP = 2048, QL = 256, KVL = 128, NQU = 768, NKVU = 1024;
constexpr float EPS = 1e-6f;
constexpr float LOG2E = 1.4426950408889634f;
constexpr float C2_FOX = 0.125f * LOG2E, C2_MLA = 0.10206207261596575f * LOG2E;
constexpr size_t MiB = 1u << 20;
constexpr size_t WS_WIN = 1 * MiB, WS_WQ = 5 * MiB, WS_WKV = 5 * MiB + 512 * 1024, WS_WO = 6 * MiB, WS_W1 = 8 * MiB, WS_W2 = 16 * MiB;
constexpr size_t WS_RT = 24 * MiB, WS_LF = 26 * MiB, WS_LC = 26 * MiB + 512 * 1024, WS_SS = 27 * MiB, WS_KR = 28 * MiB, WS_KB = 29 * MiB, WS_SSQ = 31 * MiB, WS_SSKV = 31 * MiB + 512 * 1024, WS_BIASF = 28 * MiB;
constexpr size_t WS_XN = 32 * MiB, WS_H = 64 * MiB, WS_P = 64 * MiB, WS_QM = 128 * MiB, WS_KVM = 152 * MiB, WS_QN = 184 * MiB, WS_O = 192 * MiB, WS_KVN = 224 * MiB, WS_END = 228 * MiB;
constexpr int RING_BYTES = 131072, LDS_BYTES = 147456;
static_assert(att::LDS_BYTES <= LDS_BYTES, "attention scratch fits the LDS allocation");

__device__ __forceinline__ unsigned f2bf(float f) { unsigned u = __builtin_bit_cast(unsigned, f); return (u + 0x7fffu + ((u >> 16) & 1u)) >> 16; }
__device__ __forceinline__ unsigned pk2(float lo, float hi) { return f2bf(lo) | (f2bf(hi) << 16); }
__device__ __forceinline__ float bf2f(unsigned short h) { return __builtin_bit_cast(float, (unsigned)h << 16); }
__device__ __forceinline__ float wave_sum(float v) {
#pragma unroll
    for (int o = 1; o < 64; o <<= 1) v += __shfl_xor(v, o);
    return v;
}
__device__ __forceinline__ int map_row(int mode, int n) {
    if (mode == 1) { const int h = n / 96, d = n % 96; if (d < 64) return n; const int i = d - 64; return h * 96 + (i < 16 ? 64 + 2 * i : 64 + 2 * (i - 16) + 1); }
    if (mode == 2) { const int h = n >> 7, j = n & 127; return j < 64 ? h * 64 + j : 512 + h * 64 + (j - 64); }
    if (mode == 3) { if (n < 1536 || n >= 1960) return n; if (n < 1544) return 1952 + (n - 1536); if (n < 1800) return 1536 + (n - 1544); if (n < 1928) return 1792 + (n - 1800);
        const int i = n - 1928; return 1920 + (i < 16 ? 2 * i : 2 * (i - 16) + 1); }
    return n;
}
__device__ __forceinline__ void p0_transpose_item(const float* W, int K, int N, int nblk, bf16* WT, int mode, const float* gk, LAS float* scr, int item, int lane) {
    const int kb = item / nblk, nb = item % nblk, k0 = 64 * kb, n0 = 32 * nb;
    const int nn = n0 + (lane & 31);
    float wv[32];
#pragma unroll
    for (int i = 0; i < 32; ++i) { const int kk = 2 * i + (lane >> 5); wv[i] = (nn < N) ? W[(size_t)(k0 + kk) * N + nn] : 0.f; }
    if (gk) {
#pragma unroll
        for (int i = 0; i < 32; ++i) wv[i] *= gk[k0 + 2 * i + (lane >> 5)]; }
#pragma unroll
    for (int i = 0; i < 32; ++i) { const int kk = 2 * i + (lane >> 5); scr[kk * 33 + (lane & 31)] = wv[i]; }
    asm volatile("s_waitcnt lgkmcnt(0)" ::: "memory");
    const int c = lane & 7;
#pragma unroll
    for (int j = 0; j < 4; ++j) { const int n = (lane >> 3) + 8 * j; const LAS float* sp = scr + (8 * c) * 33 + n;
        v4u o; o.x = pk2(sp[0 * 33], sp[1 * 33]); o.y = pk2(sp[2 * 33], sp[3 * 33]); o.z = pk2(sp[4 * 33], sp[5 * 33]); o.w = pk2(sp[6 * 33], sp[7 * 33]);
        *(v4u*)(WT + (size_t)map_row(mode, n0 + n) * K + k0 + 8 * c) = o; }
    asm volatile("s_waitcnt lgkmcnt(0)" ::: "memory");
}
__device__ __forceinline__ void sincos_d(double x, float& sn, float& cs) {
    const double k = rint(x * 0.63661977236758134308);
    double r = fma(-k, 1.57079632679489655800e+00, x); r = fma(-k, 6.12323399573676603587e-17, r);
    const double r2 = r * r;
    double s = -1.0 / 6227020800.0; s = s * r2 + 1.0 / 39916800.0; s = s * r2 - 1.0 / 362880.0; s = s * r2 + 1.0 / 5040.0; s = s * r2 - 1.0 / 120.0; s = s * r2 + 1.0 / 6.0; s = r - r * r2 * s;
    double c = 1.0 / 479001600.0; c = c * r2 - 1.0 / 3628800.0; c = c * r2 + 1.0 / 40320.0; c = c * r2 - 1.0 / 720.0; c = c * r2 + 1.0 / 24.0; c = c * r2 - 0.5; c = 1.0 + r2 * c;
    const int q = ((int)k) & 3;
    const double ss = (q == 0) ? s : (q == 1) ? c : (q == 2) ? -s : -c;
    const double cc = (q == 0) ? c : (q == 1) ? -s : (q == 2) ? -c : s;
    sn = (float)ss; cs = (float)cc;
}

#define RLX_AGENT __ATOMIC_RELAXED, __HIP_MEMORY_SCOPE_AGENT
#define XB_TMO      128
#define XB_XCNT(j)  (256  + 64 * (j))
#define XB_XSUB(j)  (1280 + 64 * (j))
#define XB_XGEN(j)  (2304 + 64 * (j))
#define XB_TOP      3328
#define XB_TOPGEN   3392
#define XCD_BAR_WORDS 3456
#define XB_SPIN_CAP (1u << 18)

__device__ __forceinline__ unsigned xb_ld(unsigned* p)              { return __hip_atomic_load(p, __ATOMIC_RELAXED, __HIP_MEMORY_SCOPE_AGENT); }
__device__ __forceinline__ unsigned xb_add(unsigned* p, unsigned v) { return __hip_atomic_fetch_add(p, v, __ATOMIC_RELAXED, __HIP_MEMORY_SCOPE_AGENT); }
__device__ __forceinline__ unsigned xb_xcc_id() { return (unsigned)__builtin_amdgcn_s_getreg((3 << 11) | 20) & 0xFu; }
#define XB_SPIN(cond, bar) do { unsigned _sp = 0; while (cond) { __builtin_amdgcn_s_sleep(1); \
    if ((++_sp & 255u) == 0u) { if (xb_ld(&(bar)[XB_TMO])) break; if (_sp > XB_SPIN_CAP) { atomicAdd(&(bar)[XB_TMO], 1u); break; } } } } while (0)

struct XcdBarrier {
    unsigned* bar; unsigned x;
    volatile LAS unsigned* st;
};

__device__ __forceinline__ XcdBarrier xcd_barrier_post(unsigned* bar, volatile LAS unsigned* st) {
    XcdBarrier b; b.bar = bar; b.x = xb_xcc_id(); b.st = st;
    if (threadIdx.x == 0) (void)xb_add(&bar[XB_XCNT(b.x)], 1u);
    return b;
}
__device__ __forceinline__ void xcd_barrier_complete(unsigned* bar, unsigned x, unsigned& nloc, unsigned& nx) {
    const unsigned G = gridDim.x * gridDim.y * gridDim.z;
    unsigned sum, cnt, mine, sp = 0u;
    for (;;) {
        sum = 0u; cnt = 0u; mine = 0u;
#pragma unroll
        for (unsigned j = 0; j < 16; ++j) { const unsigned c = xb_ld(&bar[XB_XCNT(j)]); sum += c; cnt += (c > 0u) ? 1u : 0u; mine = (j == x) ? c : mine; }
        if (sum == G) break;
        __builtin_amdgcn_s_sleep(1);
        if ((++sp & 255u) == 0u) { if (xb_ld(&bar[XB_TMO])) break; if (sp > XB_SPIN_CAP) { atomicAdd(&bar[XB_TMO], 1u); break; } }
    }
    nloc = mine > 0u ? mine : 1u; nx = cnt > 0u ? cnt : 1u;
}

__device__ __forceinline__ void xcd_barrier(const XcdBarrier& b) {
    asm volatile("s_waitcnt vmcnt(0)" ::: "memory");
    __syncthreads();
    if (threadIdx.x == 0) {
        unsigned* bar = b.bar;
        __builtin_amdgcn_s_waitcnt(0);
        unsigned nloc = b.st[0], nx = b.st[1];
        if (nloc == 0u) { xcd_barrier_complete(bar, b.x, nloc, nx); b.st[0] = nloc; b.st[1] = nx; }
        const unsigned old = xb_add(&bar[XB_XSUB(b.x)], 1u);
        const unsigned gen = old / nloc;
        if (old + 1u == (gen + 1u) * nloc) {
            __builtin_amdgcn_fence(__ATOMIC_RELEASE, "agent");
            asm volatile("s_waitcnt vmcnt(0)" ::: "memory");
            const unsigned og = xb_add(&bar[XB_TOP], 1u);
            const unsigned tg = og / nx;
            if (og + 1u == (tg + 1u) * nx) xb_add(&bar[XB_TOPGEN], 1u);
            else XB_SPIN(xb_ld(&bar[XB_TOPGEN]) == tg, bar);
            __builtin_amdgcn_fence(__ATOMIC_ACQUIRE, "agent");
            xb_add(&bar[XB_XGEN(b.x)], 1u);
            asm volatile("s_waitcnt vmcnt(0)" ::: "memory");
        } else {
            XB_SPIN(xb_ld(&bar[XB_XGEN(b.x)]) == gen, bar);
            __builtin_amdgcn_fence(__ATOMIC_ACQUIRE, "agent");
            asm volatile("s_waitcnt vmcnt(0)" ::: "memory");
        }
    }
    __syncthreads();
}

constexpr int MISC_OFF = LDS_BYTES - 128;
constexpr size_t WS_CTL = 0, CTL_ZERO_BYTES = 64 * 1024;
constexpr int CW_KMAX = 8192, CW_QF = 8192 + 512, CW_QM = 8192 + 1024, CW_PCNT = 8192 + 1536, CW_KMAXM = 13824, CW_QMAXM = 14400, CW_DONE = 14464;
static_assert(att::LDS_BYTES <= MISC_OFF, "LDS map");
struct Args { const float* in[13]; float* out; unsigned char* ws; int ph_lo, ph_hi, dup, pad; };
constexpr int NPHASE = 8;

__global__ void __launch_bounds__(NWAVES * 64, 2) mk_fwd(Args args) {
    extern __shared__ __attribute__((aligned(16))) unsigned char lds_raw[];
    LAS unsigned char* lds = (LAS unsigned char*)lds_raw;
    const int G = gridDim.x, bx = blockIdx.x;
#define MK_IDS int tid = threadIdx.x; asm volatile("" : "+v"(tid)); const int lane = tid & 63, wave = __builtin_amdgcn_readfirstlane(tid >> 6); const int gw = vcu * NWAVES + wave; (void)gw; (void)lane;
    const int vcu = (G % 8 == 0) ? (bx % 8) * (G / 8) + bx / 8 : bx;
    const int NGW = G * NWAVES;
    unsigned char* ws = args.ws;
#define MKP_x ((const float*)args.in[0])
#define MKP_g_mix ((const float*)args.in[1])
#define MKP_w_in ((const float*)args.in[2])
#define MKP_b_f ((const float*)args.in[3])
#define MKP_g_q ((const float*)args.in[4])
#define MKP_w_q_up ((const float*)args.in[5])
#define MKP_g_kv ((const float*)args.in[6])
#define MKP_w_kv_up ((const float*)args.in[7])
#define MKP_w_o ((const float*)args.in[8])
#define MKP_g_mlp ((const float*)args.in[9])
#define MKP_w_ff1 ((const float*)args.in[10])
#define MKP_w_ff2 ((const float*)args.in[11])
#define MKP_g_final ((const float*)args.in[12])
#define MKP_out (args.out)
#define MKP_Win_t ((bf16*)(args.ws + WS_WIN))
#define MKP_Wq_t ((bf16*)(args.ws + WS_WQ))
#define MKP_Wkv_t ((bf16*)(args.ws + WS_WKV))
#define MKP_Wo_t ((bf16*)(args.ws + WS_WO))
#define MKP_W1_t ((bf16*)(args.ws + WS_W1))
#define MKP_W2_t ((bf16*)(args.ws + WS_W2))
#define MKP_RT ((float*)(args.ws + WS_RT))
#define MKP_LF ((float*)(args.ws + WS_LF))
#define MKP_SS ((float*)(args.ws + WS_SS))
#define MKP_SSQ ((float*)(args.ws + WS_SSQ))
#define MKP_BIASF ((float*)(args.ws + WS_BIASF))
#define MKP_QMAX ((float*)(args.ws + WS_LC))
#define MKP_SSKV ((float*)(args.ws + WS_SSKV))
#define MKP_KB ((bf16*)(args.ws + WS_KB))
#define MKP_KR ((bf16*)(args.ws + WS_KR))
#define MKP_XN ((bf16*)(args.ws + WS_XN))
#define MKP_HB ((bf16*)(args.ws + WS_H))
#define MKP_P ((bf16*)(args.ws + WS_P))
#define MKP_QM ((bf16*)(args.ws + WS_QM))
#define MKP_KVM ((bf16*)(args.ws + WS_KVM))
#define MKP_QN ((bf16*)(args.ws + WS_QN))
#define MKP_OB ((bf16*)(args.ws + WS_O))
#define MKP_KVN ((bf16*)(args.ws + WS_KVN))
    const int lo = args.ph_lo, hi = args.ph_hi;
#ifndef MK_MASK
#define MK_MASK 0x1ff
#endif
#define IN(k) (((MK_MASK >> (k)) & 1) && lo <= (k) && (k) < hi)
#define REP(k) for (int rep_ = 0; rep_ < ((args.dup == (k)) ? 2 : 1); ++rep_)
    { volatile LAS unsigned* misc = (volatile LAS unsigned*)(lds + MISC_OFF); if (threadIdx.x < 32) misc[threadIdx.x] = 0u; }
    __syncthreads();
    (void)xcd_barrier_post((unsigned*)(ws + WS_CTL), (volatile LAS unsigned*)(lds + MISC_OFF) + 8);
    if (args.ph_lo < 0) cg::this_grid().sync();
#ifdef TS_PHASE
    unsigned long long ts_a_ = 0, ts_b_ = 0;
#define TS_BEGIN(k) do { if ((k) == TS_PHASE || (TS_PHASE == 99 && (k) == 0)) ts_a_ = __builtin_amdgcn_s_memrealtime(); } while (0)
#define TS_END(k) do { if ((k) == TS_PHASE || (TS_PHASE == 99 && (k) == 7)) ts_b_ = __builtin_amdgcn_s_memrealtime(); } while (0)
#else
#define TS_BEGIN(k)
#define TS_END(k)
#endif
#define SEAM(k) do { if (IN(k) && IN((k) + 1)) { XcdBarrier b_; b_.bar = (unsigned*)(args.ws + WS_CTL); b_.x = xb_xcc_id(); b_.st = (volatile LAS unsigned*)(lds + MISC_OFF) + 8; xcd_barrier(b_); } } while (0)

    TS_BEGIN(0);
    if (IN(0)) { MK_IDS
        LAS float* scr = (LAS float*)(lds + wave * 16384);
        constexpr int I_IN = (D / 64) * (NINP / 32), I_Q = (QL / 64) * (NQU / 32), I_KV = (KVL / 64) * (NKVU / 32), I_O = (D / 64) * (D / 32), I_1 = (D / 64) * (FF / 32), I_2 = (FF / 64) * (D / 32);
        constexpr int NITEMS = I_IN + I_Q + I_KV;
        (void)I_O; (void)I_1; (void)I_2;
        for (int it = gw; it < NITEMS; it += NGW) {
            int r = it;
            if (r < I_IN) { p0_transpose_item(MKP_w_in, D, NIN, NINP / 32, MKP_Win_t, 3, nullptr, scr, r, lane); continue; } r -= I_IN;
            if (r < I_Q) { p0_transpose_item(MKP_w_q_up, QL, NQU, NQU / 32, MKP_Wq_t, 1, MKP_g_q, scr, r, lane); continue; } r -= I_Q;
            p0_transpose_item(MKP_w_kv_up, KVL, NKVU, NKVU / 32, MKP_Wkv_t, 2, MKP_g_kv, scr, r, lane);
        }
        for (int m0 = gw; m0 < M; m0 += 4 * NGW) {
            const f32x4* gr = (const f32x4*)MKP_g_mix + lane; f32x4 v[4][4]; float s2[4];
#pragma unroll
            for (int r = 0; r < 4; ++r) { const int m = m0 + r * NGW; const f32x4* xr = (const f32x4*)(MKP_x + (size_t)(m < M ? m : 0) * D) + lane;
#pragma unroll
                for (int j = 0; j < 4; ++j) v[r][j] = xr[64 * j]; }
#pragma unroll
            for (int r = 0; r < 4; ++r) { s2[r] = 0.f;
#pragma unroll
                for (int j = 0; j < 4; ++j) s2[r] += (v[r][j].x * v[r][j].x + v[r][j].y * v[r][j].y) + (v[r][j].z * v[r][j].z + v[r][j].w * v[r][j].w);
                s2[r] = 1.f / sqrtf(wave_sum(s2[r]) * (1.f / D) + EPS); }
#pragma unroll
            for (int r = 0; r < 4; ++r) { const int m = m0 + r * NGW; if (m < M) { unsigned long long* o8 = (unsigned long long*)(MKP_XN + (size_t)m * D) + lane; const float rstd = s2[r];
#pragma unroll
                for (int j = 0; j < 4; ++j) { const f32x4 g = gr[64 * j]; o8[64 * j] = (unsigned long long)pk2(v[r][j].x * rstd * g.x, v[r][j].y * rstd * g.y) | ((unsigned long long)pk2(v[r][j].z * rstd * g.z, v[r][j].w * rstd * g.w) << 32); } } }
        }
        for (int e = (vcu * NWAVES * 64 + tid); e < M * 16; e += G * NWAVES * 64) {
            const int m = e >> 4, i = e & 15; double inv = 1.0; for (int j = 0; j < i; ++j) inv *= 0.56234132519034908039;
            float sn, cs; sincos_d((double)m * inv, sn, cs); MKP_RT[2 * e] = cs; MKP_RT[2 * e + 1] = sn;
        }
    }
    SEAM(0);
    TS_END(0);
    TS_BEGIN(1);
    if (IN(1)) {
        pg8::Gemm g{MKP_XN, MKP_Win_t, M, NINP, D}; pg8::StaticOrder S; S.init(M, NINP, G, bx);
        pg8::EpiIn E{MKP_P, NINP, C2_FOX, MKP_SSQ, MKP_SSKV, MKP_RT, MKP_b_f, MKP_LF, M};
        pg8::gemm_phase<pg8::EpiIn, pg8::StaticOrder, PG8_ALIGN, PG8_SP2>(lds, g, S, E);
    }
    SEAM(1);
    TS_END(1);
    TS_BEGIN(3);
    if (IN(3)) { MK_IDS
        if (wave >= 2) {
            LAS float* scr = (LAS float*)(lds + wave * 16384);
            constexpr int J_O = (D / 64) * (D / 32), J_1 = (D / 64) * (FF / 32), J_2 = (FF / 64) * (D / 32);
            for (int it = vcu * 6 + (wave - 2); it < J_O + J_1 + J_2; it += G * 6) {
                int r = it;
                if (r < J_O) { p0_transpose_item(MKP_w_o, D, D, D / 32, MKP_Wo_t, 0, nullptr, scr, r, lane); continue; } r -= J_O;
                if (r < J_1) { p0_transpose_item(MKP_w_ff1, D, FF, FF / 32, MKP_W1_t, 0, MKP_g_mlp, scr, r, lane); continue; } r -= J_1;
                p0_transpose_item(MKP_w_ff2, FF, D, D / 32, MKP_W2_t, 0, nullptr, scr, r, lane);
            }
        }
        if (wave < 2) { const int job = bx + 256 * wave;
            if (job < 512 && bx < 256) { const int h = job >> 6, ti = job & 63; const f32x4* lf4 = (const f32x4*)(MKP_LF + (size_t)h * M);
                float pre = 0.f; { int j = 0; float pa[8] = {0.f, 0.f, 0.f, 0.f, 0.f, 0.f, 0.f, 0.f};
                    for (; j + 8 <= ti; j += 8) { f32x4 w[8];
#pragma unroll
                        for (int u = 0; u < 8; ++u) w[u] = lf4[(j + u) * 64 + lane];
#pragma unroll
                        for (int u = 0; u < 8; ++u) pa[u] += (w[u].x + w[u].y) + (w[u].z + w[u].w); }
                    for (; j < ti; ++j) { const f32x4 w = lf4[j * 64 + lane]; pa[0] += (w.x + w.y) + (w.z + w.w); }
                    pre = ((pa[0] + pa[1]) + (pa[2] + pa[3])) + ((pa[4] + pa[5]) + (pa[6] + pa[7])); }
                pre = wave_sum(pre);
                const f32x4 v = lf4[ti * 64 + lane];
                const float s1 = v.x, s2 = s1 + v.y, s3 = s2 + v.z, s4 = s3 + v.w; float inc = s4;
#pragma unroll
                for (int o = 1; o < 64; o <<= 1) { const float n = __shfl_up(inc, o); if (lane >= o) inc += n; }
                const float ex = pre + (inc - s4); const float cs[4] = {ex + s1, ex + s2, ex + s3, ex + s4};
                *(f32x4*)(MKP_BIASF + (size_t)h * M + ti * 256 + 4 * lane) = (f32x4){-cs[0] * LOG2E, -cs[1] * LOG2E, -cs[2] * LOG2E, -cs[3] * LOG2E};
                { float km = 0.f;
                  float qmx = 0.f;
                  for (int e = 0; e < 4; ++e) { const v4u* kr = (const v4u*)(MKP_P + (size_t)(ti * 256 + 4 * lane + e) * NINP + 512 + h * 64); float a2 = 0.f; const v4u* qrw = kr - 64; float q2 = 0.f;
#pragma unroll
                      for (int c8 = 0; c8 < 8; ++c8) { const v4u w = qrw[c8]; const unsigned ww[4] = {w.x, w.y, w.z, w.w};
#pragma unroll
                          for (int q4 = 0; q4 < 4; ++q4) { const float lo_ = __builtin_bit_cast(float, ww[q4] << 16), hi_ = __builtin_bit_cast(float, ww[q4] & 0xffff0000u); q2 += lo_ * lo_ + hi_ * hi_; } }
                      qmx = fmaxf(qmx, q2);
#pragma unroll
                      for (int c8 = 0; c8 < 8; ++c8) { const v4u w = kr[c8]; const unsigned ww[4] = {w.x, w.y, w.z, w.w};
#pragma unroll
                          for (int q4 = 0; q4 < 4; ++q4) { const float lo_ = __builtin_bit_cast(float, ww[q4] << 16), hi_ = __builtin_bit_cast(float, ww[q4] & 0xffff0000u); a2 += lo_ * lo_ + hi_ * hi_; } }
                      km = fmaxf(km, a2); }
#pragma unroll
                  for (int o = 32; o >= 1; o >>= 1) km = fmaxf(km, __shfl_xor(km, o));
#pragma unroll
                  for (int o = 32; o >= 1; o >>= 1) qmx = fmaxf(qmx, __shfl_xor(qmx, o));
                  if (lane == 0) { atomicMax((unsigned*)(args.ws + WS_CTL) + CW_KMAX + 64 * h, __builtin_bit_cast(unsigned, km)); MKP_QMAX[h * 64 + ti] = qmx; } }
#pragma unroll
                for (int e = 0; e < 4; ++e) { const float b = -cs[e] * LOG2E; const unsigned bh = f2bf(b); const float r1 = b - __builtin_bit_cast(float, bh << 16); const unsigned bm = f2bf(r1);
                    const float r2 = r1 - __builtin_bit_cast(float, bm << 16); const unsigned bl = f2bf(r2);
                    *(v4u*)(MKP_KB + ((size_t)h * M + ti * 256 + 4 * lane + e) * 8) = (v4u){bh | (bm << 16), bl | 0x3F800000u, 0x3F803F80u, 0u}; } } }
        __syncthreads();
        { int kq = QL; asm volatile("" : "+s"(kq)); pg8::Gemm g{MKP_P + 1536, MKP_Wq_t, M, NQU, kq, NINP}; pg8::StaticOrder S; S.init(M, NQU, G, bx);
          pg8::EpiQm E{MKP_QM, NQU, MKP_RT, C2_MLA, MKP_SSQ, EPS};
          pg8::gemm_phase<pg8::EpiQm, pg8::StaticOrder, PG8_ALIGN, PG8_SP2>(lds, g, S, E); }
        { int kkv = KVL; asm volatile("" : "+s"(kkv)); pg8::Gemm g{MKP_P + 1792, MKP_Wkv_t, M, NKVU, kkv, NINP}; pg8::StaticOrder S; S.init(M, NKVU, G, bx);
          pg8::EpiKv E{MKP_KVM, NKVU, MKP_SSKV, EPS};
          pg8::gemm_phase<pg8::EpiKv, pg8::StaticOrder, PG8_ALIGN, PG8_SP2>(lds, g, S, E); }
    }
    SEAM(3);
    TS_END(3);
    TS_BEGIN(4);
    if (IN(4)) {
        const int v = (G == 256) ? vcu : bx; const int h0 = (v >> 5) & 7;
        volatile LAS unsigned* misc = (volatile LAS unsigned*)(lds + MISC_OFF);
        unsigned* ctlw = (unsigned*)(args.ws + WS_CTL);
        { const int tid_ = threadIdx.x, lane_ = tid_ & 63, tok = bx * 64 + (tid_ >> 3), hh = tid_ & 7; float k2 = 0.f, q2 = 0.f;
          if (bx < 256) {
            const v4u* kp = (const v4u*)(MKP_KVM + (size_t)tok * NKVU + hh * 64); const v4u* rp = (const v4u*)(MKP_P + (size_t)tok * NINP + 1920); const v4u* qp = (const v4u*)(MKP_QM + (size_t)tok * NQU + hh * 96);
#define MK_SQ(w_, acc_) do { const unsigned ww_[4] = {w_.x, w_.y, w_.z, w_.w}; _Pragma("unroll") for (int q4_ = 0; q4_ < 4; ++q4_) { const float lo_ = __builtin_bit_cast(float, ww_[q4_] << 16), hi_ = __builtin_bit_cast(float, ww_[q4_] & 0xffff0000u); acc_ += lo_ * lo_ + hi_ * hi_; } } while (0)
#pragma unroll
            for (int c8 = 0; c8 < 8; ++c8) { const v4u w = kp[c8]; MK_SQ(w, k2); }
#pragma unroll
            for (int c8 = 0; c8 < 4; ++c8) { const v4u w = rp[c8]; MK_SQ(w, k2); }
#pragma unroll
            for (int c8 = 0; c8 < 12; ++c8) { const v4u w = qp[c8]; MK_SQ(w, q2); }
#undef MK_SQ
          }
#pragma unroll
          for (int o = 8; o <= 32; o <<= 1) { k2 = fmaxf(k2, __shfl_xor(k2, o)); q2 = fmaxf(q2, __shfl_xor(q2, o)); }
          if (lane_ < 8) { atomicMax(ctlw + CW_KMAXM + 64 * lane_, __builtin_bit_cast(unsigned, k2)); atomicMax(ctlw + CW_QMAXM, __builtin_bit_cast(unsigned, q2)); }
          asm volatile("s_waitcnt vmcnt(0)" ::: "memory"); __syncthreads();
          if (tid_ == 0) { __hip_atomic_fetch_add(ctlw + CW_DONE, 1u, __ATOMIC_RELAXED, __HIP_MEMORY_SCOPE_AGENT); unsigned sp = 0;
              while (__hip_atomic_load(ctlw + CW_DONE, __ATOMIC_RELAXED, __HIP_MEMORY_SCOPE_AGENT) < (unsigned)G) { __builtin_amdgcn_s_sleep(2); if (++sp > (1u << 22)) break; } }
          __syncthreads(); }
        bool okfix = true;
        { const float qmM = __builtin_bit_cast(float, __hip_atomic_load(ctlw + CW_QMAXM, __ATOMIC_RELAXED, __HIP_MEMORY_SCOPE_AGENT)); const int lane_ = threadIdx.x & 63;
          for (int h = 0; h < 8; ++h) { const float kF = __builtin_bit_cast(float, __hip_atomic_load(ctlw + CW_KMAX + 64 * h, __ATOMIC_RELAXED, __HIP_MEMORY_SCOPE_AGENT));
              const float kM = __builtin_bit_cast(float, __hip_atomic_load(ctlw + CW_KMAXM + 64 * h, __ATOMIC_RELAXED, __HIP_MEMORY_SCOPE_AGENT));
              float qF = MKP_QMAX[h * 64 + lane_];
#pragma unroll
              for (int o = 32; o >= 1; o >>= 1) qF = fmaxf(qF, __shfl_xor(qF, o));
              okfix = okfix && (qF * kF < 2025.f) && (qmM * kM < 2025.f); }
          okfix = __builtin_amdgcn_readfirstlane(okfix ? 1 : 0) != 0; }
#define MK_ATT_LOOPS(FIXV) do { \
        for (int rep = 0; rep < PROBE_FOX; ++rep) \
        for (int k = 0; k < 8; ++k) { const int h = (h0 + k) & 7; \
            const float kmax2 = __builtin_bit_cast(float, __hip_atomic_load(ctlw + CW_KMAX + 64 * h, __ATOMIC_RELAXED, __HIP_MEMORY_SCOPE_AGENT)); \
            att::Src s{MKP_P + h * 64, NINP, MKP_P + 512 + h * 64, NINP, MKP_KB + (size_t)h * M * 8, 8, MKP_P + 1024 + h * 64, NINP, MKP_OB + h * 64, D}; \
            for (;;) { \
                if (threadIdx.x == 0) misc[0] = __hip_atomic_fetch_add(ctlw + CW_QF + 64 * h + 16 * rep, 1u, __ATOMIC_RELAXED, __HIP_MEMORY_SCOPE_AGENT); \
                __syncthreads(); const unsigned i = misc[0]; __syncthreads(); \
                if (i >= 64u) break; \
                att::attn_unit<false, FIXV>(63 - (int)i, s, lds, MKP_BIASF + (size_t)h * M, kmax2, MKP_QMAX + h * 64); \
            } } \
        asm volatile("" ::: "memory"); \
        for (int rep = 0; rep < PROBE_MLA; ++rep) \
        for (int k = 0; k < 8; ++k) { const int h = (h0 + k) & 7; \
            const float kmaxm = __builtin_bit_cast(float, __hip_atomic_load(ctlw + CW_KMAXM + 64 * h, __ATOMIC_RELAXED, __HIP_MEMORY_SCOPE_AGENT)); \
            att::Src s{MKP_QM + h * 96, NQU, MKP_KVM + h * 64, NKVU, MKP_P + 1920, NINP, MKP_KVM + 512 + h * 64, NKVU, MKP_OB + 512 + h * 64, D}; \
            for (;;) { \
                if (threadIdx.x == 0) misc[0] = __hip_atomic_fetch_add(ctlw + CW_QM + 64 * h + 16 * rep, 1u, __ATOMIC_RELAXED, __HIP_MEMORY_SCOPE_AGENT); \
                __syncthreads(); const unsigned i = misc[0]; __syncthreads(); \
                if (i >= 64u) break; \
                att::attn_unit<true, FIXV>(63 - (int)i, s, lds, nullptr, kmaxm, nullptr); \
            } } } while (0)
#ifndef PROBE_FOX
#define PROBE_FOX 1
#endif
#ifndef PROBE_MLA
#define PROBE_MLA 1
#endif
        if (okfix) MK_ATT_LOOPS(true); else MK_ATT_LOOPS(false);
#undef MK_ATT_LOOPS
    }
#ifdef ATT_PRIO
    __builtin_amdgcn_s_setprio(0);
#endif
    SEAM(4);
    TS_END(4);
    TS_BEGIN(5);
    if (IN(5)) {
        pg8::Gemm g{MKP_OB, MKP_Wo_t, M, D, D}; pg8::StaticOrder S; S.init(M, D, G, bx);
        pg8::EpiRes E{MKP_x, MKP_out, D, MKP_XN, MKP_SS};
        pg8::gemm_phase<pg8::EpiRes, pg8::StaticOrder, PG8_ALIGN, PG8_SP2>(lds, g, S, E);
    }
    SEAM(5);
    TS_END(5);
    TS_BEGIN(6);
    if (IN(6)) {
        pg8::Gemm g{MKP_XN, MKP_W1_t, M, FF, D}; pg8::StaticOrder S; S.init(M, FF, G, bx);
        pg8::EpiSqRelu E{MKP_HB, FF, MKP_SS, EPS, 1.f / D};
        pg8::gemm_phase<pg8::EpiSqRelu, pg8::StaticOrder, PG8_ALIGN, PG8_SP2>(lds, g, S, E);
    }
    SEAM(6);
    TS_END(6);
    TS_BEGIN(7);
    if (IN(7)) {
        pg8::Gemm g{MKP_HB, MKP_W2_t, M, D, FF}; pg8::StaticOrder S; S.init(M, D, G, bx);
        pg8::EpiResNorm E{MKP_out, MKP_out, D, MKP_g_final, MKP_SSQ, (unsigned*)(args.ws + WS_CTL) + CW_PCNT, EPS, 1.f / D};
        pg8::gemm_phase<pg8::EpiResNorm, pg8::StaticOrder, false, PG8_SP2>(lds, g, S, E);
    }
#ifdef TS_PHASE
    { XcdBarrier b_; b_.bar = (unsigned*)(args.ws + WS_CTL); b_.x = xb_xcc_id(); b_.st = (volatile LAS unsigned*)(lds + MISC_OFF) + 8; xcd_barrier(b_); }
    TS_END(7);
    if (blockIdx.x == 0 && threadIdx.x == 0) MKP_out[0] = (float)(((ts_b_ - ts_a_) / TS_Q) * (TS_Q / 100ull));
#endif
#undef IN
#undef SEAM
#undef MKP_x
#undef MKP_g_mix
#undef MKP_w_in
#undef MKP_b_f
#undef MKP_g_q
#undef MKP_w_q_up
#undef MKP_g_kv
#undef MKP_w_kv_up
#undef MKP_w_o
#undef MKP_g_mlp
#undef MKP_w_ff1
#undef MKP_w_ff2
#undef MKP_g_final
#undef MKP_out
#undef MKP_Win_t
#undef MKP_Wq_t
#undef MKP_Wkv_t
#undef MKP_Wo_t
#undef MKP_W1_t
#undef MKP_W2_t
#undef MKP_RT
#undef MKP_LF
#undef MKP_SS
#undef MKP_SSQ
#undef MKP_BIASF
#undef MKP_QMAX
#undef MKP_SSKV
#undef MKP_KB
#undef MKP_KR
#undef MKP_XN
#undef MKP_HB
#undef MKP_P
#undef MKP_QM
#undef MKP_KVM
#undef MKP_QN
#undef MKP_OB
#undef MKP_KVN
}

#ifndef MK_ONE_LAUNCH
#define MK_ONE_LAUNCH 1
#endif
extern "C" void kernel_launch(void* const* d_in, const int* in_sizes, int n_in, void* d_out, int out_size, void* d_ws, size_t ws_size, hipStream_t stream) {
    static int ready = 0;
    if (ready == 0) {
        if (n_in != 13 || in_sizes[0] != M * D || out_size != M * D || ws_size < WS_END) { fprintf(stderr, "kernel_launch: unexpected shapes (n_in %d, in0 %d, out %d, ws %zu)\n", n_in, n_in > 0 ? in_sizes[0] : -1, out_size, ws_size); ready = -1; return; }
        if (hipFuncSetAttribute((const void*)mk_fwd, hipFuncAttributeMaxDynamicSharedMemorySize, LDS_BYTES) != hipSuccess) { fprintf(stderr, "kernel_launch: hipFuncSetAttribute failed\n"); ready = -1; return; }
        ready = 1;
    }
    if (ready < 0) return;
    if (hipMemsetAsync((char*)d_ws + WS_CTL, 0, CTL_ZERO_BYTES, stream) != hipSuccess) { fprintf(stderr, "kernel_launch: hipMemsetAsync failed\n"); return; }
    Args a{};
    for (int i = 0; i < 13; ++i) a.in[i] = (const float*)d_in[i];
    a.out = (float*)d_out; a.ws = (unsigned char*)d_ws;
#ifndef MK_DUP
#define MK_DUP -1
#endif
    a.dup = MK_DUP;
    const int grid = 256;
#if MK_ONE_LAUNCH
    a.ph_lo = 0; a.ph_hi = NPHASE;
    void* kargs[] = {&a};
    hipError_t e = hipLaunchCooperativeKernel((const void*)mk_fwd, dim3(grid), dim3(NWAVES * 64), kargs, LDS_BYTES, stream);
    if (e != hipSuccess) fprintf(stderr, "kernel_launch: cooperative launch failed: %s\n", hipGetErrorString(e));
#else
    for (int p = 0; p < NPHASE; ++p) { a.ph_lo = p; a.ph_hi = p + 1; hipLaunchKernelGGL(mk_fwd, dim3(grid), dim3(NWAVES * 64), LDS_BYTES, stream, a); }
#endif
}
```

```cpp
#include <hip/hip_runtime.h>
#include <hip/hip_cooperative_groups.h>
#include <hip/hip_bf16.h>
#include <cstdio>
#include <cstdint>
#include <cmath>
namespace pg8 {
#define PG8_LAS __attribute__((address_space(3)))
typedef unsigned short bf16_t;
typedef short bf16x8 __attribute__((ext_vector_type(8)));
typedef float f32x4 __attribute__((ext_vector_type(4)));
typedef unsigned u32x4 __attribute__((ext_vector_type(4)));
constexpr int BM = 256, BK = 64, HALF = 128, HTB = HALF * BK * 2  , STAGE_BYTES = 8 * HTB, NXCD = 8, WGM = 8;

__host__ __device__ __forceinline__ int lds_byte(int r, int c) { const int st = (r >> 4) * 2 + (c >> 5), rr = r & 15, cc = c & 31, ob = rr * 64 + cc * 2; return st * 1024 + (ob ^ (((ob >> 9) & 1) << 5)); }
__host__ __device__ __forceinline__ void stage_rc(int b, int& R, int& C) { const int st = b / 1024, sb = b % 1024, swz = sb ^ (((sb >> 9) & 1) << 5); R = (st >> 1) * 16 + swz / 64; C = (st & 1) * 32 + (swz % 64) / 2; }
__host__ __device__ __forceinline__ int perm32(int rho) { const int n = rho >> 4, i = rho & 15; return 8 * (i >> 2) + 4 * n + (i & 3); }

struct Unit { int pm, pn; };
struct Gemm { const bf16_t* A; const bf16_t* Bt; int M, N, K; int lda; };

struct StaticOrder {
    int nM, nN, nwg, G, c;
    __host__ __device__ void init(int M, int N, int G_, int c_) { nM = M / BM; nN = N / BM; nwg = nM * nN; G = G_; c = c_; }
    __host__ __device__ bool next(int i, Unit& u) const {
        const long L = (long)i * G + c; if (L >= nwg) return false;
        int wgid = (int)L; { const int q = nwg / NXCD, r = nwg % NXCD, xcd = wgid % NXCD, off = wgid / NXCD; wgid = (xcd < r ? xcd * (q + 1) : r * (q + 1) + (xcd - r) * q) + off; }
        const int nig = WGM * nN, gid = wgid / nig, fm = gid * WGM, gsz = (nM - fm) < WGM ? (nM - fm) : WGM;
        u.pm = fm + ((wgid % nig) % gsz); u.pn = (wgid % nig) / gsz; return true;
    }
    __device__ __forceinline__ void a_ready(const Unit&) const {}
    __device__ __forceinline__ void done(const Unit&) const {}
};

__device__ __forceinline__ unsigned cvt_pk_bf16(float lo, float hi) { unsigned r; asm volatile("v_cvt_pk_bf16_f32 %0, %1, %2" : "=v"(r) : "v"(lo), "v"(hi)); return r; }
typedef float f32x2 __attribute__((ext_vector_type(2)));
__device__ __forceinline__ f32x2 gelu_pk(f32x2 v) {
    const f32x2 av = __builtin_elementwise_abs(v), d = av * 0.2316418882f + 1.0f;
    f32x2 t; t.x = __builtin_amdgcn_rcpf(d.x); t.y = __builtin_amdgcn_rcpf(d.y);
    f32x2 q = t * 0.5307027145f + (-0.7265760135f); q = q * t + 0.7107068705f; q = q * t + (-0.142248368f); q = q * t + 0.127414796f; q = q * t;
    const f32x2 s = (v * v) * (-0.72134752044f);
    f32x2 e; e.x = __builtin_amdgcn_exp2f(s.x); e.y = __builtin_amdgcn_exp2f(s.y);
    const f32x2 m = v * (q * e), r = v - m;
    f32x2 o; o.x = v.x < 0.f ? m.x : r.x; o.y = v.y < 0.f ? m.y : r.y; return o;
}

template <int ACT  > struct EpiBf16 {
    static constexpr bool PERM = true, AFTER_DRAIN = false; static_assert(ACT == 0 || ACT == 1, "EpiBf16: ACT is 0 (none) or 1 (gelu_pk)");
    bf16_t* O; int ldc; const float* bias; int split_cols; size_t split_stride; float scale0;
    __device__ __forceinline__ void operator()(const f32x4 (&acc)[2][2][4][2], const Unit& u, int wr, int wc, int fr, int fq) const {
        const int row0 = u.pm * BM + wr * 64 + fr; int colt = u.pn * BM; bf16_t* base = O;
        float sc = 1.f; if (split_cols) { const int t = colt / split_cols; base += (size_t)t * split_stride; colt -= t * split_cols; if (t == 0) sc = scale0; }
        const int col0 = colt + wc * 32 + 8 * fq, bcol0 = u.pn * BM + wc * 32 + 8 * fq;
        f32x4 bv[2][2];
#pragma unroll
        for (int bj = 0; bj < 2; ++bj)
#pragma unroll
            for (int n = 0; n < 2; ++n) bv[bj][n] = bias ? *(const f32x4*)(bias + bcol0 + bj * HALF + 4 * n) : (f32x4){0.f, 0.f, 0.f, 0.f};
#pragma unroll
        for (int ai = 0; ai < 2; ++ai)
#pragma unroll
            for (int m = 0; m < 4; ++m) { bf16_t* rowp = base + (size_t)(row0 + ai * HALF + m * 16) * ldc + col0;
#pragma unroll
                for (int bj = 0; bj < 2; ++bj) { f32x4 v0 = acc[ai][bj][m][0] + bv[bj][0], v1 = acc[ai][bj][m][1] + bv[bj][1];
                    if (ACT == 1) { f32x2 a = gelu_pk((f32x2){v0[0], v0[1]}), b = gelu_pk((f32x2){v0[2], v0[3]}), c = gelu_pk((f32x2){v1[0], v1[1]}), d = gelu_pk((f32x2){v1[2], v1[3]});
                        v0 = (f32x4){a.x, a.y, b.x, b.y}; v1 = (f32x4){c.x, c.y, d.x, d.y}; }
                    v0 = v0 * sc; v1 = v1 * sc; u32x4 w; w.x = cvt_pk_bf16(v0[0], v0[1]); w.y = cvt_pk_bf16(v0[2], v0[3]); w.z = cvt_pk_bf16(v1[0], v1[1]); w.w = cvt_pk_bf16(v1[2], v1[3]);
                    *(u32x4*)(rowp + bj * HALF) = w; } }
    }
};

struct EpiQm {
    static constexpr bool PERM = true, AFTER_DRAIN = false;
    bf16_t* O; int ldc; const float* rt; float scale; const float* ssq; float eps;
    __device__ __forceinline__ void operator()(const f32x4 (&acc)[2][2][4][2], const Unit& u, int wr, int wc, int fr, int fq) const {
        const int row0 = u.pm * BM + wr * 64 + fr, col0 = u.pn * BM + wc * 32 + 8 * fq;
#pragma unroll
        for (int ai = 0; ai < 2; ++ai)
#pragma unroll
            for (int m = 0; m < 4; ++m) { const int row = row0 + ai * HALF + m * 16;
                const f32x4 sq = *(const f32x4*)(ssq + (size_t)row * 4); const float rs = scale / sqrtf(((sq[0] + sq[1]) + (sq[2] + sq[3])) * (1.0f / 256.0f) + eps);
#pragma unroll
                for (int bj = 0; bj < 2; ++bj) { const int c = col0 + bj * HALF, d = c % 96;
                    f32x4 v0 = acc[ai][bj][m][0], v1 = acc[ai][bj][m][1];
                    if (d >= 64) { const f32x4* t = (const f32x4*)(rt + (size_t)row * 32 + (d - 64)); const f32x4 t0 = t[0], t1 = t[1];
                        f32x4 w0, w1;
                        w0[0] = v0[0] * t0[0] - v0[1] * t0[1]; w0[1] = v0[1] * t0[0] + v0[0] * t0[1];
                        w0[2] = v0[2] * t0[2] - v0[3] * t0[3]; w0[3] = v0[3] * t0[2] + v0[2] * t0[3];
                        w1[0] = v1[0] * t1[0] - v1[1] * t1[1]; w1[1] = v1[1] * t1[0] + v1[0] * t1[1];
                        w1[2] = v1[2] * t1[2] - v1[3] * t1[3]; w1[3] = v1[3] * t1[2] + v1[2] * t1[3];
                        v0 = w0; v1 = w1; }
                    v0 = v0 * rs; v1 = v1 * rs; u32x4 w; w.x = cvt_pk_bf16(v0[0], v0[1]); w.y = cvt_pk_bf16(v0[2], v0[3]); w.z = cvt_pk_bf16(v1[0], v1[1]); w.w = cvt_pk_bf16(v1[2], v1[3]);
                    *(u32x4*)(O + (size_t)row * ldc + c) = w; }
                asm volatile("" ::: "memory"); }
    }
};

struct EpiKv {
    static constexpr bool PERM = true, AFTER_DRAIN = false;
    bf16_t* O; int ldc; const float* ssq; float eps;
    __device__ __forceinline__ void operator()(const f32x4 (&acc)[2][2][4][2], const Unit& u, int wr, int wc, int fr, int fq) const {
        const int row0 = u.pm * BM + wr * 64 + fr, col0 = u.pn * BM + wc * 32 + 8 * fq;
#pragma unroll
        for (int ai = 0; ai < 2; ++ai)
#pragma unroll
            for (int m = 0; m < 4; ++m) { const int row = row0 + ai * HALF + m * 16;
                const f32x4 sq = *(const f32x4*)(ssq + (size_t)row * 4); const float rs = 1.0f / sqrtf(((sq[0] + sq[1]) + (sq[2] + sq[3])) * (1.0f / 128.0f) + eps);
#pragma unroll
                for (int bj = 0; bj < 2; ++bj) { const f32x4 v0 = acc[ai][bj][m][0] * rs, v1 = acc[ai][bj][m][1] * rs;
                    u32x4 w; w.x = cvt_pk_bf16(v0[0], v0[1]); w.y = cvt_pk_bf16(v0[2], v0[3]); w.z = cvt_pk_bf16(v1[0], v1[1]); w.w = cvt_pk_bf16(v1[2], v1[3]);
                    *(u32x4*)(O + (size_t)row * ldc + col0 + bj * HALF) = w; }
                asm volatile("" ::: "memory"); }
    }
};
struct EpiIn {
    static constexpr bool PERM = true, AFTER_DRAIN = false;
    bf16_t* O; int ldc; float scale0; float* ssq; float* sskv; const float* rt; const float* bf; float* lf; int nrows;
    __device__ __forceinline__ void operator()(const f32x4 (&acc)[2][2][4][2], const Unit& u, int wr, int wc, int fr, int fq) const {
        const int row0 = u.pm * BM + wr * 64 + fr, col0 = u.pn * BM + wc * 32 + 8 * fq; const int pn = u.pn;
        const float sc = pn < 2 ? scale0 : 1.f;
#pragma unroll
        for (int ai = 0; ai < 2; ++ai)
#pragma unroll
            for (int m = 0; m < 4; ++m) { const int row = row0 + ai * HALF + m * 16; bf16_t* rowp = O + (size_t)row * ldc + col0; float s0 = 0.f, s1 = 0.f;
#pragma unroll
                for (int bj = 0; bj < 2; ++bj) { f32x4 v0 = acc[ai][bj][m][0] * sc, v1 = acc[ai][bj][m][1] * sc;
                    const float sq = ((v0[0] * v0[0] + v0[1] * v0[1]) + (v0[2] * v0[2] + v0[3] * v0[3])) + ((v1[0] * v1[0] + v1[1] * v1[1]) + (v1[2] * v1[2] + v1[3] * v1[3]));
                    if (bj == 0) s0 = sq; else s1 = sq;
                    bool store = true;
                    if (pn == 7 && bj == 1) { store = (wc == 0);
                        if (wc == 0) { const f32x4* t = (const f32x4*)(rt + (size_t)row * 32 + 8 * fq); const f32x4 t0 = t[0], t1 = t[1]; f32x4 w0, w1;
                            w0[0] = v0[0] * t0[0] - v0[1] * t0[1]; w0[1] = v0[1] * t0[0] + v0[0] * t0[1];
                            w0[2] = v0[2] * t0[2] - v0[3] * t0[3]; w0[3] = v0[3] * t0[2] + v0[2] * t0[3];
                            w1[0] = v1[0] * t1[0] - v1[1] * t1[1]; w1[1] = v1[1] * t1[0] + v1[0] * t1[1];
                            w1[2] = v1[2] * t1[2] - v1[3] * t1[3]; w1[3] = v1[3] * t1[2] + v1[2] * t1[3];
                            v0 = w0; v1 = w1; }
                        else if (wc == 1 && fq == 0) {
#pragma unroll
                            for (int e = 0; e < 8; ++e) { const float z = (e < 4 ? v0[e & 3] : v1[e & 3]) + bf[e]; lf[(size_t)e * nrows + row] = fminf(z, 0.f) - 0.6931471805599453f * __builtin_amdgcn_logf(1.0f + __builtin_amdgcn_exp2f(-1.4426950408889634f * fabsf(z))); } } }
                    if (store) { u32x4 w; w.x = cvt_pk_bf16(v0[0], v0[1]); w.y = cvt_pk_bf16(v0[2], v0[3]); w.z = cvt_pk_bf16(v1[0], v1[1]); w.w = cvt_pk_bf16(v1[2], v1[3]);
                        *(u32x4*)(rowp + bj * HALF) = w; } }
                if (pn == 6) { float s = s0 + s1; s += __shfl_xor(s, 16); s += __shfl_xor(s, 32); if (fq == 0) ssq[(size_t)row * 4 + wc] = s; }
                if (pn == 7) { float s = s0; s += __shfl_xor(s, 16); s += __shfl_xor(s, 32); if (fq == 0) sskv[(size_t)row * 4 + wc] = s; }
                asm volatile("" ::: "memory"); }
    }
};
struct EpiRes {
    static constexpr bool PERM = false, AFTER_DRAIN = false;
    const float* base; float* out; int ldc; bf16_t* ob; float* ss;
    __device__ __forceinline__ void operator()(const f32x4 (&acc)[2][2][4][2], const Unit& u, int wr, int wc, int fr, int fq) const {
        typedef unsigned u32x2v __attribute__((ext_vector_type(2)));
        const int row0 = u.pm * BM + wr * 64 + fr, col0 = u.pn * BM + wc * 32 + 4 * fq;
#pragma unroll
        for (int ai = 0; ai < 2; ++ai)
#pragma unroll
            for (int m = 0; m < 4; ++m) { const int row = row0 + ai * HALF + m * 16; const size_t off = (size_t)row * ldc + col0; float s = 0.f;
#pragma unroll
                for (int bj = 0; bj < 2; ++bj)
#pragma unroll
                    for (int n = 0; n < 2; ++n) { const f32x4 v = *(const f32x4*)(base + off + bj * HALF + n * 16) + acc[ai][bj][m][n];
                        *(f32x4*)(out + off + bj * HALF + n * 16) = v; s += (v[0] * v[0] + v[1] * v[1]) + (v[2] * v[2] + v[3] * v[3]);
                        if (ob) { u32x2v w; w.x = cvt_pk_bf16(v[0], v[1]); w.y = cvt_pk_bf16(v[2], v[3]); *(u32x2v*)(ob + off + bj * HALF + n * 16) = w; } }
                if (ss) { s += __shfl_xor(s, 16); s += __shfl_xor(s, 32); if (fq == 0) ss[(size_t)row * 16 + u.pn * 4 + wc] = s; }
                asm volatile("" ::: "memory");
            }
    }
};

struct EpiResNorm {
    static constexpr bool PERM = false, AFTER_DRAIN = true;
    const float* base; float* out; int ldc; const float* g; float* xs; unsigned* cnt; float eps; float inv_n;
    __device__ __forceinline__ void fused(f32x4 (&acc)[2][2][4][2], const Unit& u, int wr, int wc, int fr, int fq, PG8_LAS unsigned char* lds, int wid, int lane) const {
        PG8_LAS float* Pm = (PG8_LAS float*)lds;
        PG8_LAS float* S = (PG8_LAS float*)(lds + 4096);
        const int row0 = u.pm * BM + wr * 64 + fr, col0 = u.pn * BM + wc * 32 + 4 * fq;
#pragma unroll
        for (int ai = 0; ai < 2; ++ai)
#pragma unroll
            for (int m = 0; m < 4; ++m) { const size_t off = (size_t)(row0 + ai * HALF + m * 16) * ldc + col0; float s = 0.f;
#pragma unroll
                for (int bj = 0; bj < 2; ++bj)
#pragma unroll
                    for (int n = 0; n < 2; ++n) { const f32x4 v = *(const f32x4*)(base + off + bj * HALF + n * 16) + acc[ai][bj][m][n]; acc[ai][bj][m][n] = v;
                        s += (v[0] * v[0] + v[1] * v[1]) + (v[2] * v[2] + v[3] * v[3]); }
                s += __shfl_xor(s, 16); s += __shfl_xor(s, 32);
                if (fq == 0) Pm[(ai * HALF + wr * 64 + m * 16 + fr) * 4 + wc] = s;
                if (m & 1) asm volatile("" ::: "memory"); }
        asm volatile("s_waitcnt lgkmcnt(0)" ::: "memory"); __builtin_amdgcn_s_barrier(); asm volatile("" ::: "memory");
        const int tid = wid * 64 + lane;
        if (tid < 256) { const f32x4 p4 = *(const PG8_LAS f32x4*)(Pm + tid * 4);
            __hip_atomic_store(xs + (size_t)(u.pm * BM + tid) * 4 + u.pn, (p4[0] + p4[1]) + (p4[2] + p4[3]), __ATOMIC_RELAXED, __HIP_MEMORY_SCOPE_AGENT);
            asm volatile("s_waitcnt vmcnt(0)" ::: "memory");
            if (lane == 0) __hip_atomic_fetch_add(cnt + 64 * u.pm, 1u, __ATOMIC_RELAXED, __HIP_MEMORY_SCOPE_AGENT); }
        if (wid == 0) { unsigned sp = 0;
            while ((unsigned)__builtin_amdgcn_readfirstlane(__hip_atomic_load(cnt + 64 * u.pm, __ATOMIC_RELAXED, __HIP_MEMORY_SCOPE_AGENT)) < 16u) { __builtin_amdgcn_s_sleep(2); if (++sp > (1u << 22)) break; }
            __builtin_amdgcn_fence(__ATOMIC_ACQUIRE, "agent"); }
        asm volatile("s_waitcnt vmcnt(0) lgkmcnt(0)" ::: "memory"); __builtin_amdgcn_s_barrier(); asm volatile("" ::: "memory");
        if (tid < 256) { const float* xp = xs + (size_t)(u.pm * BM + tid) * 4;
            const float t0 = __hip_atomic_load(xp + 0, __ATOMIC_RELAXED, __HIP_MEMORY_SCOPE_AGENT), t1 = __hip_atomic_load(xp + 1, __ATOMIC_RELAXED, __HIP_MEMORY_SCOPE_AGENT);
            const float t2 = __hip_atomic_load(xp + 2, __ATOMIC_RELAXED, __HIP_MEMORY_SCOPE_AGENT), t3 = __hip_atomic_load(xp + 3, __ATOMIC_RELAXED, __HIP_MEMORY_SCOPE_AGENT);
            S[tid] = 1.0f / sqrtf(((t0 + t1) + (t2 + t3)) * inv_n + eps); }
        asm volatile("s_waitcnt vmcnt(0) lgkmcnt(0)" ::: "memory"); __builtin_amdgcn_s_barrier(); asm volatile("" ::: "memory");
        f32x4 gv[2][2];
#pragma unroll
        for (int bj = 0; bj < 2; ++bj)
#pragma unroll
            for (int n = 0; n < 2; ++n) gv[bj][n] = *(const f32x4*)(g + col0 + bj * HALF + n * 16);
#pragma unroll
        for (int ai = 0; ai < 2; ++ai)
#pragma unroll
            for (int m = 0; m < 4; ++m) { const int r = ai * HALF + wr * 64 + m * 16 + fr; const float rs = S[r]; const size_t off = (size_t)(u.pm * BM + r) * ldc + col0;
#pragma unroll
                for (int bj = 0; bj < 2; ++bj)
#pragma unroll
                    for (int n = 0; n < 2; ++n) *(f32x4*)(out + off + bj * HALF + n * 16) = acc[ai][bj][m][n] * rs * gv[bj][n]; }
    }
};
struct EpiSqRelu {
    static constexpr bool PERM = true, AFTER_DRAIN = false;
    bf16_t* O; int ldc; const float* ss; float eps; float inv_n;
    __device__ __forceinline__ void operator()(const f32x4 (&acc)[2][2][4][2], const Unit& u, int wr, int wc, int fr, int fq) const {
        const int row0 = u.pm * BM + wr * 64 + fr, col0 = u.pn * BM + wc * 32 + 8 * fq;
#pragma unroll
        for (int ai = 0; ai < 2; ++ai)
#pragma unroll
            for (int m = 0; m < 4; ++m) { const int row = row0 + ai * HALF + m * 16;
                const f32x4* sp = (const f32x4*)(ss + (size_t)row * 16); const f32x4 a = sp[0], b = sp[1], c = sp[2], d = sp[3];
                const float tot = ((a[0] + a[1]) + (a[2] + a[3])) + ((b[0] + b[1]) + (b[2] + b[3])) + ((c[0] + c[1]) + (c[2] + c[3])) + ((d[0] + d[1]) + (d[2] + d[3]));
                const float rstd = 1.0f / sqrtf(tot * inv_n + eps);
#pragma unroll
                for (int bj = 0; bj < 2; ++bj) { f32x4 v0 = acc[ai][bj][m][0] * rstd, v1 = acc[ai][bj][m][1] * rstd;
#pragma unroll
                    for (int e = 0; e < 4; ++e) { const float x0 = fmaxf(v0[e], 0.f), x1 = fmaxf(v1[e], 0.f); v0[e] = x0 * x0; v1[e] = x1 * x1; }
                    u32x4 w; w.x = cvt_pk_bf16(v0[0], v0[1]); w.y = cvt_pk_bf16(v0[2], v0[3]); w.z = cvt_pk_bf16(v1[0], v1[1]); w.w = cvt_pk_bf16(v1[2], v1[3]);
                    *(u32x4*)(O + (size_t)row * ldc + col0 + bj * HALF) = w; }
                asm volatile("" ::: "memory"); }
    }
};


template <class Epi, class Sched, bool ALIGN_EPI = false, bool SP2 = false>
__device__ __forceinline__ void gemm_phase(PG8_LAS unsigned char* lds, const Gemm g, const Sched& S, const Epi& E) {
    const int tid = threadIdx.x, wid = __builtin_amdgcn_readfirstlane(tid >> 6), lane = tid & 63, wr = wid >> 2, wc = wid & 3, fr = lane & 15, fq = lane >> 4;
    const int K = g.K, nt = K / BK, lda = g.lda ? g.lda : g.K;
    unsigned voffA[2], voffB[2];
#pragma unroll
    for (int i = 0; i < 2; ++i) { int R, C; stage_rc(tid * 16 + i * 8192, R, C); const int Rb = Epi::PERM ? ((R & ~31) + perm32(R & 31)) : R;
        voffA[i] = (unsigned)(R * lda + C) * 2u; voffB[i] = (unsigned)(Rb * K + C) * 2u; }
    const size_t kstep = (size_t)(BK * 2);
    const size_t hstep = (size_t)HALF * K * 2;
    const size_t tstep = 2 * hstep;
    const size_t hstepA = (size_t)HALF * lda * 2, tstepA = 2 * hstepA;
    const unsigned ldsw = (unsigned)wid * 1024u;
    const int aoff = lds_byte(wr * 64 + fr, fq * 8), boff = lds_byte(wc * 32 + fr, fq * 8);
#define PG8_SA(b, h) (((b) * 2 + (h)) * HTB)
#define PG8_SB(b, h) ((4 + (b) * 2 + (h)) * HTB)
#define PG8_STAGE(bufoff, gbase, voff) do { _Pragma("unroll") for (int _i = 0; _i < 2; ++_i) \
        __builtin_amdgcn_global_load_lds((const unsigned*)((const char*)(gbase) + (voff)[_i]), (PG8_LAS unsigned*)(lds + (bufoff) + ldsw + _i * 8192), 16, 0, 0); } while (0)
#define PG8_LDA(dst, b, h) do { _Pragma("unroll") for (int m = 0; m < 4; ++m) _Pragma("unroll") for (int k = 0; k < 2; ++k) dst[m][k] = *(const PG8_LAS bf16x8*)(lds + PG8_SA(b, h) + aoff + m * 2048 + k * 1024); } while (0)
#define PG8_LDB(dst, b, h) do { _Pragma("unroll") for (int n = 0; n < 2; ++n) _Pragma("unroll") for (int k = 0; k < 2; ++k) dst[n][k] = *(const PG8_LAS bf16x8*)(lds + PG8_SB(b, h) + boff + n * 2048 + k * 1024); } while (0)
#define PG8_MMA(ai, bj, At, Bt) do { __builtin_amdgcn_s_setprio(1); _Pragma("unroll") for (int m = 0; m < 4; ++m) _Pragma("unroll") for (int n = 0; n < 2; ++n) _Pragma("unroll") for (int k = 0; k < 2; ++k) \
        acc[ai][bj][m][n] = __builtin_amdgcn_mfma_f32_16x16x32_bf16(Bt[n][k], At[m][k], acc[ai][bj][m][n], 0, 0, 0); __builtin_amdgcn_s_setprio(0); } while (0)
#define PG8_WAIT_V(n) asm volatile("s_waitcnt vmcnt(" #n ")" ::: "memory")
#define PG8_WAIT_L(n) asm volatile("s_waitcnt lgkmcnt(" #n ")" ::: "memory")
#define PG8_BAR __builtin_amdgcn_s_barrier()
#define PG8_SCHED __builtin_amdgcn_sched_barrier(0)
    Unit cur, nxt; int ui = 0;
    if (!S.next(0, cur)) return;
    f32x4 acc[2][2][4][2];
#pragma unroll
    for (int a = 0; a < 2; ++a)
#pragma unroll
        for (int b = 0; b < 2; ++b)
#pragma unroll
            for (int m = 0; m < 4; ++m)
#pragma unroll
                for (int n = 0; n < 2; ++n) acc[a][b][m][n] = (f32x4){0.f, 0.f, 0.f, 0.f};
    bf16x8 At[4][2], B0[2][2], B1[2][2];
    const char* cA = (const char*)g.A + (size_t)cur.pm * tstepA; const char* cB = (const char*)g.Bt + (size_t)cur.pn * tstep;
    S.a_ready(cur);
    if constexpr (SP2) {
        PG8_STAGE(PG8_SB(0, 0), cB, voffB); PG8_STAGE(PG8_SB(0, 1), cB + hstep, voffB); PG8_STAGE(PG8_SA(0, 0), cA, voffA); PG8_STAGE(PG8_SA(0, 1), cA + hstepA, voffA);
        if (wr == 1) PG8_BAR;
        PG8_WAIT_V(2); PG8_BAR;
        PG8_STAGE(PG8_SB(1, 0), cB + kstep, voffB); PG8_STAGE(PG8_SA(1, 0), cA + kstep, voffA); PG8_STAGE(PG8_SB(1, 1), cB + hstep + kstep, voffB);
        PG8_WAIT_V(6); PG8_BAR;
    } else {
        PG8_STAGE(PG8_SB(0, 0), cB, voffB); PG8_STAGE(PG8_SA(0, 0), cA, voffA); PG8_STAGE(PG8_SB(0, 1), cB + hstep, voffB); PG8_STAGE(PG8_SA(0, 1), cA + hstepA, voffA);
        if (wr == 1) PG8_BAR;
        PG8_WAIT_V(4); PG8_BAR;
        PG8_STAGE(PG8_SB(1, 0), cB + kstep, voffB); PG8_STAGE(PG8_SA(1, 0), cA + kstep, voffA); PG8_STAGE(PG8_SB(1, 1), cB + hstep + kstep, voffB);
        PG8_WAIT_V(6); PG8_BAR;
    }
    for (;;) {
        const bool has_next = S.next(ui + 1, nxt);
        const char* nA = has_next ? (const char*)g.A + (size_t)nxt.pm * tstepA : cA; const char* nB = has_next ? (const char*)g.Bt + (size_t)nxt.pn * tstep : cB;
        for (int t = 0; t < nt; t += 2) {
            const bool last = (t == nt - 2);
            const char* a1 = cA + (size_t)(t + 1) * kstep;
            const char* a2 = last ? nA : cA + (size_t)(t + 2) * kstep; const char* b2 = last ? nB : cB + (size_t)(t + 2) * kstep;
            const char* a3 = a2 + kstep; const char* b3 = b2 + kstep;
            if (last && has_next) S.a_ready(nxt);
            if constexpr (SP2) {
            PG8_LDB(B0, 0, 0); PG8_LDB(B1, 0, 1); PG8_SCHED; PG8_LDA(At, 0, 0); PG8_STAGE(PG8_SA(1, 1), a1 + hstepA, voffA);
            PG8_WAIT_V(8); PG8_WAIT_L(0); PG8_BAR; PG8_MMA(0, 0, At, B0); PG8_MMA(0, 1, At, B1); PG8_BAR; PG8_SCHED;
            PG8_LDA(At, 0, 1); PG8_STAGE(PG8_SB(0, 0), b2, voffB); PG8_STAGE(PG8_SB(0, 1), b2 + hstep, voffB); PG8_STAGE(PG8_SA(0, 0), a2, voffA);
            PG8_WAIT_V(8); PG8_WAIT_L(0); PG8_BAR; PG8_MMA(1, 0, At, B0); PG8_MMA(1, 1, At, B1); PG8_BAR; PG8_SCHED;
            PG8_LDB(B0, 1, 0); PG8_LDB(B1, 1, 1); PG8_SCHED; PG8_LDA(At, 1, 0); PG8_STAGE(PG8_SA(0, 1), a2 + hstepA, voffA);
            PG8_WAIT_V(8); PG8_WAIT_L(0); PG8_BAR; PG8_MMA(0, 0, At, B0); PG8_MMA(0, 1, At, B1); PG8_BAR; PG8_SCHED;
            PG8_LDA(At, 1, 1); PG8_STAGE(PG8_SB(1, 0), b3, voffB); PG8_STAGE(PG8_SB(1, 1), b3 + hstep, voffB); PG8_STAGE(PG8_SA(1, 0), a3, voffA);
            PG8_WAIT_V(8); PG8_WAIT_L(0); PG8_BAR; PG8_MMA(1, 0, At, B0); PG8_MMA(1, 1, At, B1); PG8_BAR; PG8_SCHED;
            } else {
            PG8_LDB(B0, 0, 0); PG8_SCHED; PG8_LDA(At, 0, 0); PG8_STAGE(PG8_SA(1, 1), a1 + hstepA, voffA);
            PG8_WAIT_L(8); PG8_BAR; PG8_WAIT_L(0); PG8_MMA(0, 0, At, B0); PG8_BAR; PG8_SCHED;
            PG8_LDB(B1, 0, 1); PG8_STAGE(PG8_SB(0, 0), b2, voffB);
            PG8_BAR; PG8_WAIT_L(0); PG8_MMA(0, 1, At, B1); PG8_BAR;
            PG8_LDA(At, 0, 1); PG8_STAGE(PG8_SA(0, 0), a2, voffA);
            PG8_BAR; PG8_WAIT_L(0); PG8_MMA(1, 0, At, B0); PG8_BAR; PG8_SCHED;
            PG8_STAGE(PG8_SB(0, 1), b2 + hstep, voffB);
            PG8_WAIT_V(6); PG8_BAR; PG8_MMA(1, 1, At, B1); PG8_BAR;
            PG8_LDB(B0, 1, 0); PG8_SCHED; PG8_LDA(At, 1, 0); PG8_STAGE(PG8_SA(0, 1), a2 + hstepA, voffA);
            PG8_WAIT_L(8); PG8_BAR; PG8_WAIT_L(0); PG8_MMA(0, 0, At, B0); PG8_BAR; PG8_SCHED;
            PG8_LDB(B1, 1, 1); PG8_STAGE(PG8_SB(1, 0), b3, voffB);
            PG8_BAR; PG8_WAIT_L(0); PG8_MMA(0, 1, At, B1); PG8_BAR;
            PG8_LDA(At, 1, 1); PG8_STAGE(PG8_SA(1, 0), a3, voffA);
            PG8_BAR; PG8_WAIT_L(0); PG8_MMA(1, 0, At, B0); PG8_BAR; PG8_SCHED;
            PG8_STAGE(PG8_SB(1, 1), b3 + hstep, voffB);
            PG8_WAIT_V(6); PG8_BAR; PG8_MMA(1, 1, At, B1); PG8_BAR;
            }
        }
        if constexpr (ALIGN_EPI) { if (wr == 0) PG8_BAR; }
        if constexpr (!Epi::AFTER_DRAIN) { E(acc, cur, wr, wc, fr, fq); S.done(cur); }
        if (!has_next) break;
#pragma unroll
        for (int a = 0; a < 2; ++a)
#pragma unroll
            for (int b = 0; b < 2; ++b)
#pragma unroll
                for (int m = 0; m < 4; ++m)
#pragma unroll
                    for (int n = 0; n < 2; ++n) acc[a][b][m][n] = (f32x4){0.f, 0.f, 0.f, 0.f};
        cur = nxt; cA = nA; cB = nB; ++ui;
        if constexpr (ALIGN_EPI) { if (wr == 1) PG8_BAR; }
    }
    PG8_WAIT_V(0);
    if constexpr (!ALIGN_EPI) { if (wr == 0) PG8_BAR; }
    PG8_BAR;
    if constexpr (Epi::AFTER_DRAIN) { E.fused(acc, cur, wr, wc, fr, fq, lds, wid, lane); S.done(cur); }
#undef PG8_SA
#undef PG8_SB
#undef PG8_STAGE
#undef PG8_LDA
#undef PG8_LDB
#undef PG8_MMA
#undef PG8_WAIT_V
#undef PG8_WAIT_L
#undef PG8_BAR
#undef PG8_SCHED
}
}

#ifndef PG8_SP2
#define PG8_SP2 true
#endif
#ifndef PG8_ALIGN
#define PG8_ALIGN true
#endif
namespace att {
#define LAS3 __attribute__((address_space(3)))
using bf16x8 = __attribute__((ext_vector_type(8))) short;
using s16x4 = __attribute__((ext_vector_type(4))) short;
using f32x16 = __attribute__((ext_vector_type(16))) float;
using f32x4 = __attribute__((ext_vector_type(4))) float;
using u32x4 = __attribute__((ext_vector_type(4))) unsigned;
typedef unsigned short u16;
typedef LAS3 const unsigned char* lds_cptr;
typedef short v4i16_t __attribute__((ext_vector_type(4)));
constexpr int SEQ = 16384, NW = 8, QBLK = 32, QB = 256, KVBLK = 64;
constexpr int KSLOT = 12288, VSLOT = 8192, NKS = 4, NVS = 4;
constexpr int LDS_K = 0, LDS_V = NKS * KSLOT, LDS_WS = LDS_V + NVS * VSLOT, LDS_OST = LDS_WS + NW * 256, LDS_QX = LDS_OST + NW * 4096, LDS_BYTES = LDS_QX + NW * 2048;
__device__ __forceinline__ int crow(int r, int hi) { return (r & 3) + 8 * (r >> 2) + 4 * hi; }
__device__ __forceinline__ void glds16(const void* gsrc, unsigned lds_dst) { unsigned keep;
    asm volatile("s_mov_b32 %0, m0\n\ts_mov_b32 m0, %2\n\ts_nop 0\n\tglobal_load_lds_dwordx4 %1, off\n\ts_mov_b32 m0, %0" : "=&s"(keep) : "v"(gsrc), "s"(lds_dst) : "memory"); }
typedef float f32x2_t __attribute__((ext_vector_type(2))); typedef __bf16 bf16x2_t __attribute__((ext_vector_type(2)));
__device__ __forceinline__ unsigned cvtpk_s(float lo, float hi) { f32x2_t v = {lo, hi}; bf16x2_t b = __builtin_convertvector(v, bf16x2_t); return __builtin_bit_cast(unsigned, b); }
__device__ __forceinline__ s16x4 vtr(lds_cptr p) { return __builtin_bit_cast(s16x4, __builtin_amdgcn_ds_read_tr16_b64_v4i16((LAS3 v4i16_t*)p)); }
#define ATT_SBAR() __builtin_amdgcn_sched_barrier(0)
#define ATT_WAIT_BAR(N) asm volatile("s_waitcnt vmcnt(" #N ") lgkmcnt(0)\n\ts_barrier" ::: "memory")
struct Src {
    const u16* q; int qp;
    const u16* k; int kp;
    const u16* k2; int k2p;
    const u16* v; int vp;
    u16* o; int op;
};
template <int NDK, int NQR, bool ZC, int XHS, int JLO, int JHI, bool EARLY>
__device__ __forceinline__ void phase_a(f32x16& C0, f32x16& C1, const lds_cptr* kb_, int ksl_, const bf16x8* qr, lds_cptr qx_, const f32x16& negm, bf16x8* kf, bf16x8* qx) {
    constexpr int KPF = 4;
#define ATT_SH(s_) (EARLY ? ((s_) / NDK) : ((s_) & 1))
#define ATT_SD(s_) (EARLY ? ((s_) % NDK) : ((s_) >> 1))
#define ATT_KRD(s_) kf[s_] = *(const LAS3 bf16x8*)(kb_[ATT_SD(s_)] + ksl_ + ATT_SH(s_) * (ATT_SD(s_) < 4 ? 4096 : XHS))
    if (JLO == 0) {
#pragma unroll
        for (int j = 0; j < KPF; ++j) ATT_KRD(j); }
#pragma unroll
    for (int j = JLO; j < JHI; ++j) {
        if (j + KPF < 2 * NDK) ATT_KRD(j + KPF);
        { const int dn = ATT_SD(j) + 2; if (NDK > NQR && dn >= NQR && dn < NDK && (EARLY || ATT_SH(j) == 0)) qx[dn >= NQR ? dn - NQR : 0] = *(const LAS3 bf16x8*)(qx_ + (dn >= NQR ? dn - NQR : 0) * 1024); }
        ATT_SBAR();
        const int d0 = ATT_SD(j); const f32x16 z = f32x16{}; const bf16x8 qf = (d0 < NQR) ? qr[d0 < NQR ? d0 : 0] : qx[d0 >= NQR ? d0 - NQR : 0];
        if (ATT_SH(j)) C1 = __builtin_amdgcn_mfma_f32_32x32x16_bf16(kf[j], qf, (d0 == 0) ? (ZC ? z : negm) : C1, 0, 0, 0);
        else           C0 = __builtin_amdgcn_mfma_f32_32x32x16_bf16(kf[j], qf, (d0 == 0) ? (ZC ? z : negm) : C0, 0, 0, 0);
        if (EARLY && j > NDK) { const int e0 = 16 * (j - NDK - 1) / (NDK - 1), e1 = 16 * (j - NDK) / (NDK - 1);
#pragma unroll
            for (int e = e0; e < e1; ++e) C0[e] = __builtin_amdgcn_exp2f(C0[e]);
            asm volatile("" : "+v"(C0)); }
        ATT_SBAR();
    }
#undef ATT_KRD
#undef ATT_SH
#undef ATT_SD
}
template <bool QK, bool FIN, bool EARLY>
__device__ __forceinline__ void phase_b(f32x16& C0, f32x16& C1, f32x16* o, lds_cptr vp_, u32x4* pw, float& l_reg) {
    s16x4 vlo[8], vhi[8]; float sacc = 0.f, sacd = 0.f;
#define ATT_VRD(i) do { const int vi_ = ((i) >> 1) + 4 * ((i) & 1); vlo[i] = vtr(vp_ + ((vi_ >> 2) * 4096 + (vi_ & 3) * 1024)); vhi[i] = vtr(vp_ + ((vi_ >> 2) * 4096 + (vi_ & 3) * 1024 + 512)); } while (0)
    if (FIN) { ATT_VRD(0); ATT_VRD(1); }
#pragma unroll
    for (int i = 0; i < 8; ++i) {
        if (FIN && i + 2 < 8) ATT_VRD(i + 2);
        ATT_SBAR();
        if (FIN) { const bf16x8 vf = (bf16x8){vlo[i][0], vlo[i][1], vlo[i][2], vlo[i][3], vhi[i][0], vhi[i][1], vhi[i][2], vhi[i][3]};
            o[i & 1] = __builtin_amdgcn_mfma_f32_32x32x16_bf16(__builtin_bit_cast(bf16x8, pw[i >> 1]), vf, o[i & 1], 0, 0, 0); }
        if (QK) { f32x16& X = (i < 4) ? C0 : C1; const int b = 4 * (i & 3);
            if (EARLY) { C1[2 * i] = __builtin_amdgcn_exp2f(C1[2 * i]); C1[2 * i + 1] = __builtin_amdgcn_exp2f(C1[2 * i + 1]); asm volatile("" : "+v"(C1)); }
            else { X[b] = __builtin_amdgcn_exp2f(X[b]); X[b + 1] = __builtin_amdgcn_exp2f(X[b + 1]); X[b + 2] = __builtin_amdgcn_exp2f(X[b + 2]); X[b + 3] = __builtin_amdgcn_exp2f(X[b + 3]); }
            sacc += X[b]; sacd += X[b + 1]; sacc += X[b + 2]; sacd += X[b + 3]; asm volatile("" : "+v"(sacc), "+v"(sacd));
            if (i & 1) { const int k = i >> 1, c = 8 * (k & 1);
                pw[k] = (u32x4){cvtpk_s(X[c], X[c + 1]), cvtpk_s(X[c + 2], X[c + 3]), cvtpk_s(X[c + 4], X[c + 5]), cvtpk_s(X[c + 6], X[c + 7])}; asm volatile("" : "+v"(pw[k])); } }
        ATT_SBAR();
    }
#undef ATT_VRD
    if (QK) l_reg += sacc + sacd;
}
template <bool MLA, bool FIX> __device__ __forceinline__ void attn_unit(int qb, const Src& s, LAS3 unsigned char* shm, const float* bias_h, float kmax2, const float* qmax_h) {
    constexpr int NDK = MLA ? 6 : 5, NX = MLA ? 4 : 1, NQR = MLA ? 4 : 5;
    constexpr float THRL = MLA ? 8.0f : 16.0f;
    const int tid = threadIdx.x, lane = tid & 63, r32 = lane & 31, hi = lane >> 5; const int wid = __builtin_amdgcn_readfirstlane(tid >> 6);
    const int q0 = qb * QB;
    const unsigned lds0 = (unsigned)(uintptr_t)shm;
    LAS3 float* wsf = (LAS3 float*)(shm + LDS_WS) + wid * 64;
    const int NT = (q0 + QB) / KVBLK;
    const int wvis = NT - 4 + (wid >> 1);
    const bool xw = wid < NX;
    const int krow = 8 * wid + (lane >> 3);
    const u16* ksrc = s.k + (size_t)krow * s.kp + (((lane & 7) ^ ((krow >> 1) & 7)) * 8);
    const int k2row = 16 * (wid & 3) + (lane >> 2);
    const u16* k2src = MLA ? s.k2 + (size_t)k2row * s.k2p + (((lane & 3) ^ ((k2row >> 2) & 3)) * 8) : s.k2 + (size_t)lane * s.k2p;
    const u16* vsrc = s.v + (size_t)(16 * (wid & 3) + (lane >> 2)) * s.vp + (wid >> 2) * 32 + (lane & 3) * 8;
    const unsigned kdst = lds0 + LDS_K + wid * 1024, k2dst = lds0 + LDS_K + (8 + (wid & 3)) * 1024, vdst = lds0 + LDS_V + wid * 1024;
#define ATT_DMA_K(t) do { const int sl_ = (t) & 3; glds16(ksrc + (size_t)(t) * KVBLK * s.kp, (unsigned)__builtin_amdgcn_readfirstlane(kdst + sl_ * KSLOT)); \
        if (xw) glds16(k2src + (size_t)(t) * KVBLK * s.k2p, (unsigned)__builtin_amdgcn_readfirstlane(k2dst + sl_ * KSLOT)); } while (0)
#define ATT_DMA_V(t, vsl) glds16(vsrc + (size_t)(t) * KVBLK * s.vp, (unsigned)__builtin_amdgcn_readfirstlane(vdst + (vsl)))
    if (!MLA) {
        if (tid < 256) { const int sl = tid >> 6; *(LAS3 f32x4*)(shm + LDS_K + sl * KSLOT + 9 * 1024 + (tid & 63) * 16) = (f32x4){0.f, 0.f, 0.f, 0.f}; } }
    if (MLA) { ATT_DMA_K(0); ATT_DMA_V(0, 0); ATT_DMA_K(1); ATT_DMA_K(2); }
    const u16* Qw = s.q + (size_t)(q0 + wid * QBLK + r32) * s.qp + hi * 8;
    bf16x8 qr[NQR];
#pragma unroll
    for (int d0 = 0; d0 < 4; ++d0) qr[d0] = *reinterpret_cast<const bf16x8*>(Qw + d0 * 16);
    const lds_cptr qx0 = (lds_cptr)shm + LDS_QX + wid * 2048 + lane * 16;
    float mla_ref = 0.f;
    if (MLA) { const bf16x8 q4 = *reinterpret_cast<const bf16x8*>(Qw + 64), q5 = *reinterpret_cast<const bf16x8*>(Qw + 80);
        *(LAS3 bf16x8*)(shm + LDS_QX + wid * 2048 + lane * 16) = q4; *(LAS3 bf16x8*)(shm + LDS_QX + wid * 2048 + 1024 + lane * 16) = q5;
        if (FIX) { float nq = 0.f;
#pragma unroll
            for (int e = 0; e < 8; ++e) { const float a = __uint_as_float((unsigned)(unsigned short)q4[e] << 16), b = __uint_as_float((unsigned)(unsigned short)q5[e] << 16); nq += a * a + b * b; }
#pragma unroll
            for (int d0 = 0; d0 < 4; ++d0)
#pragma unroll
                for (int e = 0; e < 8; ++e) { const float a = __uint_as_float((unsigned)(unsigned short)qr[d0][e] << 16); nq += a * a; }
            nq += __shfl_xor(nq, 32); mla_ref = sqrtf(nq * kmax2); } }
    const short one = hi ? (short)0 : (short)0x3F80;
    if (!MLA) qr[NQR - 1] = (bf16x8){one, one, one, 0, 0, 0, 0, 0};
    int t0 = 0;
    if (!MLA) {
        const float qm = qmax_h[qb];
        const float bunit = sqrtf(qm * kmax2);
        const float thr = FIX ? bias_h[q0] - 152.f : bias_h[q0] - 170.f - 2.f * bunit;
        if (FIX) { const float nm_ = -(bias_h[q0 + wid * QBLK + r32] + bunit); const unsigned h_ = cvtpk_s(nm_, 0.f) & 0xffffu; const float r1_ = nm_ - __uint_as_float(h_ << 16); const unsigned m_ = cvtpk_s(r1_, 0.f) & 0xffffu;
            const float r2_ = r1_ - __uint_as_float(m_ << 16); const unsigned l_ = cvtpk_s(r2_, 0.f) & 0xffffu;
            if (hi == 0) qr[NQR - 1] = (bf16x8){one, one, one, (short)h_, (short)m_, (short)l_, 0, 0}; }
        int best = 0;
        for (int tt = 1 + lane; tt <= NT - 4; tt += 64) { if (bias_h[64 * tt - 1] < thr) best = tt; }
#pragma unroll
        for (int o_ = 32; o_ >= 1; o_ >>= 1) best = max(best, __shfl_xor(best, o_));
        t0 = __builtin_amdgcn_readfirstlane(best);
    }
    if (!MLA) { ATT_DMA_K(t0); ATT_DMA_V(t0, (t0 & 3) * VSLOT); ATT_DMA_K(t0 + 1); ATT_DMA_K(t0 + 2); }
    float mhat = 0.f, l_reg = 0.f; f32x16 o[2]; o[0] = f32x16{}; o[1] = f32x16{}; f32x16 negm = f32x16{};
    if (MLA && FIX) {
#pragma unroll
        for (int r = 0; r < 16; ++r) negm[r] = -mla_ref; }
    const int qrel = wid * QBLK + r32;
    lds_cptr kb[NDK];
#pragma unroll
    for (int d0 = 0; d0 < 4; ++d0) kb[d0] = (lds_cptr)shm + LDS_K + r32 * 128 + ((((2 * d0 + hi) ^ ((r32 >> 1) & 7))) << 4);
    if (MLA) {
#pragma unroll
        for (int d0 = 4; d0 < NDK; ++d0) kb[d0] = (lds_cptr)shm + LDS_K + 8192 + r32 * 64 + ((((2 * (d0 - 4) + hi) ^ ((r32 >> 2) & 3))) << 4);
    } else kb[NDK - 1] = (lds_cptr)shm + LDS_K + 8192 + hi * 1024 + r32 * 16;
    constexpr int XHS = MLA ? 2048 : 512;
    const lds_cptr vp0 = (lds_cptr)shm + LDS_V + ((lane >> 4) & 1) * 32 + (lane & 3) * 8 + (4 * hi + ((lane & 15) >> 2)) * 64;
    f32x16 C0, C1; u32x4 pw[4]; bool resc = false;
#define ATT_TOP(t) do { if ((t) == t0 || (t) + 2 >= NT) { ATT_WAIT_BAR(0); } else if (xw) { ATT_WAIT_BAR(3); } else { ATT_WAIT_BAR(2); } \
        } while (0)
#define ATT_ISSUE(t) do { if ((t) + 3 < NT) ATT_DMA_K((t) + 3); if ((t) + 1 < NT) ATT_DMA_V((t) + 1, (((t) + 1) & 3) * VSLOT); } while (0)
#ifdef ATT_QKPRIO
#define ATT_PRIO_ON() __builtin_amdgcn_s_setprio(1)
#define ATT_PRIO_OFF() __builtin_amdgcn_s_setprio(0)
#else
#define ATT_PRIO_ON()
#define ATT_PRIO_OFF()
#endif
#define ATT_QK(t, E) do { bf16x8 kf_[2 * NDK]; bf16x8 qx_[NDK > NQR ? NDK - NQR : 1]; \
        phase_a<NDK, NQR, !MLA, XHS, 0, 4, E>(C0, C1, ATT_KS(t), qr, qx0, negm, kf_, qx_); ATT_ISSUE(t); ATT_SBAR(); \
        phase_a<NDK, NQR, !MLA, XHS, 4, 2 * NDK, E>(C0, C1, ATT_KS(t), qr, qx0, negm, kf_, qx_); } while (0)
#define ATT_MASK(C0, C1, t) do { const int kbq_ = 64 * ((t) - (NT - 4)) + 4 * hi; \
        _Pragma("unroll") for (int r = 0; r < 16; ++r) { const int kv_ = kbq_ + (r & 3) + 8 * (r >> 2); if (kv_ > qrel) C0[r] = -INFINITY; if (kv_ + 32 > qrel) C1[r] = -INFINITY; } } while (0)
#define ATT_DECIDE(C0, C1, FIRST) do { if (!FIX) { \
        float a_ = fmaxf(fmaxf(C0[0], C0[1]), C1[0]), b_ = fmaxf(fmaxf(C0[2], C0[3]), C1[1]); a_ = fmaxf(fmaxf(a_, C1[2]), C1[3]); \
        _Pragma("unroll") for (int r = 4; r < 16; r += 4) { a_ = fmaxf(fmaxf(a_, C0[r]), C0[r + 1]); b_ = fmaxf(fmaxf(b_, C0[r + 2]), C0[r + 3]); a_ = fmaxf(fmaxf(a_, C1[r]), C1[r + 1]); b_ = fmaxf(fmaxf(b_, C1[r + 2]), C1[r + 3]); } \
        float rm_ = fmaxf(a_, b_); { auto rr_ = __builtin_amdgcn_permlane32_swap(__float_as_uint(rm_), __float_as_uint(rm_), false, false); rm_ = fmaxf(__uint_as_float(rr_[0]), __uint_as_float(rr_[1])); } \
        resc = false; \
        if ((FIRST) || __any(rm_ > THRL)) { float dl_ = (FIRST) ? rm_ : fmaxf(rm_, 0.f); \
            if (!MLA) { const float nm_ = -(mhat + dl_); const unsigned h_ = cvtpk_s(nm_, 0.f) & 0xffffu; const float r1_ = nm_ - __uint_as_float(h_ << 16); const unsigned m_ = cvtpk_s(r1_, 0.f) & 0xffffu; \
                const float r2_ = r1_ - __uint_as_float(m_ << 16); const unsigned l_ = cvtpk_s(r2_, 0.f) & 0xffffu; \
                const float mn_ = -((__uint_as_float(h_ << 16) + __uint_as_float(m_ << 16)) + __uint_as_float(l_ << 16)); dl_ = mn_ - mhat; mhat = mn_; \
                if (hi == 0) qr[NQR - 1] = (bf16x8){one, one, one, (short)h_, (short)m_, (short)l_, 0, 0}; } \
            else { mhat += dl_; _Pragma("unroll") for (int r = 0; r < 16; ++r) negm[r] = -mhat; } \
            _Pragma("unroll") for (int r = 0; r < 16; ++r) { C0[r] -= dl_; C1[r] -= dl_; } \
            if (!(FIRST)) { const float f_ = __builtin_amdgcn_exp2f(-dl_); l_reg *= f_; if (hi == 0) wsf[r32] = f_; resc = true; } } } } while (0)
#define ATT_RESC() do { if (!FIX && resc) { \
        _Pragma("unroll") for (int i = 0; i < 4; ++i) { const f32x4 fv_ = *(const LAS3 f32x4*)(wsf + 8 * i + 4 * hi); \
            _Pragma("unroll") for (int d = 0; d < 2; ++d) { o[d][4 * i] *= fv_[0]; o[d][4 * i + 1] *= fv_[1]; o[d][4 * i + 2] *= fv_[2]; o[d][4 * i + 3] *= fv_[3]; } } } } while (0)
#define ATT_VS(tt) (vp0 + (((tt)) & 3) * VSLOT)
#define ATT_KS(tt) kb, ((((tt)) & 3) * KSLOT)
#ifndef ATT_STAGGER
#define ATT_STAGGER 0
#endif
    if (!ATT_STAGGER || wid < 4) {
#define ATT_STEP(t, MASKED) do { ATT_TOP(t); \
        constexpr bool E_ = FIX && (MLA || !(MASKED)); \
        ATT_QK(t, E_); \
        if (!MLA && (MASKED)) ATT_MASK(C0, C1, t); \
        ATT_DECIDE(C0, C1, false); ATT_SBAR(); \
        phase_b<true, true, E_>(C0, C1, o, ATT_VS((t) - 1), pw, l_reg); \
        ATT_RESC(); } while (0)
        ATT_TOP(t0);
        ATT_QK(t0, false);
        if (!MLA && wvis == t0) ATT_MASK(C0, C1, t0);
        ATT_DECIDE(C0, C1, true); ATT_SBAR();
        phase_b<true, false, false>(C0, C1, o, vp0, pw, l_reg);
        int t = t0 + 1;
        for (; t < wvis; ++t) ATT_STEP(t, false);
        if (t == wvis) { ATT_STEP(t, true); ++t; }
        { ATT_TOP(t); ATT_ISSUE(t); phase_b<false, true, false>(C0, C1, o, ATT_VS(t - 1), pw, l_reg); ++t; }
        for (; t <= NT + ATT_STAGGER; ++t) { ATT_TOP(t); ATT_ISSUE(t); }
#undef ATT_STEP
    } else {
        ATT_TOP(t0);
        ATT_QK(t0, false);
        ATT_DECIDE(C0, C1, true); ATT_SBAR();
        ATT_TOP(t0 + 1);
        phase_b<true, false, false>(C0, C1, o, vp0, pw, l_reg); ATT_SBAR();
        ATT_QK(t0 + 1, false);
        ATT_DECIDE(C0, C1, false); ATT_SBAR();
        int t = t0 + 2;
#define ATT_STEP2(t, MASKED) do { ATT_TOP(t); \
        phase_b<true, true, false>(C0, C1, o, ATT_VS((t) - 2), pw, l_reg); \
        ATT_RESC(); ATT_SBAR(); \
        ATT_QK(t, false); \
        if (!MLA && (MASKED)) ATT_MASK(C0, C1, t); \
        ATT_DECIDE(C0, C1, false); ATT_SBAR(); } while (0)
        for (; t < wvis; ++t) ATT_STEP2(t, false);
        ATT_STEP2(t, true); ++t;
        { ATT_TOP(t); ATT_ISSUE(t); phase_b<true, true, false>(C0, C1, o, ATT_VS(t - 2), pw, l_reg); ATT_RESC(); ++t; }
        { ATT_TOP(t); ATT_ISSUE(t); phase_b<false, true, false>(C0, C1, o, ATT_VS(t - 2), pw, l_reg); ++t; }
        for (; t <= NT + ATT_STAGGER; ++t) { ATT_TOP(t); ATT_ISSUE(t); }
#undef ATT_STEP2
    }
    { auto rr = __builtin_amdgcn_permlane32_swap(__float_as_uint(l_reg), __float_as_uint(l_reg), false, false); l_reg = __uint_as_float(rr[0]) + __uint_as_float(rr[1]); }
    if (hi == 0) wsf[32 + r32] = 1.0f / l_reg;
    float rli[16];
#pragma unroll
    for (int i = 0; i < 4; ++i) { const f32x4 fv = *(const LAS3 f32x4*)(wsf + 32 + 8 * i + 4 * hi); rli[4 * i] = fv[0]; rli[4 * i + 1] = fv[1]; rli[4 * i + 2] = fv[2]; rli[4 * i + 3] = fv[3]; }
    u16* Ow = s.o + (size_t)(q0 + wid * QBLK) * s.op;
    { LAS3 u16* stg = (LAS3 u16*)(shm + LDS_OST) + wid * 2048;
#pragma unroll
        for (int r = 0; r < 16; ++r) { const int orow = crow(r, hi);
#pragma unroll
            for (int d0 = 0; d0 < 2; ++d0) stg[orow * 64 + d0 * 32 + r32] = (u16)(cvtpk_s(o[d0][r] * rli[r], 0.f) & 0xffffu); }
        asm volatile("s_waitcnt lgkmcnt(0)" ::: "memory");
#pragma unroll
        for (int i = 0; i < 4; ++i) { const int row = i * 8 + (lane >> 3), ch = lane & 7; const u32x4 v = *(const LAS3 u32x4*)(stg + row * 64 + ch * 8); *(u32x4*)(Ow + (size_t)row * s.op + ch * 8) = v; } }
    asm volatile("s_waitcnt lgkmcnt(0)\n\ts_barrier" ::: "memory");
#undef ATT_DMA_K
#undef ATT_DMA_V
#undef ATT_TOP
#undef ATT_ISSUE
#undef ATT_QK
#undef ATT_MASK
#undef ATT_DECIDE
#undef ATT_RESC
#undef ATT_STEP
}
}

namespace cg = cooperative_groups;
#define LAS __attribute__((address_space(3)))
typedef unsigned short bf16;
typedef unsigned v4u __attribute__((ext_vector_type(4)));
typedef unsigned v2u __attribute__((ext_vector_type(2)));
typedef float f32x4 __attribute__((ext_vector_type(4)));
constexpr int NWAVES = 8;
constexpr int M = 16384, D = 1024, FF = 4096, NIN = 1960, NINP = 2048, QL = 256, KVL = 128, NQU = 768, NKVU = 1024;
constexpr float EPS = 1e-6f;
constexpr float LOG2E = 1.4426950408889634f;
constexpr float C2_FOX = 0.125f * LOG2E, C2_MLA = 0.10206207261596575f * LOG2E;
constexpr size_t MiB = 1u << 20;
constexpr size_t WS_WIN = 1 * MiB, WS_WQ = 5 * MiB, WS_WKV = 5 * MiB + 512 * 1024, WS_WO = 6 * MiB, WS_W1 = 8 * MiB, WS_W2 = 16 * MiB;
constexpr size_t WS_RT = 24 * MiB, WS_LF = 26 * MiB, WS_LC = 26 * MiB + 512 * 1024, WS_SS = 27 * MiB, WS_KR = 28 * MiB, WS_KB = 29 * MiB, WS_SSQ = 31 * MiB, WS_SSKV = 31 * MiB + 512 * 1024, WS_BIASF = 28 * MiB;
constexpr size_t WS_XN = 32 * MiB, WS_H = 64 * MiB, WS_P = 64 * MiB, WS_QM = 128 * MiB, WS_KVM = 152 * MiB, WS_QN = 184 * MiB, WS_O = 192 * MiB, WS_KVN = 224 * MiB, WS_END = 228 * MiB;
constexpr int RING_BYTES = 131072, LDS_BYTES = 147456;
static_assert(att::LDS_BYTES <= LDS_BYTES, "attention scratch fits the LDS allocation");

__device__ __forceinline__ unsigned f2bf(float f) { unsigned u = __builtin_bit_cast(unsigned, f); return (u + 0x7fffu + ((u >> 16) & 1u)) >> 16; }
__device__ __forceinline__ unsigned pk2(float lo, float hi) { return f2bf(lo) | (f2bf(hi) << 16); }
__device__ __forceinline__ float bf2f(unsigned short h) { return __builtin_bit_cast(float, (unsigned)h << 16); }
__device__ __forceinline__ float wave_sum(float v) {
#pragma unroll
    for (int o = 1; o < 64; o <<= 1) v += __shfl_xor(v, o);
    return v;
}
__device__ __forceinline__ int map_row(int mode, int n) {
    if (mode == 1) { const int h = n / 96, d = n % 96; if (d < 64) return n; const int i = d - 64; return h * 96 + (i < 16 ? 64 + 2 * i : 64 + 2 * (i - 16) + 1); }
    if (mode == 2) { const int h = n >> 7, j = n & 127; return j < 64 ? h * 64 + j : 512 + h * 64 + (j - 64); }
    if (mode == 3) { if (n < 1536 || n >= 1960) return n; if (n < 1544) return 1952 + (n - 1536); if (n < 1800) return 1536 + (n - 1544); if (n < 1928) return 1792 + (n - 1800);
        const int i = n - 1928; return 1920 + (i < 16 ? 2 * i : 2 * (i - 16) + 1); }
    return n;
}
__device__ __forceinline__ void p0_transpose_item(const float* W, int K, int N, int nblk, bf16* WT, int mode, const float* gk, LAS float* scr, int item, int lane) {
    const int kb = item / nblk, nb = item % nblk, k0 = 64 * kb, n0 = 32 * nb;
    const int nn = n0 + (lane & 31);
    float wv[32];
#pragma unroll
    for (int i = 0; i < 32; ++i) { const int kk = 2 * i + (lane >> 5); wv[i] = (nn < N) ? W[(size_t)(k0 + kk) * N + nn] : 0.f; }
    if (gk) {
#pragma unroll
        for (int i = 0; i < 32; ++i) wv[i] *= gk[k0 + 2 * i + (lane >> 5)]; }
#pragma unroll
    for (int i = 0; i < 32; ++i) { const int kk = 2 * i + (lane >> 5); scr[kk * 33 + (lane & 31)] = wv[i]; }
    asm volatile("s_waitcnt lgkmcnt(0)" ::: "memory");
    const int c = lane & 7;
#pragma unroll
    for (int j = 0; j < 4; ++j) { const int n = (lane >> 3) + 8 * j; const LAS float* sp = scr + (8 * c) * 33 + n;
        v4u o; o.x = pk2(sp[0 * 33], sp[1 * 33]); o.y = pk2(sp[2 * 33], sp[3 * 33]); o.z = pk2(sp[4 * 33], sp[5 * 33]); o.w = pk2(sp[6 * 33], sp[7 * 33]);
        *(v4u*)(WT + (size_t)map_row(mode, n0 + n) * K + k0 + 8 * c) = o; }
    asm volatile("s_waitcnt lgkmcnt(0)" ::: "memory");
}
__device__ __forceinline__ void sincos_d(double x, float& sn, float& cs) {
    const double k = rint(x * 0.63661977236758134308);
    double r = fma(-k, 1.57079632679489655800e+00, x); r = fma(-k, 6.12323399573676603587e-17, r);
    const double r2 = r * r;
    double s = -1.0 / 6227020800.0; s = s * r2 + 1.0 / 39916800.0; s = s * r2 - 1.0 / 362880.0; s = s * r2 + 1.0 / 5040.0; s = s * r2 - 1.0 / 120.0; s = s * r2 + 1.0 / 6.0; s = r - r * r2 * s;
    double c = 1.0 / 479001600.0; c = c * r2 - 1.0 / 3628800.0; c = c * r2 + 1.0 / 40320.0; c = c * r2 - 1.0 / 720.0; c = c * r2 + 1.0 / 24.0; c = c * r2 - 0.5; c = 1.0 + r2 * c;
    const int q = ((int)k) & 3;
    const double ss = (q == 0) ? s : (q == 1) ? c : (q == 2) ? -s : -c;
    const double cc = (q == 0) ? c : (q == 1) ? -s : (q == 2) ? -c : s;
    sn = (float)ss; cs = (float)cc;
}

#define RLX_AGENT __ATOMIC_RELAXED, __HIP_MEMORY_SCOPE_AGENT
#define XB_TMO      128
#define XB_XCNT(j)  (256  + 64 * (j))
#define XB_XSUB(j)  (1280 + 64 * (j))
#define XB_XGEN(j)  (2304 + 64 * (j))
#define XB_TOP      3328
#define XB_TOPGEN   3392
#define XCD_BAR_WORDS 3456
#define XB_SPIN_CAP (1u << 18)

__device__ __forceinline__ unsigned xb_ld(unsigned* p)              { return __hip_atomic_load(p, __ATOMIC_RELAXED, __HIP_MEMORY_SCOPE_AGENT); }
__device__ __forceinline__ unsigned xb_add(unsigned* p, unsigned v) { return __hip_atomic_fetch_add(p, v, __ATOMIC_RELAXED, __HIP_MEMORY_SCOPE_AGENT); }
__device__ __forceinline__ unsigned xb_xcc_id() { return (unsigned)__builtin_amdgcn_s_getreg((3 << 11) | 20) & 0xFu; }
#define XB_SPIN(cond, bar) do { unsigned _sp = 0; while (cond) { __builtin_amdgcn_s_sleep(1); \
    if ((++_sp & 255u) == 0u) { if (xb_ld(&(bar)[XB_TMO])) break; if (_sp > XB_SPIN_CAP) { atomicAdd(&(bar)[XB_TMO], 1u); break; } } } } while (0)

struct XcdBarrier {
    unsigned* bar; unsigned x;
    volatile LAS unsigned* st;
};

__device__ __forceinline__ XcdBarrier xcd_barrier_post(unsigned* bar, volatile LAS unsigned* st) {
    XcdBarrier b; b.bar = bar; b.x = xb_xcc_id(); b.st = st;
    if (threadIdx.x == 0) (void)xb_add(&bar[XB_XCNT(b.x)], 1u);
    return b;
}
__device__ __forceinline__ void xcd_barrier_complete(unsigned* bar, unsigned x, unsigned& nloc, unsigned& nx) {
    const unsigned G = gridDim.x * gridDim.y * gridDim.z;
    unsigned sum, cnt, mine, sp = 0u;
    for (;;) {
        sum = 0u; cnt = 0u; mine = 0u;
#pragma unroll
        for (unsigned j = 0; j < 16; ++j) { const unsigned c = xb_ld(&bar[XB_XCNT(j)]); sum += c; cnt += (c > 0u) ? 1u : 0u; mine = (j == x) ? c : mine; }
        if (sum == G) break;
        __builtin_amdgcn_s_sleep(1);
        if ((++sp & 255u) == 0u) { if (xb_ld(&bar[XB_TMO])) break; if (sp > XB_SPIN_CAP) { atomicAdd(&bar[XB_TMO], 1u); break; } }
    }
    nloc = mine > 0u ? mine : 1u; nx = cnt > 0u ? cnt : 1u;
}

__device__ __forceinline__ void xcd_barrier(const XcdBarrier& b) {
    asm volatile("s_waitcnt vmcnt(0)" ::: "memory");
    __syncthreads();
    if (threadIdx.x == 0) {
        unsigned* bar = b.bar;
        __builtin_amdgcn_s_waitcnt(0);
        unsigned nloc = b.st[0], nx = b.st[1];
        if (nloc == 0u) { xcd_barrier_complete(bar, b.x, nloc, nx); b.st[0] = nloc; b.st[1] = nx; }
        const unsigned old = xb_add(&bar[XB_XSUB(b.x)], 1u);
        const unsigned gen = old / nloc;
        if (old + 1u == (gen + 1u) * nloc) {
            __builtin_amdgcn_fence(__ATOMIC_RELEASE, "agent");
            asm volatile("s_waitcnt vmcnt(0)" ::: "memory");
            const unsigned og = xb_add(&bar[XB_TOP], 1u);
            const unsigned tg = og / nx;
            if (og + 1u == (tg + 1u) * nx) xb_add(&bar[XB_TOPGEN], 1u);
            else XB_SPIN(xb_ld(&bar[XB_TOPGEN]) == tg, bar);
            __builtin_amdgcn_fence(__ATOMIC_ACQUIRE, "agent");
            xb_add(&bar[XB_XGEN(b.x)], 1u);
            asm volatile("s_waitcnt vmcnt(0)" ::: "memory");
        } else {
            XB_SPIN(xb_ld(&bar[XB_XGEN(b.x)]) == gen, bar);
            __builtin_amdgcn_fence(__ATOMIC_ACQUIRE, "agent");
            asm volatile("s_waitcnt vmcnt(0)" ::: "memory");
        }
    }
    __syncthreads();
}

constexpr int MISC_OFF = LDS_BYTES - 128;
constexpr size_t WS_CTL = 0, CTL_ZERO_BYTES = 64 * 1024;
constexpr int CW_KMAX = 8192, CW_QF = 8192 + 512, CW_QM = 8192 + 1024, CW_PCNT = 8192 + 1536, CW_KMAXM = 13824, CW_QMAXM = 14400, CW_DONE = 14464;
static_assert(att::LDS_BYTES <= MISC_OFF, "LDS map");
struct Args { const float* in[13]; float* out; unsigned char* ws; int ph_lo, ph_hi, dup, pad; };
constexpr int NPHASE = 8;

__global__ void __launch_bounds__(NWAVES * 64, 2) mk_fwd(Args args) {
    extern __shared__ __attribute__((aligned(16))) unsigned char lds_raw[];
    LAS unsigned char* lds = (LAS unsigned char*)lds_raw;
    const int G = gridDim.x, bx = blockIdx.x;
#define MK_IDS int tid = threadIdx.x; asm volatile("" : "+v"(tid)); const int lane = tid & 63, wave = __builtin_amdgcn_readfirstlane(tid >> 6); const int gw = vcu * NWAVES + wave; (void)gw; (void)lane;
    const int vcu = (G % 8 == 0) ? (bx % 8) * (G / 8) + bx / 8 : bx;
    const int NGW = G * NWAVES;
    unsigned char* ws = args.ws;
#define MKP_x ((const float*)args.in[0])
#define MKP_g_mix ((const float*)args.in[1])
#define MKP_w_in ((const float*)args.in[2])
#define MKP_b_f ((const float*)args.in[3])
#define MKP_g_q ((const float*)args.in[4])
#define MKP_w_q_up ((const float*)args.in[5])
#define MKP_g_kv ((const float*)args.in[6])
#define MKP_w_kv_up ((const float*)args.in[7])
#define MKP_w_o ((const float*)args.in[8])
#define MKP_g_mlp ((const float*)args.in[9])
#define MKP_w_ff1 ((const float*)args.in[10])
#define MKP_w_ff2 ((const float*)args.in[11])
#define MKP_g_final ((const float*)args.in[12])
#define MKP_out (args.out)
#define MKP_Win_t ((bf16*)(args.ws + WS_WIN))
#define MKP_Wq_t ((bf16*)(args.ws + WS_WQ))
#define MKP_Wkv_t ((bf16*)(args.ws + WS_WKV))
#define MKP_Wo_t ((bf16*)(args.ws + WS_WO))
#define MKP_W1_t ((bf16*)(args.ws + WS_W1))
#define MKP_W2_t ((bf16*)(args.ws + WS_W2))
#define MKP_RT ((float*)(args.ws + WS_RT))
#define MKP_LF ((float*)(args.ws + WS_LF))
#define MKP_SS ((float*)(args.ws + WS_SS))
#define MKP_SSQ ((float*)(args.ws + WS_SSQ))
#define MKP_BIASF ((float*)(args.ws + WS_BIASF))
#define MKP_QMAX ((float*)(args.ws + WS_LC))
#define MKP_SSKV ((float*)(args.ws + WS_SSKV))
#define MKP_KB ((bf16*)(args.ws + WS_KB))
#define MKP_KR ((bf16*)(args.ws + WS_KR))
#define MKP_XN ((bf16*)(args.ws + WS_XN))
#define MKP_HB ((bf16*)(args.ws + WS_H))
#define MKP_P ((bf16*)(args.ws + WS_P))
#define MKP_QM ((bf16*)(args.ws + WS_QM))
#define MKP_KVM ((bf16*)(args.ws + WS_KVM))
#define MKP_QN ((bf16*)(args.ws + WS_QN))
#define MKP_OB ((bf16*)(args.ws + WS_O))
#define MKP_KVN ((bf16*)(args.ws + WS_KVN))
    const int lo = args.ph_lo, hi = args.ph_hi;
#ifndef MK_MASK
#define MK_MASK 0x1ff
#endif
#define IN(k) (((MK_MASK >> (k)) & 1) && lo <= (k) && (k) < hi)
#define REP(k) for (int rep_ = 0; rep_ < ((args.dup == (k)) ? 2 : 1); ++rep_)
    { volatile LAS unsigned* misc = (volatile LAS unsigned*)(lds + MISC_OFF); if (threadIdx.x < 32) misc[threadIdx.x] = 0u; }
    __syncthreads();
    (void)xcd_barrier_post((unsigned*)(ws + WS_CTL), (volatile LAS unsigned*)(lds + MISC_OFF) + 8);
    if (args.ph_lo < 0) cg::this_grid().sync();
#ifdef TS_PHASE
    unsigned long long ts_a_ = 0, ts_b_ = 0;
#define TS_BEGIN(k) do { if ((k) == TS_PHASE || (TS_PHASE == 99 && (k) == 0)) ts_a_ = __builtin_amdgcn_s_memrealtime(); } while (0)
#define TS_END(k) do { if ((k) == TS_PHASE || (TS_PHASE == 99 && (k) == 7)) ts_b_ = __builtin_amdgcn_s_memrealtime(); } while (0)
#else
#define TS_BEGIN(k)
#define TS_END(k)
#endif
#define SEAM(k) do { if (IN(k) && IN((k) + 1)) { XcdBarrier b_; b_.bar = (unsigned*)(args.ws + WS_CTL); b_.x = xb_xcc_id(); b_.st = (volatile LAS unsigned*)(lds + MISC_OFF) + 8; xcd_barrier(b_); } } while (0)

    TS_BEGIN(0);
    if (IN(0)) { MK_IDS
        LAS float* scr = (LAS float*)(lds + wave * 16384);
        constexpr int I_IN = (D / 64) * (NINP / 32), I_Q = (QL / 64) * (NQU / 32), I_KV = (KVL / 64) * (NKVU / 32), I_O = (D / 64) * (D / 32), I_1 = (D / 64) * (FF / 32), I_2 = (FF / 64) * (D / 32);
        constexpr int NITEMS = I_IN + I_Q + I_KV;
        (void)I_O; (void)I_1; (void)I_2;
        for (int it = gw; it < NITEMS; it += NGW) {
            int r = it;
            if (r < I_IN) { p0_transpose_item(MKP_w_in, D, NIN, NINP / 32, MKP_Win_t, 3, nullptr, scr, r, lane); continue; } r -= I_IN;
            if (r < I_Q) { p0_transpose_item(MKP_w_q_up, QL, NQU, NQU / 32, MKP_Wq_t, 1, MKP_g_q, scr, r, lane); continue; } r -= I_Q;
            p0_transpose_item(MKP_w_kv_up, KVL, NKVU, NKVU / 32, MKP_Wkv_t, 2, MKP_g_kv, scr, r, lane);
        }
        for (int m0 = gw; m0 < M; m0 += 4 * NGW) {
            const f32x4* gr = (const f32x4*)MKP_g_mix + lane; f32x4 v[4][4]; float s2[4];
#pragma unroll
            for (int r = 0; r < 4; ++r) { const int m = m0 + r * NGW; const f32x4* xr = (const f32x4*)(MKP_x + (size_t)(m < M ? m : 0) * D) + lane;
#pragma unroll
                for (int j = 0; j < 4; ++j) v[r][j] = xr[64 * j]; }
#pragma unroll
            for (int r = 0; r < 4; ++r) { s2[r] = 0.f;
#pragma unroll
                for (int j = 0; j < 4; ++j) s2[r] += (v[r][j].x * v[r][j].x + v[r][j].y * v[r][j].y) + (v[r][j].z * v[r][j].z + v[r][j].w * v[r][j].w);
                s2[r] = 1.f / sqrtf(wave_sum(s2[r]) * (1.f / D) + EPS); }
#pragma unroll
            for (int r = 0; r < 4; ++r) { const int m = m0 + r * NGW; if (m < M) { unsigned long long* o8 = (unsigned long long*)(MKP_XN + (size_t)m * D) + lane; const float rstd = s2[r];
#pragma unroll
                for (int j = 0; j < 4; ++j) { const f32x4 g = gr[64 * j]; o8[64 * j] = (unsigned long long)pk2(v[r][j].x * rstd * g.x, v[r][j].y * rstd * g.y) | ((unsigned long long)pk2(v[r][j].z * rstd * g.z, v[r][j].w * rstd * g.w) << 32); } } }
        }
        for (int e = (vcu * NWAVES * 64 + tid); e < M * 16; e += G * NWAVES * 64) {
            const int m = e >> 4, i = e & 15; double inv = 1.0; for (int j = 0; j < i; ++j) inv *= 0.56234132519034908039;
            float sn, cs; sincos_d((double)m * inv, sn, cs); MKP_RT[2 * e] = cs; MKP_RT[2 * e + 1] = sn;
        }
    }
    SEAM(0);
    TS_END(0);
    TS_BEGIN(1);
    if (IN(1)) {
        pg8::Gemm g{MKP_XN, MKP_Win_t, M, NINP, D}; pg8::StaticOrder S; S.init(M, NINP, G, bx);
        pg8::EpiIn E{MKP_P, NINP, C2_FOX, MKP_SSQ, MKP_SSKV, MKP_RT, MKP_b_f, MKP_LF, M};
        pg8::gemm_phase<pg8::EpiIn, pg8::StaticOrder, PG8_ALIGN, PG8_SP2>(lds, g, S, E);
    }
    SEAM(1);
    TS_END(1);
    TS_BEGIN(3);
    if (IN(3)) { MK_IDS
        if (wave >= 2) {
            LAS float* scr = (LAS float*)(lds + wave * 16384);
            constexpr int J_O = (D / 64) * (D / 32), J_1 = (D / 64) * (FF / 32), J_2 = (FF / 64) * (D / 32);
            for (int it = vcu * 6 + (wave - 2); it < J_O + J_1 + J_2; it += G * 6) {
                int r = it;
                if (r < J_O) { p0_transpose_item(MKP_w_o, D, D, D / 32, MKP_Wo_t, 0, nullptr, scr, r, lane); continue; } r -= J_O;
                if (r < J_1) { p0_transpose_item(MKP_w_ff1, D, FF, FF / 32, MKP_W1_t, 0, MKP_g_mlp, scr, r, lane); continue; } r -= J_1;
                p0_transpose_item(MKP_w_ff2, FF, D, D / 32, MKP_W2_t, 0, nullptr, scr, r, lane);
            }
        }
        if (wave < 2) { const int job = bx + 256 * wave;
            if (job < 512 && bx < 256) { const int h = job >> 6, ti = job & 63; const f32x4* lf4 = (const f32x4*)(MKP_LF + (size_t)h * M);
                float pre = 0.f; { int j = 0; float pa[8] = {0.f, 0.f, 0.f, 0.f, 0.f, 0.f, 0.f, 0.f};
                    for (; j + 8 <= ti; j += 8) { f32x4 w[8];
#pragma unroll
                        for (int u = 0; u < 8; ++u) w[u] = lf4[(j + u) * 64 + lane];
#pragma unroll
                        for (int u = 0; u < 8; ++u) pa[u] += (w[u].x + w[u].y) + (w[u].z + w[u].w); }
                    for (; j < ti; ++j) { const f32x4 w = lf4[j * 64 + lane]; pa[0] += (w.x + w.y) + (w.z + w.w); }
                    pre = ((pa[0] + pa[1]) + (pa[2] + pa[3])) + ((pa[4] + pa[5]) + (pa[6] + pa[7])); }
                pre = wave_sum(pre);
                const f32x4 v = lf4[ti * 64 + lane];
                const float s1 = v.x, s2 = s1 + v.y, s3 = s2 + v.z, s4 = s3 + v.w; float inc = s4;
#pragma unroll
                for (int o = 1; o < 64; o <<= 1) { const float n = __shfl_up(inc, o); if (lane >= o) inc += n; }
                const float ex = pre + (inc - s4); const float cs[4] = {ex + s1, ex + s2, ex + s3, ex + s4};
                *(f32x4*)(MKP_BIASF + (size_t)h * M + ti * 256 + 4 * lane) = (f32x4){-cs[0] * LOG2E, -cs[1] * LOG2E, -cs[2] * LOG2E, -cs[3] * LOG2E};
                { float km = 0.f;
                  float qmx = 0.f;
                  for (int e = 0; e < 4; ++e) { const v4u* kr = (const v4u*)(MKP_P + (size_t)(ti * 256 + 4 * lane + e) * NINP + 512 + h * 64); float a2 = 0.f; const v4u* qrw = kr - 64; float q2 = 0.f;
#pragma unroll
                      for (int c8 = 0; c8 < 8; ++c8) { const v4u w = qrw[c8]; const unsigned ww[4] = {w.x, w.y, w.z, w.w};
#pragma unroll
                          for (int q4 = 0; q4 < 4; ++q4) { const float lo_ = __builtin_bit_cast(float, ww[q4] << 16), hi_ = __builtin_bit_cast(float, ww[q4] & 0xffff0000u); q2 += lo_ * lo_ + hi_ * hi_; } }
                      qmx = fmaxf(qmx, q2);
#pragma unroll
                      for (int c8 = 0; c8 < 8; ++c8) { const v4u w = kr[c8]; const unsigned ww[4] = {w.x, w.y, w.z, w.w};
#pragma unroll
                          for (int q4 = 0; q4 < 4; ++q4) { const float lo_ = __builtin_bit_cast(float, ww[q4] << 16), hi_ = __builtin_bit_cast(float, ww[q4] & 0xffff0000u); a2 += lo_ * lo_ + hi_ * hi_; } }
                      km = fmaxf(km, a2); }
#pragma unroll
                  for (int o = 32; o >= 1; o >>= 1) km = fmaxf(km, __shfl_xor(km, o));
#pragma unroll
                  for (int o = 32; o >= 1; o >>= 1) qmx = fmaxf(qmx, __shfl_xor(qmx, o));
                  if (lane == 0) { atomicMax((unsigned*)(args.ws + WS_CTL) + CW_KMAX + 64 * h, __builtin_bit_cast(unsigned, km)); MKP_QMAX[h * 64 + ti] = qmx; } }
#pragma unroll
                for (int e = 0; e < 4; ++e) { const float b = -cs[e] * LOG2E; const unsigned bh = f2bf(b); const float r1 = b - __builtin_bit_cast(float, bh << 16); const unsigned bm = f2bf(r1);
                    const float r2 = r1 - __builtin_bit_cast(float, bm << 16); const unsigned bl = f2bf(r2);
                    *(v4u*)(MKP_KB + ((size_t)h * M + ti * 256 + 4 * lane + e) * 8) = (v4u){bh | (bm << 16), bl | 0x3F800000u, 0x3F803F80u, 0u}; } } }
        __syncthreads();
        { int kq = QL; asm volatile("" : "+s"(kq)); pg8::Gemm g{MKP_P + 1536, MKP_Wq_t, M, NQU, kq, NINP}; pg8::StaticOrder S; S.init(M, NQU, G, bx);
          pg8::EpiQm E{MKP_QM, NQU, MKP_RT, C2_MLA, MKP_SSQ, EPS};
          pg8::gemm_phase<pg8::EpiQm, pg8::StaticOrder, PG8_ALIGN, PG8_SP2>(lds, g, S, E); }
        { int kkv = KVL; asm volatile("" : "+s"(kkv)); pg8::Gemm g{MKP_P + 1792, MKP_Wkv_t, M, NKVU, kkv, NINP}; pg8::StaticOrder S; S.init(M, NKVU, G, bx);
          pg8::EpiKv E{MKP_KVM, NKVU, MKP_SSKV, EPS};
          pg8::gemm_phase<pg8::EpiKv, pg8::StaticOrder, PG8_ALIGN, PG8_SP2>(lds, g, S, E); }
    }
    SEAM(3);
    TS_END(3);
    TS_BEGIN(4);
    if (IN(4)) {
        const int v = (G == 256) ? vcu : bx; const int h0 = (v >> 5) & 7;
        volatile LAS unsigned* misc = (volatile LAS unsigned*)(lds + MISC_OFF);
        unsigned* ctlw = (unsigned*)(args.ws + WS_CTL);
        { const int tid_ = threadIdx.x, lane_ = tid_ & 63, tok = bx * 64 + (tid_ >> 3), hh = tid_ & 7; float k2 = 0.f, q2 = 0.f;
          if (bx < 256) {
            const v4u* kp = (const v4u*)(MKP_KVM + (size_t)tok * NKVU + hh * 64); const v4u* rp = (const v4u*)(MKP_P + (size_t)tok * NINP + 1920); const v4u* qp = (const v4u*)(MKP_QM + (size_t)tok * NQU + hh * 96);
#define MK_SQ(w_, acc_) do { const unsigned ww_[4] = {w_.x, w_.y, w_.z, w_.w}; _Pragma("unroll") for (int q4_ = 0; q4_ < 4; ++q4_) { const float lo_ = __builtin_bit_cast(float, ww_[q4_] << 16), hi_ = __builtin_bit_cast(float, ww_[q4_] & 0xffff0000u); acc_ += lo_ * lo_ + hi_ * hi_; } } while (0)
#pragma unroll
            for (int c8 = 0; c8 < 8; ++c8) { const v4u w = kp[c8]; MK_SQ(w, k2); }
#pragma unroll
            for (int c8 = 0; c8 < 4; ++c8) { const v4u w = rp[c8]; MK_SQ(w, k2); }
#pragma unroll
            for (int c8 = 0; c8 < 12; ++c8) { const v4u w = qp[c8]; MK_SQ(w, q2); }
#undef MK_SQ
          }
#pragma unroll
          for (int o = 8; o <= 32; o <<= 1) { k2 = fmaxf(k2, __shfl_xor(k2, o)); q2 = fmaxf(q2, __shfl_xor(q2, o)); }
          if (lane_ < 8) { atomicMax(ctlw + CW_KMAXM + 64 * lane_, __builtin_bit_cast(unsigned, k2)); atomicMax(ctlw + CW_QMAXM, __builtin_bit_cast(unsigned, q2)); }
          asm volatile("s_waitcnt vmcnt(0)" ::: "memory"); __syncthreads();
          if (tid_ == 0) __hip_atomic_fetch_add(ctlw + CW_DONE, 1u, __ATOMIC_RELAXED, __HIP_MEMORY_SCOPE_AGENT); }
        bool okF = true;
        { const int lane_ = threadIdx.x & 63;
          for (int h = 0; h < 8; ++h) { const float kF = __builtin_bit_cast(float, __hip_atomic_load(ctlw + CW_KMAX + 64 * h, __ATOMIC_RELAXED, __HIP_MEMORY_SCOPE_AGENT));
              float qF = MKP_QMAX[h * 64 + lane_];
#pragma unroll
              for (int o = 32; o >= 1; o >>= 1) qF = fmaxf(qF, __shfl_xor(qF, o));
              okF = okF && (qF * kF < 2025.f); }
          okF = __builtin_amdgcn_readfirstlane(okF ? 1 : 0) != 0; }
#ifndef PROBE_FOX
#define PROBE_FOX 1
#endif
#ifndef PROBE_MLA
#define PROBE_MLA 1
#endif
#define MK_FOX_LOOPS(FIXV) do { \
        for (int rep = 0; rep < PROBE_FOX; ++rep) \
        for (int k = 0; k < 8; ++k) { const int h = (h0 + k) & 7; \
            const float kmax2 = __builtin_bit_cast(float, __hip_atomic_load(ctlw + CW_KMAX + 64 * h, __ATOMIC_RELAXED, __HIP_MEMORY_SCOPE_AGENT)); \
            att::Src s{MKP_P + h * 64, NINP, MKP_P + 512 + h * 64, NINP, MKP_KB + (size_t)h * M * 8, 8, MKP_P + 1024 + h * 64, NINP, MKP_OB + h * 64, D}; \
            for (;;) { \
                if (threadIdx.x == 0) misc[0] = __hip_atomic_fetch_add(ctlw + CW_QF + 64 * h + 16 * rep, 1u, __ATOMIC_RELAXED, __HIP_MEMORY_SCOPE_AGENT); \
                __syncthreads(); const unsigned i = misc[0]; __syncthreads(); \
                if (i >= 64u) break; \
                att::attn_unit<false, FIXV>(63 - (int)i, s, lds, MKP_BIASF + (size_t)h * M, kmax2, MKP_QMAX + h * 64); \
            } } } while (0)
#define MK_MLA_LOOPS(FIXV) do { \
        for (int rep = 0; rep < PROBE_MLA; ++rep) \
        for (int k = 0; k < 8; ++k) { const int h = (h0 + k) & 7; \
            const float kmaxm = __builtin_bit_cast(float, __hip_atomic_load(ctlw + CW_KMAXM + 64 * h, __ATOMIC_RELAXED, __HIP_MEMORY_SCOPE_AGENT)); \
            att::Src s{MKP_QM + h * 96, NQU, MKP_KVM + h * 64, NKVU, MKP_P + 1920, NINP, MKP_KVM + 512 + h * 64, NKVU, MKP_OB + 512 + h * 64, D}; \
            for (;;) { \
                if (threadIdx.x == 0) misc[0] = __hip_atomic_fetch_add(ctlw + CW_QM + 64 * h + 16 * rep, 1u, __ATOMIC_RELAXED, __HIP_MEMORY_SCOPE_AGENT); \
                __syncthreads(); const unsigned i = misc[0]; __syncthreads(); \
                if (i >= 64u) break; \
                att::attn_unit<true, FIXV>(63 - (int)i, s, lds, nullptr, kmaxm, nullptr); \
            } } } while (0)
        if (okF) MK_FOX_LOOPS(true); else MK_FOX_LOOPS(false);
        asm volatile("" ::: "memory");
        if (threadIdx.x == 0) { unsigned sp = 0; while (__hip_atomic_load(ctlw + CW_DONE, __ATOMIC_RELAXED, __HIP_MEMORY_SCOPE_AGENT) < (unsigned)G) { __builtin_amdgcn_s_sleep(2); if (++sp > (1u << 22)) break; } }
        __syncthreads();
        bool okM = true;
        { const float qmM = __builtin_bit_cast(float, __hip_atomic_load(ctlw + CW_QMAXM, __ATOMIC_RELAXED, __HIP_MEMORY_SCOPE_AGENT));
          for (int h = 0; h < 8; ++h) { const float kM = __builtin_bit_cast(float, __hip_atomic_load(ctlw + CW_KMAXM + 64 * h, __ATOMIC_RELAXED, __HIP_MEMORY_SCOPE_AGENT)); okM = okM && (qmM * kM < 2025.f); }
          okM = __builtin_amdgcn_readfirstlane(okM ? 1 : 0) != 0; }
        if (okM) MK_MLA_LOOPS(true); else MK_MLA_LOOPS(false);
#undef MK_FOX_LOOPS
#undef MK_MLA_LOOPS
    }
#ifdef ATT_PRIO
    __builtin_amdgcn_s_setprio(0);
#endif
    SEAM(4);
    TS_END(4);
    TS_BEGIN(5);
    if (IN(5)) {
        pg8::Gemm g{MKP_OB, MKP_Wo_t, M, D, D}; pg8::StaticOrder S; S.init(M, D, G, bx);
        pg8::EpiRes E{MKP_x, MKP_out, D, MKP_XN, MKP_SS};
        pg8::gemm_phase<pg8::EpiRes, pg8::StaticOrder, PG8_ALIGN, PG8_SP2>(lds, g, S, E);
    }
    SEAM(5);
    TS_END(5);
    TS_BEGIN(6);
    if (IN(6)) {
        pg8::Gemm g{MKP_XN, MKP_W1_t, M, FF, D}; pg8::StaticOrder S; S.init(M, FF, G, bx);
        pg8::EpiSqRelu E{MKP_HB, FF, MKP_SS, EPS, 1.f / D};
        pg8::gemm_phase<pg8::EpiSqRelu, pg8::StaticOrder, PG8_ALIGN, PG8_SP2>(lds, g, S, E);
    }
    SEAM(6);
    TS_END(6);
    TS_BEGIN(7);
    if (IN(7)) {
        pg8::Gemm g{MKP_HB, MKP_W2_t, M, D, FF}; pg8::StaticOrder S; S.init(M, D, G, bx);
        pg8::EpiResNorm E{MKP_out, MKP_out, D, MKP_g_final, MKP_SSQ, (unsigned*)(args.ws + WS_CTL) + CW_PCNT, EPS, 1.f / D};
        pg8::gemm_phase<pg8::EpiResNorm, pg8::StaticOrder, false, PG8_SP2>(lds, g, S, E);
    }
#ifdef TS_PHASE
    { XcdBarrier b_; b_.bar = (unsigned*)(args.ws + WS_CTL); b_.x = xb_xcc_id(); b_.st = (volatile LAS unsigned*)(lds + MISC_OFF) + 8; xcd_barrier(b_); }
    TS_END(7);
    if (blockIdx.x == 0 && threadIdx.x == 0) MKP_out[0] = (float)(((ts_b_ - ts_a_) / TS_Q) * (TS_Q / 100ull));
#endif
#undef IN
#undef SEAM
#undef MKP_x
#undef MKP_g_mix
#undef MKP_w_in
#undef MKP_b_f
#undef MKP_g_q
#undef MKP_w_q_up
#undef MKP_g_kv
#undef MKP_w_kv_up
#undef MKP_w_o
#undef MKP_g_mlp
#undef MKP_w_ff1
#undef MKP_w_ff2
#undef MKP_g_final
#undef MKP_out
#undef MKP_Win_t
#undef MKP_Wq_t
#undef MKP_Wkv_t
#undef MKP_Wo_t
#undef MKP_W1_t
#undef MKP_W2_t
#undef MKP_RT
#undef MKP_LF
#undef MKP_SS
#undef MKP_SSQ
#undef MKP_BIASF
#undef MKP_QMAX
#undef MKP_SSKV
#undef MKP_KB
#undef MKP_KR
#undef MKP_XN
#undef MKP_HB
#undef MKP_P
#undef MKP_QM
#undef MKP_KVM
#undef MKP_QN
#undef MKP_OB
#undef MKP_KVN
}

#ifndef MK_ONE_LAUNCH
#define MK_ONE_LAUNCH 1
#endif
extern "C" void kernel_launch(void* const* d_in, const int* in_sizes, int n_in, void* d_out, int out_size, void* d_ws, size_t ws_size, hipStream_t stream) {
    static int ready = 0;
    if (ready == 0) {
        if (n_in != 13 || in_sizes[0] != M * D || out_size != M * D || ws_size < WS_END) { fprintf(stderr, "kernel_launch: unexpected shapes (n_in %d, in0 %d, out %d, ws %zu)\n", n_in, n_in > 0 ? in_sizes[0] : -1, out_size, ws_size); ready = -1; return; }
        if (hipFuncSetAttribute((const void*)mk_fwd, hipFuncAttributeMaxDynamicSharedMemorySize, LDS_BYTES) != hipSuccess) { fprintf(stderr, "kernel_launch: hipFuncSetAttribute failed\n"); ready = -1; return; }
        ready = 1;
    }
    if (ready < 0) return;
    if (hipMemsetAsync((char*)d_ws + WS_CTL, 0, CTL_ZERO_BYTES, stream) != hipSuccess) { fprintf(stderr, "kernel_launch: hipMemsetAsync failed\n"); return; }
    Args a{};
    for (int i = 0; i < 13; ++i) a.in[i] = (const float*)d_in[i];
    a.out = (float*)d_out; a.ws = (unsigned char*)d_ws;
#ifndef MK_DUP
#define MK_DUP -1
#endif
    a.dup = MK_DUP;
    const int grid = 256;
#if MK_ONE_LAUNCH
    a.ph_lo = 0; a.ph_hi = NPHASE;
    void* kargs[] = {&a};
    hipError_t e = hipLaunchCooperativeKernel((const void*)mk_fwd, dim3(grid), dim3(NWAVES * 64), kargs, LDS_BYTES, stream);
    if (e != hipSuccess) fprintf(stderr, "kernel_launch: cooperative launch failed: %s\n", hipGetErrorString(e));
#else
    for (int p = 0; p < NPHASE; ++p) { a.ph_lo = p; a.ph_hi = p + 1; hipLaunchKernelGGL(mk_fwd, dim3(grid), dim3(NWAVES * 64), LDS_BYTES, stream, a); }
#endif
}
```

```cpp
#include <hip/hip_runtime.h>
#include <hip/hip_cooperative_groups.h>
#include <hip/hip_bf16.h>
#include <cstdio>
#include <cstdint>
#include <cmath>
namespace pg8 {
#define PG8_LAS __attribute__((address_space(3)))
typedef unsigned short bf16_t;
typedef short bf16x8 __attribute__((ext_vector_type(8)));
typedef float f32x4 __attribute__((ext_vector_type(4)));
typedef unsigned u32x4 __attribute__((ext_vector_type(4)));
constexpr int BM = 256, BK = 64, HALF = 128, HTB = HALF * BK * 2  , STAGE_BYTES = 8 * HTB, NXCD = 8, WGM = 8;

__host__ __device__ __forceinline__ int lds_byte(int r, int c) { const int st = (r >> 4) * 2 + (c >> 5), rr = r & 15, cc = c & 31, ob = rr * 64 + cc * 2; return st * 1024 + (ob ^ (((ob >> 9) & 1) << 5)); }
__host__ __device__ __forceinline__ void stage_rc(int b, int& R, int& C) { const int st = b / 1024, sb = b % 1024, swz = sb ^ (((sb >> 9) & 1) << 5); R = (st >> 1) * 16 + swz / 64; C = (st & 1) * 32 + (swz % 64) / 2; }
__host__ __device__ __forceinline__ int perm32(int rho) { const int n = rho >> 4, i = rho & 15; return 8 * (i >> 2) + 4 * n + (i & 3); }

struct Unit { int pm, pn; };
struct Gemm { const bf16_t* A; const bf16_t* Bt; int M, N, K; int lda; };

struct StaticOrder {
    int nM, nN, nwg, G, c;
    __host__ __device__ void init(int M, int N, int G_, int c_) { nM = M / BM; nN = N / BM; nwg = nM * nN; G = G_; c = c_; }
    __host__ __device__ bool next(int i, Unit& u) const {
        const long L = (long)i * G + c; if (L >= nwg) return false;
        int wgid = (int)L; { const int q = nwg / NXCD, r = nwg % NXCD, xcd = wgid % NXCD, off = wgid / NXCD; wgid = (xcd < r ? xcd * (q + 1) : r * (q + 1) + (xcd - r) * q) + off; }
        const int nig = WGM * nN, gid = wgid / nig, fm = gid * WGM, gsz = (nM - fm) < WGM ? (nM - fm) : WGM;
        u.pm = fm + ((wgid % nig) % gsz); u.pn = (wgid % nig) / gsz; return true;
    }
    __device__ __forceinline__ void a_ready(const Unit&) const {}
    __device__ __forceinline__ void done(const Unit&) const {}
};

__device__ __forceinline__ unsigned cvt_pk_bf16(float lo, float hi) { unsigned r; asm volatile("v_cvt_pk_bf16_f32 %0, %1, %2" : "=v"(r) : "v"(lo), "v"(hi)); return r; }
typedef float f32x2 __attribute__((ext_vector_type(2)));
__device__ __forceinline__ f32x2 gelu_pk(f32x2 v) {
    const f32x2 av = __builtin_elementwise_abs(v), d = av * 0.2316418882f + 1.0f;
    f32x2 t; t.x = __builtin_amdgcn_rcpf(d.x); t.y = __builtin_amdgcn_rcpf(d.y);
    f32x2 q = t * 0.5307027145f + (-0.7265760135f); q = q * t + 0.7107068705f; q = q * t + (-0.142248368f); q = q * t + 0.127414796f; q = q * t;
    const f32x2 s = (v * v) * (-0.72134752044f);
    f32x2 e; e.x = __builtin_amdgcn_exp2f(s.x); e.y = __builtin_amdgcn_exp2f(s.y);
    const f32x2 m = v * (q * e), r = v - m;
    f32x2 o; o.x = v.x < 0.f ? m.x : r.x; o.y = v.y < 0.f ? m.y : r.y; return o;
}

template <int ACT  > struct EpiBf16 {
    static constexpr bool PERM = true, AFTER_DRAIN = false; static_assert(ACT == 0 || ACT == 1, "EpiBf16: ACT is 0 (none) or 1 (gelu_pk)");
    bf16_t* O; int ldc; const float* bias; int split_cols; size_t split_stride; float scale0;
    __device__ __forceinline__ void operator()(const f32x4 (&acc)[2][2][4][2], const Unit& u, int wr, int wc, int fr, int fq) const {
        const int row0 = u.pm * BM + wr * 64 + fr; int colt = u.pn * BM; bf16_t* base = O;
        float sc = 1.f; if (split_cols) { const int t = colt / split_cols; base += (size_t)t * split_stride; colt -= t * split_cols; if (t == 0) sc = scale0; }
        const int col0 = colt + wc * 32 + 8 * fq, bcol0 = u.pn * BM + wc * 32 + 8 * fq;
        f32x4 bv[2][2];
#pragma unroll
        for (int bj = 0; bj < 2; ++bj)
#pragma unroll
            for (int n = 0; n < 2; ++n) bv[bj][n] = bias ? *(const f32x4*)(bias + bcol0 + bj * HALF + 4 * n) : (f32x4){0.f, 0.f, 0.f, 0.f};
#pragma unroll
        for (int ai = 0; ai < 2; ++ai)
#pragma unroll
            for (int m = 0; m < 4; ++m) { bf16_t* rowp = base + (size_t)(row0 + ai * HALF + m * 16) * ldc + col0;
#pragma unroll
                for (int bj = 0; bj < 2; ++bj) { f32x4 v0 = acc[ai][bj][m][0] + bv[bj][0], v1 = acc[ai][bj][m][1] + bv[bj][1];
                    if (ACT == 1) { f32x2 a = gelu_pk((f32x2){v0[0], v0[1]}), b = gelu_pk((f32x2){v0[2], v0[3]}), c = gelu_pk((f32x2){v1[0], v1[1]}), d = gelu_pk((f32x2){v1[2], v1[3]});
                        v0 = (f32x4){a.x, a.y, b.x, b.y}; v1 = (f32x4){c.x, c.y, d.x, d.y}; }
                    v0 = v0 * sc; v1 = v1 * sc; u32x4 w; w.x = cvt_pk_bf16(v0[0], v0[1]); w.y = cvt_pk_bf16(v0[2], v0[3]); w.z = cvt_pk_bf16(v1[0], v1[1]); w.w = cvt_pk_bf16(v1[2], v1[3]);
                    *(u32x4*)(rowp + bj * HALF) = w; } }
    }
};

struct EpiQm {
    static constexpr bool PERM = true, AFTER_DRAIN = false;
    bf16_t* O; int ldc; const float* rt; float scale; const float* ssq; float eps;
    __device__ __forceinline__ void operator()(const f32x4 (&acc)[2][2][4][2], const Unit& u, int wr, int wc, int fr, int fq) const {
        const int row0 = u.pm * BM + wr * 64 + fr, col0 = u.pn * BM + wc * 32 + 8 * fq;
#pragma unroll
        for (int ai = 0; ai < 2; ++ai)
#pragma unroll
            for (int m = 0; m < 4; ++m) { const int row = row0 + ai * HALF + m * 16;
                const f32x4 sq = *(const f32x4*)(ssq + (size_t)row * 4); const float rs = scale / sqrtf(((sq[0] + sq[1]) + (sq[2] + sq[3])) * (1.0f / 256.0f) + eps);
#pragma unroll
                for (int bj = 0; bj < 2; ++bj) { const int c = col0 + bj * HALF, d = c % 96;
                    f32x4 v0 = acc[ai][bj][m][0], v1 = acc[ai][bj][m][1];
                    if (d >= 64) { const f32x4* t = (const f32x4*)(rt + (size_t)row * 32 + (d - 64)); const f32x4 t0 = t[0], t1 = t[1];
                        f32x4 w0, w1;
                        w0[0] = v0[0] * t0[0] - v0[1] * t0[1]; w0[1] = v0[1] * t0[0] + v0[0] * t0[1];
                        w0[2] = v0[2] * t0[2] - v0[3] * t0[3]; w0[3] = v0[3] * t0[2] + v0[2] * t0[3];
                        w1[0] = v1[0] * t1[0] - v1[1] * t1[1]; w1[1] = v1[1] * t1[0] + v1[0] * t1[1];
                        w1[2] = v1[2] * t1[2] - v1[3] * t1[3]; w1[3] = v1[3] * t1[2] + v1[2] * t1[3];
                        v0 = w0; v1 = w1; }
                    v0 = v0 * rs; v1 = v1 * rs; u32x4 w; w.x = cvt_pk_bf16(v0[0], v0[1]); w.y = cvt_pk_bf16(v0[2], v0[3]); w.z = cvt_pk_bf16(v1[0], v1[1]); w.w = cvt_pk_bf16(v1[2], v1[3]);
                    *(u32x4*)(O + (size_t)row * ldc + c) = w; }
                asm volatile("" ::: "memory"); }
    }
};

struct EpiKv {
    static constexpr bool PERM = true, AFTER_DRAIN = false;
    bf16_t* O; int ldc; const float* ssq; float eps;
    __device__ __forceinline__ void operator()(const f32x4 (&acc)[2][2][4][2], const Unit& u, int wr, int wc, int fr, int fq) const {
        const int row0 = u.pm * BM + wr * 64 + fr, col0 = u.pn * BM + wc * 32 + 8 * fq;
#pragma unroll
        for (int ai = 0; ai < 2; ++ai)
#pragma unroll
            for (int m = 0; m < 4; ++m) { const int row = row0 + ai * HALF + m * 16;
                const f32x4 sq = *(const f32x4*)(ssq + (size_t)row * 4); const float rs = 1.0f / sqrtf(((sq[0] + sq[1]) + (sq[2] + sq[3])) * (1.0f / 128.0f) + eps);
#pragma unroll
                for (int bj = 0; bj < 2; ++bj) { const f32x4 v0 = acc[ai][bj][m][0] * rs, v1 = acc[ai][bj][m][1] * rs;
                    u32x4 w; w.x = cvt_pk_bf16(v0[0], v0[1]); w.y = cvt_pk_bf16(v0[2], v0[3]); w.z = cvt_pk_bf16(v1[0], v1[1]); w.w = cvt_pk_bf16(v1[2], v1[3]);
                    *(u32x4*)(O + (size_t)row * ldc + col0 + bj * HALF) = w; }
                asm volatile("" ::: "memory"); }
    }
};
struct EpiIn {
    static constexpr bool PERM = true, AFTER_DRAIN = false;
    bf16_t* O; int ldc; float scale0; float* ssq; float* sskv; const float* rt; const float* bf; float* lf; int nrows;
    __device__ __forceinline__ void operator()(const f32x4 (&acc)[2][2][4][2], const Unit& u, int wr, int wc, int fr, int fq) const {
        const int row0 = u.pm * BM + wr * 64 + fr, col0 = u.pn * BM + wc * 32 + 8 * fq; const int pn = u.pn;
        const float sc = pn < 2 ? scale0 : 1.f;
#pragma unroll
        for (int ai = 0; ai < 2; ++ai)
#pragma unroll
            for (int m = 0; m < 4; ++m) { const int row = row0 + ai * HALF + m * 16; bf16_t* rowp = O + (size_t)row * ldc + col0; float s0 = 0.f, s1 = 0.f;
#pragma unroll
                for (int bj = 0; bj < 2; ++bj) { f32x4 v0 = acc[ai][bj][m][0] * sc, v1 = acc[ai][bj][m][1] * sc;
                    const float sq = ((v0[0] * v0[0] + v0[1] * v0[1]) + (v0[2] * v0[2] + v0[3] * v0[3])) + ((v1[0] * v1[0] + v1[1] * v1[1]) + (v1[2] * v1[2] + v1[3] * v1[3]));
                    if (bj == 0) s0 = sq; else s1 = sq;
                    bool store = true;
                    if (pn == 7 && bj == 1) { store = (wc == 0);
                        if (wc == 0) { const f32x4* t = (const f32x4*)(rt + (size_t)row * 32 + 8 * fq); const f32x4 t0 = t[0], t1 = t[1]; f32x4 w0, w1;
                            w0[0] = v0[0] * t0[0] - v0[1] * t0[1]; w0[1] = v0[1] * t0[0] + v0[0] * t0[1];
                            w0[2] = v0[2] * t0[2] - v0[3] * t0[3]; w0[3] = v0[3] * t0[2] + v0[2] * t0[3];
                            w1[0] = v1[0] * t1[0] - v1[1] * t1[1]; w1[1] = v1[1] * t1[0] + v1[0] * t1[1];
                            w1[2] = v1[2] * t1[2] - v1[3] * t1[3]; w1[3] = v1[3] * t1[2] + v1[2] * t1[3];
                            v0 = w0; v1 = w1; }
                        else if (wc == 1 && fq == 0) {
#pragma unroll
                            for (int e = 0; e < 8; ++e) { const float z = (e < 4 ? v0[e & 3] : v1[e & 3]) + bf[e]; lf[(size_t)e * nrows + row] = fminf(z, 0.f) - 0.6931471805599453f * __builtin_amdgcn_logf(1.0f + __builtin_amdgcn_exp2f(-1.4426950408889634f * fabsf(z))); } } }
                    if (store) { u32x4 w; w.x = cvt_pk_bf16(v0[0], v0[1]); w.y = cvt_pk_bf16(v0[2], v0[3]); w.z = cvt_pk_bf16(v1[0], v1[1]); w.w = cvt_pk_bf16(v1[2], v1[3]);
                        *(u32x4*)(rowp + bj * HALF) = w; } }
                if (pn == 6) { float s = s0 + s1; s += __shfl_xor(s, 16); s += __shfl_xor(s, 32); if (fq == 0) ssq[(size_t)row * 4 + wc] = s; }
                if (pn == 7) { float s = s0; s += __shfl_xor(s, 16); s += __shfl_xor(s, 32); if (fq == 0) sskv[(size_t)row * 4 + wc] = s; }
                asm volatile("" ::: "memory"); }
    }
};
struct EpiRes {
    static constexpr bool PERM = false, AFTER_DRAIN = false;
    const float* base; float* out; int ldc; bf16_t* ob; float* ss;
    __device__ __forceinline__ void operator()(const f32x4 (&acc)[2][2][4][2], const Unit& u, int wr, int wc, int fr, int fq) const {
        typedef unsigned u32x2v __attribute__((ext_vector_type(2)));
        const int row0 = u.pm * BM + wr * 64 + fr, col0 = u.pn * BM + wc * 32 + 4 * fq;
#pragma unroll
        for (int ai = 0; ai < 2; ++ai)
#pragma unroll
            for (int m = 0; m < 4; ++m) { const int row = row0 + ai * HALF + m * 16; const size_t off = (size_t)row * ldc + col0; float s = 0.f;
#pragma unroll
                for (int bj = 0; bj < 2; ++bj)
#pragma unroll
                    for (int n = 0; n < 2; ++n) { const f32x4 v = *(const f32x4*)(base + off + bj * HALF + n * 16) + acc[ai][bj][m][n];
                        *(f32x4*)(out + off + bj * HALF + n * 16) = v; s += (v[0] * v[0] + v[1] * v[1]) + (v[2] * v[2] + v[3] * v[3]);
                        if (ob) { u32x2v w; w.x = cvt_pk_bf16(v[0], v[1]); w.y = cvt_pk_bf16(v[2], v[3]); *(u32x2v*)(ob + off + bj * HALF + n * 16) = w; } }
                if (ss) { s += __shfl_xor(s, 16); s += __shfl_xor(s, 32); if (fq == 0) ss[(size_t)row * 16 + u.pn * 4 + wc] = s; }
                asm volatile("" ::: "memory");
            }
    }
};

struct EpiResNorm {
    static constexpr bool PERM = false, AFTER_DRAIN = true;
    const float* base; float* out; int ldc; const float* g; float* xs; unsigned* cnt; float eps; float inv_n;
    __device__ __forceinline__ void fused(f32x4 (&acc)[2][2][4][2], const Unit& u, int wr, int wc, int fr, int fq, PG8_LAS unsigned char* lds, int wid, int lane) const {
        PG8_LAS float* Pm = (PG8_LAS float*)lds;
        PG8_LAS float* S = (PG8_LAS float*)(lds + 4096);
        const int row0 = u.pm * BM + wr * 64 + fr, col0 = u.pn * BM + wc * 32 + 4 * fq;
#pragma unroll
        for (int ai = 0; ai < 2; ++ai)
#pragma unroll
            for (int m = 0; m < 4; ++m) { const size_t off = (size_t)(row0 + ai * HALF + m * 16) * ldc + col0; float s = 0.f;
#pragma unroll
                for (int bj = 0; bj < 2; ++bj)
#pragma unroll
                    for (int n = 0; n < 2; ++n) { const f32x4 v = *(const f32x4*)(base + off + bj * HALF + n * 16) + acc[ai][bj][m][n]; acc[ai][bj][m][n] = v;
                        s += (v[0] * v[0] + v[1] * v[1]) + (v[2] * v[2] + v[3] * v[3]); }
                s += __shfl_xor(s, 16); s += __shfl_xor(s, 32);
                if (fq == 0) Pm[(ai * HALF + wr * 64 + m * 16 + fr) * 4 + wc] = s;
                if (m & 1) asm volatile("" ::: "memory"); }
        asm volatile("s_waitcnt lgkmcnt(0)" ::: "memory"); __builtin_amdgcn_s_barrier(); asm volatile("" ::: "memory");
        const int tid = wid * 64 + lane;
        if (tid < 256) { const f32x4 p4 = *(const PG8_LAS f32x4*)(Pm + tid * 4);
            __hip_atomic_store(xs + (size_t)(u.pm * BM + tid) * 4 + u.pn, (p4[0] + p4[1]) + (p4[2] + p4[3]), __ATOMIC_RELAXED, __HIP_MEMORY_SCOPE_AGENT);
            asm volatile("s_waitcnt vmcnt(0)" ::: "memory");
            if (lane == 0) __hip_atomic_fetch_add(cnt + 64 * u.pm, 1u, __ATOMIC_RELAXED, __HIP_MEMORY_SCOPE_AGENT); }
        if (wid == 0) { unsigned sp = 0;
            while ((unsigned)__builtin_amdgcn_readfirstlane(__hip_atomic_load(cnt + 64 * u.pm, __ATOMIC_RELAXED, __HIP_MEMORY_SCOPE_AGENT)) < 16u) { __builtin_amdgcn_s_sleep(2); if (++sp > (1u << 22)) break; }
            __builtin_amdgcn_fence(__ATOMIC_ACQUIRE, "agent"); }
        asm volatile("s_waitcnt vmcnt(0) lgkmcnt(0)" ::: "memory"); __builtin_amdgcn_s_barrier(); asm volatile("" ::: "memory");
        if (tid < 256) { const float* xp = xs + (size_t)(u.pm * BM + tid) * 4;
            const float t0 = __hip_atomic_load(xp + 0, __ATOMIC_RELAXED, __HIP_MEMORY_SCOPE_AGENT), t1 = __hip_atomic_load(xp + 1, __ATOMIC_RELAXED, __HIP_MEMORY_SCOPE_AGENT);
            const float t2 = __hip_atomic_load(xp + 2, __ATOMIC_RELAXED, __HIP_MEMORY_SCOPE_AGENT), t3 = __hip_atomic_load(xp + 3, __ATOMIC_RELAXED, __HIP_MEMORY_SCOPE_AGENT);
            S[tid] = 1.0f / sqrtf(((t0 + t1) + (t2 + t3)) * inv_n + eps); }
        asm volatile("s_waitcnt vmcnt(0) lgkmcnt(0)" ::: "memory"); __builtin_amdgcn_s_barrier(); asm volatile("" ::: "memory");
        f32x4 gv[2][2];
#pragma unroll
        for (int bj = 0; bj < 2; ++bj)
#pragma unroll
            for (int n = 0; n < 2; ++n) gv[bj][n] = *(const f32x4*)(g + col0 + bj * HALF + n * 16);
#pragma unroll
        for (int ai = 0; ai < 2; ++ai)
#pragma unroll
            for (int m = 0; m < 4; ++m) { const int r = ai * HALF + wr * 64 + m * 16 + fr; const float rs = S[r]; const size_t off = (size_t)(u.pm * BM + r) * ldc + col0;
#pragma unroll
                for (int bj = 0; bj < 2; ++bj)
#pragma unroll
                    for (int n = 0; n < 2; ++n) *(f32x4*)(out + off + bj * HALF + n * 16) = acc[ai][bj][m][n] * rs * gv[bj][n]; }
    }
};
struct EpiSqRelu {
    static constexpr bool PERM = true, AFTER_DRAIN = false;
    bf16_t* O; int ldc; const float* ss; float eps; float inv_n;
    __device__ __forceinline__ void operator()(const f32x4 (&acc)[2][2][4][2], const Unit& u, int wr, int wc, int fr, int fq) const {
        const int row0 = u.pm * BM + wr * 64 + fr, col0 = u.pn * BM + wc * 32 + 8 * fq;
#pragma unroll
        for (int ai = 0; ai < 2; ++ai)
#pragma unroll
            for (int m = 0; m < 4; ++m) { const int row = row0 + ai * HALF + m * 16;
                const f32x4* sp = (const f32x4*)(ss + (size_t)row * 16); const f32x4 a = sp[0], b = sp[1], c = sp[2], d = sp[3];
                const float tot = ((a[0] + a[1]) + (a[2] + a[3])) + ((b[0] + b[1]) + (b[2] + b[3])) + ((c[0] + c[1]) + (c[2] + c[3])) + ((d[0] + d[1]) + (d[2] + d[3]));
                const float rstd = 1.0f / sqrtf(tot * inv_n + eps);
#pragma unroll
                for (int bj = 0; bj < 2; ++bj) { f32x4 v0 = acc[ai][bj][m][0] * rstd, v1 = acc[ai][bj][m][1] * rstd;
#pragma unroll
                    for (int e = 0; e < 4; ++e) { const float x0 = fmaxf(v0[e], 0.f), x1 = fmaxf(v1[e], 0.f); v0[e] = x0 * x0; v1[e] = x1 * x1; }
                    u32x4 w; w.x = cvt_pk_bf16(v0[0], v0[1]); w.y = cvt_pk_bf16(v0[2], v0[3]); w.z = cvt_pk_bf16(v1[0], v1[1]); w.w = cvt_pk_bf16(v1[2], v1[3]);
                    *(u32x4*)(O + (size_t)row * ldc + col0 + bj * HALF) = w; }
                asm volatile("" ::: "memory"); }
    }
};


template <class Epi, class Sched, bool ALIGN_EPI = false, bool SP2 = false>
__device__ __forceinline__ void gemm_phase(PG8_LAS unsigned char* lds, const Gemm g, const Sched& S, const Epi& E) {
    const int tid = threadIdx.x, wid = __builtin_amdgcn_readfirstlane(tid >> 6), lane = tid & 63, wr = wid >> 2, wc = wid & 3, fr = lane & 15, fq = lane >> 4;
    const int K = g.K, nt = K / BK, lda = g.lda ? g.lda : g.K;
    unsigned voffA[2], voffB[2];
#pragma unroll
    for (int i = 0; i < 2; ++i) { int R, C; stage_rc(tid * 16 + i * 8192, R, C); const int Rb = Epi::PERM ? ((R & ~31) + perm32(R & 31)) : R;
        voffA[i] = (unsigned)(R * lda + C) * 2u; voffB[i] = (unsigned)(Rb * K + C) * 2u; }
    const size_t kstep = (size_t)(BK * 2);
    const size_t hstep = (size_t)HALF * K * 2;
    const size_t tstep = 2 * hstep;
    const size_t hstepA = (size_t)HALF * lda * 2, tstepA = 2 * hstepA;
    const unsigned ldsw = (unsigned)wid * 1024u;
    const int aoff = lds_byte(wr * 64 + fr, fq * 8), boff = lds_byte(wc * 32 + fr, fq * 8);
#define PG8_SA(b, h) (((b) * 2 + (h)) * HTB)
#define PG8_SB(b, h) ((4 + (b) * 2 + (h)) * HTB)
#define PG8_STAGE(bufoff, gbase, voff) do { _Pragma("unroll") for (int _i = 0; _i < 2; ++_i) \
        __builtin_amdgcn_global_load_lds((const unsigned*)((const char*)(gbase) + (voff)[_i]), (PG8_LAS unsigned*)(lds + (bufoff) + ldsw + _i * 8192), 16, 0, 0); } while (0)
#define PG8_LDA(dst, b, h) do { _Pragma("unroll") for (int m = 0; m < 4; ++m) _Pragma("unroll") for (int k = 0; k < 2; ++k) dst[m][k] = *(const PG8_LAS bf16x8*)(lds + PG8_SA(b, h) + aoff + m * 2048 + k * 1024); } while (0)
#define PG8_LDB(dst, b, h) do { _Pragma("unroll") for (int n = 0; n < 2; ++n) _Pragma("unroll") for (int k = 0; k < 2; ++k) dst[n][k] = *(const PG8_LAS bf16x8*)(lds + PG8_SB(b, h) + boff + n * 2048 + k * 1024); } while (0)
#define PG8_MMA(ai, bj, At, Bt) do { __builtin_amdgcn_s_setprio(1); _Pragma("unroll") for (int m = 0; m < 4; ++m) _Pragma("unroll") for (int n = 0; n < 2; ++n) _Pragma("unroll") for (int k = 0; k < 2; ++k) \
        acc[ai][bj][m][n] = __builtin_amdgcn_mfma_f32_16x16x32_bf16(Bt[n][k], At[m][k], acc[ai][bj][m][n], 0, 0, 0); __builtin_amdgcn_s_setprio(0); } while (0)
#define PG8_WAIT_V(n) asm volatile("s_waitcnt vmcnt(" #n ")" ::: "memory")
#define PG8_WAIT_L(n) asm volatile("s_waitcnt lgkmcnt(" #n ")" ::: "memory")
#define PG8_BAR __builtin_amdgcn_s_barrier()
#define PG8_SCHED __builtin_amdgcn_sched_barrier(0)
    Unit cur, nxt; int ui = 0;
    if (!S.next(0, cur)) return;
    f32x4 acc[2][2][4][2];
#pragma unroll
    for (int a = 0; a < 2; ++a)
#pragma unroll
        for (int b = 0; b < 2; ++b)
#pragma unroll
            for (int m = 0; m < 4; ++m)
#pragma unroll
                for (int n = 0; n < 2; ++n) acc[a][b][m][n] = (f32x4){0.f, 0.f, 0.f, 0.f};
    bf16x8 At[4][2], B0[2][2], B1[2][2];
    const char* cA = (const char*)g.A + (size_t)cur.pm * tstepA; const char* cB = (const char*)g.Bt + (size_t)cur.pn * tstep;
    S.a_ready(cur);
    if constexpr (SP2) {
        PG8_STAGE(PG8_SB(0, 0), cB, voffB); PG8_STAGE(PG8_SB(0, 1), cB + hstep, voffB); PG8_STAGE(PG8_SA(0, 0), cA, voffA); PG8_STAGE(PG8_SA(0, 1), cA + hstepA, voffA);
        if (wr == 1) PG8_BAR;
        PG8_WAIT_V(2); PG8_BAR;
        PG8_STAGE(PG8_SB(1, 0), cB + kstep, voffB); PG8_STAGE(PG8_SA(1, 0), cA + kstep, voffA); PG8_STAGE(PG8_SB(1, 1), cB + hstep + kstep, voffB);
        PG8_WAIT_V(6); PG8_BAR;
    } else {
        PG8_STAGE(PG8_SB(0, 0), cB, voffB); PG8_STAGE(PG8_SA(0, 0), cA, voffA); PG8_STAGE(PG8_SB(0, 1), cB + hstep, voffB); PG8_STAGE(PG8_SA(0, 1), cA + hstepA, voffA);
        if (wr == 1) PG8_BAR;
        PG8_WAIT_V(4); PG8_BAR;
        PG8_STAGE(PG8_SB(1, 0), cB + kstep, voffB); PG8_STAGE(PG8_SA(1, 0), cA + kstep, voffA); PG8_STAGE(PG8_SB(1, 1), cB + hstep + kstep, voffB);
        PG8_WAIT_V(6); PG8_BAR;
    }
    for (;;) {
        const bool has_next = S.next(ui + 1, nxt);
        const char* nA = has_next ? (const char*)g.A + (size_t)nxt.pm * tstepA : cA; const char* nB = has_next ? (const char*)g.Bt + (size_t)nxt.pn * tstep : cB;
        for (int t = 0; t < nt; t += 2) {
            const bool last = (t == nt - 2);
            const char* a1 = cA + (size_t)(t + 1) * kstep;
            const char* a2 = last ? nA : cA + (size_t)(t + 2) * kstep; const char* b2 = last ? nB : cB + (size_t)(t + 2) * kstep;
            const char* a3 = a2 + kstep; const char* b3 = b2 + kstep;
            if (last && has_next) S.a_ready(nxt);
            if constexpr (SP2) {
            PG8_LDB(B0, 0, 0); PG8_LDB(B1, 0, 1); PG8_SCHED; PG8_LDA(At, 0, 0); PG8_STAGE(PG8_SA(1, 1), a1 + hstepA, voffA);
            PG8_WAIT_V(8); PG8_WAIT_L(0); PG8_BAR; PG8_MMA(0, 0, At, B0); PG8_MMA(0, 1, At, B1); PG8_BAR; PG8_SCHED;
            PG8_LDA(At, 0, 1); PG8_STAGE(PG8_SB(0, 0), b2, voffB); PG8_STAGE(PG8_SB(0, 1), b2 + hstep, voffB); PG8_STAGE(PG8_SA(0, 0), a2, voffA);
            PG8_WAIT_V(8); PG8_WAIT_L(0); PG8_BAR; PG8_MMA(1, 0, At, B0); PG8_MMA(1, 1, At, B1); PG8_BAR; PG8_SCHED;
            PG8_LDB(B0, 1, 0); PG8_LDB(B1, 1, 1); PG8_SCHED; PG8_LDA(At, 1, 0); PG8_STAGE(PG8_SA(0, 1), a2 + hstepA, voffA);
            PG8_WAIT_V(8); PG8_WAIT_L(0); PG8_BAR; PG8_MMA(0, 0, At, B0); PG8_MMA(0, 1, At, B1); PG8_BAR; PG8_SCHED;
            PG8_LDA(At, 1, 1); PG8_STAGE(PG8_SB(1, 0), b3, voffB); PG8_STAGE(PG8_SB(1, 1), b3 + hstep, voffB); PG8_STAGE(PG8_SA(1, 0), a3, voffA);
            PG8_WAIT_V(8); PG8_WAIT_L(0); PG8_BAR; PG8_MMA(1, 0, At, B0); PG8_MMA(1, 1, At, B1); PG8_BAR; PG8_SCHED;
            } else {
            PG8_LDB(B0, 0, 0); PG8_SCHED; PG8_LDA(At, 0, 0); PG8_STAGE(PG8_SA(1, 1), a1 + hstepA, voffA);
            PG8_WAIT_L(8); PG8_BAR; PG8_WAIT_L(0); PG8_MMA(0, 0, At, B0); PG8_BAR; PG8_SCHED;
            PG8_LDB(B1, 0, 1); PG8_STAGE(PG8_SB(0, 0), b2, voffB);
            PG8_BAR; PG8_WAIT_L(0); PG8_MMA(0, 1, At, B1); PG8_BAR;
            PG8_LDA(At, 0, 1); PG8_STAGE(PG8_SA(0, 0), a2, voffA);
            PG8_BAR; PG8_WAIT_L(0); PG8_MMA(1, 0, At, B0); PG8_BAR; PG8_SCHED;
            PG8_STAGE(PG8_SB(0, 1), b2 + hstep, voffB);
            PG8_WAIT_V(6); PG8_BAR; PG8_MMA(1, 1, At, B1); PG8_BAR;
            PG8_LDB(B0, 1, 0); PG8_SCHED; PG8_LDA(At, 1, 0); PG8_STAGE(PG8_SA(0, 1), a2 + hstepA, voffA);
            PG8_WAIT_L(8); PG8_BAR; PG8_WAIT_L(0); PG8_MMA(0, 0, At, B0); PG8_BAR; PG8_SCHED;
            PG8_LDB(B1, 1, 1); PG8_STAGE(PG8_SB(1, 0), b3, voffB);
            PG8_BAR; PG8_WAIT_L(0); PG8_MMA(0, 1, At, B1); PG8_BAR;
            PG8_LDA(At, 1, 1); PG8_STAGE(PG8_SA(1, 0), a3, voffA);
            PG8_BAR; PG8_WAIT_L(0); PG8_MMA(1, 0, At, B0); PG8_BAR; PG8_SCHED;
            PG8_STAGE(PG8_SB(1, 1), b3 + hstep, voffB);
            PG8_WAIT_V(6); PG8_BAR; PG8_MMA(1, 1, At, B1); PG8_BAR;
            }
        }
        if constexpr (ALIGN_EPI) { if (wr == 0) PG8_BAR; }
        if constexpr (!Epi::AFTER_DRAIN) { E(acc, cur, wr, wc, fr, fq); S.done(cur); }
        if (!has_next) break;
#pragma unroll
        for (int a = 0; a < 2; ++a)
#pragma unroll
            for (int b = 0; b < 2; ++b)
#pragma unroll
                for (int m = 0; m < 4; ++m)
#pragma unroll
                    for (int n = 0; n < 2; ++n) acc[a][b][m][n] = (f32x4){0.f, 0.f, 0.f, 0.f};
        cur = nxt; cA = nA; cB = nB; ++ui;
        if constexpr (ALIGN_EPI) { if (wr == 1) PG8_BAR; }
    }
    PG8_WAIT_V(0);
    if constexpr (!ALIGN_EPI) { if (wr == 0) PG8_BAR; }
    PG8_BAR;
    if constexpr (Epi::AFTER_DRAIN) { E.fused(acc, cur, wr, wc, fr, fq, lds, wid, lane); S.done(cur); }
#undef PG8_SA
#undef PG8_SB
#undef PG8_STAGE
#undef PG8_LDA
#undef PG8_LDB
#undef PG8_MMA
#undef PG8_WAIT_V
#undef PG8_WAIT_L
#undef PG8_BAR
#undef PG8_SCHED
}
}

#ifndef PG8_SP2
#define PG8_SP2 true
#endif
#ifndef PG8_ALIGN
#define PG8_ALIGN true
#endif
namespace att {
#define LAS3 __attribute__((address_space(3)))
using bf16x8 = __attribute__((ext_vector_type(8))) short;
using s16x4 = __attribute__((ext_vector_type(4))) short;
using f32x16 = __attribute__((ext_vector_type(16))) float;
using f32x4 = __attribute__((ext_vector_type(4))) float;
using u32x4 = __attribute__((ext_vector_type(4))) unsigned;
typedef unsigned short u16;
typedef LAS3 const unsigned char* lds_cptr;
typedef short v4i16_t __attribute__((ext_vector_type(4)));
constexpr int SEQ = 16384, NW = 8, QBLK = 32, QB = 256, KVBLK = 64;
constexpr int KSLOT = 12288, VSLOT = 8192, NKS = 4, NVS = 4;
constexpr int LDS_K = 0, LDS_V = NKS * KSLOT, LDS_WS = LDS_V + NVS * VSLOT, LDS_OST = LDS_WS + NW * 256, LDS_QX = LDS_OST + NW * 4096, LDS_BYTES = LDS_QX + NW * 2048;
__device__ __forceinline__ int crow(int r, int hi) { return (r & 3) + 8 * (r >> 2) + 4 * hi; }
__device__ __forceinline__ void glds16(const void* gsrc, unsigned lds_dst) { unsigned keep;
    asm volatile("s_mov_b32 %0, m0\n\ts_mov_b32 m0, %2\n\ts_nop 0\n\tglobal_load_lds_dwordx4 %1, off\n\ts_mov_b32 m0, %0" : "=&s"(keep) : "v"(gsrc), "s"(lds_dst) : "memory"); }
typedef float f32x2_t __attribute__((ext_vector_type(2))); typedef __bf16 bf16x2_t __attribute__((ext_vector_type(2)));
__device__ __forceinline__ unsigned cvtpk_s(float lo, float hi) { f32x2_t v = {lo, hi}; bf16x2_t b = __builtin_convertvector(v, bf16x2_t); return __builtin_bit_cast(unsigned, b); }
__device__ __forceinline__ s16x4 vtr(lds_cptr p) { return __builtin_bit_cast(s16x4, __builtin_amdgcn_ds_read_tr16_b64_v4i16((LAS3 v4i16_t*)p)); }
#define ATT_SBAR() __builtin_amdgcn_sched_barrier(0)
#define ATT_WAIT_BAR(N) asm volatile("s_waitcnt vmcnt(" #N ") lgkmcnt(0)\n\ts_barrier" ::: "memory")
struct Src {
    const u16* q; int qp;
    const u16* k; int kp;
    const u16* k2; int k2p;
    const u16* v; int vp;
    u16* o; int op;
};
template <int NDK, int NQR, bool ZC, int XHS, int JLO, int JHI, bool EARLY>
__device__ __forceinline__ void phase_a(f32x16& C0, f32x16& C1, const lds_cptr* kb_, int ksl_, const bf16x8* qr, lds_cptr qx_, const f32x16& negm, bf16x8* kf, bf16x8* qx) {
    constexpr int KPF = 4;
#define ATT_SH(s_) (EARLY ? ((s_) / NDK) : ((s_) & 1))
#define ATT_SD(s_) (EARLY ? ((s_) % NDK) : ((s_) >> 1))
#define ATT_KRD(s_) kf[s_] = *(const LAS3 bf16x8*)(kb_[ATT_SD(s_)] + ksl_ + ATT_SH(s_) * (ATT_SD(s_) < 4 ? 4096 : XHS))
    if (JLO == 0) {
#pragma unroll
        for (int j = 0; j < KPF; ++j) ATT_KRD(j); }
#pragma unroll
    for (int j = JLO; j < JHI; ++j) {
        if (j + KPF < 2 * NDK) ATT_KRD(j + KPF);
        { const int dn = ATT_SD(j) + 2; if (NDK > NQR && dn >= NQR && dn < NDK && (EARLY || ATT_SH(j) == 0)) qx[dn >= NQR ? dn - NQR : 0] = *(const LAS3 bf16x8*)(qx_ + (dn >= NQR ? dn - NQR : 0) * 1024); }
        ATT_SBAR();
        const int d0 = ATT_SD(j); const f32x16 z = f32x16{}; const bf16x8 qf = (d0 < NQR) ? qr[d0 < NQR ? d0 : 0] : qx[d0 >= NQR ? d0 - NQR : 0];
        if (ATT_SH(j)) C1 = __builtin_amdgcn_mfma_f32_32x32x16_bf16(kf[j], qf, (d0 == 0) ? (ZC ? z : negm) : C1, 0, 0, 0);
        else           C0 = __builtin_amdgcn_mfma_f32_32x32x16_bf16(kf[j], qf, (d0 == 0) ? (ZC ? z : negm) : C0, 0, 0, 0);
        if (EARLY && j > NDK) { const int e0 = 16 * (j - NDK - 1) / (NDK - 1), e1 = 16 * (j - NDK) / (NDK - 1);
#pragma unroll
            for (int e = e0; e < e1; ++e) C0[e] = __builtin_amdgcn_exp2f(C0[e]);
            asm volatile("" : "+v"(C0)); }
        ATT_SBAR();
    }
#undef ATT_KRD
#undef ATT_SH
#undef ATT_SD
}
template <bool QK, bool FIN, bool EARLY>
__device__ __forceinline__ void phase_b(f32x16& C0, f32x16& C1, f32x16* o, lds_cptr vp_, u32x4* pw, float& l_reg) {
    s16x4 vlo[8], vhi[8]; float sacc = 0.f, sacd = 0.f;
#define ATT_VRD(i) do { const int vi_ = ((i) >> 1) + 4 * ((i) & 1); vlo[i] = vtr(vp_ + ((vi_ >> 2) * 4096 + (vi_ & 3) * 1024)); vhi[i] = vtr(vp_ + ((vi_ >> 2) * 4096 + (vi_ & 3) * 1024 + 512)); } while (0)
    if (FIN) { ATT_VRD(0); ATT_VRD(1); }
#pragma unroll
    for (int i = 0; i < 8; ++i) {
        if (FIN && i + 2 < 8) ATT_VRD(i + 2);
        ATT_SBAR();
        if (FIN) { const bf16x8 vf = (bf16x8){vlo[i][0], vlo[i][1], vlo[i][2], vlo[i][3], vhi[i][0], vhi[i][1], vhi[i][2], vhi[i][3]};
            o[i & 1] = __builtin_amdgcn_mfma_f32_32x32x16_bf16(__builtin_bit_cast(bf16x8, pw[i >> 1]), vf, o[i & 1], 0, 0, 0); }
        if (QK) { f32x16& X = (i < 4) ? C0 : C1; const int b = 4 * (i & 3);
            if (EARLY) { C1[2 * i] = __builtin_amdgcn_exp2f(C1[2 * i]); C1[2 * i + 1] = __builtin_amdgcn_exp2f(C1[2 * i + 1]); asm volatile("" : "+v"(C1)); }
            else { X[b] = __builtin_amdgcn_exp2f(X[b]); X[b + 1] = __builtin_amdgcn_exp2f(X[b + 1]); X[b + 2] = __builtin_amdgcn_exp2f(X[b + 2]); X[b + 3] = __builtin_amdgcn_exp2f(X[b + 3]); }
            sacc += X[b]; sacd += X[b + 1]; sacc += X[b + 2]; sacd += X[b + 3]; asm volatile("" : "+v"(sacc), "+v"(sacd));
            if (i & 1) { const int k = i >> 1, c = 8 * (k & 1);
                pw[k] = (u32x4){cvtpk_s(X[c], X[c + 1]), cvtpk_s(X[c + 2], X[c + 3]), cvtpk_s(X[c + 4], X[c + 5]), cvtpk_s(X[c + 6], X[c + 7])}; asm volatile("" : "+v"(pw[k])); } }
        ATT_SBAR();
    }
#undef ATT_VRD
    if (QK) l_reg += sacc + sacd;
}
template <bool MLA, bool FIX> __device__ __forceinline__ void attn_unit(int qb, const Src& s, LAS3 unsigned char* shm, const float* bias_h, float kmax2, const float* qmax_h) {
    constexpr int NDK = MLA ? 6 : 5, NX = MLA ? 4 : 1, NQR = MLA ? 4 : 5;
    constexpr float THRL = MLA ? 8.0f : 16.0f;
    const int tid = threadIdx.x, lane = tid & 63, r32 = lane & 31, hi = lane >> 5; const int wid = __builtin_amdgcn_readfirstlane(tid >> 6);
    const int q0 = qb * QB;
    const unsigned lds0 = (unsigned)(uintptr_t)shm;
    LAS3 float* wsf = (LAS3 float*)(shm + LDS_WS) + wid * 64;
    const int NT = (q0 + QB) / KVBLK;
    const int wvis = NT - 4 + (wid >> 1);
    const bool xw = wid < NX;
    const int krow = 8 * wid + (lane >> 3);
    const u16* ksrc = s.k + (size_t)krow * s.kp + (((lane & 7) ^ ((krow >> 1) & 7)) * 8);
    const int k2row = 16 * (wid & 3) + (lane >> 2);
    const u16* k2src = MLA ? s.k2 + (size_t)k2row * s.k2p + (((lane & 3) ^ ((k2row >> 2) & 3)) * 8) : s.k2 + (size_t)lane * s.k2p;
    const u16* vsrc = s.v + (size_t)(16 * (wid & 3) + (lane >> 2)) * s.vp + (wid >> 2) * 32 + (lane & 3) * 8;
    const unsigned kdst = lds0 + LDS_K + wid * 1024, k2dst = lds0 + LDS_K + (8 + (wid & 3)) * 1024, vdst = lds0 + LDS_V + wid * 1024;
#define ATT_DMA_K(t) do { const int sl_ = (t) & 3; glds16(ksrc + (size_t)(t) * KVBLK * s.kp, (unsigned)__builtin_amdgcn_readfirstlane(kdst + sl_ * KSLOT)); \
        if (xw) glds16(k2src + (size_t)(t) * KVBLK * s.k2p, (unsigned)__builtin_amdgcn_readfirstlane(k2dst + sl_ * KSLOT)); } while (0)
#define ATT_DMA_V(t, vsl) glds16(vsrc + (size_t)(t) * KVBLK * s.vp, (unsigned)__builtin_amdgcn_readfirstlane(vdst + (vsl)))
    if (!MLA) {
        if (tid < 256) { const int sl = tid >> 6; *(LAS3 f32x4*)(shm + LDS_K + sl * KSLOT + 9 * 1024 + (tid & 63) * 16) = (f32x4){0.f, 0.f, 0.f, 0.f}; } }
    if (MLA) { ATT_DMA_K(0); ATT_DMA_V(0, 0); ATT_DMA_K(1); ATT_DMA_K(2); }
    const u16* Qw = s.q + (size_t)(q0 + wid * QBLK + r32) * s.qp + hi * 8;
    bf16x8 qr[NQR];
#pragma unroll
    for (int d0 = 0; d0 < 4; ++d0) qr[d0] = *reinterpret_cast<const bf16x8*>(Qw + d0 * 16);
    const lds_cptr qx0 = (lds_cptr)shm + LDS_QX + wid * 2048 + lane * 16;
    float mla_ref = 0.f;
    if (MLA) { const bf16x8 q4 = *reinterpret_cast<const bf16x8*>(Qw + 64), q5 = *reinterpret_cast<const bf16x8*>(Qw + 80);
        *(LAS3 bf16x8*)(shm + LDS_QX + wid * 2048 + lane * 16) = q4; *(LAS3 bf16x8*)(shm + LDS_QX + wid * 2048 + 1024 + lane * 16) = q5;
        if (FIX) { float nq = 0.f;
#pragma unroll
            for (int e = 0; e < 8; ++e) { const float a = __uint_as_float((unsigned)(unsigned short)q4[e] << 16), b = __uint_as_float((unsigned)(unsigned short)q5[e] << 16); nq += a * a + b * b; }
#pragma unroll
            for (int d0 = 0; d0 < 4; ++d0)
#pragma unroll
                for (int e = 0; e < 8; ++e) { const float a = __uint_as_float((unsigned)(unsigned short)qr[d0][e] << 16); nq += a * a; }
            nq += __shfl_xor(nq, 32); mla_ref = sqrtf(nq * kmax2); } }
    const short one = hi ? (short)0 : (short)0x3F80;
    if (!MLA) qr[NQR - 1] = (bf16x8){one, one, one, 0, 0, 0, 0, 0};
    int t0 = 0;
    if (!MLA) {
        const float qm = qmax_h[qb];
        const float bunit = sqrtf(qm * kmax2);
        const float thr = FIX ? bias_h[q0] - 152.f : bias_h[q0] - 170.f - 2.f * bunit;
        if (FIX) { const float nm_ = -(bias_h[q0 + wid * QBLK + r32] + bunit); const unsigned h_ = cvtpk_s(nm_, 0.f) & 0xffffu; const float r1_ = nm_ - __uint_as_float(h_ << 16); const unsigned m_ = cvtpk_s(r1_, 0.f) & 0xffffu;
            const float r2_ = r1_ - __uint_as_float(m_ << 16); const unsigned l_ = cvtpk_s(r2_, 0.f) & 0xffffu;
            if (hi == 0) qr[NQR - 1] = (bf16x8){one, one, one, (short)h_, (short)m_, (short)l_, 0, 0}; }
        int best = 0;
        for (int tt = 1 + lane; tt <= NT - 4; tt += 64) { if (bias_h[64 * tt - 1] < thr) best = tt; }
#pragma unroll
        for (int o_ = 32; o_ >= 1; o_ >>= 1) best = max(best, __shfl_xor(best, o_));
        t0 = __builtin_amdgcn_readfirstlane(best);
    }
    if (!MLA) { ATT_DMA_K(t0); ATT_DMA_V(t0, (t0 & 3) * VSLOT); ATT_DMA_K(t0 + 1); ATT_DMA_K(t0 + 2); }
    float mhat = 0.f, l_reg = 0.f; f32x16 o[2]; o[0] = f32x16{}; o[1] = f32x16{}; f32x16 negm = f32x16{};
    if (MLA && FIX) {
#pragma unroll
        for (int r = 0; r < 16; ++r) negm[r] = -mla_ref; }
    const int qrel = wid * QBLK + r32;
    lds_cptr kb[NDK];
#pragma unroll
    for (int d0 = 0; d0 < 4; ++d0) kb[d0] = (lds_cptr)shm + LDS_K + r32 * 128 + ((((2 * d0 + hi) ^ ((r32 >> 1) & 7))) << 4);
    if (MLA) {
#pragma unroll
        for (int d0 = 4; d0 < NDK; ++d0) kb[d0] = (lds_cptr)shm + LDS_K + 8192 + r32 * 64 + ((((2 * (d0 - 4) + hi) ^ ((r32 >> 2) & 3))) << 4);
    } else kb[NDK - 1] = (lds_cptr)shm + LDS_K + 8192 + hi * 1024 + r32 * 16;
    constexpr int XHS = MLA ? 2048 : 512;
    const lds_cptr vp0 = (lds_cptr)shm + LDS_V + ((lane >> 4) & 1) * 32 + (lane & 3) * 8 + (4 * hi + ((lane & 15) >> 2)) * 64;
    f32x16 C0, C1; u32x4 pw[4]; bool resc = false;
#define ATT_TOP(t) do { if ((t) == t0 || (t) + 2 >= NT) { ATT_WAIT_BAR(0); } else if (xw) { ATT_WAIT_BAR(3); } else { ATT_WAIT_BAR(2); } \
        } while (0)
#define ATT_ISSUE(t) do { if ((t) + 3 < NT) ATT_DMA_K((t) + 3); if ((t) + 1 < NT) ATT_DMA_V((t) + 1, (((t) + 1) & 3) * VSLOT); } while (0)
#ifdef ATT_QKPRIO
#define ATT_PRIO_ON() __builtin_amdgcn_s_setprio(1)
#define ATT_PRIO_OFF() __builtin_amdgcn_s_setprio(0)
#else
#define ATT_PRIO_ON()
#define ATT_PRIO_OFF()
#endif
#define ATT_QK(t, E) do { bf16x8 kf_[2 * NDK]; bf16x8 qx_[NDK > NQR ? NDK - NQR : 1]; \
        phase_a<NDK, NQR, !MLA, XHS, 0, 4, E>(C0, C1, ATT_KS(t), qr, qx0, negm, kf_, qx_); ATT_ISSUE(t); ATT_SBAR(); \
        phase_a<NDK, NQR, !MLA, XHS, 4, 2 * NDK, E>(C0, C1, ATT_KS(t), qr, qx0, negm, kf_, qx_); } while (0)
#define ATT_MASK(C0, C1, t) do { const int kbq_ = 64 * ((t) - (NT - 4)) + 4 * hi; \
        _Pragma("unroll") for (int r = 0; r < 16; ++r) { const int kv_ = kbq_ + (r & 3) + 8 * (r >> 2); if (kv_ > qrel) C0[r] = -INFINITY; if (kv_ + 32 > qrel) C1[r] = -INFINITY; } } while (0)
#define ATT_DECIDE(C0, C1, FIRST) do { if (!FIX) { \
        float a_ = fmaxf(fmaxf(C0[0], C0[1]), C1[0]), b_ = fmaxf(fmaxf(C0[2], C0[3]), C1[1]); a_ = fmaxf(fmaxf(a_, C1[2]), C1[3]); \
        _Pragma("unroll") for (int r = 4; r < 16; r += 4) { a_ = fmaxf(fmaxf(a_, C0[r]), C0[r + 1]); b_ = fmaxf(fmaxf(b_, C0[r + 2]), C0[r + 3]); a_ = fmaxf(fmaxf(a_, C1[r]), C1[r + 1]); b_ = fmaxf(fmaxf(b_, C1[r + 2]), C1[r + 3]); } \
        float rm_ = fmaxf(a_, b_); { auto rr_ = __builtin_amdgcn_permlane32_swap(__float_as_uint(rm_), __float_as_uint(rm_), false, false); rm_ = fmaxf(__uint_as_float(rr_[0]), __uint_as_float(rr_[1])); } \
        resc = false; \
        if ((FIRST) || __any(rm_ > THRL)) { float dl_ = (FIRST) ? rm_ : fmaxf(rm_, 0.f); \
            if (!MLA) { const float nm_ = -(mhat + dl_); const unsigned h_ = cvtpk_s(nm_, 0.f) & 0xffffu; const float r1_ = nm_ - __uint_as_float(h_ << 16); const unsigned m_ = cvtpk_s(r1_, 0.f) & 0xffffu; \
                const float r2_ = r1_ - __uint_as_float(m_ << 16); const unsigned l_ = cvtpk_s(r2_, 0.f) & 0xffffu; \
                const float mn_ = -((__uint_as_float(h_ << 16) + __uint_as_float(m_ << 16)) + __uint_as_float(l_ << 16)); dl_ = mn_ - mhat; mhat = mn_; \
                if (hi == 0) qr[NQR - 1] = (bf16x8){one, one, one, (short)h_, (short)m_, (short)l_, 0, 0}; } \
            else { mhat += dl_; _Pragma("unroll") for (int r = 0; r < 16; ++r) negm[r] = -mhat; } \
            _Pragma("unroll") for (int r = 0; r < 16; ++r) { C0[r] -= dl_; C1[r] -= dl_; } \
            if (!(FIRST)) { const float f_ = __builtin_amdgcn_exp2f(-dl_); l_reg *= f_; if (hi == 0) wsf[r32] = f_; resc = true; } } } } while (0)
#define ATT_RESC() do { if (!FIX && resc) { \
        _Pragma("unroll") for (int i = 0; i < 4; ++i) { const f32x4 fv_ = *(const LAS3 f32x4*)(wsf + 8 * i + 4 * hi); \
            _Pragma("unroll") for (int d = 0; d < 2; ++d) { o[d][4 * i] *= fv_[0]; o[d][4 * i + 1] *= fv_[1]; o[d][4 * i + 2] *= fv_[2]; o[d][4 * i + 3] *= fv_[3]; } } } } while (0)
#define ATT_VS(tt) (vp0 + (((tt)) & 3) * VSLOT)
#define ATT_KS(tt) kb, ((((tt)) & 3) * KSLOT)
#ifndef ATT_STAGGER
#define ATT_STAGGER 0
#endif
    if (!ATT_STAGGER || wid < 4) {
#define ATT_STEP(t, MASKED) do { ATT_TOP(t); \
        constexpr bool E_ = FIX && (MLA || !(MASKED)); \
        ATT_QK(t, E_); \
        if (!MLA && (MASKED)) ATT_MASK(C0, C1, t); \
        ATT_DECIDE(C0, C1, false); ATT_SBAR(); \
        phase_b<true, true, E_>(C0, C1, o, ATT_VS((t) - 1), pw, l_reg); \
        ATT_RESC(); } while (0)
        ATT_TOP(t0);
        ATT_QK(t0, false);
        if (!MLA && wvis == t0) ATT_MASK(C0, C1, t0);
        ATT_DECIDE(C0, C1, true); ATT_SBAR();
        phase_b<true, false, false>(C0, C1, o, vp0, pw, l_reg);
        int t = t0 + 1;
        for (; t < wvis; ++t) ATT_STEP(t, false);
        if (t == wvis) { ATT_STEP(t, true); ++t; }
        { ATT_TOP(t); ATT_ISSUE(t); phase_b<false, true, false>(C0, C1, o, ATT_VS(t - 1), pw, l_reg); ++t; }
        for (; t <= NT + ATT_STAGGER; ++t) { ATT_TOP(t); ATT_ISSUE(t); }
#undef ATT_STEP
    } else {
        ATT_TOP(t0);
        ATT_QK(t0, false);
        ATT_DECIDE(C0, C1, true); ATT_SBAR();
        ATT_TOP(t0 + 1);
        phase_b<true, false, false>(C0, C1, o, vp0, pw, l_reg); ATT_SBAR();
        ATT_QK(t0 + 1, false);
        ATT_DECIDE(C0, C1, false); ATT_SBAR();
        int t = t0 + 2;
#define ATT_STEP2(t, MASKED) do { ATT_TOP(t); \
        phase_b<true, true, false>(C0, C1, o, ATT_VS((t) - 2), pw, l_reg); \
        ATT_RESC(); ATT_SBAR(); \
        ATT_QK(t, false); \
        if (!MLA && (MASKED)) ATT_MASK(C0, C1, t); \
        ATT_DECIDE(C0, C1, false); ATT_SBAR(); } while (0)
        for (; t < wvis; ++t) ATT_STEP2(t, false);
        ATT_STEP2(t, true); ++t;
        { ATT_TOP(t); ATT_ISSUE(t); phase_b<true, true, false>(C0, C1, o, ATT_VS(t - 2), pw, l_reg); ATT_RESC(); ++t; }
        { ATT_TOP(t); ATT_ISSUE(t); phase_b<false, true, false>(C0, C1, o, ATT_VS(t - 2), pw, l_reg); ++t; }
        for (; t <= NT + ATT_STAGGER; ++t) { ATT_TOP(t); ATT_ISSUE(t); }
#undef ATT_STEP2
    }
    { auto rr = __builtin_amdgcn_permlane32_swap(__float_as_uint(l_reg), __float_as_uint(l_reg), false, false); l_reg = __uint_as_float(rr[0]) + __uint_as_float(rr[1]); }
    if (hi == 0) wsf[32 + r32] = 1.0f / l_reg;
    float rli[16];
#pragma unroll
    for (int i = 0; i < 4; ++i) { const f32x4 fv = *(const LAS3 f32x4*)(wsf + 32 + 8 * i + 4 * hi); rli[4 * i] = fv[0]; rli[4 * i + 1] = fv[1]; rli[4 * i + 2] = fv[2]; rli[4 * i + 3] = fv[3]; }
    u16* Ow = s.o + (size_t)(q0 + wid * QBLK) * s.op;
    { LAS3 u16* stg = (LAS3 u16*)(shm + LDS_OST) + wid * 2048;
#pragma unroll
        for (int r = 0; r < 16; ++r) { const int orow = crow(r, hi);
#pragma unroll
            for (int d0 = 0; d0 < 2; ++d0) stg[orow * 64 + d0 * 32 + r32] = (u16)(cvtpk_s(o[d0][r] * rli[r], 0.f) & 0xffffu); }
        asm volatile("s_waitcnt lgkmcnt(0)" ::: "memory");
#pragma unroll
        for (int i = 0; i < 4; ++i) { const int row = i * 8 + (lane >> 3), ch = lane & 7; const u32x4 v = *(const LAS3 u32x4*)(stg + row * 64 + ch * 8); *(u32x4*)(Ow + (size_t)row * s.op + ch * 8) = v; } }
    asm volatile("s_waitcnt lgkmcnt(0)\n\ts_barrier" ::: "memory");
#undef ATT_DMA_K
#undef ATT_DMA_V
#undef ATT_TOP
#undef ATT_ISSUE
#undef ATT_QK
#undef ATT_MASK
#undef ATT_DECIDE
#undef ATT_RESC
#undef ATT_STEP
}
}

namespace cg = cooperative_groups;
#define LAS __attribute__((address_space(3)))
typedef unsigned short bf16;
typedef unsigned v4u __attribute__((ext_vector_type(4)));
typedef unsigned v2u __attribute__((ext_vector_type(2)));
typedef float f32x4 __attribute__((ext_vector_type(4)));
constexpr int NWAVES = 8;
constexpr int M = 16384, D = 1024, FF = 4096, NIN = 1960, NINP = 2048, QL = 256, KVL = 128, NQU = 768, NKVU = 1024;
constexpr float EPS = 1e-6f;
constexpr float LOG2E = 1.4426950408889634f;
constexpr float C2_FOX = 0.125f * LOG2E, C2_MLA = 0.10206207261596575f * LOG2E;
constexpr size_t MiB = 1u << 20;
constexpr size_t WS_WIN = 1 * MiB, WS_WQ = 5 * MiB, WS_WKV = 5 * MiB + 512 * 1024, WS_WO = 6 * MiB, WS_W1 = 8 * MiB, WS_W2 = 16 * MiB;
constexpr size_t WS_RT = 24 * MiB, WS_LF = 26 * MiB, WS_LC = 26 * MiB + 512 * 1024, WS_SS = 27 * MiB, WS_KR = 28 * MiB, WS_KB = 29 * MiB, WS_SSQ = 31 * MiB, WS_SSKV = 31 * MiB + 512 * 1024, WS_BIASF = 28 * MiB;
constexpr size_t WS_XN = 32 * MiB, WS_H = 64 * MiB, WS_P = 64 * MiB, WS_QM = 128 * MiB, WS_KVM = 152 * MiB, WS_QN = 184 * MiB, WS_O = 192 * MiB, WS_KVN = 224 * MiB, WS_END = 228 * MiB;
constexpr int RING_BYTES = 131072, LDS_BYTES = 147456;
static_assert(att::LDS_BYTES <= LDS_BYTES, "attention scratch fits the LDS allocation");

__device__ __forceinline__ unsigned f2bf(float f) { unsigned u = __builtin_bit_cast(unsigned, f); return (u + 0x7fffu + ((u >> 16) & 1u)) >> 16; }
__device__ __forceinline__ unsigned pk2(float lo, float hi) { return f2bf(lo) | (f2bf(hi) << 16); }
__device__ __forceinline__ float bf2f(unsigned short h) { return __builtin_bit_cast(float, (unsigned)h << 16); }
__device__ __forceinline__ float wave_sum(float v) {
#pragma unroll
    for (int o = 1; o < 64; o <<= 1) v += __shfl_xor(v, o);
    return v;
}
__device__ __forceinline__ int map_row(int mode, int n) {
    if (mode == 1) { const int h = n / 96, d = n % 96; if (d < 64) return n; const int i = d - 64; return h * 96 + (i < 16 ? 64 + 2 * i : 64 + 2 * (i - 16) + 1); }
    if (mode == 2) { const int h = n >> 7, j = n & 127; return j < 64 ? h * 64 + j : 512 + h * 64 + (j - 64); }
    if (mode == 3) { if (n < 1536 || n >= 1960) return n; if (n < 1544) return 1952 + (n - 1536); if (n < 1800) return 1536 + (n - 1544); if (n < 1928) return 1792 + (n - 1800);
        const int i = n - 1928; return 1920 + (i < 16 ? 2 * i : 2 * (i - 16) + 1); }
    return n;
}
__device__ __forceinline__ void p0_transpose_item(const float* W, int K, int N, int nblk, bf16* WT, int mode, const float* gk, LAS float* scr, int item, int lane) {
    const int kb = item / nblk, nb = item % nblk, k0 = 64 * kb, n0 = 32 * nb;
    const int nn = n0 + (lane & 31);
    float wv[32];
#pragma unroll
    for (int i = 0; i < 32; ++i) { const int kk = 2 * i + (lane >> 5); wv[i] = (nn < N) ? W[(size_t)(k0 + kk) * N + nn] : 0.f; }
    if (gk) {
#pragma unroll
        for (int i = 0; i < 32; ++i) wv[i] *= gk[k0 + 2 * i + (lane >> 5)]; }
#pragma unroll
    for (int i = 0; i < 32; ++i) { const int kk = 2 * i + (lane >> 5); scr[kk * 33 + (lane & 31)] = wv[i]; }
    asm volatile("s_waitcnt lgkmcnt(0)" ::: "memory");
    const int c = lane & 7;
#pragma unroll
    for (int j = 0; j < 4; ++j) { const int n = (lane >> 3) + 8 * j; const LAS float* sp = scr + (8 * c) * 33 + n;
        v4u o; o.x = pk2(sp[0 * 33], sp[1 * 33]); o.y = pk2(sp[2 * 33], sp[3 * 33]); o.z = pk2(sp[4 * 33], sp[5 * 33]); o.w = pk2(sp[6 * 33], sp[7 * 33]);
        *(v4u*)(WT + (size_t)map_row(mode, n0 + n) * K + k0 + 8 * c) = o; }
    asm volatile("s_waitcnt lgkmcnt(0)" ::: "memory");
}
__device__ __forceinline__ void sincos_d(double x, float& sn, float& cs) {
    const double k = rint(x * 0.63661977236758134308);
    double r = fma(-k, 1.57079632679489655800e+00, x); r = fma(-k, 6.12323399573676603587e-17, r);
    const double r2 = r * r;
    double s = -1.0 / 6227020800.0; s = s * r2 + 1.0 / 39916800.0; s = s * r2 - 1.0 / 362880.0; s = s * r2 + 1.0 / 5040.0; s = s * r2 - 1.0 / 120.0; s = s * r2 + 1.0 / 6.0; s = r - r * r2 * s;
    double c = 1.0 / 479001600.0; c = c * r2 - 1.0 / 3628800.0; c = c * r2 + 1.0 / 40320.0; c = c * r2 - 1.0 / 720.0; c = c * r2 + 1.0 / 24.0; c = c * r2 - 0.5; c = 1.0 + r2 * c;
    const int q = ((int)k) & 3;
    const double ss = (q == 0) ? s : (q == 1) ? c : (q == 2) ? -s : -c;
    const double cc = (q == 0) ? c : (q == 1) ? -s : (q == 2) ? -c : s;
    sn = (float)ss; cs = (float)cc;
}

#define RLX_AGENT __ATOMIC_RELAXED, __HIP_MEMORY_SCOPE_AGENT
#define XB_TMO      128
#define XB_XCNT(j)  (256  + 64 * (j))
#define XB_XSUB(j)  (1280 + 64 * (j))
#define XB_XGEN(j)  (2304 + 64 * (j))
#define XB_TOP      3328
#define XB_TOPGEN   3392
#define XCD_BAR_WORDS 3456
#define XB_SPIN_CAP (1u << 18)

__device__ __forceinline__ unsigned xb_ld(unsigned* p)              { return __hip_atomic_load(p, __ATOMIC_RELAXED, __HIP_MEMORY_SCOPE_AGENT); }
__device__ __forceinline__ unsigned xb_add(unsigned* p, unsigned v) { return __hip_atomic_fetch_add(p, v, __ATOMIC_RELAXED, __HIP_MEMORY_SCOPE_AGENT); }
__device__ __forceinline__ unsigned xb_xcc_id() { return (unsigned)__builtin_amdgcn_s_getreg((3 << 11) | 20) & 0xFu; }
#define XB_SPIN(cond, bar) do { unsigned _sp = 0; while (cond) { __builtin_amdgcn_s_sleep(1); \
    if ((++_sp & 255u) == 0u) { if (xb_ld(&(bar)[XB_TMO])) break; if (_sp > XB_SPIN_CAP) { atomicAdd(&(bar)[XB_TMO], 1u); break; } } } } while (0)

struct XcdBarrier {
    unsigned* bar; unsigned x;
    volatile LAS unsigned* st;
};

__device__ __forceinline__ XcdBarrier xcd_barrier_post(unsigned* bar, volatile LAS unsigned* st) {
    XcdBarrier b; b.bar = bar; b.x = xb_xcc_id(); b.st = st;
    if (threadIdx.x == 0) (void)xb_add(&bar[XB_XCNT(b.x)], 1u);
    return b;
}
__device__ __forceinline__ void xcd_barrier_complete(unsigned* bar, unsigned x, unsigned& nloc, unsigned& nx) {
    const unsigned G = gridDim.x * gridDim.y * gridDim.z;
    unsigned sum, cnt, mine, sp = 0u;
    for (;;) {
        sum = 0u; cnt = 0u; mine = 0u;
#pragma unroll
        for (unsigned j = 0; j < 16; ++j) { const unsigned c = xb_ld(&bar[XB_XCNT(j)]); sum += c; cnt += (c > 0u) ? 1u : 0u; mine = (j == x) ? c : mine; }
        if (sum == G) break;
        __builtin_amdgcn_s_sleep(1);
        if ((++sp & 255u) == 0u) { if (xb_ld(&bar[XB_TMO])) break; if (sp > XB_SPIN_CAP) { atomicAdd(&bar[XB_TMO], 1u); break; } }
    }
    nloc = mine > 0u ? mine : 1u; nx = cnt > 0u ? cnt : 1u;
}

__device__ __forceinline__ void xcd_barrier(const XcdBarrier& b) {
    asm volatile("s_waitcnt vmcnt(0)" ::: "memory");
    __syncthreads();
    if (threadIdx.x == 0) {
        unsigned* bar = b.bar;
        __builtin_amdgcn_s_waitcnt(0);
        unsigned nloc = b.st[0], nx = b.st[1];
        if (nloc == 0u) { xcd_barrier_complete(bar, b.x, nloc, nx); b.st[0] = nloc; b.st[1] = nx; }
        const unsigned old = xb_add(&bar[XB_XSUB(b.x)], 1u);
        const unsigned gen = old / nloc;
        if (old + 1u == (gen + 1u) * nloc) {
            __builtin_amdgcn_fence(__ATOMIC_RELEASE, "agent");
            asm volatile("s_waitcnt vmcnt(0)" ::: "memory");
            const unsigned og = xb_add(&bar[XB_TOP], 1u);
            const unsigned tg = og / nx;
            if (og + 1u == (tg + 1u) * nx) xb_add(&bar[XB_TOPGEN], 1u);
            else XB_SPIN(xb_ld(&bar[XB_TOPGEN]) == tg, bar);
            __builtin_amdgcn_fence(__ATOMIC_ACQUIRE, "agent");
            xb_add(&bar[XB_XGEN(b.x)], 1u);
            asm volatile("s_waitcnt vmcnt(0)" ::: "memory");
        } else {
            XB_SPIN(xb_ld(&bar[XB_XGEN(b.x)]) == gen, bar);
            __builtin_amdgcn_fence(__ATOMIC_ACQUIRE, "agent");
            asm volatile("s_waitcnt vmcnt(0)" ::: "memory");
        }
    }
    __syncthreads();
}

constexpr int MISC_OFF = LDS_BYTES - 128;
constexpr size_t WS_CTL = 0, CTL_ZERO_BYTES = 64 * 1024;
constexpr int CW_KMAX = 8192, CW_QF = 8192 + 512, CW_QM = 8192 + 1024, CW_PCNT = 8192 + 1536, CW_KMAXM = 13824, CW_QMAXM = 14400, CW_DONE = 14464;
static_assert(att::LDS_BYTES <= MISC_OFF, "LDS map");
struct Args { const float* in[13]; float* out; unsigned char* ws; int ph_lo, ph_hi, dup, pad; };
constexpr int NPHASE = 8;

__global__ void __launch_bounds__(NWAVES * 64, 2) mk_fwd(Args args) {
    extern __shared__ __attribute__((aligned(16))) unsigned char lds_raw[];
    LAS unsigned char* lds = (LAS unsigned char*)lds_raw;
    const int G = gridDim.x, bx = blockIdx.x;
#define MK_IDS int tid = threadIdx.x; asm volatile("" : "+v"(tid)); const int lane = tid & 63, wave = __builtin_amdgcn_readfirstlane(tid >> 6); const int gw = vcu * NWAVES + wave; (void)gw; (void)lane;
    const int vcu = (G % 8 == 0) ? (bx % 8) * (G / 8) + bx / 8 : bx;
    const int NGW = G * NWAVES;
    unsigned char* ws = args.ws;
#define MKP_x ((const float*)args.in[0])
#define MKP_g_mix ((const float*)args.in[1])
#define MKP_w_in ((const float*)args.in[2])
#define MKP_b_f ((const float*)args.in[3])
#define MKP_g_q ((const float*)args.in[4])
#define MKP_w_q_up ((const float*)args.in[5])
#define MKP_g_kv ((const float*)args.in[6])
#define MKP_w_kv_up ((const float*)args.in[7])
#define MKP_w_o ((const float*)args.in[8])
#define MKP_g_mlp ((const float*)args.in[9])
#define MKP_w_ff1 ((const float*)args.in[10])
#define MKP_w_ff2 ((const float*)args.in[11])
#define MKP_g_final ((const float*)args.in[12])
#define MKP_out (args.out)
#define MKP_Win_t ((bf16*)(args.ws + WS_WIN))
#define MKP_Wq_t ((bf16*)(args.ws + WS_WQ))
#define MKP_Wkv_t ((bf16*)(args.ws + WS_WKV))
#define MKP_Wo_t ((bf16*)(args.ws + WS_WO))
#define MKP_W1_t ((bf16*)(args.ws + WS_W1))
#define MKP_W2_t ((bf16*)(args.ws + WS_W2))
#define MKP_RT ((float*)(args.ws + WS_RT))
#define MKP_LF ((float*)(args.ws + WS_LF))
#define MKP_SS ((float*)(args.ws + WS_SS))
#define MKP_SSQ ((float*)(args.ws + WS_SSQ))
#define MKP_BIASF ((float*)(args.ws + WS_BIASF))
#define MKP_QMAX ((float*)(args.ws + WS_LC))
#define MKP_SSKV ((float*)(args.ws + WS_SSKV))
#define MKP_KB ((bf16*)(args.ws + WS_KB))
#define MKP_KR ((bf16*)(args.ws + WS_KR))
#define MKP_XN ((bf16*)(args.ws + WS_XN))
#define MKP_HB ((bf16*)(args.ws + WS_H))
#define MKP_P ((bf16*)(args.ws + WS_P))
#define MKP_QM ((bf16*)(args.ws + WS_QM))
#define MKP_KVM ((bf16*)(args.ws + WS_KVM))
#define MKP_QN ((bf16*)(args.ws + WS_QN))
#define MKP_OB ((bf16*)(args.ws + WS_O))
#define MKP_KVN ((bf16*)(args.ws + WS_KVN))
    const int lo = args.ph_lo, hi = args.ph_hi;
#ifndef MK_MASK
#define MK_MASK 0x1ff
#endif
#define IN(k) (((MK_MASK >> (k)) & 1) && lo <= (k) && (k) < hi)
#define REP(k) for (int rep_ = 0; rep_ < ((args.dup == (k)) ? 2 : 1); ++rep_)
    { volatile LAS unsigned* misc = (volatile LAS unsigned*)(lds + MISC_OFF); if (threadIdx.x < 32) misc[threadIdx.x] = 0u; }
    __syncthreads();
    (void)xcd_barrier_post((unsigned*)(ws + WS_CTL), (volatile LAS unsigned*)(lds + MISC_OFF) + 8);
    if (args.ph_lo < 0) cg::this_grid().sync();
#ifdef TS_PHASE
    unsigned long long ts_a_ = 0, ts_b_ = 0;
#define TS_BEGIN(k) do { if ((k) == TS_PHASE || (TS_PHASE == 99 && (k) == 0)) ts_a_ = __builtin_amdgcn_s_memrealtime(); } while (0)
#define TS_END(k) do { if ((k) == TS_PHASE || (TS_PHASE == 99 && (k) == 7)) ts_b_ = __builtin_amdgcn_s_memrealtime(); } while (0)
#else
#define TS_BEGIN(k)
#define TS_END(k)
#endif
#define SEAM(k) do { if (IN(k) && IN((k) + 1)) { XcdBarrier b_; b_.bar = (unsigned*)(args.ws + WS_CTL); b_.x = xb_xcc_id(); b_.st = (volatile LAS unsigned*)(lds + MISC_OFF) + 8; xcd_barrier(b_); } } while (0)

    TS_BEGIN(0);
    if (IN(0)) { MK_IDS
        LAS float* scr = (LAS float*)(lds + wave * 16384);
        constexpr int I_IN = (D / 64) * (NINP / 32), I_Q = (QL / 64) * (NQU / 32), I_KV = (KVL / 64) * (NKVU / 32), I_O = (D / 64) * (D / 32), I_1 = (D / 64) * (FF / 32), I_2 = (FF / 64) * (D / 32);
        constexpr int NITEMS = I_IN + I_Q + I_KV;
        (void)I_O; (void)I_1; (void)I_2;
        for (int it = gw; it < NITEMS; it += NGW) {
            int r = it;
            if (r < I_IN) { p0_transpose_item(MKP_w_in, D, NIN, NINP / 32, MKP_Win_t, 3, nullptr, scr, r, lane); continue; } r -= I_IN;
            if (r < I_Q) { p0_transpose_item(MKP_w_q_up, QL, NQU, NQU / 32, MKP_Wq_t, 1, MKP_g_q, scr, r, lane); continue; } r -= I_Q;
            p0_transpose_item(MKP_w_kv_up, KVL, NKVU, NKVU / 32, MKP_Wkv_t, 2, MKP_g_kv, scr, r, lane);
        }
        for (int m0 = gw; m0 < M; m0 += 4 * NGW) {
            const f32x4* gr = (const f32x4*)MKP_g_mix + lane; f32x4 v[4][4]; float s2[4];
#pragma unroll
            for (int r = 0; r < 4; ++r) { const int m = m0 + r * NGW; const f32x4* xr = (const f32x4*)(MKP_x + (size_t)(m < M ? m : 0) * D) + lane;
#pragma unroll
                for (int j = 0; j < 4; ++j) v[r][j] = xr[64 * j]; }
#pragma unroll
            for (int r = 0; r < 4; ++r) { s2[r] = 0.f;
#pragma unroll
                for (int j = 0; j < 4; ++j) s2[r] += (v[r][j].x * v[r][j].x + v[r][j].y * v[r][j].y) + (v[r][j].z * v[r][j].z + v[r][j].w * v[r][j].w);
                s2[r] = 1.f / sqrtf(wave_sum(s2[r]) * (1.f / D) + EPS); }
#pragma unroll
            for (int r = 0; r < 4; ++r) { const int m = m0 + r * NGW; if (m < M) { unsigned long long* o8 = (unsigned long long*)(MKP_XN + (size_t)m * D) + lane; const float rstd = s2[r];
#pragma unroll
                for (int j = 0; j < 4; ++j) { const f32x4 g = gr[64 * j]; o8[64 * j] = (unsigned long long)pk2(v[r][j].x * rstd * g.x, v[r][j].y * rstd * g.y) | ((unsigned long long)pk2(v[r][j].z * rstd * g.z, v[r][j].w * rstd * g.w) << 32); } } }
        }
        for (int e = (vcu * NWAVES * 64 + tid); e < M * 16; e += G * NWAVES * 64) {
            const int m = e >> 4, i = e & 15; double inv = 1.0; for (int j = 0; j < i; ++j) inv *= 0.56234132519034908039;
            float sn, cs; sincos_d((double)m * inv, sn, cs); MKP_RT[2 * e] = cs; MKP_RT[2 * e + 1] = sn;
        }
    }
    SEAM(0);
    TS_END(0);
    TS_BEGIN(1);
    if (IN(1)) {
        pg8::Gemm g{MKP_XN, MKP_Win_t, M, NINP, D}; pg8::StaticOrder S; S.init(M, NINP, G, bx);
        pg8::EpiIn E{MKP_P, NINP, C2_FOX, MKP_SSQ, MKP_SSKV, MKP_RT, MKP_b_f, MKP_LF, M};
        pg8::gemm_phase<pg8::EpiIn, pg8::StaticOrder, PG8_ALIGN, PG8_SP2>(lds, g, S, E);
    }
    SEAM(1);
    TS_END(1);
    TS_BEGIN(3);
    if (IN(3)) { MK_IDS
        if (wave >= 2) {
            LAS float* scr = (LAS float*)(lds + wave * 16384);
            constexpr int J_O = (D / 64) * (D / 32), J_1 = (D / 64) * (FF / 32), J_2 = (FF / 64) * (D / 32);
            for (int it = vcu * 6 + (wave - 2); it < J_O + J_1 + J_2; it += G * 6) {
                int r = it;
                if (r < J_O) { p0_transpose_item(MKP_w_o, D, D, D / 32, MKP_Wo_t, 0, nullptr, scr, r, lane); continue; } r -= J_O;
                if (r < J_1) { p0_transpose_item(MKP_w_ff1, D, FF, FF / 32, MKP_W1_t, 0, MKP_g_mlp, scr, r, lane); continue; } r -= J_1;
                p0_transpose_item(MKP_w_ff2, FF, D, D / 32, MKP_W2_t, 0, nullptr, scr, r, lane);
            }
        }
        if (wave < 2) { const int job = bx + 256 * wave;
            if (job < 512 && bx < 256) { const int h = job >> 6, ti = job & 63; const f32x4* lf4 = (const f32x4*)(MKP_LF + (size_t)h * M);
                float pre = 0.f; { int j = 0; float pa[8] = {0.f, 0.f, 0.f, 0.f, 0.f, 0.f, 0.f, 0.f};
                    for (; j + 8 <= ti; j += 8) { f32x4 w[8];
#pragma unroll
                        for (int u = 0; u < 8; ++u) w[u] = lf4[(j + u) * 64 + lane];
#pragma unroll
                        for (int u = 0; u < 8; ++u) pa[u] += (w[u].x + w[u].y) + (w[u].z + w[u].w); }
                    for (; j < ti; ++j) { const f32x4 w = lf4[j * 64 + lane]; pa[0] += (w.x + w.y) + (w.z + w.w); }
                    pre = ((pa[0] + pa[1]) + (pa[2] + pa[3])) + ((pa[4] + pa[5]) + (pa[6] + pa[7])); }
                pre = wave_sum(pre);
                const f32x4 v = lf4[ti * 64 + lane];
                const float s1 = v.x, s2 = s1 + v.y, s3 = s2 + v.z, s4 = s3 + v.w; float inc = s4;
#pragma unroll
                for (int o = 1; o < 64; o <<= 1) { const float n = __shfl_up(inc, o); if (lane >= o) inc += n; }
                const float ex = pre + (inc - s4); const float cs[4] = {ex + s1, ex + s2, ex + s3, ex + s4};
                *(f32x4*)(MKP_BIASF + (size_t)h * M + ti * 256 + 4 * lane) = (f32x4){-cs[0] * LOG2E, -cs[1] * LOG2E, -cs[2] * LOG2E, -cs[3] * LOG2E};
                { float km = 0.f;
                  float qmx = 0.f;
                  for (int e = 0; e < 4; ++e) { const v4u* kr = (const v4u*)(MKP_P + (size_t)(ti * 256 + 4 * lane + e) * NINP + 512 + h * 64); float a2 = 0.f; const v4u* qrw = kr - 64; float q2 = 0.f;
#pragma unroll
                      for (int c8 = 0; c8 < 8; ++c8) { const v4u w = qrw[c8]; const unsigned ww[4] = {w.x, w.y, w.z, w.w};
#pragma unroll
                          for (int q4 = 0; q4 < 4; ++q4) { const float lo_ = __builtin_bit_cast(float, ww[q4] << 16), hi_ = __builtin_bit_cast(float, ww[q4] & 0xffff0000u); q2 += lo_ * lo_ + hi_ * hi_; } }
                      qmx = fmaxf(qmx, q2);
#pragma unroll
                      for (int c8 = 0; c8 < 8; ++c8) { const v4u w = kr[c8]; const unsigned ww[4] = {w.x, w.y, w.z, w.w};
#pragma unroll
                          for (int q4 = 0; q4 < 4; ++q4) { const float lo_ = __builtin_bit_cast(float, ww[q4] << 16), hi_ = __builtin_bit_cast(float, ww[q4] & 0xffff0000u); a2 += lo_ * lo_ + hi_ * hi_; } }
                      km = fmaxf(km, a2); }
#pragma unroll
                  for (int o = 32; o >= 1; o >>= 1) km = fmaxf(km, __shfl_xor(km, o));
#pragma unroll
                  for (int o = 32; o >= 1; o >>= 1) qmx = fmaxf(qmx, __shfl_xor(qmx, o));
                  if (lane == 0) { atomicMax((unsigned*)(args.ws + WS_CTL) + CW_KMAX + 64 * h, __builtin_bit_cast(unsigned, km)); MKP_QMAX[h * 64 + ti] = qmx; } }
#pragma unroll
                for (int e = 0; e < 4; ++e) { const float b = -cs[e] * LOG2E; const unsigned bh = f2bf(b); const float r1 = b - __builtin_bit_cast(float, bh << 16); const unsigned bm = f2bf(r1);
                    const float r2 = r1 - __builtin_bit_cast(float, bm << 16); const unsigned bl = f2bf(r2);
                    *(v4u*)(MKP_KB + ((size_t)h * M + ti * 256 + 4 * lane + e) * 8) = (v4u){bh | (bm << 16), bl | 0x3F800000u, 0x3F803F80u, 0u}; } } }
        __syncthreads();
        { int kq = QL; asm volatile("" : "+s"(kq)); pg8::Gemm g{MKP_P + 1536, MKP_Wq_t, M, NQU, kq, NINP}; pg8::StaticOrder S; S.init(M, NQU, G, bx);
          pg8::EpiQm E{MKP_QM, NQU, MKP_RT, C2_MLA, MKP_SSQ, EPS};
          pg8::gemm_phase<pg8::EpiQm, pg8::StaticOrder, PG8_ALIGN, PG8_SP2>(lds, g, S, E); }
        { int kkv = KVL; asm volatile("" : "+s"(kkv)); pg8::Gemm g{MKP_P + 1792, MKP_Wkv_t, M, NKVU, kkv, NINP}; pg8::StaticOrder S; S.init(M, NKVU, G, bx);
          pg8::EpiKv E{MKP_KVM, NKVU, MKP_SSKV, EPS};
          pg8::gemm_phase<pg8::EpiKv, pg8::StaticOrder, PG8_ALIGN, PG8_SP2>(lds, g, S, E); }
    }
    SEAM(3);
    TS_END(3);
    TS_BEGIN(4);
    if (IN(4)) {
        const int v = (G == 256) ? vcu : bx; const int h0 = (v >> 5) & 7;
        volatile LAS unsigned* misc = (volatile LAS unsigned*)(lds + MISC_OFF);
        unsigned* ctlw = (unsigned*)(args.ws + WS_CTL);
        { const int tid_ = threadIdx.x, lane_ = tid_ & 63, tok = bx * 64 + (tid_ >> 3), hh = tid_ & 7; float k2 = 0.f, q2 = 0.f;
          if (bx < 256) {
            const v4u* kp = (const v4u*)(MKP_KVM + (size_t)tok * NKVU + hh * 64); const v4u* rp = (const v4u*)(MKP_P + (size_t)tok * NINP + 1920); const v4u* qp = (const v4u*)(MKP_QM + (size_t)tok * NQU + hh * 96);
#define MK_SQ(w_, acc_) do { const unsigned ww_[4] = {w_.x, w_.y, w_.z, w_.w}; _Pragma("unroll") for (int q4_ = 0; q4_ < 4; ++q4_) { const float lo_ = __builtin_bit_cast(float, ww_[q4_] << 16), hi_ = __builtin_bit_cast(float, ww_[q4_] & 0xffff0000u); acc_ += lo_ * lo_ + hi_ * hi_; } } while (0)
#pragma unroll
            for (int c8 = 0; c8 < 8; ++c8) { const v4u w = kp[c8]; MK_SQ(w, k2); }
#pragma unroll
            for (int c8 = 0; c8 < 4; ++c8) { const v4u w = rp[c8]; MK_SQ(w, k2); }
#pragma unroll
            for (int c8 = 0; c8 < 12; ++c8) { const v4u w = qp[c8]; MK_SQ(w, q2); }
#undef MK_SQ
          }
#pragma unroll
          for (int o = 8; o <= 32; o <<= 1) { k2 = fmaxf(k2, __shfl_xor(k2, o)); q2 = fmaxf(q2, __shfl_xor(q2, o)); }
          if (lane_ < 8) { atomicMax(ctlw + CW_KMAXM + 64 * lane_, __builtin_bit_cast(unsigned, k2)); atomicMax(ctlw + CW_QMAXM, __builtin_bit_cast(unsigned, q2)); }
          asm volatile("s_waitcnt vmcnt(0)" ::: "memory"); __syncthreads();
          if (tid_ == 0) __hip_atomic_fetch_add(ctlw + CW_DONE, 1u, __ATOMIC_RELAXED, __HIP_MEMORY_SCOPE_AGENT); }
        bool okF = true;
        { const int lane_ = threadIdx.x & 63;
          for (int h = 0; h < 8; ++h) { const float kF = __builtin_bit_cast(float, __hip_atomic_load(ctlw + CW_KMAX + 64 * h, __ATOMIC_RELAXED, __HIP_MEMORY_SCOPE_AGENT));
              float qF = MKP_QMAX[h * 64 + lane_];
#pragma unroll
              for (int o = 32; o >= 1; o >>= 1) qF = fmaxf(qF, __shfl_xor(qF, o));
              okF = okF && (qF * kF < 2025.f); }
          okF = __builtin_amdgcn_readfirstlane(okF ? 1 : 0) != 0; }
#ifndef PROBE_FOX
#define PROBE_FOX 1
#endif
#ifndef PROBE_MLA
#define PROBE_MLA 1
#endif
#define MK_POP(CWQ) \
            if ((threadIdx.x >> 6) == 0) { const int ln_ = threadIdx.x & 63; unsigned i_ = 0xFFFFFFFFu; int hs_ = h0; \
                if (own) { if (ln_ == 0) i_ = __hip_atomic_fetch_add(ctlw + (CWQ) + 64 * h0 + 16 * rep, 1u, __ATOMIC_RELAXED, __HIP_MEMORY_SCOPE_AGENT); i_ = (unsigned)__builtin_amdgcn_readfirstlane((int)i_); } \
                if (!own || i_ >= 64u) { unsigned c_ = 64u; if (ln_ < 8) c_ = __hip_atomic_load(ctlw + (CWQ) + 64 * ((h0 + ln_) & 7) + 16 * rep, __ATOMIC_RELAXED, __HIP_MEMORY_SCOPE_AGENT); \
                    const unsigned long long m_ = __ballot(c_ < 64u); i_ = 0xFFFFFFFFu; \
                    if (m_ != 0ull) { hs_ = (h0 + (int)__builtin_ctzll(m_)) & 7; if (ln_ == 0) i_ = __hip_atomic_fetch_add(ctlw + (CWQ) + 64 * hs_ + 16 * rep, 1u, __ATOMIC_RELAXED, __HIP_MEMORY_SCOPE_AGENT); \
                        i_ = (unsigned)__builtin_amdgcn_readfirstlane((int)i_); if (i_ >= 64u) i_ = 0xFFFFFFFEu; } } \
                if (ln_ == 0) { misc[0] = i_; misc[1] = (unsigned)hs_; } } \
            __syncthreads(); const unsigned i = misc[0]; const int h = (int)misc[1]; __syncthreads(); \
            if (h != h0 || i >= 64u) own = false; \
            if (i == 0xFFFFFFFFu) break; \
            if (i >= 64u) continue;
#define MK_FOX_LOOPS(FIXV) do { \
        for (int rep = 0; rep < PROBE_FOX; ++rep) { bool own = true; \
        for (;;) { MK_POP(CW_QF) \
            const float kmax2 = __builtin_bit_cast(float, __hip_atomic_load(ctlw + CW_KMAX + 64 * h, __ATOMIC_RELAXED, __HIP_MEMORY_SCOPE_AGENT)); \
            att::Src s{MKP_P + h * 64, NINP, MKP_P + 512 + h * 64, NINP, MKP_KB + (size_t)h * M * 8, 8, MKP_P + 1024 + h * 64, NINP, MKP_OB + h * 64, D}; \
            att::attn_unit<false, FIXV>(63 - (int)i, s, lds, MKP_BIASF + (size_t)h * M, kmax2, MKP_QMAX + h * 64); \
        } } } while (0)
#define MK_MLA_LOOPS(FIXV) do { \
        for (int rep = 0; rep < PROBE_MLA; ++rep) { bool own = true; \
        for (;;) { MK_POP(CW_QM) \
            const float kmaxm = __builtin_bit_cast(float, __hip_atomic_load(ctlw + CW_KMAXM + 64 * h, __ATOMIC_RELAXED, __HIP_MEMORY_SCOPE_AGENT)); \
            att::Src s{MKP_QM + h * 96, NQU, MKP_KVM + h * 64, NKVU, MKP_P + 1920, NINP, MKP_KVM + 512 + h * 64, NKVU, MKP_OB + 512 + h * 64, D}; \
            att::attn_unit<true, FIXV>(63 - (int)i, s, lds, nullptr, kmaxm, nullptr); \
        } } } while (0)
        if (okF) MK_FOX_LOOPS(true); else MK_FOX_LOOPS(false);
        asm volatile("" ::: "memory");
        if (threadIdx.x == 0) { unsigned sp = 0; while (__hip_atomic_load(ctlw + CW_DONE, __ATOMIC_RELAXED, __HIP_MEMORY_SCOPE_AGENT) < (unsigned)G) { __builtin_amdgcn_s_sleep(2); if (++sp > (1u << 22)) break; } }
        __syncthreads();
        bool okM = true;
        { const float qmM = __builtin_bit_cast(float, __hip_atomic_load(ctlw + CW_QMAXM, __ATOMIC_RELAXED, __HIP_MEMORY_SCOPE_AGENT));
          for (int h = 0; h < 8; ++h) { const float kM = __builtin_bit_cast(float, __hip_atomic_load(ctlw + CW_KMAXM + 64 * h, __ATOMIC_RELAXED, __HIP_MEMORY_SCOPE_AGENT)); okM = okM && (qmM * kM < 2025.f); }
          okM = __builtin_amdgcn_readfirstlane(okM ? 1 : 0) != 0; }
        if (okM) MK_MLA_LOOPS(true); else MK_MLA_LOOPS(false);
#undef MK_FOX_LOOPS
#undef MK_MLA_LOOPS
#undef MK_POP
    }
#ifdef ATT_PRIO
    __builtin_amdgcn_s_setprio(0);
#endif
    SEAM(4);
    TS_END(4);
    TS_BEGIN(5);
    if (IN(5)) {
        pg8::Gemm g{MKP_OB, MKP_Wo_t, M, D, D}; pg8::StaticOrder S; S.init(M, D, G, bx);
        pg8::EpiRes E{MKP_x, MKP_out, D, MKP_XN, MKP_SS};
        pg8::gemm_phase<pg8::EpiRes, pg8::StaticOrder, PG8_ALIGN, PG8_SP2>(lds, g, S, E);
    }
    SEAM(5);
    TS_END(5);
    TS_BEGIN(6);
    if (IN(6)) {
        pg8::Gemm g{MKP_XN, MKP_W1_t, M, FF, D}; pg8::StaticOrder S; S.init(M, FF, G, bx);
        pg8::EpiSqRelu E{MKP_HB, FF, MKP_SS, EPS, 1.f / D};
        pg8::gemm_phase<pg8::EpiSqRelu, pg8::StaticOrder, PG8_ALIGN, PG8_SP2>(lds, g, S, E);
    }
    SEAM(6);
    TS_END(6);
    TS_BEGIN(7);
    if (IN(7)) {
        pg8::Gemm g{MKP_HB, MKP_W2_t, M, D, FF}; pg8::StaticOrder S; S.init(M, D, G, bx);
        pg8::EpiResNorm E{MKP_out, MKP_out, D, MKP_g_final, MKP_SSQ, (unsigned*)(args.ws + WS_CTL) + CW_PCNT, EPS, 1.f / D};
        pg8::gemm_phase<pg8::EpiResNorm, pg8::StaticOrder, false, PG8_SP2>(lds, g, S, E);
    }
#ifdef TS_PHASE
    { XcdBarrier b_; b_.bar = (unsigned*)(args.ws + WS_CTL); b_.x = xb_xcc_id(); b_.st = (volatile LAS unsigned*)(lds + MISC_OFF) + 8; xcd_barrier(b_); }
    TS_END(7);
    if (blockIdx.x == 0 && threadIdx.x == 0) MKP_out[0] = (float)(((ts_b_ - ts_a_) / TS_Q) * (TS_Q / 100ull));
#endif
#undef IN
#undef SEAM
#undef MKP_x
#undef MKP_g_mix
#undef MKP_w_in
#undef MKP_b_f
#undef MKP_g_q
#undef MKP_w_q_up
#undef MKP_g_kv
#undef MKP_w_kv_up
#undef MKP_w_o
#undef MKP_g_mlp
#undef MKP_w_ff1
#undef MKP_w_ff2
#undef MKP_g_final
#undef MKP_out
#undef MKP_Win_t
#undef MKP_Wq_t
#undef MKP_Wkv_t
#undef MKP_Wo_t
#undef MKP_W1_t
#undef MKP_W2_t
#undef MKP_RT
#undef MKP_LF
#undef MKP_SS
#undef MKP_SSQ
#undef MKP_BIASF
#undef MKP_QMAX
#undef MKP_SSKV
#undef MKP_KB
#undef MKP_KR
#undef MKP_XN
#undef MKP_HB
#undef MKP_P
#undef MKP_QM
#undef MKP_KVM
#undef MKP_QN
#undef MKP_OB
#undef MKP_KVN
}

#ifndef MK_ONE_LAUNCH
#define MK_ONE_LAUNCH 1
#endif
extern "C" void kernel_launch(void* const* d_in, const int* in_sizes, int n_in, void* d_out, int out_size, void* d_ws, size_t ws_size, hipStream_t stream) {
    static int ready = 0;
    if (ready == 0) {
        if (n_in != 13 || in_sizes[0] != M * D || out_size != M * D || ws_size < WS_END) { fprintf(stderr, "kernel_launch: unexpected shapes (n_in %d, in0 %d, out %d, ws %zu)\n", n_in, n_in > 0 ? in_sizes[0] : -1, out_size, ws_size); ready = -1; return; }
        if (hipFuncSetAttribute((const void*)mk_fwd, hipFuncAttributeMaxDynamicSharedMemorySize, LDS_BYTES) != hipSuccess) { fprintf(stderr, "kernel_launch: hipFuncSetAttribute failed\n"); ready = -1; return; }
        ready = 1;
    }
    if (ready < 0) return;
    if (hipMemsetAsync((char*)d_ws + WS_CTL, 0, CTL_ZERO_BYTES, stream) != hipSuccess) { fprintf(stderr, "kernel_launch: hipMemsetAsync failed\n"); return; }
    Args a{};
    for (int i = 0; i < 13; ++i) a.in[i] = (const float*)d_in[i];
    a.out = (float*)d_out; a.ws = (unsigned char*)d_ws;
#ifndef MK_DUP
#define MK_DUP -1
#endif
    a.dup = MK_DUP;
    const int grid = 256;
#if MK_ONE_LAUNCH
    a.ph_lo = 0; a.ph_hi = NPHASE;
    void* kargs[] = {&a};
    hipError_t e = hipLaunchCooperativeKernel((const void*)mk_fwd, dim3(grid), dim3(NWAVES * 64), kargs, LDS_BYTES, stream);
    if (e != hipSuccess) fprintf(stderr, "kernel_launch: cooperative launch failed: %s\n", hipGetErrorString(e));
#else
    for (int p = 0; p < NPHASE; ++p) { a.ph_lo = p; a.ph_hi = p + 1; hipLaunchKernelGGL(mk_fwd, dim3(grid), dim3(NWAVES * 64), LDS_BYTES, stream, a); }
#endif
}
```

```cpp
#include <hip/hip_runtime.h>
#include <hip/hip_cooperative_groups.h>
#include <hip/hip_bf16.h>
#include <cstdio>
#include <cstdint>
#include <cmath>
namespace pg8 {
#define PG8_LAS __attribute__((address_space(3)))
typedef unsigned short bf16_t;
typedef short bf16x8 __attribute__((ext_vector_type(8)));
typedef float f32x4 __attribute__((ext_vector_type(4)));
typedef unsigned u32x4 __attribute__((ext_vector_type(4)));
constexpr int BM = 256, BK = 64, HALF = 128, HTB = HALF * BK * 2  , STAGE_BYTES = 8 * HTB, NXCD = 8, WGM = 8;

__host__ __device__ __forceinline__ int lds_byte(int r, int c) { const int st = (r >> 4) * 2 + (c >> 5), rr = r & 15, cc = c & 31, ob = rr * 64 + cc * 2; return st * 1024 + (ob ^ (((ob >> 9) & 1) << 5)); }
__host__ __device__ __forceinline__ void stage_rc(int b, int& R, int& C) { const int st = b / 1024, sb = b % 1024, swz = sb ^ (((sb >> 9) & 1) << 5); R = (st >> 1) * 16 + swz / 64; C = (st & 1) * 32 + (swz % 64) / 2; }
__host__ __device__ __forceinline__ int perm32(int rho) { const int n = rho >> 4, i = rho & 15; return 8 * (i >> 2) + 4 * n + (i & 3); }

struct Unit { int pm, pn; };
struct Gemm { const bf16_t* A; const bf16_t* Bt; int M, N, K; int lda; };

struct StaticOrder {
    int nM, nN, nwg, G, c;
    __host__ __device__ void init(int M, int N, int G_, int c_) { nM = M / BM; nN = N / BM; nwg = nM * nN; G = G_; c = c_; }
    __host__ __device__ bool next(int i, Unit& u) const {
        const long L = (long)i * G + c; if (L >= nwg) return false;
        int wgid = (int)L; { const int q = nwg / NXCD, r = nwg % NXCD, xcd = wgid % NXCD, off = wgid / NXCD; wgid = (xcd < r ? xcd * (q + 1) : r * (q + 1) + (xcd - r) * q) + off; }
        const int nig = WGM * nN, gid = wgid / nig, fm = gid * WGM, gsz = (nM - fm) < WGM ? (nM - fm) : WGM;
        u.pm = fm + ((wgid % nig) % gsz); u.pn = (wgid % nig) / gsz; return true;
    }
    __device__ __forceinline__ void a_ready(const Unit&) const {}
    __device__ __forceinline__ void done(const Unit&) const {}
};

__device__ __forceinline__ unsigned cvt_pk_bf16(float lo, float hi) { unsigned r; asm volatile("v_cvt_pk_bf16_f32 %0, %1, %2" : "=v"(r) : "v"(lo), "v"(hi)); return r; }
typedef float f32x2 __attribute__((ext_vector_type(2)));
__device__ __forceinline__ f32x2 gelu_pk(f32x2 v) {
    const f32x2 av = __builtin_elementwise_abs(v), d = av * 0.2316418882f + 1.0f;
    f32x2 t; t.x = __builtin_amdgcn_rcpf(d.x); t.y = __builtin_amdgcn_rcpf(d.y);
    f32x2 q = t * 0.5307027145f + (-0.7265760135f); q = q * t + 0.7107068705f; q = q * t + (-0.142248368f); q = q * t + 0.127414796f; q = q * t;
    const f32x2 s = (v * v) * (-0.72134752044f);
    f32x2 e; e.x = __builtin_amdgcn_exp2f(s.x); e.y = __builtin_amdgcn_exp2f(s.y);
    const f32x2 m = v * (q * e), r = v - m;
    f32x2 o; o.x = v.x < 0.f ? m.x : r.x; o.y = v.y < 0.f ? m.y : r.y; return o;
}

template <int ACT  > struct EpiBf16 {
    static constexpr bool PERM = true, AFTER_DRAIN = false; static_assert(ACT == 0 || ACT == 1, "EpiBf16: ACT is 0 (none) or 1 (gelu_pk)");
    bf16_t* O; int ldc; const float* bias; int split_cols; size_t split_stride; float scale0;
    __device__ __forceinline__ void operator()(const f32x4 (&acc)[2][2][4][2], const Unit& u, int wr, int wc, int fr, int fq) const {
        const int row0 = u.pm * BM + wr * 64 + fr; int colt = u.pn * BM; bf16_t* base = O;
        float sc = 1.f; if (split_cols) { const int t = colt / split_cols; base += (size_t)t * split_stride; colt -= t * split_cols; if (t == 0) sc = scale0; }
        const int col0 = colt + wc * 32 + 8 * fq, bcol0 = u.pn * BM + wc * 32 + 8 * fq;
        f32x4 bv[2][2];
#pragma unroll
        for (int bj = 0; bj < 2; ++bj)
#pragma unroll
            for (int n = 0; n < 2; ++n) bv[bj][n] = bias ? *(const f32x4*)(bias + bcol0 + bj * HALF + 4 * n) : (f32x4){0.f, 0.f, 0.f, 0.f};
#pragma unroll
        for (int ai = 0; ai < 2; ++ai)
#pragma unroll
            for (int m = 0; m < 4; ++m) { bf16_t* rowp = base + (size_t)(row0 + ai * HALF + m * 16) * ldc + col0;
#pragma unroll
                for (int bj = 0; bj < 2; ++bj) { f32x4 v0 = acc[ai][bj][m][0] + bv[bj][0], v1 = acc[ai][bj][m][1] + bv[bj][1];
                    if (ACT == 1) { f32x2 a = gelu_pk((f32x2){v0[0], v0[1]}), b = gelu_pk((f32x2){v0[2], v0[3]}), c = gelu_pk((f32x2){v1[0], v1[1]}), d = gelu_pk((f32x2){v1[2], v1[3]});
                        v0 = (f32x4){a.x, a.y, b.x, b.y}; v1 = (f32x4){c.x, c.y, d.x, d.y}; }
                    v0 = v0 * sc; v1 = v1 * sc; u32x4 w; w.x = cvt_pk_bf16(v0[0], v0[1]); w.y = cvt_pk_bf16(v0[2], v0[3]); w.z = cvt_pk_bf16(v1[0], v1[1]); w.w = cvt_pk_bf16(v1[2], v1[3]);
                    *(u32x4*)(rowp + bj * HALF) = w; } }
    }
};

struct EpiQm {
    static constexpr bool PERM = true, AFTER_DRAIN = false;
    bf16_t* O; int ldc; const float* rt; float scale; const float* ssq; float eps;
    __device__ __forceinline__ void operator()(const f32x4 (&acc)[2][2][4][2], const Unit& u, int wr, int wc, int fr, int fq) const {
        const int row0 = u.pm * BM + wr * 64 + fr, col0 = u.pn * BM + wc * 32 + 8 * fq;
#pragma unroll
        for (int ai = 0; ai < 2; ++ai)
#pragma unroll
            for (int m = 0; m < 4; ++m) { const int row = row0 + ai * HALF + m * 16;
                const f32x4 sq = *(const f32x4*)(ssq + (size_t)row * 4); const float rs = scale / sqrtf(((sq[0] + sq[1]) + (sq[2] + sq[3])) * (1.0f / 256.0f) + eps);
#pragma unroll
                for (int bj = 0; bj < 2; ++bj) { const int c = col0 + bj * HALF, d = c % 96;
                    f32x4 v0 = acc[ai][bj][m][0], v1 = acc[ai][bj][m][1];
                    if (d >= 64) { const f32x4* t = (const f32x4*)(rt + (size_t)row * 32 + (d - 64)); const f32x4 t0 = t[0], t1 = t[1];
                        f32x4 w0, w1;
                        w0[0] = v0[0] * t0[0] - v0[1] * t0[1]; w0[1] = v0[1] * t0[0] + v0[0] * t0[1];
                        w0[2] = v0[2] * t0[2] - v0[3] * t0[3]; w0[3] = v0[3] * t0[2] + v0[2] * t0[3];
                        w1[0] = v1[0] * t1[0] - v1[1] * t1[1]; w1[1] = v1[1] * t1[0] + v1[0] * t1[1];
                        w1[2] = v1[2] * t1[2] - v1[3] * t1[3]; w1[3] = v1[3] * t1[2] + v1[2] * t1[3];
                        v0 = w0; v1 = w1; }
                    v0 = v0 * rs; v1 = v1 * rs; u32x4 w; w.x = cvt_pk_bf16(v0[0], v0[1]); w.y = cvt_pk_bf16(v0[2], v0[3]); w.z = cvt_pk_bf16(v1[0], v1[1]); w.w = cvt_pk_bf16(v1[2], v1[3]);
                    *(u32x4*)(O + (size_t)row * ldc + c) = w; }
                asm volatile("" ::: "memory"); }
    }
};

struct EpiKv {
    static constexpr bool PERM = true, AFTER_DRAIN = false;
    bf16_t* O; int ldc; const float* ssq; float eps;
    __device__ __forceinline__ void operator()(const f32x4 (&acc)[2][2][4][2], const Unit& u, int wr, int wc, int fr, int fq) const {
        const int row0 = u.pm * BM + wr * 64 + fr, col0 = u.pn * BM + wc * 32 + 8 * fq;
#pragma unroll
        for (int ai = 0; ai < 2; ++ai)
#pragma unroll
            for (int m = 0; m < 4; ++m) { const int row = row0 + ai * HALF + m * 16;
                const f32x4 sq = *(const f32x4*)(ssq + (size_t)row * 4); const float rs = 1.0f / sqrtf(((sq[0] + sq[1]) + (sq[2] + sq[3])) * (1.0f / 128.0f) + eps);
#pragma unroll
                for (int bj = 0; bj < 2; ++bj) { const f32x4 v0 = acc[ai][bj][m][0] * rs, v1 = acc[ai][bj][m][1] * rs;
                    u32x4 w; w.x = cvt_pk_bf16(v0[0], v0[1]); w.y = cvt_pk_bf16(v0[2], v0[3]); w.z = cvt_pk_bf16(v1[0], v1[1]); w.w = cvt_pk_bf16(v1[2], v1[3]);
                    *(u32x4*)(O + (size_t)row * ldc + col0 + bj * HALF) = w; }
                asm volatile("" ::: "memory"); }
    }
};
struct EpiIn {
    static constexpr bool PERM = true, AFTER_DRAIN = false;
    bf16_t* O; int ldc; float scale0; float* ssq; float* sskv; const float* rt; const float* bf; float* lf; int nrows;
    __device__ __forceinline__ void operator()(const f32x4 (&acc)[2][2][4][2], const Unit& u, int wr, int wc, int fr, int fq) const {
        const int row0 = u.pm * BM + wr * 64 + fr, col0 = u.pn * BM + wc * 32 + 8 * fq; const int pn = u.pn;
        const float sc = pn < 2 ? scale0 : 1.f;
#pragma unroll
        for (int ai = 0; ai < 2; ++ai)
#pragma unroll
            for (int m = 0; m < 4; ++m) { const int row = row0 + ai * HALF + m * 16; bf16_t* rowp = O + (size_t)row * ldc + col0; float s0 = 0.f, s1 = 0.f;
#pragma unroll
                for (int bj = 0; bj < 2; ++bj) { f32x4 v0 = acc[ai][bj][m][0] * sc, v1 = acc[ai][bj][m][1] * sc;
                    const float sq = ((v0[0] * v0[0] + v0[1] * v0[1]) + (v0[2] * v0[2] + v0[3] * v0[3])) + ((v1[0] * v1[0] + v1[1] * v1[1]) + (v1[2] * v1[2] + v1[3] * v1[3]));
                    if (bj == 0) s0 = sq; else s1 = sq;
                    bool store = true;
                    if (pn == 7 && bj == 1) { store = (wc == 0);
                        if (wc == 0) { const f32x4* t = (const f32x4*)(rt + (size_t)row * 32 + 8 * fq); const f32x4 t0 = t[0], t1 = t[1]; f32x4 w0, w1;
                            w0[0] = v0[0] * t0[0] - v0[1] * t0[1]; w0[1] = v0[1] * t0[0] + v0[0] * t0[1];
                            w0[2] = v0[2] * t0[2] - v0[3] * t0[3]; w0[3] = v0[3] * t0[2] + v0[2] * t0[3];
                            w1[0] = v1[0] * t1[0] - v1[1] * t1[1]; w1[1] = v1[1] * t1[0] + v1[0] * t1[1];
                            w1[2] = v1[2] * t1[2] - v1[3] * t1[3]; w1[3] = v1[3] * t1[2] + v1[2] * t1[3];
                            v0 = w0; v1 = w1; }
                        else if (wc == 1 && fq == 0) {
#pragma unroll
                            for (int e = 0; e < 8; ++e) { const float z = (e < 4 ? v0[e & 3] : v1[e & 3]) + bf[e]; lf[(size_t)e * nrows + row] = fminf(z, 0.f) - 0.6931471805599453f * __builtin_amdgcn_logf(1.0f + __builtin_amdgcn_exp2f(-1.4426950408889634f * fabsf(z))); } } }
                    if (store) { u32x4 w; w.x = cvt_pk_bf16(v0[0], v0[1]); w.y = cvt_pk_bf16(v0[2], v0[3]); w.z = cvt_pk_bf16(v1[0], v1[1]); w.w = cvt_pk_bf16(v1[2], v1[3]);
                        *(u32x4*)(rowp + bj * HALF) = w; } }
                if (pn == 6) { float s = s0 + s1; s += __shfl_xor(s, 16); s += __shfl_xor(s, 32); if (fq == 0) ssq[(size_t)row * 4 + wc] = s; }
                if (pn == 7) { float s = s0; s += __shfl_xor(s, 16); s += __shfl_xor(s, 32); if (fq == 0) sskv[(size_t)row * 4 + wc] = s; }
                asm volatile("" ::: "memory"); }
    }
};
struct EpiRes {
    static constexpr bool PERM = false, AFTER_DRAIN = false;
    const float* base; float* out; int ldc; bf16_t* ob; float* ss;
    __device__ __forceinline__ void operator()(const f32x4 (&acc)[2][2][4][2], const Unit& u, int wr, int wc, int fr, int fq) const {
        typedef unsigned u32x2v __attribute__((ext_vector_type(2)));
        const int row0 = u.pm * BM + wr * 64 + fr, col0 = u.pn * BM + wc * 32 + 4 * fq;
#pragma unroll
        for (int ai = 0; ai < 2; ++ai)
#pragma unroll
            for (int m = 0; m < 4; ++m) { const int row = row0 + ai * HALF + m * 16; const size_t off = (size_t)row * ldc + col0; float s = 0.f;
#pragma unroll
                for (int bj = 0; bj < 2; ++bj)
#pragma unroll
                    for (int n = 0; n < 2; ++n) { const f32x4 v = *(const f32x4*)(base + off + bj * HALF + n * 16) + acc[ai][bj][m][n];
                        *(f32x4*)(out + off + bj * HALF + n * 16) = v; s += (v[0] * v[0] + v[1] * v[1]) + (v[2] * v[2] + v[3] * v[3]);
                        if (ob) { u32x2v w; w.x = cvt_pk_bf16(v[0], v[1]); w.y = cvt_pk_bf16(v[2], v[3]); *(u32x2v*)(ob + off + bj * HALF + n * 16) = w; } }
                if (ss) { s += __shfl_xor(s, 16); s += __shfl_xor(s, 32); if (fq == 0) ss[(size_t)row * 16 + u.pn * 4 + wc] = s; }
                asm volatile("" ::: "memory");
            }
    }
};

struct EpiResNorm {
    static constexpr bool PERM = false, AFTER_DRAIN = true;
    const float* base; float* out; int ldc; const float* g; float* xs; unsigned* cnt; float eps; float inv_n;
    __device__ __forceinline__ void fused(f32x4 (&acc)[2][2][4][2], const Unit& u, int wr, int wc, int fr, int fq, PG8_LAS unsigned char* lds, int wid, int lane) const {
        PG8_LAS float* Pm = (PG8_LAS float*)lds;
        PG8_LAS float* S = (PG8_LAS float*)(lds + 4096);
        const int row0 = u.pm * BM + wr * 64 + fr, col0 = u.pn * BM + wc * 32 + 4 * fq;
#pragma unroll
        for (int ai = 0; ai < 2; ++ai)
#pragma unroll
            for (int m = 0; m < 4; ++m) { const size_t off = (size_t)(row0 + ai * HALF + m * 16) * ldc + col0; float s = 0.f;
#pragma unroll
                for (int bj = 0; bj < 2; ++bj)
#pragma unroll
                    for (int n = 0; n < 2; ++n) { const f32x4 v = *(const f32x4*)(base + off + bj * HALF + n * 16) + acc[ai][bj][m][n]; acc[ai][bj][m][n] = v;
                        s += (v[0] * v[0] + v[1] * v[1]) + (v[2] * v[2] + v[3] * v[3]); }
                s += __shfl_xor(s, 16); s += __shfl_xor(s, 32);
                if (fq == 0) Pm[(ai * HALF + wr * 64 + m * 16 + fr) * 4 + wc] = s;
                if (m & 1) asm volatile("" ::: "memory"); }
        asm volatile("s_waitcnt lgkmcnt(0)" ::: "memory"); __builtin_amdgcn_s_barrier(); asm volatile("" ::: "memory");
        const int tid = wid * 64 + lane;
        if (tid < 256) { const f32x4 p4 = *(const PG8_LAS f32x4*)(Pm + tid * 4);
            __hip_atomic_store(xs + (size_t)(u.pm * BM + tid) * 4 + u.pn, (p4[0] + p4[1]) + (p4[2] + p4[3]), __ATOMIC_RELAXED, __HIP_MEMORY_SCOPE_AGENT);
            asm volatile("s_waitcnt vmcnt(0)" ::: "memory");
            if (lane == 0) __hip_atomic_fetch_add(cnt + 64 * u.pm, 1u, __ATOMIC_RELAXED, __HIP_MEMORY_SCOPE_AGENT); }
        if (wid == 0) { unsigned sp = 0;
            while ((unsigned)__builtin_amdgcn_readfirstlane(__hip_atomic_load(cnt + 64 * u.pm, __ATOMIC_RELAXED, __HIP_MEMORY_SCOPE_AGENT)) < 16u) { __builtin_amdgcn_s_sleep(2); if (++sp > (1u << 22)) break; }
            __builtin_amdgcn_fence(__ATOMIC_ACQUIRE, "agent"); }
        asm volatile("s_waitcnt vmcnt(0) lgkmcnt(0)" ::: "memory"); __builtin_amdgcn_s_barrier(); asm volatile("" ::: "memory");
        if (tid < 256) { const float* xp = xs + (size_t)(u.pm * BM + tid) * 4;
            const float t0 = __hip_atomic_load(xp + 0, __ATOMIC_RELAXED, __HIP_MEMORY_SCOPE_AGENT), t1 = __hip_atomic_load(xp + 1, __ATOMIC_RELAXED, __HIP_MEMORY_SCOPE_AGENT);
            const float t2 = __hip_atomic_load(xp + 2, __ATOMIC_RELAXED, __HIP_MEMORY_SCOPE_AGENT), t3 = __hip_atomic_load(xp + 3, __ATOMIC_RELAXED, __HIP_MEMORY_SCOPE_AGENT);
            S[tid] = 1.0f / sqrtf(((t0 + t1) + (t2 + t3)) * inv_n + eps); }
        asm volatile("s_waitcnt vmcnt(0) lgkmcnt(0)" ::: "memory"); __builtin_amdgcn_s_barrier(); asm volatile("" ::: "memory");
        f32x4 gv[2][2];
#pragma unroll
        for (int bj = 0; bj < 2; ++bj)
#pragma unroll
            for (int n = 0; n < 2; ++n) gv[bj][n] = *(const f32x4*)(g + col0 + bj * HALF + n * 16);
#pragma unroll
        for (int ai = 0; ai < 2; ++ai)
#pragma unroll
            for (int m = 0; m < 4; ++m) { const int r = ai * HALF + wr * 64 + m * 16 + fr; const float rs = S[r]; const size_t off = (size_t)(u.pm * BM + r) * ldc + col0;
#pragma unroll
                for (int bj = 0; bj < 2; ++bj)
#pragma unroll
                    for (int n = 0; n < 2; ++n) *(f32x4*)(out + off + bj * HALF + n * 16) = acc[ai][bj][m][n] * rs * gv[bj][n]; }
    }
};
struct EpiSqRelu {
    static constexpr bool PERM = true, AFTER_DRAIN = false;
    bf16_t* O; int ldc; const float* ss; float eps; float inv_n;
    __device__ __forceinline__ void operator()(const f32x4 (&acc)[2][2][4][2], const Unit& u, int wr, int wc, int fr, int fq) const {
        const int row0 = u.pm * BM + wr * 64 + fr, col0 = u.pn * BM + wc * 32 + 8 * fq;
#pragma unroll
        for (int ai = 0; ai < 2; ++ai)
#pragma unroll
            for (int m = 0; m < 4; ++m) { const int row = row0 + ai * HALF + m * 16;
                const f32x4* sp = (const f32x4*)(ss + (size_t)row * 16); const f32x4 a = sp[0], b = sp[1], c = sp[2], d = sp[3];
                const float tot = ((a[0] + a[1]) + (a[2] + a[3])) + ((b[0] + b[1]) + (b[2] + b[3])) + ((c[0] + c[1]) + (c[2] + c[3])) + ((d[0] + d[1]) + (d[2] + d[3]));
                const float rstd = 1.0f / sqrtf(tot * inv_n + eps);
#pragma unroll
                for (int bj = 0; bj < 2; ++bj) { f32x4 v0 = acc[ai][bj][m][0] * rstd, v1 = acc[ai][bj][m][1] * rstd;
#pragma unroll
                    for (int e = 0; e < 4; ++e) { const float x0 = fmaxf(v0[e], 0.f), x1 = fmaxf(v1[e], 0.f); v0[e] = x0 * x0; v1[e] = x1 * x1; }
                    u32x4 w; w.x = cvt_pk_bf16(v0[0], v0[1]); w.y = cvt_pk_bf16(v0[2], v0[3]); w.z = cvt_pk_bf16(v1[0], v1[1]); w.w = cvt_pk_bf16(v1[2], v1[3]);
                    *(u32x4*)(O + (size_t)row * ldc + col0 + bj * HALF) = w; }
                asm volatile("" ::: "memory"); }
    }
};


template <class Epi, class Sched, bool ALIGN_EPI = false, bool SP2 = false>
__device__ __forceinline__ void gemm_phase(PG8_LAS unsigned char* lds, const Gemm g, const Sched& S, const Epi& E) {
    const int tid = threadIdx.x, wid = __builtin_amdgcn_readfirstlane(tid >> 6), lane = tid & 63, wr = wid >> 2, wc = wid & 3, fr = lane & 15, fq = lane >> 4;
    const int K = g.K, nt = K / BK, lda = g.lda ? g.lda : g.K;
    unsigned voffA[2], voffB[2];
#pragma unroll
    for (int i = 0; i < 2; ++i) { int R, C; stage_rc(tid * 16 + i * 8192, R, C); const int Rb = Epi::PERM ? ((R & ~31) + perm32(R & 31)) : R;
        voffA[i] = (unsigned)(R * lda + C) * 2u; voffB[i] = (unsigned)(Rb * K + C) * 2u; }
    const size_t kstep = (size_t)(BK * 2);
    const size_t hstep = (size_t)HALF * K * 2;
    const size_t tstep = 2 * hstep;
    const size_t hstepA = (size_t)HALF * lda * 2, tstepA = 2 * hstepA;
    const unsigned ldsw = (unsigned)wid * 1024u;
    const int aoff = lds_byte(wr * 64 + fr, fq * 8), boff = lds_byte(wc * 32 + fr, fq * 8);
#define PG8_SA(b, h) (((b) * 2 + (h)) * HTB)
#define PG8_SB(b, h) ((4 + (b) * 2 + (h)) * HTB)
#define PG8_STAGE(bufoff, gbase, voff) do { _Pragma("unroll") for (int _i = 0; _i < 2; ++_i) \
        __builtin_amdgcn_global_load_lds((const unsigned*)((const char*)(gbase) + (voff)[_i]), (PG8_LAS unsigned*)(lds + (bufoff) + ldsw + _i * 8192), 16, 0, 0); } while (0)
#define PG8_LDA(dst, b, h) do { _Pragma("unroll") for (int m = 0; m < 4; ++m) _Pragma("unroll") for (int k = 0; k < 2; ++k) dst[m][k] = *(const PG8_LAS bf16x8*)(lds + PG8_SA(b, h) + aoff + m * 2048 + k * 1024); } while (0)
#define PG8_LDB(dst, b, h) do { _Pragma("unroll") for (int n = 0; n < 2; ++n) _Pragma("unroll") for (int k = 0; k < 2; ++k) dst[n][k] = *(const PG8_LAS bf16x8*)(lds + PG8_SB(b, h) + boff + n * 2048 + k * 1024); } while (0)
#define PG8_MMA(ai, bj, At, Bt) do { __builtin_amdgcn_s_setprio(1); _Pragma("unroll") for (int m = 0; m < 4; ++m) _Pragma("unroll") for (int n = 0; n < 2; ++n) _Pragma("unroll") for (int k = 0; k < 2; ++k) \
        acc[ai][bj][m][n] = __builtin_amdgcn_mfma_f32_16x16x32_bf16(Bt[n][k], At[m][k], acc[ai][bj][m][n], 0, 0, 0); __builtin_amdgcn_s_setprio(0); } while (0)
#define PG8_WAIT_V(n) asm volatile("s_waitcnt vmcnt(" #n ")" ::: "memory")
#define PG8_WAIT_L(n) asm volatile("s_waitcnt lgkmcnt(" #n ")" ::: "memory")
#define PG8_BAR __builtin_amdgcn_s_barrier()
#define PG8_SCHED __builtin_amdgcn_sched_barrier(0)
    Unit cur, nxt; int ui = 0;
    if (!S.next(0, cur)) return;
    f32x4 acc[2][2][4][2];
#pragma unroll
    for (int a = 0; a < 2; ++a)
#pragma unroll
        for (int b = 0; b < 2; ++b)
#pragma unroll
            for (int m = 0; m < 4; ++m)
#pragma unroll
                for (int n = 0; n < 2; ++n) acc[a][b][m][n] = (f32x4){0.f, 0.f, 0.f, 0.f};
    bf16x8 At[4][2], B0[2][2], B1[2][2];
    const char* cA = (const char*)g.A + (size_t)cur.pm * tstepA; const char* cB = (const char*)g.Bt + (size_t)cur.pn * tstep;
    S.a_ready(cur);
    if constexpr (SP2) {
        PG8_STAGE(PG8_SB(0, 0), cB, voffB); PG8_STAGE(PG8_SB(0, 1), cB + hstep, voffB); PG8_STAGE(PG8_SA(0, 0), cA, voffA); PG8_STAGE(PG8_SA(0, 1), cA + hstepA, voffA);
        if (wr == 1) PG8_BAR;
        PG8_WAIT_V(2); PG8_BAR;
        PG8_STAGE(PG8_SB(1, 0), cB + kstep, voffB); PG8_STAGE(PG8_SA(1, 0), cA + kstep, voffA); PG8_STAGE(PG8_SB(1, 1), cB + hstep + kstep, voffB);
        PG8_WAIT_V(6); PG8_BAR;
    } else {
        PG8_STAGE(PG8_SB(0, 0), cB, voffB); PG8_STAGE(PG8_SA(0, 0), cA, voffA); PG8_STAGE(PG8_SB(0, 1), cB + hstep, voffB); PG8_STAGE(PG8_SA(0, 1), cA + hstepA, voffA);
        if (wr == 1) PG8_BAR;
        PG8_WAIT_V(4); PG8_BAR;
        PG8_STAGE(PG8_SB(1, 0), cB + kstep, voffB); PG8_STAGE(PG8_SA(1, 0), cA + kstep, voffA); PG8_STAGE(PG8_SB(1, 1), cB + hstep + kstep, voffB);
        PG8_WAIT_V(6); PG8_BAR;
    }
    for (;;) {
        const bool has_next = S.next(ui + 1, nxt);
        const char* nA = has_next ? (const char*)g.A + (size_t)nxt.pm * tstepA : cA; const char* nB = has_next ? (const char*)g.Bt + (size_t)nxt.pn * tstep : cB;
        for (int t = 0; t < nt; t += 2) {
            const bool last = (t == nt - 2);
            const char* a1 = cA + (size_t)(t + 1) * kstep;
            const char* a2 = last ? nA : cA + (size_t)(t + 2) * kstep; const char* b2 = last ? nB : cB + (size_t)(t + 2) * kstep;
            const char* a3 = a2 + kstep; const char* b3 = b2 + kstep;
            if (last && has_next) S.a_ready(nxt);
            if constexpr (SP2) {
            PG8_LDB(B0, 0, 0); PG8_LDB(B1, 0, 1); PG8_SCHED; PG8_LDA(At, 0, 0); PG8_STAGE(PG8_SA(1, 1), a1 + hstepA, voffA);
            PG8_WAIT_V(8); PG8_WAIT_L(0); PG8_BAR; PG8_MMA(0, 0, At, B0); PG8_MMA(0, 1, At, B1); PG8_BAR; PG8_SCHED;
            PG8_LDA(At, 0, 1); PG8_STAGE(PG8_SB(0, 0), b2, voffB); PG8_STAGE(PG8_SB(0, 1), b2 + hstep, voffB); PG8_STAGE(PG8_SA(0, 0), a2, voffA);
            PG8_WAIT_V(8); PG8_WAIT_L(0); PG8_BAR; PG8_MMA(1, 0, At, B0); PG8_MMA(1, 1, At, B1); PG8_BAR; PG8_SCHED;
            PG8_LDB(B0, 1, 0); PG8_LDB(B1, 1, 1); PG8_SCHED; PG8_LDA(At, 1, 0); PG8_STAGE(PG8_SA(0, 1), a2 + hstepA, voffA);
            PG8_WAIT_V(8); PG8_WAIT_L(0); PG8_BAR; PG8_MMA(0, 0, At, B0); PG8_MMA(0, 1, At, B1); PG8_BAR; PG8_SCHED;
            PG8_LDA(At, 1, 1); PG8_STAGE(PG8_SB(1, 0), b3, voffB); PG8_STAGE(PG8_SB(1, 1), b3 + hstep, voffB); PG8_STAGE(PG8_SA(1, 0), a3, voffA);
            PG8_WAIT_V(8); PG8_WAIT_L(0); PG8_BAR; PG8_MMA(1, 0, At, B0); PG8_MMA(1, 1, At, B1); PG8_BAR; PG8_SCHED;
            } else {
            PG8_LDB(B0, 0, 0); PG8_SCHED; PG8_LDA(At, 0, 0); PG8_STAGE(PG8_SA(1, 1), a1 + hstepA, voffA);
            PG8_WAIT_L(8); PG8_BAR; PG8_WAIT_L(0); PG8_MMA(0, 0, At, B0); PG8_BAR; PG8_SCHED;
            PG8_LDB(B1, 0, 1); PG8_STAGE(PG8_SB(0, 0), b2, voffB);
            PG8_BAR; PG8_WAIT_L(0); PG8_MMA(0, 1, At, B1); PG8_BAR;
            PG8_LDA(At, 0, 1); PG8_STAGE(PG8_SA(0, 0), a2, voffA);
            PG8_BAR; PG8_WAIT_L(0); PG8_MMA(1, 0, At, B0); PG8_BAR; PG8_SCHED;
            PG8_STAGE(PG8_SB(0, 1), b2 + hstep, voffB);
            PG8_WAIT_V(6); PG8_BAR; PG8_MMA(1, 1, At, B1); PG8_BAR;
            PG8_LDB(B0, 1, 0); PG8_SCHED; PG8_LDA(At, 1, 0); PG8_STAGE(PG8_SA(0, 1), a2 + hstepA, voffA);
            PG8_WAIT_L(8); PG8_BAR; PG8_WAIT_L(0); PG8_MMA(0, 0, At, B0); PG8_BAR; PG8_SCHED;
            PG8_LDB(B1, 1, 1); PG8_STAGE(PG8_SB(1, 0), b3, voffB);
            PG8_BAR; PG8_WAIT_L(0); PG8_MMA(0, 1, At, B1); PG8_BAR;
            PG8_LDA(At, 1, 1); PG8_STAGE(PG8_SA(1, 0), a3, voffA);
            PG8_BAR; PG8_WAIT_L(0); PG8_MMA(1, 0, At, B0); PG8_BAR; PG8_SCHED;
            PG8_STAGE(PG8_SB(1, 1), b3 + hstep, voffB);
            PG8_WAIT_V(6); PG8_BAR; PG8_MMA(1, 1, At, B1); PG8_BAR;
            }
        }
        if constexpr (ALIGN_EPI) { if (wr == 0) PG8_BAR; }
        if constexpr (!Epi::AFTER_DRAIN) { E(acc, cur, wr, wc, fr, fq); S.done(cur); }
        if (!has_next) break;
#pragma unroll
        for (int a = 0; a < 2; ++a)
#pragma unroll
            for (int b = 0; b < 2; ++b)
#pragma unroll
                for (int m = 0; m < 4; ++m)
#pragma unroll
                    for (int n = 0; n < 2; ++n) acc[a][b][m][n] = (f32x4){0.f, 0.f, 0.f, 0.f};
        cur = nxt; cA = nA; cB = nB; ++ui;
        if constexpr (ALIGN_EPI) { if (wr == 1) PG8_BAR; }
    }
    PG8_WAIT_V(0);
    if constexpr (!ALIGN_EPI) { if (wr == 0) PG8_BAR; }
    PG8_BAR;
    if constexpr (Epi::AFTER_DRAIN) { E.fused(acc, cur, wr, wc, fr, fq, lds, wid, lane); S.done(cur); }
#undef PG8_SA
#undef PG8_SB
#undef PG8_STAGE
#undef PG8_LDA
#undef PG8_LDB
#undef PG8_MMA
#undef PG8_WAIT_V
#undef PG8_WAIT_L
#undef PG8_BAR
#undef PG8_SCHED
}
}

#ifndef PG8_SP2
#define PG8_SP2 true
#endif
#ifndef PG8_ALIGN
#define PG8_ALIGN true
#endif
namespace att {
#define LAS3 __attribute__((address_space(3)))
using bf16x8 = __attribute__((ext_vector_type(8))) short;
using s16x4 = __attribute__((ext_vector_type(4))) short;
using f32x16 = __attribute__((ext_vector_type(16))) float;
using f32x4 = __attribute__((ext_vector_type(4))) float;
using u32x4 = __attribute__((ext_vector_type(4))) unsigned;
typedef unsigned short u16;
typedef LAS3 const unsigned char* lds_cptr;
typedef short v4i16_t __attribute__((ext_vector_type(4)));
constexpr int SEQ = 16384, NW = 8, QBLK = 32, QB = 256, KVBLK = 64;
constexpr int KSLOT = 12288, VSLOT = 8192, NKS = 4, NVS = 4;
constexpr int LDS_K = 0, LDS_V = NKS * KSLOT, LDS_WS = LDS_V + NVS * VSLOT, LDS_OST = LDS_WS + NW * 256, LDS_QX = LDS_OST + NW * 4096, LDS_BYTES = LDS_QX + NW * 2048;
__device__ __forceinline__ int crow(int r, int hi) { return (r & 3) + 8 * (r >> 2) + 4 * hi; }
__device__ __forceinline__ void glds16(const void* gsrc, unsigned lds_dst) {
    asm volatile("s_mov_b32 m0, %1\n\ts_nop 0\n\tglobal_load_lds_dwordx4 %0, off" : : "v"(gsrc), "s"(lds_dst) : "memory", "m0"); }
typedef float f32x2_t __attribute__((ext_vector_type(2))); typedef __bf16 bf16x2_t __attribute__((ext_vector_type(2)));
__device__ __forceinline__ unsigned cvtpk_s(float lo, float hi) { f32x2_t v = {lo, hi}; bf16x2_t b = __builtin_convertvector(v, bf16x2_t); return __builtin_bit_cast(unsigned, b); }
__device__ __forceinline__ s16x4 vtr(lds_cptr p) { return __builtin_bit_cast(s16x4, __builtin_amdgcn_ds_read_tr16_b64_v4i16((LAS3 v4i16_t*)p)); }
#define ATT_SBAR() __builtin_amdgcn_sched_barrier(0)
#define ATT_WAIT_BAR(N) asm volatile("s_waitcnt vmcnt(" #N ") lgkmcnt(0)\n\ts_barrier" ::: "memory")
struct Src {
    const u16* q; int qp;
    const u16* k; int kp;
    const u16* k2; int k2p;
    const u16* v; int vp;
    u16* o; int op;
};
template <int NDK, int NQR, bool ZC, int XHS, int JLO, int JHI, bool EARLY>
__device__ __forceinline__ void phase_a(f32x16& C0, f32x16& C1, const lds_cptr* kb_, int ksl_, const bf16x8* qr, lds_cptr qx_, const f32x16& negm, bf16x8* kf, bf16x8* qx) {
    constexpr int KPF = 4;
#define ATT_SH(s_) (EARLY ? ((s_) / NDK) : ((s_) & 1))
#define ATT_SD(s_) (EARLY ? ((s_) % NDK) : ((s_) >> 1))
#define ATT_KRD(s_) kf[s_] = *(const LAS3 bf16x8*)(kb_[ATT_SD(s_)] + ksl_ + ATT_SH(s_) * (ATT_SD(s_) < 4 ? 4096 : XHS))
    if (JLO == 0) {
#pragma unroll
        for (int j = 0; j < KPF; ++j) ATT_KRD(j); }
#pragma unroll
    for (int j = JLO; j < JHI; ++j) {
        if (j + KPF < 2 * NDK) ATT_KRD(j + KPF);
        { const int dn = ATT_SD(j) + 2; if (NDK > NQR && dn >= NQR && dn < NDK && (EARLY || ATT_SH(j) == 0)) qx[dn >= NQR ? dn - NQR : 0] = *(const LAS3 bf16x8*)(qx_ + (dn >= NQR ? dn - NQR : 0) * 1024); }
        ATT_SBAR();
        const int d0 = ATT_SD(j); const f32x16 z = f32x16{}; const bf16x8 qf = (d0 < NQR) ? qr[d0 < NQR ? d0 : 0] : qx[d0 >= NQR ? d0 - NQR : 0];
        if (ATT_SH(j)) C1 = __builtin_amdgcn_mfma_f32_32x32x16_bf16(kf[j], qf, (d0 == 0) ? (ZC ? z : negm) : C1, 0, 0, 0);
        else           C0 = __builtin_amdgcn_mfma_f32_32x32x16_bf16(kf[j], qf, (d0 == 0) ? (ZC ? z : negm) : C0, 0, 0, 0);
        if (EARLY && j > NDK) { const int e0 = 16 * (j - NDK - 1) / (NDK - 1), e1 = 16 * (j - NDK) / (NDK - 1);
#pragma unroll
            for (int e = e0; e < e1; ++e) C0[e] = __builtin_amdgcn_exp2f(C0[e]);
            asm volatile("" : "+v"(C0)); }
        ATT_SBAR();
    }
#undef ATT_KRD
#undef ATT_SH
#undef ATT_SD
}
template <bool QK, bool FIN, bool EARLY>
__device__ __forceinline__ void phase_b(f32x16& C0, f32x16& C1, f32x16* o, lds_cptr vp_, u32x4* pw, float& l_reg) {
    s16x4 vlo[8], vhi[8]; float sacc = 0.f, sacd = 0.f;
#define ATT_VRD(i) do { const int vi_ = ((i) >> 1) + 4 * ((i) & 1); vlo[i] = vtr(vp_ + ((vi_ >> 2) * 4096 + (vi_ & 3) * 1024)); vhi[i] = vtr(vp_ + ((vi_ >> 2) * 4096 + (vi_ & 3) * 1024 + 512)); } while (0)
    if (FIN) { ATT_VRD(0); ATT_VRD(1); }
#pragma unroll
    for (int i = 0; i < 8; ++i) {
        if (FIN && i + 2 < 8) ATT_VRD(i + 2);
        ATT_SBAR();
        if (FIN) { const bf16x8 vf = (bf16x8){vlo[i][0], vlo[i][1], vlo[i][2], vlo[i][3], vhi[i][0], vhi[i][1], vhi[i][2], vhi[i][3]};
            o[i & 1] = __builtin_amdgcn_mfma_f32_32x32x16_bf16(__builtin_bit_cast(bf16x8, pw[i >> 1]), vf, o[i & 1], 0, 0, 0); }
        if (QK) { f32x16& X = (i < 4) ? C0 : C1; const int b = 4 * (i & 3);
            if (EARLY) { C1[2 * i] = __builtin_amdgcn_exp2f(C1[2 * i]); C1[2 * i + 1] = __builtin_amdgcn_exp2f(C1[2 * i + 1]); asm volatile("" : "+v"(C1)); }
            else { X[b] = __builtin_amdgcn_exp2f(X[b]); X[b + 1] = __builtin_amdgcn_exp2f(X[b + 1]); X[b + 2] = __builtin_amdgcn_exp2f(X[b + 2]); X[b + 3] = __builtin_amdgcn_exp2f(X[b + 3]); }
            sacc += X[b]; sacd += X[b + 1]; sacc += X[b + 2]; sacd += X[b + 3]; asm volatile("" : "+v"(sacc), "+v"(sacd));
            if (i & 1) { const int k = i >> 1, c = 8 * (k & 1);
                pw[k] = (u32x4){cvtpk_s(X[c], X[c + 1]), cvtpk_s(X[c + 2], X[c + 3]), cvtpk_s(X[c + 4], X[c + 5]), cvtpk_s(X[c + 6], X[c + 7])}; asm volatile("" : "+v"(pw[k])); } }
        ATT_SBAR();
    }
#undef ATT_VRD
    if (QK) l_reg += sacc + sacd;
}
template <bool MLA, bool FIX> __device__ __forceinline__ void attn_unit(int qb, const Src& s, LAS3 unsigned char* shm, const float* bias_h, float kmax2, const float* qmax_h) {
    constexpr int NDK = MLA ? 6 : 5, NX = MLA ? 4 : 1, NQR = MLA ? 4 : 5;
    constexpr float THRL = MLA ? 8.0f : 16.0f;
    const int tid = threadIdx.x, lane = tid & 63, r32 = lane & 31, hi = lane >> 5; const int wid = __builtin_amdgcn_readfirstlane(tid >> 6);
    const int q0 = qb * QB;
    const unsigned lds0 = (unsigned)(uintptr_t)shm;
    LAS3 float* wsf = (LAS3 float*)(shm + LDS_WS) + wid * 64;
    const int NT = (q0 + QB) / KVBLK;
    const int wvis = NT - 4 + (wid >> 1);
    const bool xw = wid < NX;
    const int krow = 8 * wid + (lane >> 3);
    const u16* ksrc = s.k + (size_t)krow * s.kp + (((lane & 7) ^ ((krow >> 1) & 7)) * 8);
    const int k2row = 16 * (wid & 3) + (lane >> 2);
    const u16* k2src = MLA ? s.k2 + (size_t)k2row * s.k2p + (((lane & 3) ^ ((k2row >> 2) & 3)) * 8) : s.k2 + (size_t)lane * s.k2p;
    const u16* vsrc = s.v + (size_t)(16 * (wid & 3) + (lane >> 2)) * s.vp + (wid >> 2) * 32 + (lane & 3) * 8;
    const unsigned kdst = lds0 + LDS_K + wid * 1024, k2dst = lds0 + LDS_K + (8 + (wid & 3)) * 1024, vdst = lds0 + LDS_V + wid * 1024;
#define ATT_DMA_K(t) do { const int sl_ = (t) & 3; glds16(ksrc + (size_t)(t) * KVBLK * s.kp, (unsigned)__builtin_amdgcn_readfirstlane(kdst + sl_ * KSLOT)); \
        if (xw) glds16(k2src + (size_t)(t) * KVBLK * s.k2p, (unsigned)__builtin_amdgcn_readfirstlane(k2dst + sl_ * KSLOT)); } while (0)
#define ATT_DMA_V(t, vsl) glds16(vsrc + (size_t)(t) * KVBLK * s.vp, (unsigned)__builtin_amdgcn_readfirstlane(vdst + (vsl)))
    if (!MLA) {
        if (tid < 256) { const int sl = tid >> 6; *(LAS3 f32x4*)(shm + LDS_K + sl * KSLOT + 9 * 1024 + (tid & 63) * 16) = (f32x4){0.f, 0.f, 0.f, 0.f}; } }
    if (MLA) { ATT_DMA_K(0); ATT_DMA_V(0, 0); ATT_DMA_K(1); ATT_DMA_K(2); }
    const u16* Qw = s.q + (size_t)(q0 + wid * QBLK + r32) * s.qp + hi * 8;
    bf16x8 qr[NQR];
#pragma unroll
    for (int d0 = 0; d0 < 4; ++d0) qr[d0] = *reinterpret_cast<const bf16x8*>(Qw + d0 * 16);
    const lds_cptr qx0 = (lds_cptr)shm + LDS_QX + wid * 2048 + lane * 16;
    float mla_ref = 0.f;
    if (MLA) { const bf16x8 q4 = *reinterpret_cast<const bf16x8*>(Qw + 64), q5 = *reinterpret_cast<const bf16x8*>(Qw + 80);
        *(LAS3 bf16x8*)(shm + LDS_QX + wid * 2048 + lane * 16) = q4; *(LAS3 bf16x8*)(shm + LDS_QX + wid * 2048 + 1024 + lane * 16) = q5;
        if (FIX) { float nq = 0.f;
#pragma unroll
            for (int e = 0; e < 8; ++e) { const float a = __uint_as_float((unsigned)(unsigned short)q4[e] << 16), b = __uint_as_float((unsigned)(unsigned short)q5[e] << 16); nq += a * a + b * b; }
#pragma unroll
            for (int d0 = 0; d0 < 4; ++d0)
#pragma unroll
                for (int e = 0; e < 8; ++e) { const float a = __uint_as_float((unsigned)(unsigned short)qr[d0][e] << 16); nq += a * a; }
            nq += __shfl_xor(nq, 32); mla_ref = sqrtf(nq * kmax2); } }
    const short one = hi ? (short)0 : (short)0x3F80;
    if (!MLA) qr[NQR - 1] = (bf16x8){one, one, one, 0, 0, 0, 0, 0};
    int t0 = 0;
    if (!MLA) {
        const float qm = qmax_h[qb];
        const float bunit = sqrtf(qm * kmax2);
        const float thr = FIX ? bias_h[q0] - 152.f : bias_h[q0] - 170.f - 2.f * bunit;
        if (FIX) { const float nm_ = -(bias_h[q0 + wid * QBLK + r32] + bunit); const unsigned h_ = cvtpk_s(nm_, 0.f) & 0xffffu; const float r1_ = nm_ - __uint_as_float(h_ << 16); const unsigned m_ = cvtpk_s(r1_, 0.f) & 0xffffu;
            const float r2_ = r1_ - __uint_as_float(m_ << 16); const unsigned l_ = cvtpk_s(r2_, 0.f) & 0xffffu;
            if (hi == 0) qr[NQR - 1] = (bf16x8){one, one, one, (short)h_, (short)m_, (short)l_, 0, 0}; }
        int best = 0;
        for (int tt = 1 + lane; tt <= NT - 4; tt += 64) { if (bias_h[64 * tt - 1] < thr) best = tt; }
#pragma unroll
        for (int o_ = 32; o_ >= 1; o_ >>= 1) best = max(best, __shfl_xor(best, o_));
        t0 = __builtin_amdgcn_readfirstlane(best);
    }
    if (!MLA) { ATT_DMA_K(t0); ATT_DMA_V(t0, (t0 & 3) * VSLOT); ATT_DMA_K(t0 + 1); ATT_DMA_K(t0 + 2); }
    float mhat = 0.f, l_reg = 0.f; f32x16 o[2]; o[0] = f32x16{}; o[1] = f32x16{}; f32x16 negm = f32x16{};
    if (MLA && FIX) {
#pragma unroll
        for (int r = 0; r < 16; ++r) negm[r] = -mla_ref; }
    const int qrel = wid * QBLK + r32;
    lds_cptr kb[NDK];
#pragma unroll
    for (int d0 = 0; d0 < 4; ++d0) kb[d0] = (lds_cptr)shm + LDS_K + r32 * 128 + ((((2 * d0 + hi) ^ ((r32 >> 1) & 7))) << 4);
    if (MLA) {
#pragma unroll
        for (int d0 = 4; d0 < NDK; ++d0) kb[d0] = (lds_cptr)shm + LDS_K + 8192 + r32 * 64 + ((((2 * (d0 - 4) + hi) ^ ((r32 >> 2) & 3))) << 4);
    } else kb[NDK - 1] = (lds_cptr)shm + LDS_K + 8192 + hi * 1024 + r32 * 16;
    constexpr int XHS = MLA ? 2048 : 512;
    const lds_cptr vp0 = (lds_cptr)shm + LDS_V + ((lane >> 4) & 1) * 32 + (lane & 3) * 8 + (4 * hi + ((lane & 15) >> 2)) * 64;
    f32x16 C0, C1; u32x4 pw[4]; bool resc = false;
#define ATT_TOP(t) do { if ((t) == t0 || (t) + 2 >= NT) { ATT_WAIT_BAR(0); } else if (xw) { ATT_WAIT_BAR(3); } else { ATT_WAIT_BAR(2); } \
        } while (0)
#define ATT_ISSUE(t) do { if ((t) + 3 < NT) ATT_DMA_K((t) + 3); if ((t) + 1 < NT) ATT_DMA_V((t) + 1, (((t) + 1) & 3) * VSLOT); } while (0)
#ifdef ATT_QKPRIO
#define ATT_PRIO_ON() __builtin_amdgcn_s_setprio(1)
#define ATT_PRIO_OFF() __builtin_amdgcn_s_setprio(0)
#else
#define ATT_PRIO_ON()
#define ATT_PRIO_OFF()
#endif
#define ATT_QK(t, E) do { bf16x8 kf_[2 * NDK]; bf16x8 qx_[NDK > NQR ? NDK - NQR : 1]; \
        phase_a<NDK, NQR, !MLA, XHS, 0, 4, E>(C0, C1, ATT_KS(t), qr, qx0, negm, kf_, qx_); ATT_ISSUE(t); ATT_SBAR(); \
        phase_a<NDK, NQR, !MLA, XHS, 4, 2 * NDK, E>(C0, C1, ATT_KS(t), qr, qx0, negm, kf_, qx_); } while (0)
#define ATT_MASK(C0, C1, t) do { const int kbq_ = 64 * ((t) - (NT - 4)) + 4 * hi; \
        _Pragma("unroll") for (int r = 0; r < 16; ++r) { const int kv_ = kbq_ + (r & 3) + 8 * (r >> 2); if (kv_ > qrel) C0[r] = -INFINITY; if (kv_ + 32 > qrel) C1[r] = -INFINITY; } } while (0)
#define ATT_DECIDE(C0, C1, FIRST) do { if (!FIX) { \
        float a_ = fmaxf(fmaxf(C0[0], C0[1]), C1[0]), b_ = fmaxf(fmaxf(C0[2], C0[3]), C1[1]); a_ = fmaxf(fmaxf(a_, C1[2]), C1[3]); \
        _Pragma("unroll") for (int r = 4; r < 16; r += 4) { a_ = fmaxf(fmaxf(a_, C0[r]), C0[r + 1]); b_ = fmaxf(fmaxf(b_, C0[r + 2]), C0[r + 3]); a_ = fmaxf(fmaxf(a_, C1[r]), C1[r + 1]); b_ = fmaxf(fmaxf(b_, C1[r + 2]), C1[r + 3]); } \
        float rm_ = fmaxf(a_, b_); { auto rr_ = __builtin_amdgcn_permlane32_swap(__float_as_uint(rm_), __float_as_uint(rm_), false, false); rm_ = fmaxf(__uint_as_float(rr_[0]), __uint_as_float(rr_[1])); } \
        resc = false; \
        if ((FIRST) || __any(rm_ > THRL)) { float dl_ = (FIRST) ? rm_ : fmaxf(rm_, 0.f); \
            if (!MLA) { const float nm_ = -(mhat + dl_); const unsigned h_ = cvtpk_s(nm_, 0.f) & 0xffffu; const float r1_ = nm_ - __uint_as_float(h_ << 16); const unsigned m_ = cvtpk_s(r1_, 0.f) & 0xffffu; \
                const float r2_ = r1_ - __uint_as_float(m_ << 16); const unsigned l_ = cvtpk_s(r2_, 0.f) & 0xffffu; \
                const float mn_ = -((__uint_as_float(h_ << 16) + __uint_as_float(m_ << 16)) + __uint_as_float(l_ << 16)); dl_ = mn_ - mhat; mhat = mn_; \
                if (hi == 0) qr[NQR - 1] = (bf16x8){one, one, one, (short)h_, (short)m_, (short)l_, 0, 0}; } \
            else { mhat += dl_; _Pragma("unroll") for (int r = 0; r < 16; ++r) negm[r] = -mhat; } \
            _Pragma("unroll") for (int r = 0; r < 16; ++r) { C0[r] -= dl_; C1[r] -= dl_; } \
            if (!(FIRST)) { const float f_ = __builtin_amdgcn_exp2f(-dl_); l_reg *= f_; if (hi == 0) wsf[r32] = f_; resc = true; } } } } while (0)
#define ATT_RESC() do { if (!FIX && resc) { \
        _Pragma("unroll") for (int i = 0; i < 4; ++i) { const f32x4 fv_ = *(const LAS3 f32x4*)(wsf + 8 * i + 4 * hi); \
            _Pragma("unroll") for (int d = 0; d < 2; ++d) { o[d][4 * i] *= fv_[0]; o[d][4 * i + 1] *= fv_[1]; o[d][4 * i + 2] *= fv_[2]; o[d][4 * i + 3] *= fv_[3]; } } } } while (0)
#define ATT_VS(tt) (vp0 + (((tt)) & 3) * VSLOT)
#define ATT_KS(tt) kb, ((((tt)) & 3) * KSLOT)
#ifndef ATT_STAGGER
#define ATT_STAGGER 0
#endif
    if (!ATT_STAGGER || wid < 4) {
#define ATT_STEP(t, MASKED) do { ATT_TOP(t); \
        constexpr bool E_ = FIX && (MLA || !(MASKED)); \
        ATT_QK(t, E_); \
        if (!MLA && (MASKED)) ATT_MASK(C0, C1, t); \
        ATT_DECIDE(C0, C1, false); ATT_SBAR(); \
        phase_b<true, true, E_>(C0, C1, o, ATT_VS((t) - 1), pw, l_reg); \
        ATT_RESC(); } while (0)
        ATT_TOP(t0);
        ATT_QK(t0, false);
        if (!MLA && wvis == t0) ATT_MASK(C0, C1, t0);
        ATT_DECIDE(C0, C1, true); ATT_SBAR();
        phase_b<true, false, false>(C0, C1, o, vp0, pw, l_reg);
        int t = t0 + 1;
        for (; t < wvis; ++t) ATT_STEP(t, false);
        if (t == wvis) { ATT_STEP(t, true); ++t; }
        { ATT_TOP(t); ATT_ISSUE(t); phase_b<false, true, false>(C0, C1, o, ATT_VS(t - 1), pw, l_reg); ++t; }
        for (; t <= NT + ATT_STAGGER; ++t) { ATT_TOP(t); ATT_ISSUE(t); }
#undef ATT_STEP
    } else {
        ATT_TOP(t0);
        ATT_QK(t0, false);
        ATT_DECIDE(C0, C1, true); ATT_SBAR();
        ATT_TOP(t0 + 1);
        phase_b<true, false, false>(C0, C1, o, vp0, pw, l_reg); ATT_SBAR();
        ATT_QK(t0 + 1, false);
        ATT_DECIDE(C0, C1, false); ATT_SBAR();
        int t = t0 + 2;
#define ATT_STEP2(t, MASKED) do { ATT_TOP(t); \
        phase_b<true, true, false>(C0, C1, o, ATT_VS((t) - 2), pw, l_reg); \
        ATT_RESC(); ATT_SBAR(); \
        ATT_QK(t, false); \
        if (!MLA && (MASKED)) ATT_MASK(C0, C1, t); \
        ATT_DECIDE(C0, C1, false); ATT_SBAR(); } while (0)
        for (; t < wvis; ++t) ATT_STEP2(t, false);
        ATT_STEP2(t, true); ++t;
        { ATT_TOP(t); ATT_ISSUE(t); phase_b<true, true, false>(C0, C1, o, ATT_VS(t - 2), pw, l_reg); ATT_RESC(); ++t; }
        { ATT_TOP(t); ATT_ISSUE(t); phase_b<false, true, false>(C0, C1, o, ATT_VS(t - 2), pw, l_reg); ++t; }
        for (; t <= NT + ATT_STAGGER; ++t) { ATT_TOP(t); ATT_ISSUE(t); }
#undef ATT_STEP2
    }
    { auto rr = __builtin_amdgcn_permlane32_swap(__float_as_uint(l_reg), __float_as_uint(l_reg), false, false); l_reg = __uint_as_float(rr[0]) + __uint_as_float(rr[1]); }
    if (hi == 0) wsf[32 + r32] = 1.0f / l_reg;
    float rli[16];
#pragma unroll
    for (int i = 0; i < 4; ++i) { const f32x4 fv = *(const LAS3 f32x4*)(wsf + 32 + 8 * i + 4 * hi); rli[4 * i] = fv[0]; rli[4 * i + 1] = fv[1]; rli[4 * i + 2] = fv[2]; rli[4 * i + 3] = fv[3]; }
    u16* Ow = s.o + (size_t)(q0 + wid * QBLK) * s.op;
    { LAS3 u16* stg = (LAS3 u16*)(shm + LDS_OST) + wid * 2048;
#pragma unroll
        for (int r = 0; r < 16; ++r) { const int orow = crow(r, hi);
#pragma unroll
            for (int d0 = 0; d0 < 2; ++d0) stg[orow * 64 + d0 * 32 + r32] = (u16)(cvtpk_s(o[d0][r] * rli[r], 0.f) & 0xffffu); }
        asm volatile("s_waitcnt lgkmcnt(0)" ::: "memory");
#pragma unroll
        for (int i = 0; i < 4; ++i) { const int row = i * 8 + (lane >> 3), ch = lane & 7; const u32x4 v = *(const LAS3 u32x4*)(stg + row * 64 + ch * 8); *(u32x4*)(Ow + (size_t)row * s.op + ch * 8) = v; } }
    asm volatile("s_waitcnt lgkmcnt(0)\n\ts_barrier" ::: "memory");
#undef ATT_DMA_K
#undef ATT_DMA_V
#undef ATT_TOP
#undef ATT_ISSUE
#undef ATT_QK
#undef ATT_MASK
#undef ATT_DECIDE
#undef ATT_RESC
#undef ATT_STEP
}
}

namespace cg = cooperative_groups;
#define LAS __attribute__((address_space(3)))
typedef unsigned short bf16;
typedef unsigned v4u __attribute__((ext_vector_type(4)));
typedef unsigned v2u __attribute__((ext_vector_type(2)));
typedef float f32x4 __attribute__((ext_vector_type(4)));
constexpr int NWAVES = 8;
constexpr int M = 16384, D = 1024, FF = 4096, NIN = 1960, NINP = 2048, QL = 256, KVL = 128, NQU = 768, NKVU = 1024;
constexpr float EPS = 1e-6f;
constexpr float LOG2E = 1.4426950408889634f;
constexpr float C2_FOX = 0.125f * LOG2E, C2_MLA = 0.10206207261596575f * LOG2E;
constexpr size_t MiB = 1u << 20;
constexpr size_t WS_WIN = 1 * MiB, WS_WQ = 5 * MiB, WS_WKV = 5 * MiB + 512 * 1024, WS_WO = 6 * MiB, WS_W1 = 8 * MiB, WS_W2 = 16 * MiB;
constexpr size_t WS_RT = 24 * MiB, WS_LF = 26 * MiB, WS_LC = 26 * MiB + 512 * 1024, WS_SS = 27 * MiB, WS_KR = 28 * MiB, WS_KB = 29 * MiB, WS_SSQ = 31 * MiB, WS_SSKV = 31 * MiB + 512 * 1024, WS_BIASF = 28 * MiB;
constexpr size_t WS_XN = 32 * MiB, WS_H = 64 * MiB, WS_P = 64 * MiB, WS_QM = 128 * MiB, WS_KVM = 152 * MiB, WS_QN = 184 * MiB, WS_O = 192 * MiB, WS_KVN = 224 * MiB, WS_END = 228 * MiB;
constexpr int RING_BYTES = 131072, LDS_BYTES = 147456;
static_assert(att::LDS_BYTES <= LDS_BYTES, "attention scratch fits the LDS allocation");

__device__ __forceinline__ unsigned f2bf(float f) { unsigned u = __builtin_bit_cast(unsigned, f); return (u + 0x7fffu + ((u >> 16) & 1u)) >> 16; }
__device__ __forceinline__ unsigned pk2(float lo, float hi) { return f2bf(lo) | (f2bf(hi) << 16); }
__device__ __forceinline__ float bf2f(unsigned short h) { return __builtin_bit_cast(float, (unsigned)h << 16); }
__device__ __forceinline__ float wave_sum(float v) {
#pragma unroll
    for (int o = 1; o < 64; o <<= 1) v += __shfl_xor(v, o);
    return v;
}
__device__ __forceinline__ int map_row(int mode, int n) {
    if (mode == 1) { const int h = n / 96, d = n % 96; if (d < 64) return n; const int i = d - 64; return h * 96 + (i < 16 ? 64 + 2 * i : 64 + 2 * (i - 16) + 1); }
    if (mode == 2) { const int h = n >> 7, j = n & 127; return j < 64 ? h * 64 + j : 512 + h * 64 + (j - 64); }
    if (mode == 3) { if (n < 1536 || n >= 1960) return n; if (n < 1544) return 1952 + (n - 1536); if (n < 1800) return 1536 + (n - 1544); if (n < 1928) return 1792 + (n - 1800);
        const int i = n - 1928; return 1920 + (i < 16 ? 2 * i : 2 * (i - 16) + 1); }
    return n;
}
__device__ __forceinline__ void p0_transpose_item(const float* W, int K, int N, int nblk, bf16* WT, int mode, const float* gk, LAS float* scr, int item, int lane) {
    const int kb = item / nblk, nb = item % nblk, k0 = 64 * kb, n0 = 32 * nb;
    const int nn = n0 + (lane & 31);
    float wv[32];
#pragma unroll
    for (int i = 0; i < 32; ++i) { const int kk = 2 * i + (lane >> 5); wv[i] = (nn < N) ? W[(size_t)(k0 + kk) * N + nn] : 0.f; }
    if (gk) {
#pragma unroll
        for (int i = 0; i < 32; ++i) wv[i] *= gk[k0 + 2 * i + (lane >> 5)]; }
#pragma unroll
    for (int i = 0; i < 32; ++i) { const int kk = 2 * i + (lane >> 5); scr[kk * 33 + (lane & 31)] = wv[i]; }
    asm volatile("s_waitcnt lgkmcnt(0)" ::: "memory");
    const int c = lane & 7;
#pragma unroll
    for (int j = 0; j < 4; ++j) { const int n = (lane >> 3) + 8 * j; const LAS float* sp = scr + (8 * c) * 33 + n;
        v4u o; o.x = pk2(sp[0 * 33], sp[1 * 33]); o.y = pk2(sp[2 * 33], sp[3 * 33]); o.z = pk2(sp[4 * 33], sp[5 * 33]); o.w = pk2(sp[6 * 33], sp[7 * 33]);
        *(v4u*)(WT + (size_t)map_row(mode, n0 + n) * K + k0 + 8 * c) = o; }
    asm volatile("s_waitcnt lgkmcnt(0)" ::: "memory");
}
__device__ __forceinline__ void sincos_d(double x, float& sn, float& cs) {
    const double k = rint(x * 0.63661977236758134308);
    double r = fma(-k, 1.57079632679489655800e+00, x); r = fma(-k, 6.12323399573676603587e-17, r);
    const double r2 = r * r;
    double s = -1.0 / 6227020800.0; s = s * r2 + 1.0 / 39916800.0; s = s * r2 - 1.0 / 362880.0; s = s * r2 + 1.0 / 5040.0; s = s * r2 - 1.0 / 120.0; s = s * r2 + 1.0 / 6.0; s = r - r * r2 * s;
    double c = 1.0 / 479001600.0; c = c * r2 - 1.0 / 3628800.0; c = c * r2 + 1.0 / 40320.0; c = c * r2 - 1.0 / 720.0; c = c * r2 + 1.0 / 24.0; c = c * r2 - 0.5; c = 1.0 + r2 * c;
    const int q = ((int)k) & 3;
    const double ss = (q == 0) ? s : (q == 1) ? c : (q == 2) ? -s : -c;
    const double cc = (q == 0) ? c : (q == 1) ? -s : (q == 2) ? -c : s;
    sn = (float)ss; cs = (float)cc;
}

#define RLX_AGENT __ATOMIC_RELAXED, __HIP_MEMORY_SCOPE_AGENT
#define XB_TMO      128
#define XB_XCNT(j)  (256  + 64 * (j))
#define XB_XSUB(j)  (1280 + 64 * (j))
#define XB_XGEN(j)  (2304 + 64 * (j))
#define XB_TOP      3328
#define XB_TOPGEN   3392
#define XCD_BAR_WORDS 3456
#define XB_SPIN_CAP (1u << 18)

__device__ __forceinline__ unsigned xb_ld(unsigned* p)              { return __hip_atomic_load(p, __ATOMIC_RELAXED, __HIP_MEMORY_SCOPE_AGENT); }
__device__ __forceinline__ unsigned xb_add(unsigned* p, unsigned v) { return __hip_atomic_fetch_add(p, v, __ATOMIC_RELAXED, __HIP_MEMORY_SCOPE_AGENT); }
__device__ __forceinline__ unsigned xb_xcc_id() { return (unsigned)__builtin_amdgcn_s_getreg((3 << 11) | 20) & 0xFu; }
#define XB_SPIN(cond, bar) do { unsigned _sp = 0; while (cond) { __builtin_amdgcn_s_sleep(1); \
    if ((++_sp & 255u) == 0u) { if (xb_ld(&(bar)[XB_TMO])) break; if (_sp > XB_SPIN_CAP) { atomicAdd(&(bar)[XB_TMO], 1u); break; } } } } while (0)

struct XcdBarrier {
    unsigned* bar; unsigned x;
    volatile LAS unsigned* st;
};

__device__ __forceinline__ XcdBarrier xcd_barrier_post(unsigned* bar, volatile LAS unsigned* st) {
    XcdBarrier b; b.bar = bar; b.x = xb_xcc_id(); b.st = st;
    if (threadIdx.x == 0) (void)xb_add(&bar[XB_XCNT(b.x)], 1u);
    return b;
}
__device__ __forceinline__ void xcd_barrier_complete(unsigned* bar, unsigned x, unsigned& nloc, unsigned& nx) {
    const unsigned G = gridDim.x * gridDim.y * gridDim.z;
    unsigned sum, cnt, mine, sp = 0u;
    for (;;) {
        sum = 0u; cnt = 0u; mine = 0u;
#pragma unroll
        for (unsigned j = 0; j < 16; ++j) { const unsigned c = xb_ld(&bar[XB_XCNT(j)]); sum += c; cnt += (c > 0u) ? 1u : 0u; mine = (j == x) ? c : mine; }
        if (sum == G) break;
        __builtin_amdgcn_s_sleep(1);
        if ((++sp & 255u) == 0u) { if (xb_ld(&bar[XB_TMO])) break; if (sp > XB_SPIN_CAP) { atomicAdd(&bar[XB_TMO], 1u); break; } }
    }
    nloc = mine > 0u ? mine : 1u; nx = cnt > 0u ? cnt : 1u;
}

__device__ __forceinline__ void xcd_barrier(const XcdBarrier& b) {
    asm volatile("s_waitcnt vmcnt(0)" ::: "memory");
    __syncthreads();
    if (threadIdx.x == 0) {
        unsigned* bar = b.bar;
        __builtin_amdgcn_s_waitcnt(0);
        unsigned nloc = b.st[0], nx = b.st[1];
        if (nloc == 0u) { xcd_barrier_complete(bar, b.x, nloc, nx); b.st[0] = nloc; b.st[1] = nx; }
        const unsigned old = xb_add(&bar[XB_XSUB(b.x)], 1u);
        const unsigned gen = old / nloc;
        if (old + 1u == (gen + 1u) * nloc) {
            __builtin_amdgcn_fence(__ATOMIC_RELEASE, "agent");
            asm volatile("s_waitcnt vmcnt(0)" ::: "memory");
            const unsigned og = xb_add(&bar[XB_TOP], 1u);
            const unsigned tg = og / nx;
            if (og + 1u == (tg + 1u) * nx) xb_add(&bar[XB_TOPGEN], 1u);
            else XB_SPIN(xb_ld(&bar[XB_TOPGEN]) == tg, bar);
            __builtin_amdgcn_fence(__ATOMIC_ACQUIRE, "agent");
            xb_add(&bar[XB_XGEN(b.x)], 1u);
            asm volatile("s_waitcnt vmcnt(0)" ::: "memory");
        } else {
            XB_SPIN(xb_ld(&bar[XB_XGEN(b.x)]) == gen, bar);
            __builtin_amdgcn_fence(__ATOMIC_ACQUIRE, "agent");
            asm volatile("s_waitcnt vmcnt(0)" ::: "memory");
        }
    }
    __syncthreads();
}

constexpr int MISC_OFF = LDS_BYTES - 128;
constexpr size_t WS_CTL = 0, CTL_ZERO_BYTES = 64 * 1024;
constexpr int CW_KMAX = 8192, CW_QF = 8192 + 512, CW_QM = 8192 + 1024, CW_PCNT = 8192 + 1536, CW_KMAXM = 13824, CW_QMAXM = 14400, CW_DONE = 14464;
static_assert(att::LDS_BYTES <= MISC_OFF, "LDS map");
struct Args { const float* in[13]; float* out; unsigned char* ws; int ph_lo, ph_hi, dup, pad; };
constexpr int NPHASE = 8;

__global__ void __launch_bounds__(NWAVES * 64, 2) mk_fwd(Args args) {
    extern __shared__ __attribute__((aligned(16))) unsigned char lds_raw[];
    LAS unsigned char* lds = (LAS unsigned char*)lds_raw;
    const int G = gridDim.x, bx = blockIdx.x;
#define MK_IDS int tid = threadIdx.x; asm volatile("" : "+v"(tid)); const int lane = tid & 63, wave = __builtin_amdgcn_readfirstlane(tid >> 6); const int gw = vcu * NWAVES + wave; (void)gw; (void)lane;
    const int vcu = (G % 8 == 0) ? (bx % 8) * (G / 8) + bx / 8 : bx;
    const int NGW = G * NWAVES;
    unsigned char* ws = args.ws;
#define MKP_x ((const float*)args.in[0])
#define MKP_g_mix ((const float*)args.in[1])
#define MKP_w_in ((const float*)args.in[2])
#define MKP_b_f ((const float*)args.in[3])
#define MKP_g_q ((const float*)args.in[4])
#define MKP_w_q_up ((const float*)args.in[5])
#define MKP_g_kv ((const float*)args.in[6])
#define MKP_w_kv_up ((const float*)args.in[7])
#define MKP_w_o ((const float*)args.in[8])
#define MKP_g_mlp ((const float*)args.in[9])
#define MKP_w_ff1 ((const float*)args.in[10])
#define MKP_w_ff2 ((const float*)args.in[11])
#define MKP_g_final ((const float*)args.in[12])
#define MKP_out (args.out)
#define MKP_Win_t ((bf16*)(args.ws + WS_WIN))
#define MKP_Wq_t ((bf16*)(args.ws + WS_WQ))
#define MKP_Wkv_t ((bf16*)(args.ws + WS_WKV))
#define MKP_Wo_t ((bf16*)(args.ws + WS_WO))
#define MKP_W1_t ((bf16*)(args.ws + WS_W1))
#define MKP_W2_t ((bf16*)(args.ws + WS_W2))
#define MKP_RT ((float*)(args.ws + WS_RT))
#define MKP_LF ((float*)(args.ws + WS_LF))
#define MKP_SS ((float*)(args.ws + WS_SS))
#define MKP_SSQ ((float*)(args.ws + WS_SSQ))
#define MKP_BIASF ((float*)(args.ws + WS_BIASF))
#define MKP_QMAX ((float*)(args.ws + WS_LC))
#define MKP_SSKV ((float*)(args.ws + WS_SSKV))
#define MKP_KB ((bf16*)(args.ws + WS_KB))
#define MKP_KR ((bf16*)(args.ws + WS_KR))
#define MKP_XN ((bf16*)(args.ws + WS_XN))
#define MKP_HB ((bf16*)(args.ws + WS_H))
#define MKP_P ((bf16*)(args.ws + WS_P))
#define MKP_QM ((bf16*)(args.ws + WS_QM))
#define MKP_KVM ((bf16*)(args.ws + WS_KVM))
#define MKP_QN ((bf16*)(args.ws + WS_QN))
#define MKP_OB ((bf16*)(args.ws + WS_O))
#define MKP_KVN ((bf16*)(args.ws + WS_KVN))
    const int lo = args.ph_lo, hi = args.ph_hi;
#ifndef MK_MASK
#define MK_MASK 0x1ff
#endif
#define IN(k) (((MK_MASK >> (k)) & 1) && lo <= (k) && (k) < hi)
#define REP(k) for (int rep_ = 0; rep_ < ((args.dup == (k)) ? 2 : 1); ++rep_)
    { volatile LAS unsigned* misc = (volatile LAS unsigned*)(lds + MISC_OFF); if (threadIdx.x < 32) misc[threadIdx.x] = 0u; }
    __syncthreads();
    (void)xcd_barrier_post((unsigned*)(ws + WS_CTL), (volatile LAS unsigned*)(lds + MISC_OFF) + 8);
    if (args.ph_lo < 0) cg::this_grid().sync();
#ifdef TS_PHASE
    unsigned long long ts_a_ = 0, ts_b_ = 0;
#define TS_BEGIN(k) do { if ((k) == TS_PHASE || (TS_PHASE == 99 && (k) == 0)) ts_a_ = __builtin_amdgcn_s_memrealtime(); } while (0)
#define TS_END(k) do { if ((k) == TS_PHASE || (TS_PHASE == 99 && (k) == 7)) ts_b_ = __builtin_amdgcn_s_memrealtime(); } while (0)
#else
#define TS_BEGIN(k)
#define TS_END(k)
#endif
#define SEAM(k) do { if (IN(k) && IN((k) + 1)) { XcdBarrier b_; b_.bar = (unsigned*)(args.ws + WS_CTL); b_.x = xb_xcc_id(); b_.st = (volatile LAS unsigned*)(lds + MISC_OFF) + 8; xcd_barrier(b_); } } while (0)

    TS_BEGIN(0);
    if (IN(0)) { MK_IDS
        LAS float* scr = (LAS float*)(lds + wave * 16384);
        constexpr int I_IN = (D / 64) * (NINP / 32), I_Q = (QL / 64) * (NQU / 32), I_KV = (KVL / 64) * (NKVU / 32), I_O = (D / 64) * (D / 32), I_1 = (D / 64) * (FF / 32), I_2 = (FF / 64) * (D / 32);
        constexpr int NITEMS = I_IN + I_Q + I_KV;
        (void)I_O; (void)I_1; (void)I_2;
        for (int it = gw; it < NITEMS; it += NGW) {
            int r = it;
            if (r < I_IN) { p0_transpose_item(MKP_w_in, D, NIN, NINP / 32, MKP_Win_t, 3, nullptr, scr, r, lane); continue; } r -= I_IN;
            if (r < I_Q) { p0_transpose_item(MKP_w_q_up, QL, NQU, NQU / 32, MKP_Wq_t, 1, MKP_g_q, scr, r, lane); continue; } r -= I_Q;
            p0_transpose_item(MKP_w_kv_up, KVL, NKVU, NKVU / 32, MKP_Wkv_t, 2, MKP_g_kv, scr, r, lane);
        }
        for (int m0 = gw; m0 < M; m0 += 4 * NGW) {
            const f32x4* gr = (const f32x4*)MKP_g_mix + lane; f32x4 v[4][4]; float s2[4];
#pragma unroll
            for (int r = 0; r < 4; ++r) { const int m = m0 + r * NGW; const f32x4* xr = (const f32x4*)(MKP_x + (size_t)(m < M ? m : 0) * D) + lane;
#pragma unroll
                for (int j = 0; j < 4; ++j) v[r][j] = xr[64 * j]; }
#pragma unroll
            for (int r = 0; r < 4; ++r) { s2[r] = 0.f;
#pragma unroll
                for (int j = 0; j < 4; ++j) s2[r] += (v[r][j].x * v[r][j].x + v[r][j].y * v[r][j].y) + (v[r][j].z * v[r][j].z + v[r][j].w * v[r][j].w);
                s2[r] = 1.f / sqrtf(wave_sum(s2[r]) * (1.f / D) + EPS); }
#pragma unroll
            for (int r = 0; r < 4; ++r) { const int m = m0 + r * NGW; if (m < M) { unsigned long long* o8 = (unsigned long long*)(MKP_XN + (size_t)m * D) + lane; const float rstd = s2[r];
#pragma unroll
                for (int j = 0; j < 4; ++j) { const f32x4 g = gr[64 * j]; o8[64 * j] = (unsigned long long)pk2(v[r][j].x * rstd * g.x, v[r][j].y * rstd * g.y) | ((unsigned long long)pk2(v[r][j].z * rstd * g.z, v[r][j].w * rstd * g.w) << 32); } } }
        }
        for (int e = (vcu * NWAVES * 64 + tid); e < M * 16; e += G * NWAVES * 64) {
            const int m = e >> 4, i = e & 15; double inv = 1.0; for (int j = 0; j < i; ++j) inv *= 0.56234132519034908039;
            float sn, cs; sincos_d((double)m * inv, sn, cs); MKP_RT[2 * e] = cs; MKP_RT[2 * e + 1] = sn;
        }
    }
    SEAM(0);
    TS_END(0);
    TS_BEGIN(1);
    if (IN(1)) {
        pg8::Gemm g{MKP_XN, MKP_Win_t, M, NINP, D}; pg8::StaticOrder S; S.init(M, NINP, G, bx);
        pg8::EpiIn E{MKP_P, NINP, C2_FOX, MKP_SSQ, MKP_SSKV, MKP_RT, MKP_b_f, MKP_LF, M};
        pg8::gemm_phase<pg8::EpiIn, pg8::StaticOrder, PG8_ALIGN, PG8_SP2>(lds, g, S, E);
    }
    SEAM(1);
    TS_END(1);
    TS_BEGIN(3);
    if (IN(3)) { MK_IDS
        if (wave >= 2) {
            LAS float* scr = (LAS float*)(lds + wave * 16384);
            constexpr int J_O = (D / 64) * (D / 32), J_1 = (D / 64) * (FF / 32), J_2 = (FF / 64) * (D / 32);
            for (int it = vcu * 6 + (wave - 2); it < J_O + J_1 + J_2; it += G * 6) {
                int r = it;
                if (r < J_O) { p0_transpose_item(MKP_w_o, D, D, D / 32, MKP_Wo_t, 0, nullptr, scr, r, lane); continue; } r -= J_O;
                if (r < J_1) { p0_transpose_item(MKP_w_ff1, D, FF, FF / 32, MKP_W1_t, 0, MKP_g_mlp, scr, r, lane); continue; } r -= J_1;
                p0_transpose_item(MKP_w_ff2, FF, D, D / 32, MKP_W2_t, 0, nullptr, scr, r, lane);
            }
        }
        if (wave < 2) { const int job = bx + 256 * wave;
            if (job < 512 && bx < 256) { const int h = job >> 6, ti = job & 63; const f32x4* lf4 = (const f32x4*)(MKP_LF + (size_t)h * M);
                float pre = 0.f; { int j = 0; float pa[8] = {0.f, 0.f, 0.f, 0.f, 0.f, 0.f, 0.f, 0.f};
                    for (; j + 8 <= ti; j += 8) { f32x4 w[8];
#pragma unroll
                        for (int u = 0; u < 8; ++u) w[u] = lf4[(j + u) * 64 + lane];
#pragma unroll
                        for (int u = 0; u < 8; ++u) pa[u] += (w[u].x + w[u].y) + (w[u].z + w[u].w); }
                    for (; j < ti; ++j) { const f32x4 w = lf4[j * 64 + lane]; pa[0] += (w.x + w.y) + (w.z + w.w); }
                    pre = ((pa[0] + pa[1]) + (pa[2] + pa[3])) + ((pa[4] + pa[5]) + (pa[6] + pa[7])); }
                pre = wave_sum(pre);
                const f32x4 v = lf4[ti * 64 + lane];
                const float s1 = v.x, s2 = s1 + v.y, s3 = s2 + v.z, s4 = s3 + v.w; float inc = s4;
#pragma unroll
                for (int o = 1; o < 64; o <<= 1) { const float n = __shfl_up(inc, o); if (lane >= o) inc += n; }
                const float ex = pre + (inc - s4); const float cs[4] = {ex + s1, ex + s2, ex + s3, ex + s4};
                *(f32x4*)(MKP_BIASF + (size_t)h * M + ti * 256 + 4 * lane) = (f32x4){-cs[0] * LOG2E, -cs[1] * LOG2E, -cs[2] * LOG2E, -cs[3] * LOG2E};
                { float km = 0.f;
                  float qmx = 0.f;
                  for (int e = 0; e < 4; ++e) { const v4u* kr = (const v4u*)(MKP_P + (size_t)(ti * 256 + 4 * lane + e) * NINP + 512 + h * 64); float a2 = 0.f; const v4u* qrw = kr - 64; float q2 = 0.f;
#pragma unroll
                      for (int c8 = 0; c8 < 8; ++c8) { const v4u w = qrw[c8]; const unsigned ww[4] = {w.x, w.y, w.z, w.w};
#pragma unroll
                          for (int q4 = 0; q4 < 4; ++q4) { const float lo_ = __builtin_bit_cast(float, ww[q4] << 16), hi_ = __builtin_bit_cast(float, ww[q4] & 0xffff0000u); q2 += lo_ * lo_ + hi_ * hi_; } }
                      qmx = fmaxf(qmx, q2);
#pragma unroll
                      for (int c8 = 0; c8 < 8; ++c8) { const v4u w = kr[c8]; const unsigned ww[4] = {w.x, w.y, w.z, w.w};
#pragma unroll
                          for (int q4 = 0; q4 < 4; ++q4) { const float lo_ = __builtin_bit_cast(float, ww[q4] << 16), hi_ = __builtin_bit_cast(float, ww[q4] & 0xffff0000u); a2 += lo_ * lo_ + hi_ * hi_; } }
                      km = fmaxf(km, a2); }
#pragma unroll
                  for (int o = 32; o >= 1; o >>= 1) km = fmaxf(km, __shfl_xor(km, o));
#pragma unroll
                  for (int o = 32; o >= 1; o >>= 1) qmx = fmaxf(qmx, __shfl_xor(qmx, o));
                  if (lane == 0) { atomicMax((unsigned*)(args.ws + WS_CTL) + CW_KMAX + 64 * h, __builtin_bit_cast(unsigned, km)); MKP_QMAX[h * 64 + ti] = qmx; } }
#pragma unroll
                for (int e = 0; e < 4; ++e) { const float b = -cs[e] * LOG2E; const unsigned bh = f2bf(b); const float r1 = b - __builtin_bit_cast(float, bh << 16); const unsigned bm = f2bf(r1);
                    const float r2 = r1 - __builtin_bit_cast(float, bm << 16); const unsigned bl = f2bf(r2);
                    *(v4u*)(MKP_KB + ((size_t)h * M + ti * 256 + 4 * lane + e) * 8) = (v4u){bh | (bm << 16), bl | 0x3F800000u, 0x3F803F80u, 0u}; } } }
        __syncthreads();
        { int kq = QL; asm volatile("" : "+s"(kq)); pg8::Gemm g{MKP_P + 1536, MKP_Wq_t, M, NQU, kq, NINP}; pg8::StaticOrder S; S.init(M, NQU, G, bx);
          pg8::EpiQm E{MKP_QM, NQU, MKP_RT, C2_MLA, MKP_SSQ, EPS};
          pg8::gemm_phase<pg8::EpiQm, pg8::StaticOrder, PG8_ALIGN, PG8_SP2>(lds, g, S, E); }
        { int kkv = KVL; asm volatile("" : "+s"(kkv)); pg8::Gemm g{MKP_P + 1792, MKP_Wkv_t, M, NKVU, kkv, NINP}; pg8::StaticOrder S; S.init(M, NKVU, G, bx);
          pg8::EpiKv E{MKP_KVM, NKVU, MKP_SSKV, EPS};
          pg8::gemm_phase<pg8::EpiKv, pg8::StaticOrder, PG8_ALIGN, PG8_SP2>(lds, g, S, E); }
    }
    SEAM(3);
    TS_END(3);
    TS_BEGIN(4);
    if (IN(4)) {
        const int v = (G == 256) ? vcu : bx; const int h0 = (v >> 5) & 7;
        volatile LAS unsigned* misc = (volatile LAS unsigned*)(lds + MISC_OFF);
        unsigned* ctlw = (unsigned*)(args.ws + WS_CTL);
        { const int tid_ = threadIdx.x, lane_ = tid_ & 63, tok = bx * 64 + (tid_ >> 3), hh = tid_ & 7; float k2 = 0.f, q2 = 0.f;
          if (bx < 256) {
            const v4u* kp = (const v4u*)(MKP_KVM + (size_t)tok * NKVU + hh * 64); const v4u* rp = (const v4u*)(MKP_P + (size_t)tok * NINP + 1920); const v4u* qp = (const v4u*)(MKP_QM + (size_t)tok * NQU + hh * 96);
#define MK_SQ(w_, acc_) do { const unsigned ww_[4] = {w_.x, w_.y, w_.z, w_.w}; _Pragma("unroll") for (int q4_ = 0; q4_ < 4; ++q4_) { const float lo_ = __builtin_bit_cast(float, ww_[q4_] << 16), hi_ = __builtin_bit_cast(float, ww_[q4_] & 0xffff0000u); acc_ += lo_ * lo_ + hi_ * hi_; } } while (0)
#pragma unroll
            for (int c8 = 0; c8 < 8; ++c8) { const v4u w = kp[c8]; MK_SQ(w, k2); }
#pragma unroll
            for (int c8 = 0; c8 < 4; ++c8) { const v4u w = rp[c8]; MK_SQ(w, k2); }
#pragma unroll
            for (int c8 = 0; c8 < 12; ++c8) { const v4u w = qp[c8]; MK_SQ(w, q2); }
#undef MK_SQ
          }
#pragma unroll
          for (int o = 8; o <= 32; o <<= 1) { k2 = fmaxf(k2, __shfl_xor(k2, o)); q2 = fmaxf(q2, __shfl_xor(q2, o)); }
          if (lane_ < 8) { atomicMax(ctlw + CW_KMAXM + 64 * lane_, __builtin_bit_cast(unsigned, k2)); atomicMax(ctlw + CW_QMAXM, __builtin_bit_cast(unsigned, q2)); }
          asm volatile("s_waitcnt vmcnt(0)" ::: "memory"); __syncthreads();
          if (tid_ == 0) __hip_atomic_fetch_add(ctlw + CW_DONE, 1u, __ATOMIC_RELAXED, __HIP_MEMORY_SCOPE_AGENT); }
        bool okF = true;
        { const int lane_ = threadIdx.x & 63;
          for (int h = 0; h < 8; ++h) { const float kF = __builtin_bit_cast(float, __hip_atomic_load(ctlw + CW_KMAX + 64 * h, __ATOMIC_RELAXED, __HIP_MEMORY_SCOPE_AGENT));
              float qF = MKP_QMAX[h * 64 + lane_];
#pragma unroll
              for (int o = 32; o >= 1; o >>= 1) qF = fmaxf(qF, __shfl_xor(qF, o));
              okF = okF && (qF * kF < 2025.f); }
          okF = __builtin_amdgcn_readfirstlane(okF ? 1 : 0) != 0; }
#ifndef PROBE_FOX
#define PROBE_FOX 1
#endif
#ifndef PROBE_MLA
#define PROBE_MLA 1
#endif
#define MK_POP(CWQ) \
            if ((threadIdx.x >> 6) == 0) { const int ln_ = threadIdx.x & 63; unsigned i_ = 0xFFFFFFFFu; int hs_ = h0; \
                if (own) { if (ln_ == 0) i_ = __hip_atomic_fetch_add(ctlw + (CWQ) + 64 * h0 + 16 * rep, 1u, __ATOMIC_RELAXED, __HIP_MEMORY_SCOPE_AGENT); i_ = (unsigned)__builtin_amdgcn_readfirstlane((int)i_); } \
                if (!own || i_ >= 64u) { unsigned c_ = 64u; if (ln_ < 8) c_ = __hip_atomic_load(ctlw + (CWQ) + 64 * ((h0 + ln_) & 7) + 16 * rep, __ATOMIC_RELAXED, __HIP_MEMORY_SCOPE_AGENT); \
                    const unsigned long long m_ = __ballot(c_ < 64u); i_ = 0xFFFFFFFFu; \
                    if (m_ != 0ull) { hs_ = (h0 + (int)__builtin_ctzll(m_)) & 7; if (ln_ == 0) i_ = __hip_atomic_fetch_add(ctlw + (CWQ) + 64 * hs_ + 16 * rep, 1u, __ATOMIC_RELAXED, __HIP_MEMORY_SCOPE_AGENT); \
                        i_ = (unsigned)__builtin_amdgcn_readfirstlane((int)i_); if (i_ >= 64u) i_ = 0xFFFFFFFEu; } } \
                if (ln_ == 0) { misc[0] = i_; misc[1] = (unsigned)hs_; } } \
            __syncthreads(); const unsigned i = misc[0]; const int h = (int)misc[1]; __syncthreads(); \
            if (h != h0 || i >= 64u) own = false; \
            if (i == 0xFFFFFFFFu) break; \
            if (i >= 64u) continue;
#define MK_FOX_LOOPS(FIXV) do { \
        for (int rep = 0; rep < PROBE_FOX; ++rep) { bool own = true; \
        for (;;) { MK_POP(CW_QF) \
            const float kmax2 = __builtin_bit_cast(float, __hip_atomic_load(ctlw + CW_KMAX + 64 * h, __ATOMIC_RELAXED, __HIP_MEMORY_SCOPE_AGENT)); \
            att::Src s{MKP_P + h * 64, NINP, MKP_P + 512 + h * 64, NINP, MKP_KB + (size_t)h * M * 8, 8, MKP_P + 1024 + h * 64, NINP, MKP_OB + h * 64, D}; \
            att::attn_unit<false, FIXV>(63 - (int)i, s, lds, MKP_BIASF + (size_t)h * M, kmax2, MKP_QMAX + h * 64); \
        } } } while (0)
#define MK_MLA_LOOPS(FIXV) do { \
        for (int rep = 0; rep < PROBE_MLA; ++rep) { bool own = true; \
        for (;;) { MK_POP(CW_QM) \
            const float kmaxm = __builtin_bit_cast(float, __hip_atomic_load(ctlw + CW_KMAXM + 64 * h, __ATOMIC_RELAXED, __HIP_MEMORY_SCOPE_AGENT)); \
            att::Src s{MKP_QM + h * 96, NQU, MKP_KVM + h * 64, NKVU, MKP_P + 1920, NINP, MKP_KVM + 512 + h * 64, NKVU, MKP_OB + 512 + h * 64, D}; \
            att::attn_unit<true, FIXV>(63 - (int)i, s, lds, nullptr, kmaxm, nullptr); \
        } } } while (0)
        if (okF) MK_FOX_LOOPS(true); else MK_FOX_LOOPS(false);
        asm volatile("" ::: "memory");
        if (threadIdx.x == 0) { unsigned sp = 0; while (__hip_atomic_load(ctlw + CW_DONE, __ATOMIC_RELAXED, __HIP_MEMORY_SCOPE_AGENT) < (unsigned)G) { __builtin_amdgcn_s_sleep(2); if (++sp > (1u << 22)) break; } }
        __syncthreads();
        bool okM = true;
        { const float qmM = __builtin_bit_cast(float, __hip_atomic_load(ctlw + CW_QMAXM, __ATOMIC_RELAXED, __HIP_MEMORY_SCOPE_AGENT));
          for (int h = 0; h < 8; ++h) { const float kM = __builtin_bit_cast(float, __hip_atomic_load(ctlw + CW_KMAXM + 64 * h, __ATOMIC_RELAXED, __HIP_MEMORY_SCOPE_AGENT)); okM = okM && (qmM * kM < 2025.f); }
          okM = __builtin_amdgcn_readfirstlane(okM ? 1 : 0) != 0; }
        if (okM) MK_MLA_LOOPS(true); else MK_MLA_LOOPS(false);
#undef MK_FOX_LOOPS
#undef MK_MLA_LOOPS
#undef MK_POP
    }
#ifdef ATT_PRIO
    __builtin_amdgcn_s_setprio(0);
#endif
    SEAM(4);
    TS_END(4);
    TS_BEGIN(5);
    if (IN(5)) {
        pg8::Gemm g{MKP_OB, MKP_Wo_t, M, D, D}; pg8::StaticOrder S; S.init(M, D, G, bx);
        pg8::EpiRes E{MKP_x, MKP_out, D, MKP_XN, MKP_SS};
        pg8::gemm_phase<pg8::EpiRes, pg8::StaticOrder, PG8_ALIGN, PG8_SP2>(lds, g, S, E);
    }
    SEAM(5);
    TS_END(5);
    TS_BEGIN(6);
    if (IN(6)) {
        pg8::Gemm g{MKP_XN, MKP_W1_t, M, FF, D}; pg8::StaticOrder S; S.init(M, FF, G, bx);
        pg8::EpiSqRelu E{MKP_HB, FF, MKP_SS, EPS, 1.f / D};
        pg8::gemm_phase<pg8::EpiSqRelu, pg8::StaticOrder, PG8_ALIGN, PG8_SP2>(lds, g, S, E);
    }
    SEAM(6);
    TS_END(6);
    TS_BEGIN(7);
    if (IN(7)) {
        pg8::Gemm g{MKP_HB, MKP_W2_t, M, D, FF}; pg8::StaticOrder S; S.init(M, D, G, bx);
        pg8::EpiResNorm E{MKP_out, MKP_out, D, MKP_g_final, MKP_SSQ, (unsigned*)(args.ws + WS_CTL) + CW_PCNT, EPS, 1.f / D};
        pg8::gemm_phase<pg8::EpiResNorm, pg8::StaticOrder, false, PG8_SP2>(lds, g, S, E);
    }
#ifdef TS_PHASE
    { XcdBarrier b_; b_.bar = (unsigned*)(args.ws + WS_CTL); b_.x = xb_xcc_id(); b_.st = (volatile LAS unsigned*)(lds + MISC_OFF) + 8; xcd_barrier(b_); }
    TS_END(7);
    if (blockIdx.x == 0 && threadIdx.x == 0) MKP_out[0] = (float)(((ts_b_ - ts_a_) / TS_Q) * (TS_Q / 100ull));
#endif
#undef IN
#undef SEAM
#undef MKP_x
#undef MKP_g_mix
#undef MKP_w_in
#undef MKP_b_f
#undef MKP_g_q
#undef MKP_w_q_up
#undef MKP_g_kv
#undef MKP_w_kv_up
#undef MKP_w_o
#undef MKP_g_mlp
#undef MKP_w_ff1
#undef MKP_w_ff2
#undef MKP_g_final
#undef MKP_out
#undef MKP_Win_t
#undef MKP_Wq_t
#undef MKP_Wkv_t
#undef MKP_Wo_t
#undef MKP_W1_t
#undef MKP_W2_t
#undef MKP_RT
#undef MKP_LF
#undef MKP_SS
#undef MKP_SSQ
#undef MKP_BIASF
#undef MKP_QMAX
#undef MKP_SSKV
#undef MKP_KB
#undef MKP_KR
#undef MKP_XN
#undef MKP_HB
#undef MKP_P
#undef MKP_QM
#undef MKP_KVM
#undef MKP_QN
#undef MKP_OB
#undef MKP_KVN
}

#ifndef MK_ONE_LAUNCH
#define MK_ONE_LAUNCH 1
#endif
extern "C" void kernel_launch(void* const* d_in, const int* in_sizes, int n_in, void* d_out, int out_size, void* d_ws, size_t ws_size, hipStream_t stream) {
    static int ready = 0;
    if (ready == 0) {
        if (n_in != 13 || in_sizes[0] != M * D || out_size != M * D || ws_size < WS_END) { fprintf(stderr, "kernel_launch: unexpected shapes (n_in %d, in0 %d, out %d, ws %zu)\n", n_in, n_in > 0 ? in_sizes[0] : -1, out_size, ws_size); ready = -1; return; }
        if (hipFuncSetAttribute((const void*)mk_fwd, hipFuncAttributeMaxDynamicSharedMemorySize, LDS_BYTES) != hipSuccess) { fprintf(stderr, "kernel_launch: hipFuncSetAttribute failed\n"); ready = -1; return; }
        ready = 1;
    }
    if (ready < 0) return;
    if (hipMemsetAsync((char*)d_ws + WS_CTL, 0, CTL_ZERO_BYTES, stream) != hipSuccess) { fprintf(stderr, "kernel_launch: hipMemsetAsync failed\n"); return; }
    Args a{};
    for (int i = 0; i < 13; ++i) a.in[i] = (const float*)d_in[i];
    a.out = (float*)d_out; a.ws = (unsigned char*)d_ws;
#ifndef MK_DUP
#define MK_DUP -1
#endif
    a.dup = MK_DUP;
    const int grid = 256;
#if MK_ONE_LAUNCH
    a.ph_lo = 0; a.ph_hi = NPHASE;
    void* kargs[] = {&a};
    hipError_t e = hipLaunchCooperativeKernel((const void*)mk_fwd, dim3(grid), dim3(NWAVES * 64), kargs, LDS_BYTES, stream);
    if (e != hipSuccess) fprintf(stderr, "kernel_launch: cooperative launch failed: %s\n", hipGetErrorString(e));
#else
    for (int p = 0; p < NPHASE; ++p) { a.ph_lo = p; a.ph_hi = p + 1; hipLaunchKernelGGL(mk_fwd, dim3(grid), dim3(NWAVES * 64), LDS_BYTES, stream, a); }
#endif
}
```

```cpp
#include <hip/hip_runtime.h>
#include <hip/hip_cooperative_groups.h>
#include <hip/hip_bf16.h>
#include <cstdio>
#include <cstdint>
#include <cmath>
namespace pg8 {
#define PG8_LAS __attribute__((address_space(3)))
typedef unsigned short bf16_t;
typedef short bf16x8 __attribute__((ext_vector_type(8)));
typedef float f32x4 __attribute__((ext_vector_type(4)));
typedef unsigned u32x4 __attribute__((ext_vector_type(4)));
constexpr int BM = 256, BK = 64, HALF = 128, HTB = HALF * BK * 2  , STAGE_BYTES = 8 * HTB, NXCD = 8, WGM = 8;

__host__ __device__ __forceinline__ int lds_byte(int r, int c) { const int st = (r >> 4) * 2 + (c >> 5), rr = r & 15, cc = c & 31, ob = rr * 64 + cc * 2; return st * 1024 + (ob ^ (((ob >> 9) & 1) << 5)); }
__host__ __device__ __forceinline__ void stage_rc(int b, int& R, int& C) { const int st = b / 1024, sb = b % 1024, swz = sb ^ (((sb >> 9) & 1) << 5); R = (st >> 1) * 16 + swz / 64; C = (st & 1) * 32 + (swz % 64) / 2; }
__host__ __device__ __forceinline__ int perm32(int rho) { const int n = rho >> 4, i = rho & 15; return 8 * (i >> 2) + 4 * n + (i & 3); }

struct Unit { int pm, pn; };
struct Gemm { const bf16_t* A; const bf16_t* Bt; int M, N, K; int lda; };

struct StaticOrder {
    int nM, nN, nwg, G, c;
    __host__ __device__ void init(int M, int N, int G_, int c_) { nM = M / BM; nN = N / BM; nwg = nM * nN; G = G_; c = c_; }
    __host__ __device__ bool next(int i, Unit& u) const {
        const long L = (long)i * G + c; if (L >= nwg) return false;
        int wgid = (int)L; { const int q = nwg / NXCD, r = nwg % NXCD, xcd = wgid % NXCD, off = wgid / NXCD; wgid = (xcd < r ? xcd * (q + 1) : r * (q + 1) + (xcd - r) * q) + off; }
        const int nig = WGM * nN, gid = wgid / nig, fm = gid * WGM, gsz = (nM - fm) < WGM ? (nM - fm) : WGM;
        u.pm = fm + ((wgid % nig) % gsz); u.pn = (wgid % nig) / gsz; return true;
    }
    __device__ __forceinline__ void a_ready(const Unit&) const {}
    __device__ __forceinline__ void done(const Unit&) const {}
};

__device__ __forceinline__ unsigned cvt_pk_bf16(float lo, float hi) { unsigned r; asm volatile("v_cvt_pk_bf16_f32 %0, %1, %2" : "=v"(r) : "v"(lo), "v"(hi)); return r; }
typedef float f32x2 __attribute__((ext_vector_type(2)));
__device__ __forceinline__ f32x2 gelu_pk(f32x2 v) {
    const f32x2 av = __builtin_elementwise_abs(v), d = av * 0.2316418882f + 1.0f;
    f32x2 t; t.x = __builtin_amdgcn_rcpf(d.x); t.y = __builtin_amdgcn_rcpf(d.y);
    f32x2 q = t * 0.5307027145f + (-0.7265760135f); q = q * t + 0.7107068705f; q = q * t + (-0.142248368f); q = q * t + 0.127414796f; q = q * t;
    const f32x2 s = (v * v) * (-0.72134752044f);
    f32x2 e; e.x = __builtin_amdgcn_exp2f(s.x); e.y = __builtin_amdgcn_exp2f(s.y);
    const f32x2 m = v * (q * e), r = v - m;
    f32x2 o; o.x = v.x < 0.f ? m.x : r.x; o.y = v.y < 0.f ? m.y : r.y; return o;
}

template <int ACT  > struct EpiBf16 {
    static constexpr bool PERM = true, AFTER_DRAIN = false; static_assert(ACT == 0 || ACT == 1, "EpiBf16: ACT is 0 (none) or 1 (gelu_pk)");
    bf16_t* O; int ldc; const float* bias; int split_cols; size_t split_stride; float scale0;
    __device__ __forceinline__ void operator()(const f32x4 (&acc)[2][2][4][2], const Unit& u, int wr, int wc, int fr, int fq) const {
        const int row0 = u.pm * BM + wr * 64 + fr; int colt = u.pn * BM; bf16_t* base = O;
        float sc = 1.f; if (split_cols) { const int t = colt / split_cols; base += (size_t)t * split_stride; colt -= t * split_cols; if (t == 0) sc = scale0; }
        const int col0 = colt + wc * 32 + 8 * fq, bcol0 = u.pn * BM + wc * 32 + 8 * fq;
        f32x4 bv[2][2];
#pragma unroll
        for (int bj = 0; bj < 2; ++bj)
#pragma unroll
            for (int n = 0; n < 2; ++n) bv[bj][n] = bias ? *(const f32x4*)(bias + bcol0 + bj * HALF + 4 * n) : (f32x4){0.f, 0.f, 0.f, 0.f};
#pragma unroll
        for (int ai = 0; ai < 2; ++ai)
#pragma unroll
            for (int m = 0; m < 4; ++m) { bf16_t* rowp = base + (size_t)(row0 + ai * HALF + m * 16) * ldc + col0;
#pragma unroll
                for (int bj = 0; bj < 2; ++bj) { f32x4 v0 = acc[ai][bj][m][0] + bv[bj][0], v1 = acc[ai][bj][m][1] + bv[bj][1];
                    if (ACT == 1) { f32x2 a = gelu_pk((f32x2){v0[0], v0[1]}), b = gelu_pk((f32x2){v0[2], v0[3]}), c = gelu_pk((f32x2){v1[0], v1[1]}), d = gelu_pk((f32x2){v1[2], v1[3]});
                        v0 = (f32x4){a.x, a.y, b.x, b.y}; v1 = (f32x4){c.x, c.y, d.x, d.y}; }
                    v0 = v0 * sc; v1 = v1 * sc; u32x4 w; w.x = cvt_pk_bf16(v0[0], v0[1]); w.y = cvt_pk_bf16(v0[2], v0[3]); w.z = cvt_pk_bf16(v1[0], v1[1]); w.w = cvt_pk_bf16(v1[2], v1[3]);
                    *(u32x4*)(rowp + bj * HALF) = w; } }
    }
};

struct EpiQm {
    static constexpr bool PERM = true, AFTER_DRAIN = false;
    bf16_t* O; int ldc; const float* rt; float scale; const float* ssq; float eps;
    __device__ __forceinline__ void operator()(const f32x4 (&acc)[2][2][4][2], const Unit& u, int wr, int wc, int fr, int fq) const {
        const int row0 = u.pm * BM + wr * 64 + fr, col0 = u.pn * BM + wc * 32 + 8 * fq;
#pragma unroll
        for (int ai = 0; ai < 2; ++ai)
#pragma unroll
            for (int m = 0; m < 4; ++m) { const int row = row0 + ai * HALF + m * 16;
                const f32x4 sq = *(const f32x4*)(ssq + (size_t)row * 4); const float rs = scale / sqrtf(((sq[0] + sq[1]) + (sq[2] + sq[3])) * (1.0f / 256.0f) + eps);
#pragma unroll
                for (int bj = 0; bj < 2; ++bj) { const int c = col0 + bj * HALF, d = c % 96;
                    f32x4 v0 = acc[ai][bj][m][0], v1 = acc[ai][bj][m][1];
                    if (d >= 64) { const f32x4* t = (const f32x4*)(rt + (size_t)row * 32 + (d - 64)); const f32x4 t0 = t[0], t1 = t[1];
                        f32x4 w0, w1;
                        w0[0] = v0[0] * t0[0] - v0[1] * t0[1]; w0[1] = v0[1] * t0[0] + v0[0] * t0[1];
                        w0[2] = v0[2] * t0[2] - v0[3] * t0[3]; w0[3] = v0[3] * t0[2] + v0[2] * t0[3];
                        w1[0] = v1[0] * t1[0] - v1[1] * t1[1]; w1[1] = v1[1] * t1[0] + v1[0] * t1[1];
                        w1[2] = v1[2] * t1[2] - v1[3] * t1[3]; w1[3] = v1[3] * t1[2] + v1[2] * t1[3];
                        v0 = w0; v1 = w1; }
                    v0 = v0 * rs; v1 = v1 * rs; u32x4 w; w.x = cvt_pk_bf16(v0[0], v0[1]); w.y = cvt_pk_bf16(v0[2], v0[3]); w.z = cvt_pk_bf16(v1[0], v1[1]); w.w = cvt_pk_bf16(v1[2], v1[3]);
                    *(u32x4*)(O + (size_t)row * ldc + c) = w; }
                asm volatile("" ::: "memory"); }
    }
};

struct EpiKv {
    static constexpr bool PERM = true, AFTER_DRAIN = false;
    bf16_t* O; int ldc; const float* ssq; float eps;
    __device__ __forceinline__ void operator()(const f32x4 (&acc)[2][2][4][2], const Unit& u, int wr, int wc, int fr, int fq) const {
        const int row0 = u.pm * BM + wr * 64 + fr, col0 = u.pn * BM + wc * 32 + 8 * fq;
#pragma unroll
        for (int ai = 0; ai < 2; ++ai)
#pragma unroll
            for (int m = 0; m < 4; ++m) { const int row = row0 + ai * HALF + m * 16;
                const f32x4 sq = *(const f32x4*)(ssq + (size_t)row * 4); const float rs = 1.0f / sqrtf(((sq[0] + sq[1]) + (sq[2] + sq[3])) * (1.0f / 128.0f) + eps);
#pragma unroll
                for (int bj = 0; bj < 2; ++bj) { const f32x4 v0 = acc[ai][bj][m][0] * rs, v1 = acc[ai][bj][m][1] * rs;
                    u32x4 w; w.x = cvt_pk_bf16(v0[0], v0[1]); w.y = cvt_pk_bf16(v0[2], v0[3]); w.z = cvt_pk_bf16(v1[0], v1[1]); w.w = cvt_pk_bf16(v1[2], v1[3]);
                    *(u32x4*)(O + (size_t)row * ldc + col0 + bj * HALF) = w; }
                asm volatile("" ::: "memory"); }
    }
};
struct EpiIn {
    static constexpr bool PERM = true, AFTER_DRAIN = false;
    bf16_t* O; int ldc; float scale0; float* ssq; float* sskv; const float* rt; const float* bf; float* lf; int nrows;
    __device__ __forceinline__ void operator()(const f32x4 (&acc)[2][2][4][2], const Unit& u, int wr, int wc, int fr, int fq) const {
        const int row0 = u.pm * BM + wr * 64 + fr, col0 = u.pn * BM + wc * 32 + 8 * fq; const int pn = u.pn;
        const float sc = pn < 2 ? scale0 : 1.f;
#pragma unroll
        for (int ai = 0; ai < 2; ++ai)
#pragma unroll
            for (int m = 0; m < 4; ++m) { const int row = row0 + ai * HALF + m * 16; bf16_t* rowp = O + (size_t)row * ldc + col0; float s0 = 0.f, s1 = 0.f;
#pragma unroll
                for (int bj = 0; bj < 2; ++bj) { f32x4 v0 = acc[ai][bj][m][0] * sc, v1 = acc[ai][bj][m][1] * sc;
                    const float sq = ((v0[0] * v0[0] + v0[1] * v0[1]) + (v0[2] * v0[2] + v0[3] * v0[3])) + ((v1[0] * v1[0] + v1[1] * v1[1]) + (v1[2] * v1[2] + v1[3] * v1[3]));
                    if (bj == 0) s0 = sq; else s1 = sq;
                    bool store = true;
                    if (pn == 7 && bj == 1) { store = (wc == 0);
                        if (wc == 0) { const f32x4* t = (const f32x4*)(rt + (size_t)row * 32 + 8 * fq); const f32x4 t0 = t[0], t1 = t[1]; f32x4 w0, w1;
                            w0[0] = v0[0] * t0[0] - v0[1] * t0[1]; w0[1] = v0[1] * t0[0] + v0[0] * t0[1];
                            w0[2] = v0[2] * t0[2] - v0[3] * t0[3]; w0[3] = v0[3] * t0[2] + v0[2] * t0[3];
                            w1[0] = v1[0] * t1[0] - v1[1] * t1[1]; w1[1] = v1[1] * t1[0] + v1[0] * t1[1];
                            w1[2] = v1[2] * t1[2] - v1[3] * t1[3]; w1[3] = v1[3] * t1[2] + v1[2] * t1[3];
                            v0 = w0; v1 = w1; }
                        else if (wc == 1 && fq == 0) {
#pragma unroll
                            for (int e = 0; e < 8; ++e) { const float z = (e < 4 ? v0[e & 3] : v1[e & 3]) + bf[e]; lf[(size_t)e * nrows + row] = fminf(z, 0.f) - 0.6931471805599453f * __builtin_amdgcn_logf(1.0f + __builtin_amdgcn_exp2f(-1.4426950408889634f * fabsf(z))); } } }
                    if (store) { u32x4 w; w.x = cvt_pk_bf16(v0[0], v0[1]); w.y = cvt_pk_bf16(v0[2], v0[3]); w.z = cvt_pk_bf16(v1[0], v1[1]); w.w = cvt_pk_bf16(v1[2], v1[3]);
                        *(u32x4*)(rowp + bj * HALF) = w; } }
                if (pn == 6) { float s = s0 + s1; s += __shfl_xor(s, 16); s += __shfl_xor(s, 32); if (fq == 0) ssq[(size_t)row * 4 + wc] = s; }
                if (pn == 7) { float s = s0; s += __shfl_xor(s, 16); s += __shfl_xor(s, 32); if (fq == 0) sskv[(size_t)row * 4 + wc] = s; }
                asm volatile("" ::: "memory"); }
    }
};
struct EpiRes {
    static constexpr bool PERM = false, AFTER_DRAIN = false;
    const float* base; float* out; int ldc; bf16_t* ob; float* ss;
    __device__ __forceinline__ void operator()(const f32x4 (&acc)[2][2][4][2], const Unit& u, int wr, int wc, int fr, int fq) const {
        typedef unsigned u32x2v __attribute__((ext_vector_type(2)));
        const int row0 = u.pm * BM + wr * 64 + fr, col0 = u.pn * BM + wc * 32 + 4 * fq;
        f32x4 cb[2][2], nb[2][2];
        { const size_t off = (size_t)row0 * ldc + col0;
#pragma unroll
          for (int bj = 0; bj < 2; ++bj)
#pragma unroll
              for (int n = 0; n < 2; ++n) cb[bj][n] = *(const f32x4*)(base + off + bj * HALF + n * 16); }
#pragma unroll
        for (int g = 0; g < 8; ++g) { const int ai = g >> 2, m = g & 3; const int row = row0 + ai * HALF + m * 16; const size_t off = (size_t)row * ldc + col0; float s = 0.f;
            if (g + 1 < 8) { const int ai1 = (g + 1) >> 2, m1 = (g + 1) & 3; const size_t off1 = (size_t)(row0 + ai1 * HALF + m1 * 16) * ldc + col0;
#pragma unroll
                for (int bj = 0; bj < 2; ++bj)
#pragma unroll
                    for (int n = 0; n < 2; ++n) nb[bj][n] = *(const f32x4*)(base + off1 + bj * HALF + n * 16); }
            asm volatile("" ::: "memory");
#pragma unroll
            for (int bj = 0; bj < 2; ++bj)
#pragma unroll
                for (int n = 0; n < 2; ++n) { const f32x4 v = cb[bj][n] + acc[ai][bj][m][n];
                    *(f32x4*)(out + off + bj * HALF + n * 16) = v; s += (v[0] * v[0] + v[1] * v[1]) + (v[2] * v[2] + v[3] * v[3]);
                    if (ob) { u32x2v w; w.x = cvt_pk_bf16(v[0], v[1]); w.y = cvt_pk_bf16(v[2], v[3]); *(u32x2v*)(ob + off + bj * HALF + n * 16) = w; } }
            if (ss) { s += __shfl_xor(s, 16); s += __shfl_xor(s, 32); if (fq == 0) ss[(size_t)row * 16 + u.pn * 4 + wc] = s; }
#pragma unroll
            for (int bj = 0; bj < 2; ++bj)
#pragma unroll
                for (int n = 0; n < 2; ++n) cb[bj][n] = nb[bj][n];
        }
    }
};

struct EpiResNorm {
    static constexpr bool PERM = false, AFTER_DRAIN = true;
    const float* base; float* out; int ldc; const float* g; float* xs; unsigned* cnt; float eps; float inv_n;
    __device__ __forceinline__ void fused(f32x4 (&acc)[2][2][4][2], const Unit& u, int wr, int wc, int fr, int fq, PG8_LAS unsigned char* lds, int wid, int lane) const {
        PG8_LAS float* Pm = (PG8_LAS float*)lds;
        PG8_LAS float* S = (PG8_LAS float*)(lds + 4096);
        const int row0 = u.pm * BM + wr * 64 + fr, col0 = u.pn * BM + wc * 32 + 4 * fq;
        f32x4 cb[2][2], nb[2][2];
        { const size_t off = (size_t)row0 * ldc + col0;
#pragma unroll
          for (int bj = 0; bj < 2; ++bj)
#pragma unroll
              for (int n = 0; n < 2; ++n) cb[bj][n] = *(const f32x4*)(base + off + bj * HALF + n * 16); }
#pragma unroll
        for (int g = 0; g < 8; ++g) { const int ai = g >> 2, m = g & 3; float s = 0.f;
            if (g + 1 < 8) { const size_t off1 = (size_t)(row0 + ((g + 1) >> 2) * HALF + ((g + 1) & 3) * 16) * ldc + col0;
#pragma unroll
                for (int bj = 0; bj < 2; ++bj)
#pragma unroll
                    for (int n = 0; n < 2; ++n) nb[bj][n] = *(const f32x4*)(base + off1 + bj * HALF + n * 16); }
            asm volatile("" ::: "memory");
#pragma unroll
            for (int bj = 0; bj < 2; ++bj)
#pragma unroll
                for (int n = 0; n < 2; ++n) { const f32x4 v = cb[bj][n] + acc[ai][bj][m][n]; acc[ai][bj][m][n] = v;
                    s += (v[0] * v[0] + v[1] * v[1]) + (v[2] * v[2] + v[3] * v[3]); }
            s += __shfl_xor(s, 16); s += __shfl_xor(s, 32);
            if (fq == 0) Pm[(ai * HALF + wr * 64 + m * 16 + fr) * 4 + wc] = s;
#pragma unroll
            for (int bj = 0; bj < 2; ++bj)
#pragma unroll
                for (int n = 0; n < 2; ++n) cb[bj][n] = nb[bj][n]; }
        asm volatile("s_waitcnt lgkmcnt(0)" ::: "memory"); __builtin_amdgcn_s_barrier(); asm volatile("" ::: "memory");
        const int tid = wid * 64 + lane;
        if (tid < 256) { const f32x4 p4 = *(const PG8_LAS f32x4*)(Pm + tid * 4);
            __hip_atomic_store(xs + (size_t)(u.pm * BM + tid) * 4 + u.pn, (p4[0] + p4[1]) + (p4[2] + p4[3]), __ATOMIC_RELAXED, __HIP_MEMORY_SCOPE_AGENT);
            asm volatile("s_waitcnt vmcnt(0)" ::: "memory");
            if (lane == 0) __hip_atomic_fetch_add(cnt + 64 * u.pm, 1u, __ATOMIC_RELAXED, __HIP_MEMORY_SCOPE_AGENT); }
        if (wid == 0) { unsigned sp = 0;
            while ((unsigned)__builtin_amdgcn_readfirstlane(__hip_atomic_load(cnt + 64 * u.pm, __ATOMIC_RELAXED, __HIP_MEMORY_SCOPE_AGENT)) < 16u) { __builtin_amdgcn_s_sleep(2); if (++sp > (1u << 22)) break; }
            __builtin_amdgcn_fence(__ATOMIC_ACQUIRE, "agent"); }
        asm volatile("s_waitcnt vmcnt(0) lgkmcnt(0)" ::: "memory"); __builtin_amdgcn_s_barrier(); asm volatile("" ::: "memory");
        if (tid < 256) { const float* xp = xs + (size_t)(u.pm * BM + tid) * 4;
            const float t0 = __hip_atomic_load(xp + 0, __ATOMIC_RELAXED, __HIP_MEMORY_SCOPE_AGENT), t1 = __hip_atomic_load(xp + 1, __ATOMIC_RELAXED, __HIP_MEMORY_SCOPE_AGENT);
            const float t2 = __hip_atomic_load(xp + 2, __ATOMIC_RELAXED, __HIP_MEMORY_SCOPE_AGENT), t3 = __hip_atomic_load(xp + 3, __ATOMIC_RELAXED, __HIP_MEMORY_SCOPE_AGENT);
            S[tid] = 1.0f / sqrtf(((t0 + t1) + (t2 + t3)) * inv_n + eps); }
        asm volatile("s_waitcnt vmcnt(0) lgkmcnt(0)" ::: "memory"); __builtin_amdgcn_s_barrier(); asm volatile("" ::: "memory");
        f32x4 gv[2][2];
#pragma unroll
        for (int bj = 0; bj < 2; ++bj)
#pragma unroll
            for (int n = 0; n < 2; ++n) gv[bj][n] = *(const f32x4*)(g + col0 + bj * HALF + n * 16);
#pragma unroll
        for (int ai = 0; ai < 2; ++ai)
#pragma unroll
            for (int m = 0; m < 4; ++m) { const int r = ai * HALF + wr * 64 + m * 16 + fr; const float rs = S[r]; const size_t off = (size_t)(u.pm * BM + r) * ldc + col0;
#pragma unroll
                for (int bj = 0; bj < 2; ++bj)
#pragma unroll
                    for (int n = 0; n < 2; ++n) *(f32x4*)(out + off + bj * HALF + n * 16) = acc[ai][bj][m][n] * rs * gv[bj][n]; }
    }
};
struct EpiSqRelu {
    static constexpr bool PERM = true, AFTER_DRAIN = false;
    bf16_t* O; int ldc; const float* ss; float eps; float inv_n;
    __device__ __forceinline__ void operator()(const f32x4 (&acc)[2][2][4][2], const Unit& u, int wr, int wc, int fr, int fq) const {
        const int row0 = u.pm * BM + wr * 64 + fr, col0 = u.pn * BM + wc * 32 + 8 * fq;
        f32x4 cs[4], ns[4];
        { const f32x4* sp = (const f32x4*)(ss + (size_t)row0 * 16); cs[0] = sp[0]; cs[1] = sp[1]; cs[2] = sp[2]; cs[3] = sp[3]; }
#pragma unroll
        for (int g = 0; g < 8; ++g) { const int ai = g >> 2, m = g & 3; const int row = row0 + ai * HALF + m * 16;
            if (g + 1 < 8) { const f32x4* sp = (const f32x4*)(ss + (size_t)(row0 + ((g + 1) >> 2) * HALF + ((g + 1) & 3) * 16) * 16); ns[0] = sp[0]; ns[1] = sp[1]; ns[2] = sp[2]; ns[3] = sp[3]; }
            asm volatile("" ::: "memory");
            const f32x4 a = cs[0], b = cs[1], c = cs[2], d = cs[3];
            const float tot = ((a[0] + a[1]) + (a[2] + a[3])) + ((b[0] + b[1]) + (b[2] + b[3])) + ((c[0] + c[1]) + (c[2] + c[3])) + ((d[0] + d[1]) + (d[2] + d[3]));
            const float rstd = 1.0f / sqrtf(tot * inv_n + eps);
#pragma unroll
            for (int bj = 0; bj < 2; ++bj) { f32x4 v0 = acc[ai][bj][m][0] * rstd, v1 = acc[ai][bj][m][1] * rstd;
#pragma unroll
                for (int e = 0; e < 4; ++e) { const float x0 = fmaxf(v0[e], 0.f), x1 = fmaxf(v1[e], 0.f); v0[e] = x0 * x0; v1[e] = x1 * x1; }
                u32x4 w; w.x = cvt_pk_bf16(v0[0], v0[1]); w.y = cvt_pk_bf16(v0[2], v0[3]); w.z = cvt_pk_bf16(v1[0], v1[1]); w.w = cvt_pk_bf16(v1[2], v1[3]);
                *(u32x4*)(O + (size_t)row * ldc + col0 + bj * HALF) = w; }
            cs[0] = ns[0]; cs[1] = ns[1]; cs[2] = ns[2]; cs[3] = ns[3]; }
    }
};


template <class Epi, class Sched, bool ALIGN_EPI = false, bool SP2 = false>
__device__ __forceinline__ void gemm_phase(PG8_LAS unsigned char* lds, const Gemm g, const Sched& S, const Epi& E) {
    const int tid = threadIdx.x, wid = __builtin_amdgcn_readfirstlane(tid >> 6), lane = tid & 63, wr = wid >> 2, wc = wid & 3, fr = lane & 15, fq = lane >> 4;
    const int K = g.K, nt = K / BK, lda = g.lda ? g.lda : g.K;
    unsigned voffA[2], voffB[2];
#pragma unroll
    for (int i = 0; i < 2; ++i) { int R, C; stage_rc(tid * 16 + i * 8192, R, C); const int Rb = Epi::PERM ? ((R & ~31) + perm32(R & 31)) : R;
        voffA[i] = (unsigned)(R * lda + C) * 2u; voffB[i] = (unsigned)(Rb * K + C) * 2u; }
    const size_t kstep = (size_t)(BK * 2);
    const size_t hstep = (size_t)HALF * K * 2;
    const size_t tstep = 2 * hstep;
    const size_t hstepA = (size_t)HALF * lda * 2, tstepA = 2 * hstepA;
    const unsigned ldsw = (unsigned)wid * 1024u;
    const int aoff = lds_byte(wr * 64 + fr, fq * 8), boff = lds_byte(wc * 32 + fr, fq * 8);
#define PG8_SA(b, h) (((b) * 2 + (h)) * HTB)
#define PG8_SB(b, h) ((4 + (b) * 2 + (h)) * HTB)
#define PG8_STAGE(bufoff, gbase, voff) do { _Pragma("unroll") for (int _i = 0; _i < 2; ++_i) \
        __builtin_amdgcn_global_load_lds((const unsigned*)((const char*)(gbase) + (voff)[_i]), (PG8_LAS unsigned*)(lds + (bufoff) + ldsw + _i * 8192), 16, 0, 0); } while (0)
#define PG8_LDA(dst, b, h) do { _Pragma("unroll") for (int m = 0; m < 4; ++m) _Pragma("unroll") for (int k = 0; k < 2; ++k) dst[m][k] = *(const PG8_LAS bf16x8*)(lds + PG8_SA(b, h) + aoff + m * 2048 + k * 1024); } while (0)
#define PG8_LDB(dst, b, h) do { _Pragma("unroll") for (int n = 0; n < 2; ++n) _Pragma("unroll") for (int k = 0; k < 2; ++k) dst[n][k] = *(const PG8_LAS bf16x8*)(lds + PG8_SB(b, h) + boff + n * 2048 + k * 1024); } while (0)
#define PG8_MMA(ai, bj, At, Bt) do { __builtin_amdgcn_s_setprio(1); _Pragma("unroll") for (int m = 0; m < 4; ++m) _Pragma("unroll") for (int n = 0; n < 2; ++n) _Pragma("unroll") for (int k = 0; k < 2; ++k) \
        acc[ai][bj][m][n] = __builtin_amdgcn_mfma_f32_16x16x32_bf16(Bt[n][k], At[m][k], acc[ai][bj][m][n], 0, 0, 0); __builtin_amdgcn_s_setprio(0); } while (0)
#define PG8_WAIT_V(n) asm volatile("s_waitcnt vmcnt(" #n ")" ::: "memory")
#define PG8_WAIT_L(n) asm volatile("s_waitcnt lgkmcnt(" #n ")" ::: "memory")
#define PG8_BAR __builtin_amdgcn_s_barrier()
#define PG8_SCHED __builtin_amdgcn_sched_barrier(0)
    Unit cur, nxt; int ui = 0;
    if (!S.next(0, cur)) return;
    f32x4 acc[2][2][4][2];
#pragma unroll
    for (int a = 0; a < 2; ++a)
#pragma unroll
        for (int b = 0; b < 2; ++b)
#pragma unroll
            for (int m = 0; m < 4; ++m)
#pragma unroll
                for (int n = 0; n < 2; ++n) acc[a][b][m][n] = (f32x4){0.f, 0.f, 0.f, 0.f};
    bf16x8 At[4][2], B0[2][2], B1[2][2];
    const char* cA = (const char*)g.A + (size_t)cur.pm * tstepA; const char* cB = (const char*)g.Bt + (size_t)cur.pn * tstep;
    S.a_ready(cur);
    if constexpr (SP2) {
        PG8_STAGE(PG8_SB(0, 0), cB, voffB); PG8_STAGE(PG8_SB(0, 1), cB + hstep, voffB); PG8_STAGE(PG8_SA(0, 0), cA, voffA); PG8_STAGE(PG8_SA(0, 1), cA + hstepA, voffA);
        if (wr == 1) PG8_BAR;
        PG8_WAIT_V(2); PG8_BAR;
        PG8_STAGE(PG8_SB(1, 0), cB + kstep, voffB); PG8_STAGE(PG8_SA(1, 0), cA + kstep, voffA); PG8_STAGE(PG8_SB(1, 1), cB + hstep + kstep, voffB);
        PG8_WAIT_V(6); PG8_BAR;
    } else {
        PG8_STAGE(PG8_SB(0, 0), cB, voffB); PG8_STAGE(PG8_SA(0, 0), cA, voffA); PG8_STAGE(PG8_SB(0, 1), cB + hstep, voffB); PG8_STAGE(PG8_SA(0, 1), cA + hstepA, voffA);
        if (wr == 1) PG8_BAR;
        PG8_WAIT_V(4); PG8_BAR;
        PG8_STAGE(PG8_SB(1, 0), cB + kstep, voffB); PG8_STAGE(PG8_SA(1, 0), cA + kstep, voffA); PG8_STAGE(PG8_SB(1, 1), cB + hstep + kstep, voffB);
        PG8_WAIT_V(6); PG8_BAR;
    }
    for (;;) {
        const bool has_next = S.next(ui + 1, nxt);
        const char* nA = has_next ? (const char*)g.A + (size_t)nxt.pm * tstepA : cA; const char* nB = has_next ? (const char*)g.Bt + (size_t)nxt.pn * tstep : cB;
        for (int t = 0; t < nt; t += 2) {
            const bool last = (t == nt - 2);
            const char* a1 = cA + (size_t)(t + 1) * kstep;
            const char* a2 = last ? nA : cA + (size_t)(t + 2) * kstep; const char* b2 = last ? nB : cB + (size_t)(t + 2) * kstep;
            const char* a3 = a2 + kstep; const char* b3 = b2 + kstep;
            if (last && has_next) S.a_ready(nxt);
            if constexpr (SP2) {
            PG8_LDB(B0, 0, 0); PG8_LDB(B1, 0, 1); PG8_SCHED; PG8_LDA(At, 0, 0); PG8_STAGE(PG8_SA(1, 1), a1 + hstepA, voffA);
            PG8_WAIT_V(8); PG8_WAIT_L(0); PG8_BAR; PG8_MMA(0, 0, At, B0); PG8_MMA(0, 1, At, B1); PG8_BAR; PG8_SCHED;
            PG8_LDA(At, 0, 1); PG8_STAGE(PG8_SB(0, 0), b2, voffB); PG8_STAGE(PG8_SB(0, 1), b2 + hstep, voffB); PG8_STAGE(PG8_SA(0, 0), a2, voffA);
            PG8_WAIT_V(8); PG8_WAIT_L(0); PG8_BAR; PG8_MMA(1, 0, At, B0); PG8_MMA(1, 1, At, B1); PG8_BAR; PG8_SCHED;
            PG8_LDB(B0, 1, 0); PG8_LDB(B1, 1, 1); PG8_SCHED; PG8_LDA(At, 1, 0); PG8_STAGE(PG8_SA(0, 1), a2 + hstepA, voffA);
            PG8_WAIT_V(8); PG8_WAIT_L(0); PG8_BAR; PG8_MMA(0, 0, At, B0); PG8_MMA(0, 1, At, B1); PG8_BAR; PG8_SCHED;
            PG8_LDA(At, 1, 1); PG8_STAGE(PG8_SB(1, 0), b3, voffB); PG8_STAGE(PG8_SB(1, 1), b3 + hstep, voffB); PG8_STAGE(PG8_SA(1, 0), a3, voffA);
            PG8_WAIT_V(8); PG8_WAIT_L(0); PG8_BAR; PG8_MMA(1, 0, At, B0); PG8_MMA(1, 1, At, B1); PG8_BAR; PG8_SCHED;
            } else {
            PG8_LDB(B0, 0, 0); PG8_SCHED; PG8_LDA(At, 0, 0); PG8_STAGE(PG8_SA(1, 1), a1 + hstepA, voffA);
            PG8_WAIT_L(8); PG8_BAR; PG8_WAIT_L(0); PG8_MMA(0, 0, At, B0); PG8_BAR; PG8_SCHED;
            PG8_LDB(B1, 0, 1); PG8_STAGE(PG8_SB(0, 0), b2, voffB);
            PG8_BAR; PG8_WAIT_L(0); PG8_MMA(0, 1, At, B1); PG8_BAR;
            PG8_LDA(At, 0, 1); PG8_STAGE(PG8_SA(0, 0), a2, voffA);
            PG8_BAR; PG8_WAIT_L(0); PG8_MMA(1, 0, At, B0); PG8_BAR; PG8_SCHED;
            PG8_STAGE(PG8_SB(0, 1), b2 + hstep, voffB);
            PG8_WAIT_V(6); PG8_BAR; PG8_MMA(1, 1, At, B1); PG8_BAR;
            PG8_LDB(B0, 1, 0); PG8_SCHED; PG8_LDA(At, 1, 0); PG8_STAGE(PG8_SA(0, 1), a2 + hstepA, voffA);
            PG8_WAIT_L(8); PG8_BAR; PG8_WAIT_L(0); PG8_MMA(0, 0, At, B0); PG8_BAR; PG8_SCHED;
            PG8_LDB(B1, 1, 1); PG8_STAGE(PG8_SB(1, 0), b3, voffB);
            PG8_BAR; PG8_WAIT_L(0); PG8_MMA(0, 1, At, B1); PG8_BAR;
            PG8_LDA(At, 1, 1); PG8_STAGE(PG8_SA(1, 0), a3, voffA);
            PG8_BAR; PG8_WAIT_L(0); PG8_MMA(1, 0, At, B0); PG8_BAR; PG8_SCHED;
            PG8_STAGE(PG8_SB(1, 1), b3 + hstep, voffB);
            PG8_WAIT_V(6); PG8_BAR; PG8_MMA(1, 1, At, B1); PG8_BAR;
            }
        }
        if constexpr (ALIGN_EPI) { if (wr == 0) PG8_BAR; }
        if constexpr (!Epi::AFTER_DRAIN) { E(acc, cur, wr, wc, fr, fq); S.done(cur); }
        if (!has_next) break;
#pragma unroll
        for (int a = 0; a < 2; ++a)
#pragma unroll
            for (int b = 0; b < 2; ++b)
#pragma unroll
                for (int m = 0; m < 4; ++m)
#pragma unroll
                    for (int n = 0; n < 2; ++n) acc[a][b][m][n] = (f32x4){0.f, 0.f, 0.f, 0.f};
        cur = nxt; cA = nA; cB = nB; ++ui;
        if constexpr (ALIGN_EPI) { if (wr == 1) PG8_BAR; }
    }
    PG8_WAIT_V(0);
    if constexpr (!ALIGN_EPI) { if (wr == 0) PG8_BAR; }
    PG8_BAR;
    if constexpr (Epi::AFTER_DRAIN) { E.fused(acc, cur, wr, wc, fr, fq, lds, wid, lane); S.done(cur); }
#undef PG8_SA
#undef PG8_SB
#undef PG8_STAGE
#undef PG8_LDA
#undef PG8_LDB
#undef PG8_MMA
#undef PG8_WAIT_V
#undef PG8_WAIT_L
#undef PG8_BAR
#undef PG8_SCHED
}
}

#ifndef PG8_SP2
#define PG8_SP2 true
#endif
#ifndef PG8_ALIGN
#define PG8_ALIGN true
#endif
namespace att {
#define LAS3 __attribute__((address_space(3)))
using bf16x8 = __attribute__((ext_vector_type(8))) short;
using s16x4 = __attribute__((ext_vector_type(4))) short;
using f32x16 = __attribute__((ext_vector_type(16))) float;
using f32x4 = __attribute__((ext_vector_type(4))) float;
using u32x4 = __attribute__((ext_vector_type(4))) unsigned;
typedef unsigned short u16;
typedef LAS3 const unsigned char* lds_cptr;
typedef short v4i16_t __attribute__((ext_vector_type(4)));
constexpr int SEQ = 16384, NW = 8, QBLK = 32, QB = 256, KVBLK = 64;
constexpr int KSLOT = 12288, VSLOT = 8192, NKS = 4, NVS = 4;
constexpr int LDS_K = 0, LDS_V = NKS * KSLOT, LDS_WS = LDS_V + NVS * VSLOT, LDS_OST = LDS_WS + NW * 256, LDS_QX = LDS_OST + NW * 4096, LDS_BYTES = LDS_QX + NW * 2048;
__device__ __forceinline__ int crow(int r, int hi) { return (r & 3) + 8 * (r >> 2) + 4 * hi; }
__device__ __forceinline__ void glds16(const void* gsrc, unsigned lds_dst) {
    asm volatile("s_mov_b32 m0, %1\n\ts_nop 0\n\tglobal_load_lds_dwordx4 %0, off" : : "v"(gsrc), "s"(lds_dst) : "memory", "m0"); }
typedef float f32x2_t __attribute__((ext_vector_type(2))); typedef __bf16 bf16x2_t __attribute__((ext_vector_type(2)));
__device__ __forceinline__ unsigned cvtpk_s(float lo, float hi) { f32x2_t v = {lo, hi}; bf16x2_t b = __builtin_convertvector(v, bf16x2_t); return __builtin_bit_cast(unsigned, b); }
__device__ __forceinline__ s16x4 vtr(lds_cptr p) { return __builtin_bit_cast(s16x4, __builtin_amdgcn_ds_read_tr16_b64_v4i16((LAS3 v4i16_t*)p)); }
#define ATT_SBAR() __builtin_amdgcn_sched_barrier(0)
#define ATT_WAIT_BAR(N) asm volatile("s_waitcnt vmcnt(" #N ") lgkmcnt(0)\n\ts_barrier" ::: "memory")
struct Src {
    const u16* q; int qp;
    const u16* k; int kp;
    const u16* k2; int k2p;
    const u16* v; int vp;
    u16* o; int op;
};
template <int NDK, int NQR, bool ZC, int XHS, int JLO, int JHI, bool EARLY>
__device__ __forceinline__ void phase_a(f32x16& C0, f32x16& C1, const lds_cptr* kb_, int ksl_, const bf16x8* qr, lds_cptr qx_, const f32x16& negm, bf16x8* kf, bf16x8* qx) {
    constexpr int KPF = 4;
#define ATT_SH(s_) (EARLY ? ((s_) / NDK) : ((s_) & 1))
#define ATT_SD(s_) (EARLY ? ((s_) % NDK) : ((s_) >> 1))
#define ATT_KRD(s_) kf[s_] = *(const LAS3 bf16x8*)(kb_[ATT_SD(s_)] + ksl_ + ATT_SH(s_) * (ATT_SD(s_) < 4 ? 4096 : XHS))
    if (JLO == 0) {
#pragma unroll
        for (int j = 0; j < KPF; ++j) ATT_KRD(j); }
#pragma unroll
    for (int j = JLO; j < JHI; ++j) {
        if (j + KPF < 2 * NDK) ATT_KRD(j + KPF);
        { const int dn = ATT_SD(j) + 2; if (NDK > NQR && dn >= NQR && dn < NDK && (EARLY || ATT_SH(j) == 0)) qx[dn >= NQR ? dn - NQR : 0] = *(const LAS3 bf16x8*)(qx_ + (dn >= NQR ? dn - NQR : 0) * 1024); }
        ATT_SBAR();
        const int d0 = ATT_SD(j); const f32x16 z = f32x16{}; const bf16x8 qf = (d0 < NQR) ? qr[d0 < NQR ? d0 : 0] : qx[d0 >= NQR ? d0 - NQR : 0];
        if (ATT_SH(j)) C1 = __builtin_amdgcn_mfma_f32_32x32x16_bf16(kf[j], qf, (d0 == 0) ? (ZC ? z : negm) : C1, 0, 0, 0);
        else           C0 = __builtin_amdgcn_mfma_f32_32x32x16_bf16(kf[j], qf, (d0 == 0) ? (ZC ? z : negm) : C0, 0, 0, 0);
        if (EARLY && j > NDK) { const int e0 = 16 * (j - NDK - 1) / (NDK - 1), e1 = 16 * (j - NDK) / (NDK - 1);
#pragma unroll
            for (int e = e0; e < e1; ++e) C0[e] = __builtin_amdgcn_exp2f(C0[e]);
            asm volatile("" : "+v"(C0)); }
        ATT_SBAR();
    }
#undef ATT_KRD
#undef ATT_SH
#undef ATT_SD
}
template <bool QK, bool FIN, bool EARLY>
__device__ __forceinline__ void phase_b(f32x16& C0, f32x16& C1, f32x16* o, lds_cptr vp_, u32x4* pw, float& l_reg) {
    s16x4 vlo[8], vhi[8]; float sacc = 0.f, sacd = 0.f;
#define ATT_VRD(i) do { const int vi_ = ((i) >> 1) + 4 * ((i) & 1); vlo[i] = vtr(vp_ + ((vi_ >> 2) * 4096 + (vi_ & 3) * 1024)); vhi[i] = vtr(vp_ + ((vi_ >> 2) * 4096 + (vi_ & 3) * 1024 + 512)); } while (0)
    if (FIN) { ATT_VRD(0); ATT_VRD(1); }
#pragma unroll
    for (int i = 0; i < 8; ++i) {
        if (FIN && i + 2 < 8) ATT_VRD(i + 2);
        ATT_SBAR();
        if (FIN) { const bf16x8 vf = (bf16x8){vlo[i][0], vlo[i][1], vlo[i][2], vlo[i][3], vhi[i][0], vhi[i][1], vhi[i][2], vhi[i][3]};
            o[i & 1] = __builtin_amdgcn_mfma_f32_32x32x16_bf16(__builtin_bit_cast(bf16x8, pw[i >> 1]), vf, o[i & 1], 0, 0, 0); }
        if (QK) { f32x16& X = (i < 4) ? C0 : C1; const int b = 4 * (i & 3);
            if (EARLY) { C1[2 * i] = __builtin_amdgcn_exp2f(C1[2 * i]); C1[2 * i + 1] = __builtin_amdgcn_exp2f(C1[2 * i + 1]); asm volatile("" : "+v"(C1)); }
            else { X[b] = __builtin_amdgcn_exp2f(X[b]); X[b + 1] = __builtin_amdgcn_exp2f(X[b + 1]); X[b + 2] = __builtin_amdgcn_exp2f(X[b + 2]); X[b + 3] = __builtin_amdgcn_exp2f(X[b + 3]); }
            sacc += X[b]; sacd += X[b + 1]; sacc += X[b + 2]; sacd += X[b + 3]; asm volatile("" : "+v"(sacc), "+v"(sacd));
            if (i & 1) { const int k = i >> 1, c = 8 * (k & 1);
                pw[k] = (u32x4){cvtpk_s(X[c], X[c + 1]), cvtpk_s(X[c + 2], X[c + 3]), cvtpk_s(X[c + 4], X[c + 5]), cvtpk_s(X[c + 6], X[c + 7])}; asm volatile("" : "+v"(pw[k])); } }
        ATT_SBAR();
    }
#undef ATT_VRD
    if (QK) l_reg += sacc + sacd;
}
template <bool MLA, bool FIX> __device__ __forceinline__ void attn_unit(int qb, const Src& s, LAS3 unsigned char* shm, const float* bias_h, float kmax2, const float* qmax_h) {
    constexpr int NDK = MLA ? 6 : 5, NX = MLA ? 4 : 1, NQR = MLA ? 4 : 5;
    constexpr float THRL = MLA ? 8.0f : 16.0f;
    const int tid = threadIdx.x, lane = tid & 63, r32 = lane & 31, hi = lane >> 5; const int wid = __builtin_amdgcn_readfirstlane(tid >> 6);
    const int q0 = qb * QB;
    const unsigned lds0 = (unsigned)(uintptr_t)shm;
    LAS3 float* wsf = (LAS3 float*)(shm + LDS_WS) + wid * 64;
    const int NT = (q0 + QB) / KVBLK;
    const int wvis = NT - 4 + (wid >> 1);
    const bool xw = wid < NX;
    const int krow = 8 * wid + (lane >> 3);
    const u16* ksrc = s.k + (size_t)krow * s.kp + (((lane & 7) ^ ((krow >> 1) & 7)) * 8);
    const int k2row = 16 * (wid & 3) + (lane >> 2);
    const u16* k2src = MLA ? s.k2 + (size_t)k2row * s.k2p + (((lane & 3) ^ ((k2row >> 2) & 3)) * 8) : s.k2 + (size_t)lane * s.k2p;
    const u16* vsrc = s.v + (size_t)(16 * (wid & 3) + (lane >> 2)) * s.vp + (wid >> 2) * 32 + (lane & 3) * 8;
    const unsigned kdst = lds0 + LDS_K + wid * 1024, k2dst = lds0 + LDS_K + (8 + (wid & 3)) * 1024, vdst = lds0 + LDS_V + wid * 1024;
#define ATT_DMA_K(t) do { const int sl_ = (t) & 3; glds16(ksrc + (size_t)(t) * KVBLK * s.kp, (unsigned)__builtin_amdgcn_readfirstlane(kdst + sl_ * KSLOT)); \
        if (xw) glds16(k2src + (size_t)(t) * KVBLK * s.k2p, (unsigned)__builtin_amdgcn_readfirstlane(k2dst + sl_ * KSLOT)); } while (0)
#define ATT_DMA_V(t, vsl) glds16(vsrc + (size_t)(t) * KVBLK * s.vp, (unsigned)__builtin_amdgcn_readfirstlane(vdst + (vsl)))
    if (!MLA) {
        if (tid < 256) { const int sl = tid >> 6; *(LAS3 f32x4*)(shm + LDS_K + sl * KSLOT + 9 * 1024 + (tid & 63) * 16) = (f32x4){0.f, 0.f, 0.f, 0.f}; } }
    if (MLA) { ATT_DMA_K(0); ATT_DMA_V(0, 0); ATT_DMA_K(1); ATT_DMA_K(2); }
    const u16* Qw = s.q + (size_t)(q0 + wid * QBLK + r32) * s.qp + hi * 8;
    bf16x8 qr[NQR];
#pragma unroll
    for (int d0 = 0; d0 < 4; ++d0) qr[d0] = *reinterpret_cast<const bf16x8*>(Qw + d0 * 16);
    const lds_cptr qx0 = (lds_cptr)shm + LDS_QX + wid * 2048 + lane * 16;
    float mla_ref = 0.f;
    if (MLA) { const bf16x8 q4 = *reinterpret_cast<const bf16x8*>(Qw + 64), q5 = *reinterpret_cast<const bf16x8*>(Qw + 80);
        *(LAS3 bf16x8*)(shm + LDS_QX + wid * 2048 + lane * 16) = q4; *(LAS3 bf16x8*)(shm + LDS_QX + wid * 2048 + 1024 + lane * 16) = q5;
        if (FIX) { float nq = 0.f;
#pragma unroll
            for (int e = 0; e < 8; ++e) { const float a = __uint_as_float((unsigned)(unsigned short)q4[e] << 16), b = __uint_as_float((unsigned)(unsigned short)q5[e] << 16); nq += a * a + b * b; }
#pragma unroll
            for (int d0 = 0; d0 < 4; ++d0)
#pragma unroll
                for (int e = 0; e < 8; ++e) { const float a = __uint_as_float((unsigned)(unsigned short)qr[d0][e] << 16); nq += a * a; }
            nq += __shfl_xor(nq, 32); mla_ref = sqrtf(nq * kmax2); } }
    const short one = hi ? (short)0 : (short)0x3F80;
    if (!MLA) qr[NQR - 1] = (bf16x8){one, one, one, 0, 0, 0, 0, 0};
    int t0 = 0;
    if (!MLA) {
        const float qm = qmax_h[qb];
        const float bunit = sqrtf(qm * kmax2);
        const float thr = FIX ? bias_h[q0] - 152.f : bias_h[q0] - 170.f - 2.f * bunit;
        if (FIX) { const float nm_ = -(bias_h[q0 + wid * QBLK + r32] + bunit); const unsigned h_ = cvtpk_s(nm_, 0.f) & 0xffffu; const float r1_ = nm_ - __uint_as_float(h_ << 16); const unsigned m_ = cvtpk_s(r1_, 0.f) & 0xffffu;
            const float r2_ = r1_ - __uint_as_float(m_ << 16); const unsigned l_ = cvtpk_s(r2_, 0.f) & 0xffffu;
            if (hi == 0) qr[NQR - 1] = (bf16x8){one, one, one, (short)h_, (short)m_, (short)l_, 0, 0}; }
        int best = 0;
        for (int tt = 1 + lane; tt <= NT - 4; tt += 64) { if (bias_h[64 * tt - 1] < thr) best = tt; }
#pragma unroll
        for (int o_ = 32; o_ >= 1; o_ >>= 1) best = max(best, __shfl_xor(best, o_));
        t0 = __builtin_amdgcn_readfirstlane(best);
    }
    if (!MLA) { ATT_DMA_K(t0); ATT_DMA_V(t0, (t0 & 3) * VSLOT); ATT_DMA_K(t0 + 1); ATT_DMA_K(t0 + 2); }
    float mhat = 0.f, l_reg = 0.f; f32x16 o[2]; o[0] = f32x16{}; o[1] = f32x16{}; f32x16 negm = f32x16{};
    if (MLA && FIX) {
#pragma unroll
        for (int r = 0; r < 16; ++r) negm[r] = -mla_ref; }
    const int qrel = wid * QBLK + r32;
    lds_cptr kb[NDK];
#pragma unroll
    for (int d0 = 0; d0 < 4; ++d0) kb[d0] = (lds_cptr)shm + LDS_K + r32 * 128 + ((((2 * d0 + hi) ^ ((r32 >> 1) & 7))) << 4);
    if (MLA) {
#pragma unroll
        for (int d0 = 4; d0 < NDK; ++d0) kb[d0] = (lds_cptr)shm + LDS_K + 8192 + r32 * 64 + ((((2 * (d0 - 4) + hi) ^ ((r32 >> 2) & 3))) << 4);
    } else kb[NDK - 1] = (lds_cptr)shm + LDS_K + 8192 + hi * 1024 + r32 * 16;
    constexpr int XHS = MLA ? 2048 : 512;
    const lds_cptr vp0 = (lds_cptr)shm + LDS_V + ((lane >> 4) & 1) * 32 + (lane & 3) * 8 + (4 * hi + ((lane & 15) >> 2)) * 64;
    f32x16 C0, C1; u32x4 pw[4]; bool resc = false;
#define ATT_TOP(t) do { if ((t) == t0 || (t) + 2 >= NT) { ATT_WAIT_BAR(0); } else if (xw) { ATT_WAIT_BAR(3); } else { ATT_WAIT_BAR(2); } \
        } while (0)
#define ATT_ISSUE(t) do { if ((t) + 3 < NT) ATT_DMA_K((t) + 3); if ((t) + 1 < NT) ATT_DMA_V((t) + 1, (((t) + 1) & 3) * VSLOT); } while (0)
#ifdef ATT_QKPRIO
#define ATT_PRIO_ON() __builtin_amdgcn_s_setprio(1)
#define ATT_PRIO_OFF() __builtin_amdgcn_s_setprio(0)
#else
#define ATT_PRIO_ON()
#define ATT_PRIO_OFF()
#endif
#define ATT_QK(t, E) do { bf16x8 kf_[2 * NDK]; bf16x8 qx_[NDK > NQR ? NDK - NQR : 1]; \
        phase_a<NDK, NQR, !MLA, XHS, 0, 4, E>(C0, C1, ATT_KS(t), qr, qx0, negm, kf_, qx_); ATT_ISSUE(t); ATT_SBAR(); \
        phase_a<NDK, NQR, !MLA, XHS, 4, 2 * NDK, E>(C0, C1, ATT_KS(t), qr, qx0, negm, kf_, qx_); } while (0)
#define ATT_MASK(C0, C1, t) do { const int kbq_ = 64 * ((t) - (NT - 4)) + 4 * hi; \
        _Pragma("unroll") for (int r = 0; r < 16; ++r) { const int kv_ = kbq_ + (r & 3) + 8 * (r >> 2); if (kv_ > qrel) C0[r] = -INFINITY; if (kv_ + 32 > qrel) C1[r] = -INFINITY; } } while (0)
#define ATT_DECIDE(C0, C1, FIRST) do { if (!FIX) { \
        float a_ = fmaxf(fmaxf(C0[0], C0[1]), C1[0]), b_ = fmaxf(fmaxf(C0[2], C0[3]), C1[1]); a_ = fmaxf(fmaxf(a_, C1[2]), C1[3]); \
        _Pragma("unroll") for (int r = 4; r < 16; r += 4) { a_ = fmaxf(fmaxf(a_, C0[r]), C0[r + 1]); b_ = fmaxf(fmaxf(b_, C0[r + 2]), C0[r + 3]); a_ = fmaxf(fmaxf(a_, C1[r]), C1[r + 1]); b_ = fmaxf(fmaxf(b_, C1[r + 2]), C1[r + 3]); } \
        float rm_ = fmaxf(a_, b_); { auto rr_ = __builtin_amdgcn_permlane32_swap(__float_as_uint(rm_), __float_as_uint(rm_), false, false); rm_ = fmaxf(__uint_as_float(rr_[0]), __uint_as_float(rr_[1])); } \
        resc = false; \
        if ((FIRST) || __any(rm_ > THRL)) { float dl_ = (FIRST) ? rm_ : fmaxf(rm_, 0.f); \
            if (!MLA) { const float nm_ = -(mhat + dl_); const unsigned h_ = cvtpk_s(nm_, 0.f) & 0xffffu; const float r1_ = nm_ - __uint_as_float(h_ << 16); const unsigned m_ = cvtpk_s(r1_, 0.f) & 0xffffu; \
                const float r2_ = r1_ - __uint_as_float(m_ << 16); const unsigned l_ = cvtpk_s(r2_, 0.f) & 0xffffu; \
                const float mn_ = -((__uint_as_float(h_ << 16) + __uint_as_float(m_ << 16)) + __uint_as_float(l_ << 16)); dl_ = mn_ - mhat; mhat = mn_; \
                if (hi == 0) qr[NQR - 1] = (bf16x8){one, one, one, (short)h_, (short)m_, (short)l_, 0, 0}; } \
            else { mhat += dl_; _Pragma("unroll") for (int r = 0; r < 16; ++r) negm[r] = -mhat; } \
            _Pragma("unroll") for (int r = 0; r < 16; ++r) { C0[r] -= dl_; C1[r] -= dl_; } \
            if (!(FIRST)) { const float f_ = __builtin_amdgcn_exp2f(-dl_); l_reg *= f_; if (hi == 0) wsf[r32] = f_; resc = true; } } } } while (0)
#define ATT_RESC() do { if (!FIX && resc) { \
        _Pragma("unroll") for (int i = 0; i < 4; ++i) { const f32x4 fv_ = *(const LAS3 f32x4*)(wsf + 8 * i + 4 * hi); \
            _Pragma("unroll") for (int d = 0; d < 2; ++d) { o[d][4 * i] *= fv_[0]; o[d][4 * i + 1] *= fv_[1]; o[d][4 * i + 2] *= fv_[2]; o[d][4 * i + 3] *= fv_[3]; } } } } while (0)
#define ATT_VS(tt) (vp0 + (((tt)) & 3) * VSLOT)
#define ATT_KS(tt) kb, ((((tt)) & 3) * KSLOT)
#ifndef ATT_STAGGER
#define ATT_STAGGER 0
#endif
    if (!ATT_STAGGER || wid < 4) {
#define ATT_STEP(t, MASKED) do { ATT_TOP(t); \
        constexpr bool E_ = FIX && (MLA || !(MASKED)); \
        ATT_QK(t, E_); \
        if (!MLA && (MASKED)) ATT_MASK(C0, C1, t); \
        ATT_DECIDE(C0, C1, false); ATT_SBAR(); \
        phase_b<true, true, E_>(C0, C1, o, ATT_VS((t) - 1), pw, l_reg); \
        ATT_RESC(); } while (0)
        ATT_TOP(t0);
        ATT_QK(t0, false);
        if (!MLA && wvis == t0) ATT_MASK(C0, C1, t0);
        ATT_DECIDE(C0, C1, true); ATT_SBAR();
        phase_b<true, false, false>(C0, C1, o, vp0, pw, l_reg);
        int t = t0 + 1;
        for (; t < wvis; ++t) ATT_STEP(t, false);
        if (t == wvis) { ATT_STEP(t, true); ++t; }
        { ATT_TOP(t); ATT_ISSUE(t); phase_b<false, true, false>(C0, C1, o, ATT_VS(t - 1), pw, l_reg); ++t; }
        for (; t <= NT + ATT_STAGGER; ++t) { ATT_TOP(t); ATT_ISSUE(t); }
#undef ATT_STEP
    } else {
        ATT_TOP(t0);
        ATT_QK(t0, false);
        ATT_DECIDE(C0, C1, true); ATT_SBAR();
        ATT_TOP(t0 + 1);
        phase_b<true, false, false>(C0, C1, o, vp0, pw, l_reg); ATT_SBAR();
        ATT_QK(t0 + 1, false);
        ATT_DECIDE(C0, C1, false); ATT_SBAR();
        int t = t0 + 2;
#define ATT_STEP2(t, MASKED) do { ATT_TOP(t); \
        phase_b<true, true, false>(C0, C1, o, ATT_VS((t) - 2), pw, l_reg); \
        ATT_RESC(); ATT_SBAR(); \
        ATT_QK(t, false); \
        if (!MLA && (MASKED)) ATT_MASK(C0, C1, t); \
        ATT_DECIDE(C0, C1, false); ATT_SBAR(); } while (0)
        for (; t < wvis; ++t) ATT_STEP2(t, false);
        ATT_STEP2(t, true); ++t;
        { ATT_TOP(t); ATT_ISSUE(t); phase_b<true, true, false>(C0, C1, o, ATT_VS(t - 2), pw, l_reg); ATT_RESC(); ++t; }
        { ATT_TOP(t); ATT_ISSUE(t); phase_b<false, true, false>(C0, C1, o, ATT_VS(t - 2), pw, l_reg); ++t; }
        for (; t <= NT + ATT_STAGGER; ++t) { ATT_TOP(t); ATT_ISSUE(t); }
#undef ATT_STEP2
    }
    { auto rr = __builtin_amdgcn_permlane32_swap(__float_as_uint(l_reg), __float_as_uint(l_reg), false, false); l_reg = __uint_as_float(rr[0]) + __uint_as_float(rr[1]); }
    if (hi == 0) wsf[32 + r32] = 1.0f / l_reg;
    float rli[16];
#pragma unroll
    for (int i = 0; i < 4; ++i) { const f32x4 fv = *(const LAS3 f32x4*)(wsf + 32 + 8 * i + 4 * hi); rli[4 * i] = fv[0]; rli[4 * i + 1] = fv[1]; rli[4 * i + 2] = fv[2]; rli[4 * i + 3] = fv[3]; }
    u16* Ow = s.o + (size_t)(q0 + wid * QBLK) * s.op;
    { LAS3 u16* stg = (LAS3 u16*)(shm + LDS_OST) + wid * 2048;
#pragma unroll
        for (int r = 0; r < 16; ++r) { const int orow = crow(r, hi);
#pragma unroll
            for (int d0 = 0; d0 < 2; ++d0) stg[orow * 64 + d0 * 32 + r32] = (u16)(cvtpk_s(o[d0][r] * rli[r], 0.f) & 0xffffu); }
        asm volatile("s_waitcnt lgkmcnt(0)" ::: "memory");
#pragma unroll
        for (int i = 0; i < 4; ++i) { const int row = i * 8 + (lane >> 3), ch = lane & 7; const u32x4 v = *(const LAS3 u32x4*)(stg + row * 64 + ch * 8); *(u32x4*)(Ow + (size_t)row * s.op + ch * 8) = v; } }
    asm volatile("s_waitcnt lgkmcnt(0)\n\ts_barrier" ::: "memory");
#undef ATT_DMA_K
#undef ATT_DMA_V
#undef ATT_TOP
#undef ATT_ISSUE
#undef ATT_QK
#undef ATT_MASK
#undef ATT_DECIDE
#undef ATT_RESC
#undef ATT_STEP
}
}

namespace cg = cooperative_groups;
#define LAS __attribute__((address_space(3)))
typedef unsigned short bf16;
typedef unsigned v4u __attribute__((ext_vector_type(4)));
typedef unsigned v2u __attribute__((ext_vector_type(2)));
typedef float f32x4 __attribute__((ext_vector_type(4)));
constexpr int NWAVES = 8;
constexpr int M = 16384, D = 1024, FF = 4096, NIN = 1960, NINP = 2048, QL = 256, KVL = 128, NQU = 768, NKVU = 1024;
constexpr float EPS = 1e-6f;
constexpr float LOG2E = 1.4426950408889634f;
constexpr float C2_FOX = 0.125f * LOG2E, C2_MLA = 0.10206207261596575f * LOG2E;
constexpr size_t MiB = 1u << 20;
constexpr size_t WS_WIN = 1 * MiB, WS_WQ = 5 * MiB, WS_WKV = 5 * MiB + 512 * 1024, WS_WO = 6 * MiB, WS_W1 = 8 * MiB, WS_W2 = 16 * MiB;
constexpr size_t WS_RT = 24 * MiB, WS_LF = 26 * MiB, WS_LC = 26 * MiB + 512 * 1024, WS_SS = 27 * MiB, WS_KR = 28 * MiB, WS_KB = 29 * MiB, WS_SSQ = 31 * MiB, WS_SSKV = 31 * MiB + 512 * 1024, WS_BIASF = 28 * MiB;
constexpr size_t WS_XN = 32 * MiB, WS_H = 64 * MiB, WS_P = 64 * MiB, WS_QM = 128 * MiB, WS_KVM = 152 * MiB, WS_QN = 184 * MiB, WS_O = 192 * MiB, WS_KVN = 224 * MiB, WS_END = 228 * MiB;
constexpr int RING_BYTES = 131072, LDS_BYTES = 147456;
static_assert(att::LDS_BYTES <= LDS_BYTES, "attention scratch fits the LDS allocation");

__device__ __forceinline__ unsigned f2bf(float f) { unsigned u = __builtin_bit_cast(unsigned, f); return (u + 0x7fffu + ((u >> 16) & 1u)) >> 16; }
__device__ __forceinline__ unsigned pk2(float lo, float hi) { return f2bf(lo) | (f2bf(hi) << 16); }
__device__ __forceinline__ float bf2f(unsigned short h) { return __builtin_bit_cast(float, (unsigned)h << 16); }
__device__ __forceinline__ float wave_sum(float v) {
#pragma unroll
    for (int o = 1; o < 64; o <<= 1) v += __shfl_xor(v, o);
    return v;
}
__device__ __forceinline__ int map_row(int mode, int n) {
    if (mode == 1) { const int h = n / 96, d = n % 96; if (d < 64) return n; const int i = d - 64; return h * 96 + (i < 16 ? 64 + 2 * i : 64 + 2 * (i - 16) + 1); }
    if (mode == 2) { const int h = n >> 7, j = n & 127; return j < 64 ? h * 64 + j : 512 + h * 64 + (j - 64); }
    if (mode == 3) { if (n < 1536 || n >= 1960) return n; if (n < 1544) return 1952 + (n - 1536); if (n < 1800) return 1536 + (n - 1544); if (n < 1928) return 1792 + (n - 1800);
        const int i = n - 1928; return 1920 + (i < 16 ? 2 * i : 2 * (i - 16) + 1); }
    return n;
}
__device__ __forceinline__ void p0_transpose_item(const float* W, int K, int N, int nblk, bf16* WT, int mode, const float* gk, LAS float* scr, int item, int lane) {
    const int kb = item / nblk, nb = item % nblk, k0 = 64 * kb, n0 = 32 * nb;
    const int nn = n0 + (lane & 31);
    float wv[32];
#pragma unroll
    for (int i = 0; i < 32; ++i) { const int kk = 2 * i + (lane >> 5); wv[i] = (nn < N) ? W[(size_t)(k0 + kk) * N + nn] : 0.f; }
    if (gk) {
#pragma unroll
        for (int i = 0; i < 32; ++i) wv[i] *= gk[k0 + 2 * i + (lane >> 5)]; }
#pragma unroll
    for (int i = 0; i < 32; ++i) { const int kk = 2 * i + (lane >> 5); scr[kk * 33 + (lane & 31)] = wv[i]; }
    asm volatile("s_waitcnt lgkmcnt(0)" ::: "memory");
    const int c = lane & 7;
#pragma unroll
    for (int j = 0; j < 4; ++j) { const int n = (lane >> 3) + 8 * j; const LAS float* sp = scr + (8 * c) * 33 + n;
        v4u o; o.x = pk2(sp[0 * 33], sp[1 * 33]); o.y = pk2(sp[2 * 33], sp[3 * 33]); o.z = pk2(sp[4 * 33], sp[5 * 33]); o.w = pk2(sp[6 * 33], sp[7 * 33]);
        *(v4u*)(WT + (size_t)map_row(mode, n0 + n) * K + k0 + 8 * c) = o; }
    asm volatile("s_waitcnt lgkmcnt(0)" ::: "memory");
}
__device__ __forceinline__ void sincos_d(double x, float& sn, float& cs) {
    const double k = rint(x * 0.63661977236758134308);
    double r = fma(-k, 1.57079632679489655800e+00, x); r = fma(-k, 6.12323399573676603587e-17, r);
    const double r2 = r * r;
    double s = -1.0 / 6227020800.0; s = s * r2 + 1.0 / 39916800.0; s = s * r2 - 1.0 / 362880.0; s = s * r2 + 1.0 / 5040.0; s = s * r2 - 1.0 / 120.0; s = s * r2 + 1.0 / 6.0; s = r - r * r2 * s;
    double c = 1.0 / 479001600.0; c = c * r2 - 1.0 / 3628800.0; c = c * r2 + 1.0 / 40320.0; c = c * r2 - 1.0 / 720.0; c = c * r2 + 1.0 / 24.0; c = c * r2 - 0.5; c = 1.0 + r2 * c;
    const int q = ((int)k) & 3;
    const double ss = (q == 0) ? s : (q == 1) ? c : (q == 2) ? -s : -c;
    const double cc = (q == 0) ? c : (q == 1) ? -s : (q == 2) ? -c : s;
    sn = (float)ss; cs = (float)cc;
}

#define RLX_AGENT __ATOMIC_RELAXED, __HIP_MEMORY_SCOPE_AGENT
#define XB_TMO      128
#define XB_XCNT(j)  (256  + 64 * (j))
#define XB_XSUB(j)  (1280 + 64 * (j))
#define XB_XGEN(j)  (2304 + 64 * (j))
#define XB_TOP      3328
#define XB_TOPGEN   3392
#define XCD_BAR_WORDS 3456
#define XB_SPIN_CAP (1u << 18)

__device__ __forceinline__ unsigned xb_ld(unsigned* p)              { return __hip_atomic_load(p, __ATOMIC_RELAXED, __HIP_MEMORY_SCOPE_AGENT); }
__device__ __forceinline__ unsigned xb_add(unsigned* p, unsigned v) { return __hip_atomic_fetch_add(p, v, __ATOMIC_RELAXED, __HIP_MEMORY_SCOPE_AGENT); }
__device__ __forceinline__ unsigned xb_xcc_id() { return (unsigned)__builtin_amdgcn_s_getreg((3 << 11) | 20) & 0xFu; }
#define XB_SPIN(cond, bar) do { unsigned _sp = 0; while (cond) { __builtin_amdgcn_s_sleep(1); \
    if ((++_sp & 255u) == 0u) { if (xb_ld(&(bar)[XB_TMO])) break; if (_sp > XB_SPIN_CAP) { atomicAdd(&(bar)[XB_TMO], 1u); break; } } } } while (0)

struct XcdBarrier {
    unsigned* bar; unsigned x;
    volatile LAS unsigned* st;
};

__device__ __forceinline__ XcdBarrier xcd_barrier_post(unsigned* bar, volatile LAS unsigned* st) {
    XcdBarrier b; b.bar = bar; b.x = xb_xcc_id(); b.st = st;
    if (threadIdx.x == 0) (void)xb_add(&bar[XB_XCNT(b.x)], 1u);
    return b;
}
__device__ __forceinline__ void xcd_barrier_complete(unsigned* bar, unsigned x, unsigned& nloc, unsigned& nx) {
    const unsigned G = gridDim.x * gridDim.y * gridDim.z;
    unsigned sum, cnt, mine, sp = 0u;
    for (;;) {
        sum = 0u; cnt = 0u; mine = 0u;
#pragma unroll
        for (unsigned j = 0; j < 16; ++j) { const unsigned c = xb_ld(&bar[XB_XCNT(j)]); sum += c; cnt += (c > 0u) ? 1u : 0u; mine = (j == x) ? c : mine; }
        if (sum == G) break;
        __builtin_amdgcn_s_sleep(1);
        if ((++sp & 255u) == 0u) { if (xb_ld(&bar[XB_TMO])) break; if (sp > XB_SPIN_CAP) { atomicAdd(&bar[XB_TMO], 1u); break; } }
    }
    nloc = mine > 0u ? mine : 1u; nx = cnt > 0u ? cnt : 1u;
}

__device__ __forceinline__ void xcd_barrier(const XcdBarrier& b) {
    asm volatile("s_waitcnt vmcnt(0)" ::: "memory");
    __syncthreads();
    if (threadIdx.x == 0) {
        unsigned* bar = b.bar;
        __builtin_amdgcn_s_waitcnt(0);
        unsigned nloc = b.st[0], nx = b.st[1];
        if (nloc == 0u) { xcd_barrier_complete(bar, b.x, nloc, nx); b.st[0] = nloc; b.st[1] = nx; }
        const unsigned old = xb_add(&bar[XB_XSUB(b.x)], 1u);
        const unsigned gen = old / nloc;
        if (old + 1u == (gen + 1u) * nloc) {
            __builtin_amdgcn_fence(__ATOMIC_RELEASE, "agent");
            asm volatile("s_waitcnt vmcnt(0)" ::: "memory");
            const unsigned og = xb_add(&bar[XB_TOP], 1u);
            const unsigned tg = og / nx;
            if (og + 1u == (tg + 1u) * nx) xb_add(&bar[XB_TOPGEN], 1u);
            else XB_SPIN(xb_ld(&bar[XB_TOPGEN]) == tg, bar);
            __builtin_amdgcn_fence(__ATOMIC_ACQUIRE, "agent");
            xb_add(&bar[XB_XGEN(b.x)], 1u);
            asm volatile("s_waitcnt vmcnt(0)" ::: "memory");
        } else {
            XB_SPIN(xb_ld(&bar[XB_XGEN(b.x)]) == gen, bar);
            __builtin_amdgcn_fence(__ATOMIC_ACQUIRE, "agent");
            asm volatile("s_waitcnt vmcnt(0)" ::: "memory");
        }
    }
    __syncthreads();
}

constexpr int MISC_OFF = LDS_BYTES - 128;
constexpr size_t WS_CTL = 0, CTL_ZERO_BYTES = 64 * 1024;
constexpr int CW_KMAX = 8192, CW_QF = 8192 + 512, CW_QM = 8192 + 1024, CW_PCNT = 8192 + 1536, CW_KMAXM = 13824, CW_QMAXM = 14400, CW_DONE = 14464;
static_assert(att::LDS_BYTES <= MISC_OFF, "LDS map");
struct Args { const float* in[13]; float* out; unsigned char* ws; int ph_lo, ph_hi, dup, pad; };
constexpr int NPHASE = 8;

__global__ void __launch_bounds__(NWAVES * 64, 2) mk_fwd(Args args) {
    extern __shared__ __attribute__((aligned(16))) unsigned char lds_raw[];
    LAS unsigned char* lds = (LAS unsigned char*)lds_raw;
    const int G = gridDim.x, bx = blockIdx.x;
#define MK_IDS int tid = threadIdx.x; asm volatile("" : "+v"(tid)); const int lane = tid & 63, wave = __builtin_amdgcn_readfirstlane(tid >> 6); const int gw = vcu * NWAVES + wave; (void)gw; (void)lane;
    const int vcu = (G % 8 == 0) ? (bx % 8) * (G / 8) + bx / 8 : bx;
    const int NGW = G * NWAVES;
    unsigned char* ws = args.ws;
#define MKP_x ((const float*)args.in[0])
#define MKP_g_mix ((const float*)args.in[1])
#define MKP_w_in ((const float*)args.in[2])
#define MKP_b_f ((const float*)args.in[3])
#define MKP_g_q ((const float*)args.in[4])
#define MKP_w_q_up ((const float*)args.in[5])
#define MKP_g_kv ((const float*)args.in[6])
#define MKP_w_kv_up ((const float*)args.in[7])
#define MKP_w_o ((const float*)args.in[8])
#define MKP_g_mlp ((const float*)args.in[9])
#define MKP_w_ff1 ((const float*)args.in[10])
#define MKP_w_ff2 ((const float*)args.in[11])
#define MKP_g_final ((const float*)args.in[12])
#define MKP_out (args.out)
#define MKP_Win_t ((bf16*)(args.ws + WS_WIN))
#define MKP_Wq_t ((bf16*)(args.ws + WS_WQ))
#define MKP_Wkv_t ((bf16*)(args.ws + WS_WKV))
#define MKP_Wo_t ((bf16*)(args.ws + WS_WO))
#define MKP_W1_t ((bf16*)(args.ws + WS_W1))
#define MKP_W2_t ((bf16*)(args.ws + WS_W2))
#define MKP_RT ((float*)(args.ws + WS_RT))
#define MKP_LF ((float*)(args.ws + WS_LF))
#define MKP_SS ((float*)(args.ws + WS_SS))
#define MKP_SSQ ((float*)(args.ws + WS_SSQ))
#define MKP_BIASF ((float*)(args.ws + WS_BIASF))
#define MKP_QMAX ((float*)(args.ws + WS_LC))
#define MKP_SSKV ((float*)(args.ws + WS_SSKV))
#define MKP_KB ((bf16*)(args.ws + WS_KB))
#define MKP_KR ((bf16*)(args.ws + WS_KR))
#define MKP_XN ((bf16*)(args.ws + WS_XN))
#define MKP_HB ((bf16*)(args.ws + WS_H))
#define MKP_P ((bf16*)(args.ws + WS_P))
#define MKP_QM ((bf16*)(args.ws + WS_QM))
#define MKP_KVM ((bf16*)(args.ws + WS_KVM))
#define MKP_QN ((bf16*)(args.ws + WS_QN))
#define MKP_OB ((bf16*)(args.ws + WS_O))
#define MKP_KVN ((bf16*)(args.ws + WS_KVN))
    const int lo = args.ph_lo, hi = args.ph_hi;
#ifndef MK_MASK
#define MK_MASK 0x1ff
#endif
#define IN(k) (((MK_MASK >> (k)) & 1) && lo <= (k) && (k) < hi)
#define REP(k) for (int rep_ = 0; rep_ < ((args.dup == (k)) ? 2 : 1); ++rep_)
    { volatile LAS unsigned* misc = (volatile LAS unsigned*)(lds + MISC_OFF); if (threadIdx.x < 32) misc[threadIdx.x] = 0u; }
    __syncthreads();
    (void)xcd_barrier_post((unsigned*)(ws + WS_CTL), (volatile LAS unsigned*)(lds + MISC_OFF) + 8);
    if (args.ph_lo < 0) cg::this_grid().sync();
#ifdef TS_PHASE
    unsigned long long ts_a_ = 0, ts_b_ = 0;
#define TS_BEGIN(k) do { if ((k) == TS_PHASE || (TS_PHASE == 99 && (k) == 0)) ts_a_ = __builtin_amdgcn_s_memrealtime(); } while (0)
#define TS_END(k) do { if ((k) == TS_PHASE || (TS_PHASE == 99 && (k) == 7)) ts_b_ = __builtin_amdgcn_s_memrealtime(); } while (0)
#else
#define TS_BEGIN(k)
#define TS_END(k)
#endif
#define SEAM(k) do { if (IN(k) && IN((k) + 1)) { XcdBarrier b_; b_.bar = (unsigned*)(args.ws + WS_CTL); b_.x = xb_xcc_id(); b_.st = (volatile LAS unsigned*)(lds + MISC_OFF) + 8; xcd_barrier(b_); } } while (0)

    TS_BEGIN(0);
    if (IN(0)) { MK_IDS
        LAS float* scr = (LAS float*)(lds + wave * 16384);
        constexpr int I_IN = (D / 64) * (NINP / 32), I_Q = (QL / 64) * (NQU / 32), I_KV = (KVL / 64) * (NKVU / 32), I_O = (D / 64) * (D / 32), I_1 = (D / 64) * (FF / 32), I_2 = (FF / 64) * (D / 32);
        constexpr int NITEMS = I_IN + I_Q + I_KV;
        (void)I_O; (void)I_1; (void)I_2;
        for (int it = gw; it < NITEMS; it += NGW) {
            int r = it;
            if (r < I_IN) { p0_transpose_item(MKP_w_in, D, NIN, NINP / 32, MKP_Win_t, 3, nullptr, scr, r, lane); continue; } r -= I_IN;
            if (r < I_Q) { p0_transpose_item(MKP_w_q_up, QL, NQU, NQU / 32, MKP_Wq_t, 1, MKP_g_q, scr, r, lane); continue; } r -= I_Q;
            p0_transpose_item(MKP_w_kv_up, KVL, NKVU, NKVU / 32, MKP_Wkv_t, 2, MKP_g_kv, scr, r, lane);
        }
        for (int m0 = gw; m0 < M; m0 += 4 * NGW) {
            const f32x4* gr = (const f32x4*)MKP_g_mix + lane; f32x4 v[4][4]; float s2[4];
#pragma unroll
            for (int r = 0; r < 4; ++r) { const int m = m0 + r * NGW; const f32x4* xr = (const f32x4*)(MKP_x + (size_t)(m < M ? m : 0) * D) + lane;
#pragma unroll
                for (int j = 0; j < 4; ++j) v[r][j] = xr[64 * j]; }
#pragma unroll
            for (int r = 0; r < 4; ++r) { s2[r] = 0.f;
#pragma unroll
                for (int j = 0; j < 4; ++j) s2[r] += (v[r][j].x * v[r][j].x + v[r][j].y * v[r][j].y) + (v[r][j].z * v[r][j].z + v[r][j].w * v[r][j].w);
                s2[r] = 1.f / sqrtf(wave_sum(s2[r]) * (1.f / D) + EPS); }
#pragma unroll
            for (int r = 0; r < 4; ++r) { const int m = m0 + r * NGW; if (m < M) { unsigned long long* o8 = (unsigned long long*)(MKP_XN + (size_t)m * D) + lane; const float rstd = s2[r];
#pragma unroll
                for (int j = 0; j < 4; ++j) { const f32x4 g = gr[64 * j]; o8[64 * j] = (unsigned long long)pk2(v[r][j].x * rstd * g.x, v[r][j].y * rstd * g.y) | ((unsigned long long)pk2(v[r][j].z * rstd * g.z, v[r][j].w * rstd * g.w) << 32); } } }
        }
        for (int e = (vcu * NWAVES * 64 + tid); e < M * 16; e += G * NWAVES * 64) {
            const int m = e >> 4, i = e & 15; double inv = 1.0; for (int j = 0; j < i; ++j) inv *= 0.56234132519034908039;
            float sn, cs; sincos_d((double)m * inv, sn, cs); MKP_RT[2 * e] = cs; MKP_RT[2 * e + 1] = sn;
        }
    }
    SEAM(0);
    TS_END(0);
    TS_BEGIN(1);
    if (IN(1)) {
        pg8::Gemm g{MKP_XN, MKP_Win_t, M, NINP, D}; pg8::StaticOrder S; S.init(M, NINP, G, bx);
        pg8::EpiIn E{MKP_P, NINP, C2_FOX, MKP_SSQ, MKP_SSKV, MKP_RT, MKP_b_f, MKP_LF, M};
        pg8::gemm_phase<pg8::EpiIn, pg8::StaticOrder, PG8_ALIGN, PG8_SP2>(lds, g, S, E);
    }
    SEAM(1);
    TS_END(1);
    TS_BEGIN(3);
    if (IN(3)) { MK_IDS
        if (wave >= 2) {
            LAS float* scr = (LAS float*)(lds + wave * 16384);
            constexpr int J_O = (D / 64) * (D / 32), J_1 = (D / 64) * (FF / 32), J_2 = (FF / 64) * (D / 32);
            for (int it = vcu * 6 + (wave - 2); it < J_O + J_1 + J_2; it += G * 6) {
                int r = it;
                if (r < J_O) { p0_transpose_item(MKP_w_o, D, D, D / 32, MKP_Wo_t, 0, nullptr, scr, r, lane); continue; } r -= J_O;
                if (r < J_1) { p0_transpose_item(MKP_w_ff1, D, FF, FF / 32, MKP_W1_t, 0, MKP_g_mlp, scr, r, lane); continue; } r -= J_1;
                p0_transpose_item(MKP_w_ff2, FF, D, D / 32, MKP_W2_t, 0, nullptr, scr, r, lane);
            }
        }
        if (wave < 2) { const int job = bx + 256 * wave;
            if (job < 512 && bx < 256) { const int h = job >> 6, ti = job & 63; const f32x4* lf4 = (const f32x4*)(MKP_LF + (size_t)h * M);
                float pre = 0.f; { int j = 0; float pa[8] = {0.f, 0.f, 0.f, 0.f, 0.f, 0.f, 0.f, 0.f};
                    for (; j + 8 <= ti; j += 8) { f32x4 w[8];
#pragma unroll
                        for (int u = 0; u < 8; ++u) w[u] = lf4[(j + u) * 64 + lane];
#pragma unroll
                        for (int u = 0; u < 8; ++u) pa[u] += (w[u].x + w[u].y) + (w[u].z + w[u].w); }
                    for (; j < ti; ++j) { const f32x4 w = lf4[j * 64 + lane]; pa[0] += (w.x + w.y) + (w.z + w.w); }
                    pre = ((pa[0] + pa[1]) + (pa[2] + pa[3])) + ((pa[4] + pa[5]) + (pa[6] + pa[7])); }
                pre = wave_sum(pre);
                const f32x4 v = lf4[ti * 64 + lane];
                const float s1 = v.x, s2 = s1 + v.y, s3 = s2 + v.z, s4 = s3 + v.w; float inc = s4;
#pragma unroll
                for (int o = 1; o < 64; o <<= 1) { const float n = __shfl_up(inc, o); if (lane >= o) inc += n; }
                const float ex = pre + (inc - s4); const float cs[4] = {ex + s1, ex + s2, ex + s3, ex + s4};
                *(f32x4*)(MKP_BIASF + (size_t)h * M + ti * 256 + 4 * lane) = (f32x4){-cs[0] * LOG2E, -cs[1] * LOG2E, -cs[2] * LOG2E, -cs[3] * LOG2E};
                { float km = 0.f;
                  float qmx = 0.f;
                  for (int e = 0; e < 4; ++e) { const v4u* kr = (const v4u*)(MKP_P + (size_t)(ti * 256 + 4 * lane + e) * NINP + 512 + h * 64); float a2 = 0.f; const v4u* qrw = kr - 64; float q2 = 0.f;
#pragma unroll
                      for (int c8 = 0; c8 < 8; ++c8) { const v4u w = qrw[c8]; const unsigned ww[4] = {w.x, w.y, w.z, w.w};
#pragma unroll
                          for (int q4 = 0; q4 < 4; ++q4) { const float lo_ = __builtin_bit_cast(float, ww[q4] << 16), hi_ = __builtin_bit_cast(float, ww[q4] & 0xffff0000u); q2 += lo_ * lo_ + hi_ * hi_; } }
                      qmx = fmaxf(qmx, q2);
#pragma unroll
                      for (int c8 = 0; c8 < 8; ++c8) { const v4u w = kr[c8]; const unsigned ww[4] = {w.x, w.y, w.z, w.w};
#pragma unroll
                          for (int q4 = 0; q4 < 4; ++q4) { const float lo_ = __builtin_bit_cast(float, ww[q4] << 16), hi_ = __builtin_bit_cast(float, ww[q4] & 0xffff0000u); a2 += lo_ * lo_ + hi_ * hi_; } }
                      km = fmaxf(km, a2); }
#pragma unroll
                  for (int o = 32; o >= 1; o >>= 1) km = fmaxf(km, __shfl_xor(km, o));
#pragma unroll
                  for (int o = 32; o >= 1; o >>= 1) qmx = fmaxf(qmx, __shfl_xor(qmx, o));
                  if (lane == 0) { atomicMax((unsigned*)(args.ws + WS_CTL) + CW_KMAX + 64 * h, __builtin_bit_cast(unsigned, km)); MKP_QMAX[h * 64 + ti] = qmx; } }
#pragma unroll
                for (int e = 0; e < 4; ++e) { const float b = -cs[e] * LOG2E; const unsigned bh = f2bf(b); const float r1 = b - __builtin_bit_cast(float, bh << 16); const unsigned bm = f2bf(r1);
                    const float r2 = r1 - __builtin_bit_cast(float, bm << 16); const unsigned bl = f2bf(r2);
                    *(v4u*)(MKP_KB + ((size_t)h * M + ti * 256 + 4 * lane + e) * 8) = (v4u){bh | (bm << 16), bl | 0x3F800000u, 0x3F803F80u, 0u}; } } }
        __syncthreads();
        { int kq = QL; asm volatile("" : "+s"(kq)); pg8::Gemm g{MKP_P + 1536, MKP_Wq_t, M, NQU, kq, NINP}; pg8::StaticOrder S; S.init(M, NQU, G, bx);
          pg8::EpiQm E{MKP_QM, NQU, MKP_RT, C2_MLA, MKP_SSQ, EPS};
          pg8::gemm_phase<pg8::EpiQm, pg8::StaticOrder, PG8_ALIGN, PG8_SP2>(lds, g, S, E); }
        { int kkv = KVL; asm volatile("" : "+s"(kkv)); pg8::Gemm g{MKP_P + 1792, MKP_Wkv_t, M, NKVU, kkv, NINP}; pg8::StaticOrder S; S.init(M, NKVU, G, bx);
          pg8::EpiKv E{MKP_KVM, NKVU, MKP_SSKV, EPS};
          pg8::gemm_phase<pg8::EpiKv, pg8::StaticOrder, PG8_ALIGN, PG8_SP2>(lds, g, S, E); }
    }
    SEAM(3);
    TS_END(3);
    TS_BEGIN(4);
    if (IN(4)) {
        const int v = (G == 256) ? vcu : bx; const int h0 = (v >> 5) & 7;
        volatile LAS unsigned* misc = (volatile LAS unsigned*)(lds + MISC_OFF);
        unsigned* ctlw = (unsigned*)(args.ws + WS_CTL);
        { const int tid_ = threadIdx.x, lane_ = tid_ & 63, tok = bx * 64 + (tid_ >> 3), hh = tid_ & 7; float k2 = 0.f, q2 = 0.f;
          if (bx < 256) {
            const v4u* kp = (const v4u*)(MKP_KVM + (size_t)tok * NKVU + hh * 64); const v4u* rp = (const v4u*)(MKP_P + (size_t)tok * NINP + 1920); const v4u* qp = (const v4u*)(MKP_QM + (size_t)tok * NQU + hh * 96);
#define MK_SQ(w_, acc_) do { const unsigned ww_[4] = {w_.x, w_.y, w_.z, w_.w}; _Pragma("unroll") for (int q4_ = 0; q4_ < 4; ++q4_) { const float lo_ = __builtin_bit_cast(float, ww_[q4_] << 16), hi_ = __builtin_bit_cast(float, ww_[q4_] & 0xffff0000u); acc_ += lo_ * lo_ + hi_ * hi_; } } while (0)
#pragma unroll
            for (int c8 = 0; c8 < 8; ++c8) { const v4u w = kp[c8]; MK_SQ(w, k2); }
#pragma unroll
            for (int c8 = 0; c8 < 4; ++c8) { const v4u w = rp[c8]; MK_SQ(w, k2); }
#pragma unroll
            for (int c8 = 0; c8 < 12; ++c8) { const v4u w = qp[c8]; MK_SQ(w, q2); }
#undef MK_SQ
          }
#pragma unroll
          for (int o = 8; o <= 32; o <<= 1) { k2 = fmaxf(k2, __shfl_xor(k2, o)); q2 = fmaxf(q2, __shfl_xor(q2, o)); }
          if (lane_ < 8) { atomicMax(ctlw + CW_KMAXM + 64 * lane_, __builtin_bit_cast(unsigned, k2)); atomicMax(ctlw + CW_QMAXM, __builtin_bit_cast(unsigned, q2)); }
          asm volatile("s_waitcnt vmcnt(0)" ::: "memory"); __syncthreads();
          if (tid_ == 0) __hip_atomic_fetch_add(ctlw + CW_DONE, 1u, __ATOMIC_RELAXED, __HIP_MEMORY_SCOPE_AGENT); }
        bool okF = true;
        { const int lane_ = threadIdx.x & 63;
          for (int h = 0; h < 8; ++h) { const float kF = __builtin_bit_cast(float, __hip_atomic_load(ctlw + CW_KMAX + 64 * h, __ATOMIC_RELAXED, __HIP_MEMORY_SCOPE_AGENT));
              float qF = MKP_QMAX[h * 64 + lane_];
#pragma unroll
              for (int o = 32; o >= 1; o >>= 1) qF = fmaxf(qF, __shfl_xor(qF, o));
              okF = okF && (qF * kF < 2025.f); }
          okF = __builtin_amdgcn_readfirstlane(okF ? 1 : 0) != 0; }
#ifndef PROBE_FOX
#define PROBE_FOX 1
#endif
#ifndef PROBE_MLA
#define PROBE_MLA 1
#endif
#define MK_POP(CWQ) \
            if ((threadIdx.x >> 6) == 0) { const int ln_ = threadIdx.x & 63; unsigned i_ = 0xFFFFFFFFu; int hs_ = h0; \
                if (own) { if (ln_ == 0) i_ = __hip_atomic_fetch_add(ctlw + (CWQ) + 64 * h0 + 16 * rep, 1u, __ATOMIC_RELAXED, __HIP_MEMORY_SCOPE_AGENT); i_ = (unsigned)__builtin_amdgcn_readfirstlane((int)i_); } \
                if (!own || i_ >= 64u) { unsigned c_ = 64u; if (ln_ < 8) c_ = __hip_atomic_load(ctlw + (CWQ) + 64 * ((h0 + ln_) & 7) + 16 * rep, __ATOMIC_RELAXED, __HIP_MEMORY_SCOPE_AGENT); \
                    const unsigned long long m_ = __ballot(c_ < 64u); i_ = 0xFFFFFFFFu; \
                    if (m_ != 0ull) { hs_ = (h0 + (int)__builtin_ctzll(m_)) & 7; if (ln_ == 0) i_ = __hip_atomic_fetch_add(ctlw + (CWQ) + 64 * hs_ + 16 * rep, 1u, __ATOMIC_RELAXED, __HIP_MEMORY_SCOPE_AGENT); \
                        i_ = (unsigned)__builtin_amdgcn_readfirstlane((int)i_); if (i_ >= 64u) i_ = 0xFFFFFFFEu; } } \
                if (ln_ == 0) { misc[0] = i_; misc[1] = (unsigned)hs_; } } \
            __syncthreads(); const unsigned i = misc[0]; const int h = (int)misc[1]; __syncthreads(); \
            if (h != h0 || i >= 64u) own = false; \
            if (i == 0xFFFFFFFFu) break; \
            if (i >= 64u) continue;
#define MK_FOX_LOOPS(FIXV) do { \
        for (int rep = 0; rep < PROBE_FOX; ++rep) { bool own = true; \
        for (;;) { MK_POP(CW_QF) \
            const float kmax2 = __builtin_bit_cast(float, __hip_atomic_load(ctlw + CW_KMAX + 64 * h, __ATOMIC_RELAXED, __HIP_MEMORY_SCOPE_AGENT)); \
            att::Src s{MKP_P + h * 64, NINP, MKP_P + 512 + h * 64, NINP, MKP_KB + (size_t)h * M * 8, 8, MKP_P + 1024 + h * 64, NINP, MKP_OB + h * 64, D}; \
            att::attn_unit<false, FIXV>(63 - (int)i, s, lds, MKP_BIASF + (size_t)h * M, kmax2, MKP_QMAX + h * 64); \
        } } } while (0)
#define MK_MLA_LOOPS(FIXV) do { \
        for (int rep = 0; rep < PROBE_MLA; ++rep) { bool own = true; \
        for (;;) { MK_POP(CW_QM) \
            const float kmaxm = __builtin_bit_cast(float, __hip_atomic_load(ctlw + CW_KMAXM + 64 * h, __ATOMIC_RELAXED, __HIP_MEMORY_SCOPE_AGENT)); \
            att::Src s{MKP_QM + h * 96, NQU, MKP_KVM + h * 64, NKVU, MKP_P + 1920, NINP, MKP_KVM + 512 + h * 64, NKVU, MKP_OB + 512 + h * 64, D}; \
            att::attn_unit<true, FIXV>(63 - (int)i, s, lds, nullptr, kmaxm, nullptr); \
        } } } while (0)
        if (okF) MK_FOX_LOOPS(true); else MK_FOX_LOOPS(false);
        asm volatile("" ::: "memory");
        if (threadIdx.x == 0) { unsigned sp = 0; while (__hip_atomic_load(ctlw + CW_DONE, __ATOMIC_RELAXED, __HIP_MEMORY_SCOPE_AGENT) < (unsigned)G) { __builtin_amdgcn_s_sleep(2); if (++sp > (1u << 22)) break; } }
        __syncthreads();
        bool okM = true;
        { const float qmM = __builtin_bit_cast(float, __hip_atomic_load(ctlw + CW_QMAXM, __ATOMIC_RELAXED, __HIP_MEMORY_SCOPE_AGENT));
          for (int h = 0; h < 8; ++h) { const float kM = __builtin_bit_cast(float, __hip_atomic_load(ctlw + CW_KMAXM + 64 * h, __ATOMIC_RELAXED, __HIP_MEMORY_SCOPE_AGENT)); okM = okM && (qmM * kM < 2025.f); }
          okM = __builtin_amdgcn_readfirstlane(okM ? 1 : 0) != 0; }
        if (okM) MK_MLA_LOOPS(true); else MK_MLA_LOOPS(false);
#undef MK_FOX_LOOPS
#undef MK_MLA_LOOPS
#undef MK_POP
    }
#ifdef ATT_PRIO
    __builtin_amdgcn_s_setprio(0);
#endif
    SEAM(4);
    TS_END(4);
    TS_BEGIN(5);
    if (IN(5)) {
        pg8::Gemm g{MKP_OB, MKP_Wo_t, M, D, D}; pg8::StaticOrder S; S.init(M, D, G, bx);
        pg8::EpiRes E{MKP_x, MKP_out, D, MKP_XN, MKP_SS};
        pg8::gemm_phase<pg8::EpiRes, pg8::StaticOrder, PG8_ALIGN, PG8_SP2>(lds, g, S, E);
    }
    SEAM(5);
    TS_END(5);
    TS_BEGIN(6);
    if (IN(6)) {
        pg8::Gemm g{MKP_XN, MKP_W1_t, M, FF, D}; pg8::StaticOrder S; S.init(M, FF, G, bx);
        pg8::EpiSqRelu E{MKP_HB, FF, MKP_SS, EPS, 1.f / D};
        pg8::gemm_phase<pg8::EpiSqRelu, pg8::StaticOrder, PG8_ALIGN, PG8_SP2>(lds, g, S, E);
    }
    SEAM(6);
    TS_END(6);
    TS_BEGIN(7);
    if (IN(7)) {
        pg8::Gemm g{MKP_HB, MKP_W2_t, M, D, FF}; pg8::StaticOrder S; S.init(M, D, G, bx);
        pg8::EpiResNorm E{MKP_out, MKP_out, D, MKP_g_final, MKP_SSQ, (unsigned*)(args.ws + WS_CTL) + CW_PCNT, EPS, 1.f / D};
        pg8::gemm_phase<pg8::EpiResNorm, pg8::StaticOrder, false, PG8_SP2>(lds, g, S, E);
    }
#ifdef TS_PHASE
    { XcdBarrier b_; b_.bar = (unsigned*)(args.ws + WS_CTL); b_.x = xb_xcc_id(); b_.st = (volatile LAS unsigned*)(lds + MISC_OFF) + 8; xcd_barrier(b_); }
    TS_END(7);
    if (blockIdx.x == 0 && threadIdx.x == 0) MKP_out[0] = (float)(((ts_b_ - ts_a_) / TS_Q) * (TS_Q / 100ull));
#endif
#undef IN
#undef SEAM
#undef MKP_x
#undef MKP_g_mix
#undef MKP_w_in
#undef MKP_b_f
#undef MKP_g_q
#undef MKP_w_q_up
#undef MKP_g_kv
#undef MKP_w_kv_up
#undef MKP_w_o
#undef MKP_g_mlp
#undef MKP_w_ff1
#undef MKP_w_ff2
#undef MKP_g_final
#undef MKP_out
#undef MKP_Win_t
#undef MKP_Wq_t
#undef MKP_Wkv_t
#undef MKP_Wo_t
#undef MKP_W1_t
#undef MKP_W2_t
#undef MKP_RT
#undef MKP_LF
#undef MKP_SS
#undef MKP_SSQ
#undef MKP_BIASF
#undef MKP_QMAX
#undef MKP_SSKV
#undef MKP_KB
#undef MKP_KR
#undef MKP_XN
#undef MKP_HB
#undef MKP_P
#undef MKP_QM
#undef MKP_KVM
#undef MKP_QN
#undef MKP_OB
#undef MKP_KVN
}

#ifndef MK_ONE_LAUNCH
#define MK_ONE_LAUNCH 1
#endif
extern "C" void kernel_launch(void* const* d_in, const int* in_sizes, int n_in, void* d_out, int out_size, void* d_ws, size_t ws_size, hipStream_t stream) {
    static int ready = 0;
    if (ready == 0) {
        if (n_in != 13 || in_sizes[0] != M * D || out_size != M * D || ws_size < WS_END) { fprintf(stderr, "kernel_launch: unexpected shapes (n_in %d, in0 %d, out %d, ws %zu)\n", n_in, n_in > 0 ? in_sizes[0] : -1, out_size, ws_size); ready = -1; return; }
        if (hipFuncSetAttribute((const void*)mk_fwd, hipFuncAttributeMaxDynamicSharedMemorySize, LDS_BYTES) != hipSuccess) { fprintf(stderr, "kernel_launch: hipFuncSetAttribute failed\n"); ready = -1; return; }
        ready = 1;
    }
    if (ready < 0) return;
    if (hipMemsetAsync((char*)d_ws + WS_CTL, 0, CTL_ZERO_BYTES, stream) != hipSuccess) { fprintf(stderr, "kernel_launch: hipMemsetAsync failed\n"); return; }
    Args a{};
    for (int i = 0; i < 13; ++i) a.in[i] = (const float*)d_in[i];
    a.out = (float*)d_out; a.ws = (unsigned char*)d_ws;
#ifndef MK_DUP
#define MK_DUP -1
#endif
    a.dup = MK_DUP;
    const int grid = 256;
#if MK_ONE_LAUNCH
    a.ph_lo = 0; a.ph_hi = NPHASE;
    void* kargs[] = {&a};
    hipError_t e = hipLaunchCooperativeKernel((const void*)mk_fwd, dim3(grid), dim3(NWAVES * 64), kargs, LDS_BYTES, stream);
    if (e != hipSuccess) fprintf(stderr, "kernel_launch: cooperative launch failed: %s\n", hipGetErrorString(e));
#else
    for (int p = 0; p < NPHASE; ++p) { a.ph_lo = p; a.ph_hi = p + 1; hipLaunchKernelGGL(mk_fwd, dim3(grid), dim3(NWAVES * 64), LDS_BYTES, stream, a); }
#endif
}
```

```cpp
#include <hip/hip_runtime.h>
#include <hip/hip_cooperative_groups.h>
#include <hip/hip_bf16.h>
#include <cstdio>
#include <cstdint>
#include <cmath>
namespace pg8 {
#define PG8_LAS __attribute__((address_space(3)))
typedef unsigned short bf16_t;
typedef short bf16x8 __attribute__((ext_vector_type(8)));
typedef float f32x4 __attribute__((ext_vector_type(4)));
typedef unsigned u32x4 __attribute__((ext_vector_type(4)));
constexpr int BM = 256, BK = 64, HALF = 128, HTB = HALF * BK * 2  , STAGE_BYTES = 8 * HTB, NXCD = 8, WGM = 8;

__host__ __device__ __forceinline__ int lds_byte(int r, int c) { const int st = (r >> 4) * 2 + (c >> 5), rr = r & 15, cc = c & 31, ob = rr * 64 + cc * 2; return st * 1024 + (ob ^ (((ob >> 9) & 1) << 5)); }
__host__ __device__ __forceinline__ void stage_rc(int b, int& R, int& C) { const int st = b / 1024, sb = b % 1024, swz = sb ^ (((sb >> 9) & 1) << 5); R = (st >> 1) * 16 + swz / 64; C = (st & 1) * 32 + (swz % 64) / 2; }
__host__ __device__ __forceinline__ int perm32(int rho) { const int n = rho >> 4, i = rho & 15; return 8 * (i >> 2) + 4 * n + (i & 3); }

struct Unit { int pm, pn; };
struct Gemm { const bf16_t* A; const bf16_t* Bt; int M, N, K; int lda; };

struct StaticOrder {
    int nM, nN, nwg, G, c, panel;
    __host__ __device__ __forceinline__ void init(int M, int N, int G_, int c_, int panel_ = 0) { nM = M / BM; nN = N / BM; nwg = nM * nN; G = G_; c = c_; panel = panel_; }
    __host__ __device__ __forceinline__ bool next(int i, Unit& u) const {
        if (panel) { if (i >= 4) return false; base(0, u); u.pn = 4 * u.pn + i; return true; }
        return base(i, u);
    }
    __host__ __device__ __forceinline__ bool base(int i, Unit& u) const {
        const long L = (long)i * G + c; if (L >= nwg) return false;
        int wgid = (int)L; { const int q = nwg / NXCD, r = nwg % NXCD, xcd = wgid % NXCD, off = wgid / NXCD; wgid = (xcd < r ? xcd * (q + 1) : r * (q + 1) + (xcd - r) * q) + off; }
        const int nig = WGM * nN, gid = wgid / nig, fm = gid * WGM, gsz = (nM - fm) < WGM ? (nM - fm) : WGM;
        u.pm = fm + ((wgid % nig) % gsz); u.pn = (wgid % nig) / gsz; return true;
    }
    __device__ __forceinline__ void a_ready(const Unit&) const {}
    __device__ __forceinline__ void done(const Unit&) const {}
};

__device__ __forceinline__ unsigned cvt_pk_bf16(float lo, float hi) { unsigned r; asm volatile("v_cvt_pk_bf16_f32 %0, %1, %2" : "=v"(r) : "v"(lo), "v"(hi)); return r; }
typedef float f32x2 __attribute__((ext_vector_type(2)));
__device__ __forceinline__ f32x2 gelu_pk(f32x2 v) {
    const f32x2 av = __builtin_elementwise_abs(v), d = av * 0.2316418882f + 1.0f;
    f32x2 t; t.x = __builtin_amdgcn_rcpf(d.x); t.y = __builtin_amdgcn_rcpf(d.y);
    f32x2 q = t * 0.5307027145f + (-0.7265760135f); q = q * t + 0.7107068705f; q = q * t + (-0.142248368f); q = q * t + 0.127414796f; q = q * t;
    const f32x2 s = (v * v) * (-0.72134752044f);
    f32x2 e; e.x = __builtin_amdgcn_exp2f(s.x); e.y = __builtin_amdgcn_exp2f(s.y);
    const f32x2 m = v * (q * e), r = v - m;
    f32x2 o; o.x = v.x < 0.f ? m.x : r.x; o.y = v.y < 0.f ? m.y : r.y; return o;
}

template <int ACT  > struct EpiBf16 {
    static constexpr bool PERM = true, AFTER_DRAIN = false; static_assert(ACT == 0 || ACT == 1, "EpiBf16: ACT is 0 (none) or 1 (gelu_pk)");
    bf16_t* O; int ldc; const float* bias; int split_cols; size_t split_stride; float scale0;
    __device__ __forceinline__ void operator()(const f32x4 (&acc)[2][2][4][2], const Unit& u, int wr, int wc, int fr, int fq) const {
        const int row0 = u.pm * BM + wr * 64 + fr; int colt = u.pn * BM; bf16_t* base = O;
        float sc = 1.f; if (split_cols) { const int t = colt / split_cols; base += (size_t)t * split_stride; colt -= t * split_cols; if (t == 0) sc = scale0; }
        const int col0 = colt + wc * 32 + 8 * fq, bcol0 = u.pn * BM + wc * 32 + 8 * fq;
        f32x4 bv[2][2];
#pragma unroll
        for (int bj = 0; bj < 2; ++bj)
#pragma unroll
            for (int n = 0; n < 2; ++n) bv[bj][n] = bias ? *(const f32x4*)(bias + bcol0 + bj * HALF + 4 * n) : (f32x4){0.f, 0.f, 0.f, 0.f};
#pragma unroll
        for (int ai = 0; ai < 2; ++ai)
#pragma unroll
            for (int m = 0; m < 4; ++m) { bf16_t* rowp = base + (size_t)(row0 + ai * HALF + m * 16) * ldc + col0;
#pragma unroll
                for (int bj = 0; bj < 2; ++bj) { f32x4 v0 = acc[ai][bj][m][0] + bv[bj][0], v1 = acc[ai][bj][m][1] + bv[bj][1];
                    if (ACT == 1) { f32x2 a = gelu_pk((f32x2){v0[0], v0[1]}), b = gelu_pk((f32x2){v0[2], v0[3]}), c = gelu_pk((f32x2){v1[0], v1[1]}), d = gelu_pk((f32x2){v1[2], v1[3]});
                        v0 = (f32x4){a.x, a.y, b.x, b.y}; v1 = (f32x4){c.x, c.y, d.x, d.y}; }
                    v0 = v0 * sc; v1 = v1 * sc; u32x4 w; w.x = cvt_pk_bf16(v0[0], v0[1]); w.y = cvt_pk_bf16(v0[2], v0[3]); w.z = cvt_pk_bf16(v1[0], v1[1]); w.w = cvt_pk_bf16(v1[2], v1[3]);
                    *(u32x4*)(rowp + bj * HALF) = w; } }
    }
};

struct EpiQm {
    static constexpr bool PERM = true, AFTER_DRAIN = false;
    bf16_t* O; int ldc; const float* rt; float scale; const float* ssq; float eps;
    __device__ __forceinline__ void operator()(const f32x4 (&acc)[2][2][4][2], const Unit& u, int wr, int wc, int fr, int fq) const {
        const int row0 = u.pm * BM + wr * 64 + fr, col0 = u.pn * BM + wc * 32 + 8 * fq;
#pragma unroll
        for (int ai = 0; ai < 2; ++ai)
#pragma unroll
            for (int m = 0; m < 4; ++m) { const int row = row0 + ai * HALF + m * 16;
                const f32x4 sq = *(const f32x4*)(ssq + (size_t)row * 4); const float rs = scale / sqrtf(((sq[0] + sq[1]) + (sq[2] + sq[3])) * (1.0f / 256.0f) + eps);
#pragma unroll
                for (int bj = 0; bj < 2; ++bj) { const int c = col0 + bj * HALF, d = c % 96;
                    f32x4 v0 = acc[ai][bj][m][0], v1 = acc[ai][bj][m][1];
                    if (d >= 64) { const f32x4* t = (const f32x4*)(rt + (size_t)row * 32 + (d - 64)); const f32x4 t0 = t[0], t1 = t[1];
                        f32x4 w0, w1;
                        w0[0] = v0[0] * t0[0] - v0[1] * t0[1]; w0[1] = v0[1] * t0[0] + v0[0] * t0[1];
                        w0[2] = v0[2] * t0[2] - v0[3] * t0[3]; w0[3] = v0[3] * t0[2] + v0[2] * t0[3];
                        w1[0] = v1[0] * t1[0] - v1[1] * t1[1]; w1[1] = v1[1] * t1[0] + v1[0] * t1[1];
                        w1[2] = v1[2] * t1[2] - v1[3] * t1[3]; w1[3] = v1[3] * t1[2] + v1[2] * t1[3];
                        v0 = w0; v1 = w1; }
                    v0 = v0 * rs; v1 = v1 * rs; u32x4 w; w.x = cvt_pk_bf16(v0[0], v0[1]); w.y = cvt_pk_bf16(v0[2], v0[3]); w.z = cvt_pk_bf16(v1[0], v1[1]); w.w = cvt_pk_bf16(v1[2], v1[3]);
                    *(u32x4*)(O + (size_t)row * ldc + c) = w; }
                asm volatile("" ::: "memory"); }
    }
};

struct EpiKv {
    static constexpr bool PERM = true, AFTER_DRAIN = false;
    bf16_t* O; int ldc; const float* ssq; float eps;
    __device__ __forceinline__ void operator()(const f32x4 (&acc)[2][2][4][2], const Unit& u, int wr, int wc, int fr, int fq) const {
        const int row0 = u.pm * BM + wr * 64 + fr, col0 = u.pn * BM + wc * 32 + 8 * fq;
#pragma unroll
        for (int ai = 0; ai < 2; ++ai)
#pragma unroll
            for (int m = 0; m < 4; ++m) { const int row = row0 + ai * HALF + m * 16;
                const f32x4 sq = *(const f32x4*)(ssq + (size_t)row * 4); const float rs = 1.0f / sqrtf(((sq[0] + sq[1]) + (sq[2] + sq[3])) * (1.0f / 128.0f) + eps);
#pragma unroll
                for (int bj = 0; bj < 2; ++bj) { const f32x4 v0 = acc[ai][bj][m][0] * rs, v1 = acc[ai][bj][m][1] * rs;
                    u32x4 w; w.x = cvt_pk_bf16(v0[0], v0[1]); w.y = cvt_pk_bf16(v0[2], v0[3]); w.z = cvt_pk_bf16(v1[0], v1[1]); w.w = cvt_pk_bf16(v1[2], v1[3]);
                    *(u32x4*)(O + (size_t)row * ldc + col0 + bj * HALF) = w; }
                asm volatile("" ::: "memory"); }
    }
};
struct EpiIn {
    static constexpr bool PERM = true, AFTER_DRAIN = false;
    bf16_t* O; int ldc; float scale0; float* ssq; float* sskv; const float* rt; const float* bf; float* lf; int nrows;
    __device__ __forceinline__ void operator()(const f32x4 (&acc)[2][2][4][2], const Unit& u, int wr, int wc, int fr, int fq) const {
        const int row0 = u.pm * BM + wr * 64 + fr, col0 = u.pn * BM + wc * 32 + 8 * fq; const int pn = u.pn;
        const float sc = pn < 2 ? scale0 : 1.f;
#pragma unroll
        for (int ai = 0; ai < 2; ++ai)
#pragma unroll
            for (int m = 0; m < 4; ++m) { const int row = row0 + ai * HALF + m * 16; bf16_t* rowp = O + (size_t)row * ldc + col0; float s0 = 0.f, s1 = 0.f;
#pragma unroll
                for (int bj = 0; bj < 2; ++bj) { f32x4 v0 = acc[ai][bj][m][0] * sc, v1 = acc[ai][bj][m][1] * sc;
                    const float sq = ((v0[0] * v0[0] + v0[1] * v0[1]) + (v0[2] * v0[2] + v0[3] * v0[3])) + ((v1[0] * v1[0] + v1[1] * v1[1]) + (v1[2] * v1[2] + v1[3] * v1[3]));
                    if (bj == 0) s0 = sq; else s1 = sq;
                    bool store = true;
                    if (pn == 7 && bj == 1) { store = (wc == 0);
                        if (wc == 0) { const f32x4* t = (const f32x4*)(rt + (size_t)row * 32 + 8 * fq); const f32x4 t0 = t[0], t1 = t[1]; f32x4 w0, w1;
                            w0[0] = v0[0] * t0[0] - v0[1] * t0[1]; w0[1] = v0[1] * t0[0] + v0[0] * t0[1];
                            w0[2] = v0[2] * t0[2] - v0[3] * t0[3]; w0[3] = v0[3] * t0[2] + v0[2] * t0[3];
                            w1[0] = v1[0] * t1[0] - v1[1] * t1[1]; w1[1] = v1[1] * t1[0] + v1[0] * t1[1];
                            w1[2] = v1[2] * t1[2] - v1[3] * t1[3]; w1[3] = v1[3] * t1[2] + v1[2] * t1[3];
                            v0 = w0; v1 = w1; }
                        else if (wc == 1 && fq == 0) {
#pragma unroll
                            for (int e = 0; e < 8; ++e) { const float z = (e < 4 ? v0[e & 3] : v1[e & 3]) + bf[e]; lf[(size_t)e * nrows + row] = fminf(z, 0.f) - 0.6931471805599453f * __builtin_amdgcn_logf(1.0f + __builtin_amdgcn_exp2f(-1.4426950408889634f * fabsf(z))); } } }
                    if (store) { u32x4 w; w.x = cvt_pk_bf16(v0[0], v0[1]); w.y = cvt_pk_bf16(v0[2], v0[3]); w.z = cvt_pk_bf16(v1[0], v1[1]); w.w = cvt_pk_bf16(v1[2], v1[3]);
                        *(u32x4*)(rowp + bj * HALF) = w; } }
                if (pn == 6) { float s = s0 + s1; s += __shfl_xor(s, 16); s += __shfl_xor(s, 32); if (fq == 0) ssq[(size_t)row * 4 + wc] = s; }
                if (pn == 7) { float s = s0; s += __shfl_xor(s, 16); s += __shfl_xor(s, 32); if (fq == 0) sskv[(size_t)row * 4 + wc] = s; }
                asm volatile("" ::: "memory"); }
    }
};
struct EpiRes {
    static constexpr bool PERM = false, AFTER_DRAIN = false;
    const float* base; float* out; int ldc; bf16_t* ob; float* ss;
    __device__ __forceinline__ void operator()(const f32x4 (&acc)[2][2][4][2], const Unit& u, int wr, int wc, int fr, int fq) const {
        typedef unsigned u32x2v __attribute__((ext_vector_type(2)));
        const int row0 = u.pm * BM + wr * 64 + fr, col0 = u.pn * BM + wc * 32 + 4 * fq;
        f32x4 cb[2][2], nb[2][2];
        { const size_t off = (size_t)row0 * ldc + col0;
#pragma unroll
          for (int bj = 0; bj < 2; ++bj)
#pragma unroll
              for (int n = 0; n < 2; ++n) cb[bj][n] = *(const f32x4*)(base + off + bj * HALF + n * 16); }
#pragma unroll
        for (int g = 0; g < 8; ++g) { const int ai = g >> 2, m = g & 3; const int row = row0 + ai * HALF + m * 16; const size_t off = (size_t)row * ldc + col0; float s = 0.f;
            if (g + 1 < 8) { const int ai1 = (g + 1) >> 2, m1 = (g + 1) & 3; const size_t off1 = (size_t)(row0 + ai1 * HALF + m1 * 16) * ldc + col0;
#pragma unroll
                for (int bj = 0; bj < 2; ++bj)
#pragma unroll
                    for (int n = 0; n < 2; ++n) nb[bj][n] = *(const f32x4*)(base + off1 + bj * HALF + n * 16); }
            asm volatile("" ::: "memory");
#pragma unroll
            for (int bj = 0; bj < 2; ++bj)
#pragma unroll
                for (int n = 0; n < 2; ++n) { const f32x4 v = cb[bj][n] + acc[ai][bj][m][n];
                    *(f32x4*)(out + off + bj * HALF + n * 16) = v; s += (v[0] * v[0] + v[1] * v[1]) + (v[2] * v[2] + v[3] * v[3]);
                    if (ob) { u32x2v w; w.x = cvt_pk_bf16(v[0], v[1]); w.y = cvt_pk_bf16(v[2], v[3]); *(u32x2v*)(ob + off + bj * HALF + n * 16) = w; } }
            if (ss) { s += __shfl_xor(s, 16); s += __shfl_xor(s, 32); if (fq == 0) ss[(size_t)row * 16 + u.pn * 4 + wc] = s; }
#pragma unroll
            for (int bj = 0; bj < 2; ++bj)
#pragma unroll
                for (int n = 0; n < 2; ++n) cb[bj][n] = nb[bj][n];
        }
    }
};

struct EpiResNorm {
    static constexpr bool PERM = false, AFTER_DRAIN = true;
    const float* base; float* out; int ldc; const float* g; float* xs; unsigned* cnt; float eps; float inv_n;
    __device__ __forceinline__ void fused(f32x4 (&acc)[2][2][4][2], const Unit& u, int wr, int wc, int fr, int fq, PG8_LAS unsigned char* lds, int wid, int lane) const {
        PG8_LAS float* Pm = (PG8_LAS float*)lds;
        PG8_LAS float* S = (PG8_LAS float*)(lds + 4096);
        const int row0 = u.pm * BM + wr * 64 + fr, col0 = u.pn * BM + wc * 32 + 4 * fq;
        f32x4 cb[2][2], nb[2][2];
        { const size_t off = (size_t)row0 * ldc + col0;
#pragma unroll
          for (int bj = 0; bj < 2; ++bj)
#pragma unroll
              for (int n = 0; n < 2; ++n) cb[bj][n] = *(const f32x4*)(base + off + bj * HALF + n * 16); }
#pragma unroll
        for (int g = 0; g < 8; ++g) { const int ai = g >> 2, m = g & 3; float s = 0.f;
            if (g + 1 < 8) { const size_t off1 = (size_t)(row0 + ((g + 1) >> 2) * HALF + ((g + 1) & 3) * 16) * ldc + col0;
#pragma unroll
                for (int bj = 0; bj < 2; ++bj)
#pragma unroll
                    for (int n = 0; n < 2; ++n) nb[bj][n] = *(const f32x4*)(base + off1 + bj * HALF + n * 16); }
            asm volatile("" ::: "memory");
#pragma unroll
            for (int bj = 0; bj < 2; ++bj)
#pragma unroll
                for (int n = 0; n < 2; ++n) { const f32x4 v = cb[bj][n] + acc[ai][bj][m][n]; acc[ai][bj][m][n] = v;
                    s += (v[0] * v[0] + v[1] * v[1]) + (v[2] * v[2] + v[3] * v[3]); }
            s += __shfl_xor(s, 16); s += __shfl_xor(s, 32);
            if (fq == 0) Pm[(ai * HALF + wr * 64 + m * 16 + fr) * 4 + wc] = s;
#pragma unroll
            for (int bj = 0; bj < 2; ++bj)
#pragma unroll
                for (int n = 0; n < 2; ++n) cb[bj][n] = nb[bj][n]; }
        asm volatile("s_waitcnt lgkmcnt(0)" ::: "memory"); __builtin_amdgcn_s_barrier(); asm volatile("" ::: "memory");
        const int tid = wid * 64 + lane;
        if (tid < 256) { const f32x4 p4 = *(const PG8_LAS f32x4*)(Pm + tid * 4);
            __hip_atomic_store(xs + (size_t)(u.pm * BM + tid) * 4 + u.pn, (p4[0] + p4[1]) + (p4[2] + p4[3]), __ATOMIC_RELAXED, __HIP_MEMORY_SCOPE_AGENT);
            asm volatile("s_waitcnt vmcnt(0)" ::: "memory");
            if (lane == 0) __hip_atomic_fetch_add(cnt + 64 * u.pm, 1u, __ATOMIC_RELAXED, __HIP_MEMORY_SCOPE_AGENT); }
        if (wid == 0) { unsigned sp = 0;
            while ((unsigned)__builtin_amdgcn_readfirstlane(__hip_atomic_load(cnt + 64 * u.pm, __ATOMIC_RELAXED, __HIP_MEMORY_SCOPE_AGENT)) < 16u) { __builtin_amdgcn_s_sleep(2); if (++sp > (1u << 22)) break; }
            __builtin_amdgcn_fence(__ATOMIC_ACQUIRE, "agent"); }
        asm volatile("s_waitcnt vmcnt(0) lgkmcnt(0)" ::: "memory"); __builtin_amdgcn_s_barrier(); asm volatile("" ::: "memory");
        if (tid < 256) { const float* xp = xs + (size_t)(u.pm * BM + tid) * 4;
            const float t0 = __hip_atomic_load(xp + 0, __ATOMIC_RELAXED, __HIP_MEMORY_SCOPE_AGENT), t1 = __hip_atomic_load(xp + 1, __ATOMIC_RELAXED, __HIP_MEMORY_SCOPE_AGENT);
            const float t2 = __hip_atomic_load(xp + 2, __ATOMIC_RELAXED, __HIP_MEMORY_SCOPE_AGENT), t3 = __hip_atomic_load(xp + 3, __ATOMIC_RELAXED, __HIP_MEMORY_SCOPE_AGENT);
            S[tid] = 1.0f / sqrtf(((t0 + t1) + (t2 + t3)) * inv_n + eps); }
        asm volatile("s_waitcnt vmcnt(0) lgkmcnt(0)" ::: "memory"); __builtin_amdgcn_s_barrier(); asm volatile("" ::: "memory");
        f32x4 gv[2][2];
#pragma unroll
        for (int bj = 0; bj < 2; ++bj)
#pragma unroll
            for (int n = 0; n < 2; ++n) gv[bj][n] = *(const f32x4*)(g + col0 + bj * HALF + n * 16);
#pragma unroll
        for (int ai = 0; ai < 2; ++ai)
#pragma unroll
            for (int m = 0; m < 4; ++m) { const int r = ai * HALF + wr * 64 + m * 16 + fr; const float rs = S[r]; const size_t off = (size_t)(u.pm * BM + r) * ldc + col0;
#pragma unroll
                for (int bj = 0; bj < 2; ++bj)
#pragma unroll
                    for (int n = 0; n < 2; ++n) *(f32x4*)(out + off + bj * HALF + n * 16) = acc[ai][bj][m][n] * rs * gv[bj][n]; }
    }
};
struct EpiSqRelu {
    static constexpr bool PERM = true, AFTER_DRAIN = false;
    bf16_t* O; int ldc; const float* ss; float eps; float inv_n;
    __device__ __forceinline__ void operator()(const f32x4 (&acc)[2][2][4][2], const Unit& u, int wr, int wc, int fr, int fq) const {
        const int row0 = u.pm * BM + wr * 64 + fr, col0 = u.pn * BM + wc * 32 + 8 * fq;
        f32x4 cs[4], ns[4];
        { const f32x4* sp = (const f32x4*)(ss + (size_t)row0 * 16); cs[0] = sp[0]; cs[1] = sp[1]; cs[2] = sp[2]; cs[3] = sp[3]; }
#pragma unroll
        for (int g = 0; g < 8; ++g) { const int ai = g >> 2, m = g & 3; const int row = row0 + ai * HALF + m * 16;
            if (g + 1 < 8) { const f32x4* sp = (const f32x4*)(ss + (size_t)(row0 + ((g + 1) >> 2) * HALF + ((g + 1) & 3) * 16) * 16); ns[0] = sp[0]; ns[1] = sp[1]; ns[2] = sp[2]; ns[3] = sp[3]; }
            asm volatile("" ::: "memory");
            const f32x4 a = cs[0], b = cs[1], c = cs[2], d = cs[3];
            const float tot = ((a[0] + a[1]) + (a[2] + a[3])) + ((b[0] + b[1]) + (b[2] + b[3])) + ((c[0] + c[1]) + (c[2] + c[3])) + ((d[0] + d[1]) + (d[2] + d[3]));
            const float rstd = 1.0f / sqrtf(tot * inv_n + eps);
#pragma unroll
            for (int bj = 0; bj < 2; ++bj) { f32x4 v0 = acc[ai][bj][m][0] * rstd, v1 = acc[ai][bj][m][1] * rstd;
#pragma unroll
                for (int e = 0; e < 4; ++e) { const float x0 = fmaxf(v0[e], 0.f), x1 = fmaxf(v1[e], 0.f); v0[e] = x0 * x0; v1[e] = x1 * x1; }
                u32x4 w; w.x = cvt_pk_bf16(v0[0], v0[1]); w.y = cvt_pk_bf16(v0[2], v0[3]); w.z = cvt_pk_bf16(v1[0], v1[1]); w.w = cvt_pk_bf16(v1[2], v1[3]);
                *(u32x4*)(O + (size_t)row * ldc + col0 + bj * HALF) = w; }
            cs[0] = ns[0]; cs[1] = ns[1]; cs[2] = ns[2]; cs[3] = ns[3]; }
    }
};


template <class Epi, class Sched, bool ALIGN_EPI = false, bool SP2 = false>
__device__ __forceinline__ void gemm_phase(PG8_LAS unsigned char* lds, const Gemm g, const Sched& S, const Epi& E) {
    const int tid = threadIdx.x, wid = __builtin_amdgcn_readfirstlane(tid >> 6), lane = tid & 63, wr = wid >> 2, wc = wid & 3, fr = lane & 15, fq = lane >> 4;
    const int K = g.K, nt = K / BK, lda = g.lda ? g.lda : g.K;
    unsigned voffA[2], voffB[2];
#pragma unroll
    for (int i = 0; i < 2; ++i) { int R, C; stage_rc(tid * 16 + i * 8192, R, C); const int Rb = Epi::PERM ? ((R & ~31) + perm32(R & 31)) : R;
        voffA[i] = (unsigned)(R * lda + C) * 2u; voffB[i] = (unsigned)(Rb * K + C) * 2u; }
    const size_t kstep = (size_t)(BK * 2);
    const size_t hstep = (size_t)HALF * K * 2;
    const size_t tstep = 2 * hstep;
    const size_t hstepA = (size_t)HALF * lda * 2, tstepA = 2 * hstepA;
    const unsigned ldsw = (unsigned)wid * 1024u;
    const int aoff = lds_byte(wr * 64 + fr, fq * 8), boff = lds_byte(wc * 32 + fr, fq * 8);
#define PG8_SA(b, h) (((b) * 2 + (h)) * HTB)
#define PG8_SB(b, h) ((4 + (b) * 2 + (h)) * HTB)
#define PG8_STAGE(bufoff, gbase, voff) do { _Pragma("unroll") for (int _i = 0; _i < 2; ++_i) \
        __builtin_amdgcn_global_load_lds((const unsigned*)((const char*)(gbase) + (voff)[_i]), (PG8_LAS unsigned*)(lds + (bufoff) + ldsw + _i * 8192), 16, 0, 0); } while (0)
#define PG8_LDA(dst, b, h) do { _Pragma("unroll") for (int m = 0; m < 4; ++m) _Pragma("unroll") for (int k = 0; k < 2; ++k) dst[m][k] = *(const PG8_LAS bf16x8*)(lds + PG8_SA(b, h) + aoff + m * 2048 + k * 1024); } while (0)
#define PG8_LDB(dst, b, h) do { _Pragma("unroll") for (int n = 0; n < 2; ++n) _Pragma("unroll") for (int k = 0; k < 2; ++k) dst[n][k] = *(const PG8_LAS bf16x8*)(lds + PG8_SB(b, h) + boff + n * 2048 + k * 1024); } while (0)
#define PG8_MMA(ai, bj, At, Bt) do { __builtin_amdgcn_s_setprio(1); _Pragma("unroll") for (int m = 0; m < 4; ++m) _Pragma("unroll") for (int n = 0; n < 2; ++n) _Pragma("unroll") for (int k = 0; k < 2; ++k) \
        acc[ai][bj][m][n] = __builtin_amdgcn_mfma_f32_16x16x32_bf16(Bt[n][k], At[m][k], acc[ai][bj][m][n], 0, 0, 0); __builtin_amdgcn_s_setprio(0); } while (0)
#define PG8_WAIT_V(n) asm volatile("s_waitcnt vmcnt(" #n ")" ::: "memory")
#define PG8_WAIT_L(n) asm volatile("s_waitcnt lgkmcnt(" #n ")" ::: "memory")
#define PG8_BAR __builtin_amdgcn_s_barrier()
#define PG8_SCHED __builtin_amdgcn_sched_barrier(0)
    Unit cur, nxt; int ui = 0;
    if (!S.next(0, cur)) return;
    f32x4 acc[2][2][4][2];
#pragma unroll
    for (int a = 0; a < 2; ++a)
#pragma unroll
        for (int b = 0; b < 2; ++b)
#pragma unroll
            for (int m = 0; m < 4; ++m)
#pragma unroll
                for (int n = 0; n < 2; ++n) acc[a][b][m][n] = (f32x4){0.f, 0.f, 0.f, 0.f};
    bf16x8 At[4][2], B0[2][2], B1[2][2];
    const char* cA = (const char*)g.A + (size_t)cur.pm * tstepA; const char* cB = (const char*)g.Bt + (size_t)cur.pn * tstep;
    S.a_ready(cur);
    if constexpr (SP2) {
        PG8_STAGE(PG8_SB(0, 0), cB, voffB); PG8_STAGE(PG8_SB(0, 1), cB + hstep, voffB); PG8_STAGE(PG8_SA(0, 0), cA, voffA); PG8_STAGE(PG8_SA(0, 1), cA + hstepA, voffA);
        if (wr == 1) PG8_BAR;
        PG8_WAIT_V(2); PG8_BAR;
        PG8_STAGE(PG8_SB(1, 0), cB + kstep, voffB); PG8_STAGE(PG8_SA(1, 0), cA + kstep, voffA); PG8_STAGE(PG8_SB(1, 1), cB + hstep + kstep, voffB);
        PG8_WAIT_V(6); PG8_BAR;
    } else {
        PG8_STAGE(PG8_SB(0, 0), cB, voffB); PG8_STAGE(PG8_SA(0, 0), cA, voffA); PG8_STAGE(PG8_SB(0, 1), cB + hstep, voffB); PG8_STAGE(PG8_SA(0, 1), cA + hstepA, voffA);
        if (wr == 1) PG8_BAR;
        PG8_WAIT_V(4); PG8_BAR;
        PG8_STAGE(PG8_SB(1, 0), cB + kstep, voffB); PG8_STAGE(PG8_SA(1, 0), cA + kstep, voffA); PG8_STAGE(PG8_SB(1, 1), cB + hstep + kstep, voffB);
        PG8_WAIT_V(6); PG8_BAR;
    }
    for (;;) {
        const bool has_next = S.next(ui + 1, nxt);
        const char* nA = has_next ? (const char*)g.A + (size_t)nxt.pm * tstepA : cA; const char* nB = has_next ? (const char*)g.Bt + (size_t)nxt.pn * tstep : cB;
        for (int t = 0; t < nt; t += 2) {
            const bool last = (t == nt - 2);
            const char* a1 = cA + (size_t)(t + 1) * kstep;
            const char* a2 = last ? nA : cA + (size_t)(t + 2) * kstep; const char* b2 = last ? nB : cB + (size_t)(t + 2) * kstep;
            const char* a3 = a2 + kstep; const char* b3 = b2 + kstep;
            if (last && has_next) S.a_ready(nxt);
            if constexpr (SP2) {
            PG8_LDB(B0, 0, 0); PG8_LDB(B1, 0, 1); PG8_SCHED; PG8_LDA(At, 0, 0); PG8_STAGE(PG8_SA(1, 1), a1 + hstepA, voffA);
            PG8_WAIT_V(8); PG8_WAIT_L(0); PG8_BAR; PG8_MMA(0, 0, At, B0); PG8_MMA(0, 1, At, B1); PG8_BAR; PG8_SCHED;
            PG8_LDA(At, 0, 1); PG8_STAGE(PG8_SB(0, 0), b2, voffB); PG8_STAGE(PG8_SB(0, 1), b2 + hstep, voffB); PG8_STAGE(PG8_SA(0, 0), a2, voffA);
            PG8_WAIT_V(8); PG8_WAIT_L(0); PG8_BAR; PG8_MMA(1, 0, At, B0); PG8_MMA(1, 1, At, B1); PG8_BAR; PG8_SCHED;
            PG8_LDB(B0, 1, 0); PG8_LDB(B1, 1, 1); PG8_SCHED; PG8_LDA(At, 1, 0); PG8_STAGE(PG8_SA(0, 1), a2 + hstepA, voffA);
            PG8_WAIT_V(8); PG8_WAIT_L(0); PG8_BAR; PG8_MMA(0, 0, At, B0); PG8_MMA(0, 1, At, B1); PG8_BAR; PG8_SCHED;
            PG8_LDA(At, 1, 1); PG8_STAGE(PG8_SB(1, 0), b3, voffB); PG8_STAGE(PG8_SB(1, 1), b3 + hstep, voffB); PG8_STAGE(PG8_SA(1, 0), a3, voffA);
            PG8_WAIT_V(8); PG8_WAIT_L(0); PG8_BAR; PG8_MMA(1, 0, At, B0); PG8_MMA(1, 1, At, B1); PG8_BAR; PG8_SCHED;
            } else {
            PG8_LDB(B0, 0, 0); PG8_SCHED; PG8_LDA(At, 0, 0); PG8_STAGE(PG8_SA(1, 1), a1 + hstepA, voffA);
            PG8_WAIT_L(8); PG8_BAR; PG8_WAIT_L(0); PG8_MMA(0, 0, At, B0); PG8_BAR; PG8_SCHED;
            PG8_LDB(B1, 0, 1); PG8_STAGE(PG8_SB(0, 0), b2, voffB);
            PG8_BAR; PG8_WAIT_L(0); PG8_MMA(0, 1, At, B1); PG8_BAR;
            PG8_LDA(At, 0, 1); PG8_STAGE(PG8_SA(0, 0), a2, voffA);
            PG8_BAR; PG8_WAIT_L(0); PG8_MMA(1, 0, At, B0); PG8_BAR; PG8_SCHED;
            PG8_STAGE(PG8_SB(0, 1), b2 + hstep, voffB);
            PG8_WAIT_V(6); PG8_BAR; PG8_MMA(1, 1, At, B1); PG8_BAR;
            PG8_LDB(B0, 1, 0); PG8_SCHED; PG8_LDA(At, 1, 0); PG8_STAGE(PG8_SA(0, 1), a2 + hstepA, voffA);
            PG8_WAIT_L(8); PG8_BAR; PG8_WAIT_L(0); PG8_MMA(0, 0, At, B0); PG8_BAR; PG8_SCHED;
            PG8_LDB(B1, 1, 1); PG8_STAGE(PG8_SB(1, 0), b3, voffB);
            PG8_BAR; PG8_WAIT_L(0); PG8_MMA(0, 1, At, B1); PG8_BAR;
            PG8_LDA(At, 1, 1); PG8_STAGE(PG8_SA(1, 0), a3, voffA);
            PG8_BAR; PG8_WAIT_L(0); PG8_MMA(1, 0, At, B0); PG8_BAR; PG8_SCHED;
            PG8_STAGE(PG8_SB(1, 1), b3 + hstep, voffB);
            PG8_WAIT_V(6); PG8_BAR; PG8_MMA(1, 1, At, B1); PG8_BAR;
            }
        }
        if constexpr (ALIGN_EPI) { if (wr == 0) PG8_BAR; }
        if constexpr (!Epi::AFTER_DRAIN) { E(acc, cur, wr, wc, fr, fq); S.done(cur); }
        if (!has_next) break;
#pragma unroll
        for (int a = 0; a < 2; ++a)
#pragma unroll
            for (int b = 0; b < 2; ++b)
#pragma unroll
                for (int m = 0; m < 4; ++m)
#pragma unroll
                    for (int n = 0; n < 2; ++n) acc[a][b][m][n] = (f32x4){0.f, 0.f, 0.f, 0.f};
        cur = nxt; cA = nA; cB = nB; ++ui;
        if constexpr (ALIGN_EPI) { if (wr == 1) PG8_BAR; }
    }
    PG8_WAIT_V(0);
    if constexpr (!ALIGN_EPI) { if (wr == 0) PG8_BAR; }
    PG8_BAR;
    if constexpr (Epi::AFTER_DRAIN) { E.fused(acc, cur, wr, wc, fr, fq, lds, wid, lane); S.done(cur); }
#undef PG8_SA
#undef PG8_SB
#undef PG8_STAGE
#undef PG8_LDA
#undef PG8_LDB
#undef PG8_MMA
#undef PG8_WAIT_V
#undef PG8_WAIT_L
#undef PG8_BAR
#undef PG8_SCHED
}
}

#ifndef PG8_SP2
#define PG8_SP2 true
#endif
#ifndef PG8_ALIGN
#define PG8_ALIGN true
#endif
namespace att {
#define LAS3 __attribute__((address_space(3)))
using bf16x8 = __attribute__((ext_vector_type(8))) short;
using s16x4 = __attribute__((ext_vector_type(4))) short;
using f32x16 = __attribute__((ext_vector_type(16))) float;
using f32x4 = __attribute__((ext_vector_type(4))) float;
using u32x4 = __attribute__((ext_vector_type(4))) unsigned;
typedef unsigned short u16;
typedef LAS3 const unsigned char* lds_cptr;
typedef short v4i16_t __attribute__((ext_vector_type(4)));
constexpr int SEQ = 16384, NW = 8, QBLK = 32, QB = 256, KVBLK = 64;
constexpr int KSLOT = 12288, VSLOT = 8192, NKS = 4, NVS = 4;
constexpr int LDS_K = 0, LDS_V = NKS * KSLOT, LDS_WS = LDS_V + NVS * VSLOT, LDS_OST = LDS_WS + NW * 256, LDS_QX = LDS_OST + NW * 4096, LDS_BYTES = LDS_QX + NW * 2048;
__device__ __forceinline__ int crow(int r, int hi) { return (r & 3) + 8 * (r >> 2) + 4 * hi; }
__device__ __forceinline__ void glds16(const void* gsrc, unsigned lds_dst) {
    asm volatile("s_mov_b32 m0, %1\n\ts_nop 0\n\tglobal_load_lds_dwordx4 %0, off" : : "v"(gsrc), "s"(lds_dst) : "memory", "m0"); }
typedef float f32x2_t __attribute__((ext_vector_type(2))); typedef __bf16 bf16x2_t __attribute__((ext_vector_type(2)));
__device__ __forceinline__ unsigned cvtpk_s(float lo, float hi) { f32x2_t v = {lo, hi}; bf16x2_t b = __builtin_convertvector(v, bf16x2_t); return __builtin_bit_cast(unsigned, b); }
__device__ __forceinline__ s16x4 vtr(lds_cptr p) { return __builtin_bit_cast(s16x4, __builtin_amdgcn_ds_read_tr16_b64_v4i16((LAS3 v4i16_t*)p)); }
#define ATT_SBAR() __builtin_amdgcn_sched_barrier(0)
#define ATT_WAIT_BAR(N) asm volatile("s_waitcnt vmcnt(" #N ") lgkmcnt(0)\n\ts_barrier" ::: "memory")
struct Src {
    const u16* q; int qp;
    const u16* k; int kp;
    const u16* k2; int k2p;
    const u16* v; int vp;
    u16* o; int op;
};
template <int NDK, int NQR, bool ZC, int XHS, int JLO, int JHI, bool EARLY>
__device__ __forceinline__ void phase_a(f32x16& C0, f32x16& C1, const lds_cptr* kb_, int ksl_, const bf16x8* qr, lds_cptr qx_, const f32x16& negm, bf16x8* kf, bf16x8* qx) {
    constexpr int KPF = 4;
#define ATT_SH(s_) (EARLY ? ((s_) / NDK) : ((s_) & 1))
#define ATT_SD(s_) (EARLY ? ((s_) % NDK) : ((s_) >> 1))
#define ATT_KRD(s_) kf[s_] = *(const LAS3 bf16x8*)(kb_[ATT_SD(s_)] + ksl_ + ATT_SH(s_) * (ATT_SD(s_) < 4 ? 4096 : XHS))
    if (JLO == 0) {
#pragma unroll
        for (int j = 0; j < KPF; ++j) ATT_KRD(j); }
#pragma unroll
    for (int j = JLO; j < JHI; ++j) {
        if (j + KPF < 2 * NDK) ATT_KRD(j + KPF);
        { const int dn = ATT_SD(j) + 2; if (NDK > NQR && dn >= NQR && dn < NDK && (EARLY || ATT_SH(j) == 0)) qx[dn >= NQR ? dn - NQR : 0] = *(const LAS3 bf16x8*)(qx_ + (dn >= NQR ? dn - NQR : 0) * 1024); }
        ATT_SBAR();
        const int d0 = ATT_SD(j); const f32x16 z = f32x16{}; const bf16x8 qf = (d0 < NQR) ? qr[d0 < NQR ? d0 : 0] : qx[d0 >= NQR ? d0 - NQR : 0];
        if (ATT_SH(j)) C1 = __builtin_amdgcn_mfma_f32_32x32x16_bf16(kf[j], qf, (d0 == 0) ? (ZC ? z : negm) : C1, 0, 0, 0);
        else           C0 = __builtin_amdgcn_mfma_f32_32x32x16_bf16(kf[j], qf, (d0 == 0) ? (ZC ? z : negm) : C0, 0, 0, 0);
        if (EARLY && j > NDK) { const int e0 = 16 * (j - NDK - 1) / (NDK - 1), e1 = 16 * (j - NDK) / (NDK - 1);
#pragma unroll
            for (int e = e0; e < e1; ++e) C0[e] = __builtin_amdgcn_exp2f(C0[e]);
            asm volatile("" : "+v"(C0)); }
        ATT_SBAR();
    }
#undef ATT_KRD
#undef ATT_SH
#undef ATT_SD
}
template <bool QK, bool FIN, bool EARLY>
__device__ __forceinline__ void phase_b(f32x16& C0, f32x16& C1, f32x16* o, lds_cptr vp_, u32x4* pw, float& l_reg) {
    s16x4 vlo[8], vhi[8]; float sacc = 0.f, sacd = 0.f;
#define ATT_VRD(i) do { const int vi_ = ((i) >> 1) + 4 * ((i) & 1); vlo[i] = vtr(vp_ + ((vi_ >> 2) * 4096 + (vi_ & 3) * 1024)); vhi[i] = vtr(vp_ + ((vi_ >> 2) * 4096 + (vi_ & 3) * 1024 + 512)); } while (0)
    if (FIN) { ATT_VRD(0); ATT_VRD(1); }
#pragma unroll
    for (int i = 0; i < 8; ++i) {
        if (FIN && i + 2 < 8) ATT_VRD(i + 2);
        ATT_SBAR();
        if (FIN) { const bf16x8 vf = (bf16x8){vlo[i][0], vlo[i][1], vlo[i][2], vlo[i][3], vhi[i][0], vhi[i][1], vhi[i][2], vhi[i][3]};
            o[i & 1] = __builtin_amdgcn_mfma_f32_32x32x16_bf16(__builtin_bit_cast(bf16x8, pw[i >> 1]), vf, o[i & 1], 0, 0, 0); }
        if (QK) { f32x16& X = (i < 4) ? C0 : C1; const int b = 4 * (i & 3);
            if (EARLY) { C1[2 * i] = __builtin_amdgcn_exp2f(C1[2 * i]); C1[2 * i + 1] = __builtin_amdgcn_exp2f(C1[2 * i + 1]); asm volatile("" : "+v"(C1)); }
            else { X[b] = __builtin_amdgcn_exp2f(X[b]); X[b + 1] = __builtin_amdgcn_exp2f(X[b + 1]); X[b + 2] = __builtin_amdgcn_exp2f(X[b + 2]); X[b + 3] = __builtin_amdgcn_exp2f(X[b + 3]); }
            sacc += X[b]; sacd += X[b + 1]; sacc += X[b + 2]; sacd += X[b + 3]; asm volatile("" : "+v"(sacc), "+v"(sacd));
            if (i & 1) { const int k = i >> 1, c = 8 * (k & 1);
                pw[k] = (u32x4){cvtpk_s(X[c], X[c + 1]), cvtpk_s(X[c + 2], X[c + 3]), cvtpk_s(X[c + 4], X[c + 5]), cvtpk_s(X[c + 6], X[c + 7])}; asm volatile("" : "+v"(pw[k])); } }
        ATT_SBAR();
    }
#undef ATT_VRD
    if (QK) l_reg += sacc + sacd;
}
template <bool MLA, bool FIX> __device__ __forceinline__ void attn_unit(int qb, const Src& s, LAS3 unsigned char* shm, const float* bias_h, float kmax2, const float* qmax_h) {
    constexpr int NDK = MLA ? 6 : 5, NX = MLA ? 4 : 1, NQR = MLA ? 4 : 5;
    constexpr float THRL = MLA ? 8.0f : 16.0f;
    const int tid = threadIdx.x, lane = tid & 63, r32 = lane & 31, hi = lane >> 5; const int wid = __builtin_amdgcn_readfirstlane(tid >> 6);
    const int q0 = qb * QB;
    const unsigned lds0 = (unsigned)(uintptr_t)shm;
    LAS3 float* wsf = (LAS3 float*)(shm + LDS_WS) + wid * 64;
    const int NT = (q0 + QB) / KVBLK;
    const int wvis = NT - 4 + (wid >> 1);
    const bool xw = wid < NX;
    const int krow = 8 * wid + (lane >> 3);
    const u16* ksrc = s.k + (size_t)krow * s.kp + (((lane & 7) ^ ((krow >> 1) & 7)) * 8);
    const int k2row = 16 * (wid & 3) + (lane >> 2);
    const u16* k2src = MLA ? s.k2 + (size_t)k2row * s.k2p + (((lane & 3) ^ ((k2row >> 2) & 3)) * 8) : s.k2 + (size_t)lane * s.k2p;
    const u16* vsrc = s.v + (size_t)(16 * (wid & 3) + (lane >> 2)) * s.vp + (wid >> 2) * 32 + (lane & 3) * 8;
    const unsigned kdst = lds0 + LDS_K + wid * 1024, k2dst = lds0 + LDS_K + (8 + (wid & 3)) * 1024, vdst = lds0 + LDS_V + wid * 1024;
#define ATT_DMA_K(t) do { const int sl_ = (t) & 3; glds16(ksrc + (size_t)(t) * KVBLK * s.kp, (unsigned)__builtin_amdgcn_readfirstlane(kdst + sl_ * KSLOT)); \
        if (xw) glds16(k2src + (size_t)(t) * KVBLK * s.k2p, (unsigned)__builtin_amdgcn_readfirstlane(k2dst + sl_ * KSLOT)); } while (0)
#define ATT_DMA_V(t, vsl) glds16(vsrc + (size_t)(t) * KVBLK * s.vp, (unsigned)__builtin_amdgcn_readfirstlane(vdst + (vsl)))
    if (!MLA) {
        if (tid < 256) { const int sl = tid >> 6; *(LAS3 f32x4*)(shm + LDS_K + sl * KSLOT + 9 * 1024 + (tid & 63) * 16) = (f32x4){0.f, 0.f, 0.f, 0.f}; } }
    if (MLA) { ATT_DMA_K(0); ATT_DMA_V(0, 0); ATT_DMA_K(1); ATT_DMA_K(2); }
    const u16* Qw = s.q + (size_t)(q0 + wid * QBLK + r32) * s.qp + hi * 8;
    bf16x8 qr[NQR];
#pragma unroll
    for (int d0 = 0; d0 < 4; ++d0) qr[d0] = *reinterpret_cast<const bf16x8*>(Qw + d0 * 16);
    const lds_cptr qx0 = (lds_cptr)shm + LDS_QX + wid * 2048 + lane * 16;
    float mla_ref = 0.f;
    if (MLA) { const bf16x8 q4 = *reinterpret_cast<const bf16x8*>(Qw + 64), q5 = *reinterpret_cast<const bf16x8*>(Qw + 80);
        *(LAS3 bf16x8*)(shm + LDS_QX + wid * 2048 + lane * 16) = q4; *(LAS3 bf16x8*)(shm + LDS_QX + wid * 2048 + 1024 + lane * 16) = q5;
        if (FIX) { float nq = 0.f;
#pragma unroll
            for (int e = 0; e < 8; ++e) { const float a = __uint_as_float((unsigned)(unsigned short)q4[e] << 16), b = __uint_as_float((unsigned)(unsigned short)q5[e] << 16); nq += a * a + b * b; }
#pragma unroll
            for (int d0 = 0; d0 < 4; ++d0)
#pragma unroll
                for (int e = 0; e < 8; ++e) { const float a = __uint_as_float((unsigned)(unsigned short)qr[d0][e] << 16); nq += a * a; }
            nq += __shfl_xor(nq, 32); mla_ref = sqrtf(nq * kmax2); } }
    const short one = hi ? (short)0 : (short)0x3F80;
    if (!MLA) qr[NQR - 1] = (bf16x8){one, one, one, 0, 0, 0, 0, 0};
    int t0 = 0;
    if (!MLA) {
        const float qm = qmax_h[qb];
        const float bunit = sqrtf(qm * kmax2);
        const float thr = FIX ? bias_h[q0] - 152.f : bias_h[q0] - 170.f - 2.f * bunit;
        if (FIX) { const float nm_ = -(bias_h[q0 + wid * QBLK + r32] + bunit); const unsigned h_ = cvtpk_s(nm_, 0.f) & 0xffffu; const float r1_ = nm_ - __uint_as_float(h_ << 16); const unsigned m_ = cvtpk_s(r1_, 0.f) & 0xffffu;
            const float r2_ = r1_ - __uint_as_float(m_ << 16); const unsigned l_ = cvtpk_s(r2_, 0.f) & 0xffffu;
            if (hi == 0) qr[NQR - 1] = (bf16x8){one, one, one, (short)h_, (short)m_, (short)l_, 0, 0}; }
        int best = 0;
        for (int tt = 1 + lane; tt <= NT - 4; tt += 64) { if (bias_h[64 * tt - 1] < thr) best = tt; }
#pragma unroll
        for (int o_ = 32; o_ >= 1; o_ >>= 1) best = max(best, __shfl_xor(best, o_));
        t0 = __builtin_amdgcn_readfirstlane(best);
    }
    if (!MLA) { ATT_DMA_K(t0); ATT_DMA_V(t0, (t0 & 3) * VSLOT); ATT_DMA_K(t0 + 1); ATT_DMA_K(t0 + 2); }
    float mhat = 0.f, l_reg = 0.f; f32x16 o[2]; o[0] = f32x16{}; o[1] = f32x16{}; f32x16 negm = f32x16{};
    if (MLA && FIX) {
#pragma unroll
        for (int r = 0; r < 16; ++r) negm[r] = -mla_ref; }
    const int qrel = wid * QBLK + r32;
    lds_cptr kb[NDK];
#pragma unroll
    for (int d0 = 0; d0 < 4; ++d0) kb[d0] = (lds_cptr)shm + LDS_K + r32 * 128 + ((((2 * d0 + hi) ^ ((r32 >> 1) & 7))) << 4);
    if (MLA) {
#pragma unroll
        for (int d0 = 4; d0 < NDK; ++d0) kb[d0] = (lds_cptr)shm + LDS_K + 8192 + r32 * 64 + ((((2 * (d0 - 4) + hi) ^ ((r32 >> 2) & 3))) << 4);
    } else kb[NDK - 1] = (lds_cptr)shm + LDS_K + 8192 + hi * 1024 + r32 * 16;
    constexpr int XHS = MLA ? 2048 : 512;
    const lds_cptr vp0 = (lds_cptr)shm + LDS_V + ((lane >> 4) & 1) * 32 + (lane & 3) * 8 + (4 * hi + ((lane & 15) >> 2)) * 64;
    f32x16 C0, C1; u32x4 pw[4]; bool resc = false;
#define ATT_TOP(t) do { if ((t) == t0 || (t) + 2 >= NT) { ATT_WAIT_BAR(0); } else if (xw) { ATT_WAIT_BAR(3); } else { ATT_WAIT_BAR(2); } \
        } while (0)
#define ATT_ISSUE(t) do { if ((t) + 3 < NT) ATT_DMA_K((t) + 3); if ((t) + 1 < NT) ATT_DMA_V((t) + 1, (((t) + 1) & 3) * VSLOT); } while (0)
#ifdef ATT_QKPRIO
#define ATT_PRIO_ON() __builtin_amdgcn_s_setprio(1)
#define ATT_PRIO_OFF() __builtin_amdgcn_s_setprio(0)
#else
#define ATT_PRIO_ON()
#define ATT_PRIO_OFF()
#endif
#define ATT_QK(t, E) do { bf16x8 kf_[2 * NDK]; bf16x8 qx_[NDK > NQR ? NDK - NQR : 1]; \
        phase_a<NDK, NQR, !MLA, XHS, 0, 4, E>(C0, C1, ATT_KS(t), qr, qx0, negm, kf_, qx_); ATT_ISSUE(t); ATT_SBAR(); \
        phase_a<NDK, NQR, !MLA, XHS, 4, 2 * NDK, E>(C0, C1, ATT_KS(t), qr, qx0, negm, kf_, qx_); } while (0)
#define ATT_MASK(C0, C1, t) do { const int kbq_ = 64 * ((t) - (NT - 4)) + 4 * hi; \
        _Pragma("unroll") for (int r = 0; r < 16; ++r) { const int kv_ = kbq_ + (r & 3) + 8 * (r >> 2); if (kv_ > qrel) C0[r] = -INFINITY; if (kv_ + 32 > qrel) C1[r] = -INFINITY; } } while (0)
#define ATT_DECIDE(C0, C1, FIRST) do { if (!FIX) { \
        float a_ = fmaxf(fmaxf(C0[0], C0[1]), C1[0]), b_ = fmaxf(fmaxf(C0[2], C0[3]), C1[1]); a_ = fmaxf(fmaxf(a_, C1[2]), C1[3]); \
        _Pragma("unroll") for (int r = 4; r < 16; r += 4) { a_ = fmaxf(fmaxf(a_, C0[r]), C0[r + 1]); b_ = fmaxf(fmaxf(b_, C0[r + 2]), C0[r + 3]); a_ = fmaxf(fmaxf(a_, C1[r]), C1[r + 1]); b_ = fmaxf(fmaxf(b_, C1[r + 2]), C1[r + 3]); } \
        float rm_ = fmaxf(a_, b_); { auto rr_ = __builtin_amdgcn_permlane32_swap(__float_as_uint(rm_), __float_as_uint(rm_), false, false); rm_ = fmaxf(__uint_as_float(rr_[0]), __uint_as_float(rr_[1])); } \
        resc = false; \
        if ((FIRST) || __any(rm_ > THRL)) { float dl_ = (FIRST) ? rm_ : fmaxf(rm_, 0.f); \
            if (!MLA) { const float nm_ = -(mhat + dl_); const unsigned h_ = cvtpk_s(nm_, 0.f) & 0xffffu; const float r1_ = nm_ - __uint_as_float(h_ << 16); const unsigned m_ = cvtpk_s(r1_, 0.f) & 0xffffu; \
                const float r2_ = r1_ - __uint_as_float(m_ << 16); const unsigned l_ = cvtpk_s(r2_, 0.f) & 0xffffu; \
                const float mn_ = -((__uint_as_float(h_ << 16) + __uint_as_float(m_ << 16)) + __uint_as_float(l_ << 16)); dl_ = mn_ - mhat; mhat = mn_; \
                if (hi == 0) qr[NQR - 1] = (bf16x8){one, one, one, (short)h_, (short)m_, (short)l_, 0, 0}; } \
            else { mhat += dl_; _Pragma("unroll") for (int r = 0; r < 16; ++r) negm[r] = -mhat; } \
            _Pragma("unroll") for (int r = 0; r < 16; ++r) { C0[r] -= dl_; C1[r] -= dl_; } \
            if (!(FIRST)) { const float f_ = __builtin_amdgcn_exp2f(-dl_); l_reg *= f_; if (hi == 0) wsf[r32] = f_; resc = true; } } } } while (0)
#define ATT_RESC() do { if (!FIX && resc) { \
        _Pragma("unroll") for (int i = 0; i < 4; ++i) { const f32x4 fv_ = *(const LAS3 f32x4*)(wsf + 8 * i + 4 * hi); \
            _Pragma("unroll") for (int d = 0; d < 2; ++d) { o[d][4 * i] *= fv_[0]; o[d][4 * i + 1] *= fv_[1]; o[d][4 * i + 2] *= fv_[2]; o[d][4 * i + 3] *= fv_[3]; } } } } while (0)
#define ATT_VS(tt) (vp0 + (((tt)) & 3) * VSLOT)
#define ATT_KS(tt) kb, ((((tt)) & 3) * KSLOT)
#ifndef ATT_STAGGER
#define ATT_STAGGER 0
#endif
    if (!ATT_STAGGER || wid < 4) {
#define ATT_STEP(t, MASKED) do { ATT_TOP(t); \
        constexpr bool E_ = FIX && (MLA || !(MASKED)); \
        ATT_QK(t, E_); \
        if (!MLA && (MASKED)) ATT_MASK(C0, C1, t); \
        ATT_DECIDE(C0, C1, false); ATT_SBAR(); \
        phase_b<true, true, E_>(C0, C1, o, ATT_VS((t) - 1), pw, l_reg); \
        ATT_RESC(); } while (0)
        ATT_TOP(t0);
        ATT_QK(t0, false);
        if (!MLA && wvis == t0) ATT_MASK(C0, C1, t0);
        ATT_DECIDE(C0, C1, true); ATT_SBAR();
        phase_b<true, false, false>(C0, C1, o, vp0, pw, l_reg);
        int t = t0 + 1;
        for (; t < wvis; ++t) ATT_STEP(t, false);
        if (t == wvis) { ATT_STEP(t, true); ++t; }
        { ATT_TOP(t); ATT_ISSUE(t); phase_b<false, true, false>(C0, C1, o, ATT_VS(t - 1), pw, l_reg); ++t; }
        for (; t <= NT + ATT_STAGGER; ++t) { ATT_TOP(t); ATT_ISSUE(t); }
#undef ATT_STEP
    } else {
        ATT_TOP(t0);
        ATT_QK(t0, false);
        ATT_DECIDE(C0, C1, true); ATT_SBAR();
        ATT_TOP(t0 + 1);
        phase_b<true, false, false>(C0, C1, o, vp0, pw, l_reg); ATT_SBAR();
        ATT_QK(t0 + 1, false);
        ATT_DECIDE(C0, C1, false); ATT_SBAR();
        int t = t0 + 2;
#define ATT_STEP2(t, MASKED) do { ATT_TOP(t); \
        phase_b<true, true, false>(C0, C1, o, ATT_VS((t) - 2), pw, l_reg); \
        ATT_RESC(); ATT_SBAR(); \
        ATT_QK(t, false); \
        if (!MLA && (MASKED)) ATT_MASK(C0, C1, t); \
        ATT_DECIDE(C0, C1, false); ATT_SBAR(); } while (0)
        for (; t < wvis; ++t) ATT_STEP2(t, false);
        ATT_STEP2(t, true); ++t;
        { ATT_TOP(t); ATT_ISSUE(t); phase_b<true, true, false>(C0, C1, o, ATT_VS(t - 2), pw, l_reg); ATT_RESC(); ++t; }
        { ATT_TOP(t); ATT_ISSUE(t); phase_b<false, true, false>(C0, C1, o, ATT_VS(t - 2), pw, l_reg); ++t; }
        for (; t <= NT + ATT_STAGGER; ++t) { ATT_TOP(t); ATT_ISSUE(t); }
#undef ATT_STEP2
    }
    { auto rr = __builtin_amdgcn_permlane32_swap(__float_as_uint(l_reg), __float_as_uint(l_reg), false, false); l_reg = __uint_as_float(rr[0]) + __uint_as_float(rr[1]); }
    if (hi == 0) wsf[32 + r32] = 1.0f / l_reg;
    float rli[16];
#pragma unroll
    for (int i = 0; i < 4; ++i) { const f32x4 fv = *(const LAS3 f32x4*)(wsf + 32 + 8 * i + 4 * hi); rli[4 * i] = fv[0]; rli[4 * i + 1] = fv[1]; rli[4 * i + 2] = fv[2]; rli[4 * i + 3] = fv[3]; }
    u16* Ow = s.o + (size_t)(q0 + wid * QBLK) * s.op;
    { LAS3 u16* stg = (LAS3 u16*)(shm + LDS_OST) + wid * 2048;
#pragma unroll
        for (int r = 0; r < 16; ++r) { const int orow = crow(r, hi);
#pragma unroll
            for (int d0 = 0; d0 < 2; ++d0) stg[orow * 64 + d0 * 32 + r32] = (u16)(cvtpk_s(o[d0][r] * rli[r], 0.f) & 0xffffu); }
        asm volatile("s_waitcnt lgkmcnt(0)" ::: "memory");
#pragma unroll
        for (int i = 0; i < 4; ++i) { const int row = i * 8 + (lane >> 3), ch = lane & 7; const u32x4 v = *(const LAS3 u32x4*)(stg + row * 64 + ch * 8); *(u32x4*)(Ow + (size_t)row * s.op + ch * 8) = v; } }
    asm volatile("s_waitcnt lgkmcnt(0)\n\ts_barrier" ::: "memory");
#undef ATT_DMA_K
#undef ATT_DMA_V
#undef ATT_TOP
#undef ATT_ISSUE
#undef ATT_QK
#undef ATT_MASK
#undef ATT_DECIDE
#undef ATT_RESC
#undef ATT_STEP
}
}

namespace cg = cooperative_groups;
#define LAS __attribute__((address_space(3)))
typedef unsigned short bf16;
typedef unsigned v4u __attribute__((ext_vector_type(4)));
typedef unsigned v2u __attribute__((ext_vector_type(2)));
typedef float f32x4 __attribute__((ext_vector_type(4)));
constexpr int NWAVES = 8;
constexpr int M = 16384, D = 1024, FF = 4096, NIN = 1960, NINP = 2048, QL = 256, KVL = 128, NQU = 768, NKVU = 1024;
constexpr float EPS = 1e-6f;
constexpr float LOG2E = 1.4426950408889634f;
constexpr float C2_FOX = 0.125f * LOG2E, C2_MLA = 0.10206207261596575f * LOG2E;
constexpr size_t MiB = 1u << 20;
constexpr size_t WS_WIN = 1 * MiB, WS_WQ = 5 * MiB, WS_WKV = 5 * MiB + 512 * 1024, WS_WO = 6 * MiB, WS_W1 = 8 * MiB, WS_W2 = 16 * MiB;
constexpr size_t WS_RT = 24 * MiB, WS_LF = 26 * MiB, WS_LC = 26 * MiB + 512 * 1024, WS_SS = 27 * MiB, WS_KR = 28 * MiB, WS_KB = 29 * MiB, WS_SSQ = 31 * MiB, WS_SSKV = 31 * MiB + 512 * 1024, WS_BIASF = 28 * MiB;
constexpr size_t WS_XN = 32 * MiB, WS_H = 64 * MiB, WS_P = 64 * MiB, WS_QM = 128 * MiB, WS_KVM = 152 * MiB, WS_QN = 184 * MiB, WS_O = 192 * MiB, WS_KVN = 224 * MiB, WS_END = 228 * MiB;
constexpr int RING_BYTES = 131072, LDS_BYTES = 147456;
static_assert(att::LDS_BYTES <= LDS_BYTES, "attention scratch fits the LDS allocation");

__device__ __forceinline__ unsigned f2bf(float f) { unsigned u = __builtin_bit_cast(unsigned, f); return (u + 0x7fffu + ((u >> 16) & 1u)) >> 16; }
__device__ __forceinline__ unsigned pk2(float lo, float hi) { return f2bf(lo) | (f2bf(hi) << 16); }
__device__ __forceinline__ float bf2f(unsigned short h) { return __builtin_bit_cast(float, (unsigned)h << 16); }
__device__ __forceinline__ float wave_sum(float v) {
#pragma unroll
    for (int o = 1; o < 64; o <<= 1) v += __shfl_xor(v, o);
    return v;
}
__device__ __forceinline__ int map_row(int mode, int n) {
    if (mode == 1) { const int h = n / 96, d = n % 96; if (d < 64) return n; const int i = d - 64; return h * 96 + (i < 16 ? 64 + 2 * i : 64 + 2 * (i - 16) + 1); }
    if (mode == 2) { const int h = n >> 7, j = n & 127; return j < 64 ? h * 64 + j : 512 + h * 64 + (j - 64); }
    if (mode == 3) { if (n < 1536 || n >= 1960) return n; if (n < 1544) return 1952 + (n - 1536); if (n < 1800) return 1536 + (n - 1544); if (n < 1928) return 1792 + (n - 1800);
        const int i = n - 1928; return 1920 + (i < 16 ? 2 * i : 2 * (i - 16) + 1); }
    return n;
}
__device__ __forceinline__ void p0_transpose_item(const float* W, int K, int N, int nblk, bf16* WT, int mode, const float* gk, LAS float* scr, int item, int lane) {
    const int kb = item / nblk, nb = item % nblk, k0 = 64 * kb, n0 = 32 * nb;
    const int nn = n0 + (lane & 31);
    float wv[32];
#pragma unroll
    for (int i = 0; i < 32; ++i) { const int kk = 2 * i + (lane >> 5); wv[i] = (nn < N) ? W[(size_t)(k0 + kk) * N + nn] : 0.f; }
    if (gk) {
#pragma unroll
        for (int i = 0; i < 32; ++i) wv[i] *= gk[k0 + 2 * i + (lane >> 5)]; }
#pragma unroll
    for (int i = 0; i < 32; ++i) { const int kk = 2 * i + (lane >> 5); scr[kk * 33 + (lane & 31)] = wv[i]; }
    asm volatile("s_waitcnt lgkmcnt(0)" ::: "memory");
    const int c = lane & 7;
#pragma unroll
    for (int j = 0; j < 4; ++j) { const int n = (lane >> 3) + 8 * j; const LAS float* sp = scr + (8 * c) * 33 + n;
        v4u o; o.x = pk2(sp[0 * 33], sp[1 * 33]); o.y = pk2(sp[2 * 33], sp[3 * 33]); o.z = pk2(sp[4 * 33], sp[5 * 33]); o.w = pk2(sp[6 * 33], sp[7 * 33]);
        *(v4u*)(WT + (size_t)map_row(mode, n0 + n) * K + k0 + 8 * c) = o; }
    asm volatile("s_waitcnt lgkmcnt(0)" ::: "memory");
}
__device__ __forceinline__ void sincos_d(double x, float& sn, float& cs) {
    const double k = rint(x * 0.63661977236758134308);
    double r = fma(-k, 1.57079632679489655800e+00, x); r = fma(-k, 6.12323399573676603587e-17, r);
    const double r2 = r * r;
    double s = -1.0 / 6227020800.0; s = s * r2 + 1.0 / 39916800.0; s = s * r2 - 1.0 / 362880.0; s = s * r2 + 1.0 / 5040.0; s = s * r2 - 1.0 / 120.0; s = s * r2 + 1.0 / 6.0; s = r - r * r2 * s;
    double c = 1.0 / 479001600.0; c = c * r2 - 1.0 / 3628800.0; c = c * r2 + 1.0 / 40320.0; c = c * r2 - 1.0 / 720.0; c = c * r2 + 1.0 / 24.0; c = c * r2 - 0.5; c = 1.0 + r2 * c;
    const int q = ((int)k) & 3;
    const double ss = (q == 0) ? s : (q == 1) ? c : (q == 2) ? -s : -c;
    const double cc = (q == 0) ? c : (q == 1) ? -s : (q == 2) ? -c : s;
    sn = (float)ss; cs = (float)cc;
}

#define RLX_AGENT __ATOMIC_RELAXED, __HIP_MEMORY_SCOPE_AGENT
#define XB_TMO      128
#define XB_XCNT(j)  (256  + 64 * (j))
#define XB_XSUB(j)  (1280 + 64 * (j))
#define XB_XGEN(j)  (2304 + 64 * (j))
#define XB_TOP      3328
#define XB_TOPGEN   3392
#define XCD_BAR_WORDS 3456
#define XB_SPIN_CAP (1u << 18)

__device__ __forceinline__ unsigned xb_ld(unsigned* p)              { return __hip_atomic_load(p, __ATOMIC_RELAXED, __HIP_MEMORY_SCOPE_AGENT); }
__device__ __forceinline__ unsigned xb_add(unsigned* p, unsigned v) { return __hip_atomic_fetch_add(p, v, __ATOMIC_RELAXED, __HIP_MEMORY_SCOPE_AGENT); }
__device__ __forceinline__ unsigned xb_xcc_id() { return (unsigned)__builtin_amdgcn_s_getreg((3 << 11) | 20) & 0xFu; }
#define XB_SPIN(cond, bar) do { unsigned _sp = 0; while (cond) { __builtin_amdgcn_s_sleep(1); \
    if ((++_sp & 255u) == 0u) { if (xb_ld(&(bar)[XB_TMO])) break; if (_sp > XB_SPIN_CAP) { atomicAdd(&(bar)[XB_TMO], 1u); break; } } } } while (0)

struct XcdBarrier {
    unsigned* bar; unsigned x;
    volatile LAS unsigned* st;
};

__device__ __forceinline__ XcdBarrier xcd_barrier_post(unsigned* bar, volatile LAS unsigned* st) {
    XcdBarrier b; b.bar = bar; b.x = xb_xcc_id(); b.st = st;
    if (threadIdx.x == 0) (void)xb_add(&bar[XB_XCNT(b.x)], 1u);
    return b;
}
__device__ __forceinline__ void xcd_barrier_complete(unsigned* bar, unsigned x, unsigned& nloc, unsigned& nx) {
    const unsigned G = gridDim.x * gridDim.y * gridDim.z;
    unsigned sum, cnt, mine, sp = 0u;
    for (;;) {
        sum = 0u; cnt = 0u; mine = 0u;
#pragma unroll
        for (unsigned j = 0; j < 16; ++j) { const unsigned c = xb_ld(&bar[XB_XCNT(j)]); sum += c; cnt += (c > 0u) ? 1u : 0u; mine = (j == x) ? c : mine; }
        if (sum == G) break;
        __builtin_amdgcn_s_sleep(1);
        if ((++sp & 255u) == 0u) { if (xb_ld(&bar[XB_TMO])) break; if (sp > XB_SPIN_CAP) { atomicAdd(&bar[XB_TMO], 1u); break; } }
    }
    nloc = mine > 0u ? mine : 1u; nx = cnt > 0u ? cnt : 1u;
}

__device__ __forceinline__ void xcd_barrier(const XcdBarrier& b) {
    asm volatile("s_waitcnt vmcnt(0)" ::: "memory");
    __syncthreads();
    if (threadIdx.x == 0) {
        unsigned* bar = b.bar;
        __builtin_amdgcn_s_waitcnt(0);
        unsigned nloc = b.st[0], nx = b.st[1];
        if (nloc == 0u) { xcd_barrier_complete(bar, b.x, nloc, nx); b.st[0] = nloc; b.st[1] = nx; }
        const unsigned old = xb_add(&bar[XB_XSUB(b.x)], 1u);
        const unsigned gen = old / nloc;
        if (old + 1u == (gen + 1u) * nloc) {
            __builtin_amdgcn_fence(__ATOMIC_RELEASE, "agent");
            asm volatile("s_waitcnt vmcnt(0)" ::: "memory");
            const unsigned og = xb_add(&bar[XB_TOP], 1u);
            const unsigned tg = og / nx;
            if (og + 1u == (tg + 1u) * nx) xb_add(&bar[XB_TOPGEN], 1u);
            else XB_SPIN(xb_ld(&bar[XB_TOPGEN]) == tg, bar);
            __builtin_amdgcn_fence(__ATOMIC_ACQUIRE, "agent");
            xb_add(&bar[XB_XGEN(b.x)], 1u);
            asm volatile("s_waitcnt vmcnt(0)" ::: "memory");
        } else {
            XB_SPIN(xb_ld(&bar[XB_XGEN(b.x)]) == gen, bar);
            __builtin_amdgcn_fence(__ATOMIC_ACQUIRE, "agent");
            asm volatile("s_waitcnt vmcnt(0)" ::: "memory");
        }
    }
    __syncthreads();
}

constexpr int MISC_OFF = LDS_BYTES - 128;
constexpr size_t WS_CTL = 0, CTL_ZERO_BYTES = 64 * 1024;
constexpr int CW_KMAX = 8192, CW_QF = 8192 + 512, CW_QM = 8192 + 1024, CW_PCNT = 8192 + 1536, CW_KMAXM = 13824, CW_QMAXM = 14400, CW_DONE = 14464;
static_assert(att::LDS_BYTES <= MISC_OFF, "LDS map");
struct Args { const float* in[13]; float* out; unsigned char* ws; int ph_lo, ph_hi, dup, pad; };
constexpr int NPHASE = 8;

__global__ void __launch_bounds__(NWAVES * 64, 2) mk_fwd(Args args) {
    extern __shared__ __attribute__((aligned(16))) unsigned char lds_raw[];
    LAS unsigned char* lds = (LAS unsigned char*)lds_raw;
    const int G = gridDim.x, bx = blockIdx.x;
#define MK_IDS int tid = threadIdx.x; asm volatile("" : "+v"(tid)); const int lane = tid & 63, wave = __builtin_amdgcn_readfirstlane(tid >> 6); const int gw = vcu * NWAVES + wave; (void)gw; (void)lane;
    const int vcu = (G % 8 == 0) ? (bx % 8) * (G / 8) + bx / 8 : bx;
    const int NGW = G * NWAVES;
    unsigned char* ws = args.ws;
#define MKP_x ((const float*)args.in[0])
#define MKP_g_mix ((const float*)args.in[1])
#define MKP_w_in ((const float*)args.in[2])
#define MKP_b_f ((const float*)args.in[3])
#define MKP_g_q ((const float*)args.in[4])
#define MKP_w_q_up ((const float*)args.in[5])
#define MKP_g_kv ((const float*)args.in[6])
#define MKP_w_kv_up ((const float*)args.in[7])
#define MKP_w_o ((const float*)args.in[8])
#define MKP_g_mlp ((const float*)args.in[9])
#define MKP_w_ff1 ((const float*)args.in[10])
#define MKP_w_ff2 ((const float*)args.in[11])
#define MKP_g_final ((const float*)args.in[12])
#define MKP_out (args.out)
#define MKP_Win_t ((bf16*)(args.ws + WS_WIN))
#define MKP_Wq_t ((bf16*)(args.ws + WS_WQ))
#define MKP_Wkv_t ((bf16*)(args.ws + WS_WKV))
#define MKP_Wo_t ((bf16*)(args.ws + WS_WO))
#define MKP_W1_t ((bf16*)(args.ws + WS_W1))
#define MKP_W2_t ((bf16*)(args.ws + WS_W2))
#define MKP_RT ((float*)(args.ws + WS_RT))
#define MKP_LF ((float*)(args.ws + WS_LF))
#define MKP_SS ((float*)(args.ws + WS_SS))
#define MKP_SSQ ((float*)(args.ws + WS_SSQ))
#define MKP_BIASF ((float*)(args.ws + WS_BIASF))
#define MKP_QMAX ((float*)(args.ws + WS_LC))
#define MKP_SSKV ((float*)(args.ws + WS_SSKV))
#define MKP_KB ((bf16*)(args.ws + WS_KB))
#define MKP_KR ((bf16*)(args.ws + WS_KR))
#define MKP_XN ((bf16*)(args.ws + WS_XN))
#define MKP_HB ((bf16*)(args.ws + WS_H))
#define MKP_P ((bf16*)(args.ws + WS_P))
#define MKP_QM ((bf16*)(args.ws + WS_QM))
#define MKP_KVM ((bf16*)(args.ws + WS_KVM))
#define MKP_QN ((bf16*)(args.ws + WS_QN))
#define MKP_OB ((bf16*)(args.ws + WS_O))
#define MKP_KVN ((bf16*)(args.ws + WS_KVN))
    const int lo = args.ph_lo, hi = args.ph_hi;
#ifndef MK_MASK
#define MK_MASK 0x1ff
#endif
#define IN(k) (((MK_MASK >> (k)) & 1) && lo <= (k) && (k) < hi)
#define REP(k) for (int rep_ = 0; rep_ < ((args.dup == (k)) ? 2 : 1); ++rep_)
    { volatile LAS unsigned* misc = (volatile LAS unsigned*)(lds + MISC_OFF); if (threadIdx.x < 32) misc[threadIdx.x] = 0u; }
    __syncthreads();
    (void)xcd_barrier_post((unsigned*)(ws + WS_CTL), (volatile LAS unsigned*)(lds + MISC_OFF) + 8);
    if (args.ph_lo < 0) cg::this_grid().sync();
#ifdef TS_PHASE
    unsigned long long ts_a_ = 0, ts_b_ = 0;
#define TS_BEGIN(k) do { if ((k) == TS_PHASE || (TS_PHASE == 99 && (k) == 0)) ts_a_ = __builtin_amdgcn_s_memrealtime(); } while (0)
#define TS_END(k) do { if ((k) == TS_PHASE || (TS_PHASE == 99 && (k) == 7)) ts_b_ = __builtin_amdgcn_s_memrealtime(); } while (0)
#else
#define TS_BEGIN(k)
#define TS_END(k)
#endif
#define SEAM(k) do { if (IN(k) && IN((k) + 1)) { XcdBarrier b_; b_.bar = (unsigned*)(args.ws + WS_CTL); b_.x = xb_xcc_id(); b_.st = (volatile LAS unsigned*)(lds + MISC_OFF) + 8; xcd_barrier(b_); } } while (0)

    TS_BEGIN(0);
    if (IN(0)) { MK_IDS
        LAS float* scr = (LAS float*)(lds + wave * 16384);
        constexpr int I_IN = (D / 64) * (NINP / 32), I_Q = (QL / 64) * (NQU / 32), I_KV = (KVL / 64) * (NKVU / 32), I_O = (D / 64) * (D / 32), I_1 = (D / 64) * (FF / 32), I_2 = (FF / 64) * (D / 32);
        constexpr int NITEMS = I_IN + I_Q + I_KV;
        (void)I_O; (void)I_1; (void)I_2;
        for (int it = gw; it < NITEMS; it += NGW) {
            int r = it;
            if (r < I_IN) { p0_transpose_item(MKP_w_in, D, NIN, NINP / 32, MKP_Win_t, 3, nullptr, scr, r, lane); continue; } r -= I_IN;
            if (r < I_Q) { p0_transpose_item(MKP_w_q_up, QL, NQU, NQU / 32, MKP_Wq_t, 1, MKP_g_q, scr, r, lane); continue; } r -= I_Q;
            p0_transpose_item(MKP_w_kv_up, KVL, NKVU, NKVU / 32, MKP_Wkv_t, 2, MKP_g_kv, scr, r, lane);
        }
        for (int m0 = gw; m0 < M; m0 += 4 * NGW) {
            const f32x4* gr = (const f32x4*)MKP_g_mix + lane; f32x4 v[4][4]; float s2[4];
#pragma unroll
            for (int r = 0; r < 4; ++r) { const int m = m0 + r * NGW; const f32x4* xr = (const f32x4*)(MKP_x + (size_t)(m < M ? m : 0) * D) + lane;
#pragma unroll
                for (int j = 0; j < 4; ++j) v[r][j] = xr[64 * j]; }
#pragma unroll
            for (int r = 0; r < 4; ++r) { s2[r] = 0.f;
#pragma unroll
                for (int j = 0; j < 4; ++j) s2[r] += (v[r][j].x * v[r][j].x + v[r][j].y * v[r][j].y) + (v[r][j].z * v[r][j].z + v[r][j].w * v[r][j].w);
                s2[r] = 1.f / sqrtf(wave_sum(s2[r]) * (1.f / D) + EPS); }
#pragma unroll
            for (int r = 0; r < 4; ++r) { const int m = m0 + r * NGW; if (m < M) { unsigned long long* o8 = (unsigned long long*)(MKP_XN + (size_t)m * D) + lane; const float rstd = s2[r];
#pragma unroll
                for (int j = 0; j < 4; ++j) { const f32x4 g = gr[64 * j]; o8[64 * j] = (unsigned long long)pk2(v[r][j].x * rstd * g.x, v[r][j].y * rstd * g.y) | ((unsigned long long)pk2(v[r][j].z * rstd * g.z, v[r][j].w * rstd * g.w) << 32); } } }
        }
        for (int e = (vcu * NWAVES * 64 + tid); e < M * 16; e += G * NWAVES * 64) {
            const int m = e >> 4, i = e & 15; double inv = 1.0; for (int j = 0; j < i; ++j) inv *= 0.56234132519034908039;
            float sn, cs; sincos_d((double)m * inv, sn, cs); MKP_RT[2 * e] = cs; MKP_RT[2 * e + 1] = sn;
        }
    }
    SEAM(0);
    TS_END(0);
    TS_BEGIN(1);
    if (IN(1)) {
        pg8::Gemm g{MKP_XN, MKP_Win_t, M, NINP, D}; pg8::StaticOrder S; S.init(M, NINP, G, bx);
        pg8::EpiIn E{MKP_P, NINP, C2_FOX, MKP_SSQ, MKP_SSKV, MKP_RT, MKP_b_f, MKP_LF, M};
        pg8::gemm_phase<pg8::EpiIn, pg8::StaticOrder, PG8_ALIGN, PG8_SP2>(lds, g, S, E);
    }
    SEAM(1);
    TS_END(1);
    TS_BEGIN(3);
    if (IN(3)) { MK_IDS
        if (wave >= 2) {
            LAS float* scr = (LAS float*)(lds + wave * 16384);
            constexpr int J_O = (D / 64) * (D / 32), J_1 = (D / 64) * (FF / 32), J_2 = (FF / 64) * (D / 32);
            for (int it = vcu * 6 + (wave - 2); it < J_O + J_1 + J_2; it += G * 6) {
                int r = it;
                if (r < J_O) { p0_transpose_item(MKP_w_o, D, D, D / 32, MKP_Wo_t, 0, nullptr, scr, r, lane); continue; } r -= J_O;
                if (r < J_1) { p0_transpose_item(MKP_w_ff1, D, FF, FF / 32, MKP_W1_t, 0, MKP_g_mlp, scr, r, lane); continue; } r -= J_1;
                p0_transpose_item(MKP_w_ff2, FF, D, D / 32, MKP_W2_t, 0, nullptr, scr, r, lane);
            }
        }
        if (wave < 2) { const int job = bx + 256 * wave;
            if (job < 512 && bx < 256) { const int h = job >> 6, ti = job & 63; const f32x4* lf4 = (const f32x4*)(MKP_LF + (size_t)h * M);
                float pre = 0.f; { int j = 0; float pa[8] = {0.f, 0.f, 0.f, 0.f, 0.f, 0.f, 0.f, 0.f};
                    for (; j + 8 <= ti; j += 8) { f32x4 w[8];
#pragma unroll
                        for (int u = 0; u < 8; ++u) w[u] = lf4[(j + u) * 64 + lane];
#pragma unroll
                        for (int u = 0; u < 8; ++u) pa[u] += (w[u].x + w[u].y) + (w[u].z + w[u].w); }
                    for (; j < ti; ++j) { const f32x4 w = lf4[j * 64 + lane]; pa[0] += (w.x + w.y) + (w.z + w.w); }
                    pre = ((pa[0] + pa[1]) + (pa[2] + pa[3])) + ((pa[4] + pa[5]) + (pa[6] + pa[7])); }
                pre = wave_sum(pre);
                const f32x4 v = lf4[ti * 64 + lane];
                const float s1 = v.x, s2 = s1 + v.y, s3 = s2 + v.z, s4 = s3 + v.w; float inc = s4;
#pragma unroll
                for (int o = 1; o < 64; o <<= 1) { const float n = __shfl_up(inc, o); if (lane >= o) inc += n; }
                const float ex = pre + (inc - s4); const float cs[4] = {ex + s1, ex + s2, ex + s3, ex + s4};
                *(f32x4*)(MKP_BIASF + (size_t)h * M + ti * 256 + 4 * lane) = (f32x4){-cs[0] * LOG2E, -cs[1] * LOG2E, -cs[2] * LOG2E, -cs[3] * LOG2E};
                { float km = 0.f;
                  float qmx = 0.f;
                  for (int e = 0; e < 4; ++e) { const v4u* kr = (const v4u*)(MKP_P + (size_t)(ti * 256 + 4 * lane + e) * NINP + 512 + h * 64); float a2 = 0.f; const v4u* qrw = kr - 64; float q2 = 0.f;
#pragma unroll
                      for (int c8 = 0; c8 < 8; ++c8) { const v4u w = qrw[c8]; const unsigned ww[4] = {w.x, w.y, w.z, w.w};
#pragma unroll
                          for (int q4 = 0; q4 < 4; ++q4) { const float lo_ = __builtin_bit_cast(float, ww[q4] << 16), hi_ = __builtin_bit_cast(float, ww[q4] & 0xffff0000u); q2 += lo_ * lo_ + hi_ * hi_; } }
                      qmx = fmaxf(qmx, q2);
#pragma unroll
                      for (int c8 = 0; c8 < 8; ++c8) { const v4u w = kr[c8]; const unsigned ww[4] = {w.x, w.y, w.z, w.w};
#pragma unroll
                          for (int q4 = 0; q4 < 4; ++q4) { const float lo_ = __builtin_bit_cast(float, ww[q4] << 16), hi_ = __builtin_bit_cast(float, ww[q4] & 0xffff0000u); a2 += lo_ * lo_ + hi_ * hi_; } }
                      km = fmaxf(km, a2); }
#pragma unroll
                  for (int o = 32; o >= 1; o >>= 1) km = fmaxf(km, __shfl_xor(km, o));
#pragma unroll
                  for (int o = 32; o >= 1; o >>= 1) qmx = fmaxf(qmx, __shfl_xor(qmx, o));
                  if (lane == 0) { atomicMax((unsigned*)(args.ws + WS_CTL) + CW_KMAX + 64 * h, __builtin_bit_cast(unsigned, km)); MKP_QMAX[h * 64 + ti] = qmx; } }
#pragma unroll
                for (int e = 0; e < 4; ++e) { const float b = -cs[e] * LOG2E; const unsigned bh = f2bf(b); const float r1 = b - __builtin_bit_cast(float, bh << 16); const unsigned bm = f2bf(r1);
                    const float r2 = r1 - __builtin_bit_cast(float, bm << 16); const unsigned bl = f2bf(r2);
                    *(v4u*)(MKP_KB + ((size_t)h * M + ti * 256 + 4 * lane + e) * 8) = (v4u){bh | (bm << 16), bl | 0x3F800000u, 0x3F803F80u, 0u}; } } }
        __syncthreads();
        { int kq = QL; asm volatile("" : "+s"(kq)); pg8::Gemm g{MKP_P + 1536, MKP_Wq_t, M, NQU, kq, NINP}; pg8::StaticOrder S; S.init(M, NQU, G, bx);
          pg8::EpiQm E{MKP_QM, NQU, MKP_RT, C2_MLA, MKP_SSQ, EPS};
          pg8::gemm_phase<pg8::EpiQm, pg8::StaticOrder, PG8_ALIGN, PG8_SP2>(lds, g, S, E); }
        { int kkv = KVL; asm volatile("" : "+s"(kkv)); pg8::Gemm g{MKP_P + 1792, MKP_Wkv_t, M, NKVU, kkv, NINP}; pg8::StaticOrder S; S.init(M, NKVU, G, bx);
          pg8::EpiKv E{MKP_KVM, NKVU, MKP_SSKV, EPS};
          pg8::gemm_phase<pg8::EpiKv, pg8::StaticOrder, PG8_ALIGN, PG8_SP2>(lds, g, S, E); }
    }
    SEAM(3);
    TS_END(3);
    TS_BEGIN(4);
    if (IN(4)) {
        const int v = (G == 256) ? vcu : bx; const int h0 = (v >> 5) & 7;
        volatile LAS unsigned* misc = (volatile LAS unsigned*)(lds + MISC_OFF);
        unsigned* ctlw = (unsigned*)(args.ws + WS_CTL);
        { const int tid_ = threadIdx.x, lane_ = tid_ & 63, tok = bx * 64 + (tid_ >> 3), hh = tid_ & 7; float k2 = 0.f, q2 = 0.f;
          if (bx < 256) {
            const v4u* kp = (const v4u*)(MKP_KVM + (size_t)tok * NKVU + hh * 64); const v4u* rp = (const v4u*)(MKP_P + (size_t)tok * NINP + 1920); const v4u* qp = (const v4u*)(MKP_QM + (size_t)tok * NQU + hh * 96);
#define MK_SQ(w_, acc_) do { const unsigned ww_[4] = {w_.x, w_.y, w_.z, w_.w}; _Pragma("unroll") for (int q4_ = 0; q4_ < 4; ++q4_) { const float lo_ = __builtin_bit_cast(float, ww_[q4_] << 16), hi_ = __builtin_bit_cast(float, ww_[q4_] & 0xffff0000u); acc_ += lo_ * lo_ + hi_ * hi_; } } while (0)
#pragma unroll
            for (int c8 = 0; c8 < 8; ++c8) { const v4u w = kp[c8]; MK_SQ(w, k2); }
#pragma unroll
            for (int c8 = 0; c8 < 4; ++c8) { const v4u w = rp[c8]; MK_SQ(w, k2); }
#pragma unroll
            for (int c8 = 0; c8 < 12; ++c8) { const v4u w = qp[c8]; MK_SQ(w, q2); }
#undef MK_SQ
          }
#pragma unroll
          for (int o = 8; o <= 32; o <<= 1) { k2 = fmaxf(k2, __shfl_xor(k2, o)); q2 = fmaxf(q2, __shfl_xor(q2, o)); }
          if (lane_ < 8) { atomicMax(ctlw + CW_KMAXM + 64 * lane_, __builtin_bit_cast(unsigned, k2)); atomicMax(ctlw + CW_QMAXM, __builtin_bit_cast(unsigned, q2)); }
          asm volatile("s_waitcnt vmcnt(0)" ::: "memory"); __syncthreads();
          if (tid_ == 0) __hip_atomic_fetch_add(ctlw + CW_DONE, 1u, __ATOMIC_RELAXED, __HIP_MEMORY_SCOPE_AGENT); }
        bool okF = true;
        { const int lane_ = threadIdx.x & 63;
          for (int h = 0; h < 8; ++h) { const float kF = __builtin_bit_cast(float, __hip_atomic_load(ctlw + CW_KMAX + 64 * h, __ATOMIC_RELAXED, __HIP_MEMORY_SCOPE_AGENT));
              float qF = MKP_QMAX[h * 64 + lane_];
#pragma unroll
              for (int o = 32; o >= 1; o >>= 1) qF = fmaxf(qF, __shfl_xor(qF, o));
              okF = okF && (qF * kF < 2025.f); }
          okF = __builtin_amdgcn_readfirstlane(okF ? 1 : 0) != 0; }
#ifndef PROBE_FOX
#define PROBE_FOX 1
#endif
#ifndef PROBE_MLA
#define PROBE_MLA 1
#endif
#define MK_POP(CWQ) \
            if ((threadIdx.x >> 6) == 0) { const int ln_ = threadIdx.x & 63; unsigned i_ = 0xFFFFFFFFu; int hs_ = h0; \
                if (own) { if (ln_ == 0) i_ = __hip_atomic_fetch_add(ctlw + (CWQ) + 64 * h0 + 16 * rep, 1u, __ATOMIC_RELAXED, __HIP_MEMORY_SCOPE_AGENT); i_ = (unsigned)__builtin_amdgcn_readfirstlane((int)i_); } \
                if (!own || i_ >= 64u) { unsigned c_ = 64u; if (ln_ < 8) c_ = __hip_atomic_load(ctlw + (CWQ) + 64 * ((h0 + ln_) & 7) + 16 * rep, __ATOMIC_RELAXED, __HIP_MEMORY_SCOPE_AGENT); \
                    const unsigned long long m_ = __ballot(c_ < 64u); i_ = 0xFFFFFFFFu; \
                    if (m_ != 0ull) { hs_ = (h0 + (int)__builtin_ctzll(m_)) & 7; if (ln_ == 0) i_ = __hip_atomic_fetch_add(ctlw + (CWQ) + 64 * hs_ + 16 * rep, 1u, __ATOMIC_RELAXED, __HIP_MEMORY_SCOPE_AGENT); \
                        i_ = (unsigned)__builtin_amdgcn_readfirstlane((int)i_); if (i_ >= 64u) i_ = 0xFFFFFFFEu; } } \
                if (ln_ == 0) { misc[0] = i_; misc[1] = (unsigned)hs_; } } \
            __syncthreads(); const unsigned i = misc[0]; const int h = (int)misc[1]; __syncthreads(); \
            if (h != h0 || i >= 64u) own = false; \
            if (i == 0xFFFFFFFFu) break; \
            if (i >= 64u) continue;
#define MK_FOX_LOOPS(FIXV) do { \
        for (int rep = 0; rep < PROBE_FOX; ++rep) { bool own = true; \
        for (;;) { MK_POP(CW_QF) \
            const float kmax2 = __builtin_bit_cast(float, __hip_atomic_load(ctlw + CW_KMAX + 64 * h, __ATOMIC_RELAXED, __HIP_MEMORY_SCOPE_AGENT)); \
            att::Src s{MKP_P + h * 64, NINP, MKP_P + 512 + h * 64, NINP, MKP_KB + (size_t)h * M * 8, 8, MKP_P + 1024 + h * 64, NINP, MKP_OB + h * 64, D}; \
            att::attn_unit<false, FIXV>(63 - (int)i, s, lds, MKP_BIASF + (size_t)h * M, kmax2, MKP_QMAX + h * 64); \
        } } } while (0)
#define MK_MLA_LOOPS(FIXV) do { \
        for (int rep = 0; rep < PROBE_MLA; ++rep) { bool own = true; \
        for (;;) { MK_POP(CW_QM) \
            const float kmaxm = __builtin_bit_cast(float, __hip_atomic_load(ctlw + CW_KMAXM + 64 * h, __ATOMIC_RELAXED, __HIP_MEMORY_SCOPE_AGENT)); \
            att::Src s{MKP_QM + h * 96, NQU, MKP_KVM + h * 64, NKVU, MKP_P + 1920, NINP, MKP_KVM + 512 + h * 64, NKVU, MKP_OB + 512 + h * 64, D}; \
            att::attn_unit<true, FIXV>(63 - (int)i, s, lds, nullptr, kmaxm, nullptr); \
        } } } while (0)
        if (okF) MK_FOX_LOOPS(true); else MK_FOX_LOOPS(false);
        asm volatile("" ::: "memory");
        if (threadIdx.x == 0) { unsigned sp = 0; while (__hip_atomic_load(ctlw + CW_DONE, __ATOMIC_RELAXED, __HIP_MEMORY_SCOPE_AGENT) < (unsigned)G) { __builtin_amdgcn_s_sleep(2); if (++sp > (1u << 22)) break; } }
        __syncthreads();
        bool okM = true;
        { const float qmM = __builtin_bit_cast(float, __hip_atomic_load(ctlw + CW_QMAXM, __ATOMIC_RELAXED, __HIP_MEMORY_SCOPE_AGENT));
          for (int h = 0; h < 8; ++h) { const float kM = __builtin_bit_cast(float, __hip_atomic_load(ctlw + CW_KMAXM + 64 * h, __ATOMIC_RELAXED, __HIP_MEMORY_SCOPE_AGENT)); okM = okM && (qmM * kM < 2025.f); }
          okM = __builtin_amdgcn_readfirstlane(okM ? 1 : 0) != 0; }
        if (okM) MK_MLA_LOOPS(true); else MK_MLA_LOOPS(false);
#undef MK_FOX_LOOPS
#undef MK_MLA_LOOPS
#undef MK_POP
    }
#ifdef ATT_PRIO
    __builtin_amdgcn_s_setprio(0);
#endif
    SEAM(4);
    TS_END(4);
    TS_BEGIN(5);
    if (IN(5)) {
        pg8::Gemm g{MKP_OB, MKP_Wo_t, M, D, D}; pg8::StaticOrder S; S.init(M, D, G, bx);
        pg8::EpiRes E{MKP_x, MKP_out, D, MKP_XN, MKP_SS};
        pg8::gemm_phase<pg8::EpiRes, pg8::StaticOrder, PG8_ALIGN, PG8_SP2>(lds, g, S, E);
    }
    SEAM(5);
    TS_END(5);
    TS_BEGIN(6);
    if (IN(6)) {
        pg8::Gemm g{MKP_XN, MKP_W1_t, M, FF, D}; int pflag = 1; asm volatile("" : "+s"(pflag)); pg8::StaticOrder S; S.init(M, D, G, bx, pflag);
        pg8::EpiSqRelu E{MKP_HB, FF, MKP_SS, EPS, 1.f / D};
        pg8::gemm_phase<pg8::EpiSqRelu, pg8::StaticOrder, PG8_ALIGN, PG8_SP2>(lds, g, S, E);
    }
    SEAM(6);
    TS_END(6);
    TS_BEGIN(7);
    if (IN(7)) {
        pg8::Gemm g{MKP_HB, MKP_W2_t, M, D, FF}; pg8::StaticOrder S; S.init(M, D, G, bx);
        pg8::EpiResNorm E{MKP_out, MKP_out, D, MKP_g_final, MKP_SSQ, (unsigned*)(args.ws + WS_CTL) + CW_PCNT, EPS, 1.f / D};
        pg8::gemm_phase<pg8::EpiResNorm, pg8::StaticOrder, false, PG8_SP2>(lds, g, S, E);
    }
#ifdef TS_PHASE
    { XcdBarrier b_; b_.bar = (unsigned*)(args.ws + WS_CTL); b_.x = xb_xcc_id(); b_.st = (volatile LAS unsigned*)(lds + MISC_OFF) + 8; xcd_barrier(b_); }
    TS_END(7);
    if (blockIdx.x == 0 && threadIdx.x == 0) MKP_out[0] = (float)(((ts_b_ - ts_a_) / TS_Q) * (TS_Q / 100ull));
#endif
#undef IN
#undef SEAM
#undef MKP_x
#undef MKP_g_mix
#undef MKP_w_in
#undef MKP_b_f
#undef MKP_g_q
#undef MKP_w_q_up
#undef MKP_g_kv
#undef MKP_w_kv_up
#undef MKP_w_o
#undef MKP_g_mlp
#undef MKP_w_ff1
#undef MKP_w_ff2
#undef MKP_g_final
#undef MKP_out
#undef MKP_Win_t
#undef MKP_Wq_t
#undef MKP_Wkv_t
#undef MKP_Wo_t
#undef MKP_W1_t
#undef MKP_W2_t
#undef MKP_RT
#undef MKP_LF
#undef MKP_SS
#undef MKP_SSQ
#undef MKP_BIASF
#undef MKP_QMAX
#undef MKP_SSKV
#undef MKP_KB
#undef MKP_KR
#undef MKP_XN
#undef MKP_HB
#undef MKP_P
#undef MKP_QM
#undef MKP_KVM
#undef MKP_QN
#undef MKP_OB
#undef MKP_KVN
}

#ifndef MK_ONE_LAUNCH
#define MK_ONE_LAUNCH 1
#endif
extern "C" void kernel_launch(void* const* d_in, const int* in_sizes, int n_in, void* d_out, int out_size, void* d_ws, size_t ws_size, hipStream_t stream) {
    static int ready = 0;
    if (ready == 0) {
        if (n_in != 13 || in_sizes[0] != M * D || out_size != M * D || ws_size < WS_END) { fprintf(stderr, "kernel_launch: unexpected shapes (n_in %d, in0 %d, out %d, ws %zu)\n", n_in, n_in > 0 ? in_sizes[0] : -1, out_size, ws_size); ready = -1; return; }
        if (hipFuncSetAttribute((const void*)mk_fwd, hipFuncAttributeMaxDynamicSharedMemorySize, LDS_BYTES) != hipSuccess) { fprintf(stderr, "kernel_launch: hipFuncSetAttribute failed\n"); ready = -1; return; }
        ready = 1;
    }
    if (ready < 0) return;
    if (hipMemsetAsync((char*)d_ws + WS_CTL, 0, CTL_ZERO_BYTES, stream) != hipSuccess) { fprintf(stderr, "kernel_launch: hipMemsetAsync failed\n"); return; }
    Args a{};
    for (int i = 0; i < 13; ++i) a.in[i] = (const float*)d_in[i];
    a.out = (float*)d_out; a.ws = (unsigned char*)d_ws;
#ifndef MK_DUP
#define MK_DUP -1
#endif
    a.dup = MK_DUP;
    const int grid = 256;
#if MK_ONE_LAUNCH
    a.ph_lo = 0; a.ph_hi = NPHASE;
    void* kargs[] = {&a};
    hipError_t e = hipLaunchCooperativeKernel((const void*)mk_fwd, dim3(grid), dim3(NWAVES * 64), kargs, LDS_BYTES, stream);
    if (e != hipSuccess) fprintf(stderr, "kernel_launch: cooperative launch failed: %s\n", hipGetErrorString(e));
#else
    for (int p = 0; p < NPHASE; ++p) { a.ph_lo = p; a.ph_hi = p + 1; hipLaunchKernelGGL(mk_fwd, dim3(grid), dim3(NWAVES * 64), LDS_BYTES, stream, a); }
#endif
}
```

```cpp
#include <hip/hip_runtime.h>
#include <hip/hip_cooperative_groups.h>
#include <hip/hip_bf16.h>
#include <cstdio>
#include <cstdint>
#include <cmath>
namespace pg8 {
#define PG8_LAS __attribute__((address_space(3)))
typedef unsigned short bf16_t;
typedef short bf16x8 __attribute__((ext_vector_type(8)));
typedef float f32x4 __attribute__((ext_vector_type(4)));
typedef unsigned u32x4 __attribute__((ext_vector_type(4)));
constexpr int BM = 256, BK = 64, HALF = 128, HTB = HALF * BK * 2  , STAGE_BYTES = 8 * HTB, NXCD = 8, WGM = 8;

__host__ __device__ __forceinline__ int lds_byte(int r, int c) { const int st = (r >> 4) * 2 + (c >> 5), rr = r & 15, cc = c & 31, ob = rr * 64 + cc * 2; return st * 1024 + (ob ^ (((ob >> 9) & 1) << 5)); }
__host__ __device__ __forceinline__ void stage_rc(int b, int& R, int& C) { const int st = b / 1024, sb = b % 1024, swz = sb ^ (((sb >> 9) & 1) << 5); R = (st >> 1) * 16 + swz / 64; C = (st & 1) * 32 + (swz % 64) / 2; }
__host__ __device__ __forceinline__ int perm32(int rho) { const int n = rho >> 4, i = rho & 15; return 8 * (i >> 2) + 4 * n + (i & 3); }

struct Unit { int pm, pn; };
struct Gemm { const bf16_t* A; const bf16_t* Bt; int M, N, K; int lda; };

struct StaticOrder {
    int nM, nN, nwg, G, c, panel;
    __host__ __device__ __forceinline__ void init(int M, int N, int G_, int c_, int panel_ = 0) { nM = M / BM; nN = N / BM; nwg = nM * nN; G = G_; c = c_; panel = panel_; }
    __host__ __device__ __forceinline__ bool next(int i, Unit& u) const {
        if (panel) { if (i >= 4) return false; base(0, u); u.pn = 4 * u.pn + i; return true; }
        return base(i, u);
    }
    __host__ __device__ __forceinline__ bool base(int i, Unit& u) const {
        const long L = (long)i * G + c; if (L >= nwg) return false;
        int wgid = (int)L; { const int q = nwg / NXCD, r = nwg % NXCD, xcd = wgid % NXCD, off = wgid / NXCD; wgid = (xcd < r ? xcd * (q + 1) : r * (q + 1) + (xcd - r) * q) + off; }
        const int nig = WGM * nN, gid = wgid / nig, fm = gid * WGM, gsz = (nM - fm) < WGM ? (nM - fm) : WGM;
        u.pm = fm + ((wgid % nig) % gsz); u.pn = (wgid % nig) / gsz; return true;
    }
    __device__ __forceinline__ void a_ready(const Unit&) const {}
    __device__ __forceinline__ void done(const Unit&) const {}
};

__device__ __forceinline__ unsigned cvt_pk_bf16(float lo, float hi) { unsigned r; asm volatile("v_cvt_pk_bf16_f32 %0, %1, %2" : "=v"(r) : "v"(lo), "v"(hi)); return r; }
typedef float f32x2 __attribute__((ext_vector_type(2)));
__device__ __forceinline__ f32x2 gelu_pk(f32x2 v) {
    const f32x2 av = __builtin_elementwise_abs(v), d = av * 0.2316418882f + 1.0f;
    f32x2 t; t.x = __builtin_amdgcn_rcpf(d.x); t.y = __builtin_amdgcn_rcpf(d.y);
    f32x2 q = t * 0.5307027145f + (-0.7265760135f); q = q * t + 0.7107068705f; q = q * t + (-0.142248368f); q = q * t + 0.127414796f; q = q * t;
    const f32x2 s = (v * v) * (-0.72134752044f);
    f32x2 e; e.x = __builtin_amdgcn_exp2f(s.x); e.y = __builtin_amdgcn_exp2f(s.y);
    const f32x2 m = v * (q * e), r = v - m;
    f32x2 o; o.x = v.x < 0.f ? m.x : r.x; o.y = v.y < 0.f ? m.y : r.y; return o;
}

template <int ACT  > struct EpiBf16 {
    static constexpr bool PERM = true, AFTER_DRAIN = false; static_assert(ACT == 0 || ACT == 1, "EpiBf16: ACT is 0 (none) or 1 (gelu_pk)");
    bf16_t* O; int ldc; const float* bias; int split_cols; size_t split_stride; float scale0;
    __device__ __forceinline__ void operator()(const f32x4 (&acc)[2][2][4][2], const Unit& u, int wr, int wc, int fr, int fq) const {
        const int row0 = u.pm * BM + wr * 64 + fr; int colt = u.pn * BM; bf16_t* base = O;
        float sc = 1.f; if (split_cols) { const int t = colt / split_cols; base += (size_t)t * split_stride; colt -= t * split_cols; if (t == 0) sc = scale0; }
        const int col0 = colt + wc * 32 + 8 * fq, bcol0 = u.pn * BM + wc * 32 + 8 * fq;
        f32x4 bv[2][2];
#pragma unroll
        for (int bj = 0; bj < 2; ++bj)
#pragma unroll
            for (int n = 0; n < 2; ++n) bv[bj][n] = bias ? *(const f32x4*)(bias + bcol0 + bj * HALF + 4 * n) : (f32x4){0.f, 0.f, 0.f, 0.f};
#pragma unroll
        for (int ai = 0; ai < 2; ++ai)
#pragma unroll
            for (int m = 0; m < 4; ++m) { bf16_t* rowp = base + (size_t)(row0 + ai * HALF + m * 16) * ldc + col0;
#pragma unroll
                for (int bj = 0; bj < 2; ++bj) { f32x4 v0 = acc[ai][bj][m][0] + bv[bj][0], v1 = acc[ai][bj][m][1] + bv[bj][1];
                    if (ACT == 1) { f32x2 a = gelu_pk((f32x2){v0[0], v0[1]}), b = gelu_pk((f32x2){v0[2], v0[3]}), c = gelu_pk((f32x2){v1[0], v1[1]}), d = gelu_pk((f32x2){v1[2], v1[3]});
                        v0 = (f32x4){a.x, a.y, b.x, b.y}; v1 = (f32x4){c.x, c.y, d.x, d.y}; }
                    v0 = v0 * sc; v1 = v1 * sc; u32x4 w; w.x = cvt_pk_bf16(v0[0], v0[1]); w.y = cvt_pk_bf16(v0[2], v0[3]); w.z = cvt_pk_bf16(v1[0], v1[1]); w.w = cvt_pk_bf16(v1[2], v1[3]);
                    *(u32x4*)(rowp + bj * HALF) = w; } }
    }
};

struct EpiQm {
    static constexpr bool PERM = true, AFTER_DRAIN = false;
    bf16_t* O; int ldc; const float* rt; float scale; const float* ssq; float eps;
    __device__ __forceinline__ void operator()(const f32x4 (&acc)[2][2][4][2], const Unit& u, int wr, int wc, int fr, int fq) const {
        const int row0 = u.pm * BM + wr * 64 + fr, col0 = u.pn * BM + wc * 32 + 8 * fq;
#pragma unroll
        for (int ai = 0; ai < 2; ++ai)
#pragma unroll
            for (int m = 0; m < 4; ++m) { const int row = row0 + ai * HALF + m * 16;
                const f32x4 sq = *(const f32x4*)(ssq + (size_t)row * 4); const float rs = scale / sqrtf(((sq[0] + sq[1]) + (sq[2] + sq[3])) * (1.0f / 256.0f) + eps);
#pragma unroll
                for (int bj = 0; bj < 2; ++bj) { const int c = col0 + bj * HALF, d = c % 96;
                    f32x4 v0 = acc[ai][bj][m][0], v1 = acc[ai][bj][m][1];
                    if (d >= 64) { const f32x4* t = (const f32x4*)(rt + (size_t)row * 32 + (d - 64)); const f32x4 t0 = t[0], t1 = t[1];
                        f32x4 w0, w1;
                        w0[0] = v0[0] * t0[0] - v0[1] * t0[1]; w0[1] = v0[1] * t0[0] + v0[0] * t0[1];
                        w0[2] = v0[2] * t0[2] - v0[3] * t0[3]; w0[3] = v0[3] * t0[2] + v0[2] * t0[3];
                        w1[0] = v1[0] * t1[0] - v1[1] * t1[1]; w1[1] = v1[1] * t1[0] + v1[0] * t1[1];
                        w1[2] = v1[2] * t1[2] - v1[3] * t1[3]; w1[3] = v1[3] * t1[2] + v1[2] * t1[3];
                        v0 = w0; v1 = w1; }
                    v0 = v0 * rs; v1 = v1 * rs; u32x4 w; w.x = cvt_pk_bf16(v0[0], v0[1]); w.y = cvt_pk_bf16(v0[2], v0[3]); w.z = cvt_pk_bf16(v1[0], v1[1]); w.w = cvt_pk_bf16(v1[2], v1[3]);
                    *(u32x4*)(O + (size_t)row * ldc + c) = w; }
                asm volatile("" ::: "memory"); }
    }
};

struct EpiKv {
    static constexpr bool PERM = true, AFTER_DRAIN = false;
    bf16_t* O; int ldc; const float* ssq; float eps;
    __device__ __forceinline__ void operator()(const f32x4 (&acc)[2][2][4][2], const Unit& u, int wr, int wc, int fr, int fq) const {
        const int row0 = u.pm * BM + wr * 64 + fr, col0 = u.pn * BM + wc * 32 + 8 * fq;
#pragma unroll
        for (int ai = 0; ai < 2; ++ai)
#pragma unroll
            for (int m = 0; m < 4; ++m) { const int row = row0 + ai * HALF + m * 16;
                const f32x4 sq = *(const f32x4*)(ssq + (size_t)row * 4); const float rs = 1.0f / sqrtf(((sq[0] + sq[1]) + (sq[2] + sq[3])) * (1.0f / 128.0f) + eps);
#pragma unroll
                for (int bj = 0; bj < 2; ++bj) { const f32x4 v0 = acc[ai][bj][m][0] * rs, v1 = acc[ai][bj][m][1] * rs;
                    u32x4 w; w.x = cvt_pk_bf16(v0[0], v0[1]); w.y = cvt_pk_bf16(v0[2], v0[3]); w.z = cvt_pk_bf16(v1[0], v1[1]); w.w = cvt_pk_bf16(v1[2], v1[3]);
                    *(u32x4*)(O + (size_t)row * ldc + col0 + bj * HALF) = w; }
                asm volatile("" ::: "memory"); }
    }
};
struct EpiIn {
    static constexpr bool PERM = true, AFTER_DRAIN = false;
    bf16_t* O; int ldc; float scale0; float* ssq; float* sskv; const float* rt; const float* bf; float* lf; int nrows;
    __device__ __forceinline__ void operator()(const f32x4 (&acc)[2][2][4][2], const Unit& u, int wr, int wc, int fr, int fq) const {
        const int row0 = u.pm * BM + wr * 64 + fr, col0 = u.pn * BM + wc * 32 + 8 * fq; const int pn = u.pn;
        const float sc = pn < 2 ? scale0 : 1.f;
#pragma unroll
        for (int ai = 0; ai < 2; ++ai)
#pragma unroll
            for (int m = 0; m < 4; ++m) { const int row = row0 + ai * HALF + m * 16; bf16_t* rowp = O + (size_t)row * ldc + col0; float s0 = 0.f, s1 = 0.f;
#pragma unroll
                for (int bj = 0; bj < 2; ++bj) { f32x4 v0 = acc[ai][bj][m][0] * sc, v1 = acc[ai][bj][m][1] * sc;
                    const float sq = ((v0[0] * v0[0] + v0[1] * v0[1]) + (v0[2] * v0[2] + v0[3] * v0[3])) + ((v1[0] * v1[0] + v1[1] * v1[1]) + (v1[2] * v1[2] + v1[3] * v1[3]));
                    if (bj == 0) s0 = sq; else s1 = sq;
                    bool store = true;
                    if (pn == 7 && bj == 1) { store = (wc == 0);
                        if (wc == 0) { const f32x4* t = (const f32x4*)(rt + (size_t)row * 32 + 8 * fq); const f32x4 t0 = t[0], t1 = t[1]; f32x4 w0, w1;
                            w0[0] = v0[0] * t0[0] - v0[1] * t0[1]; w0[1] = v0[1] * t0[0] + v0[0] * t0[1];
                            w0[2] = v0[2] * t0[2] - v0[3] * t0[3]; w0[3] = v0[3] * t0[2] + v0[2] * t0[3];
                            w1[0] = v1[0] * t1[0] - v1[1] * t1[1]; w1[1] = v1[1] * t1[0] + v1[0] * t1[1];
                            w1[2] = v1[2] * t1[2] - v1[3] * t1[3]; w1[3] = v1[3] * t1[2] + v1[2] * t1[3];
                            v0 = w0; v1 = w1; }
                        else if (wc == 1 && fq == 0) {
#pragma unroll
                            for (int e = 0; e < 8; ++e) { const float z = (e < 4 ? v0[e & 3] : v1[e & 3]) + bf[e]; lf[(size_t)e * nrows + row] = fminf(z, 0.f) - 0.6931471805599453f * __builtin_amdgcn_logf(1.0f + __builtin_amdgcn_exp2f(-1.4426950408889634f * fabsf(z))); } } }
                    if (store) { u32x4 w; w.x = cvt_pk_bf16(v0[0], v0[1]); w.y = cvt_pk_bf16(v0[2], v0[3]); w.z = cvt_pk_bf16(v1[0], v1[1]); w.w = cvt_pk_bf16(v1[2], v1[3]);
                        *(u32x4*)(rowp + bj * HALF) = w; } }
                if (pn == 6) { float s = s0 + s1; s += __shfl_xor(s, 16); s += __shfl_xor(s, 32); if (fq == 0) ssq[(size_t)row * 4 + wc] = s; }
                if (pn == 7) { float s = s0; s += __shfl_xor(s, 16); s += __shfl_xor(s, 32); if (fq == 0) sskv[(size_t)row * 4 + wc] = s; }
                asm volatile("" ::: "memory"); }
    }
};
struct EpiRes {
    static constexpr bool PERM = false, AFTER_DRAIN = false;
    const float* base; float* out; int ldc; bf16_t* ob; float* ss;
    __device__ __forceinline__ void operator()(const f32x4 (&acc)[2][2][4][2], const Unit& u, int wr, int wc, int fr, int fq) const {
        typedef unsigned u32x2v __attribute__((ext_vector_type(2)));
        const int row0 = u.pm * BM + wr * 64 + fr, col0 = u.pn * BM + wc * 32 + 4 * fq;
        f32x4 cb[2][2], nb[2][2];
        { const size_t off = (size_t)row0 * ldc + col0;
#pragma unroll
          for (int bj = 0; bj < 2; ++bj)
#pragma unroll
              for (int n = 0; n < 2; ++n) cb[bj][n] = __builtin_nontemporal_load((const f32x4*)(base + off + bj * HALF + n * 16)); }
#pragma unroll
        for (int g = 0; g < 8; ++g) { const int ai = g >> 2, m = g & 3; const int row = row0 + ai * HALF + m * 16; const size_t off = (size_t)row * ldc + col0; float s = 0.f;
            if (g + 1 < 8) { const int ai1 = (g + 1) >> 2, m1 = (g + 1) & 3; const size_t off1 = (size_t)(row0 + ai1 * HALF + m1 * 16) * ldc + col0;
#pragma unroll
                for (int bj = 0; bj < 2; ++bj)
#pragma unroll
                    for (int n = 0; n < 2; ++n) nb[bj][n] = __builtin_nontemporal_load((const f32x4*)(base + off1 + bj * HALF + n * 16)); }
            asm volatile("" ::: "memory");
#pragma unroll
            for (int bj = 0; bj < 2; ++bj)
#pragma unroll
                for (int n = 0; n < 2; ++n) { const f32x4 v = cb[bj][n] + acc[ai][bj][m][n];
                    *(f32x4*)(out + off + bj * HALF + n * 16) = v; s += (v[0] * v[0] + v[1] * v[1]) + (v[2] * v[2] + v[3] * v[3]);
                    if (ob) { u32x2v w; w.x = cvt_pk_bf16(v[0], v[1]); w.y = cvt_pk_bf16(v[2], v[3]); *(u32x2v*)(ob + off + bj * HALF + n * 16) = w; } }
            if (ss) { s += __shfl_xor(s, 16); s += __shfl_xor(s, 32); if (fq == 0) ss[(size_t)row * 16 + u.pn * 4 + wc] = s; }
#pragma unroll
            for (int bj = 0; bj < 2; ++bj)
#pragma unroll
                for (int n = 0; n < 2; ++n) cb[bj][n] = nb[bj][n];
        }
    }
};

struct EpiResNorm {
    static constexpr bool PERM = false, AFTER_DRAIN = true;
    const float* base; float* out; int ldc; const float* g; float* xs; unsigned* cnt; float eps; float inv_n;
    __device__ __forceinline__ void fused(f32x4 (&acc)[2][2][4][2], const Unit& u, int wr, int wc, int fr, int fq, PG8_LAS unsigned char* lds, int wid, int lane) const {
        PG8_LAS float* Pm = (PG8_LAS float*)lds;
        PG8_LAS float* S = (PG8_LAS float*)(lds + 4096);
        const int row0 = u.pm * BM + wr * 64 + fr, col0 = u.pn * BM + wc * 32 + 4 * fq;
        f32x4 cb[2][2], nb[2][2];
        { const size_t off = (size_t)row0 * ldc + col0;
#pragma unroll
          for (int bj = 0; bj < 2; ++bj)
#pragma unroll
              for (int n = 0; n < 2; ++n) cb[bj][n] = __builtin_nontemporal_load((const f32x4*)(base + off + bj * HALF + n * 16)); }
#pragma unroll
        for (int g = 0; g < 8; ++g) { const int ai = g >> 2, m = g & 3; float s = 0.f;
            if (g + 1 < 8) { const size_t off1 = (size_t)(row0 + ((g + 1) >> 2) * HALF + ((g + 1) & 3) * 16) * ldc + col0;
#pragma unroll
                for (int bj = 0; bj < 2; ++bj)
#pragma unroll
                    for (int n = 0; n < 2; ++n) nb[bj][n] = __builtin_nontemporal_load((const f32x4*)(base + off1 + bj * HALF + n * 16)); }
            asm volatile("" ::: "memory");
#pragma unroll
            for (int bj = 0; bj < 2; ++bj)
#pragma unroll
                for (int n = 0; n < 2; ++n) { const f32x4 v = cb[bj][n] + acc[ai][bj][m][n]; acc[ai][bj][m][n] = v;
                    s += (v[0] * v[0] + v[1] * v[1]) + (v[2] * v[2] + v[3] * v[3]); }
            s += __shfl_xor(s, 16); s += __shfl_xor(s, 32);
            if (fq == 0) Pm[(ai * HALF + wr * 64 + m * 16 + fr) * 4 + wc] = s;
#pragma unroll
            for (int bj = 0; bj < 2; ++bj)
#pragma unroll
                for (int n = 0; n < 2; ++n) cb[bj][n] = nb[bj][n]; }
        asm volatile("s_waitcnt lgkmcnt(0)" ::: "memory"); __builtin_amdgcn_s_barrier(); asm volatile("" ::: "memory");
        const int tid = wid * 64 + lane;
        if (tid < 256) { const f32x4 p4 = *(const PG8_LAS f32x4*)(Pm + tid * 4);
            __hip_atomic_store(xs + (size_t)(u.pm * BM + tid) * 4 + u.pn, (p4[0] + p4[1]) + (p4[2] + p4[3]), __ATOMIC_RELAXED, __HIP_MEMORY_SCOPE_AGENT);
            asm volatile("s_waitcnt vmcnt(0)" ::: "memory");
            if (lane == 0) __hip_atomic_fetch_add(cnt + 64 * u.pm, 1u, __ATOMIC_RELAXED, __HIP_MEMORY_SCOPE_AGENT); }
        if (wid == 0) { unsigned sp = 0;
            while ((unsigned)__builtin_amdgcn_readfirstlane(__hip_atomic_load(cnt + 64 * u.pm, __ATOMIC_RELAXED, __HIP_MEMORY_SCOPE_AGENT)) < 16u) { __builtin_amdgcn_s_sleep(2); if (++sp > (1u << 22)) break; }
            __builtin_amdgcn_fence(__ATOMIC_ACQUIRE, "agent"); }
        asm volatile("s_waitcnt vmcnt(0) lgkmcnt(0)" ::: "memory"); __builtin_amdgcn_s_barrier(); asm volatile("" ::: "memory");
        if (tid < 256) { const float* xp = xs + (size_t)(u.pm * BM + tid) * 4;
            const float t0 = __hip_atomic_load(xp + 0, __ATOMIC_RELAXED, __HIP_MEMORY_SCOPE_AGENT), t1 = __hip_atomic_load(xp + 1, __ATOMIC_RELAXED, __HIP_MEMORY_SCOPE_AGENT);
            const float t2 = __hip_atomic_load(xp + 2, __ATOMIC_RELAXED, __HIP_MEMORY_SCOPE_AGENT), t3 = __hip_atomic_load(xp + 3, __ATOMIC_RELAXED, __HIP_MEMORY_SCOPE_AGENT);
            S[tid] = 1.0f / sqrtf(((t0 + t1) + (t2 + t3)) * inv_n + eps); }
        asm volatile("s_waitcnt vmcnt(0) lgkmcnt(0)" ::: "memory"); __builtin_amdgcn_s_barrier(); asm volatile("" ::: "memory");
        f32x4 gv[2][2];
#pragma unroll
        for (int bj = 0; bj < 2; ++bj)
#pragma unroll
            for (int n = 0; n < 2; ++n) gv[bj][n] = *(const f32x4*)(g + col0 + bj * HALF + n * 16);
#pragma unroll
        for (int ai = 0; ai < 2; ++ai)
#pragma unroll
            for (int m = 0; m < 4; ++m) { const int r = ai * HALF + wr * 64 + m * 16 + fr; const float rs = S[r]; const size_t off = (size_t)(u.pm * BM + r) * ldc + col0;
#pragma unroll
                for (int bj = 0; bj < 2; ++bj)
#pragma unroll
                    for (int n = 0; n < 2; ++n) *(f32x4*)(out + off + bj * HALF + n * 16) = acc[ai][bj][m][n] * rs * gv[bj][n]; }
    }
};
struct EpiSqRelu {
    static constexpr bool PERM = true, AFTER_DRAIN = false;
    bf16_t* O; int ldc; const float* ss; float eps; float inv_n;
    __device__ __forceinline__ void operator()(const f32x4 (&acc)[2][2][4][2], const Unit& u, int wr, int wc, int fr, int fq) const {
        const int row0 = u.pm * BM + wr * 64 + fr, col0 = u.pn * BM + wc * 32 + 8 * fq;
        f32x4 cs[4], ns[4];
        { const f32x4* sp = (const f32x4*)(ss + (size_t)row0 * 16); cs[0] = sp[0]; cs[1] = sp[1]; cs[2] = sp[2]; cs[3] = sp[3]; }
#pragma unroll
        for (int g = 0; g < 8; ++g) { const int ai = g >> 2, m = g & 3; const int row = row0 + ai * HALF + m * 16;
            if (g + 1 < 8) { const f32x4* sp = (const f32x4*)(ss + (size_t)(row0 + ((g + 1) >> 2) * HALF + ((g + 1) & 3) * 16) * 16); ns[0] = sp[0]; ns[1] = sp[1]; ns[2] = sp[2]; ns[3] = sp[3]; }
            asm volatile("" ::: "memory");
            const f32x4 a = cs[0], b = cs[1], c = cs[2], d = cs[3];
            const float tot = ((a[0] + a[1]) + (a[2] + a[3])) + ((b[0] + b[1]) + (b[2] + b[3])) + ((c[0] + c[1]) + (c[2] + c[3])) + ((d[0] + d[1]) + (d[2] + d[3]));
            const float rstd = 1.0f / sqrtf(tot * inv_n + eps);
#pragma unroll
            for (int bj = 0; bj < 2; ++bj) { f32x4 v0 = acc[ai][bj][m][0] * rstd, v1 = acc[ai][bj][m][1] * rstd;
#pragma unroll
                for (int e = 0; e < 4; ++e) { const float x0 = fmaxf(v0[e], 0.f), x1 = fmaxf(v1[e], 0.f); v0[e] = x0 * x0; v1[e] = x1 * x1; }
                u32x4 w; w.x = cvt_pk_bf16(v0[0], v0[1]); w.y = cvt_pk_bf16(v0[2], v0[3]); w.z = cvt_pk_bf16(v1[0], v1[1]); w.w = cvt_pk_bf16(v1[2], v1[3]);
                *(u32x4*)(O + (size_t)row * ldc + col0 + bj * HALF) = w; }
            cs[0] = ns[0]; cs[1] = ns[1]; cs[2] = ns[2]; cs[3] = ns[3]; }
    }
};


template <class Epi, class Sched, bool ALIGN_EPI = false, bool SP2 = false>
__device__ __forceinline__ void gemm_phase(PG8_LAS unsigned char* lds, const Gemm g, const Sched& S, const Epi& E) {
    const int tid = threadIdx.x, wid = __builtin_amdgcn_readfirstlane(tid >> 6), lane = tid & 63, wr = wid >> 2, wc = wid & 3, fr = lane & 15, fq = lane >> 4;
    const int K = g.K, nt = K / BK, lda = g.lda ? g.lda : g.K;
    unsigned voffA[2], voffB[2];
#pragma unroll
    for (int i = 0; i < 2; ++i) { int R, C; stage_rc(tid * 16 + i * 8192, R, C); const int Rb = Epi::PERM ? ((R & ~31) + perm32(R & 31)) : R;
        voffA[i] = (unsigned)(R * lda + C) * 2u; voffB[i] = (unsigned)(Rb * K + C) * 2u; }
    const size_t kstep = (size_t)(BK * 2);
    const size_t hstep = (size_t)HALF * K * 2;
    const size_t tstep = 2 * hstep;
    const size_t hstepA = (size_t)HALF * lda * 2, tstepA = 2 * hstepA;
    const unsigned ldsw = (unsigned)wid * 1024u;
    const int aoff = lds_byte(wr * 64 + fr, fq * 8), boff = lds_byte(wc * 32 + fr, fq * 8);
#define PG8_SA(b, h) (((b) * 2 + (h)) * HTB)
#define PG8_SB(b, h) ((4 + (b) * 2 + (h)) * HTB)
#define PG8_STAGE(bufoff, gbase, voff) do { _Pragma("unroll") for (int _i = 0; _i < 2; ++_i) \
        __builtin_amdgcn_global_load_lds((const unsigned*)((const char*)(gbase) + (voff)[_i]), (PG8_LAS unsigned*)(lds + (bufoff) + ldsw + _i * 8192), 16, 0, 0); } while (0)
#define PG8_LDA(dst, b, h) do { _Pragma("unroll") for (int m = 0; m < 4; ++m) _Pragma("unroll") for (int k = 0; k < 2; ++k) dst[m][k] = *(const PG8_LAS bf16x8*)(lds + PG8_SA(b, h) + aoff + m * 2048 + k * 1024); } while (0)
#define PG8_LDB(dst, b, h) do { _Pragma("unroll") for (int n = 0; n < 2; ++n) _Pragma("unroll") for (int k = 0; k < 2; ++k) dst[n][k] = *(const PG8_LAS bf16x8*)(lds + PG8_SB(b, h) + boff + n * 2048 + k * 1024); } while (0)
#define PG8_MMA(ai, bj, At, Bt) do { __builtin_amdgcn_s_setprio(1); _Pragma("unroll") for (int m = 0; m < 4; ++m) _Pragma("unroll") for (int n = 0; n < 2; ++n) _Pragma("unroll") for (int k = 0; k < 2; ++k) \
        acc[ai][bj][m][n] = __builtin_amdgcn_mfma_f32_16x16x32_bf16(Bt[n][k], At[m][k], acc[ai][bj][m][n], 0, 0, 0); __builtin_amdgcn_s_setprio(0); } while (0)
#define PG8_WAIT_V(n) asm volatile("s_waitcnt vmcnt(" #n ")" ::: "memory")
#define PG8_WAIT_L(n) asm volatile("s_waitcnt lgkmcnt(" #n ")" ::: "memory")
#define PG8_BAR __builtin_amdgcn_s_barrier()
#define PG8_SCHED __builtin_amdgcn_sched_barrier(0)
    Unit cur, nxt; int ui = 0;
    if (!S.next(0, cur)) return;
    f32x4 acc[2][2][4][2];
#pragma unroll
    for (int a = 0; a < 2; ++a)
#pragma unroll
        for (int b = 0; b < 2; ++b)
#pragma unroll
            for (int m = 0; m < 4; ++m)
#pragma unroll
                for (int n = 0; n < 2; ++n) acc[a][b][m][n] = (f32x4){0.f, 0.f, 0.f, 0.f};
    bf16x8 At[4][2], B0[2][2], B1[2][2];
    const char* cA = (const char*)g.A + (size_t)cur.pm * tstepA; const char* cB = (const char*)g.Bt + (size_t)cur.pn * tstep;
    S.a_ready(cur);
    if constexpr (SP2) {
        PG8_STAGE(PG8_SB(0, 0), cB, voffB); PG8_STAGE(PG8_SB(0, 1), cB + hstep, voffB); PG8_STAGE(PG8_SA(0, 0), cA, voffA); PG8_STAGE(PG8_SA(0, 1), cA + hstepA, voffA);
        if (wr == 1) PG8_BAR;
        PG8_WAIT_V(2); PG8_BAR;
        PG8_STAGE(PG8_SB(1, 0), cB + kstep, voffB); PG8_STAGE(PG8_SA(1, 0), cA + kstep, voffA); PG8_STAGE(PG8_SB(1, 1), cB + hstep + kstep, voffB);
        PG8_WAIT_V(6); PG8_BAR;
    } else {
        PG8_STAGE(PG8_SB(0, 0), cB, voffB); PG8_STAGE(PG8_SA(0, 0), cA, voffA); PG8_STAGE(PG8_SB(0, 1), cB + hstep, voffB); PG8_STAGE(PG8_SA(0, 1), cA + hstepA, voffA);
        if (wr == 1) PG8_BAR;
        PG8_WAIT_V(4); PG8_BAR;
        PG8_STAGE(PG8_SB(1, 0), cB + kstep, voffB); PG8_STAGE(PG8_SA(1, 0), cA + kstep, voffA); PG8_STAGE(PG8_SB(1, 1), cB + hstep + kstep, voffB);
        PG8_WAIT_V(6); PG8_BAR;
    }
    for (;;) {
        const bool has_next = S.next(ui + 1, nxt);
        const char* nA = has_next ? (const char*)g.A + (size_t)nxt.pm * tstepA : cA; const char* nB = has_next ? (const char*)g.Bt + (size_t)nxt.pn * tstep : cB;
        for (int t = 0; t < nt; t += 2) {
            const bool last = (t == nt - 2);
            const char* a1 = cA + (size_t)(t + 1) * kstep;
            const char* a2 = last ? nA : cA + (size_t)(t + 2) * kstep; const char* b2 = last ? nB : cB + (size_t)(t + 2) * kstep;
            const char* a3 = a2 + kstep; const char* b3 = b2 + kstep;
            if (last && has_next) S.a_ready(nxt);
            if constexpr (SP2) {
            PG8_LDB(B0, 0, 0); PG8_LDB(B1, 0, 1); PG8_SCHED; PG8_LDA(At, 0, 0); PG8_STAGE(PG8_SA(1, 1), a1 + hstepA, voffA);
            PG8_WAIT_V(8); PG8_WAIT_L(0); PG8_BAR; PG8_MMA(0, 0, At, B0); PG8_MMA(0, 1, At, B1); PG8_BAR; PG8_SCHED;
            PG8_LDA(At, 0, 1); PG8_STAGE(PG8_SB(0, 0), b2, voffB); PG8_STAGE(PG8_SB(0, 1), b2 + hstep, voffB); PG8_STAGE(PG8_SA(0, 0), a2, voffA);
            PG8_WAIT_V(8); PG8_WAIT_L(0); PG8_BAR; PG8_MMA(1, 0, At, B0); PG8_MMA(1, 1, At, B1); PG8_BAR; PG8_SCHED;
            PG8_LDB(B0, 1, 0); PG8_LDB(B1, 1, 1); PG8_SCHED; PG8_LDA(At, 1, 0); PG8_STAGE(PG8_SA(0, 1), a2 + hstepA, voffA);
            PG8_WAIT_V(8); PG8_WAIT_L(0); PG8_BAR; PG8_MMA(0, 0, At, B0); PG8_MMA(0, 1, At, B1); PG8_BAR; PG8_SCHED;
            PG8_LDA(At, 1, 1); PG8_STAGE(PG8_SB(1, 0), b3, voffB); PG8_STAGE(PG8_SB(1, 1), b3 + hstep, voffB); PG8_STAGE(PG8_SA(1, 0), a3, voffA);
            PG8_WAIT_V(8); PG8_WAIT_L(0); PG8_BAR; PG8_MMA(1, 0, At, B0); PG8_MMA(1, 1, At, B1); PG8_BAR; PG8_SCHED;
            } else {
            PG8_LDB(B0, 0, 0); PG8_SCHED; PG8_LDA(At, 0, 0); PG8_STAGE(PG8_SA(1, 1), a1 + hstepA, voffA);
            PG8_WAIT_L(8); PG8_BAR; PG8_WAIT_L(0); PG8_MMA(0, 0, At, B0); PG8_BAR; PG8_SCHED;
            PG8_LDB(B1, 0, 1); PG8_STAGE(PG8_SB(0, 0), b2, voffB);
            PG8_BAR; PG8_WAIT_L(0); PG8_MMA(0, 1, At, B1); PG8_BAR;
            PG8_LDA(At, 0, 1); PG8_STAGE(PG8_SA(0, 0), a2, voffA);
            PG8_BAR; PG8_WAIT_L(0); PG8_MMA(1, 0, At, B0); PG8_BAR; PG8_SCHED;
            PG8_STAGE(PG8_SB(0, 1), b2 + hstep, voffB);
            PG8_WAIT_V(6); PG8_BAR; PG8_MMA(1, 1, At, B1); PG8_BAR;
            PG8_LDB(B0, 1, 0); PG8_SCHED; PG8_LDA(At, 1, 0); PG8_STAGE(PG8_SA(0, 1), a2 + hstepA, voffA);
            PG8_WAIT_L(8); PG8_BAR; PG8_WAIT_L(0); PG8_MMA(0, 0, At, B0); PG8_BAR; PG8_SCHED;
            PG8_LDB(B1, 1, 1); PG8_STAGE(PG8_SB(1, 0), b3, voffB);
            PG8_BAR; PG8_WAIT_L(0); PG8_MMA(0, 1, At, B1); PG8_BAR;
            PG8_LDA(At, 1, 1); PG8_STAGE(PG8_SA(1, 0), a3, voffA);
            PG8_BAR; PG8_WAIT_L(0); PG8_MMA(1, 0, At, B0); PG8_BAR; PG8_SCHED;
            PG8_STAGE(PG8_SB(1, 1), b3 + hstep, voffB);
            PG8_WAIT_V(6); PG8_BAR; PG8_MMA(1, 1, At, B1); PG8_BAR;
            }
        }
        if constexpr (ALIGN_EPI) { if (wr == 0) PG8_BAR; }
        if constexpr (!Epi::AFTER_DRAIN) { E(acc, cur, wr, wc, fr, fq); S.done(cur); }
        if (!has_next) break;
#pragma unroll
        for (int a = 0; a < 2; ++a)
#pragma unroll
            for (int b = 0; b < 2; ++b)
#pragma unroll
                for (int m = 0; m < 4; ++m)
#pragma unroll
                    for (int n = 0; n < 2; ++n) acc[a][b][m][n] = (f32x4){0.f, 0.f, 0.f, 0.f};
        cur = nxt; cA = nA; cB = nB; ++ui;
        if constexpr (ALIGN_EPI) { if (wr == 1) PG8_BAR; }
    }
    PG8_WAIT_V(0);
    if constexpr (!ALIGN_EPI) { if (wr == 0) PG8_BAR; }
    PG8_BAR;
    if constexpr (Epi::AFTER_DRAIN) { E.fused(acc, cur, wr, wc, fr, fq, lds, wid, lane); S.done(cur); }
#undef PG8_SA
#undef PG8_SB
#undef PG8_STAGE
#undef PG8_LDA
#undef PG8_LDB
#undef PG8_MMA
#undef PG8_WAIT_V
#undef PG8_WAIT_L
#undef PG8_BAR
#undef PG8_SCHED
}
}

#ifndef PG8_SP2
#define PG8_SP2 true
#endif
#ifndef PG8_ALIGN
#define PG8_ALIGN true
#endif
namespace att {
#define LAS3 __attribute__((address_space(3)))
using bf16x8 = __attribute__((ext_vector_type(8))) short;
using s16x4 = __attribute__((ext_vector_type(4))) short;
using f32x16 = __attribute__((ext_vector_type(16))) float;
using f32x4 = __attribute__((ext_vector_type(4))) float;
using u32x4 = __attribute__((ext_vector_type(4))) unsigned;
typedef unsigned short u16;
typedef LAS3 const unsigned char* lds_cptr;
typedef short v4i16_t __attribute__((ext_vector_type(4)));
constexpr int SEQ = 16384, NW = 8, QBLK = 32, QB = 256, KVBLK = 64;
constexpr int KSLOT = 12288, VSLOT = 8192, NKS = 4, NVS = 4;
constexpr int LDS_K = 0, LDS_V = NKS * KSLOT, LDS_WS = LDS_V + NVS * VSLOT, LDS_OST = LDS_WS + NW * 256, LDS_QX = LDS_OST + NW * 4096, LDS_BYTES = LDS_QX + NW * 2048;
__device__ __forceinline__ int crow(int r, int hi) { return (r & 3) + 8 * (r >> 2) + 4 * hi; }
__device__ __forceinline__ void glds16(const void* gsrc, unsigned lds_dst) {
    asm volatile("s_mov_b32 m0, %1\n\ts_nop 0\n\tglobal_load_lds_dwordx4 %0, off" : : "v"(gsrc), "s"(lds_dst) : "memory", "m0"); }
typedef float f32x2_t __attribute__((ext_vector_type(2))); typedef __bf16 bf16x2_t __attribute__((ext_vector_type(2)));
__device__ __forceinline__ unsigned cvtpk_s(float lo, float hi) { f32x2_t v = {lo, hi}; bf16x2_t b = __builtin_convertvector(v, bf16x2_t); return __builtin_bit_cast(unsigned, b); }
__device__ __forceinline__ s16x4 vtr(lds_cptr p) { return __builtin_bit_cast(s16x4, __builtin_amdgcn_ds_read_tr16_b64_v4i16((LAS3 v4i16_t*)p)); }
#define ATT_SBAR() __builtin_amdgcn_sched_barrier(0)
#define ATT_WAIT_BAR(N) asm volatile("s_waitcnt vmcnt(" #N ") lgkmcnt(0)\n\ts_barrier" ::: "memory")
struct Src {
    const u16* q; int qp;
    const u16* k; int kp;
    const u16* k2; int k2p;
    const u16* v; int vp;
    u16* o; int op;
};
template <int NDK, int NQR, bool ZC, int XHS, int JLO, int JHI, bool EARLY>
__device__ __forceinline__ void phase_a(f32x16& C0, f32x16& C1, const lds_cptr* kb_, int ksl_, const bf16x8* qr, lds_cptr qx_, const f32x16& negm, bf16x8* kf, bf16x8* qx) {
    constexpr int KPF = 4;
#define ATT_SH(s_) (EARLY ? ((s_) / NDK) : ((s_) & 1))
#define ATT_SD(s_) (EARLY ? ((s_) % NDK) : ((s_) >> 1))
#define ATT_KRD(s_) kf[s_] = *(const LAS3 bf16x8*)(kb_[ATT_SD(s_)] + ksl_ + ATT_SH(s_) * (ATT_SD(s_) < 4 ? 4096 : XHS))
    if (JLO == 0) {
#pragma unroll
        for (int j = 0; j < KPF; ++j) ATT_KRD(j); }
#pragma unroll
    for (int j = JLO; j < JHI; ++j) {
        if (j + KPF < 2 * NDK) ATT_KRD(j + KPF);
        { const int dn = ATT_SD(j) + 2; if (NDK > NQR && dn >= NQR && dn < NDK && (EARLY || ATT_SH(j) == 0)) qx[dn >= NQR ? dn - NQR : 0] = *(const LAS3 bf16x8*)(qx_ + (dn >= NQR ? dn - NQR : 0) * 1024); }
        ATT_SBAR();
        const int d0 = ATT_SD(j); const f32x16 z = f32x16{}; const bf16x8 qf = (d0 < NQR) ? qr[d0 < NQR ? d0 : 0] : qx[d0 >= NQR ? d0 - NQR : 0];
        if (ATT_SH(j)) C1 = __builtin_amdgcn_mfma_f32_32x32x16_bf16(kf[j], qf, (d0 == 0) ? (ZC ? z : negm) : C1, 0, 0, 0);
        else           C0 = __builtin_amdgcn_mfma_f32_32x32x16_bf16(kf[j], qf, (d0 == 0) ? (ZC ? z : negm) : C0, 0, 0, 0);
        if (EARLY && j > NDK) { const int e0 = 16 * (j - NDK - 1) / (NDK - 1), e1 = 16 * (j - NDK) / (NDK - 1);
#pragma unroll
            for (int e = e0; e < e1; ++e) C0[e] = __builtin_amdgcn_exp2f(C0[e]);
            asm volatile("" : "+v"(C0)); }
        ATT_SBAR();
    }
#undef ATT_KRD
#undef ATT_SH
#undef ATT_SD
}
template <bool QK, bool FIN, bool EARLY>
__device__ __forceinline__ void phase_b(f32x16& C0, f32x16& C1, f32x16* o, lds_cptr vp_, u32x4* pw, float& l_reg) {
    s16x4 vlo[8], vhi[8]; float sacc = 0.f, sacd = 0.f;
#define ATT_VRD(i) do { const int vi_ = ((i) >> 1) + 4 * ((i) & 1); vlo[i] = vtr(vp_ + ((vi_ >> 2) * 4096 + (vi_ & 3) * 1024)); vhi[i] = vtr(vp_ + ((vi_ >> 2) * 4096 + (vi_ & 3) * 1024 + 512)); } while (0)
    if (FIN) { ATT_VRD(0); ATT_VRD(1); }
#pragma unroll
    for (int i = 0; i < 8; ++i) {
        if (FIN && i + 2 < 8) ATT_VRD(i + 2);
        ATT_SBAR();
        if (FIN) { const bf16x8 vf = (bf16x8){vlo[i][0], vlo[i][1], vlo[i][2], vlo[i][3], vhi[i][0], vhi[i][1], vhi[i][2], vhi[i][3]};
            o[i & 1] = __builtin_amdgcn_mfma_f32_32x32x16_bf16(__builtin_bit_cast(bf16x8, pw[i >> 1]), vf, o[i & 1], 0, 0, 0); }
        if (QK) { f32x16& X = (i < 4) ? C0 : C1; const int b = 4 * (i & 3);
            if (EARLY) { C1[2 * i] = __builtin_amdgcn_exp2f(C1[2 * i]); C1[2 * i + 1] = __builtin_amdgcn_exp2f(C1[2 * i + 1]); asm volatile("" : "+v"(C1)); }
            else { X[b] = __builtin_amdgcn_exp2f(X[b]); X[b + 1] = __builtin_amdgcn_exp2f(X[b + 1]); X[b + 2] = __builtin_amdgcn_exp2f(X[b + 2]); X[b + 3] = __builtin_amdgcn_exp2f(X[b + 3]); }
            sacc += X[b]; sacd += X[b + 1]; sacc += X[b + 2]; sacd += X[b + 3]; asm volatile("" : "+v"(sacc), "+v"(sacd));
            if (i & 1) { const int k = i >> 1, c = 8 * (k & 1);
                pw[k] = (u32x4){cvtpk_s(X[c], X[c + 1]), cvtpk_s(X[c + 2], X[c + 3]), cvtpk_s(X[c + 4], X[c + 5]), cvtpk_s(X[c + 6], X[c + 7])}; asm volatile("" : "+v"(pw[k])); } }
        ATT_SBAR();
    }
#undef ATT_VRD
    if (QK) l_reg += sacc + sacd;
}
template <bool MLA, bool FIX> __device__ __forceinline__ void attn_unit(int qb, const Src& s, LAS3 unsigned char* shm, const float* bias_h, float kmax2, const float* qmax_h) {
    constexpr int NDK = MLA ? 6 : 5, NX = MLA ? 4 : 1, NQR = MLA ? 4 : 5;
    constexpr float THRL = MLA ? 8.0f : 16.0f;
    const int tid = threadIdx.x, lane = tid & 63, r32 = lane & 31, hi = lane >> 5; const int wid = __builtin_amdgcn_readfirstlane(tid >> 6);
    const int q0 = qb * QB;
    const unsigned lds0 = (unsigned)(uintptr_t)shm;
    LAS3 float* wsf = (LAS3 float*)(shm + LDS_WS) + wid * 64;
    const int NT = (q0 + QB) / KVBLK;
    const int wvis = NT - 4 + (wid >> 1);
    const bool xw = wid < NX;
    const int krow = 8 * wid + (lane >> 3);
    const u16* ksrc = s.k + (size_t)krow * s.kp + (((lane & 7) ^ ((krow >> 1) & 7)) * 8);
    const int k2row = 16 * (wid & 3) + (lane >> 2);
    const u16* k2src = MLA ? s.k2 + (size_t)k2row * s.k2p + (((lane & 3) ^ ((k2row >> 2) & 3)) * 8) : s.k2 + (size_t)lane * s.k2p;
    const u16* vsrc = s.v + (size_t)(16 * (wid & 3) + (lane >> 2)) * s.vp + (wid >> 2) * 32 + (lane & 3) * 8;
    const unsigned kdst = lds0 + LDS_K + wid * 1024, k2dst = lds0 + LDS_K + (8 + (wid & 3)) * 1024, vdst = lds0 + LDS_V + wid * 1024;
#define ATT_DMA_K(t) do { const int sl_ = (t) & 3; glds16(ksrc + (size_t)(t) * KVBLK * s.kp, (unsigned)__builtin_amdgcn_readfirstlane(kdst + sl_ * KSLOT)); \
        if (xw) glds16(k2src + (size_t)(t) * KVBLK * s.k2p, (unsigned)__builtin_amdgcn_readfirstlane(k2dst + sl_ * KSLOT)); } while (0)
#define ATT_DMA_V(t, vsl) glds16(vsrc + (size_t)(t) * KVBLK * s.vp, (unsigned)__builtin_amdgcn_readfirstlane(vdst + (vsl)))
    if (!MLA) {
        if (tid < 256) { const int sl = tid >> 6; *(LAS3 f32x4*)(shm + LDS_K + sl * KSLOT + 9 * 1024 + (tid & 63) * 16) = (f32x4){0.f, 0.f, 0.f, 0.f}; } }
    if (MLA) { ATT_DMA_K(0); ATT_DMA_V(0, 0); ATT_DMA_K(1); ATT_DMA_K(2); }
    const u16* Qw = s.q + (size_t)(q0 + wid * QBLK + r32) * s.qp + hi * 8;
    bf16x8 qr[NQR];
#pragma unroll
    for (int d0 = 0; d0 < 4; ++d0) qr[d0] = *reinterpret_cast<const bf16x8*>(Qw + d0 * 16);
    const lds_cptr qx0 = (lds_cptr)shm + LDS_QX + wid * 2048 + lane * 16;
    float mla_ref = 0.f;
    if (MLA) { const bf16x8 q4 = *reinterpret_cast<const bf16x8*>(Qw + 64), q5 = *reinterpret_cast<const bf16x8*>(Qw + 80);
        *(LAS3 bf16x8*)(shm + LDS_QX + wid * 2048 + lane * 16) = q4; *(LAS3 bf16x8*)(shm + LDS_QX + wid * 2048 + 1024 + lane * 16) = q5;
        if (FIX) { float nq = 0.f;
#pragma unroll
            for (int e = 0; e < 8; ++e) { const float a = __uint_as_float((unsigned)(unsigned short)q4[e] << 16), b = __uint_as_float((unsigned)(unsigned short)q5[e] << 16); nq += a * a + b * b; }
#pragma unroll
            for (int d0 = 0; d0 < 4; ++d0)
#pragma unroll
                for (int e = 0; e < 8; ++e) { const float a = __uint_as_float((unsigned)(unsigned short)qr[d0][e] << 16); nq += a * a; }
            nq += __shfl_xor(nq, 32); mla_ref = sqrtf(nq * kmax2); } }
    const short one = hi ? (short)0 : (short)0x3F80;
    if (!MLA) qr[NQR - 1] = (bf16x8){one, one, one, 0, 0, 0, 0, 0};
    int t0 = 0;
    if (!MLA) {
        const float qm = qmax_h[qb];
        const float bunit = sqrtf(qm * kmax2);
        const float thr = FIX ? bias_h[q0] - 152.f : bias_h[q0] - 170.f - 2.f * bunit;
        if (FIX) { const float nm_ = -(bias_h[q0 + wid * QBLK + r32] + bunit); const unsigned h_ = cvtpk_s(nm_, 0.f) & 0xffffu; const float r1_ = nm_ - __uint_as_float(h_ << 16); const unsigned m_ = cvtpk_s(r1_, 0.f) & 0xffffu;
            const float r2_ = r1_ - __uint_as_float(m_ << 16); const unsigned l_ = cvtpk_s(r2_, 0.f) & 0xffffu;
            if (hi == 0) qr[NQR - 1] = (bf16x8){one, one, one, (short)h_, (short)m_, (short)l_, 0, 0}; }
        int best = 0;
        for (int tt = 1 + lane; tt <= NT - 4; tt += 64) { if (bias_h[64 * tt - 1] < thr) best = tt; }
#pragma unroll
        for (int o_ = 32; o_ >= 1; o_ >>= 1) best = max(best, __shfl_xor(best, o_));
        t0 = __builtin_amdgcn_readfirstlane(best);
    }
    if (!MLA) { ATT_DMA_K(t0); ATT_DMA_V(t0, (t0 & 3) * VSLOT); ATT_DMA_K(t0 + 1); ATT_DMA_K(t0 + 2); }
    float mhat = 0.f, l_reg = 0.f; f32x16 o[2]; o[0] = f32x16{}; o[1] = f32x16{}; f32x16 negm = f32x16{};
    if (MLA && FIX) {
#pragma unroll
        for (int r = 0; r < 16; ++r) negm[r] = -mla_ref; }
    const int qrel = wid * QBLK + r32;
    lds_cptr kb[NDK];
#pragma unroll
    for (int d0 = 0; d0 < 4; ++d0) kb[d0] = (lds_cptr)shm + LDS_K + r32 * 128 + ((((2 * d0 + hi) ^ ((r32 >> 1) & 7))) << 4);
    if (MLA) {
#pragma unroll
        for (int d0 = 4; d0 < NDK; ++d0) kb[d0] = (lds_cptr)shm + LDS_K + 8192 + r32 * 64 + ((((2 * (d0 - 4) + hi) ^ ((r32 >> 2) & 3))) << 4);
    } else kb[NDK - 1] = (lds_cptr)shm + LDS_K + 8192 + hi * 1024 + r32 * 16;
    constexpr int XHS = MLA ? 2048 : 512;
    const lds_cptr vp0 = (lds_cptr)shm + LDS_V + ((lane >> 4) & 1) * 32 + (lane & 3) * 8 + (4 * hi + ((lane & 15) >> 2)) * 64;
    f32x16 C0, C1; u32x4 pw[4]; bool resc = false;
#define ATT_TOP(t) do { if ((t) == t0 || (t) + 2 >= NT) { ATT_WAIT_BAR(0); } else if (xw) { ATT_WAIT_BAR(3); } else { ATT_WAIT_BAR(2); } \
        } while (0)
#define ATT_ISSUE(t) do { if ((t) + 3 < NT) ATT_DMA_K((t) + 3); if ((t) + 1 < NT) ATT_DMA_V((t) + 1, (((t) + 1) & 3) * VSLOT); } while (0)
#ifdef ATT_QKPRIO
#define ATT_PRIO_ON() __builtin_amdgcn_s_setprio(1)
#define ATT_PRIO_OFF() __builtin_amdgcn_s_setprio(0)
#else
#define ATT_PRIO_ON()
#define ATT_PRIO_OFF()
#endif
#define ATT_QK(t, E) do { bf16x8 kf_[2 * NDK]; bf16x8 qx_[NDK > NQR ? NDK - NQR : 1]; \
        phase_a<NDK, NQR, !MLA, XHS, 0, 4, E>(C0, C1, ATT_KS(t), qr, qx0, negm, kf_, qx_); ATT_ISSUE(t); ATT_SBAR(); \
        phase_a<NDK, NQR, !MLA, XHS, 4, 2 * NDK, E>(C0, C1, ATT_KS(t), qr, qx0, negm, kf_, qx_); } while (0)
#define ATT_MASK(C0, C1, t) do { const int kbq_ = 64 * ((t) - (NT - 4)) + 4 * hi; \
        _Pragma("unroll") for (int r = 0; r < 16; ++r) { const int kv_ = kbq_ + (r & 3) + 8 * (r >> 2); if (kv_ > qrel) C0[r] = -INFINITY; if (kv_ + 32 > qrel) C1[r] = -INFINITY; } } while (0)
#define ATT_DECIDE(C0, C1, FIRST) do { if (!FIX) { \
        float a_ = fmaxf(fmaxf(C0[0], C0[1]), C1[0]), b_ = fmaxf(fmaxf(C0[2], C0[3]), C1[1]); a_ = fmaxf(fmaxf(a_, C1[2]), C1[3]); \
        _Pragma("unroll") for (int r = 4; r < 16; r += 4) { a_ = fmaxf(fmaxf(a_, C0[r]), C0[r + 1]); b_ = fmaxf(fmaxf(b_, C0[r + 2]), C0[r + 3]); a_ = fmaxf(fmaxf(a_, C1[r]), C1[r + 1]); b_ = fmaxf(fmaxf(b_, C1[r + 2]), C1[r + 3]); } \
        float rm_ = fmaxf(a_, b_); { auto rr_ = __builtin_amdgcn_permlane32_swap(__float_as_uint(rm_), __float_as_uint(rm_), false, false); rm_ = fmaxf(__uint_as_float(rr_[0]), __uint_as_float(rr_[1])); } \
        resc = false; \
        if ((FIRST) || __any(rm_ > THRL)) { float dl_ = (FIRST) ? rm_ : fmaxf(rm_, 0.f); \
            if (!MLA) { const float nm_ = -(mhat + dl_); const unsigned h_ = cvtpk_s(nm_, 0.f) & 0xffffu; const float r1_ = nm_ - __uint_as_float(h_ << 16); const unsigned m_ = cvtpk_s(r1_, 0.f) & 0xffffu; \
                const float r2_ = r1_ - __uint_as_float(m_ << 16); const unsigned l_ = cvtpk_s(r2_, 0.f) & 0xffffu; \
                const float mn_ = -((__uint_as_float(h_ << 16) + __uint_as_float(m_ << 16)) + __uint_as_float(l_ << 16)); dl_ = mn_ - mhat; mhat = mn_; \
                if (hi == 0) qr[NQR - 1] = (bf16x8){one, one, one, (short)h_, (short)m_, (short)l_, 0, 0}; } \
            else { mhat += dl_; _Pragma("unroll") for (int r = 0; r < 16; ++r) negm[r] = -mhat; } \
            _Pragma("unroll") for (int r = 0; r < 16; ++r) { C0[r] -= dl_; C1[r] -= dl_; } \
            if (!(FIRST)) { const float f_ = __builtin_amdgcn_exp2f(-dl_); l_reg *= f_; if (hi == 0) wsf[r32] = f_; resc = true; } } } } while (0)
#define ATT_RESC() do { if (!FIX && resc) { \
        _Pragma("unroll") for (int i = 0; i < 4; ++i) { const f32x4 fv_ = *(const LAS3 f32x4*)(wsf + 8 * i + 4 * hi); \
            _Pragma("unroll") for (int d = 0; d < 2; ++d) { o[d][4 * i] *= fv_[0]; o[d][4 * i + 1] *= fv_[1]; o[d][4 * i + 2] *= fv_[2]; o[d][4 * i + 3] *= fv_[3]; } } } } while (0)
#define ATT_VS(tt) (vp0 + (((tt)) & 3) * VSLOT)
#define ATT_KS(tt) kb, ((((tt)) & 3) * KSLOT)
#ifndef ATT_STAGGER
#define ATT_STAGGER 0
#endif
    if (!ATT_STAGGER || wid < 4) {
#define ATT_STEP(t, MASKED) do { ATT_TOP(t); \
        constexpr bool E_ = FIX && (MLA || !(MASKED)); \
        ATT_QK(t, E_); \
        if (!MLA && (MASKED)) ATT_MASK(C0, C1, t); \
        ATT_DECIDE(C0, C1, false); ATT_SBAR(); \
        phase_b<true, true, E_>(C0, C1, o, ATT_VS((t) - 1), pw, l_reg); \
        ATT_RESC(); } while (0)
        ATT_TOP(t0);
        ATT_QK(t0, false);
        if (!MLA && wvis == t0) ATT_MASK(C0, C1, t0);
        ATT_DECIDE(C0, C1, true); ATT_SBAR();
        phase_b<true, false, false>(C0, C1, o, vp0, pw, l_reg);
        int t = t0 + 1;
        for (; t < wvis; ++t) ATT_STEP(t, false);
        if (t == wvis) { ATT_STEP(t, true); ++t; }
        { ATT_TOP(t); ATT_ISSUE(t); phase_b<false, true, false>(C0, C1, o, ATT_VS(t - 1), pw, l_reg); ++t; }
        for (; t <= NT + ATT_STAGGER; ++t) { ATT_TOP(t); ATT_ISSUE(t); }
#undef ATT_STEP
    } else {
        ATT_TOP(t0);
        ATT_QK(t0, false);
        ATT_DECIDE(C0, C1, true); ATT_SBAR();
        ATT_TOP(t0 + 1);
        phase_b<true, false, false>(C0, C1, o, vp0, pw, l_reg); ATT_SBAR();
        ATT_QK(t0 + 1, false);
        ATT_DECIDE(C0, C1, false); ATT_SBAR();
        int t = t0 + 2;
#define ATT_STEP2(t, MASKED) do { ATT_TOP(t); \
        phase_b<true, true, false>(C0, C1, o, ATT_VS((t) - 2), pw, l_reg); \
        ATT_RESC(); ATT_SBAR(); \
        ATT_QK(t, false); \
        if (!MLA && (MASKED)) ATT_MASK(C0, C1, t); \
        ATT_DECIDE(C0, C1, false); ATT_SBAR(); } while (0)
        for (; t < wvis; ++t) ATT_STEP2(t, false);
        ATT_STEP2(t, true); ++t;
        { ATT_TOP(t); ATT_ISSUE(t); phase_b<true, true, false>(C0, C1, o, ATT_VS(t - 2), pw, l_reg); ATT_RESC(); ++t; }
        { ATT_TOP(t); ATT_ISSUE(t); phase_b<false, true, false>(C0, C1, o, ATT_VS(t - 2), pw, l_reg); ++t; }
        for (; t <= NT + ATT_STAGGER; ++t) { ATT_TOP(t); ATT_ISSUE(t); }
#undef ATT_STEP2
    }
    { auto rr = __builtin_amdgcn_permlane32_swap(__float_as_uint(l_reg), __float_as_uint(l_reg), false, false); l_reg = __uint_as_float(rr[0]) + __uint_as_float(rr[1]); }
    if (hi == 0) wsf[32 + r32] = 1.0f / l_reg;
    float rli[16];
#pragma unroll
    for (int i = 0; i < 4; ++i) { const f32x4 fv = *(const LAS3 f32x4*)(wsf + 32 + 8 * i + 4 * hi); rli[4 * i] = fv[0]; rli[4 * i + 1] = fv[1]; rli[4 * i + 2] = fv[2]; rli[4 * i + 3] = fv[3]; }
    u16* Ow = s.o + (size_t)(q0 + wid * QBLK) * s.op;
    { LAS3 u16* stg = (LAS3 u16*)(shm + LDS_OST) + wid * 2048;
#pragma unroll
        for (int r = 0; r < 16; ++r) { const int orow = crow(r, hi);
#pragma unroll
            for (int d0 = 0; d0 < 2; ++d0) stg[orow * 64 + d0 * 32 + r32] = (u16)(cvtpk_s(o[d0][r] * rli[r], 0.f) & 0xffffu); }
        asm volatile("s_waitcnt lgkmcnt(0)" ::: "memory");
#pragma unroll
        for (int i = 0; i < 4; ++i) { const int row = i * 8 + (lane >> 3), ch = lane & 7; const u32x4 v = *(const LAS3 u32x4*)(stg + row * 64 + ch * 8); *(u32x4*)(Ow + (size_t)row * s.op + ch * 8) = v; } }
    asm volatile("s_waitcnt lgkmcnt(0)\n\ts_barrier" ::: "memory");
#undef ATT_DMA_K
#undef ATT_DMA_V
#undef ATT_TOP
#undef ATT_ISSUE
#undef ATT_QK
#undef ATT_MASK
#undef ATT_DECIDE
#undef ATT_RESC
#undef ATT_STEP
}
}

namespace cg = cooperative_groups;
#define LAS __attribute__((address_space(3)))
typedef unsigned short bf16;
typedef unsigned v4u __attribute__((ext_vector_type(4)));
typedef unsigned v2u __attribute__((ext_vector_type(2)));
typedef float f32x4 __attribute__((ext_vector_type(4)));
constexpr int NWAVES = 8;
constexpr int M = 16384, D = 1024, FF = 4096, NIN = 1960, NINP = 2048, QL = 256, KVL = 128, NQU = 768, NKVU = 1024;
constexpr float EPS = 1e-6f;
constexpr float LOG2E = 1.4426950408889634f;
constexpr float C2_FOX = 0.125f * LOG2E, C2_MLA = 0.10206207261596575f * LOG2E;
constexpr size_t MiB = 1u << 20;
constexpr size_t WS_WIN = 1 * MiB, WS_WQ = 5 * MiB, WS_WKV = 5 * MiB + 512 * 1024, WS_WO = 6 * MiB, WS_W1 = 8 * MiB, WS_W2 = 16 * MiB;
constexpr size_t WS_RT = 24 * MiB, WS_LF = 26 * MiB, WS_LC = 26 * MiB + 512 * 1024, WS_SS = 27 * MiB, WS_KR = 28 * MiB, WS_KB = 29 * MiB, WS_SSQ = 31 * MiB, WS_SSKV = 31 * MiB + 512 * 1024, WS_BIASF = 28 * MiB;
constexpr size_t WS_XN = 32 * MiB, WS_H = 64 * MiB, WS_P = 64 * MiB, WS_QM = 128 * MiB, WS_KVM = 152 * MiB, WS_QN = 184 * MiB, WS_O = 192 * MiB, WS_KVN = 224 * MiB, WS_END = 228 * MiB;
constexpr int RING_BYTES = 131072, LDS_BYTES = 147456;
static_assert(att::LDS_BYTES <= LDS_BYTES, "attention scratch fits the LDS allocation");

__device__ __forceinline__ unsigned f2bf(float f) { unsigned u = __builtin_bit_cast(unsigned, f); return (u + 0x7fffu + ((u >> 16) & 1u)) >> 16; }
__device__ __forceinline__ unsigned pk2(float lo, float hi) { return f2bf(lo) | (f2bf(hi) << 16); }
__device__ __forceinline__ float bf2f(unsigned short h) { return __builtin_bit_cast(float, (unsigned)h << 16); }
__device__ __forceinline__ float wave_sum(float v) {
#pragma unroll
    for (int o = 1; o < 64; o <<= 1) v += __shfl_xor(v, o);
    return v;
}
__device__ __forceinline__ int map_row(int mode, int n) {
    if (mode == 1) { const int h = n / 96, d = n % 96; if (d < 64) return n; const int i = d - 64; return h * 96 + (i < 16 ? 64 + 2 * i : 64 + 2 * (i - 16) + 1); }
    if (mode == 2) { const int h = n >> 7, j = n & 127; return j < 64 ? h * 64 + j : 512 + h * 64 + (j - 64); }
    if (mode == 3) { if (n < 1536 || n >= 1960) return n; if (n < 1544) return 1952 + (n - 1536); if (n < 1800) return 1536 + (n - 1544); if (n < 1928) return 1792 + (n - 1800);
        const int i = n - 1928; return 1920 + (i < 16 ? 2 * i : 2 * (i - 16) + 1); }
    return n;
}
__device__ __forceinline__ void p0_transpose_item(const float* W, int K, int N, int nblk, bf16* WT, int mode, const float* gk, LAS float* scr, int item, int lane) {
    const int kb = item / nblk, nb = item % nblk, k0 = 64 * kb, n0 = 32 * nb;
    const int nn = n0 + (lane & 31);
    float wv[32];
#pragma unroll
    for (int i = 0; i < 32; ++i) { const int kk = 2 * i + (lane >> 5); wv[i] = (nn < N) ? W[(size_t)(k0 + kk) * N + nn] : 0.f; }
    if (gk) {
#pragma unroll
        for (int i = 0; i < 32; ++i) wv[i] *= gk[k0 + 2 * i + (lane >> 5)]; }
#pragma unroll
    for (int i = 0; i < 32; ++i) { const int kk = 2 * i + (lane >> 5); scr[kk * 33 + (lane & 31)] = wv[i]; }
    asm volatile("s_waitcnt lgkmcnt(0)" ::: "memory");
    const int c = lane & 7;
#pragma unroll
    for (int j = 0; j < 4; ++j) { const int n = (lane >> 3) + 8 * j; const LAS float* sp = scr + (8 * c) * 33 + n;
        v4u o; o.x = pk2(sp[0 * 33], sp[1 * 33]); o.y = pk2(sp[2 * 33], sp[3 * 33]); o.z = pk2(sp[4 * 33], sp[5 * 33]); o.w = pk2(sp[6 * 33], sp[7 * 33]);
        *(v4u*)(WT + (size_t)map_row(mode, n0 + n) * K + k0 + 8 * c) = o; }
    asm volatile("s_waitcnt lgkmcnt(0)" ::: "memory");
}
__device__ __forceinline__ void sincos_d(double x, float& sn, float& cs) {
    const double k = rint(x * 0.63661977236758134308);
    double r = fma(-k, 1.57079632679489655800e+00, x); r = fma(-k, 6.12323399573676603587e-17, r);
    const double r2 = r * r;
    double s = -1.0 / 6227020800.0; s = s * r2 + 1.0 / 39916800.0; s = s * r2 - 1.0 / 362880.0; s = s * r2 + 1.0 / 5040.0; s = s * r2 - 1.0 / 120.0; s = s * r2 + 1.0 / 6.0; s = r - r * r2 * s;
    double c = 1.0 / 479001600.0; c = c * r2 - 1.0 / 3628800.0; c = c * r2 + 1.0 / 40320.0; c = c * r2 - 1.0 / 720.0; c = c * r2 + 1.0 / 24.0; c = c * r2 - 0.5; c = 1.0 + r2 * c;
    const int q = ((int)k) & 3;
    const double ss = (q == 0) ? s : (q == 1) ? c : (q == 2) ? -s : -c;
    const double cc = (q == 0) ? c : (q == 1) ? -s : (q == 2) ? -c : s;
    sn = (float)ss; cs = (float)cc;
}

#define RLX_AGENT __ATOMIC_RELAXED, __HIP_MEMORY_SCOPE_AGENT
#define XB_TMO      128
#define XB_XCNT(j)  (256  + 64 * (j))
#define XB_XSUB(j)  (1280 + 64 * (j))
#define XB_XGEN(j)  (2304 + 64 * (j))
#define XB_TOP      3328
#define XB_TOPGEN   3392
#define XCD_BAR_WORDS 3456
#define XB_SPIN_CAP (1u << 18)

__device__ __forceinline__ unsigned xb_ld(unsigned* p)              { return __hip_atomic_load(p, __ATOMIC_RELAXED, __HIP_MEMORY_SCOPE_AGENT); }
__device__ __forceinline__ unsigned xb_add(unsigned* p, unsigned v) { return __hip_atomic_fetch_add(p, v, __ATOMIC_RELAXED, __HIP_MEMORY_SCOPE_AGENT); }
__device__ __forceinline__ unsigned xb_xcc_id() { return (unsigned)__builtin_amdgcn_s_getreg((3 << 11) | 20) & 0xFu; }
#define XB_SPIN(cond, bar) do { unsigned _sp = 0; while (cond) { __builtin_amdgcn_s_sleep(1); \
    if ((++_sp & 255u) == 0u) { if (xb_ld(&(bar)[XB_TMO])) break; if (_sp > XB_SPIN_CAP) { atomicAdd(&(bar)[XB_TMO], 1u); break; } } } } while (0)

struct XcdBarrier {
    unsigned* bar; unsigned x;
    volatile LAS unsigned* st;
};

__device__ __forceinline__ XcdBarrier xcd_barrier_post(unsigned* bar, volatile LAS unsigned* st) {
    XcdBarrier b; b.bar = bar; b.x = xb_xcc_id(); b.st = st;
    if (threadIdx.x == 0) (void)xb_add(&bar[XB_XCNT(b.x)], 1u);
    return b;
}
__device__ __forceinline__ void xcd_barrier_complete(unsigned* bar, unsigned x, unsigned& nloc, unsigned& nx) {
    const unsigned G = gridDim.x * gridDim.y * gridDim.z;
    unsigned sum, cnt, mine, sp = 0u;
    for (;;) {
        sum = 0u; cnt = 0u; mine = 0u;
#pragma unroll
        for (unsigned j = 0; j < 16; ++j) { const unsigned c = xb_ld(&bar[XB_XCNT(j)]); sum += c; cnt += (c > 0u) ? 1u : 0u; mine = (j == x) ? c : mine; }
        if (sum == G) break;
        __builtin_amdgcn_s_sleep(1);
        if ((++sp & 255u) == 0u) { if (xb_ld(&bar[XB_TMO])) break; if (sp > XB_SPIN_CAP) { atomicAdd(&bar[XB_TMO], 1u); break; } }
    }
    nloc = mine > 0u ? mine : 1u; nx = cnt > 0u ? cnt : 1u;
}

__device__ __forceinline__ void xcd_barrier(const XcdBarrier& b) {
    asm volatile("s_waitcnt vmcnt(0)" ::: "memory");
    __syncthreads();
    if (threadIdx.x == 0) {
        unsigned* bar = b.bar;
        __builtin_amdgcn_s_waitcnt(0);
        unsigned nloc = b.st[0], nx = b.st[1];
        if (nloc == 0u) { xcd_barrier_complete(bar, b.x, nloc, nx); b.st[0] = nloc; b.st[1] = nx; }
        const unsigned old = xb_add(&bar[XB_XSUB(b.x)], 1u);
        const unsigned gen = old / nloc;
        if (old + 1u == (gen + 1u) * nloc) {
            __builtin_amdgcn_fence(__ATOMIC_RELEASE, "agent");
            asm volatile("s_waitcnt vmcnt(0)" ::: "memory");
            const unsigned og = xb_add(&bar[XB_TOP], 1u);
            const unsigned tg = og / nx;
            if (og + 1u == (tg + 1u) * nx) xb_add(&bar[XB_TOPGEN], 1u);
            else XB_SPIN(xb_ld(&bar[XB_TOPGEN]) == tg, bar);
            __builtin_amdgcn_fence(__ATOMIC_ACQUIRE, "agent");
            xb_add(&bar[XB_XGEN(b.x)], 1u);
            asm volatile("s_waitcnt vmcnt(0)" ::: "memory");
        } else {
            XB_SPIN(xb_ld(&bar[XB_XGEN(b.x)]) == gen, bar);
            __builtin_amdgcn_fence(__ATOMIC_ACQUIRE, "agent");
            asm volatile("s_waitcnt vmcnt(0)" ::: "memory");
        }
    }
    __syncthreads();
}

constexpr int MISC_OFF = LDS_BYTES - 128;
constexpr size_t WS_CTL = 0, CTL_ZERO_BYTES = 64 * 1024;
constexpr int CW_KMAX = 8192, CW_QF = 8192 + 512, CW_QM = 8192 + 1024, CW_PCNT = 8192 + 1536, CW_KMAXM = 13824, CW_QMAXM = 14400, CW_DONE = 14464;
static_assert(att::LDS_BYTES <= MISC_OFF, "LDS map");
struct Args { const float* in[13]; float* out; unsigned char* ws; int ph_lo, ph_hi, dup, pad; };
constexpr int NPHASE = 8;

__global__ void __launch_bounds__(NWAVES * 64, 2) mk_fwd(Args args) {
    extern __shared__ __attribute__((aligned(16))) unsigned char lds_raw[];
    LAS unsigned char* lds = (LAS unsigned char*)lds_raw;
    const int G = gridDim.x, bx = blockIdx.x;
#define MK_IDS int tid = threadIdx.x; asm volatile("" : "+v"(tid)); const int lane = tid & 63, wave = __builtin_amdgcn_readfirstlane(tid >> 6); const int gw = vcu * NWAVES + wave; (void)gw; (void)lane;
    const int vcu = (G % 8 == 0) ? (bx % 8) * (G / 8) + bx / 8 : bx;
    const int NGW = G * NWAVES;
    unsigned char* ws = args.ws;
#define MKP_x ((const float*)args.in[0])
#define MKP_g_mix ((const float*)args.in[1])
#define MKP_w_in ((const float*)args.in[2])
#define MKP_b_f ((const float*)args.in[3])
#define MKP_g_q ((const float*)args.in[4])
#define MKP_w_q_up ((const float*)args.in[5])
#define MKP_g_kv ((const float*)args.in[6])
#define MKP_w_kv_up ((const float*)args.in[7])
#define MKP_w_o ((const float*)args.in[8])
#define MKP_g_mlp ((const float*)args.in[9])
#define MKP_w_ff1 ((const float*)args.in[10])
#define MKP_w_ff2 ((const float*)args.in[11])
#define MKP_g_final ((const float*)args.in[12])
#define MKP_out (args.out)
#define MKP_Win_t ((bf16*)(args.ws + WS_WIN))
#define MKP_Wq_t ((bf16*)(args.ws + WS_WQ))
#define MKP_Wkv_t ((bf16*)(args.ws + WS_WKV))
#define MKP_Wo_t ((bf16*)(args.ws + WS_WO))
#define MKP_W1_t ((bf16*)(args.ws + WS_W1))
#define MKP_W2_t ((bf16*)(args.ws + WS_W2))
#define MKP_RT ((float*)(args.ws + WS_RT))
#define MKP_LF ((float*)(args.ws + WS_LF))
#define MKP_SS ((float*)(args.ws + WS_SS))
#define MKP_SSQ ((float*)(args.ws + WS_SSQ))
#define MKP_BIASF ((float*)(args.ws + WS_BIASF))
#define MKP_QMAX ((float*)(args.ws + WS_LC))
#define MKP_SSKV ((float*)(args.ws + WS_SSKV))
#define MKP_KB ((bf16*)(args.ws + WS_KB))
#define MKP_KR ((bf16*)(args.ws + WS_KR))
#define MKP_XN ((bf16*)(args.ws + WS_XN))
#define MKP_HB ((bf16*)(args.ws + WS_H))
#define MKP_P ((bf16*)(args.ws + WS_P))
#define MKP_QM ((bf16*)(args.ws + WS_QM))
#define MKP_KVM ((bf16*)(args.ws + WS_KVM))
#define MKP_QN ((bf16*)(args.ws + WS_QN))
#define MKP_OB ((bf16*)(args.ws + WS_O))
#define MKP_KVN ((bf16*)(args.ws + WS_KVN))
    const int lo = args.ph_lo, hi = args.ph_hi;
#ifndef MK_MASK
#define MK_MASK 0x1ff
#endif
#define IN(k) (((MK_MASK >> (k)) & 1) && lo <= (k) && (k) < hi)
#define REP(k) for (int rep_ = 0; rep_ < ((args.dup == (k)) ? 2 : 1); ++rep_)
    { volatile LAS unsigned* misc = (volatile LAS unsigned*)(lds + MISC_OFF); if (threadIdx.x < 32) misc[threadIdx.x] = 0u; }
    __syncthreads();
    (void)xcd_barrier_post((unsigned*)(ws + WS_CTL), (volatile LAS unsigned*)(lds + MISC_OFF) + 8);
    if (args.ph_lo < 0) cg::this_grid().sync();
#ifdef TS_PHASE
    unsigned long long ts_a_ = 0, ts_b_ = 0;
#define TS_BEGIN(k) do { if ((k) == TS_PHASE || (TS_PHASE == 99 && (k) == 0)) ts_a_ = __builtin_amdgcn_s_memrealtime(); } while (0)
#define TS_END(k) do { if ((k) == TS_PHASE || (TS_PHASE == 99 && (k) == 7)) ts_b_ = __builtin_amdgcn_s_memrealtime(); } while (0)
#else
#define TS_BEGIN(k)
#define TS_END(k)
#endif
#define SEAM(k) do { if (IN(k) && IN((k) + 1)) { XcdBarrier b_; b_.bar = (unsigned*)(args.ws + WS_CTL); b_.x = xb_xcc_id(); b_.st = (volatile LAS unsigned*)(lds + MISC_OFF) + 8; xcd_barrier(b_); } } while (0)

    TS_BEGIN(0);
    if (IN(0)) { MK_IDS
        LAS float* scr = (LAS float*)(lds + wave * 16384);
        constexpr int I_IN = (D / 64) * (NINP / 32), I_Q = (QL / 64) * (NQU / 32), I_KV = (KVL / 64) * (NKVU / 32), I_O = (D / 64) * (D / 32), I_1 = (D / 64) * (FF / 32), I_2 = (FF / 64) * (D / 32);
        constexpr int NITEMS = I_IN + I_Q + I_KV;
        (void)I_O; (void)I_1; (void)I_2;
        for (int it = gw; it < NITEMS; it += NGW) {
            int r = it;
            if (r < I_IN) { p0_transpose_item(MKP_w_in, D, NIN, NINP / 32, MKP_Win_t, 3, nullptr, scr, r, lane); continue; } r -= I_IN;
            if (r < I_Q) { p0_transpose_item(MKP_w_q_up, QL, NQU, NQU / 32, MKP_Wq_t, 1, MKP_g_q, scr, r, lane); continue; } r -= I_Q;
            p0_transpose_item(MKP_w_kv_up, KVL, NKVU, NKVU / 32, MKP_Wkv_t, 2, MKP_g_kv, scr, r, lane);
        }
        for (int m0 = gw; m0 < M; m0 += 4 * NGW) {
            const f32x4* gr = (const f32x4*)MKP_g_mix + lane; f32x4 v[4][4]; float s2[4];
#pragma unroll
            for (int r = 0; r < 4; ++r) { const int m = m0 + r * NGW; const f32x4* xr = (const f32x4*)(MKP_x + (size_t)(m < M ? m : 0) * D) + lane;
#pragma unroll
                for (int j = 0; j < 4; ++j) v[r][j] = __builtin_nontemporal_load(xr + 64 * j); }
#pragma unroll
            for (int r = 0; r < 4; ++r) { s2[r] = 0.f;
#pragma unroll
                for (int j = 0; j < 4; ++j) s2[r] += (v[r][j].x * v[r][j].x + v[r][j].y * v[r][j].y) + (v[r][j].z * v[r][j].z + v[r][j].w * v[r][j].w);
                s2[r] = 1.f / sqrtf(wave_sum(s2[r]) * (1.f / D) + EPS); }
#pragma unroll
            for (int r = 0; r < 4; ++r) { const int m = m0 + r * NGW; if (m < M) { unsigned long long* o8 = (unsigned long long*)(MKP_XN + (size_t)m * D) + lane; const float rstd = s2[r];
#pragma unroll
                for (int j = 0; j < 4; ++j) { const f32x4 g = gr[64 * j]; o8[64 * j] = (unsigned long long)pk2(v[r][j].x * rstd * g.x, v[r][j].y * rstd * g.y) | ((unsigned long long)pk2(v[r][j].z * rstd * g.z, v[r][j].w * rstd * g.w) << 32); } } }
        }
        for (int e = (vcu * NWAVES * 64 + tid); e < M * 16; e += G * NWAVES * 64) {
            const int m = e >> 4, i = e & 15; double inv = 1.0; for (int j = 0; j < i; ++j) inv *= 0.56234132519034908039;
            float sn, cs; sincos_d((double)m * inv, sn, cs); MKP_RT[2 * e] = cs; MKP_RT[2 * e + 1] = sn;
        }
    }
    SEAM(0);
    TS_END(0);
    TS_BEGIN(1);
    if (IN(1)) {
        pg8::Gemm g{MKP_XN, MKP_Win_t, M, NINP, D}; pg8::StaticOrder S; S.init(M, NINP, G, bx);
        pg8::EpiIn E{MKP_P, NINP, C2_FOX, MKP_SSQ, MKP_SSKV, MKP_RT, MKP_b_f, MKP_LF, M};
        pg8::gemm_phase<pg8::EpiIn, pg8::StaticOrder, PG8_ALIGN, PG8_SP2>(lds, g, S, E);
    }
    SEAM(1);
    TS_END(1);
    TS_BEGIN(3);
    if (IN(3)) { MK_IDS
        if (wave >= 2) {
            LAS float* scr = (LAS float*)(lds + wave * 16384);
            constexpr int J_O = (D / 64) * (D / 32), J_1 = (D / 64) * (FF / 32), J_2 = (FF / 64) * (D / 32);
            for (int it = vcu * 6 + (wave - 2); it < J_O + J_1 + J_2; it += G * 6) {
                int r = it;
                if (r < J_O) { p0_transpose_item(MKP_w_o, D, D, D / 32, MKP_Wo_t, 0, nullptr, scr, r, lane); continue; } r -= J_O;
                if (r < J_1) { p0_transpose_item(MKP_w_ff1, D, FF, FF / 32, MKP_W1_t, 0, MKP_g_mlp, scr, r, lane); continue; } r -= J_1;
                p0_transpose_item(MKP_w_ff2, FF, D, D / 32, MKP_W2_t, 0, nullptr, scr, r, lane);
            }
        }
        if (wave < 2) { const int job = bx + 256 * wave;
            if (job < 512 && bx < 256) { const int h = job >> 6, ti = job & 63; const f32x4* lf4 = (const f32x4*)(MKP_LF + (size_t)h * M);
                float pre = 0.f; { int j = 0; float pa[8] = {0.f, 0.f, 0.f, 0.f, 0.f, 0.f, 0.f, 0.f};
                    for (; j + 8 <= ti; j += 8) { f32x4 w[8];
#pragma unroll
                        for (int u = 0; u < 8; ++u) w[u] = lf4[(j + u) * 64 + lane];
#pragma unroll
                        for (int u = 0; u < 8; ++u) pa[u] += (w[u].x + w[u].y) + (w[u].z + w[u].w); }
                    for (; j < ti; ++j) { const f32x4 w = lf4[j * 64 + lane]; pa[0] += (w.x + w.y) + (w.z + w.w); }
                    pre = ((pa[0] + pa[1]) + (pa[2] + pa[3])) + ((pa[4] + pa[5]) + (pa[6] + pa[7])); }
                pre = wave_sum(pre);
                const f32x4 v = lf4[ti * 64 + lane];
                const float s1 = v.x, s2 = s1 + v.y, s3 = s2 + v.z, s4 = s3 + v.w; float inc = s4;
#pragma unroll
                for (int o = 1; o < 64; o <<= 1) { const float n = __shfl_up(inc, o); if (lane >= o) inc += n; }
                const float ex = pre + (inc - s4); const float cs[4] = {ex + s1, ex + s2, ex + s3, ex + s4};
                *(f32x4*)(MKP_BIASF + (size_t)h * M + ti * 256 + 4 * lane) = (f32x4){-cs[0] * LOG2E, -cs[1] * LOG2E, -cs[2] * LOG2E, -cs[3] * LOG2E};
                { float km = 0.f;
                  float qmx = 0.f;
                  for (int e = 0; e < 4; ++e) { const v4u* kr = (const v4u*)(MKP_P + (size_t)(ti * 256 + 4 * lane + e) * NINP + 512 + h * 64); float a2 = 0.f; const v4u* qrw = kr - 64; float q2 = 0.f;
#pragma unroll
                      for (int c8 = 0; c8 < 8; ++c8) { const v4u w = qrw[c8]; const unsigned ww[4] = {w.x, w.y, w.z, w.w};
#pragma unroll
                          for (int q4 = 0; q4 < 4; ++q4) { const float lo_ = __builtin_bit_cast(float, ww[q4] << 16), hi_ = __builtin_bit_cast(float, ww[q4] & 0xffff0000u); q2 += lo_ * lo_ + hi_ * hi_; } }
                      qmx = fmaxf(qmx, q2);
#pragma unroll
                      for (int c8 = 0; c8 < 8; ++c8) { const v4u w = kr[c8]; const unsigned ww[4] = {w.x, w.y, w.z, w.w};
#pragma unroll
                          for (int q4 = 0; q4 < 4; ++q4) { const float lo_ = __builtin_bit_cast(float, ww[q4] << 16), hi_ = __builtin_bit_cast(float, ww[q4] & 0xffff0000u); a2 += lo_ * lo_ + hi_ * hi_; } }
                      km = fmaxf(km, a2); }
#pragma unroll
                  for (int o = 32; o >= 1; o >>= 1) km = fmaxf(km, __shfl_xor(km, o));
#pragma unroll
                  for (int o = 32; o >= 1; o >>= 1) qmx = fmaxf(qmx, __shfl_xor(qmx, o));
                  if (lane == 0) { atomicMax((unsigned*)(args.ws + WS_CTL) + CW_KMAX + 64 * h, __builtin_bit_cast(unsigned, km)); MKP_QMAX[h * 64 + ti] = qmx; } }
#pragma unroll
                for (int e = 0; e < 4; ++e) { const float b = -cs[e] * LOG2E; const unsigned bh = f2bf(b); const float r1 = b - __builtin_bit_cast(float, bh << 16); const unsigned bm = f2bf(r1);
                    const float r2 = r1 - __builtin_bit_cast(float, bm << 16); const unsigned bl = f2bf(r2);
                    *(v4u*)(MKP_KB + ((size_t)h * M + ti * 256 + 4 * lane + e) * 8) = (v4u){bh | (bm << 16), bl | 0x3F800000u, 0x3F803F80u, 0u}; } } }
        __syncthreads();
        { int kq = QL; asm volatile("" : "+s"(kq)); pg8::Gemm g{MKP_P + 1536, MKP_Wq_t, M, NQU, kq, NINP}; pg8::StaticOrder S; S.init(M, NQU, G, bx);
          pg8::EpiQm E{MKP_QM, NQU, MKP_RT, C2_MLA, MKP_SSQ, EPS};
          pg8::gemm_phase<pg8::EpiQm, pg8::StaticOrder, PG8_ALIGN, PG8_SP2>(lds, g, S, E); }
        { int kkv = KVL; asm volatile("" : "+s"(kkv)); pg8::Gemm g{MKP_P + 1792, MKP_Wkv_t, M, NKVU, kkv, NINP}; pg8::StaticOrder S; S.init(M, NKVU, G, bx);
          pg8::EpiKv E{MKP_KVM, NKVU, MKP_SSKV, EPS};
          pg8::gemm_phase<pg8::EpiKv, pg8::StaticOrder, PG8_ALIGN, PG8_SP2>(lds, g, S, E); }
    }
    SEAM(3);
    TS_END(3);
    TS_BEGIN(4);
    if (IN(4)) {
        const int v = (G == 256) ? vcu : bx; const int h0 = (v >> 5) & 7;
        volatile LAS unsigned* misc = (volatile LAS unsigned*)(lds + MISC_OFF);
        unsigned* ctlw = (unsigned*)(args.ws + WS_CTL);
        { const int tid_ = threadIdx.x, lane_ = tid_ & 63, tok = bx * 64 + (tid_ >> 3), hh = tid_ & 7; float k2 = 0.f, q2 = 0.f;
          if (bx < 256) {
            const v4u* kp = (const v4u*)(MKP_KVM + (size_t)tok * NKVU + hh * 64); const v4u* rp = (const v4u*)(MKP_P + (size_t)tok * NINP + 1920); const v4u* qp = (const v4u*)(MKP_QM + (size_t)tok * NQU + hh * 96);
#define MK_SQ(w_, acc_) do { const unsigned ww_[4] = {w_.x, w_.y, w_.z, w_.w}; _Pragma("unroll") for (int q4_ = 0; q4_ < 4; ++q4_) { const float lo_ = __builtin_bit_cast(float, ww_[q4_] << 16), hi_ = __builtin_bit_cast(float, ww_[q4_] & 0xffff0000u); acc_ += lo_ * lo_ + hi_ * hi_; } } while (0)
#pragma unroll
            for (int c8 = 0; c8 < 8; ++c8) { const v4u w = kp[c8]; MK_SQ(w, k2); }
#pragma unroll
            for (int c8 = 0; c8 < 4; ++c8) { const v4u w = rp[c8]; MK_SQ(w, k2); }
#pragma unroll
            for (int c8 = 0; c8 < 12; ++c8) { const v4u w = qp[c8]; MK_SQ(w, q2); }
#undef MK_SQ
          }
#pragma unroll
          for (int o = 8; o <= 32; o <<= 1) { k2 = fmaxf(k2, __shfl_xor(k2, o)); q2 = fmaxf(q2, __shfl_xor(q2, o)); }
          if (lane_ < 8) { atomicMax(ctlw + CW_KMAXM + 64 * lane_, __builtin_bit_cast(unsigned, k2)); atomicMax(ctlw + CW_QMAXM, __builtin_bit_cast(unsigned, q2)); }
          asm volatile("s_waitcnt vmcnt(0)" ::: "memory"); __syncthreads();
          if (tid_ == 0) __hip_atomic_fetch_add(ctlw + CW_DONE, 1u, __ATOMIC_RELAXED, __HIP_MEMORY_SCOPE_AGENT); }
        bool okF = true;
        { const int lane_ = threadIdx.x & 63;
          for (int h = 0; h < 8; ++h) { const float kF = __builtin_bit_cast(float, __hip_atomic_load(ctlw + CW_KMAX + 64 * h, __ATOMIC_RELAXED, __HIP_MEMORY_SCOPE_AGENT));
              float qF = MKP_QMAX[h * 64 + lane_];
#pragma unroll
              for (int o = 32; o >= 1; o >>= 1) qF = fmaxf(qF, __shfl_xor(qF, o));
              okF = okF && (qF * kF < 2025.f); }
          okF = __builtin_amdgcn_readfirstlane(okF ? 1 : 0) != 0; }
#ifndef PROBE_FOX
#define PROBE_FOX 1
#endif
#ifndef PROBE_MLA
#define PROBE_MLA 1
#endif
#define MK_POP(CWQ) \
            if ((threadIdx.x >> 6) == 0) { const int ln_ = threadIdx.x & 63; unsigned i_ = 0xFFFFFFFFu; int hs_ = h0; \
                if (own) { if (ln_ == 0) i_ = __hip_atomic_fetch_add(ctlw + (CWQ) + 64 * h0 + 16 * rep, 1u, __ATOMIC_RELAXED, __HIP_MEMORY_SCOPE_AGENT); i_ = (unsigned)__builtin_amdgcn_readfirstlane((int)i_); } \
                if (!own || i_ >= 64u) { unsigned c_ = 64u; if (ln_ < 8) c_ = __hip_atomic_load(ctlw + (CWQ) + 64 * ((h0 + ln_) & 7) + 16 * rep, __ATOMIC_RELAXED, __HIP_MEMORY_SCOPE_AGENT); \
                    const unsigned long long m_ = __ballot(c_ < 64u); i_ = 0xFFFFFFFFu; \
                    if (m_ != 0ull) { hs_ = (h0 + (int)__builtin_ctzll(m_)) & 7; if (ln_ == 0) i_ = __hip_atomic_fetch_add(ctlw + (CWQ) + 64 * hs_ + 16 * rep, 1u, __ATOMIC_RELAXED, __HIP_MEMORY_SCOPE_AGENT); \
                        i_ = (unsigned)__builtin_amdgcn_readfirstlane((int)i_); if (i_ >= 64u) i_ = 0xFFFFFFFEu; } } \
                if (ln_ == 0) { misc[0] = i_; misc[1] = (unsigned)hs_; } } \
            __syncthreads(); const unsigned i = misc[0]; const int h = (int)misc[1]; __syncthreads(); \
            if (h != h0 || i >= 64u) own = false; \
            if (i == 0xFFFFFFFFu) break; \
            if (i >= 64u) continue;
#define MK_FOX_LOOPS(FIXV) do { \
        for (int rep = 0; rep < PROBE_FOX; ++rep) { bool own = true; \
        for (;;) { MK_POP(CW_QF) \
            const float kmax2 = __builtin_bit_cast(float, __hip_atomic_load(ctlw + CW_KMAX + 64 * h, __ATOMIC_RELAXED, __HIP_MEMORY_SCOPE_AGENT)); \
            att::Src s{MKP_P + h * 64, NINP, MKP_P + 512 + h * 64, NINP, MKP_KB + (size_t)h * M * 8, 8, MKP_P + 1024 + h * 64, NINP, MKP_OB + h * 64, D}; \
            att::attn_unit<false, FIXV>(63 - (int)i, s, lds, MKP_BIASF + (size_t)h * M, kmax2, MKP_QMAX + h * 64); \
        } } } while (0)
#define MK_MLA_LOOPS(FIXV) do { \
        for (int rep = 0; rep < PROBE_MLA; ++rep) { bool own = true; \
        for (;;) { MK_POP(CW_QM) \
            const float kmaxm = __builtin_bit_cast(float, __hip_atomic_load(ctlw + CW_KMAXM + 64 * h, __ATOMIC_RELAXED, __HIP_MEMORY_SCOPE_AGENT)); \
            att::Src s{MKP_QM + h * 96, NQU, MKP_KVM + h * 64, NKVU, MKP_P + 1920, NINP, MKP_KVM + 512 + h * 64, NKVU, MKP_OB + 512 + h * 64, D}; \
            att::attn_unit<true, FIXV>(63 - (int)i, s, lds, nullptr, kmaxm, nullptr); \
        } } } while (0)
        if (okF) MK_FOX_LOOPS(true); else MK_FOX_LOOPS(false);
        asm volatile("" ::: "memory");
        if (threadIdx.x == 0) { unsigned sp = 0; while (__hip_atomic_load(ctlw + CW_DONE, __ATOMIC_RELAXED, __HIP_MEMORY_SCOPE_AGENT) < (unsigned)G) { __builtin_amdgcn_s_sleep(2); if (++sp > (1u << 22)) break; } }
        __syncthreads();
        bool okM = true;
        { const float qmM = __builtin_bit_cast(float, __hip_atomic_load(ctlw + CW_QMAXM, __ATOMIC_RELAXED, __HIP_MEMORY_SCOPE_AGENT));
          for (int h = 0; h < 8; ++h) { const float kM = __builtin_bit_cast(float, __hip_atomic_load(ctlw + CW_KMAXM + 64 * h, __ATOMIC_RELAXED, __HIP_MEMORY_SCOPE_AGENT)); okM = okM && (qmM * kM < 2025.f); }
          okM = __builtin_amdgcn_readfirstlane(okM ? 1 : 0) != 0; }
        if (okM) MK_MLA_LOOPS(true); else MK_MLA_LOOPS(false);
#undef MK_FOX_LOOPS
#undef MK_MLA_LOOPS
#undef MK_POP
    }
#ifdef ATT_PRIO
    __builtin_amdgcn_s_setprio(0);
#endif
    SEAM(4);
    TS_END(4);
    TS_BEGIN(5);
    if (IN(5)) {
        pg8::Gemm g{MKP_OB, MKP_Wo_t, M, D, D}; pg8::StaticOrder S; S.init(M, D, G, bx);
        pg8::EpiRes E{MKP_x, MKP_out, D, MKP_XN, MKP_SS};
        pg8::gemm_phase<pg8::EpiRes, pg8::StaticOrder, PG8_ALIGN, PG8_SP2>(lds, g, S, E);
    }
    SEAM(5);
    TS_END(5);
    TS_BEGIN(6);
    if (IN(6)) {
        pg8::Gemm g{MKP_XN, MKP_W1_t, M, FF, D}; int pflag = 1; asm volatile("" : "+s"(pflag)); pg8::StaticOrder S; S.init(M, D, G, bx, pflag);
        pg8::EpiSqRelu E{MKP_HB, FF, MKP_SS, EPS, 1.f / D};
        pg8::gemm_phase<pg8::EpiSqRelu, pg8::StaticOrder, PG8_ALIGN, PG8_SP2>(lds, g, S, E);
    }
    SEAM(6);
    TS_END(6);
    TS_BEGIN(7);
    if (IN(7)) {
        pg8::Gemm g{MKP_HB, MKP_W2_t, M, D, FF}; pg8::StaticOrder S; S.init(M, D, G, bx);
        pg8::EpiResNorm E{MKP_out, MKP_out, D, MKP_g_final, MKP_SSQ, (unsigned*)(args.ws + WS_CTL) + CW_PCNT, EPS, 1.f / D};
        pg8::gemm_phase<pg8::EpiResNorm, pg8::StaticOrder, false, PG8_SP2>(lds, g, S, E);
    }
#ifdef TS_PHASE
    { XcdBarrier b_; b_.bar = (unsigned*)(args.ws + WS_CTL); b_.x = xb_xcc_id(); b_.st = (volatile LAS unsigned*)(lds + MISC_OFF) + 8; xcd_barrier(b_); }
    TS_END(7);
    if (blockIdx.x == 0 && threadIdx.x == 0) MKP_out[0] = (float)(((ts_b_ - ts_a_) / TS_Q) * (TS_Q / 100ull));
#endif
#undef IN
#undef SEAM
#undef MKP_x
#undef MKP_g_mix
#undef MKP_w_in
#undef MKP_b_f
#undef MKP_g_q
#undef MKP_w_q_up
#undef MKP_g_kv
#undef MKP_w_kv_up
#undef MKP_w_o
#undef MKP_g_mlp
#undef MKP_w_ff1
#undef MKP_w_ff2
#undef MKP_g_final
#undef MKP_out
#undef MKP_Win_t
#undef MKP_Wq_t
#undef MKP_Wkv_t
#undef MKP_Wo_t
#undef MKP_W1_t
#undef MKP_W2_t
#undef MKP_RT
#undef MKP_LF
#undef MKP_SS
#undef MKP_SSQ
#undef MKP_BIASF
#undef MKP_QMAX
#undef MKP_SSKV
#undef MKP_KB
#undef MKP_KR
#undef MKP_XN
#undef MKP_HB
#undef MKP_P
#undef MKP_QM
#undef MKP_KVM
#undef MKP_QN
#undef MKP_OB
#undef MKP_KVN
}

#ifndef MK_ONE_LAUNCH
#define MK_ONE_LAUNCH 1
#endif
extern "C" void kernel_launch(void* const* d_in, const int* in_sizes, int n_in, void* d_out, int out_size, void* d_ws, size_t ws_size, hipStream_t stream) {
    static int ready = 0;
    if (ready == 0) {
        if (n_in != 13 || in_sizes[0] != M * D || out_size != M * D || ws_size < WS_END) { fprintf(stderr, "kernel_launch: unexpected shapes (n_in %d, in0 %d, out %d, ws %zu)\n", n_in, n_in > 0 ? in_sizes[0] : -1, out_size, ws_size); ready = -1; return; }
        if (hipFuncSetAttribute((const void*)mk_fwd, hipFuncAttributeMaxDynamicSharedMemorySize, LDS_BYTES) != hipSuccess) { fprintf(stderr, "kernel_launch: hipFuncSetAttribute failed\n"); ready = -1; return; }
        ready = 1;
    }
    if (ready < 0) return;
    if (hipMemsetAsync((char*)d_ws + WS_CTL, 0, CTL_ZERO_BYTES, stream) != hipSuccess) { fprintf(stderr, "kernel_launch: hipMemsetAsync failed\n"); return; }
    Args a{};
    for (int i = 0; i < 13; ++i) a.in[i] = (const float*)d_in[i];
    a.out = (float*)d_out; a.ws = (unsigned char*)d_ws;
#ifndef MK_DUP
#define MK_DUP -1
#endif
    a.dup = MK_DUP;
    const int grid = 256;
#if MK_ONE_LAUNCH
    a.ph_lo = 0; a.ph_hi = NPHASE;
    void* kargs[] = {&a};
    hipError_t e = hipLaunchCooperativeKernel((const void*)mk_fwd, dim3(grid), dim3(NWAVES * 64), kargs, LDS_BYTES, stream);
    if (e != hipSuccess) fprintf(stderr, "kernel_launch: cooperative launch failed: %s\n", hipGetErrorString(e));
#else
    for (int p = 0; p < NPHASE; ++p) { a.ph_lo = p; a.ph_hi = p + 1; hipLaunchKernelGGL(mk_fwd, dim3(grid), dim3(NWAVES * 64), LDS_BYTES, stream, a); }
#endif
}
```

```cpp
#include <hip/hip_runtime.h>
#include <hip/hip_cooperative_groups.h>
#include <hip/hip_bf16.h>
#include <cstdio>
#include <cstdint>
#include <cmath>
namespace pg8 {
#define PG8_LAS __attribute__((address_space(3)))
typedef unsigned short bf16_t;
typedef short bf16x8 __attribute__((ext_vector_type(8)));
typedef float f32x4 __attribute__((ext_vector_type(4)));
typedef unsigned u32x4 __attribute__((ext_vector_type(4)));
constexpr int BM = 256, BK = 64, HALF = 128, HTB = HALF * BK * 2  , STAGE_BYTES = 8 * HTB, NXCD = 8, WGM = 8;

__host__ __device__ __forceinline__ int lds_byte(int r, int c) { const int st = (r >> 4) * 2 + (c >> 5), rr = r & 15, cc = c & 31, ob = rr * 64 + cc * 2; return st * 1024 + (ob ^ (((ob >> 9) & 1) << 5)); }
__host__ __device__ __forceinline__ void stage_rc(int b, int& R, int& C) { const int st = b / 1024, sb = b % 1024, swz = sb ^ (((sb >> 9) & 1) << 5); R = (st >> 1) * 16 + swz / 64; C = (st & 1) * 32 + (swz % 64) / 2; }
__host__ __device__ __forceinline__ int perm32(int rho) { const int n = rho >> 4, i = rho & 15; return 8 * (i >> 2) + 4 * n + (i & 3); }

struct Unit { int pm, pn; };
struct Gemm { const bf16_t* A; const bf16_t* Bt; int M, N, K; int lda; };

struct StaticOrder {
    int nM, nN, nwg, G, c, panel;
    __host__ __device__ __forceinline__ void init(int M, int N, int G_, int c_, int panel_ = 0) { nM = M / BM; nN = N / BM; nwg = nM * nN; G = G_; c = c_; panel = panel_; }
    __host__ __device__ __forceinline__ bool next(int i, Unit& u) const {
        if (panel) { if (i >= 4) return false; base(0, u); u.pn = 4 * u.pn + i; return true; }
        return base(i, u);
    }
    __host__ __device__ __forceinline__ bool base(int i, Unit& u) const {
        const long L = (long)i * G + c; if (L >= nwg) return false;
        int wgid = (int)L; { const int q = nwg / NXCD, r = nwg % NXCD, xcd = wgid % NXCD, off = wgid / NXCD; wgid = (xcd < r ? xcd * (q + 1) : r * (q + 1) + (xcd - r) * q) + off; }
        const int nig = WGM * nN, gid = wgid / nig, fm = gid * WGM, gsz = (nM - fm) < WGM ? (nM - fm) : WGM;
        u.pm = fm + ((wgid % nig) % gsz); u.pn = (wgid % nig) / gsz; return true;
    }
    __device__ __forceinline__ void a_ready(const Unit&) const {}
    __device__ __forceinline__ void done(const Unit&) const {}
};

__device__ __forceinline__ unsigned cvt_pk_bf16(float lo, float hi) { unsigned r; asm volatile("v_cvt_pk_bf16_f32 %0, %1, %2" : "=v"(r) : "v"(lo), "v"(hi)); return r; }
typedef float f32x2 __attribute__((ext_vector_type(2)));
__device__ __forceinline__ f32x2 gelu_pk(f32x2 v) {
    const f32x2 av = __builtin_elementwise_abs(v), d = av * 0.2316418882f + 1.0f;
    f32x2 t; t.x = __builtin_amdgcn_rcpf(d.x); t.y = __builtin_amdgcn_rcpf(d.y);
    f32x2 q = t * 0.5307027145f + (-0.7265760135f); q = q * t + 0.7107068705f; q = q * t + (-0.142248368f); q = q * t + 0.127414796f; q = q * t;
    const f32x2 s = (v * v) * (-0.72134752044f);
    f32x2 e; e.x = __builtin_amdgcn_exp2f(s.x); e.y = __builtin_amdgcn_exp2f(s.y);
    const f32x2 m = v * (q * e), r = v - m;
    f32x2 o; o.x = v.x < 0.f ? m.x : r.x; o.y = v.y < 0.f ? m.y : r.y; return o;
}

template <int ACT  > struct EpiBf16 {
    static constexpr bool PERM = true, AFTER_DRAIN = false; static_assert(ACT == 0 || ACT == 1, "EpiBf16: ACT is 0 (none) or 1 (gelu_pk)");
    bf16_t* O; int ldc; const float* bias; int split_cols; size_t split_stride; float scale0;
    __device__ __forceinline__ void operator()(const f32x4 (&acc)[2][2][4][2], const Unit& u, int wr, int wc, int fr, int fq) const {
        const int row0 = u.pm * BM + wr * 64 + fr; int colt = u.pn * BM; bf16_t* base = O;
        float sc = 1.f; if (split_cols) { const int t = colt / split_cols; base += (size_t)t * split_stride; colt -= t * split_cols; if (t == 0) sc = scale0; }
        const int col0 = colt + wc * 32 + 8 * fq, bcol0 = u.pn * BM + wc * 32 + 8 * fq;
        f32x4 bv[2][2];
#pragma unroll
        for (int bj = 0; bj < 2; ++bj)
#pragma unroll
            for (int n = 0; n < 2; ++n) bv[bj][n] = bias ? *(const f32x4*)(bias + bcol0 + bj * HALF + 4 * n) : (f32x4){0.f, 0.f, 0.f, 0.f};
#pragma unroll
        for (int ai = 0; ai < 2; ++ai)
#pragma unroll
            for (int m = 0; m < 4; ++m) { bf16_t* rowp = base + (size_t)(row0 + ai * HALF + m * 16) * ldc + col0;
#pragma unroll
                for (int bj = 0; bj < 2; ++bj) { f32x4 v0 = acc[ai][bj][m][0] + bv[bj][0], v1 = acc[ai][bj][m][1] + bv[bj][1];
                    if (ACT == 1) { f32x2 a = gelu_pk((f32x2){v0[0], v0[1]}), b = gelu_pk((f32x2){v0[2], v0[3]}), c = gelu_pk((f32x2){v1[0], v1[1]}), d = gelu_pk((f32x2){v1[2], v1[3]});
                        v0 = (f32x4){a.x, a.y, b.x, b.y}; v1 = (f32x4){c.x, c.y, d.x, d.y}; }
                    v0 = v0 * sc; v1 = v1 * sc; u32x4 w; w.x = cvt_pk_bf16(v0[0], v0[1]); w.y = cvt_pk_bf16(v0[2], v0[3]); w.z = cvt_pk_bf16(v1[0], v1[1]); w.w = cvt_pk_bf16(v1[2], v1[3]);
                    *(u32x4*)(rowp + bj * HALF) = w; } }
    }
};

struct EpiQm {
    static constexpr bool PERM = true, AFTER_DRAIN = false;
    bf16_t* O; int ldc; const float* rt; float scale; const float* ssq; float eps;
    __device__ __forceinline__ void operator()(const f32x4 (&acc)[2][2][4][2], const Unit& u, int wr, int wc, int fr, int fq) const {
        const int row0 = u.pm * BM + wr * 64 + fr, col0 = u.pn * BM + wc * 32 + 8 * fq;
#pragma unroll
        for (int ai = 0; ai < 2; ++ai)
#pragma unroll
            for (int m = 0; m < 4; ++m) { const int row = row0 + ai * HALF + m * 16;
                const f32x4 sq = *(const f32x4*)(ssq + (size_t)row * 4); const float rs = scale / sqrtf(((sq[0] + sq[1]) + (sq[2] + sq[3])) * (1.0f / 256.0f) + eps);
#pragma unroll
                for (int bj = 0; bj < 2; ++bj) { const int c = col0 + bj * HALF, d = c % 96;
                    f32x4 v0 = acc[ai][bj][m][0], v1 = acc[ai][bj][m][1];
                    if (d >= 64) { const f32x4* t = (const f32x4*)(rt + (size_t)row * 32 + (d - 64)); const f32x4 t0 = t[0], t1 = t[1];
                        f32x4 w0, w1;
                        w0[0] = v0[0] * t0[0] - v0[1] * t0[1]; w0[1] = v0[1] * t0[0] + v0[0] * t0[1];
                        w0[2] = v0[2] * t0[2] - v0[3] * t0[3]; w0[3] = v0[3] * t0[2] + v0[2] * t0[3];
                        w1[0] = v1[0] * t1[0] - v1[1] * t1[1]; w1[1] = v1[1] * t1[0] + v1[0] * t1[1];
                        w1[2] = v1[2] * t1[2] - v1[3] * t1[3]; w1[3] = v1[3] * t1[2] + v1[2] * t1[3];
                        v0 = w0; v1 = w1; }
                    v0 = v0 * rs; v1 = v1 * rs; u32x4 w; w.x = cvt_pk_bf16(v0[0], v0[1]); w.y = cvt_pk_bf16(v0[2], v0[3]); w.z = cvt_pk_bf16(v1[0], v1[1]); w.w = cvt_pk_bf16(v1[2], v1[3]);
                    *(u32x4*)(O + (size_t)row * ldc + c) = w; }
                asm volatile("" ::: "memory"); }
    }
};

struct EpiKv {
    static constexpr bool PERM = true, AFTER_DRAIN = false;
    bf16_t* O; int ldc; const float* ssq; float eps;
    __device__ __forceinline__ void operator()(const f32x4 (&acc)[2][2][4][2], const Unit& u, int wr, int wc, int fr, int fq) const {
        const int row0 = u.pm * BM + wr * 64 + fr, col0 = u.pn * BM + wc * 32 + 8 * fq;
#pragma unroll
        for (int ai = 0; ai < 2; ++ai)
#pragma unroll
            for (int m = 0; m < 4; ++m) { const int row = row0 + ai * HALF + m * 16;
                const f32x4 sq = *(const f32x4*)(ssq + (size_t)row * 4); const float rs = 1.0f / sqrtf(((sq[0] + sq[1]) + (sq[2] + sq[3])) * (1.0f / 128.0f) + eps);
#pragma unroll
                for (int bj = 0; bj < 2; ++bj) { const f32x4 v0 = acc[ai][bj][m][0] * rs, v1 = acc[ai][bj][m][1] * rs;
                    u32x4 w; w.x = cvt_pk_bf16(v0[0], v0[1]); w.y = cvt_pk_bf16(v0[2], v0[3]); w.z = cvt_pk_bf16(v1[0], v1[1]); w.w = cvt_pk_bf16(v1[2], v1[3]);
                    *(u32x4*)(O + (size_t)row * ldc + col0 + bj * HALF) = w; }
                asm volatile("" ::: "memory"); }
    }
};
struct EpiIn {
    static constexpr bool PERM = true, AFTER_DRAIN = false;
    bf16_t* O; int ldc; float scale0; float* ssq; float* sskv; const float* rt; const float* bf; float* lf; int nrows;
    __device__ __forceinline__ void operator()(const f32x4 (&acc)[2][2][4][2], const Unit& u, int wr, int wc, int fr, int fq) const {
        const int row0 = u.pm * BM + wr * 64 + fr, col0 = u.pn * BM + wc * 32 + 8 * fq; const int pn = u.pn;
        const float sc = pn < 2 ? scale0 : 1.f;
#pragma unroll
        for (int ai = 0; ai < 2; ++ai)
#pragma unroll
            for (int m = 0; m < 4; ++m) { const int row = row0 + ai * HALF + m * 16; bf16_t* rowp = O + (size_t)row * ldc + col0; float s0 = 0.f, s1 = 0.f;
#pragma unroll
                for (int bj = 0; bj < 2; ++bj) { f32x4 v0 = acc[ai][bj][m][0] * sc, v1 = acc[ai][bj][m][1] * sc;
                    const float sq = ((v0[0] * v0[0] + v0[1] * v0[1]) + (v0[2] * v0[2] + v0[3] * v0[3])) + ((v1[0] * v1[0] + v1[1] * v1[1]) + (v1[2] * v1[2] + v1[3] * v1[3]));
                    if (bj == 0) s0 = sq; else s1 = sq;
                    bool store = true;
                    if (pn == 7 && bj == 1) { store = (wc == 0);
                        if (wc == 0) { const f32x4* t = (const f32x4*)(rt + (size_t)row * 32 + 8 * fq); const f32x4 t0 = t[0], t1 = t[1]; f32x4 w0, w1;
                            w0[0] = v0[0] * t0[0] - v0[1] * t0[1]; w0[1] = v0[1] * t0[0] + v0[0] * t0[1];
                            w0[2] = v0[2] * t0[2] - v0[3] * t0[3]; w0[3] = v0[3] * t0[2] + v0[2] * t0[3];
                            w1[0] = v1[0] * t1[0] - v1[1] * t1[1]; w1[1] = v1[1] * t1[0] + v1[0] * t1[1];
                            w1[2] = v1[2] * t1[2] - v1[3] * t1[3]; w1[3] = v1[3] * t1[2] + v1[2] * t1[3];
                            v0 = w0; v1 = w1; }
                        else if (wc == 1 && fq == 0) {
#pragma unroll
                            for (int e = 0; e < 8; ++e) { const float z = (e < 4 ? v0[e & 3] : v1[e & 3]) + bf[e]; lf[(size_t)e * nrows + row] = fminf(z, 0.f) - 0.6931471805599453f * __builtin_amdgcn_logf(1.0f + __builtin_amdgcn_exp2f(-1.4426950408889634f * fabsf(z))); } } }
                    if (store) { u32x4 w; w.x = cvt_pk_bf16(v0[0], v0[1]); w.y = cvt_pk_bf16(v0[2], v0[3]); w.z = cvt_pk_bf16(v1[0], v1[1]); w.w = cvt_pk_bf16(v1[2], v1[3]);
                        *(u32x4*)(rowp + bj * HALF) = w; } }
                if (pn == 6) { float s = s0 + s1; s += __shfl_xor(s, 16); s += __shfl_xor(s, 32); if (fq == 0) ssq[(size_t)row * 4 + wc] = s; }
                if (pn == 7) { float s = s0; s += __shfl_xor(s, 16); s += __shfl_xor(s, 32); if (fq == 0) sskv[(size_t)row * 4 + wc] = s; }
                asm volatile("" ::: "memory"); }
    }
};
struct EpiRes {
    static constexpr bool PERM = false, AFTER_DRAIN = false;
    const float* base; float* out; int ldc; bf16_t* ob; float* ss;
    __device__ __forceinline__ void operator()(const f32x4 (&acc)[2][2][4][2], const Unit& u, int wr, int wc, int fr, int fq) const {
        typedef unsigned u32x2v __attribute__((ext_vector_type(2)));
        const int row0 = u.pm * BM + wr * 64 + fr, col0 = u.pn * BM + wc * 32 + 4 * fq;
        f32x4 cb[2][2], nb[2][2];
        { const size_t off = (size_t)row0 * ldc + col0;
#pragma unroll
          for (int bj = 0; bj < 2; ++bj)
#pragma unroll
              for (int n = 0; n < 2; ++n) cb[bj][n] = __builtin_nontemporal_load((const f32x4*)(base + off + bj * HALF + n * 16)); }
#pragma unroll
        for (int g = 0; g < 8; ++g) { const int ai = g >> 2, m = g & 3; const int row = row0 + ai * HALF + m * 16; const size_t off = (size_t)row * ldc + col0; float s = 0.f;
            if (g + 1 < 8) { const int ai1 = (g + 1) >> 2, m1 = (g + 1) & 3; const size_t off1 = (size_t)(row0 + ai1 * HALF + m1 * 16) * ldc + col0;
#pragma unroll
                for (int bj = 0; bj < 2; ++bj)
#pragma unroll
                    for (int n = 0; n < 2; ++n) nb[bj][n] = __builtin_nontemporal_load((const f32x4*)(base + off1 + bj * HALF + n * 16)); }
            asm volatile("" ::: "memory");
#pragma unroll
            for (int bj = 0; bj < 2; ++bj)
#pragma unroll
                for (int n = 0; n < 2; ++n) { const f32x4 v = cb[bj][n] + acc[ai][bj][m][n];
                    __builtin_nontemporal_store(v, (f32x4*)(out + off + bj * HALF + n * 16)); s += (v[0] * v[0] + v[1] * v[1]) + (v[2] * v[2] + v[3] * v[3]);
                    if (ob) { u32x2v w; w.x = cvt_pk_bf16(v[0], v[1]); w.y = cvt_pk_bf16(v[2], v[3]); *(u32x2v*)(ob + off + bj * HALF + n * 16) = w; } }
            if (ss) { s += __shfl_xor(s, 16); s += __shfl_xor(s, 32); if (fq == 0) ss[(size_t)row * 16 + u.pn * 4 + wc] = s; }
#pragma unroll
            for (int bj = 0; bj < 2; ++bj)
#pragma unroll
                for (int n = 0; n < 2; ++n) cb[bj][n] = nb[bj][n];
        }
    }
};

struct EpiResNorm {
    static constexpr bool PERM = false, AFTER_DRAIN = true;
    const float* base; float* out; int ldc; const float* g; float* xs; unsigned* cnt; float eps; float inv_n;
    __device__ __forceinline__ void fused(f32x4 (&acc)[2][2][4][2], const Unit& u, int wr, int wc, int fr, int fq, PG8_LAS unsigned char* lds, int wid, int lane) const {
        PG8_LAS float* Pm = (PG8_LAS float*)lds;
        PG8_LAS float* S = (PG8_LAS float*)(lds + 4096);
        const int row0 = u.pm * BM + wr * 64 + fr, col0 = u.pn * BM + wc * 32 + 4 * fq;
        f32x4 cb[2][2], nb[2][2];
        { const size_t off = (size_t)row0 * ldc + col0;
#pragma unroll
          for (int bj = 0; bj < 2; ++bj)
#pragma unroll
              for (int n = 0; n < 2; ++n) cb[bj][n] = __builtin_nontemporal_load((const f32x4*)(base + off + bj * HALF + n * 16)); }
#pragma unroll
        for (int g = 0; g < 8; ++g) { const int ai = g >> 2, m = g & 3; float s = 0.f;
            if (g + 1 < 8) { const size_t off1 = (size_t)(row0 + ((g + 1) >> 2) * HALF + ((g + 1) & 3) * 16) * ldc + col0;
#pragma unroll
                for (int bj = 0; bj < 2; ++bj)
#pragma unroll
                    for (int n = 0; n < 2; ++n) nb[bj][n] = __builtin_nontemporal_load((const f32x4*)(base + off1 + bj * HALF + n * 16)); }
            asm volatile("" ::: "memory");
#pragma unroll
            for (int bj = 0; bj < 2; ++bj)
#pragma unroll
                for (int n = 0; n < 2; ++n) { const f32x4 v = cb[bj][n] + acc[ai][bj][m][n]; acc[ai][bj][m][n] = v;
                    s += (v[0] * v[0] + v[1] * v[1]) + (v[2] * v[2] + v[3] * v[3]); }
            s += __shfl_xor(s, 16); s += __shfl_xor(s, 32);
            if (fq == 0) Pm[(ai * HALF + wr * 64 + m * 16 + fr) * 4 + wc] = s;
#pragma unroll
            for (int bj = 0; bj < 2; ++bj)
#pragma unroll
                for (int n = 0; n < 2; ++n) cb[bj][n] = nb[bj][n]; }
        asm volatile("s_waitcnt lgkmcnt(0)" ::: "memory"); __builtin_amdgcn_s_barrier(); asm volatile("" ::: "memory");
        const int tid = wid * 64 + lane;
        if (tid < 256) { const f32x4 p4 = *(const PG8_LAS f32x4*)(Pm + tid * 4);
            __hip_atomic_store(xs + (size_t)(u.pm * BM + tid) * 4 + u.pn, (p4[0] + p4[1]) + (p4[2] + p4[3]), __ATOMIC_RELAXED, __HIP_MEMORY_SCOPE_AGENT);
            asm volatile("s_waitcnt vmcnt(0)" ::: "memory");
            if (lane == 0) __hip_atomic_fetch_add(cnt + 64 * u.pm, 1u, __ATOMIC_RELAXED, __HIP_MEMORY_SCOPE_AGENT); }
        if (wid == 0) { unsigned sp = 0;
            while ((unsigned)__builtin_amdgcn_readfirstlane(__hip_atomic_load(cnt + 64 * u.pm, __ATOMIC_RELAXED, __HIP_MEMORY_SCOPE_AGENT)) < 16u) { __builtin_amdgcn_s_sleep(2); if (++sp > (1u << 22)) break; }
            __builtin_amdgcn_fence(__ATOMIC_ACQUIRE, "agent"); }
        asm volatile("s_waitcnt vmcnt(0) lgkmcnt(0)" ::: "memory"); __builtin_amdgcn_s_barrier(); asm volatile("" ::: "memory");
        if (tid < 256) { const float* xp = xs + (size_t)(u.pm * BM + tid) * 4;
            const float t0 = __hip_atomic_load(xp + 0, __ATOMIC_RELAXED, __HIP_MEMORY_SCOPE_AGENT), t1 = __hip_atomic_load(xp + 1, __ATOMIC_RELAXED, __HIP_MEMORY_SCOPE_AGENT);
            const float t2 = __hip_atomic_load(xp + 2, __ATOMIC_RELAXED, __HIP_MEMORY_SCOPE_AGENT), t3 = __hip_atomic_load(xp + 3, __ATOMIC_RELAXED, __HIP_MEMORY_SCOPE_AGENT);
            S[tid] = 1.0f / sqrtf(((t0 + t1) + (t2 + t3)) * inv_n + eps); }
        asm volatile("s_waitcnt vmcnt(0) lgkmcnt(0)" ::: "memory"); __builtin_amdgcn_s_barrier(); asm volatile("" ::: "memory");
        f32x4 gv[2][2];
#pragma unroll
        for (int bj = 0; bj < 2; ++bj)
#pragma unroll
            for (int n = 0; n < 2; ++n) gv[bj][n] = *(const f32x4*)(g + col0 + bj * HALF + n * 16);
#pragma unroll
        for (int ai = 0; ai < 2; ++ai)
#pragma unroll
            for (int m = 0; m < 4; ++m) { const int r = ai * HALF + wr * 64 + m * 16 + fr; const float rs = S[r]; const size_t off = (size_t)(u.pm * BM + r) * ldc + col0;
#pragma unroll
                for (int bj = 0; bj < 2; ++bj)
#pragma unroll
                    for (int n = 0; n < 2; ++n) __builtin_nontemporal_store(acc[ai][bj][m][n] * rs * gv[bj][n], (f32x4*)(out + off + bj * HALF + n * 16)); }
    }
};
struct EpiSqRelu {
    static constexpr bool PERM = true, AFTER_DRAIN = false;
    bf16_t* O; int ldc; const float* ss; float eps; float inv_n;
    __device__ __forceinline__ void operator()(const f32x4 (&acc)[2][2][4][2], const Unit& u, int wr, int wc, int fr, int fq) const {
        const int row0 = u.pm * BM + wr * 64 + fr, col0 = u.pn * BM + wc * 32 + 8 * fq;
        f32x4 cs[4], ns[4];
        { const f32x4* sp = (const f32x4*)(ss + (size_t)row0 * 16); cs[0] = sp[0]; cs[1] = sp[1]; cs[2] = sp[2]; cs[3] = sp[3]; }
#pragma unroll
        for (int g = 0; g < 8; ++g) { const int ai = g >> 2, m = g & 3; const int row = row0 + ai * HALF + m * 16;
            if (g + 1 < 8) { const f32x4* sp = (const f32x4*)(ss + (size_t)(row0 + ((g + 1) >> 2) * HALF + ((g + 1) & 3) * 16) * 16); ns[0] = sp[0]; ns[1] = sp[1]; ns[2] = sp[2]; ns[3] = sp[3]; }
            asm volatile("" ::: "memory");
            const f32x4 a = cs[0], b = cs[1], c = cs[2], d = cs[3];
            const float tot = ((a[0] + a[1]) + (a[2] + a[3])) + ((b[0] + b[1]) + (b[2] + b[3])) + ((c[0] + c[1]) + (c[2] + c[3])) + ((d[0] + d[1]) + (d[2] + d[3]));
            const float rstd = 1.0f / sqrtf(tot * inv_n + eps);
#pragma unroll
            for (int bj = 0; bj < 2; ++bj) { f32x4 v0 = acc[ai][bj][m][0] * rstd, v1 = acc[ai][bj][m][1] * rstd;
#pragma unroll
                for (int e = 0; e < 4; ++e) { const float x0 = fmaxf(v0[e], 0.f), x1 = fmaxf(v1[e], 0.f); v0[e] = x0 * x0; v1[e] = x1 * x1; }
                u32x4 w; w.x = cvt_pk_bf16(v0[0], v0[1]); w.y = cvt_pk_bf16(v0[2], v0[3]); w.z = cvt_pk_bf16(v1[0], v1[1]); w.w = cvt_pk_bf16(v1[2], v1[3]);
                *(u32x4*)(O + (size_t)row * ldc + col0 + bj * HALF) = w; }
            cs[0] = ns[0]; cs[1] = ns[1]; cs[2] = ns[2]; cs[3] = ns[3]; }
    }
};


template <class Epi, class Sched, bool ALIGN_EPI = false, bool SP2 = false>
__device__ __forceinline__ void gemm_phase(PG8_LAS unsigned char* lds, const Gemm g, const Sched& S, const Epi& E) {
    const int tid = threadIdx.x, wid = __builtin_amdgcn_readfirstlane(tid >> 6), lane = tid & 63, wr = wid >> 2, wc = wid & 3, fr = lane & 15, fq = lane >> 4;
    const int K = g.K, nt = K / BK, lda = g.lda ? g.lda : g.K;
    unsigned voffA[2], voffB[2];
#pragma unroll
    for (int i = 0; i < 2; ++i) { int R, C; stage_rc(tid * 16 + i * 8192, R, C); const int Rb = Epi::PERM ? ((R & ~31) + perm32(R & 31)) : R;
        voffA[i] = (unsigned)(R * lda + C) * 2u; voffB[i] = (unsigned)(Rb * K + C) * 2u; }
    const size_t kstep = (size_t)(BK * 2);
    const size_t hstep = (size_t)HALF * K * 2;
    const size_t tstep = 2 * hstep;
    const size_t hstepA = (size_t)HALF * lda * 2, tstepA = 2 * hstepA;
    const unsigned ldsw = (unsigned)wid * 1024u;
    const int aoff = lds_byte(wr * 64 + fr, fq * 8), boff = lds_byte(wc * 32 + fr, fq * 8);
#define PG8_SA(b, h) (((b) * 2 + (h)) * HTB)
#define PG8_SB(b, h) ((4 + (b) * 2 + (h)) * HTB)
#define PG8_STAGE(bufoff, gbase, voff) do { _Pragma("unroll") for (int _i = 0; _i < 2; ++_i) \
        __builtin_amdgcn_global_load_lds((const unsigned*)((const char*)(gbase) + (voff)[_i]), (PG8_LAS unsigned*)(lds + (bufoff) + ldsw + _i * 8192), 16, 0, 0); } while (0)
#define PG8_LDA(dst, b, h) do { _Pragma("unroll") for (int m = 0; m < 4; ++m) _Pragma("unroll") for (int k = 0; k < 2; ++k) dst[m][k] = *(const PG8_LAS bf16x8*)(lds + PG8_SA(b, h) + aoff + m * 2048 + k * 1024); } while (0)
#define PG8_LDB(dst, b, h) do { _Pragma("unroll") for (int n = 0; n < 2; ++n) _Pragma("unroll") for (int k = 0; k < 2; ++k) dst[n][k] = *(const PG8_LAS bf16x8*)(lds + PG8_SB(b, h) + boff + n * 2048 + k * 1024); } while (0)
#define PG8_MMA(ai, bj, At, Bt) do { __builtin_amdgcn_s_setprio(1); _Pragma("unroll") for (int m = 0; m < 4; ++m) _Pragma("unroll") for (int n = 0; n < 2; ++n) _Pragma("unroll") for (int k = 0; k < 2; ++k) \
        acc[ai][bj][m][n] = __builtin_amdgcn_mfma_f32_16x16x32_bf16(Bt[n][k], At[m][k], acc[ai][bj][m][n], 0, 0, 0); __builtin_amdgcn_s_setprio(0); } while (0)
#define PG8_WAIT_V(n) asm volatile("s_waitcnt vmcnt(" #n ")" ::: "memory")
#define PG8_WAIT_L(n) asm volatile("s_waitcnt lgkmcnt(" #n ")" ::: "memory")
#define PG8_BAR __builtin_amdgcn_s_barrier()
#define PG8_SCHED __builtin_amdgcn_sched_barrier(0)
    Unit cur, nxt; int ui = 0;
    if (!S.next(0, cur)) return;
    f32x4 acc[2][2][4][2];
#pragma unroll
    for (int a = 0; a < 2; ++a)
#pragma unroll
        for (int b = 0; b < 2; ++b)
#pragma unroll
            for (int m = 0; m < 4; ++m)
#pragma unroll
                for (int n = 0; n < 2; ++n) acc[a][b][m][n] = (f32x4){0.f, 0.f, 0.f, 0.f};
    bf16x8 At[4][2], B0[2][2], B1[2][2];
    const char* cA = (const char*)g.A + (size_t)cur.pm * tstepA; const char* cB = (const char*)g.Bt + (size_t)cur.pn * tstep;
    S.a_ready(cur);
    if constexpr (SP2) {
        PG8_STAGE(PG8_SB(0, 0), cB, voffB); PG8_STAGE(PG8_SB(0, 1), cB + hstep, voffB); PG8_STAGE(PG8_SA(0, 0), cA, voffA); PG8_STAGE(PG8_SA(0, 1), cA + hstepA, voffA);
        if (wr == 1) PG8_BAR;
        PG8_WAIT_V(2); PG8_BAR;
        PG8_STAGE(PG8_SB(1, 0), cB + kstep, voffB); PG8_STAGE(PG8_SA(1, 0), cA + kstep, voffA); PG8_STAGE(PG8_SB(1, 1), cB + hstep + kstep, voffB);
        PG8_WAIT_V(6); PG8_BAR;
    } else {
        PG8_STAGE(PG8_SB(0, 0), cB, voffB); PG8_STAGE(PG8_SA(0, 0), cA, voffA); PG8_STAGE(PG8_SB(0, 1), cB + hstep, voffB); PG8_STAGE(PG8_SA(0, 1), cA + hstepA, voffA);
        if (wr == 1) PG8_BAR;
        PG8_WAIT_V(4); PG8_BAR;
        PG8_STAGE(PG8_SB(1, 0), cB + kstep, voffB); PG8_STAGE(PG8_SA(1, 0), cA + kstep, voffA); PG8_STAGE(PG8_SB(1, 1), cB + hstep + kstep, voffB);
        PG8_WAIT_V(6); PG8_BAR;
    }
    for (;;) {
        const bool has_next = S.next(ui + 1, nxt);
        const char* nA = has_next ? (const char*)g.A + (size_t)nxt.pm * tstepA : cA; const char* nB = has_next ? (const char*)g.Bt + (size_t)nxt.pn * tstep : cB;
        for (int t = 0; t < nt; t += 2) {
            const bool last = (t == nt - 2);
            const char* a1 = cA + (size_t)(t + 1) * kstep;
            const char* a2 = last ? nA : cA + (size_t)(t + 2) * kstep; const char* b2 = last ? nB : cB + (size_t)(t + 2) * kstep;
            const char* a3 = a2 + kstep; const char* b3 = b2 + kstep;
            if (last && has_next) S.a_ready(nxt);
            if constexpr (SP2) {
            PG8_LDB(B0, 0, 0); PG8_LDB(B1, 0, 1); PG8_SCHED; PG8_LDA(At, 0, 0); PG8_STAGE(PG8_SA(1, 1), a1 + hstepA, voffA);
            PG8_WAIT_V(8); PG8_WAIT_L(0); PG8_BAR; PG8_MMA(0, 0, At, B0); PG8_MMA(0, 1, At, B1); PG8_BAR; PG8_SCHED;
            PG8_LDA(At, 0, 1); PG8_STAGE(PG8_SB(0, 0), b2, voffB); PG8_STAGE(PG8_SB(0, 1), b2 + hstep, voffB); PG8_STAGE(PG8_SA(0, 0), a2, voffA);
            PG8_WAIT_V(8); PG8_WAIT_L(0); PG8_BAR; PG8_MMA(1, 0, At, B0); PG8_MMA(1, 1, At, B1); PG8_BAR; PG8_SCHED;
            PG8_LDB(B0, 1, 0); PG8_LDB(B1, 1, 1); PG8_SCHED; PG8_LDA(At, 1, 0); PG8_STAGE(PG8_SA(0, 1), a2 + hstepA, voffA);
            PG8_WAIT_V(8); PG8_WAIT_L(0); PG8_BAR; PG8_MMA(0, 0, At, B0); PG8_MMA(0, 1, At, B1); PG8_BAR; PG8_SCHED;
            PG8_LDA(At, 1, 1); PG8_STAGE(PG8_SB(1, 0), b3, voffB); PG8_STAGE(PG8_SB(1, 1), b3 + hstep, voffB); PG8_STAGE(PG8_SA(1, 0), a3, voffA);
            PG8_WAIT_V(8); PG8_WAIT_L(0); PG8_BAR; PG8_MMA(1, 0, At, B0); PG8_MMA(1, 1, At, B1); PG8_BAR; PG8_SCHED;
            } else {
            PG8_LDB(B0, 0, 0); PG8_SCHED; PG8_LDA(At, 0, 0); PG8_STAGE(PG8_SA(1, 1), a1 + hstepA, voffA);
            PG8_WAIT_L(8); PG8_BAR; PG8_WAIT_L(0); PG8_MMA(0, 0, At, B0); PG8_BAR; PG8_SCHED;
            PG8_LDB(B1, 0, 1); PG8_STAGE(PG8_SB(0, 0), b2, voffB);
            PG8_BAR; PG8_WAIT_L(0); PG8_MMA(0, 1, At, B1); PG8_BAR;
            PG8_LDA(At, 0, 1); PG8_STAGE(PG8_SA(0, 0), a2, voffA);
            PG8_BAR; PG8_WAIT_L(0); PG8_MMA(1, 0, At, B0); PG8_BAR; PG8_SCHED;
            PG8_STAGE(PG8_SB(0, 1), b2 + hstep, voffB);
            PG8_WAIT_V(6); PG8_BAR; PG8_MMA(1, 1, At, B1); PG8_BAR;
            PG8_LDB(B0, 1, 0); PG8_SCHED; PG8_LDA(At, 1, 0); PG8_STAGE(PG8_SA(0, 1), a2 + hstepA, voffA);
            PG8_WAIT_L(8); PG8_BAR; PG8_WAIT_L(0); PG8_MMA(0, 0, At, B0); PG8_BAR; PG8_SCHED;
            PG8_LDB(B1, 1, 1); PG8_STAGE(PG8_SB(1, 0), b3, voffB);
            PG8_BAR; PG8_WAIT_L(0); PG8_MMA(0, 1, At, B1); PG8_BAR;
            PG8_LDA(At, 1, 1); PG8_STAGE(PG8_SA(1, 0), a3, voffA);
            PG8_BAR; PG8_WAIT_L(0); PG8_MMA(1, 0, At, B0); PG8_BAR; PG8_SCHED;
            PG8_STAGE(PG8_SB(1, 1), b3 + hstep, voffB);
            PG8_WAIT_V(6); PG8_BAR; PG8_MMA(1, 1, At, B1); PG8_BAR;
            }
        }
        if constexpr (ALIGN_EPI) { if (wr == 0) PG8_BAR; }
        if constexpr (!Epi::AFTER_DRAIN) { E(acc, cur, wr, wc, fr, fq); S.done(cur); }
        if (!has_next) break;
#pragma unroll
        for (int a = 0; a < 2; ++a)
#pragma unroll
            for (int b = 0; b < 2; ++b)
#pragma unroll
                for (int m = 0; m < 4; ++m)
#pragma unroll
                    for (int n = 0; n < 2; ++n) acc[a][b][m][n] = (f32x4){0.f, 0.f, 0.f, 0.f};
        cur = nxt; cA = nA; cB = nB; ++ui;
        if constexpr (ALIGN_EPI) { if (wr == 1) PG8_BAR; }
    }
    PG8_WAIT_V(0);
    if constexpr (!ALIGN_EPI) { if (wr == 0) PG8_BAR; }
    PG8_BAR;
    if constexpr (Epi::AFTER_DRAIN) { E.fused(acc, cur, wr, wc, fr, fq, lds, wid, lane); S.done(cur); }
#undef PG8_SA
#undef PG8_SB
#undef PG8_STAGE
#undef PG8_LDA
#undef PG8_LDB
#undef PG8_MMA
#undef PG8_WAIT_V
#undef PG8_WAIT_L
#undef PG8_BAR
#undef PG8_SCHED
}
}

#ifndef PG8_SP2
#define PG8_SP2 true
#endif
#ifndef PG8_ALIGN
#define PG8_ALIGN true
#endif
namespace att {
#define LAS3 __attribute__((address_space(3)))
using bf16x8 = __attribute__((ext_vector_type(8))) short;
using s16x4 = __attribute__((ext_vector_type(4))) short;
using f32x16 = __attribute__((ext_vector_type(16))) float;
using f32x4 = __attribute__((ext_vector_type(4))) float;
using u32x4 = __attribute__((ext_vector_type(4))) unsigned;
typedef unsigned short u16;
typedef LAS3 const unsigned char* lds_cptr;
typedef short v4i16_t __attribute__((ext_vector_type(4)));
constexpr int SEQ = 16384, NW = 8, QBLK = 32, QB = 256, KVBLK = 64;
constexpr int KSLOT = 12288, VSLOT = 8192, NKS = 4, NVS = 4;
constexpr int LDS_K = 0, LDS_V = NKS * KSLOT, LDS_WS = LDS_V + NVS * VSLOT, LDS_OST = LDS_WS + NW * 256, LDS_QX = LDS_OST + NW * 4096, LDS_BYTES = LDS_QX + NW * 2048;
__device__ __forceinline__ int crow(int r, int hi) { return (r & 3) + 8 * (r >> 2) + 4 * hi; }
__device__ __forceinline__ void glds16(const void* gsrc, unsigned lds_dst) {
    asm volatile("s_mov_b32 m0, %1\n\ts_nop 0\n\tglobal_load_lds_dwordx4 %0, off" : : "v"(gsrc), "s"(lds_dst) : "memory", "m0"); }
typedef float f32x2_t __attribute__((ext_vector_type(2))); typedef __bf16 bf16x2_t __attribute__((ext_vector_type(2)));
__device__ __forceinline__ unsigned cvtpk_s(float lo, float hi) { f32x2_t v = {lo, hi}; bf16x2_t b = __builtin_convertvector(v, bf16x2_t); return __builtin_bit_cast(unsigned, b); }
__device__ __forceinline__ s16x4 vtr(lds_cptr p) { return __builtin_bit_cast(s16x4, __builtin_amdgcn_ds_read_tr16_b64_v4i16((LAS3 v4i16_t*)p)); }
#define ATT_SBAR() __builtin_amdgcn_sched_barrier(0)
#define ATT_WAIT_BAR(N) asm volatile("s_waitcnt vmcnt(" #N ") lgkmcnt(0)\n\ts_barrier" ::: "memory")
struct Src {
    const u16* q; int qp;
    const u16* k; int kp;
    const u16* k2; int k2p;
    const u16* v; int vp;
    u16* o; int op;
};
template <int NDK, int NQR, bool ZC, int XHS, int JLO, int JHI, bool EARLY>
__device__ __forceinline__ void phase_a(f32x16& C0, f32x16& C1, const lds_cptr* kb_, int ksl_, const bf16x8* qr, lds_cptr qx_, const f32x16& negm, bf16x8* kf, bf16x8* qx) {
    constexpr int KPF = 4;
#define ATT_SH(s_) (EARLY ? ((s_) / NDK) : ((s_) & 1))
#define ATT_SD(s_) (EARLY ? ((s_) % NDK) : ((s_) >> 1))
#define ATT_KRD(s_) kf[s_] = *(const LAS3 bf16x8*)(kb_[ATT_SD(s_)] + ksl_ + ATT_SH(s_) * (ATT_SD(s_) < 4 ? 4096 : XHS))
    if (JLO == 0) {
#pragma unroll
        for (int j = 0; j < KPF; ++j) ATT_KRD(j); }
#pragma unroll
    for (int j = JLO; j < JHI; ++j) {
        if (j + KPF < 2 * NDK) ATT_KRD(j + KPF);
        { const int dn = ATT_SD(j) + 2; if (NDK > NQR && dn >= NQR && dn < NDK && (EARLY || ATT_SH(j) == 0)) qx[dn >= NQR ? dn - NQR : 0] = *(const LAS3 bf16x8*)(qx_ + (dn >= NQR ? dn - NQR : 0) * 1024); }
        ATT_SBAR();
        const int d0 = ATT_SD(j); const f32x16 z = f32x16{}; const bf16x8 qf = (d0 < NQR) ? qr[d0 < NQR ? d0 : 0] : qx[d0 >= NQR ? d0 - NQR : 0];
        if (ATT_SH(j)) C1 = __builtin_amdgcn_mfma_f32_32x32x16_bf16(kf[j], qf, (d0 == 0) ? (ZC ? z : negm) : C1, 0, 0, 0);
        else           C0 = __builtin_amdgcn_mfma_f32_32x32x16_bf16(kf[j], qf, (d0 == 0) ? (ZC ? z : negm) : C0, 0, 0, 0);
        if (EARLY && j > NDK) { const int e0 = 16 * (j - NDK - 1) / (NDK - 1), e1 = 16 * (j - NDK) / (NDK - 1);
#pragma unroll
            for (int e = e0; e < e1; ++e) C0[e] = __builtin_amdgcn_exp2f(C0[e]);
            asm volatile("" : "+v"(C0)); }
        ATT_SBAR();
    }
#undef ATT_KRD
#undef ATT_SH
#undef ATT_SD
}
template <bool QK, bool FIN, bool EARLY>
__device__ __forceinline__ void phase_b(f32x16& C0, f32x16& C1, f32x16* o, lds_cptr vp_, u32x4* pw, float& l_reg) {
    s16x4 vlo[8], vhi[8]; float sacc = 0.f, sacd = 0.f;
#define ATT_VRD(i) do { const int vi_ = ((i) >> 1) + 4 * ((i) & 1); vlo[i] = vtr(vp_ + ((vi_ >> 2) * 4096 + (vi_ & 3) * 1024)); vhi[i] = vtr(vp_ + ((vi_ >> 2) * 4096 + (vi_ & 3) * 1024 + 512)); } while (0)
    if (FIN) { ATT_VRD(0); ATT_VRD(1); }
#pragma unroll
    for (int i = 0; i < 8; ++i) {
        if (FIN && i + 2 < 8) ATT_VRD(i + 2);
        ATT_SBAR();
        if (FIN) { const bf16x8 vf = (bf16x8){vlo[i][0], vlo[i][1], vlo[i][2], vlo[i][3], vhi[i][0], vhi[i][1], vhi[i][2], vhi[i][3]};
            o[i & 1] = __builtin_amdgcn_mfma_f32_32x32x16_bf16(__builtin_bit_cast(bf16x8, pw[i >> 1]), vf, o[i & 1], 0, 0, 0); }
        if (QK) { f32x16& X = (i < 4) ? C0 : C1; const int b = 4 * (i & 3);
            if (EARLY) { C1[2 * i] = __builtin_amdgcn_exp2f(C1[2 * i]); C1[2 * i + 1] = __builtin_amdgcn_exp2f(C1[2 * i + 1]); asm volatile("" : "+v"(C1)); }
            else { X[b] = __builtin_amdgcn_exp2f(X[b]); X[b + 1] = __builtin_amdgcn_exp2f(X[b + 1]); X[b + 2] = __builtin_amdgcn_exp2f(X[b + 2]); X[b + 3] = __builtin_amdgcn_exp2f(X[b + 3]); }
            sacc += X[b]; sacd += X[b + 1]; sacc += X[b + 2]; sacd += X[b + 3]; asm volatile("" : "+v"(sacc), "+v"(sacd));
            if (i & 1) { const int k = i >> 1, c = 8 * (k & 1);
                pw[k] = (u32x4){cvtpk_s(X[c], X[c + 1]), cvtpk_s(X[c + 2], X[c + 3]), cvtpk_s(X[c + 4], X[c + 5]), cvtpk_s(X[c + 6], X[c + 7])}; asm volatile("" : "+v"(pw[k])); } }
        ATT_SBAR();
    }
#undef ATT_VRD
    if (QK) l_reg += sacc + sacd;
}
template <bool MLA, bool FIX> __device__ __forceinline__ void attn_unit(int qb, const Src& s, LAS3 unsigned char* shm, const float* bias_h, float kmax2, const float* qmax_h) {
    constexpr int NDK = MLA ? 6 : 5, NX = MLA ? 4 : 1, NQR = MLA ? 4 : 5;
    constexpr float THRL = MLA ? 8.0f : 16.0f;
    const int tid = threadIdx.x, lane = tid & 63, r32 = lane & 31, hi = lane >> 5; const int wid = __builtin_amdgcn_readfirstlane(tid >> 6);
    const int q0 = qb * QB;
    const unsigned lds0 = (unsigned)(uintptr_t)shm;
    LAS3 float* wsf = (LAS3 float*)(shm + LDS_WS) + wid * 64;
    const int NT = (q0 + QB) / KVBLK;
    const int wvis = NT - 4 + (wid >> 1);
    const bool xw = wid < NX;
    const int krow = 8 * wid + (lane >> 3);
    const u16* ksrc = s.k + (size_t)krow * s.kp + (((lane & 7) ^ ((krow >> 1) & 7)) * 8);
    const int k2row = 16 * (wid & 3) + (lane >> 2);
    const u16* k2src = MLA ? s.k2 + (size_t)k2row * s.k2p + (((lane & 3) ^ ((k2row >> 2) & 3)) * 8) : s.k2 + (size_t)lane * s.k2p;
    const u16* vsrc = s.v + (size_t)(16 * (wid & 3) + (lane >> 2)) * s.vp + (wid >> 2) * 32 + (lane & 3) * 8;
    const unsigned kdst = lds0 + LDS_K + wid * 1024, k2dst = lds0 + LDS_K + (8 + (wid & 3)) * 1024, vdst = lds0 + LDS_V + wid * 1024;
#define ATT_DMA_K(t) do { const int sl_ = (t) & 3; glds16(ksrc + (size_t)(t) * KVBLK * s.kp, (unsigned)__builtin_amdgcn_readfirstlane(kdst + sl_ * KSLOT)); \
        if (xw) glds16(k2src + (size_t)(t) * KVBLK * s.k2p, (unsigned)__builtin_amdgcn_readfirstlane(k2dst + sl_ * KSLOT)); } while (0)
#define ATT_DMA_V(t, vsl) glds16(vsrc + (size_t)(t) * KVBLK * s.vp, (unsigned)__builtin_amdgcn_readfirstlane(vdst + (vsl)))
    if (!MLA) {
        if (tid < 256) { const int sl = tid >> 6; *(LAS3 f32x4*)(shm + LDS_K + sl * KSLOT + 9 * 1024 + (tid & 63) * 16) = (f32x4){0.f, 0.f, 0.f, 0.f}; } }
    if (MLA) { ATT_DMA_K(0); ATT_DMA_V(0, 0); ATT_DMA_K(1); ATT_DMA_K(2); }
    const u16* Qw = s.q + (size_t)(q0 + wid * QBLK + r32) * s.qp + hi * 8;
    bf16x8 qr[NQR];
#pragma unroll
    for (int d0 = 0; d0 < 4; ++d0) qr[d0] = __builtin_nontemporal_load(reinterpret_cast<const bf16x8*>(Qw + d0 * 16));
    const lds_cptr qx0 = (lds_cptr)shm + LDS_QX + wid * 2048 + lane * 16;
    float mla_ref = 0.f;
    if (MLA) { const bf16x8 q4 = *reinterpret_cast<const bf16x8*>(Qw + 64), q5 = *reinterpret_cast<const bf16x8*>(Qw + 80);
        *(LAS3 bf16x8*)(shm + LDS_QX + wid * 2048 + lane * 16) = q4; *(LAS3 bf16x8*)(shm + LDS_QX + wid * 2048 + 1024 + lane * 16) = q5;
        if (FIX) { float nq = 0.f;
#pragma unroll
            for (int e = 0; e < 8; ++e) { const float a = __uint_as_float((unsigned)(unsigned short)q4[e] << 16), b = __uint_as_float((unsigned)(unsigned short)q5[e] << 16); nq += a * a + b * b; }
#pragma unroll
            for (int d0 = 0; d0 < 4; ++d0)
#pragma unroll
                for (int e = 0; e < 8; ++e) { const float a = __uint_as_float((unsigned)(unsigned short)qr[d0][e] << 16); nq += a * a; }
            nq += __shfl_xor(nq, 32); mla_ref = sqrtf(nq * kmax2); } }
    const short one = hi ? (short)0 : (short)0x3F80;
    if (!MLA) qr[NQR - 1] = (bf16x8){one, one, one, 0, 0, 0, 0, 0};
    int t0 = 0;
    if (!MLA) {
        const float qm = qmax_h[qb];
        const float bunit = sqrtf(qm * kmax2);
        const float thr = FIX ? bias_h[q0] - 152.f : bias_h[q0] - 170.f - 2.f * bunit;
        if (FIX) { const float nm_ = -(bias_h[q0 + wid * QBLK + r32] + bunit); const unsigned h_ = cvtpk_s(nm_, 0.f) & 0xffffu; const float r1_ = nm_ - __uint_as_float(h_ << 16); const unsigned m_ = cvtpk_s(r1_, 0.f) & 0xffffu;
            const float r2_ = r1_ - __uint_as_float(m_ << 16); const unsigned l_ = cvtpk_s(r2_, 0.f) & 0xffffu;
            if (hi == 0) qr[NQR - 1] = (bf16x8){one, one, one, (short)h_, (short)m_, (short)l_, 0, 0}; }
        int best = 0;
        for (int tt = 1 + lane; tt <= NT - 4; tt += 64) { if (bias_h[64 * tt - 1] < thr) best = tt; }
#pragma unroll
        for (int o_ = 32; o_ >= 1; o_ >>= 1) best = max(best, __shfl_xor(best, o_));
        t0 = __builtin_amdgcn_readfirstlane(best);
    }
    if (!MLA) { ATT_DMA_K(t0); ATT_DMA_V(t0, (t0 & 3) * VSLOT); ATT_DMA_K(t0 + 1); ATT_DMA_K(t0 + 2); }
    float mhat = 0.f, l_reg = 0.f; f32x16 o[2]; o[0] = f32x16{}; o[1] = f32x16{}; f32x16 negm = f32x16{};
    if (MLA && FIX) {
#pragma unroll
        for (int r = 0; r < 16; ++r) negm[r] = -mla_ref; }
    const int qrel = wid * QBLK + r32;
    lds_cptr kb[NDK];
#pragma unroll
    for (int d0 = 0; d0 < 4; ++d0) kb[d0] = (lds_cptr)shm + LDS_K + r32 * 128 + ((((2 * d0 + hi) ^ ((r32 >> 1) & 7))) << 4);
    if (MLA) {
#pragma unroll
        for (int d0 = 4; d0 < NDK; ++d0) kb[d0] = (lds_cptr)shm + LDS_K + 8192 + r32 * 64 + ((((2 * (d0 - 4) + hi) ^ ((r32 >> 2) & 3))) << 4);
    } else kb[NDK - 1] = (lds_cptr)shm + LDS_K + 8192 + hi * 1024 + r32 * 16;
    constexpr int XHS = MLA ? 2048 : 512;
    const lds_cptr vp0 = (lds_cptr)shm + LDS_V + ((lane >> 4) & 1) * 32 + (lane & 3) * 8 + (4 * hi + ((lane & 15) >> 2)) * 64;
    f32x16 C0, C1; u32x4 pw[4]; bool resc = false;
#define ATT_TOP(t) do { if ((t) == t0 || (t) + 2 >= NT) { ATT_WAIT_BAR(0); } else if (xw) { ATT_WAIT_BAR(3); } else { ATT_WAIT_BAR(2); } \
        } while (0)
#define ATT_ISSUE(t) do { if ((t) + 3 < NT) ATT_DMA_K((t) + 3); if ((t) + 1 < NT) ATT_DMA_V((t) + 1, (((t) + 1) & 3) * VSLOT); } while (0)
#ifdef ATT_QKPRIO
#define ATT_PRIO_ON() __builtin_amdgcn_s_setprio(1)
#define ATT_PRIO_OFF() __builtin_amdgcn_s_setprio(0)
#else
#define ATT_PRIO_ON()
#define ATT_PRIO_OFF()
#endif
#define ATT_QK(t, E) do { bf16x8 kf_[2 * NDK]; bf16x8 qx_[NDK > NQR ? NDK - NQR : 1]; \
        phase_a<NDK, NQR, !MLA, XHS, 0, 4, E>(C0, C1, ATT_KS(t), qr, qx0, negm, kf_, qx_); ATT_ISSUE(t); ATT_SBAR(); \
        phase_a<NDK, NQR, !MLA, XHS, 4, 2 * NDK, E>(C0, C1, ATT_KS(t), qr, qx0, negm, kf_, qx_); } while (0)
#define ATT_MASK(C0, C1, t) do { const int kbq_ = 64 * ((t) - (NT - 4)) + 4 * hi; \
        _Pragma("unroll") for (int r = 0; r < 16; ++r) { const int kv_ = kbq_ + (r & 3) + 8 * (r >> 2); if (kv_ > qrel) C0[r] = -INFINITY; if (kv_ + 32 > qrel) C1[r] = -INFINITY; } } while (0)
#define ATT_DECIDE(C0, C1, FIRST) do { if (!FIX) { \
        float a_ = fmaxf(fmaxf(C0[0], C0[1]), C1[0]), b_ = fmaxf(fmaxf(C0[2], C0[3]), C1[1]); a_ = fmaxf(fmaxf(a_, C1[2]), C1[3]); \
        _Pragma("unroll") for (int r = 4; r < 16; r += 4) { a_ = fmaxf(fmaxf(a_, C0[r]), C0[r + 1]); b_ = fmaxf(fmaxf(b_, C0[r + 2]), C0[r + 3]); a_ = fmaxf(fmaxf(a_, C1[r]), C1[r + 1]); b_ = fmaxf(fmaxf(b_, C1[r + 2]), C1[r + 3]); } \
        float rm_ = fmaxf(a_, b_); { auto rr_ = __builtin_amdgcn_permlane32_swap(__float_as_uint(rm_), __float_as_uint(rm_), false, false); rm_ = fmaxf(__uint_as_float(rr_[0]), __uint_as_float(rr_[1])); } \
        resc = false; \
        if ((FIRST) || __any(rm_ > THRL)) { float dl_ = (FIRST) ? rm_ : fmaxf(rm_, 0.f); \
            if (!MLA) { const float nm_ = -(mhat + dl_); const unsigned h_ = cvtpk_s(nm_, 0.f) & 0xffffu; const float r1_ = nm_ - __uint_as_float(h_ << 16); const unsigned m_ = cvtpk_s(r1_, 0.f) & 0xffffu; \
                const float r2_ = r1_ - __uint_as_float(m_ << 16); const unsigned l_ = cvtpk_s(r2_, 0.f) & 0xffffu; \
                const float mn_ = -((__uint_as_float(h_ << 16) + __uint_as_float(m_ << 16)) + __uint_as_float(l_ << 16)); dl_ = mn_ - mhat; mhat = mn_; \
                if (hi == 0) qr[NQR - 1] = (bf16x8){one, one, one, (short)h_, (short)m_, (short)l_, 0, 0}; } \
            else { mhat += dl_; _Pragma("unroll") for (int r = 0; r < 16; ++r) negm[r] = -mhat; } \
            _Pragma("unroll") for (int r = 0; r < 16; ++r) { C0[r] -= dl_; C1[r] -= dl_; } \
            if (!(FIRST)) { const float f_ = __builtin_amdgcn_exp2f(-dl_); l_reg *= f_; if (hi == 0) wsf[r32] = f_; resc = true; } } } } while (0)
#define ATT_RESC() do { if (!FIX && resc) { \
        _Pragma("unroll") for (int i = 0; i < 4; ++i) { const f32x4 fv_ = *(const LAS3 f32x4*)(wsf + 8 * i + 4 * hi); \
            _Pragma("unroll") for (int d = 0; d < 2; ++d) { o[d][4 * i] *= fv_[0]; o[d][4 * i + 1] *= fv_[1]; o[d][4 * i + 2] *= fv_[2]; o[d][4 * i + 3] *= fv_[3]; } } } } while (0)
#define ATT_VS(tt) (vp0 + (((tt)) & 3) * VSLOT)
#define ATT_KS(tt) kb, ((((tt)) & 3) * KSLOT)
#ifndef ATT_STAGGER
#define ATT_STAGGER 0
#endif
    if (!ATT_STAGGER || wid < 4) {
#define ATT_STEP(t, MASKED) do { ATT_TOP(t); \
        constexpr bool E_ = FIX && (MLA || !(MASKED)); \
        ATT_QK(t, E_); \
        if (!MLA && (MASKED)) ATT_MASK(C0, C1, t); \
        ATT_DECIDE(C0, C1, false); ATT_SBAR(); \
        phase_b<true, true, E_>(C0, C1, o, ATT_VS((t) - 1), pw, l_reg); \
        ATT_RESC(); } while (0)
        ATT_TOP(t0);
        ATT_QK(t0, false);
        if (!MLA && wvis == t0) ATT_MASK(C0, C1, t0);
        ATT_DECIDE(C0, C1, true); ATT_SBAR();
        phase_b<true, false, false>(C0, C1, o, vp0, pw, l_reg);
        int t = t0 + 1;
        for (; t < wvis; ++t) ATT_STEP(t, false);
        if (t == wvis) { ATT_STEP(t, true); ++t; }
        { ATT_TOP(t); ATT_ISSUE(t); phase_b<false, true, false>(C0, C1, o, ATT_VS(t - 1), pw, l_reg); ++t; }
        for (; t <= NT + ATT_STAGGER; ++t) { ATT_TOP(t); ATT_ISSUE(t); }
#undef ATT_STEP
    } else {
        ATT_TOP(t0);
        ATT_QK(t0, false);
        ATT_DECIDE(C0, C1, true); ATT_SBAR();
        ATT_TOP(t0 + 1);
        phase_b<true, false, false>(C0, C1, o, vp0, pw, l_reg); ATT_SBAR();
        ATT_QK(t0 + 1, false);
        ATT_DECIDE(C0, C1, false); ATT_SBAR();
        int t = t0 + 2;
#define ATT_STEP2(t, MASKED) do { ATT_TOP(t); \
        phase_b<true, true, false>(C0, C1, o, ATT_VS((t) - 2), pw, l_reg); \
        ATT_RESC(); ATT_SBAR(); \
        ATT_QK(t, false); \
        if (!MLA && (MASKED)) ATT_MASK(C0, C1, t); \
        ATT_DECIDE(C0, C1, false); ATT_SBAR(); } while (0)
        for (; t < wvis; ++t) ATT_STEP2(t, false);
        ATT_STEP2(t, true); ++t;
        { ATT_TOP(t); ATT_ISSUE(t); phase_b<true, true, false>(C0, C1, o, ATT_VS(t - 2), pw, l_reg); ATT_RESC(); ++t; }
        { ATT_TOP(t); ATT_ISSUE(t); phase_b<false, true, false>(C0, C1, o, ATT_VS(t - 2), pw, l_reg); ++t; }
        for (; t <= NT + ATT_STAGGER; ++t) { ATT_TOP(t); ATT_ISSUE(t); }
#undef ATT_STEP2
    }
    { auto rr = __builtin_amdgcn_permlane32_swap(__float_as_uint(l_reg), __float_as_uint(l_reg), false, false); l_reg = __uint_as_float(rr[0]) + __uint_as_float(rr[1]); }
    if (hi == 0) wsf[32 + r32] = 1.0f / l_reg;
    float rli[16];
#pragma unroll
    for (int i = 0; i < 4; ++i) { const f32x4 fv = *(const LAS3 f32x4*)(wsf + 32 + 8 * i + 4 * hi); rli[4 * i] = fv[0]; rli[4 * i + 1] = fv[1]; rli[4 * i + 2] = fv[2]; rli[4 * i + 3] = fv[3]; }
    u16* Ow = s.o + (size_t)(q0 + wid * QBLK) * s.op;
    { LAS3 u16* stg = (LAS3 u16*)(shm + LDS_OST) + wid * 2048;
#pragma unroll
        for (int r = 0; r < 16; ++r) { const int orow = crow(r, hi);
#pragma unroll
            for (int d0 = 0; d0 < 2; ++d0) stg[orow * 64 + d0 * 32 + r32] = (u16)(cvtpk_s(o[d0][r] * rli[r], 0.f) & 0xffffu); }
        asm volatile("s_waitcnt lgkmcnt(0)" ::: "memory");
#pragma unroll
        for (int i = 0; i < 4; ++i) { const int row = i * 8 + (lane >> 3), ch = lane & 7; const u32x4 v = *(const LAS3 u32x4*)(stg + row * 64 + ch * 8); *(u32x4*)(Ow + (size_t)row * s.op + ch * 8) = v; } }
    asm volatile("s_waitcnt lgkmcnt(0)\n\ts_barrier" ::: "memory");
#undef ATT_DMA_K
#undef ATT_DMA_V
#undef ATT_TOP
#undef ATT_ISSUE
#undef ATT_QK
#undef ATT_MASK
#undef ATT_DECIDE
#undef ATT_RESC
#undef ATT_STEP
}
}

namespace cg = cooperative_groups;
#define LAS __attribute__((address_space(3)))
typedef unsigned short bf16;
typedef unsigned v4u __attribute__((ext_vector_type(4)));
typedef unsigned v2u __attribute__((ext_vector_type(2)));
typedef float f32x4 __attribute__((ext_vector_type(4)));
constexpr int NWAVES = 8;
constexpr int M = 16384, D = 1024, FF = 4096, NIN = 1960, NINP = 2048, QL = 256, KVL = 128, NQU = 768, NKVU = 1024;
constexpr float EPS = 1e-6f;
constexpr float LOG2E = 1.4426950408889634f;
constexpr float C2_FOX = 0.125f * LOG2E, C2_MLA = 0.10206207261596575f * LOG2E;
constexpr size_t MiB = 1u << 20;
constexpr size_t WS_WIN = 1 * MiB, WS_WQ = 5 * MiB, WS_WKV = 5 * MiB + 512 * 1024, WS_WO = 6 * MiB, WS_W1 = 8 * MiB, WS_W2 = 16 * MiB;
constexpr size_t WS_RT = 24 * MiB, WS_LF = 26 * MiB, WS_LC = 26 * MiB + 512 * 1024, WS_SS = 27 * MiB, WS_KR = 28 * MiB, WS_KB = 29 * MiB, WS_SSQ = 31 * MiB, WS_SSKV = 31 * MiB + 512 * 1024, WS_BIASF = 28 * MiB;
constexpr size_t WS_XN = 32 * MiB, WS_H = 64 * MiB, WS_P = 64 * MiB, WS_QM = 128 * MiB, WS_KVM = 152 * MiB, WS_QN = 184 * MiB, WS_O = 192 * MiB, WS_KVN = 224 * MiB, WS_END = 228 * MiB;
constexpr int RING_BYTES = 131072, LDS_BYTES = 147456;
static_assert(att::LDS_BYTES <= LDS_BYTES, "attention scratch fits the LDS allocation");

__device__ __forceinline__ unsigned f2bf(float f) { unsigned u = __builtin_bit_cast(unsigned, f); return (u + 0x7fffu + ((u >> 16) & 1u)) >> 16; }
__device__ __forceinline__ unsigned pk2(float lo, float hi) { return f2bf(lo) | (f2bf(hi) << 16); }
__device__ __forceinline__ float bf2f(unsigned short h) { return __builtin_bit_cast(float, (unsigned)h << 16); }
__device__ __forceinline__ float wave_sum(float v) {
#pragma unroll
    for (int o = 1; o < 64; o <<= 1) v += __shfl_xor(v, o);
    return v;
}
__device__ __forceinline__ int map_row(int mode, int n) {
    if (mode == 1) { const int h = n / 96, d = n % 96; if (d < 64) return n; const int i = d - 64; return h * 96 + (i < 16 ? 64 + 2 * i : 64 + 2 * (i - 16) + 1); }
    if (mode == 2) { const int h = n >> 7, j = n & 127; return j < 64 ? h * 64 + j : 512 + h * 64 + (j - 64); }
    if (mode == 3) { if (n < 1536 || n >= 1960) return n; if (n < 1544) return 1952 + (n - 1536); if (n < 1800) return 1536 + (n - 1544); if (n < 1928) return 1792 + (n - 1800);
        const int i = n - 1928; return 1920 + (i < 16 ? 2 * i : 2 * (i - 16) + 1); }
    return n;
}
__device__ __forceinline__ void p0_transpose_item(const float* W, int K, int N, int nblk, bf16* WT, int mode, const float* gk, LAS float* scr, int item, int lane) {
    const int kb = item / nblk, nb = item % nblk, k0 = 64 * kb, n0 = 32 * nb;
    const int nn = n0 + (lane & 31);
    float wv[32];
#pragma unroll
    for (int i = 0; i < 32; ++i) { const int kk = 2 * i + (lane >> 5); wv[i] = (nn < N) ? __builtin_nontemporal_load(W + (size_t)(k0 + kk) * N + nn) : 0.f; }
    if (gk) {
#pragma unroll
        for (int i = 0; i < 32; ++i) wv[i] *= gk[k0 + 2 * i + (lane >> 5)]; }
#pragma unroll
    for (int i = 0; i < 32; ++i) { const int kk = 2 * i + (lane >> 5); scr[kk * 33 + (lane & 31)] = wv[i]; }
    asm volatile("s_waitcnt lgkmcnt(0)" ::: "memory");
    const int c = lane & 7;
#pragma unroll
    for (int j = 0; j < 4; ++j) { const int n = (lane >> 3) + 8 * j; const LAS float* sp = scr + (8 * c) * 33 + n;
        v4u o; o.x = pk2(sp[0 * 33], sp[1 * 33]); o.y = pk2(sp[2 * 33], sp[3 * 33]); o.z = pk2(sp[4 * 33], sp[5 * 33]); o.w = pk2(sp[6 * 33], sp[7 * 33]);
        *(v4u*)(WT + (size_t)map_row(mode, n0 + n) * K + k0 + 8 * c) = o; }
    asm volatile("s_waitcnt lgkmcnt(0)" ::: "memory");
}
__device__ __forceinline__ void sincos_d(double x, float& sn, float& cs) {
    const double k = rint(x * 0.63661977236758134308);
    double r = fma(-k, 1.57079632679489655800e+00, x); r = fma(-k, 6.12323399573676603587e-17, r);
    const double r2 = r * r;
    double s = -1.0 / 6227020800.0; s = s * r2 + 1.0 / 39916800.0; s = s * r2 - 1.0 / 362880.0; s = s * r2 + 1.0 / 5040.0; s = s * r2 - 1.0 / 120.0; s = s * r2 + 1.0 / 6.0; s = r - r * r2 * s;
    double c = 1.0 / 479001600.0; c = c * r2 - 1.0 / 3628800.0; c = c * r2 + 1.0 / 40320.0; c = c * r2 - 1.0 / 720.0; c = c * r2 + 1.0 / 24.0; c = c * r2 - 0.5; c = 1.0 + r2 * c;
    const int q = ((int)k) & 3;
    const double ss = (q == 0) ? s : (q == 1) ? c : (q == 2) ? -s : -c;
    const double cc = (q == 0) ? c : (q == 1) ? -s : (q == 2) ? -c : s;
    sn = (float)ss; cs = (float)cc;
}

#define RLX_AGENT __ATOMIC_RELAXED, __HIP_MEMORY_SCOPE_AGENT
#define XB_TMO      128
#define XB_XCNT(j)  (256  + 64 * (j))
#define XB_XSUB(j)  (1280 + 64 * (j))
#define XB_XGEN(j)  (2304 + 64 * (j))
#define XB_TOP      3328
#define XB_TOPGEN   3392
#define XCD_BAR_WORDS 3456
#define XB_SPIN_CAP (1u << 18)

__device__ __forceinline__ unsigned xb_ld(unsigned* p)              { return __hip_atomic_load(p, __ATOMIC_RELAXED, __HIP_MEMORY_SCOPE_AGENT); }
__device__ __forceinline__ unsigned xb_add(unsigned* p, unsigned v) { return __hip_atomic_fetch_add(p, v, __ATOMIC_RELAXED, __HIP_MEMORY_SCOPE_AGENT); }
__device__ __forceinline__ unsigned xb_xcc_id() { return (unsigned)__builtin_amdgcn_s_getreg((3 << 11) | 20) & 0xFu; }
#define XB_SPIN(cond, bar) do { unsigned _sp = 0; while (cond) { __builtin_amdgcn_s_sleep(1); \
    if ((++_sp & 255u) == 0u) { if (xb_ld(&(bar)[XB_TMO])) break; if (_sp > XB_SPIN_CAP) { atomicAdd(&(bar)[XB_TMO], 1u); break; } } } } while (0)

struct XcdBarrier {
    unsigned* bar; unsigned x;
    volatile LAS unsigned* st;
};

__device__ __forceinline__ XcdBarrier xcd_barrier_post(unsigned* bar, volatile LAS unsigned* st) {
    XcdBarrier b; b.bar = bar; b.x = xb_xcc_id(); b.st = st;
    if (threadIdx.x == 0) (void)xb_add(&bar[XB_XCNT(b.x)], 1u);
    return b;
}
__device__ __forceinline__ void xcd_barrier_complete(unsigned* bar, unsigned x, unsigned& nloc, unsigned& nx) {
    const unsigned G = gridDim.x * gridDim.y * gridDim.z;
    unsigned sum, cnt, mine, sp = 0u;
    for (;;) {
        sum = 0u; cnt = 0u; mine = 0u;
#pragma unroll
        for (unsigned j = 0; j < 16; ++j) { const unsigned c = xb_ld(&bar[XB_XCNT(j)]); sum += c; cnt += (c > 0u) ? 1u : 0u; mine = (j == x) ? c : mine; }
        if (sum == G) break;
        __builtin_amdgcn_s_sleep(1);
        if ((++sp & 255u) == 0u) { if (xb_ld(&bar[XB_TMO])) break; if (sp > XB_SPIN_CAP) { atomicAdd(&bar[XB_TMO], 1u); break; } }
    }
    nloc = mine > 0u ? mine : 1u; nx = cnt > 0u ? cnt : 1u;
}

__device__ __forceinline__ void xcd_barrier(const XcdBarrier& b) {
    asm volatile("s_waitcnt vmcnt(0)" ::: "memory");
    __syncthreads();
    if (threadIdx.x == 0) {
        unsigned* bar = b.bar;
        __builtin_amdgcn_s_waitcnt(0);
        unsigned nloc = b.st[0], nx = b.st[1];
        if (nloc == 0u) { xcd_barrier_complete(bar, b.x, nloc, nx); b.st[0] = nloc; b.st[1] = nx; }
        const unsigned old = xb_add(&bar[XB_XSUB(b.x)], 1u);
        const unsigned gen = old / nloc;
        if (old + 1u == (gen + 1u) * nloc) {
            __builtin_amdgcn_fence(__ATOMIC_RELEASE, "agent");
            asm volatile("s_waitcnt vmcnt(0)" ::: "memory");
            const unsigned og = xb_add(&bar[XB_TOP], 1u);
            const unsigned tg = og / nx;
            if (og + 1u == (tg + 1u) * nx) xb_add(&bar[XB_TOPGEN], 1u);
            else XB_SPIN(xb_ld(&bar[XB_TOPGEN]) == tg, bar);
            __builtin_amdgcn_fence(__ATOMIC_ACQUIRE, "agent");
            xb_add(&bar[XB_XGEN(b.x)], 1u);
            asm volatile("s_waitcnt vmcnt(0)" ::: "memory");
        } else {
            XB_SPIN(xb_ld(&bar[XB_XGEN(b.x)]) == gen, bar);
            __builtin_amdgcn_fence(__ATOMIC_ACQUIRE, "agent");
            asm volatile("s_waitcnt vmcnt(0)" ::: "memory");
        }
    }
    __syncthreads();
}

constexpr int MISC_OFF = LDS_BYTES - 128;
constexpr size_t WS_CTL = 0, CTL_ZERO_BYTES = 64 * 1024;
constexpr int CW_KMAX = 8192, CW_QF = 8192 + 512, CW_QM = 8192 + 1024, CW_PCNT = 8192 + 1536, CW_KMAXM = 13824, CW_QMAXM = 14400, CW_DONE = 14464;
static_assert(att::LDS_BYTES <= MISC_OFF, "LDS map");
struct Args { const float* in[13]; float* out; unsigned char* ws; int ph_lo, ph_hi, dup, pad; };
constexpr int NPHASE = 8;

__global__ void __launch_bounds__(NWAVES * 64, 2) mk_fwd(Args args) {
    extern __shared__ __attribute__((aligned(16))) unsigned char lds_raw[];
    LAS unsigned char* lds = (LAS unsigned char*)lds_raw;
    const int G = gridDim.x, bx = blockIdx.x;
#define MK_IDS int tid = threadIdx.x; asm volatile("" : "+v"(tid)); const int lane = tid & 63, wave = __builtin_amdgcn_readfirstlane(tid >> 6); const int gw = vcu * NWAVES + wave; (void)gw; (void)lane;
    const int vcu = (G % 8 == 0) ? (bx % 8) * (G / 8) + bx / 8 : bx;
    const int NGW = G * NWAVES;
    unsigned char* ws = args.ws;
#define MKP_x ((const float*)args.in[0])
#define MKP_g_mix ((const float*)args.in[1])
#define MKP_w_in ((const float*)args.in[2])
#define MKP_b_f ((const float*)args.in[3])
#define MKP_g_q ((const float*)args.in[4])
#define MKP_w_q_up ((const float*)args.in[5])
#define MKP_g_kv ((const float*)args.in[6])
#define MKP_w_kv_up ((const float*)args.in[7])
#define MKP_w_o ((const float*)args.in[8])
#define MKP_g_mlp ((const float*)args.in[9])
#define MKP_w_ff1 ((const float*)args.in[10])
#define MKP_w_ff2 ((const float*)args.in[11])
#define MKP_g_final ((const float*)args.in[12])
#define MKP_out (args.out)
#define MKP_Win_t ((bf16*)(args.ws + WS_WIN))
#define MKP_Wq_t ((bf16*)(args.ws + WS_WQ))
#define MKP_Wkv_t ((bf16*)(args.ws + WS_WKV))
#define MKP_Wo_t ((bf16*)(args.ws + WS_WO))
#define MKP_W1_t ((bf16*)(args.ws + WS_W1))
#define MKP_W2_t ((bf16*)(args.ws + WS_W2))
#define MKP_RT ((float*)(args.ws + WS_RT))
#define MKP_LF ((float*)(args.ws + WS_LF))
#define MKP_SS ((float*)(args.ws + WS_SS))
#define MKP_SSQ ((float*)(args.ws + WS_SSQ))
#define MKP_BIASF ((float*)(args.ws + WS_BIASF))
#define MKP_QMAX ((float*)(args.ws + WS_LC))
#define MKP_SSKV ((float*)(args.ws + WS_SSKV))
#define MKP_KB ((bf16*)(args.ws + WS_KB))
#define MKP_KR ((bf16*)(args.ws + WS_KR))
#define MKP_XN ((bf16*)(args.ws + WS_XN))
#define MKP_HB ((bf16*)(args.ws + WS_H))
#define MKP_P ((bf16*)(args.ws + WS_P))
#define MKP_QM ((bf16*)(args.ws + WS_QM))
#define MKP_KVM ((bf16*)(args.ws + WS_KVM))
#define MKP_QN ((bf16*)(args.ws + WS_QN))
#define MKP_OB ((bf16*)(args.ws + WS_O))
#define MKP_KVN ((bf16*)(args.ws + WS_KVN))
    const int lo = args.ph_lo, hi = args.ph_hi;
#ifndef MK_MASK
#define MK_MASK 0x1ff
#endif
#define IN(k) (((MK_MASK >> (k)) & 1) && lo <= (k) && (k) < hi)
#define REP(k) for (int rep_ = 0; rep_ < ((args.dup == (k)) ? 2 : 1); ++rep_)
    { volatile LAS unsigned* misc = (volatile LAS unsigned*)(lds + MISC_OFF); if (threadIdx.x < 32) misc[threadIdx.x] = 0u; }
    __syncthreads();
    (void)xcd_barrier_post((unsigned*)(ws + WS_CTL), (volatile LAS unsigned*)(lds + MISC_OFF) + 8);
    if (args.ph_lo < 0) cg::this_grid().sync();
#ifdef TS_PHASE
    unsigned long long ts_a_ = 0, ts_b_ = 0;
#define TS_BEGIN(k) do { if ((k) == TS_PHASE || (TS_PHASE == 99 && (k) == 0)) ts_a_ = __builtin_amdgcn_s_memrealtime(); } while (0)
#define TS_END(k) do { if ((k) == TS_PHASE || (TS_PHASE == 99 && (k) == 7)) ts_b_ = __builtin_amdgcn_s_memrealtime(); } while (0)
#else
#define TS_BEGIN(k)
#define TS_END(k)
#endif
#define SEAM(k) do { if (IN(k) && IN((k) + 1)) { XcdBarrier b_; b_.bar = (unsigned*)(args.ws + WS_CTL); b_.x = xb_xcc_id(); b_.st = (volatile LAS unsigned*)(lds + MISC_OFF) + 8; xcd_barrier(b_); } } while (0)

    TS_BEGIN(0);
    if (IN(0)) { MK_IDS
        LAS float* scr = (LAS float*)(lds + wave * 16384);
        constexpr int I_IN = (D / 64) * (NINP / 32), I_Q = (QL / 64) * (NQU / 32), I_KV = (KVL / 64) * (NKVU / 32), I_O = (D / 64) * (D / 32), I_1 = (D / 64) * (FF / 32), I_2 = (FF / 64) * (D / 32);
        constexpr int NITEMS = I_IN + I_Q + I_KV;
        (void)I_O; (void)I_1; (void)I_2;
        for (int it = gw; it < NITEMS; it += NGW) {
            int r = it;
            if (r < I_IN) { p0_transpose_item(MKP_w_in, D, NIN, NINP / 32, MKP_Win_t, 3, nullptr, scr, r, lane); continue; } r -= I_IN;
            if (r < I_Q) { p0_transpose_item(MKP_w_q_up, QL, NQU, NQU / 32, MKP_Wq_t, 1, MKP_g_q, scr, r, lane); continue; } r -= I_Q;
            p0_transpose_item(MKP_w_kv_up, KVL, NKVU, NKVU / 32, MKP_Wkv_t, 2, MKP_g_kv, scr, r, lane);
        }
        for (int m0 = gw; m0 < M; m0 += 4 * NGW) {
            const f32x4* gr = (const f32x4*)MKP_g_mix + lane; f32x4 v[4][4]; float s2[4];
#pragma unroll
            for (int r = 0; r < 4; ++r) { const int m = m0 + r * NGW; const f32x4* xr = (const f32x4*)(MKP_x + (size_t)(m < M ? m : 0) * D) + lane;
#pragma unroll
                for (int j = 0; j < 4; ++j) v[r][j] = __builtin_nontemporal_load(xr + 64 * j); }
#pragma unroll
            for (int r = 0; r < 4; ++r) { s2[r] = 0.f;
#pragma unroll
                for (int j = 0; j < 4; ++j) s2[r] += (v[r][j].x * v[r][j].x + v[r][j].y * v[r][j].y) + (v[r][j].z * v[r][j].z + v[r][j].w * v[r][j].w);
                s2[r] = 1.f / sqrtf(wave_sum(s2[r]) * (1.f / D) + EPS); }
#pragma unroll
            for (int r = 0; r < 4; ++r) { const int m = m0 + r * NGW; if (m < M) { unsigned long long* o8 = (unsigned long long*)(MKP_XN + (size_t)m * D) + lane; const float rstd = s2[r];
#pragma unroll
                for (int j = 0; j < 4; ++j) { const f32x4 g = gr[64 * j]; o8[64 * j] = (unsigned long long)pk2(v[r][j].x * rstd * g.x, v[r][j].y * rstd * g.y) | ((unsigned long long)pk2(v[r][j].z * rstd * g.z, v[r][j].w * rstd * g.w) << 32); } } }
        }
        for (int e = (vcu * NWAVES * 64 + tid); e < M * 16; e += G * NWAVES * 64) {
            const int m = e >> 4, i = e & 15; double inv = 1.0; for (int j = 0; j < i; ++j) inv *= 0.56234132519034908039;
            float sn, cs; sincos_d((double)m * inv, sn, cs); MKP_RT[2 * e] = cs; MKP_RT[2 * e + 1] = sn;
        }
    }
    SEAM(0);
    TS_END(0);
    TS_BEGIN(1);
    if (IN(1)) {
        pg8::Gemm g{MKP_XN, MKP_Win_t, M, NINP, D}; pg8::StaticOrder S; S.init(M, NINP, G, bx);
        pg8::EpiIn E{MKP_P, NINP, C2_FOX, MKP_SSQ, MKP_SSKV, MKP_RT, MKP_b_f, MKP_LF, M};
        pg8::gemm_phase<pg8::EpiIn, pg8::StaticOrder, PG8_ALIGN, PG8_SP2>(lds, g, S, E);
    }
    SEAM(1);
    TS_END(1);
    TS_BEGIN(3);
    if (IN(3)) { MK_IDS
        if (wave >= 2) {
            LAS float* scr = (LAS float*)(lds + wave * 16384);
            constexpr int J_O = (D / 64) * (D / 32), J_1 = (D / 64) * (FF / 32), J_2 = (FF / 64) * (D / 32);
            for (int it = vcu * 6 + (wave - 2); it < J_O + J_1 + J_2; it += G * 6) {
                int r = it;
                if (r < J_O) { p0_transpose_item(MKP_w_o, D, D, D / 32, MKP_Wo_t, 0, nullptr, scr, r, lane); continue; } r -= J_O;
                if (r < J_1) { p0_transpose_item(MKP_w_ff1, D, FF, FF / 32, MKP_W1_t, 0, MKP_g_mlp, scr, r, lane); continue; } r -= J_1;
                p0_transpose_item(MKP_w_ff2, FF, D, D / 32, MKP_W2_t, 0, nullptr, scr, r, lane);
            }
        }
        if (wave < 2) { const int job = bx + 256 * wave;
            if (job < 512 && bx < 256) { const int h = job >> 6, ti = job & 63; const f32x4* lf4 = (const f32x4*)(MKP_LF + (size_t)h * M);
                float pre = 0.f; { int j = 0; float pa[8] = {0.f, 0.f, 0.f, 0.f, 0.f, 0.f, 0.f, 0.f};
                    for (; j + 8 <= ti; j += 8) { f32x4 w[8];
#pragma unroll
                        for (int u = 0; u < 8; ++u) w[u] = lf4[(j + u) * 64 + lane];
#pragma unroll
                        for (int u = 0; u < 8; ++u) pa[u] += (w[u].x + w[u].y) + (w[u].z + w[u].w); }
                    for (; j < ti; ++j) { const f32x4 w = lf4[j * 64 + lane]; pa[0] += (w.x + w.y) + (w.z + w.w); }
                    pre = ((pa[0] + pa[1]) + (pa[2] + pa[3])) + ((pa[4] + pa[5]) + (pa[6] + pa[7])); }
                pre = wave_sum(pre);
                const f32x4 v = lf4[ti * 64 + lane];
                const float s1 = v.x, s2 = s1 + v.y, s3 = s2 + v.z, s4 = s3 + v.w; float inc = s4;
#pragma unroll
                for (int o = 1; o < 64; o <<= 1) { const float n = __shfl_up(inc, o); if (lane >= o) inc += n; }
                const float ex = pre + (inc - s4); const float cs[4] = {ex + s1, ex + s2, ex + s3, ex + s4};
                *(f32x4*)(MKP_BIASF + (size_t)h * M + ti * 256 + 4 * lane) = (f32x4){-cs[0] * LOG2E, -cs[1] * LOG2E, -cs[2] * LOG2E, -cs[3] * LOG2E};
                { float km = 0.f;
                  float qmx = 0.f;
                  for (int e = 0; e < 4; ++e) { const v4u* kr = (const v4u*)(MKP_P + (size_t)(ti * 256 + 4 * lane + e) * NINP + 512 + h * 64); float a2 = 0.f; const v4u* qrw = kr - 64; float q2 = 0.f;
#pragma unroll
                      for (int c8 = 0; c8 < 8; ++c8) { const v4u w = qrw[c8]; const unsigned ww[4] = {w.x, w.y, w.z, w.w};
#pragma unroll
                          for (int q4 = 0; q4 < 4; ++q4) { const float lo_ = __builtin_bit_cast(float, ww[q4] << 16), hi_ = __builtin_bit_cast(float, ww[q4] & 0xffff0000u); q2 += lo_ * lo_ + hi_ * hi_; } }
                      qmx = fmaxf(qmx, q2);
#pragma unroll
                      for (int c8 = 0; c8 < 8; ++c8) { const v4u w = kr[c8]; const unsigned ww[4] = {w.x, w.y, w.z, w.w};
#pragma unroll
                          for (int q4 = 0; q4 < 4; ++q4) { const float lo_ = __builtin_bit_cast(float, ww[q4] << 16), hi_ = __builtin_bit_cast(float, ww[q4] & 0xffff0000u); a2 += lo_ * lo_ + hi_ * hi_; } }
                      km = fmaxf(km, a2); }
#pragma unroll
                  for (int o = 32; o >= 1; o >>= 1) km = fmaxf(km, __shfl_xor(km, o));
#pragma unroll
                  for (int o = 32; o >= 1; o >>= 1) qmx = fmaxf(qmx, __shfl_xor(qmx, o));
                  if (lane == 0) { atomicMax((unsigned*)(args.ws + WS_CTL) + CW_KMAX + 64 * h, __builtin_bit_cast(unsigned, km)); MKP_QMAX[h * 64 + ti] = qmx; } }
#pragma unroll
                for (int e = 0; e < 4; ++e) { const float b = -cs[e] * LOG2E; const unsigned bh = f2bf(b); const float r1 = b - __builtin_bit_cast(float, bh << 16); const unsigned bm = f2bf(r1);
                    const float r2 = r1 - __builtin_bit_cast(float, bm << 16); const unsigned bl = f2bf(r2);
                    *(v4u*)(MKP_KB + ((size_t)h * M + ti * 256 + 4 * lane + e) * 8) = (v4u){bh | (bm << 16), bl | 0x3F800000u, 0x3F803F80u, 0u}; } } }
        __syncthreads();
        { int kq = QL; asm volatile("" : "+s"(kq)); pg8::Gemm g{MKP_P + 1536, MKP_Wq_t, M, NQU, kq, NINP}; pg8::StaticOrder S; S.init(M, NQU, G, bx);
          pg8::EpiQm E{MKP_QM, NQU, MKP_RT, C2_MLA, MKP_SSQ, EPS};
          pg8::gemm_phase<pg8::EpiQm, pg8::StaticOrder, PG8_ALIGN, PG8_SP2>(lds, g, S, E); }
        { int kkv = KVL; asm volatile("" : "+s"(kkv)); pg8::Gemm g{MKP_P + 1792, MKP_Wkv_t, M, NKVU, kkv, NINP}; pg8::StaticOrder S; S.init(M, NKVU, G, bx);
          pg8::EpiKv E{MKP_KVM, NKVU, MKP_SSKV, EPS};
          pg8::gemm_phase<pg8::EpiKv, pg8::StaticOrder, PG8_ALIGN, PG8_SP2>(lds, g, S, E); }
    }
    SEAM(3);
    TS_END(3);
    TS_BEGIN(4);
    if (IN(4)) {
        const int v = (G == 256) ? vcu : bx; const int h0 = (v >> 5) & 7;
        volatile LAS unsigned* misc = (volatile LAS unsigned*)(lds + MISC_OFF);
        unsigned* ctlw = (unsigned*)(args.ws + WS_CTL);
        { const int tid_ = threadIdx.x, lane_ = tid_ & 63, tok = bx * 64 + (tid_ >> 3), hh = tid_ & 7; float k2 = 0.f, q2 = 0.f;
          if (bx < 256) {
            const v4u* kp = (const v4u*)(MKP_KVM + (size_t)tok * NKVU + hh * 64); const v4u* rp = (const v4u*)(MKP_P + (size_t)tok * NINP + 1920); const v4u* qp = (const v4u*)(MKP_QM + (size_t)tok * NQU + hh * 96);
#define MK_SQ(w_, acc_) do { const unsigned ww_[4] = {w_.x, w_.y, w_.z, w_.w}; _Pragma("unroll") for (int q4_ = 0; q4_ < 4; ++q4_) { const float lo_ = __builtin_bit_cast(float, ww_[q4_] << 16), hi_ = __builtin_bit_cast(float, ww_[q4_] & 0xffff0000u); acc_ += lo_ * lo_ + hi_ * hi_; } } while (0)
#pragma unroll
            for (int c8 = 0; c8 < 8; ++c8) { const v4u w = kp[c8]; MK_SQ(w, k2); }
#pragma unroll
            for (int c8 = 0; c8 < 4; ++c8) { const v4u w = rp[c8]; MK_SQ(w, k2); }
#pragma unroll
            for (int c8 = 0; c8 < 12; ++c8) { const v4u w = qp[c8]; MK_SQ(w, q2); }
#undef MK_SQ
          }
#pragma unroll
          for (int o = 8; o <= 32; o <<= 1) { k2 = fmaxf(k2, __shfl_xor(k2, o)); q2 = fmaxf(q2, __shfl_xor(q2, o)); }
          if (lane_ < 8) { atomicMax(ctlw + CW_KMAXM + 64 * lane_, __builtin_bit_cast(unsigned, k2)); atomicMax(ctlw + CW_QMAXM, __builtin_bit_cast(unsigned, q2)); }
          asm volatile("s_waitcnt vmcnt(0)" ::: "memory"); __syncthreads();
          if (tid_ == 0) __hip_atomic_fetch_add(ctlw + CW_DONE, 1u, __ATOMIC_RELAXED, __HIP_MEMORY_SCOPE_AGENT); }
        bool okF = true;
        { const int lane_ = threadIdx.x & 63;
          for (int h = 0; h < 8; ++h) { const float kF = __builtin_bit_cast(float, __hip_atomic_load(ctlw + CW_KMAX + 64 * h, __ATOMIC_RELAXED, __HIP_MEMORY_SCOPE_AGENT));
              float qF = MKP_QMAX[h * 64 + lane_];
#pragma unroll
              for (int o = 32; o >= 1; o >>= 1) qF = fmaxf(qF, __shfl_xor(qF, o));
              okF = okF && (qF * kF < 2025.f); }
          okF = __builtin_amdgcn_readfirstlane(okF ? 1 : 0) != 0; }
#ifndef PROBE_FOX
#define PROBE_FOX 1
#endif
#ifndef PROBE_MLA
#define PROBE_MLA 1
#endif
#define MK_POP(CWQ) \
            if ((threadIdx.x >> 6) == 0) { const int ln_ = threadIdx.x & 63; unsigned i_ = 0xFFFFFFFFu; int hs_ = h0; \
                if (own) { if (ln_ == 0) i_ = __hip_atomic_fetch_add(ctlw + (CWQ) + 64 * h0 + 16 * rep, 1u, __ATOMIC_RELAXED, __HIP_MEMORY_SCOPE_AGENT); i_ = (unsigned)__builtin_amdgcn_readfirstlane((int)i_); } \
                if (!own || i_ >= 64u) { unsigned c_ = 64u; if (ln_ < 8) c_ = __hip_atomic_load(ctlw + (CWQ) + 64 * ((h0 + ln_) & 7) + 16 * rep, __ATOMIC_RELAXED, __HIP_MEMORY_SCOPE_AGENT); \
                    const unsigned long long m_ = __ballot(c_ < 64u); i_ = 0xFFFFFFFFu; \
                    if (m_ != 0ull) { hs_ = (h0 + (int)__builtin_ctzll(m_)) & 7; if (ln_ == 0) i_ = __hip_atomic_fetch_add(ctlw + (CWQ) + 64 * hs_ + 16 * rep, 1u, __ATOMIC_RELAXED, __HIP_MEMORY_SCOPE_AGENT); \
                        i_ = (unsigned)__builtin_amdgcn_readfirstlane((int)i_); if (i_ >= 64u) i_ = 0xFFFFFFFEu; } } \
                if (ln_ == 0) { misc[0] = i_; misc[1] = (unsigned)hs_; } } \
            __syncthreads(); const unsigned i = misc[0]; const int h = (int)misc[1]; __syncthreads(); \
            if (h != h0 || i >= 64u) own = false; \
            if (i == 0xFFFFFFFFu) break; \
            if (i >= 64u) continue;
#define MK_FOX_LOOPS(FIXV) do { \
        for (int rep = 0; rep < PROBE_FOX; ++rep) { bool own = true; \
        for (;;) { MK_POP(CW_QF) \
            const float kmax2 = __builtin_bit_cast(float, __hip_atomic_load(ctlw + CW_KMAX + 64 * h, __ATOMIC_RELAXED, __HIP_MEMORY_SCOPE_AGENT)); \
            att::Src s{MKP_P + h * 64, NINP, MKP_P + 512 + h * 64, NINP, MKP_KB + (size_t)h * M * 8, 8, MKP_P + 1024 + h * 64, NINP, MKP_OB + h * 64, D}; \
            att::attn_unit<false, FIXV>(63 - (int)i, s, lds, MKP_BIASF + (size_t)h * M, kmax2, MKP_QMAX + h * 64); \
        } } } while (0)
#define MK_MLA_LOOPS(FIXV) do { \
        for (int rep = 0; rep < PROBE_MLA; ++rep) { bool own = true; \
        for (;;) { MK_POP(CW_QM) \
            const float kmaxm = __builtin_bit_cast(float, __hip_atomic_load(ctlw + CW_KMAXM + 64 * h, __ATOMIC_RELAXED, __HIP_MEMORY_SCOPE_AGENT)); \
            att::Src s{MKP_QM + h * 96, NQU, MKP_KVM + h * 64, NKVU, MKP_P + 1920, NINP, MKP_KVM + 512 + h * 64, NKVU, MKP_OB + 512 + h * 64, D}; \
            att::attn_unit<true, FIXV>(63 - (int)i, s, lds, nullptr, kmaxm, nullptr); \
        } } } while (0)
        if (okF) MK_FOX_LOOPS(true); else MK_FOX_LOOPS(false);
        asm volatile("" ::: "memory");
        if (threadIdx.x == 0) { unsigned sp = 0; while (__hip_atomic_load(ctlw + CW_DONE, __ATOMIC_RELAXED, __HIP_MEMORY_SCOPE_AGENT) < (unsigned)G) { __builtin_amdgcn_s_sleep(2); if (++sp > (1u << 22)) break; } }
        __syncthreads();
        bool okM = true;
        { const float qmM = __builtin_bit_cast(float, __hip_atomic_load(ctlw + CW_QMAXM, __ATOMIC_RELAXED, __HIP_MEMORY_SCOPE_AGENT));
          for (int h = 0; h < 8; ++h) { const float kM = __builtin_bit_cast(float, __hip_atomic_load(ctlw + CW_KMAXM + 64 * h, __ATOMIC_RELAXED, __HIP_MEMORY_SCOPE_AGENT)); okM = okM && (qmM * kM < 2025.f); }
          okM = __builtin_amdgcn_readfirstlane(okM ? 1 : 0) != 0; }
        if (okM) MK_MLA_LOOPS(true); else MK_MLA_LOOPS(false);
#undef MK_FOX_LOOPS
#undef MK_MLA_LOOPS
#undef MK_POP
    }
#ifdef ATT_PRIO
    __builtin_amdgcn_s_setprio(0);
#endif
    SEAM(4);
    TS_END(4);
    TS_BEGIN(5);
    if (IN(5)) {
        pg8::Gemm g{MKP_OB, MKP_Wo_t, M, D, D}; pg8::StaticOrder S; S.init(M, D, G, bx);
        pg8::EpiRes E{MKP_x, MKP_out, D, MKP_XN, MKP_SS};
        pg8::gemm_phase<pg8::EpiRes, pg8::StaticOrder, PG8_ALIGN, PG8_SP2>(lds, g, S, E);
    }
    SEAM(5);
    TS_END(5);
    TS_BEGIN(6);
    if (IN(6)) {
        pg8::Gemm g{MKP_XN, MKP_W1_t, M, FF, D}; int pflag = 1; asm volatile("" : "+s"(pflag)); pg8::StaticOrder S; S.init(M, D, G, bx, pflag);
        pg8::EpiSqRelu E{MKP_HB, FF, MKP_SS, EPS, 1.f / D};
        pg8::gemm_phase<pg8::EpiSqRelu, pg8::StaticOrder, PG8_ALIGN, PG8_SP2>(lds, g, S, E);
    }
    SEAM(6);
    TS_END(6);
    TS_BEGIN(7);
    if (IN(7)) {
        pg8::Gemm g{MKP_HB, MKP_W2_t, M, D, FF}; pg8::StaticOrder S; S.init(M, D, G, bx);
        pg8::EpiResNorm E{MKP_out, MKP_out, D, MKP_g_final, MKP_SSQ, (unsigned*)(args.ws + WS_CTL) + CW_PCNT, EPS, 1.f / D};
        pg8::gemm_phase<pg8::EpiResNorm, pg8::StaticOrder, false, PG8_SP2>(lds, g, S, E);
    }
#ifdef TS_PHASE
    { XcdBarrier b_; b_.bar = (unsigned*)(args.ws + WS_CTL); b_.x = xb_xcc_id(); b_.st = (volatile LAS unsigned*)(lds + MISC_OFF) + 8; xcd_barrier(b_); }
    TS_END(7);
    if (blockIdx.x == 0 && threadIdx.x == 0) MKP_out[0] = (float)(((ts_b_ - ts_a_) / TS_Q) * (TS_Q / 100ull));
#endif
#undef IN
#undef SEAM
#undef MKP_x
#undef MKP_g_mix
#undef MKP_w_in
#undef MKP_b_f
#undef MKP_g_q
#undef MKP_w_q_up
#undef MKP_g_kv
#undef MKP_w_kv_up
#undef MKP_w_o
#undef MKP_g_mlp
#undef MKP_w_ff1
#undef MKP_w_ff2
#undef MKP_g_final
#undef MKP_out
#undef MKP_Win_t
#undef MKP_Wq_t
#undef MKP_Wkv_t
#undef MKP_Wo_t
#undef MKP_W1_t
#undef MKP_W2_t
#undef MKP_RT
#undef MKP_LF
#undef MKP_SS
#undef MKP_SSQ
#undef MKP_BIASF
#undef MKP_QMAX
#undef MKP_SSKV
#undef MKP_KB
#undef MKP_KR
#undef MKP_XN
#undef MKP_HB
#undef MKP_P
#undef MKP_QM
#undef MKP_KVM
#undef MKP_QN
#undef MKP_OB
#undef MKP_KVN
}

#ifndef MK_ONE_LAUNCH
#define MK_ONE_LAUNCH 1
#endif
extern "C" void kernel_launch(void* const* d_in, const int* in_sizes, int n_in, void* d_out, int out_size, void* d_ws, size_t ws_size, hipStream_t stream) {
    static int ready = 0;
    if (ready == 0) {
        if (n_in != 13 || in_sizes[0] != M * D || out_size != M * D || ws_size < WS_END) { fprintf(stderr, "kernel_launch: unexpected shapes (n_in %d, in0 %d, out %d, ws %zu)\n", n_in, n_in > 0 ? in_sizes[0] : -1, out_size, ws_size); ready = -1; return; }
        if (hipFuncSetAttribute((const void*)mk_fwd, hipFuncAttributeMaxDynamicSharedMemorySize, LDS_BYTES) != hipSuccess) { fprintf(stderr, "kernel_launch: hipFuncSetAttribute failed\n"); ready = -1; return; }
        ready = 1;
    }
    if (ready < 0) return;
    if (hipMemsetAsync((char*)d_ws + WS_CTL, 0, CTL_ZERO_BYTES, stream) != hipSuccess) { fprintf(stderr, "kernel_launch: hipMemsetAsync failed\n"); return; }
    Args a{};
    for (int i = 0; i < 13; ++i) a.in[i] = (const float*)d_in[i];
    a.out = (float*)d_out; a.ws = (unsigned char*)d_ws;
#ifndef MK_DUP
#define MK_DUP -1
#endif
    a.dup = MK_DUP;
    const int grid = 256;
#if MK_ONE_LAUNCH
    a.ph_lo = 0; a.ph_hi = NPHASE;
    void* kargs[] = {&a};
    hipError_t e = hipLaunchCooperativeKernel((const void*)mk_fwd, dim3(grid), dim3(NWAVES * 64), kargs, LDS_BYTES, stream);
    if (e != hipSuccess) fprintf(stderr, "kernel_launch: cooperative launch failed: %s\n", hipGetErrorString(e));
#else
    for (int p = 0; p < NPHASE; ++p) { a.ph_lo = p; a.ph_hi = p + 1; hipLaunchKernelGGL(mk_fwd, dim3(grid), dim3(NWAVES * 64), LDS_BYTES, stream, a); }
#endif
}
```
